# Optimizing an MI355X kernel written in HIP

```python
import jax
import jax.numpy as jnp
from jax import lax
import numpy as np

D_MODEL = 1024
BATCH = 4
SEQ = 8192
DEPTH = 2

CHUNK = 64
Q_BLOCK = 128
HEAD_DIM = 64
ROPE_THETA = 10000.0

DSA_HEADS = 8
IDX_HEADS = 4
IDX_DIM = 64
DSA_TOPK_MAX = 256

FOX_HEADS = 8

HGRN_HEADS = 8
HGRN_DK = 64
HGRN_DV = 64

N_BRANCH = 3

N_EXPERTS = 32
TOP_K = 4
D_EXPERT = D_MODEL
SWIGLU_LIMIT = 7.0
SWIGLU_ALPHA = 1.702
MOE_BLOCK = 256

LN_EPS = 1e-5
RMS_EPS = 1e-6
DEEPNORM_ALPHA = (2 * DEPTH) ** 0.25
DEEPNORM_BETA = (8 * DEPTH) ** -0.25

IN_SPLITS = (
    DSA_HEADS * HEAD_DIM, DSA_HEADS * HEAD_DIM, DSA_HEADS * HEAD_DIM,
    IDX_HEADS * IDX_DIM, IDX_DIM, IDX_HEADS,
    FOX_HEADS * HEAD_DIM, FOX_HEADS * HEAD_DIM, FOX_HEADS * HEAD_DIM,
    FOX_HEADS,
    HGRN_HEADS * HGRN_DK, HGRN_HEADS * HGRN_DK,
    HGRN_HEADS * HGRN_DV, HGRN_HEADS * HGRN_DV,
    N_BRANCH * D_MODEL,
)
D_IN = sum(IN_SPLITS)
SPLIT_POINTS = tuple(int(v) for v in np.cumsum(IN_SPLITS)[:-1])

kernel_name = 'hybrid_dsa_fox_hgrn2_moe_deepnorm'


def layer_norm(x, g, b):
    x32 = x.astype(jnp.float32)
    mu = jnp.mean(x32, axis=-1, keepdims=True)
    var = jnp.mean(jnp.square(x32 - mu), axis=-1, keepdims=True)
    return ((x32 - mu) * lax.rsqrt(var + LN_EPS) * g + b).astype(x.dtype)


def rope(t, pos):
    half = t.shape[-1] // 2
    inv = ROPE_THETA ** (-jnp.arange(half, dtype=jnp.float32) / half)
    ang = pos.astype(jnp.float32)[:, None] * inv[None, :]
    cos = jnp.cos(ang)[None, :, None, :]
    sin = jnp.sin(ang)[None, :, None, :]
    t32 = t.astype(jnp.float32)
    t1, t2 = t32[..., :half], t32[..., half:]
    return jnp.concatenate([t1 * cos - t2 * sin, t2 * cos + t1 * sin], axis=-1).astype(t.dtype)


def dsa_attention(q, k, v, iq, ik, iw):
    B, S, H, Dh = q.shape
    k_sel = min(DSA_TOPK_MAX, S // 4)
    n_blk = S // Q_BLOCK
    key_pos = jnp.arange(S)
    scale = Dh ** -0.5
    iscale = IDX_DIM ** -0.5
    ik32 = ik.astype(jnp.float32)
    gather = jax.vmap(lambda t, idx: t[idx])

    def block(i):
        t0 = i * Q_BLOCK
        qpos = t0 + jnp.arange(Q_BLOCK)
        iq_b = lax.dynamic_slice_in_dim(iq, t0, Q_BLOCK, axis=1).astype(jnp.float32)
        iw_b = lax.dynamic_slice_in_dim(iw, t0, Q_BLOCK, axis=1)
        rel = jax.nn.relu(jnp.einsum('bqhd,bsd->bqhs', iq_b, ik32) * iscale)
        score = jnp.einsum('bqhs,bqh->bqs', rel, iw_b)
        admissible = key_pos[None, :] < ((qpos // CHUNK + 1) * CHUNK)[:, None]
        score = jnp.where(admissible[None], score, -jnp.inf)
        sel_score, sel_idx = lax.top_k(score, k_sel)
        valid = jnp.isfinite(sel_score)
        kg = gather(k, sel_idx)
        vg = gather(v, sel_idx)
        q_b = lax.dynamic_slice_in_dim(q, t0, Q_BLOCK, axis=1)
        logits = jnp.einsum('bqhd,bqkhd->bhqk', q_b, kg,
                            preferred_element_type=jnp.float32) * scale
        logits = jnp.where(valid[:, None], logits, -jnp.inf)
        p = jax.nn.softmax(logits, axis=-1)
        return jnp.einsum('bhqk,bqkhd->bqhd', p.astype(v.dtype), vg)

    out = lax.map(block, jnp.arange(n_blk))
    return out.transpose(1, 0, 2, 3, 4).reshape(B, S, H * Dh)


def fox_attention(q, k, v, log_f):
    B, S, H, Dh = q.shape
    n_blk = S // Q_BLOCK
    key_pos = jnp.arange(S)
    scale = Dh ** -0.5
    c = jnp.cumsum(log_f, axis=1).transpose(0, 2, 1)

    def block(i):
        t0 = i * Q_BLOCK
        qpos = t0 + jnp.arange(Q_BLOCK)
        q_b = lax.dynamic_slice_in_dim(q, t0, Q_BLOCK, axis=1)
        c_b = lax.dynamic_slice_in_dim(c, t0, Q_BLOCK, axis=2)
        logits = (jnp.einsum('bqhd,bshd->bhqs', q_b, k,
                             preferred_element_type=jnp.float32) * scale
                  + c_b[..., None] - c[:, :, None, :])
        causal = key_pos[None, :] <= qpos[:, None]
        logits = jnp.where(causal, logits, -jnp.inf)
        p = jax.nn.softmax(logits, axis=-1)
        return jnp.einsum('bhqs,bshd->bqhd', p.astype(v.dtype), v)

    out = lax.map(block, jnp.arange(n_blk))
    return out.transpose(1, 0, 2, 3, 4).reshape(B, S, H * Dh)


def hgrn2_recurrence(q, k, v, log_f):
    B, S, H, DK = q.shape
    DV = v.shape[-1]
    n_c = S // CHUNK

    def to_chunks(t):
        return t.reshape(B, n_c, CHUNK, H, t.shape[-1]).transpose(1, 0, 3, 2, 4)

    tri = jnp.tril(jnp.ones((CHUNK, CHUNK), dtype=bool))

    def step(state, inp):
        qc, kc, vc, lfc = inp
        b = jnp.cumsum(lfc, axis=2)
        inter = jnp.einsum('bhtd,bhde->bhte', qc * jnp.exp(b), state)
        decay = jnp.exp(jnp.where(tri[:, :, None],
                                  b[:, :, :, None, :] - b[:, :, None, :, :], -jnp.inf))
        scores = jnp.einsum('bhtsd,bhsd->bhts', qc[:, :, :, None, :] * decay, kc)
        intra = jnp.einsum('bhts,bhse->bhte', scores, vc)
        b_last = b[:, :, -1, :]
        new_state = (jnp.exp(b_last)[..., None] * state
                     + jnp.einsum('bhsd,bhse->bhde', kc * jnp.exp(b_last[:, :, None, :] - b), vc))
        return new_state, inter + intra

    state0 = jnp.zeros((B, H, DK, DV), jnp.float32)
    _, out = lax.scan(step, state0, (to_chunks(q), to_chunks(k), to_chunks(v), to_chunks(log_f)))
    return out.transpose(1, 0, 3, 2, 4).reshape(B, S, H, DV)


def token_mixers(x, w_in, b_fox_f, lb, hgrn_norm_g, w_pa, w_pb, w_pc, w_out):
    B, S, _ = x.shape
    pos = jnp.arange(S)
    z = x @ w_in
    (aq, ak, av, iq, ik, iw, fq, fk, fv, ff, cq, cf, ci, cg, gt) = jnp.split(z, SPLIT_POINTS, axis=-1)

    def heads(t, h):
        return t.reshape(B, S, h, -1)

    aq = rope(heads(aq, DSA_HEADS), pos)
    ak = rope(heads(ak, DSA_HEADS), pos)
    av = heads(av, DSA_HEADS)
    iq = rope(heads(iq, IDX_HEADS), pos)
    ik = rope(ik[:, :, None, :], pos)[:, :, 0, :]
    iw = iw.astype(jnp.float32) * IDX_HEADS ** -0.5
    o_a = dsa_attention(aq, ak, av, iq, ik, iw)

    log_f_fox = jax.nn.log_sigmoid(ff.astype(jnp.float32) + b_fox_f.astype(jnp.float32))
    o_b = fox_attention(heads(fq, FOX_HEADS), heads(fk, FOX_HEADS), heads(fv, FOX_HEADS), log_f_fox)

    zf = cf.astype(jnp.float32)
    log_f_c = jnp.logaddexp(jnp.log(lb), jnp.log1p(-lb) + jax.nn.log_sigmoid(zf))
    k_c = (1.0 - lb) * jax.nn.sigmoid(-zf)
    o_c = hgrn2_recurrence(heads(cq.astype(jnp.float32), HGRN_HEADS), heads(k_c, HGRN_HEADS),
                           heads(ci.astype(jnp.float32), HGRN_HEADS), heads(log_f_c, HGRN_HEADS))
    o_c = (o_c * lax.rsqrt(jnp.mean(jnp.square(o_c), axis=-1, keepdims=True) + RMS_EPS)
           * hgrn_norm_g.astype(jnp.float32).reshape(HGRN_HEADS, HGRN_DV)
           * jax.nn.sigmoid(heads(cg.astype(jnp.float32), HGRN_HEADS)))
    o_c = o_c.reshape(B, S, HGRN_HEADS * HGRN_DV).astype(x.dtype)

    g = jax.nn.sigmoid(gt.reshape(B, S, N_BRANCH, D_MODEL))
    merged = g[:, :, 0] * (o_a @ w_pa) + g[:, :, 1] * (o_b @ w_pb) + g[:, :, 2] * (o_c @ w_pc)
    return merged @ w_out


def moe_ffn(h, w_router, b_router, w_gu, b_gu, w_down, b_down):
    B, S, D = h.shape
    xt = h.reshape(-1, D)
    n_tok = xt.shape[0]
    n_assign = n_tok * TOP_K
    logits = xt.astype(jnp.float32) @ w_router.astype(jnp.float32) + b_router.astype(jnp.float32)
    top_val, top_idx = lax.top_k(logits, TOP_K)
    gates = jax.nn.softmax(top_val, axis=-1)

    flat_e = top_idx.reshape(-1).astype(jnp.int32)
    order = jnp.argsort(flat_e).astype(jnp.int32)
    sorted_e = flat_e[order]
    counts = jnp.bincount(flat_e, length=N_EXPERTS).astype(jnp.int32)
    padded = (counts + MOE_BLOCK - 1) // MOE_BLOCK * MOE_BLOCK
    pad_end = jnp.cumsum(padded)
    pad_start = pad_end - padded
    start = jnp.cumsum(counts) - counts
    rank = jnp.arange(n_assign, dtype=jnp.int32) - start[sorted_e]
    dest = pad_start[sorted_e] + rank
    n_blocks = -(-(n_assign + N_EXPERTS * (MOE_BLOCK - 1)) // MOE_BLOCK)
    tok_sorted = order // TOP_K
    slot_tok = jnp.zeros((n_blocks * MOE_BLOCK,), jnp.int32).at[dest].set(tok_sorted)
    blk_e = jnp.searchsorted(pad_end, jnp.arange(n_blocks, dtype=jnp.int32) * MOE_BLOCK, side='right')
    blk_e = jnp.minimum(blk_e, N_EXPERTS - 1)

    def expert_block(args):
        tok, e = args
        xb = xt[tok]
        gu = xb @ w_gu[e] + b_gu[e]
        gate = jnp.minimum(gu[:, :D_EXPERT], SWIGLU_LIMIT)
        up = jnp.clip(gu[:, D_EXPERT:], -SWIGLU_LIMIT, SWIGLU_LIMIT)
        act = gate * jax.nn.sigmoid(SWIGLU_ALPHA * gate) * (up + 1.0)
        return act @ w_down[e] + b_down[e]

    y_slots = lax.map(expert_block, (slot_tok.reshape(n_blocks, MOE_BLOCK), blk_e))
    y_slots = y_slots.reshape(n_blocks * MOE_BLOCK, D)
    gate_sorted = gates.reshape(-1)[order].astype(y_slots.dtype)
    y_assign = y_slots[dest] * gate_sorted[:, None]
    out = jax.ops.segment_sum(y_assign, tok_sorted, num_segments=n_tok)
    return out.reshape(B, S, D).astype(h.dtype)


def setup_inputs(seed: int = 0) -> dict:
    key = jax.random.key(seed)
    ks = jax.random.split(key, 20)
    f32 = jnp.float32
    wa = DSA_HEADS * HEAD_DIM
    wb = FOX_HEADS * HEAD_DIM
    wc = HGRN_HEADS * HGRN_DV
    nrm = lambda k, shape: jax.random.normal(k, shape, f32)
    return {
        'x': nrm(ks[0], (BATCH, SEQ, D_MODEL)),
        'w_in': nrm(ks[1], (DEPTH, D_MODEL, D_IN)) * D_MODEL ** -0.5,
        'b_fox_f': 3.0 + 0.1 * nrm(ks[2], (DEPTH, FOX_HEADS)),
        'hgrn_lb_logits': 0.5 * nrm(ks[3], (DEPTH, HGRN_HEADS * HGRN_DK)),
        'hgrn_norm_g': 1.0 + 0.02 * nrm(ks[4], (DEPTH, HGRN_HEADS * HGRN_DV)),
        'w_branch_a': nrm(ks[5], (DEPTH, wa, D_MODEL)) * wa ** -0.5 * DEEPNORM_BETA,
        'w_branch_b': nrm(ks[6], (DEPTH, wb, D_MODEL)) * wb ** -0.5 * DEEPNORM_BETA,
        'w_branch_c': nrm(ks[7], (DEPTH, wc, D_MODEL)) * wc ** -0.5 * DEEPNORM_BETA,
        'w_out': nrm(ks[8], (DEPTH, D_MODEL, D_MODEL)) * D_MODEL ** -0.5 * DEEPNORM_BETA,
        'ln1_g': 1.0 + 0.02 * nrm(ks[9], (DEPTH, D_MODEL)),
        'ln1_b': 0.02 * nrm(ks[10], (DEPTH, D_MODEL)),
        'w_router': nrm(ks[11], (DEPTH, D_MODEL, N_EXPERTS)) * D_MODEL ** -0.5,
        'b_router': 0.01 * nrm(ks[12], (DEPTH, N_EXPERTS)),
        'w_gu': nrm(ks[13], (DEPTH, N_EXPERTS, D_MODEL, 2 * D_EXPERT)) * D_MODEL ** -0.5,
        'b_gu': 0.01 * nrm(ks[14], (DEPTH, N_EXPERTS, 2 * D_EXPERT)),
        'w_down': nrm(ks[15], (DEPTH, N_EXPERTS, D_EXPERT, D_MODEL)) * D_EXPERT ** -0.5 * DEEPNORM_BETA,
        'b_down': 0.01 * nrm(ks[16], (DEPTH, N_EXPERTS, D_MODEL)),
        'ln2_g': 1.0 + 0.02 * nrm(ks[17], (DEPTH, D_MODEL)),
        'ln2_b': 0.02 * nrm(ks[18], (DEPTH, D_MODEL)),
    }


def reference(x, w_in, b_fox_f, hgrn_lb_logits, hgrn_norm_g, w_branch_a, w_branch_b, w_branch_c,
              w_out, ln1_g, ln1_b, w_router, b_router, w_gu, b_gu, w_down, b_down, ln2_g, ln2_b):
    p = jax.nn.softmax(hgrn_lb_logits.astype(jnp.float32), axis=0)
    lbs = jnp.cumsum(p, axis=0)
    lbs = lbs - lbs[0]
    for l in range(DEPTH):
        mix = token_mixers(x, w_in[l], b_fox_f[l], lbs[l], hgrn_norm_g[l],
                           w_branch_a[l], w_branch_b[l], w_branch_c[l], w_out[l])
        x = layer_norm(DEEPNORM_ALPHA * x + mix, ln1_g[l], ln1_b[l])
        ffn = moe_ffn(x, w_router[l], b_router[l], w_gu[l], b_gu[l], w_down[l], b_down[l])
        x = layer_norm(DEEPNORM_ALPHA * x + ffn, ln2_g[l], ln2_b[l])
    return x
```

```cpp
#include <hip/hip_runtime.h>
#include <cstdio>
#include <cstdint>

#define GAS __attribute__((address_space(1)))
#define LAS __attribute__((address_space(3)))
typedef unsigned short bf16;
typedef short bf16x8 __attribute__((ext_vector_type(8)));
typedef short s16x4 __attribute__((ext_vector_type(4)));
typedef float f32x2 __attribute__((ext_vector_type(2)));
typedef float f32x4 __attribute__((ext_vector_type(4)));
typedef float f32x16 __attribute__((ext_vector_type(16)));
typedef unsigned u32x2 __attribute__((ext_vector_type(2)));
typedef unsigned u32x4 __attribute__((ext_vector_type(4)));
typedef unsigned long long u64;

__device__ __forceinline__ unsigned f2bf(float f) { unsigned u = __builtin_bit_cast(unsigned, f); return (u + 0x7fffu + ((u >> 16) & 1u)) >> 16; }
__device__ __forceinline__ unsigned pk2(float lo, float hi) { return f2bf(lo) | (f2bf(hi) << 16); }
__device__ __forceinline__ float bf2f(unsigned b) { return __builtin_bit_cast(float, b << 16); }
__device__ __forceinline__ float bflo(unsigned w) { return __builtin_bit_cast(float, w << 16); }
__device__ __forceinline__ float bfhi(unsigned w) { return __builtin_bit_cast(float, w & 0xffff0000u); }
__device__ __forceinline__ float sigmoidf_(float x) { return 1.0f / (1.0f + __expf(-x)); }

namespace pg8 {
#define PG8_LAS __attribute__((address_space(3)))
typedef unsigned short bf16_t;
typedef short bf16x8 __attribute__((ext_vector_type(8)));
typedef float f32x4 __attribute__((ext_vector_type(4)));
typedef unsigned u32x4 __attribute__((ext_vector_type(4)));
constexpr int BM = 256, BK = 64, HALF = 128, HTB = HALF * BK * 2  , STAGE_BYTES = 8 * HTB, NXCD = 8, WGM = 8;

__host__ __device__ __forceinline__ int lds_byte(int r, int c) { const int st = (r >> 4) * 2 + (c >> 5), rr = r & 15, cc = c & 31, ob = rr * 64 + cc * 2; return st * 1024 + (ob ^ (((ob >> 9) & 1) << 5)); }
__host__ __device__ __forceinline__ void stage_rc(int b, int& R, int& C) { const int st = b / 1024, sb = b % 1024, swz = sb ^ (((sb >> 9) & 1) << 5); R = (st >> 1) * 16 + swz / 64; C = (st & 1) * 32 + (swz % 64) / 2; }
__host__ __device__ __forceinline__ int perm32(int rho) { const int n = rho >> 4, i = rho & 15; return 8 * (i >> 2) + 4 * n + (i & 3); }

struct Unit { int pm, pn; };
struct Gemm { const bf16_t* A; const bf16_t* Bt; int M, N, K; };

struct StaticOrder {
    static constexpr bool GATHER = false; const int* tok = nullptr;
    int nM, nN, nwg, G, c;
    __host__ __device__ void init(int M, int N, int G_, int c_) { nM = M / BM; nN = N / BM; nwg = nM * nN; G = G_; c = c_; }
    __host__ __device__ bool next(int i, Unit& u) const {
        const long L = (long)i * G + c; if (L >= nwg) return false;
        int wgid = (int)L; { const int q = nwg / NXCD, r = nwg % NXCD, xcd = wgid % NXCD, off = wgid / NXCD; wgid = (xcd < r ? xcd * (q + 1) : r * (q + 1) + (xcd - r) * q) + off; }
        const int nig = WGM * nN, gid = wgid / nig, fm = gid * WGM, gsz = (nM - fm) < WGM ? (nM - fm) : WGM;
        u.pm = fm + ((wgid % nig) % gsz); u.pn = (wgid % nig) / gsz; return true;
    }
    __device__ __forceinline__ void a_ready(const Unit&) const {}
    __device__ __forceinline__ void done(const Unit&) const {}
};
template <bool GATHER_> struct MoeOrderT {
    static constexpr bool GATHER = GATHER_;
    const PG8_LAS int* list; const int* tok;
    __device__ bool next(int i, Unit& u) const {
        if (i >= __builtin_amdgcn_readfirstlane(list[0])) return false;
        u.pm = __builtin_amdgcn_readfirstlane(list[2 + 2 * i]); u.pn = __builtin_amdgcn_readfirstlane(list[3 + 2 * i]); return true;
    }
    __device__ __forceinline__ void a_ready(const Unit&) const {}
    __device__ __forceinline__ void done(const Unit&) const {}
};
typedef MoeOrderT<false> MoeOrder; typedef MoeOrderT<true> MoeOrderG;
__device__ __forceinline__ void moe_build_list(PG8_LAS int* list, const int* blk, int nN, int G, int c, int tid) {
    if (tid == 0) { const int* bst = blk + 16 + 544 + 16; int n = 0;
        if (G % 8 == 0) { const int W = G / 8, j = c / 8, x = c % 8;
            for (int i = 0; i < 64; ++i) { const int uu = i * W + j; const int bi = uu / nN, pl = uu - bi * nN; int rem = bi; bool ok = false;
                for (int k = 0; k < 4 && !ok; ++k) { const int e = x + 8 * k; const int b0 = bst[e], b1 = bst[e + 1]; if (rem < b1 - b0) { list[2 + 2 * n] = b0 + rem; list[3 + 2 * n] = e * nN + pl; ++n; ok = true; } else rem -= b1 - b0; }
                if (!ok) break; }
        } else { const int nb = bst[32];
            for (int i = 0; i < 64; ++i) { const int uu = i * G + c; const int bi = uu / nN, pl = uu - bi * nN; if (bi >= nb) break; int e = 0; for (int k = 1; k < 32; ++k) if (bi >= bst[k]) e = k; list[2 + 2 * n] = bi; list[3 + 2 * n] = e * nN + pl; ++n; } }
        list[0] = n; }
    asm volatile("s_waitcnt lgkmcnt(0)\n\ts_barrier" ::: "memory");
}

__device__ __forceinline__ unsigned cvt_pk_bf16(float lo, float hi) { unsigned r; asm volatile("v_cvt_pk_bf16_f32 %0, %1, %2" : "=v"(r) : "v"(lo), "v"(hi)); return r; }

struct EpiZ {
    static constexpr bool PERM = true, AFTER_DRAIN = false, MIDK = false;
    bf16_t* O; int ldc; const float* trig;
    __device__ __forceinline__ void operator()(const f32x4 (&acc)[2][2][4][2], const Unit& u, int wr, int wc, int fr, int fq) const {
        asm volatile("" : "+v"(fr), "+v"(fq));
        const int row0 = u.pm * BM + wr * 64 + fr; const int col0 = u.pn * BM + wc * 32 + 8 * fq;
        const bool rot_all = (u.pn < 4) || (u.pn == 32); const bool rot_b0 = rot_all || (u.pn == 33 && wc < 2);
        const int i0 = (wc & 1) * 16 + 4 * fq;
#pragma unroll
        for (int ai = 0; ai < 2; ++ai)
#pragma unroll
            for (int m = 0; m < 4; ++m) { const int row = row0 + ai * HALF + m * 16; bf16_t* rowp = O + (size_t)row * ldc + col0;
                f32x4 ca = {1.f, 0.f, 1.f, 0.f}, cb = {1.f, 0.f, 1.f, 0.f};
                if (rot_b0) { const float* tp = trig + ((size_t)(row & 8191) * 32 + i0) * 2; ca = *(const f32x4*)tp; cb = *(const f32x4*)(tp + 4); }
#pragma unroll
                for (int bj = 0; bj < 2; ++bj) { f32x4 v0 = acc[ai][bj][m][0], v1 = acc[ai][bj][m][1];
                    if (bj == 0 ? rot_b0 : rot_all) {
                        const f32x4 r0 = {v0[0] * ca[0] - v0[1] * ca[1], v0[1] * ca[0] + v0[0] * ca[1], v0[2] * ca[2] - v0[3] * ca[3], v0[3] * ca[2] + v0[2] * ca[3]};
                        const f32x4 r1 = {v1[0] * cb[0] - v1[1] * cb[1], v1[1] * cb[0] + v1[0] * cb[1], v1[2] * cb[2] - v1[3] * cb[3], v1[3] * cb[2] + v1[2] * cb[3]};
                        v0 = r0; v1 = r1; }
                    u32x4 w; w.x = cvt_pk_bf16(v0[0], v0[1]); w.y = cvt_pk_bf16(v0[2], v0[3]); w.z = cvt_pk_bf16(v1[0], v1[1]); w.w = cvt_pk_bf16(v1[2], v1[3]);
                    *(u32x4*)(rowp + bj * HALF) = w; } }
    }
};
struct EpiF32 {
    static constexpr bool PERM = true, AFTER_DRAIN = false, MIDK = false;
    float* O; int ldc;
    __device__ __forceinline__ void operator()(const f32x4 (&acc)[2][2][4][2], const Unit& u, int wr, int wc, int fr, int fq) const {
        asm volatile("" : "+v"(fr), "+v"(fq));
        const int row0 = u.pm * BM + wr * 64 + fr; const int col0 = u.pn * BM + wc * 32 + 8 * fq;
#pragma unroll
        for (int ai = 0; ai < 2; ++ai)
#pragma unroll
            for (int m = 0; m < 4; ++m) { float* rowp = O + (size_t)(row0 + ai * HALF + m * 16) * ldc + col0;
#pragma unroll
                for (int bj = 0; bj < 2; ++bj) { *(f32x4*)(rowp + bj * HALF) = acc[ai][bj][m][0]; *(f32x4*)(rowp + bj * HALF + 4) = acc[ai][bj][m][1]; } }
    }
};
struct EpiMerge {
    static constexpr bool PERM = true, AFTER_DRAIN = false, MIDK = true;
    const bf16_t* Gz; int gp; bf16_t* O; int ldc;
    __device__ __forceinline__ void scale(f32x4 (&acc)[2][2][4][2], const Unit& u, int idx, int wr, int wc, int fr, int fq) const {
        asm volatile("" : "+v"(fr), "+v"(fq));
        const int row0 = u.pm * BM + wr * 64 + fr; const int col0 = u.pn * BM + wc * 32 + 8 * fq;
        const int pa = (idx == 2) ? 2048 : (idx == 1) ? 2048 : 1024, pb = (idx == 1) ? 1024 : 0;
#pragma unroll
        for (int ai = 0; ai < 2; ++ai)
#pragma unroll
            for (int m = 0; m < 4; ++m) { const bf16_t* rowp = Gz + (size_t)(row0 + ai * HALF + m * 16) * gp + col0;
#pragma unroll
                for (int bj = 0; bj < 2; ++bj) { const u32x4 wa = *(const u32x4*)(rowp + pa + bj * HALF); u32x4 wb = wa; if (idx != 2) wb = *(const u32x4*)(rowp + pb + bj * HALF);
                    float s[8];
#pragma unroll
                    for (int i = 0; i < 4; ++i) { const float ea0 = __expf(-bflo(wa[i])), ea1 = __expf(-bfhi(wa[i]));
                        if (idx == 2) { s[2 * i] = __builtin_amdgcn_rcpf(1.f + ea0); s[2 * i + 1] = __builtin_amdgcn_rcpf(1.f + ea1); }
                        else { const float eb0 = __expf(-bflo(wb[i])), eb1 = __expf(-bfhi(wb[i])); s[2 * i] = (1.f + ea0) * __builtin_amdgcn_rcpf(1.f + eb0); s[2 * i + 1] = (1.f + ea1) * __builtin_amdgcn_rcpf(1.f + eb1); } }
                    acc[ai][bj][m][0] = acc[ai][bj][m][0] * (f32x4){s[0], s[1], s[2], s[3]}; acc[ai][bj][m][1] = acc[ai][bj][m][1] * (f32x4){s[4], s[5], s[6], s[7]}; }
                asm volatile("" ::: "memory"); }
    }
    __device__ __forceinline__ void mid(f32x4 (&acc)[2][2][4][2], const Unit& u, int idx, int wr, int wc, int fr, int fq) const { scale(acc, u, idx, wr, wc, fr, fq); }
    __device__ __forceinline__ void operator()(f32x4 (&acc)[2][2][4][2], const Unit& u, int wr, int wc, int fr, int fq) const {
        scale(acc, u, 2, wr, wc, fr, fq);
        asm volatile("" : "+v"(fr), "+v"(fq));
        const int row0 = u.pm * BM + wr * 64 + fr; const int col0 = u.pn * BM + wc * 32 + 8 * fq;
#pragma unroll
        for (int ai = 0; ai < 2; ++ai)
#pragma unroll
            for (int m = 0; m < 4; ++m) { bf16_t* rowp = O + (size_t)(row0 + ai * HALF + m * 16) * ldc + col0;
#pragma unroll
                for (int bj = 0; bj < 2; ++bj) { const f32x4 v0 = acc[ai][bj][m][0], v1 = acc[ai][bj][m][1];
                    u32x4 w; w.x = cvt_pk_bf16(v0[0], v0[1]); w.y = cvt_pk_bf16(v0[2], v0[3]); w.z = cvt_pk_bf16(v1[0], v1[1]); w.w = cvt_pk_bf16(v1[2], v1[3]);
                    *(u32x4*)(rowp + bj * HALF) = w; } }
    }
};
struct EpiSwiGLU {
    static constexpr bool PERM = true, AFTER_DRAIN = false, MIDK = false;
    bf16_t* O; const float* bias; int nN;
    __device__ __forceinline__ void operator()(const f32x4 (&acc)[2][2][4][2], const Unit& u, int wr, int wc, int fr, int fq) const {
        const int e = u.pn / nN, pl = u.pn - e * nN;
        asm volatile("" : "+v"(fr), "+v"(fq));
        const int row0 = u.pm * BM + wr * 64 + fr; const int colt = pl * BM + wc * 32 + 8 * fq;
        const float* bp = bias + (size_t)e * 2048 + colt;
        f32x4 bv[2][2];
#pragma unroll
        for (int bj = 0; bj < 2; ++bj) { bv[bj][0] = *(const f32x4*)(bp + bj * HALF); bv[bj][1] = *(const f32x4*)(bp + bj * HALF + 4); }
#pragma unroll
        for (int ai = 0; ai < 2; ++ai)
#pragma unroll
            for (int m = 0; m < 4; ++m) { unsigned char* rowp = (unsigned char*)O + (size_t)(row0 + ai * HALF + m * 16) * 1024 + (colt >> 1);
#pragma unroll
                for (int bj = 0; bj < 2; ++bj) { const f32x4 v0 = acc[ai][bj][m][0] + bv[bj][0], v1 = acc[ai][bj][m][1] + bv[bj][1];
                    float a[4];
                    const float gt[4] = {v0[0], v0[2], v1[0], v1[2]}, up[4] = {v0[1], v0[3], v1[1], v1[3]};
#pragma unroll
                    for (int i = 0; i < 4; ++i) { const float g = fminf(gt[i], 7.0f); const float uu = fminf(fmaxf(up[i], -7.0f), 7.0f);
                        a[i] = g * (1.0f / (1.0f + __expf(-1.702f * g))) * (uu + 1.0f); }
                    int w8 = __builtin_amdgcn_cvt_pk_fp8_f32(a[0], a[1], 0, false); w8 = __builtin_amdgcn_cvt_pk_fp8_f32(a[2], a[3], w8, true);
                    *(unsigned*)(rowp + bj * (HALF / 2)) = (unsigned)w8; } }
    }
};
struct EpiDown {
    static constexpr bool PERM = true, AFTER_DRAIN = false, MIDK = false;
    bf16_t* O; const float* bias; const float* gate; int nN;
    __device__ __forceinline__ void operator()(const f32x4 (&acc)[2][2][4][2], const Unit& u, int wr, int wc, int fr, int fq) const {
        const int e = u.pn / nN, pl = u.pn - e * nN;
        asm volatile("" : "+v"(fr), "+v"(fq));
        const int row0 = u.pm * BM + wr * 64 + fr; const int colt = pl * BM + wc * 32 + 8 * fq;
        const float* bp = bias + (size_t)e * 1024 + colt;
        f32x4 bv[2][2];
#pragma unroll
        for (int bj = 0; bj < 2; ++bj) { bv[bj][0] = *(const f32x4*)(bp + bj * HALF); bv[bj][1] = *(const f32x4*)(bp + bj * HALF + 4); }
#pragma unroll
        for (int ai = 0; ai < 2; ++ai)
#pragma unroll
            for (int m = 0; m < 4; ++m) { const int row = row0 + ai * HALF + m * 16; const float gs = gate[row]; bf16_t* rowp = O + (size_t)row * 1024 + colt;
#pragma unroll
                for (int bj = 0; bj < 2; ++bj) { const f32x4 v0 = (acc[ai][bj][m][0] + bv[bj][0]) * gs, v1 = (acc[ai][bj][m][1] + bv[bj][1]) * gs;
                    u32x4 w; w.x = cvt_pk_bf16(v0[0], v0[1]); w.y = cvt_pk_bf16(v0[2], v0[3]); w.z = cvt_pk_bf16(v1[0], v1[1]); w.w = cvt_pk_bf16(v1[2], v1[3]);
                    *(u32x4*)(rowp + bj * HALF) = w; } }
    }
};

template <class Epi, class Sched, bool ALIGN_EPI = false, bool SP2 = false, bool FP8 = false, int SCALE_B = 127>
__device__ __forceinline__ void gemm_phase(PG8_LAS unsigned char* lds, const Gemm g, const Sched& S, const Epi& E, int wv) {
    int tid_l = (int)__builtin_amdgcn_mbcnt_hi(~0u, __builtin_amdgcn_mbcnt_lo(~0u, 0u)); asm volatile("" : "+v"(tid_l)); tid_l += wv * 64;
    const int tid = tid_l, wid = __builtin_amdgcn_readfirstlane(tid >> 6), lane = tid & 63, wr = wid >> 2, wc = wid & 3, fr = lane & 15, fq = lane >> 4;
    const int K = g.K; const int KB = FP8 ? K : 2 * K;
    const int nt = KB / (2 * BK);
    unsigned voffA[2], voffB[2];
#pragma unroll
    for (int i = 0; i < 2; ++i) { int R, C; stage_rc(tid * 16 + i * 8192, R, C); const int Rb = Epi::PERM ? ((R & ~31) + perm32(R & 31)) : R;
        voffA[i] = (unsigned)(R * KB + 2 * C); voffB[i] = (unsigned)(Rb * KB + 2 * C); }
    unsigned voGc[2][2]; PG8_LAS unsigned* voGn_l = (PG8_LAS unsigned*)(lds + STAGE_BYTES + 1024) + tid;
#define PG8_GOFF(dst, pmv) do { if constexpr (Sched::GATHER) { _Pragma("unroll") for (int _h = 0; _h < 2; ++_h) _Pragma("unroll") for (int _i = 0; _i < 2; ++_i) { \
        const unsigned _R = voffA[_i] / (unsigned)KB, _cb = voffA[_i] % (unsigned)KB; dst[_h][_i] = (unsigned)S.tok[(pmv) * BM + _h * HALF + (int)_R] * (unsigned)KB + _cb; } } } while (0)
    const size_t kstep = (size_t)(BK * 2);
    const size_t hstep = (size_t)HALF * KB;
    const size_t tstep = 2 * hstep;
    const unsigned ldsw = (unsigned)wid * 1024u;
    const int aoff = lds_byte(wr * 64 + fr, FP8 ? fq * 16 : fq * 8), boff = lds_byte(wc * 32 + fr, FP8 ? fq * 16 : fq * 8);
    const int aoff1 = FP8 ? lds_byte(wr * 64 + fr, fq * 16 + 8) - aoff : 1024, boff1 = FP8 ? lds_byte(wc * 32 + fr, fq * 16 + 8) - boff : 1024;
#define PG8_SA(b, h) (((b) * 2 + (h)) * HTB)
#define PG8_SB(b, h) ((4 + (b) * 2 + (h)) * HTB)
#define PG8_STAGE(bufoff, gbase, voff) do { _Pragma("unroll") for (int _i = 0; _i < 2; ++_i) \
        __builtin_amdgcn_global_load_lds((const unsigned*)((const char*)(gbase) + (voff)[_i]), (PG8_LAS unsigned*)(lds + (bufoff) + ldsw + _i * 8192), 16, 0, 0); } while (0)
#define PG8_STAGE_A(bufoff, base, h, nx) do { if constexpr (Sched::GATHER) { unsigned _vo[2] = {voGc[h][0], voGc[h][1]}; if (nx) { _vo[0] = voGn_l[((h) * 2 + 0) * 512]; _vo[1] = voGn_l[((h) * 2 + 1) * 512]; } PG8_STAGE(bufoff, base, _vo); } else { PG8_STAGE(bufoff, (base) + (h) * hstep, voffA); } } while (0)
#define PG8_LD8(dst8, n_, base_, off_, off1_) do { _Pragma("unroll") for (int q_ = 0; q_ < n_; ++q_) { const v4i_ lo_ = *(const PG8_LAS v4i_*)(lds + (base_) + (off_) + q_ * 2048), hi_ = *(const PG8_LAS v4i_*)(lds + (base_) + (off_) + q_ * 2048 + (off1_)); \
        dst8[q_] = __builtin_shufflevector(lo_, hi_, 0, 1, 2, 3, 4, 5, 6, 7); } } while (0)
#define PG8_LDA(dst, b, h) do { if constexpr (FP8) { PG8_LD8(dst##8, 4, PG8_SA(b, h), aoff, aoff1); } else { _Pragma("unroll") for (int m = 0; m < 4; ++m) _Pragma("unroll") for (int k = 0; k < 2; ++k) dst[m][k] = *(const PG8_LAS bf16x8*)(lds + PG8_SA(b, h) + aoff + m * 2048 + k * aoff1); } } while (0)
#define PG8_LDB(dst, b, h) do { if constexpr (FP8) { PG8_LD8(dst##8, 2, PG8_SB(b, h), boff, boff1); } else { _Pragma("unroll") for (int n = 0; n < 2; ++n) _Pragma("unroll") for (int k = 0; k < 2; ++k) dst[n][k] = *(const PG8_LAS bf16x8*)(lds + PG8_SB(b, h) + boff + n * 2048 + k * boff1); } } while (0)
#define PG8_MMA(ai, bj, At, Bt) do { if constexpr (FP8) __builtin_amdgcn_sched_barrier(0); __builtin_amdgcn_s_setprio(1); _Pragma("unroll") for (int m = 0; m < 4; ++m) _Pragma("unroll") for (int n = 0; n < 2; ++n) { \
        if constexpr (FP8) { asm volatile("v_mfma_scale_f32_16x16x128_f8f6f4 %0, %1, %2, %0, %3, %4 op_sel_hi:[0,0,0]" : "+v"(acc[ai][bj][m][n]) : "v"(Bt##8[n]), "v"(At##8[m]), "v"(sclB), "v"(sclA)); } \
        else { _Pragma("unroll") for (int k = 0; k < 2; ++k) acc[ai][bj][m][n] = __builtin_amdgcn_mfma_f32_16x16x32_bf16(Bt[n][k], At[m][k], acc[ai][bj][m][n], 0, 0, 0); } } \
        __builtin_amdgcn_s_setprio(0); if constexpr (FP8) __builtin_amdgcn_sched_barrier(0); } while (0)
#define PG8_WAIT_V(n) asm volatile("s_waitcnt vmcnt(" #n ")" ::: "memory")
#define PG8_WAIT_L(n) asm volatile("s_waitcnt lgkmcnt(" #n ")" ::: "memory")
#define PG8_BAR __builtin_amdgcn_s_barrier()
#define PG8_SCHED __builtin_amdgcn_sched_barrier(0)
    Unit cur, nxt; int ui = 0;
    if (!S.next(0, cur)) return;
    f32x4 acc[2][2][4][2];
#pragma unroll
    for (int a = 0; a < 2; ++a)
#pragma unroll
        for (int b = 0; b < 2; ++b)
#pragma unroll
            for (int m = 0; m < 4; ++m)
#pragma unroll
                for (int n = 0; n < 2; ++n) acc[a][b][m][n] = (f32x4){0.f, 0.f, 0.f, 0.f};
    bf16x8 At[4][2], B0[2][2], B1[2][2];
    typedef int v8i_ __attribute__((ext_vector_type(8))); typedef int v4i_ __attribute__((ext_vector_type(4)));
    int sclB = SCALE_B * 0x01010101, sclA = 0x7f7f7f7f; asm volatile("" : "+v"(sclB), "+v"(sclA));
    v8i_ At8[4], B08[2], B18[2];
    const char* cA = (const char*)g.A + (Sched::GATHER ? (size_t)0 : (size_t)cur.pm * tstep); const char* cB = (const char*)g.Bt + (size_t)cur.pn * tstep;
    PG8_GOFF(voGc, cur.pm);
    S.a_ready(cur);
    if constexpr (SP2) {
        PG8_STAGE(PG8_SB(0, 0), cB, voffB); PG8_STAGE(PG8_SB(0, 1), cB + hstep, voffB); PG8_STAGE_A(PG8_SA(0, 0), cA, 0, false); PG8_STAGE_A(PG8_SA(0, 1), cA, 1, false);
        if (wr == 1) PG8_BAR;
        PG8_WAIT_V(2); PG8_BAR;
        PG8_STAGE(PG8_SB(1, 0), cB + kstep, voffB); PG8_STAGE_A(PG8_SA(1, 0), cA + kstep, 0, false); PG8_STAGE(PG8_SB(1, 1), cB + hstep + kstep, voffB);
        PG8_WAIT_V(6); PG8_BAR;
    } else {
        PG8_STAGE(PG8_SB(0, 0), cB, voffB); PG8_STAGE_A(PG8_SA(0, 0), cA, 0, false); PG8_STAGE(PG8_SB(0, 1), cB + hstep, voffB); PG8_STAGE_A(PG8_SA(0, 1), cA, 1, false);
        if (wr == 1) PG8_BAR;
        PG8_WAIT_V(4); PG8_BAR;
        PG8_STAGE(PG8_SB(1, 0), cB + kstep, voffB); PG8_STAGE_A(PG8_SA(1, 0), cA + kstep, 0, false); PG8_STAGE(PG8_SB(1, 1), cB + hstep + kstep, voffB);
        PG8_WAIT_V(6); PG8_BAR;
    }
    for (;;) {
        const bool has_next = S.next(ui + 1, nxt);
        const char* nA = has_next ? (const char*)g.A + (Sched::GATHER ? (size_t)0 : (size_t)nxt.pm * tstep) : cA;
        if constexpr (Sched::GATHER) { unsigned _vn[2][2]; if (has_next) { PG8_GOFF(_vn, nxt.pm); } else { _Pragma("unroll") for (int _h = 0; _h < 2; ++_h) _Pragma("unroll") for (int _i = 0; _i < 2; ++_i) _vn[_h][_i] = voGc[_h][_i]; }
            _Pragma("unroll") for (int _h = 0; _h < 2; ++_h) _Pragma("unroll") for (int _i = 0; _i < 2; ++_i) voGn_l[(_h * 2 + _i) * 512] = _vn[_h][_i]; } const char* nB = has_next ? (const char*)g.Bt + (size_t)nxt.pn * tstep : cB;
        for (int t = 0; t < nt; t += 2) {
            const bool last = (t == nt - 2);
            const char* a1 = cA + (size_t)(t + 1) * kstep;
            const char* a2 = last ? nA : cA + (size_t)(t + 2) * kstep; const char* b2 = last ? nB : cB + (size_t)(t + 2) * kstep;
            const char* a3 = a2 + kstep; const char* b3 = b2 + kstep;
            if (last && has_next) S.a_ready(nxt);
            if constexpr (SP2) {
            PG8_LDB(B0, 0, 0); PG8_LDB(B1, 0, 1); PG8_SCHED; PG8_LDA(At, 0, 0); PG8_STAGE_A(PG8_SA(1, 1), a1, 1, false);
            PG8_WAIT_V(8); PG8_WAIT_L(0); PG8_BAR; PG8_MMA(0, 0, At, B0); PG8_MMA(0, 1, At, B1); PG8_BAR; PG8_SCHED;
            PG8_LDA(At, 0, 1); PG8_STAGE(PG8_SB(0, 0), b2, voffB); PG8_STAGE(PG8_SB(0, 1), b2 + hstep, voffB); PG8_STAGE_A(PG8_SA(0, 0), a2, 0, last);
            PG8_WAIT_V(8); PG8_WAIT_L(0); PG8_BAR; PG8_MMA(1, 0, At, B0); PG8_MMA(1, 1, At, B1); PG8_BAR; PG8_SCHED;
            PG8_LDB(B0, 1, 0); PG8_LDB(B1, 1, 1); PG8_SCHED; PG8_LDA(At, 1, 0); PG8_STAGE_A(PG8_SA(0, 1), a2, 1, last);
            PG8_WAIT_V(8); PG8_WAIT_L(0); PG8_BAR; PG8_MMA(0, 0, At, B0); PG8_MMA(0, 1, At, B1); PG8_BAR; PG8_SCHED;
            PG8_LDA(At, 1, 1); PG8_STAGE(PG8_SB(1, 0), b3, voffB); PG8_STAGE(PG8_SB(1, 1), b3 + hstep, voffB); PG8_STAGE_A(PG8_SA(1, 0), a3, 0, last);
            PG8_WAIT_V(8); PG8_WAIT_L(0); PG8_BAR; PG8_MMA(1, 0, At, B0); PG8_MMA(1, 1, At, B1); PG8_BAR; PG8_SCHED;
            } else {
            PG8_LDB(B0, 0, 0); PG8_SCHED; PG8_LDA(At, 0, 0); PG8_STAGE_A(PG8_SA(1, 1), a1, 1, false);
            PG8_WAIT_L(8); PG8_BAR; PG8_WAIT_L(0); PG8_MMA(0, 0, At, B0); PG8_BAR; PG8_SCHED;
            PG8_LDB(B1, 0, 1); PG8_STAGE(PG8_SB(0, 0), b2, voffB);
            PG8_BAR; PG8_WAIT_L(0); PG8_MMA(0, 1, At, B1); PG8_BAR;
            PG8_LDA(At, 0, 1); PG8_STAGE_A(PG8_SA(0, 0), a2, 0, last);
            PG8_BAR; PG8_WAIT_L(0); PG8_MMA(1, 0, At, B0); PG8_BAR; PG8_SCHED;
            PG8_STAGE(PG8_SB(0, 1), b2 + hstep, voffB);
            PG8_WAIT_V(6); PG8_BAR; PG8_MMA(1, 1, At, B1); PG8_BAR;
            PG8_LDB(B0, 1, 0); PG8_SCHED; PG8_LDA(At, 1, 0); PG8_STAGE_A(PG8_SA(0, 1), a2, 1, last);
            PG8_WAIT_L(8); PG8_BAR; PG8_WAIT_L(0); PG8_MMA(0, 0, At, B0); PG8_BAR; PG8_SCHED;
            PG8_LDB(B1, 1, 1); PG8_STAGE(PG8_SB(1, 0), b3, voffB);
            PG8_BAR; PG8_WAIT_L(0); PG8_MMA(0, 1, At, B1); PG8_BAR;
            PG8_LDA(At, 1, 1); PG8_STAGE_A(PG8_SA(1, 0), a3, 0, last);
            PG8_BAR; PG8_WAIT_L(0); PG8_MMA(1, 0, At, B0); PG8_BAR; PG8_SCHED;
            PG8_STAGE(PG8_SB(1, 1), b3 + hstep, voffB);
            PG8_WAIT_V(6); PG8_BAR; PG8_MMA(1, 1, At, B1); PG8_BAR;
            }
            if constexpr (Epi::MIDK) { if (((t + 2) & 7) == 0 && t + 2 < nt) E.mid(acc, cur, ((t + 2) >> 3) - 1, wr, wc, fr, fq); }
        }
        if constexpr (FP8) asm volatile("s_nop 15\n\ts_nop 15" ::: "memory");
        if constexpr (ALIGN_EPI) { if (wr == 0) PG8_BAR; }
        if constexpr (!Epi::AFTER_DRAIN) { E(acc, cur, wr, wc, fr, fq); S.done(cur); }
        if (!has_next) break;
#pragma unroll
        for (int a = 0; a < 2; ++a)
#pragma unroll
            for (int b = 0; b < 2; ++b)
#pragma unroll
                for (int m = 0; m < 4; ++m)
#pragma unroll
                    for (int n = 0; n < 2; ++n) acc[a][b][m][n] = (f32x4){0.f, 0.f, 0.f, 0.f};
        cur = nxt; cA = nA; cB = nB; ++ui;
        if constexpr (Sched::GATHER) { _Pragma("unroll") for (int _h = 0; _h < 2; ++_h) _Pragma("unroll") for (int _i = 0; _i < 2; ++_i) voGc[_h][_i] = voGn_l[(_h * 2 + _i) * 512]; }
        if constexpr (ALIGN_EPI) { if (wr == 1) PG8_BAR; }
    }
    PG8_WAIT_V(0);
    if constexpr (!ALIGN_EPI) { if (wr == 0) PG8_BAR; }
    PG8_BAR;
#undef PG8_SA
#undef PG8_SB
#undef PG8_STAGE
#undef PG8_STAGE_A
#undef PG8_GOFF
#undef PG8_LDA
#undef PG8_LD8
#undef PG8_LDB
#undef PG8_MMA
#undef PG8_WAIT_V
#undef PG8_WAIT_L
#undef PG8_BAR
#undef PG8_SCHED
}
}
constexpr int BATCH = 4, SEQ = 8192, DM = 1024, NTOK = BATCH * SEQ, DEPTH = 2, NEXP = 32;
constexpr int D_IN = 8524, ZP = 8704;
constexpr int Z_AQ = 0, Z_AK = 512, Z_AV = 1024, Z_FQ = 1536, Z_FK = 2048, Z_FV = 2560, Z_CQ = 3072, Z_CF = 3584, Z_CI = 4096, Z_CG = 4608, Z_GT = 5120, Z_IQ = 8192, Z_IK = 8448, Z_IW = 8512, Z_FF = 8516;
constexpr int OP = 1536;
constexpr int MAXBLK = 544, MAXSLOT = MAXBLK * 256;
constexpr int BST_OFF = 16 + MAXBLK + 16;
constexpr float LOG2E = 1.4426950408889634f;
constexpr float QSCALE = 0.125f * LOG2E;
constexpr float ALPHA = 1.4142135623730951f;
constexpr float LN_EPS = 1e-5f, RMS_EPS = 1e-6f;
constexpr int NWAVES = 8, NTHR = 512;
constexpr float W8_SCALE = 64.0f; constexpr int W8_E8M0 = 127 - 6;
constexpr int NPH_LAYER = 14, NPHASES = 1 + DEPTH * NPH_LAYER;
enum { PH_INPROJ = 0, PH_PREP, PH_IDX, PH_ATTN, PH_H1, PH_H2, PH_H3, PH_MERGE, PH_WOUT, PH_LN1, PH_SLOT, PH_GU, PH_DOWN, PH_COMB };

__host__ __device__ __forceinline__ int zcol_src(int n) {
    if (n < 1024 || (n >= 8192 && n < 8512)) { const int p = n & 63; n = (n & ~63) + ((p & 1) ? 32 + (p >> 1) : (p >> 1)); }
    if (n < 1536) return n;
    if (n < 3072) return 1860 + (n - 1536);
    if (n < 5120) return 3404 + (n - 3072);
    if (n < 8192) return 5452 + (n - 5120);
    if (n < 8448) return 1536 + (n - 8192);
    if (n < 8512) return 1792 + (n - 8448);
    if (n < 8516) return 1856 + (n - 8512);
    if (n < 8524) return 3396 + (n - 8516);
    return -1;
}

constexpr size_t MiB = 1u << 20;
constexpr size_t WS_CTL = 0, CTL_ZERO_BYTES = 1 * MiB;
constexpr size_t WS_TRIG = 1 * MiB;
constexpr size_t WS_LFT = 3 * MiB;
constexpr size_t WS_CT = 4 * MiB;
constexpr size_t WS_DG = 5 * MiB, WS_D2G = 6 * MiB;
constexpr size_t WS_WGCNT = 7 * MiB;
constexpr size_t WS_BLK = 7 * MiB + 64 * 1024;
constexpr size_t WS_BGU = 7 * MiB + 128 * 1024;
constexpr size_t WS_TKE = 8 * MiB, WS_TKG = 8 * MiB + 512 * 1024, WS_TOKSLOT = 9 * MiB, WS_GSLOT = 9 * MiB + 512 * 1024;
constexpr size_t WS_SLOTTOK = 10 * MiB + 512 * 1024;
constexpr size_t WS_WRF = 11 * MiB;
constexpr size_t WS_WIN = 12 * MiB;
constexpr size_t WS_WP = 46 * MiB;
constexpr size_t WS_WOUT = 52 * MiB;
constexpr size_t WS_WGU = 56 * MiB;
constexpr size_t WS_WDN = 312 * MiB;
constexpr size_t WS_Z = 440 * MiB;
constexpr size_t WS_XG = WS_Z, WS_ACT = WS_Z + 272 * MiB;
constexpr size_t WS_OBUF = 984 * MiB;
constexpr size_t WS_MERGED = 1080 * MiB;
constexpr size_t WS_MIX = 1144 * MiB;
constexpr size_t WS_Y = WS_OBUF;
constexpr size_t WS_X1 = 1272 * MiB;
constexpr size_t WS_X1B = 1400 * MiB;
constexpr size_t WS_XCUR = 1464 * MiB;
constexpr size_t WS_XB = 1592 * MiB;
constexpr size_t WS_MASKW = 1656 * MiB;
constexpr size_t WS_UG = 1688 * MiB;
constexpr size_t WS_SST = 1752 * MiB;
constexpr size_t WS_SB = 7 * MiB + 768 * 1024;
constexpr size_t WS_KA = 1784 * MiB;
constexpr size_t WS_END = 1792 * MiB;
static_assert(WS_Y + (size_t)MAXSLOT * 1024 * 2 <= WS_X1 && WS_ACT + (size_t)MAXSLOT * 1024 * 2 <= WS_OBUF, "ws map");
constexpr int CW_TMO = 0;
constexpr int CW_BAR = 4096;

constexpr int SCR_BYTES = 153600;
constexpr int MISC_OFF = SCR_BYTES;
constexpr int LDS_BYTES = SCR_BYTES + 256;

#define RLX_AGENT __ATOMIC_RELAXED, __HIP_MEMORY_SCOPE_AGENT
#define LDS_WAIT() asm volatile("s_waitcnt lgkmcnt(0)" ::: "memory")
#define VM_WAIT() asm volatile("s_waitcnt vmcnt(0)" ::: "memory")
#define WG_BAR() asm volatile("s_waitcnt vmcnt(0) lgkmcnt(0)\n\ts_barrier" ::: "memory")
#define WG_BAR_LDS() asm volatile("s_waitcnt lgkmcnt(0)\n\ts_barrier" ::: "memory")

#define XB_TMO      128
#define XB_XCNT(j)  (256  + 64 * (j))
#define XB_XSUB(j)  (1280 + 64 * (j))
#define XB_XGEN(j)  (2304 + 64 * (j))
#define XB_TOP      3328
#define XB_TOPGEN   3392
#define XCD_BAR_WORDS 3456
#define XB_SPIN_CAP (1u << 18)

__device__ __forceinline__ unsigned xb_ld(unsigned* p)              { return __hip_atomic_load(p, __ATOMIC_RELAXED, __HIP_MEMORY_SCOPE_AGENT); }
__device__ __forceinline__ unsigned xb_add(unsigned* p, unsigned v) { return __hip_atomic_fetch_add(p, v, __ATOMIC_RELAXED, __HIP_MEMORY_SCOPE_AGENT); }
__device__ __forceinline__ unsigned xb_xcc_id() { return (unsigned)__builtin_amdgcn_s_getreg((3 << 11) | 20) & 0xFu; }
#define XB_SPIN(cond, bar) do { unsigned _sp = 0; while (cond) { __builtin_amdgcn_s_sleep(1); \
    if ((++_sp & 255u) == 0u) { if (xb_ld(&(bar)[XB_TMO])) break; if (_sp > XB_SPIN_CAP) { atomicAdd(&(bar)[XB_TMO], 1u); break; } } } } while (0)

struct XcdBarrier {
    unsigned* bar; unsigned x;
    volatile LAS unsigned* st;
};

__device__ __forceinline__ XcdBarrier xcd_barrier_post(unsigned* bar, volatile LAS unsigned* st) {
    XcdBarrier b; b.bar = bar; b.x = xb_xcc_id(); b.st = st;
    if (threadIdx.x == 0) (void)xb_add(&bar[XB_XCNT(b.x)], 1u);
    return b;
}
__device__ __forceinline__ void xcd_barrier_complete(unsigned* bar, unsigned x, unsigned& nloc, unsigned& nx) {
    const unsigned G = gridDim.x * gridDim.y * gridDim.z;
    unsigned sum, cnt, mine, sp = 0u;
    for (;;) {
        sum = 0u; cnt = 0u; mine = 0u;
#pragma unroll
        for (unsigned j = 0; j < 16; ++j) { const unsigned c = xb_ld(&bar[XB_XCNT(j)]); sum += c; cnt += (c > 0u) ? 1u : 0u; mine = (j == x) ? c : mine; }
        if (sum == G) break;
        __builtin_amdgcn_s_sleep(1);
        if ((++sp & 255u) == 0u) { if (xb_ld(&bar[XB_TMO])) break; if (sp > XB_SPIN_CAP) { atomicAdd(&bar[XB_TMO], 1u); break; } }
    }
    nloc = mine > 0u ? mine : 1u; nx = cnt > 0u ? cnt : 1u;
}

__device__ __forceinline__ void xcd_barrier(const XcdBarrier& b) {
    asm volatile("s_waitcnt vmcnt(0)" ::: "memory");
    __syncthreads();
    if (threadIdx.x == 0) {
        unsigned* bar = b.bar;
        __builtin_amdgcn_s_waitcnt(0);
        unsigned nloc = b.st[0], nx = b.st[1];
        if (nloc == 0u) { xcd_barrier_complete(bar, b.x, nloc, nx); b.st[0] = nloc; b.st[1] = nx; }
        const unsigned old = xb_add(&bar[XB_XSUB(b.x)], 1u);
        const unsigned gen = old / nloc;
        if (old + 1u == (gen + 1u) * nloc) {
            __builtin_amdgcn_fence(__ATOMIC_RELEASE, "agent");
            asm volatile("s_waitcnt vmcnt(0)" ::: "memory");
            const unsigned og = xb_add(&bar[XB_TOP], 1u);
            const unsigned tg = og / nx;
            if (og + 1u == (tg + 1u) * nx) xb_add(&bar[XB_TOPGEN], 1u);
            else XB_SPIN(xb_ld(&bar[XB_TOPGEN]) == tg, bar);
            __builtin_amdgcn_fence(__ATOMIC_ACQUIRE, "agent");
            xb_add(&bar[XB_XGEN(b.x)], 1u);
            asm volatile("s_waitcnt vmcnt(0)" ::: "memory");
        } else {
            XB_SPIN(xb_ld(&bar[XB_XGEN(b.x)]) == gen, bar);
            __builtin_amdgcn_fence(__ATOMIC_ACQUIRE, "agent");
            asm volatile("s_waitcnt vmcnt(0)" ::: "memory");
        }
    }
    __syncthreads();
}
__device__ __forceinline__ int lane_id() { int l = (int)__builtin_amdgcn_mbcnt_hi(~0u, __builtin_amdgcn_mbcnt_lo(~0u, 0u)); asm volatile("" : "+v"(l)); return l; }
__device__ __forceinline__ float wave_sum(float v) {
#pragma unroll
    for (int o = 1; o < 64; o <<= 1) v += __shfl_xor(v, o);
    return v;
}
__device__ __forceinline__ int crow(int r, int hi) { return (r & 3) + 8 * (r >> 2) + 4 * hi; }
__device__ __forceinline__ void glds16(const void* gsrc, unsigned lds_dst) { unsigned keep;
    asm volatile("s_mov_b32 %0, m0\n\ts_mov_b32 m0, %2\n\ts_nop 0\n\tglobal_load_lds_dwordx4 %1, off\n\ts_mov_b32 m0, %0" : "=&s"(keep) : "v"(gsrc), "s"(lds_dst) : "memory"); }
__device__ __forceinline__ void glds4(const void* gsrc, unsigned lds_dst) { unsigned keep;
    asm volatile("s_mov_b32 %0, m0\n\ts_mov_b32 m0, %2\n\ts_nop 0\n\tglobal_load_lds_dword %1, off\n\ts_mov_b32 m0, %0" : "=&s"(keep) : "v"(gsrc), "s"(lds_dst) : "memory"); }
typedef __bf16 bf16x2_t __attribute__((ext_vector_type(2)));
__device__ __forceinline__ unsigned cvtpk(float lo, float hi) { const f32x2 v = {lo, hi}; const bf16x2_t b = __builtin_convertvector(v, bf16x2_t); return __builtin_bit_cast(unsigned, b); }
typedef short v4i16_t __attribute__((ext_vector_type(4)));
__device__ __forceinline__ s16x4 vtr(const LAS char* p) { return __builtin_bit_cast(s16x4, __builtin_amdgcn_ds_read_tr16_b64_v4i16((LAS v4i16_t*)p)); }
__device__ __forceinline__ void plswap(float& a, float& b) { asm volatile("s_nop 1\n\tv_permlane32_swap_b32 %0, %1\n\ts_nop 1" : "+v"(a), "+v"(b)); }
__device__ __forceinline__ float swapmax(float m) { float a = m, b = m; plswap(a, b); return fmaxf(a, b); }
__device__ __forceinline__ float swapsum(float m) { float a = m, b = m; plswap(a, b); return a + b; }
#define MFMA32(a, b, c) __builtin_amdgcn_mfma_f32_32x32x16_bf16((a), (b), (c), 0, 0, 0)

struct Params {
    const float* x; const float* w_in; const float* b_fox; const float* lb_logits; const float* norm_g; const float* w_pa; const float* w_pb; const float* w_pc; const float* w_out;
    const float* ln1_g; const float* ln1_b; const float* w_router; const float* b_router; const float* w_gu; const float* b_gu; const float* w_down; const float* b_down; const float* ln2_g; const float* ln2_b;
    float* out; unsigned char* ws; int ph_lo, ph_hi, use_bar, pad;
};

typedef const __attribute__((address_space(4))) Params* KP;
__device__ __forceinline__ KP load_params() { KP kp = (KP)__builtin_amdgcn_kernarg_segment_ptr(); asm volatile("" : "+s"(kp)); return kp; }

template <class F> __device__ __forceinline__ void cvt_tile(const float* W, size_t ldsrc, int k0, bf16* WT, size_t ldw, int kd0, int n0, const F& f, LAS float* scr, int lane) {
    const int c = lane & 31; int sc; float scale; f(n0 + c, sc, scale);
#pragma unroll 8
    for (int i = 0; i < 32; ++i) { const int kk = 2 * i + (lane >> 5); scr[kk * 33 + c] = sc >= 0 ? W[(size_t)(k0 + kk) * ldsrc + sc] * scale : 0.f; }
    LDS_WAIT(); asm volatile("" ::: "memory");
    const int ch = lane & 7;
#pragma unroll
    for (int j = 0; j < 4; ++j) { const int n = (lane >> 3) + 8 * j; const LAS float* s = scr + (8 * ch) * 33 + n;
        u32x4 o; o.x = pk2(s[0 * 33], s[1 * 33]); o.y = pk2(s[2 * 33], s[3 * 33]); o.z = pk2(s[4 * 33], s[5 * 33]); o.w = pk2(s[6 * 33], s[7 * 33]);
        *(u32x4*)(WT + (size_t)(n0 + n) * ldw + kd0 + 8 * ch) = o; }
    LDS_WAIT(); asm volatile("" ::: "memory");
}
template <class F> __device__ __forceinline__ void cvt_tile8(const float* W, size_t ldsrc, int k0, unsigned char* WT, size_t ldw, int n0, const F& f, float wscale, LAS float* scr, int lane) {
    const int c = lane & 31; int sc; float scale; f(n0 + c, sc, scale); scale *= wscale;
#pragma unroll 8
    for (int i = 0; i < 32; ++i) { const int kk = 2 * i + (lane >> 5); scr[kk * 33 + c] = sc >= 0 ? W[(size_t)(k0 + kk) * ldsrc + sc] * scale : 0.f; }
    LDS_WAIT(); asm volatile("" ::: "memory");
    const int ch = lane & 7;
#pragma unroll
    for (int j = 0; j < 4; ++j) { const int n = (lane >> 3) + 8 * j; const LAS float* s = scr + (8 * ch) * 33 + n;
        int w0 = __builtin_amdgcn_cvt_pk_fp8_f32(s[0 * 33], s[1 * 33], 0, false); w0 = __builtin_amdgcn_cvt_pk_fp8_f32(s[2 * 33], s[3 * 33], w0, true);
        int w1 = __builtin_amdgcn_cvt_pk_fp8_f32(s[4 * 33], s[5 * 33], 0, false); w1 = __builtin_amdgcn_cvt_pk_fp8_f32(s[6 * 33], s[7 * 33], w1, true);
        *(u32x2*)(WT + (size_t)(n0 + n) * ldw + k0 + 8 * ch) = (u32x2){(unsigned)w0, (unsigned)w1}; }
    LDS_WAIT(); asm volatile("" ::: "memory");
}
struct MapIn { __device__ __forceinline__ void operator()(int n, int& sc, float& s) const { sc = zcol_src(n); s = (n < 512 || (n >= Z_FQ && n < Z_FK)) ? QSCALE : 1.0f; } };
struct MapGu { __device__ __forceinline__ void operator()(int n, int& sc, float& s) const { sc = (n & 1) ? 1024 + (n >> 1) : (n >> 1); s = 1.0f; } };
struct MapId { __device__ __forceinline__ void operator()(int n, int& sc, float& s) const { sc = n; s = 1.0f; } };

__device__ __forceinline__ void p0_prologue(KP p, LAS unsigned char* lds, int gw, int NGW, int wave, int lane) {
    LAS float* scr = (LAS float*)(lds + wave * 16384);
    unsigned char* ws = p->ws;
    constexpr int I_IN = 16 * 272, I_GU = 32 * 16 * 64, I_DN = 32 * 16 * 32, I_P = 3 * 8 * 32, I_OUT = 16 * 32, I_LAYER = I_IN + I_GU + I_DN + I_P + I_OUT;
    for (int it = gw; it < DEPTH * I_LAYER; it += NGW) {
        const int l = it / I_LAYER; int r = it - l * I_LAYER;
        if (r < I_IN) { const int kb = r / 272, nb = r % 272;
            cvt_tile(p->w_in + (size_t)l * 1024 * D_IN, D_IN, 64 * kb, (bf16*)(ws + WS_WIN) + (size_t)l * ZP * 1024, 1024, 64 * kb, 32 * nb, MapIn{}, scr, lane); continue; } r -= I_IN;
        if (r < I_GU) { const int e = r >> 10, r2 = r & 1023, kb = r2 >> 6, nb = r2 & 63;
            cvt_tile8(p->w_gu + (size_t)(l * 32 + e) * 1024 * 2048, 2048, 64 * kb, (unsigned char*)(ws + WS_WGU) + (size_t)(l * 32 + e) * 2048 * 1024, 1024, 32 * nb, MapGu{}, W8_SCALE, scr, lane); continue; } r -= I_GU;
        if (r < I_DN) { const int e = r >> 9, r2 = r & 511, kb = r2 >> 5, nb = r2 & 31;
            cvt_tile8(p->w_down + (size_t)(l * 32 + e) * 1024 * 1024, 1024, 64 * kb, (unsigned char*)(ws + WS_WDN) + (size_t)(l * 32 + e) * 1024 * 1024, 1024, 32 * nb, MapId{}, W8_SCALE, scr, lane); continue; } r -= I_DN;
        if (r < I_P) { const int br = r >> 8, r2 = r & 255, kb = r2 >> 5, nb = r2 & 31; const float* W = (br == 0 ? p->w_pa : br == 1 ? p->w_pb : p->w_pc) + (size_t)l * 512 * 1024;
            cvt_tile(W, 1024, 64 * kb, (bf16*)(ws + WS_WP) + (size_t)l * 1024 * 1536, 1536, br * 512 + 64 * kb, 32 * nb, MapId{}, scr, lane); continue; } r -= I_P;
        { const int kb = r >> 5, nb = r & 31;
            cvt_tile(p->w_out + (size_t)l * 1024 * 1024, 1024, 64 * kb, (bf16*)(ws + WS_WOUT) + (size_t)l * 1024 * 1024, 1024, 64 * kb, 32 * nb, MapId{}, scr, lane); }
    }
    { float* bg = (float*)(ws + WS_BGU);
      for (int i = gw * 64 + lane; i < DEPTH * 32 * 2048; i += NGW * 64) { const int n = i & 2047, le = i >> 11; bg[i] = p->b_gu[(size_t)le * 2048 + ((n & 1) ? 1024 + (n >> 1) : (n >> 1))]; } }
    { bf16* wf = (bf16*)(ws + WS_WRF);
      for (int i = gw * 64 + lane; i < DEPTH * 32 * 2 * 64 * 8; i += NGW * 64) { const int ii = i & 7, ln = (i >> 3) & 63, nt = (i >> 9) & 1, s = (i >> 10) & 31, l = i >> 15;
          const int k = 32 * s + 8 * (ln >> 4) + ii, e = 16 * nt + (ln & 15); const float w = p->w_router[((size_t)l * 1024 + k) * 32 + e];
          const unsigned hb = f2bf(w); const float lo = w - bf2f(hb);
          const size_t base = ((((size_t)l * 32 + s) * 2 + nt) * 2) * 512 + ln * 8 + ii; wf[base] = (bf16)hb; wf[base + 512] = (bf16)f2bf(lo); } }
    { f32x2* tg = (f32x2*)(ws + WS_TRIG);
      for (int i = gw * 64 + lane; i < SEQ * 32; i += NGW * 64) { const int pos = i >> 5, k = i & 31;
          const float inv = exp2f(-(float)k * (13.287712379549449f / 32.0f)); const float ang = (float)pos * inv;
          const double rev = (double)ang * 0.15915494309189535; const float fr = (float)(rev - __builtin_rint(rev));
          tg[i] = (f32x2){__builtin_amdgcn_cosf(fr), __builtin_amdgcn_sinf(fr)}; } }
    { bf16* xb = (bf16*)(ws + WS_XB);
      for (int m = gw; m < NTOK; m += NGW) { const f32x4* xr = (const f32x4*)(p->x + (size_t)m * DM) + lane; u32x2* o = (u32x2*)(xb + (size_t)m * DM) + lane;
#pragma unroll
          for (int j = 0; j < 4; ++j) { const f32x4 v = xr[64 * j]; o[64 * j] = (u32x2){pk2(v.x, v.y), pk2(v.z, v.w)}; } } }
}

__device__ __forceinline__ void prep_phase(KP p, int l, int gw, int NGW, int lane) {
    unsigned char* ws = p->ws; bf16* Z = (bf16*)(ws + WS_Z); const f32x2* tg = (const f32x2*)(ws + WS_TRIG); float* lfT = (float*)(ws + WS_LFT);
    const float bf_l = (lane < 8) ? p->b_fox[l * 8 + lane] : 0.f;
    for (int m = gw; m < NTOK; m += NGW) {
        bf16* zr = Z + (size_t)m * ZP; const int pos = m & (SEQ - 1), b = m >> 13;
        const f32x2 cs = tg[pos * 32 + (lane & 31)];
        unsigned short ta[11], tb[11];
#pragma unroll
        for (int it = 0; it < 11; ++it) { const int hh = 2 * it + (lane >> 5); const int hc = hh < 21 ? hh : 20;
            const int col = hc < 8 ? Z_AQ + hc * 64 : hc < 16 ? Z_AK + (hc - 8) * 64 : hc < 20 ? Z_IQ + (hc - 16) * 64 : Z_IK;
            const bf16* q = zr + col + (lane & 31); ta[it] = q[0]; tb[it] = q[32]; }
#pragma unroll
        for (int it = 0; it < 11; ++it) { const int hh = 2 * it + (lane >> 5);
            if (hh < 21) { const int col = hh < 8 ? Z_AQ + hh * 64 : hh < 16 ? Z_AK + (hh - 8) * 64 : hh < 20 ? Z_IQ + (hh - 16) * 64 : Z_IK;
                bf16* q = zr + col + (lane & 31); const float t1 = bf2f(ta[it]), t2 = bf2f(tb[it]);
                q[0] = (bf16)f2bf(t1 * cs.x - t2 * cs.y); q[32] = (bf16)f2bf(t2 * cs.x + t1 * cs.y); } }
#pragma unroll
        for (int j = 0; j < 2; ++j) { bf16* g0p = zr + Z_GT + lane * 8 + j * 512; const u32x4 a = *(const u32x4*)g0p, bb = *(const u32x4*)(g0p + 1024), cc = *(const u32x4*)(g0p + 2048);
            u32x4 o0, o1, o2;
#pragma unroll
            for (int i = 0; i < 4; ++i) {
                const float e0l = __expf(-bflo(a[i])), e0h = __expf(-bfhi(a[i])), e1l = __expf(-bflo(bb[i])), e1h = __expf(-bfhi(bb[i])), e2l = __expf(-bflo(cc[i])), e2h = __expf(-bfhi(cc[i]));
                o0[i] = pk2((1.f + e1l) / (1.f + e0l), (1.f + e1h) / (1.f + e0h));
                o1[i] = pk2((1.f + e2l) / (1.f + e1l), (1.f + e2h) / (1.f + e1h));
                o2[i] = pk2(1.f / (1.f + e2l), 1.f / (1.f + e2h)); }
            *(u32x4*)g0p = o0; *(u32x4*)(g0p + 1024) = o1; *(u32x4*)(g0p + 2048) = o2; }
        if (lane < 8) { const float v = bf2f(zr[Z_FF + lane]) + bf_l; const float ls = fminf(v, 0.f) - __logf(1.0f + __expf(-fabsf(v))); lfT[(size_t)(b * 8 + lane) * SEQ + pos] = ls * LOG2E; }
    }
}

constexpr int IX_CAP = 1024, IX_TRIG = 768, IX_CAND = 0, IX_BM = 0  , IX_HIST = 32 * IX_CAP * 4, IX_CNT = IX_HIST + 8 * 1024, IX_TAU = IX_CNT + 128, IX_FLAG = IX_TAU + 128, IX_END = IX_FLAG + 64;
static_assert(IX_END <= SCR_BYTES, "indexer LDS");

__device__ __forceinline__ unsigned wave_select256(LAS unsigned* cand, int n, LAS unsigned* hist, int lane) {
    unsigned x[16];
#pragma unroll
    for (int k = 0; k < 16; ++k) { const int i = lane + 64 * k; x[k] = (i < n) ? cand[i] : 0u; }
    unsigned prefix = 0u; int need = 256;
#pragma unroll
    for (int pass = 3; pass >= 0; --pass) { const int shift = 8 * pass;
        ((LAS u32x4*)hist)[lane] = (u32x4){0u, 0u, 0u, 0u};
#pragma unroll
        for (int k = 0; k < 16; ++k) { const bool ok = (lane + 64 * k < n) && (pass == 3 || (x[k] >> (shift + 8)) == (prefix >> (shift + 8)));
            if (ok) (void)__hip_atomic_fetch_add(hist + ((x[k] >> shift) & 255u), 1u, __ATOMIC_RELAXED, __HIP_MEMORY_SCOPE_WORKGROUP); }
        LDS_WAIT();
        const u32x4 b = ((const LAS u32x4*)hist)[lane];
        const int s = (int)(b.x + b.y + b.z + b.w); int suf = s;
#pragma unroll
        for (int o = 1; o < 64; o <<= 1) { const int t = __shfl_down(suf, o); if (lane + o < 64) suf += t; }
        const int above = suf - s; const bool found = (above < need) && (suf >= need);
        const int c3 = above + (int)b.w, c2 = c3 + (int)b.z, c1 = c2 + (int)b.y;
        const int d = (c3 >= need) ? 3 : (c2 >= need) ? 2 : (c1 >= need) ? 1 : 0; const int nn = need - ((d == 3) ? above : (d == 2) ? c3 : (d == 1) ? c2 : c1);
        const u64 fm = __ballot(found); const int src = (int)__builtin_ctzll(fm);
        const int digit = __builtin_amdgcn_readlane(4 * lane + d, src); need = __builtin_amdgcn_readlane(nn, src);
        prefix |= (unsigned)digit << shift;
        LDS_WAIT();
    }
    int base = 0; const u64 lt = (1ull << lane) - 1ull;
#pragma unroll
    for (int k = 0; k < 16; ++k) { const bool keep = x[k] >= prefix; const u64 mk = __ballot(keep);
        if (keep) cand[base + __popcll(mk & lt)] = x[k]; base += __popcll(mk); }
    return prefix;
}

__device__ __forceinline__ void idx_phase(KP p, int l, LAS unsigned char* lds, int vcu, int G, int tid, int wave, int lane) {
    unsigned char* ws = p->ws; const bf16* Z = (const bf16*)(ws + WS_Z);
    for (int bh = blockIdx.x; bh < 32; bh += G) {
        float* dst = (float*)(ws + WS_CT) + (size_t)bh * SEQ;
        LAS float* wt = (LAS float*)lds;
        const float bfx = p->b_fox[l * 8 + (bh & 7)]; const bf16* zf = Z + (size_t)((bh >> 3) * SEQ + tid * 16) * ZP + Z_FF + (bh & 7);
        f32x4 v[4]; float run = 0.f;
#pragma unroll
        for (int j = 0; j < 4; ++j) {
#pragma unroll
            for (int i = 0; i < 4; ++i) { const float t = bf2f(zf[(size_t)(4 * j + i) * ZP]) + bfx; v[j][i] = (fminf(t, 0.f) - __logf(1.0f + __expf(-fabsf(t)))) * LOG2E; }
            v[j].x += run; v[j].y += v[j].x; v[j].z += v[j].y; v[j].w += v[j].z; run = v[j].w; }
        float inc = run;
#pragma unroll
        for (int o = 1; o < 64; o <<= 1) { const float t = __shfl_up(inc, o); if (lane >= o) inc += t; }
        if (lane == 63) wt[wave] = inc;
        WG_BAR();
        float off = inc - run;
        for (int w = 0; w < wave; ++w) off += wt[w];
        { u32x4* ka = (u32x4*)((bf16*)(ws + WS_KA) + ((size_t)bh * SEQ + tid * 16) * 16);
#pragma unroll
          for (int j = 0; j < 4; ++j) { const f32x4 c4 = v[j] + off; *(f32x4*)(dst + tid * 16 + 4 * j) = c4;
#pragma unroll
              for (int i = 0; i < 4; ++i) { const float c = c4[i]; const unsigned h1 = f2bf(c); const float r1 = c - bf2f(h1); const unsigned h2 = f2bf(r1); const unsigned h3 = f2bf(r1 - bf2f(h2));
                  unsigned z0 = 0u; asm volatile("" : "+v"(z0));
                  ka[(4 * j + i) * 2] = (u32x4){h1 | (h2 << 16), h3 | 0x3f800000u, z0, z0}; ka[(4 * j + i) * 2 + 1] = (u32x4){z0, z0, z0, z0}; } } }
        WG_BAR();
        { float qm = 0.f, km = 0.f; const bf16* zr = Z + (size_t)((bh >> 3) * SEQ + tid * 16) * ZP + (bh & 7) * 64;
#pragma unroll 1
          for (int i = 0; i < 16; ++i) { float qs = 0.f, ks = 0.f;
#pragma unroll
              for (int c8 = 0; c8 < 8; ++c8) { const u32x4 a = *(const u32x4*)(zr + (size_t)i * ZP + Z_FQ + c8 * 8), kq = *(const u32x4*)(zr + (size_t)i * ZP + Z_FK + c8 * 8);
#pragma unroll
                  for (int w4 = 0; w4 < 4; ++w4) { qs += bflo(a[w4]) * bflo(a[w4]) + bfhi(a[w4]) * bfhi(a[w4]); ks += bflo(kq[w4]) * bflo(kq[w4]) + bfhi(kq[w4]) * bfhi(kq[w4]); } }
              qm = fmaxf(qm, qs); km = fmaxf(km, ks); }
#pragma unroll
          for (int o = 1; o < 64; o <<= 1) { qm = fmaxf(qm, __shfl_xor(qm, o)); km = fmaxf(km, __shfl_xor(km, o)); }
          if (lane == 0) { wt[16 + wave] = qm; wt[32 + wave] = km; }
          WG_BAR();
          if (tid == 0) { float q2 = 0.f, k2 = 0.f; for (int w = 0; w < NWAVES; ++w) { q2 = fmaxf(q2, wt[16 + w]); k2 = fmaxf(k2, wt[32 + w]); } ((float*)(ws + WS_SB))[bh] = sqrtf(q2) * sqrtf(k2) * 1.01f + 1.0f; }
          WG_BAR(); }
    }
    LAS unsigned* cand = (LAS unsigned*)(lds + IX_CAND); LAS unsigned* BM = (LAS unsigned*)(lds + IX_BM);
    LAS unsigned* cnt = (LAS unsigned*)(lds + IX_CNT); LAS unsigned* tau = (LAS unsigned*)(lds + IX_TAU); LAS unsigned* hist = (LAS unsigned*)(lds + IX_HIST); LAS unsigned* flg = (LAS unsigned*)(lds + IX_FLAG);
    u64* MW = (u64*)(ws + WS_MASKW);
    const int r32 = lane & 31, hi = lane >> 5;
    for (int U = vcu; U < 1024; U += G) {
        const int v = U & 255, i4 = U >> 8; const int b = v & 3, a = v >> 2;
        const int hc = (i4 == 0) ? a : (i4 == 1) ? 255 - a : (i4 == 2) ? 64 + a : 191 - a;
        const int qbase = b * SEQ + hc * 32; const int nadm = ((hc >> 1) + 1) * 64;
        if (nadm <= 256) {
            const int nw = nadm >> 6;
            for (int i = tid; i < 32 * 128; i += NTHR) { const int q = i >> 7, w = i & 127; unsigned on = (w < nw) ? 0xffffffffu : 0u; asm volatile("" : "+v"(on));
                MW[(size_t)(qbase + q) * 128 + w] = (u64)on | ((u64)on << 32); }
            continue;
        }
        const bf16* qrow = Z + (size_t)(qbase + r32) * ZP;
        bf16x8 iqf[4][4];
#pragma unroll
        for (int hd = 0; hd < 4; ++hd)
#pragma unroll
            for (int j = 0; j < 4; ++j) iqf[hd][j] = *(const bf16x8*)(qrow + Z_IQ + hd * 64 + j * 16 + hi * 8);
        float wq[4];
#pragma unroll
        for (int hd = 0; hd < 4; ++hd) wq[hd] = bf2f(qrow[Z_IW + hd]) * (0.5f * 0.125f);
        if (tid < 32) { cnt[tid] = 0u; tau[tid] = 0u; } if (tid < 3) flg[tid] = 0u;
        const int ntiles = nadm >> 5, nrounds = (ntiles + 7) >> 3;
        const bf16* kbase = Z + (size_t)(b * SEQ) * ZP + Z_IK + hi * 8;
        bf16x8 kf[4];
        WG_BAR();
        for (int rd = 0; rd < nrounds; ++rd) {
            const int tile = rd * 8 + wave;
            if (tile < ntiles) {
#pragma unroll
                for (int j = 0; j < 4; ++j) kf[j] = *(const bf16x8*)(kbase + (size_t)(tile * 32 + r32) * ZP + j * 16);
                f32x16 sc = {};
#pragma unroll
                for (int hd = 0; hd < 4; ++hd) { f32x16 pp = {};
#pragma unroll
                    for (int j = 0; j < 4; ++j) pp = MFMA32(kf[j], iqf[hd][j], pp);
#pragma unroll
                    for (int r = 0; r < 16; ++r) sc[r] = __builtin_fmaf(wq[hd], fmaxf(pp[r], 0.f), sc[r]); }
                const unsigned tq = tau[r32];
                typedef unsigned u32x16_t __attribute__((ext_vector_type(16))); u32x16_t comp, posv; bool anyp = false;
#pragma unroll
                for (int r = 0; r < 16; ++r) { const int key = tile * 32 + crow(r, hi);
                    unsigned u = __builtin_bit_cast(unsigned, sc[r] + 0.0f); u ^= (u >> 31) ? 0xffffffffu : 0x80000000u;
                    comp[r] = (u & 0xffffe000u) | (unsigned)(8191 - key); posv[r] = 0u;
                    if (comp[r] > tq) { posv[r] = __hip_atomic_fetch_add(cnt + r32, 1u, __ATOMIC_RELAXED, __HIP_MEMORY_SCOPE_WORKGROUP); anyp = true; } }
                LAS unsigned* cq_ = cand + r32 * IX_CAP; bool trig = false;
#pragma unroll
                for (int r = 0; r < 16; ++r) if (comp[r] > tq) { cq_[posv[r]] = comp[r]; trig = trig || (posv[r] >= (unsigned)IX_TRIG); }
                if (trig) flg[rd % 3] = 1u; (void)anyp;
            }
            WG_BAR_LDS();
            const bool need_any = flg[rd % 3] != 0u;
            if (tid == 0) flg[(rd + 2) % 3] = 0u;
            if (need_any) {
#pragma unroll 1
                for (int i = 0; i < 4; ++i) { const int qq = wave * 4 + i; const int n = (int)cnt[qq];
                    if (n > 256) { const unsigned th = wave_select256(cand + qq * IX_CAP, n, hist + wave * 256, lane); if (lane == 0) { cnt[qq] = 256u; tau[qq] = th; } } }
                WG_BAR_LDS();
            }
        }
#pragma unroll 1
        for (int i = 0; i < 4; ++i) { const int qq = wave * 4 + i; const int n = (int)cnt[qq];
            if (n > 256) { (void)wave_select256(cand + qq * IX_CAP, n, hist + wave * 256, lane); } }
        LDS_WAIT();
        unsigned fin[4][4];
#pragma unroll
        for (int i = 0; i < 4; ++i)
#pragma unroll
            for (int k = 0; k < 4; ++k) fin[i][k] = cand[(wave * 4 + i) * IX_CAP + lane + 64 * k];
        WG_BAR();
        for (int i = tid; i < 32 * 256; i += NTHR) BM[i] = 0u;
        WG_BAR();
#pragma unroll
        for (int i = 0; i < 4; ++i) { const int qq = wave * 4 + i;
#pragma unroll
            for (int k = 0; k < 4; ++k) { const int key = 8191 - (int)(fin[i][k] & 8191u);
                __hip_atomic_fetch_or(BM + qq * 256 + (key >> 5), 1u << (key & 31), __ATOMIC_RELAXED, __HIP_MEMORY_SCOPE_WORKGROUP); } }
        WG_BAR();
        for (int i = tid; i < 32 * 128; i += NTHR) { const int q = i >> 7, w = i & 127; MW[(size_t)(qbase + q) * 128 + w] = (u64)BM[q * 256 + 2 * w] | ((u64)BM[q * 256 + 2 * w + 1] << 32); }
        WG_BAR();
    }
}

constexpr int AT_K = 0, AT_V = 2 * 8192, AT_WS = 4 * 8192, AT_OST = AT_WS + 4096, AT_MW = AT_OST + 8 * 4096, AT_KA = AT_MW + 2 * 8 * 512, AT_END = AT_KA + 2 * 2048;
static_assert(AT_END <= SCR_BYTES, "attention LDS");
#ifndef DBG_ATT_L
#define DBG_ATT_L 0
#endif

template <int MODE>
__device__ __forceinline__ void attn_unit(int b, int h, int qb, const bf16* Z, bf16* Ob, const float* cT, const u64* MW, const void* KA, const void* SBp, LAS char* shm, int wv) {
    int tid_l = lane_id() + wv * 64;
    const int tid = tid_l, lane = tid & 63, r32 = lane & 31, hi = lane >> 5; const int wid = __builtin_amdgcn_readfirstlane(tid >> 6);
    constexpr int QC = MODE == 0 ? Z_FQ : Z_AQ, KC = MODE == 0 ? Z_FK : Z_AK, VC = MODE == 0 ? Z_FV : Z_AV, OC = MODE == 0 ? 512 : 0;
    const long rowbase = (long)b * SEQ; const int q0 = qb * 512;
    const bf16* Qw = Z + (rowbase + q0 + wid * 64) * ZP + QC + h * 64;
    const bf16* Kh = Z + rowbase * ZP + KC + h * 64; const bf16* Vh = Z + rowbase * ZP + VC + h * 64;
    const unsigned lds0 = (unsigned)(uintptr_t)shm;
    LAS float* wsf = (LAS float*)(shm + AT_WS) + wid * 128;
    const int NT = 8 * (qb + 1); const int tlast = 8 * qb + wid;
    const bf16* ksrc = Kh + (long)lane * ZP + wid * 8;
    const bf16* vsrc = Vh + (long)(16 * (wid & 3) + (lane >> 2)) * ZP + (wid >> 2) * 32 + (lane & 3) * 8;
    const unsigned kdst = lds0 + AT_K + wid * 1024, vdst = lds0 + AT_V + wid * 1024, mdst = lds0 + AT_MW + wid * 512;
    const unsigned kadst = lds0 + AT_KA + (wid & 1) * 1024;
#define DMA_KA(t, sl) do { if (MODE == 0 && wid < 2) { const int ln_ = lane_id();     \
        glds16((const bf16*)KA + ((size_t)(b * 8 + h) * SEQ + (t) * 64 + 32 * wid + (ln_ >> 1)) * 16 + (ln_ & 1) * 8, (unsigned)__builtin_amdgcn_readfirstlane(kadst + (sl) * 2048)); } } while (0)
#define DMA_K(t, slotb) glds16(ksrc + (long)(t) * 64 * ZP, (unsigned)__builtin_amdgcn_readfirstlane(kdst + (slotb)))
#define DMA_V(t, slotb) glds16(vsrc + (long)(t) * 64 * ZP, (unsigned)__builtin_amdgcn_readfirstlane(vdst + (slotb)))
#define DMA_M(t, sl) do { const int ln_ = lane_id(); const unsigned* msrcA = (const unsigned*)(MW + (size_t)(rowbase + q0 + wid * 64 + (ln_ & 31)) * 128) + (ln_ >> 5);     \
        glds4(msrcA + 2 * (t), (unsigned)__builtin_amdgcn_readfirstlane(mdst + (sl) * 4096)); glds4(msrcA + 32 * 256 + 2 * (t), (unsigned)__builtin_amdgcn_readfirstlane(mdst + (sl) * 4096 + 256)); } while (0)
    int t_start = 0, t_first = 0;
    if (MODE == 0) { const float* cg = cT + (size_t)(b * 8 + h) * SEQ; const float th = 2.0f * ((const float*)SBp)[b * 8 + h] + 40.0f; const int ln_ = lane_id();
        const float c0 = cg[q0], cw = cg[q0 + wid * 64];
        const float ca = (ln_ < NT) ? cg[64 * ln_ + 63] : -3e38f, cb = (ln_ + 64 < NT) ? cg[64 * (ln_ + 64) + 63] : -3e38f;
        { const u64 m0 = __ballot(ca <= c0 + th), m1 = __ballot(cb <= c0 + th); t_start = m0 ? (int)__builtin_ctzll(m0) : 64 + (int)__builtin_ctzll(m1 | (1ull << 63)); }
        { const u64 m0 = __ballot(ca <= cw + th), m1 = __ballot(cb <= cw + th); t_first = m0 ? (int)__builtin_ctzll(m0) : 64 + (int)__builtin_ctzll(m1 | (1ull << 63)); }
        if (t_start > 8 * qb) t_start = 8 * qb; if (t_first > tlast) t_first = tlast; }
    DMA_K(t_start, 0); DMA_V(t_start, 0); if (MODE == 1) DMA_M(0, 0); DMA_KA(t_start, 0);
    bf16x8 qA[4], qB[4];
#pragma unroll
    for (int d0 = 0; d0 < 4; ++d0) { qA[d0] = *(const bf16x8*)(Qw + (long)r32 * ZP + d0 * 16 + hi * 8); qB[d0] = *(const bf16x8*)(Qw + (long)(32 + r32) * ZP + d0 * 16 + hi * 8); }
    float mA = 0.f, mB = 0.f, lA = 0.f, lB = 0.f;
    const unsigned qa0 = (MODE == 0 && hi == 0) ? 0xbf80bf80u : 0u; const unsigned qa1c = (MODE == 0 && hi == 0) ? 0xbf80u : 0u;
    u32x4 qaA = {qa0, qa1c, 0u, 0u}, qaB = {qa0, qa1c, 0u, 0u};
    f32x16 oA[2], oB[2]; oA[0] = f32x16{}; oA[1] = f32x16{}; oB[0] = f32x16{}; oB[1] = f32x16{};
    const int qrelA = wid * 64 + r32;
    const LAS char* kp0 = shm + AT_K + hi * 1024 + r32 * 16;
    const LAS char* vp0 = shm + AT_V + ((lane >> 4) & 1) * 32 + (lane & 3) * 8 + (4 * hi + ((lane & 15) >> 2)) * 64;
    const LAS unsigned* mwp = (const LAS unsigned*)(shm + AT_MW + wid * 512);
    const LAS char* kap0 = shm + AT_KA + r32 * 32 + hi * 16;
    int slot = 0;
#define SOFTMAX(P0, P1, MH, LR, OO, QA, QREL, WSOFF, MWOFF, PW) do { \
        if (MODE == 0) { \
            if (t == tlast) { _Pragma("unroll") for (int r = 0; r < 16; ++r) { const int kv = crow(r, hi); if (kv > (QREL) - wid * 64) P0[r] = -INFINITY; if (kv + 32 > (QREL) - wid * 64) P1[r] = -INFINITY; } } \
        } else { const unsigned mlo = mwp[slot * 1024 + (MWOFF) + r32], mhi = mwp[slot * 1024 + (MWOFF) + 32 + r32]; \
            _Pragma("unroll") for (int r = 0; r < 16; ++r) { const int bitp = crow(r, hi); if (!((mlo >> bitp) & 1u)) P0[r] = -INFINITY; if (!((mhi >> bitp) & 1u)) P1[r] = -INFINITY; } } \
        float rm = __builtin_fmaxf(__builtin_fmaxf(P0[0], P0[1]), P1[0]), rm2 = __builtin_fmaxf(__builtin_fmaxf(P0[2], P0[3]), P1[1]); rm = __builtin_fmaxf(__builtin_fmaxf(rm, P1[2]), P1[3]); \
        _Pragma("unroll") for (int r = 4; r < 16; r += 4) { rm = __builtin_fmaxf(__builtin_fmaxf(rm, P0[r]), P0[r + 1]); rm2 = __builtin_fmaxf(__builtin_fmaxf(rm2, P0[r + 2]), P0[r + 3]); rm = __builtin_fmaxf(__builtin_fmaxf(rm, P1[r]), P1[r + 1]); rm2 = __builtin_fmaxf(__builtin_fmaxf(rm2, P1[r + 2]), P1[r + 3]); } \
        rm = __builtin_fmaxf(rm, rm2); \
        rm = swapmax(rm);                            \
        if (__any(rm > 8.0f)) { const bool big_ = __builtin_fabsf(MH) + __builtin_fabsf(rm > 0.f ? rm : 0.f) > 1800.0f;     \
            const float dl = rm > 0.f ? (big_ ? 64.0f * __builtin_ceilf((MH + rm) * (1.0f / 64.0f)) - MH : 8.0f * __builtin_ceilf(rm * 0.125f)) : 0.f; const float f = __builtin_amdgcn_exp2f(-dl); LR *= f; MH += dl; \
            QA[1] = (QA[1] & 0xffffu) | ((hi == 0) ? (f2bf(-MH) << 16) : 0u); \
            _Pragma("unroll") for (int r = 0; r < 16; ++r) { P0[r] -= dl; P1[r] -= dl; } \
            if (hi == 0) wsf[(WSOFF) + r32] = f; \
            LDS_WAIT(); \
            _Pragma("unroll") for (int j = 0; j < 4; ++j) { const f32x4 ff = *(const LAS f32x4*)(wsf + (WSOFF) + 8 * j + 4 * hi); \
                _Pragma("unroll") for (int i = 0; i < 4; ++i) { OO[0][4 * j + i] *= ff[i]; OO[1][4 * j + i] *= ff[i]; } } } \
        float sacc = 0.f; \
        _Pragma("unroll") for (int r = 0; r < 16; ++r) { P0[r] = __builtin_amdgcn_exp2f(P0[r]); P1[r] = __builtin_amdgcn_exp2f(P1[r]); sacc += P0[r] + P1[r]; } \
        LR += sacc; \
        _Pragma("unroll") for (int i = 0; i < 4; ++i) { PW[0][i] = cvtpk(P0[2 * i], P0[2 * i + 1]); PW[1][i] = cvtpk(P0[8 + 2 * i], P0[8 + 2 * i + 1]); PW[2][i] = cvtpk(P1[2 * i], P1[2 * i + 1]); PW[3][i] = cvtpk(P1[8 + 2 * i], P1[8 + 2 * i + 1]); } \
    } while (0)
#define PVMM(OO, PW) do { const LAS char* vp = vp0 + slot * 8192; \
        _Pragma("unroll") for (int d0 = 0; d0 < 2; ++d0) { s16x4 lo_[4], hh_[4]; \
            _Pragma("unroll") for (int ks = 0; ks < 4; ++ks) { lo_[ks] = vtr(vp + d0 * 4096 + ks * 1024); hh_[ks] = vtr(vp + d0 * 4096 + ks * 1024 + 512); } \
            _Pragma("unroll") for (int ks = 0; ks < 4; ++ks) { const bf16x8 vf = {lo_[ks][0], lo_[ks][1], lo_[ks][2], lo_[ks][3], hh_[ks][0], hh_[ks][1], hh_[ks][2], hh_[ks][3]}; \
                OO[d0] = MFMA32(__builtin_bit_cast(bf16x8, PW[ks]), vf, OO[d0]); } } } while (0)
    for (int t = t_start; t < NT; ++t) {
        asm volatile("s_waitcnt vmcnt(0) lgkmcnt(0)\n\ts_barrier" ::: "memory");
        if (t + 1 < NT) { DMA_K(t + 1, (slot ^ 1) * 8192); DMA_V(t + 1, (slot ^ 1) * 8192); if (MODE == 1) DMA_M(t + 1, slot ^ 1); DMA_KA(t + 1, slot ^ 1); }
        if (t <= tlast && t >= t_first) {
            f32x16 a0 = {}, a1 = {}, b0 = {}, b1 = {};
            { const LAS char* kb = kp0 + slot * 8192;
#pragma unroll
              for (int d0 = 0; d0 < 4; ++d0) { const bf16x8 k0 = *(const LAS bf16x8*)(kb + d0 * 2048), k1 = *(const LAS bf16x8*)(kb + d0 * 2048 + 512);
                  a0 = MFMA32(k0, qA[d0], a0); a1 = MFMA32(k1, qA[d0], a1); b0 = MFMA32(k0, qB[d0], b0); b1 = MFMA32(k1, qB[d0], b1); }
              bf16x8 x0, x1;
              if (MODE == 0) { x0 = *(const LAS bf16x8*)(kap0 + slot * 2048); x1 = *(const LAS bf16x8*)(kap0 + slot * 2048 + 1024); }
              else { const u32x4 cw = {0u, (hi == 0) ? 0x3f800000u : 0u, 0u, 0u}; x0 = __builtin_bit_cast(bf16x8, cw); x1 = x0; }
              a0 = MFMA32(x0, __builtin_bit_cast(bf16x8, qaA), a0); a1 = MFMA32(x1, __builtin_bit_cast(bf16x8, qaA), a1); b0 = MFMA32(x0, __builtin_bit_cast(bf16x8, qaB), b0); b1 = MFMA32(x1, __builtin_bit_cast(bf16x8, qaB), b1); }
            u32x4 pwA[4], pwB[4];
            SOFTMAX(a0, a1, mA, lA, oA, qaA, qrelA, 0, 0, pwA);
            PVMM(oA, pwA);
            SOFTMAX(b0, b1, mB, lB, oB, qaB, qrelA + 32, 32, 64, pwB);
            PVMM(oB, pwB);
        }
        slot ^= 1;
    }
#define EPILOG(OO, LR, WSOFF, ROWOFF) do { float l_ = swapsum(LR); if (hi == 0) wsf[64 + (WSOFF) + r32] = l_; LDS_WAIT(); float rli[16]; \
        _Pragma("unroll") for (int r = 0; r < 16; ++r) rli[r] = __builtin_amdgcn_rcpf(wsf[64 + (WSOFF) + crow(r, hi)]); \
        bf16* Ow = Ob + (rowbase + q0 + wid * 64 + (ROWOFF)) * OP + OC + h * 64; LAS bf16* stg = (LAS bf16*)(shm + AT_OST) + wid * 2048; \
        _Pragma("unroll") for (int r = 0; r < 16; ++r) { const int orow = crow(r, hi); _Pragma("unroll") for (int d0 = 0; d0 < 2; ++d0) stg[orow * 64 + d0 * 32 + r32] = (bf16)f2bf(OO[d0][r] * rli[r]); } \
        LDS_WAIT(); \
        _Pragma("unroll") for (int i = 0; i < 4; ++i) { const int row = i * 8 + (lane >> 3), ch = lane & 7; const u32x4 v = *(const LAS u32x4*)(stg + row * 64 + ch * 8); *(u32x4*)(Ow + (long)row * OP + ch * 8) = v; } \
        LDS_WAIT(); } while (0)
    EPILOG(oA, lA, 0, 0);
    EPILOG(oB, lB, 32, 32);
    asm volatile("s_waitcnt lgkmcnt(0)\n\ts_barrier" ::: "memory");
#undef DMA_K
#undef DMA_V
#undef DMA_M
#undef DMA_KA
#undef SOFTMAX
#undef PVMM
#undef EPILOG
}

__device__ __forceinline__ void attn_phase(KP p, LAS unsigned char* lds, int vcu, int G, int wv) {
    unsigned char* ws = p->ws; const bf16* Z = (const bf16*)(ws + WS_Z); bf16* Ob = (bf16*)(ws + WS_OBUF); const float* cT = (const float*)(ws + WS_CT); const u64* MW = (const u64*)(ws + WS_MASKW);
    for (int U = vcu; U < 1024; U += G) {
        const int v = U & 255, i4 = U >> 8; const int mode = i4 & 1, k = i4 >> 1; const int bh = v >> 3, s = v & 7;
        const int qb = (k == 0) ? s : 15 - s;
        if (mode == 0) attn_unit<0>(bh >> 3, bh & 7, qb, Z, Ob, cT, MW, (const void*)(ws + WS_KA), (const void*)(ws + WS_SB), (LAS char*)lds, wv);
        else attn_unit<1>(bh >> 3, bh & 7, qb, Z, Ob, cT, MW, (const void*)(ws + WS_KA), (const void*)(ws + WS_SB), (LAS char*)lds, wv);
    }
}

constexpr int HG_LF = 0, HG_KK = 16640, HG_SEG = 33280, HG_P = 35328, HG_R = HG_P + 9216, HG_RT = HG_R + 9216, HG_VT = HG_RT + 9216, HG_ST = HG_VT + 9216, HG_CG = HG_ST + 9216, HG_END = HG_CG + 9216;
static_assert(HG_END <= SCR_BYTES, "hgrn LDS");
constexpr int HP = 72;

__device__ __forceinline__ void hgrn_gates(KP p, int l, const bf16* Z, int t0, int h, LAS unsigned char* lds, int tid) {
    LAS float* LF = (LAS float*)(lds + HG_LF); LAS float* KK = (LAS float*)(lds + HG_KK); LAS float* SEG = (LAS float*)(lds + HG_SEG);
    const int row = tid >> 3, ch = tid & 7;
    const u32x4 zw = *(const u32x4*)(Z + (size_t)(t0 + row) * ZP + Z_CF + h * 64 + ch * 8);
    float lbv[8];
#pragma unroll
    for (int i = 0; i < 8; ++i) { const int dd = h * 64 + ch * 8 + i; lbv[i] = (l == 0) ? 0.f : sigmoidf_(p->lb_logits[512 + dd] - p->lb_logits[dd]); }
#pragma unroll
    for (int i = 0; i < 8; ++i) { const float zf = (i & 1) ? bfhi(zw[i >> 1]) : bflo(zw[i >> 1]);
        const float sg = sigmoidf_(zf); const float f = lbv[i] + (1.f - lbv[i]) * sg; const float kk = (1.f - lbv[i]) * (1.f - sg);
        LF[row * 65 + ch * 8 + i] = __logf(f); KK[row * 65 + ch * 8 + i] = kk; }
    WG_BAR();
    { const int d = tid & 63, seg = tid >> 6; float s = 0.f;
#pragma unroll
      for (int i = 0; i < 8; ++i) { s += LF[(seg * 8 + i) * 65 + d]; LF[(seg * 8 + i) * 65 + d] = s; }
      SEG[seg * 64 + d] = s;
      WG_BAR();
      float pre = 0.f;
      for (int s2 = 0; s2 < seg; ++s2) pre += SEG[s2 * 64 + d];
#pragma unroll
      for (int i = 0; i < 8; ++i) LF[(seg * 8 + i) * 65 + d] += pre; }
    WG_BAR();
}

__device__ __forceinline__ void h1_phase(KP p, int l, LAS unsigned char* lds, int vcu, int G, int tid, int wave, int lane) {
    unsigned char* ws = p->ws; const bf16* Z = (const bf16*)(ws + WS_Z); float* Ug = (float*)(ws + WS_UG); float* Dg = (float*)(ws + WS_DG); float* D2g = (float*)(ws + WS_D2G);
    LAS float* LF = (LAS float*)(lds + HG_LF); LAS float* KK = (LAS float*)(lds + HG_KK);
    LAS bf16* RT = (LAS bf16*)(lds + HG_RT); LAS bf16* VT = (LAS bf16*)(lds + HG_VT);
    const int r32 = lane & 31, hi = lane >> 5;
    for (int U = vcu; U < 4096; U += G) {
        const int bh = U >> 7, c = U & 127, b = bh >> 3, h = bh & 7; const int t0 = b * SEQ + c * 64;
        hgrn_gates(p, l, Z, t0, h, lds, tid);
        const int row = tid >> 3, ch = tid & 7;
        { const u32x4 vw = *(const u32x4*)(Z + (size_t)(t0 + row) * ZP + Z_CI + h * 64 + ch * 8);
#pragma unroll
          for (int i = 0; i < 8; ++i) { const int d = ch * 8 + i; const float bv = LF[row * 65 + d], bm = LF[31 * 65 + d];
              RT[d * HP + row] = (bf16)f2bf(KK[row * 65 + d] * __expf(fminf(bm - bv, 80.f)));
              VT[d * HP + row] = (bf16)((i & 1) ? (vw[i >> 1] >> 16) : (vw[i >> 1] & 0xffffu)); } }
        if (tid < 64) { const float bl = LF[63 * 65 + tid], bm = LF[31 * 65 + tid]; Dg[(size_t)U * 64 + tid] = __expf(bl); D2g[(size_t)U * 64 + tid] = __expf(bl - bm); }
        WG_BAR();
        if (wave < 4) { const int ib = wave >> 1, jb = wave & 1; f32x16 acc = {};
#pragma unroll
            for (int ks = 0; ks < 4; ++ks) { const bf16x8 a = *(const LAS bf16x8*)(RT + (32 * ib + r32) * HP + 16 * ks + 8 * hi), bb = *(const LAS bf16x8*)(VT + (32 * jb + r32) * HP + 16 * ks + 8 * hi);
                acc = MFMA32(a, bb, acc); }
            float* up = Ug + ((size_t)U * 64 + 32 * jb + r32) * 64 + 32 * ib + 4 * hi;
#pragma unroll
            for (int rr = 0; rr < 4; ++rr) *(f32x4*)(up + 8 * rr) = (f32x4){acc[4 * rr], acc[4 * rr + 1], acc[4 * rr + 2], acc[4 * rr + 3]}; }
        WG_BAR();
    }
}

__device__ __forceinline__ void h2_phase(KP p, int G, int tid) {
    unsigned char* ws = p->ws; const float* Ug = (const float*)(ws + WS_UG); const float* Dg = (const float*)(ws + WS_DG); const float* D2g = (const float*)(ws + WS_D2G); bf16* Sst = (bf16*)(ws + WS_SST);
    for (int gid = blockIdx.x * NTHR + tid; gid < 32 * 4096; gid += G * NTHR) {
        const int bh = gid >> 12, ed = gid & 4095, d = ed & 63; float S = 0.f;
        const float* up = Ug + (size_t)bh * 128 * 4096 + ed; const float* dp = Dg + (size_t)bh * 128 * 64 + d; const float* d2p = D2g + (size_t)bh * 128 * 64 + d; bf16* sp = Sst + (size_t)bh * 128 * 4096 + ed;
        for (int c0 = 0; c0 < 128; c0 += 8) { float u[8], dd[8], d2[8];
#pragma unroll
            for (int i = 0; i < 8; ++i) { u[i] = up[(size_t)(c0 + i) * 4096]; dd[i] = dp[(c0 + i) * 64]; d2[i] = d2p[(c0 + i) * 64]; }
#pragma unroll
            for (int i = 0; i < 8; ++i) { sp[(size_t)(c0 + i) * 4096] = (bf16)f2bf(S); S = dd[i] * S + d2[i] * u[i]; } }
    }
}

__device__ __forceinline__ void h3_phase(KP p, int l, LAS unsigned char* lds, int vcu, int G, int tid, int wave, int lane) {
    unsigned char* ws = p->ws; const bf16* Z = (const bf16*)(ws + WS_Z); const bf16* Sst = (const bf16*)(ws + WS_SST); bf16* Ob = (bf16*)(ws + WS_OBUF);
    LAS float* LF = (LAS float*)(lds + HG_LF); LAS float* KK = (LAS float*)(lds + HG_KK);
    LAS bf16* Pt = (LAS bf16*)(lds + HG_P); LAS bf16* Rt = (LAS bf16*)(lds + HG_R); LAS bf16* VT = (LAS bf16*)(lds + HG_VT); LAS bf16* ST = (LAS bf16*)(lds + HG_ST); LAS bf16* CG = (LAS bf16*)(lds + HG_CG);
    const int r32 = lane & 31, hi = lane >> 5;
    const float* gn = p->norm_g + l * 512;
    for (int U = vcu; U < 4096; U += G) {
        const int bh = U >> 7, c = U & 127, b = bh >> 3, h = bh & 7; const int t0 = b * SEQ + c * 64;
        hgrn_gates(p, l, Z, t0, h, lds, tid);
        const int row = tid >> 3, ch = tid & 7;
        { const bf16* zr = Z + (size_t)(t0 + row) * ZP + h * 64 + ch * 8;
          const u32x4 qw = *(const u32x4*)(zr + Z_CQ), vw = *(const u32x4*)(zr + Z_CI), gw = *(const u32x4*)(zr + Z_CG);
          const u32x4 sw = *(const u32x4*)(Sst + (size_t)U * 4096 + row * 64 + ch * 8);
          float pv[8], rv[8], sv[8];
#pragma unroll
          for (int i = 0; i < 8; ++i) { const int d = ch * 8 + i; const float bv = LF[row * 65 + d], bm = LF[31 * 65 + d];
              const float q = (i & 1) ? bfhi(qw[i >> 1]) : bflo(qw[i >> 1]);
              pv[i] = q * __expf(fminf(bv - bm, 80.f)); rv[i] = KK[row * 65 + d] * __expf(fminf(bm - bv, 80.f));
              const float s = (i & 1) ? bfhi(sw[i >> 1]) : bflo(sw[i >> 1]); sv[i] = s * __expf(bm);
              VT[d * HP + row] = (bf16)((i & 1) ? (vw[i >> 1] >> 16) : (vw[i >> 1] & 0xffffu)); }
          *(LAS u32x4*)(Pt + row * HP + ch * 8) = (u32x4){pk2(pv[0], pv[1]), pk2(pv[2], pv[3]), pk2(pv[4], pv[5]), pk2(pv[6], pv[7])};
          *(LAS u32x4*)(Rt + row * HP + ch * 8) = (u32x4){pk2(rv[0], rv[1]), pk2(rv[2], rv[3]), pk2(rv[4], rv[5]), pk2(rv[6], rv[7])};
          *(LAS u32x4*)(ST + row * HP + ch * 8) = (u32x4){pk2(sv[0], sv[1]), pk2(sv[2], sv[3]), pk2(sv[4], sv[5]), pk2(sv[6], sv[7])};
          *(LAS u32x4*)(CG + row * HP + ch * 8) = gw; }
        WG_BAR();
        if (wave < 2) { const int ib = wave;
            u32x4 pw[2][2];
#pragma unroll
            for (int k = 0; k < 2; ++k) { f32x16 a = {};
                if (k <= ib) {
#pragma unroll
                    for (int js = 0; js < 4; ++js) { const bf16x8 ra = *(const LAS bf16x8*)(Rt + (32 * k + r32) * HP + 16 * js + 8 * hi), pb = *(const LAS bf16x8*)(Pt + (32 * ib + r32) * HP + 16 * js + 8 * hi);
                        a = MFMA32(ra, pb, a); }
                    if (k == ib) {
#pragma unroll
                        for (int r = 0; r < 16; ++r) if (crow(r, hi) > r32) a[r] = 0.f;
                    }
                }
#pragma unroll
                for (int i = 0; i < 4; ++i) { pw[k][0][i] = cvtpk(a[2 * i], a[2 * i + 1]); pw[k][1][i] = cvtpk(a[8 + 2 * i], a[8 + 2 * i + 1]); } }
            f32x16 oacc[2]; float ss = 0.f;
#pragma unroll
            for (int j = 0; j < 2; ++j) { f32x16 oa = {};
#pragma unroll
                for (int k = 0; k < 2; ++k) { if (k <= ib) {
#pragma unroll
                    for (int st = 0; st < 2; ++st) { const LAS bf16* vp = VT + (32 * j + r32) * HP + 32 * k + 16 * st + 4 * hi;
                        const s16x4 v0 = *(const LAS s16x4*)vp, v1 = *(const LAS s16x4*)(vp + 8);
                        const bf16x8 vf = {v0[0], v0[1], v0[2], v0[3], v1[0], v1[1], v1[2], v1[3]};
                        oa = MFMA32(vf, __builtin_bit_cast(bf16x8, pw[k][st]), oa); } } }
#pragma unroll
                for (int js = 0; js < 4; ++js) { const bf16x8 sa = *(const LAS bf16x8*)(ST + (32 * j + r32) * HP + 16 * js + 8 * hi), pb = *(const LAS bf16x8*)(Pt + (32 * ib + r32) * HP + 16 * js + 8 * hi);
                    oa = MFMA32(sa, pb, oa); }
#pragma unroll
                for (int r = 0; r < 16; ++r) ss += oa[r] * oa[r];
                oacc[j] = oa; }
            ss = swapsum(ss);
            const float rstd = 1.0f / sqrtf(ss * (1.0f / 64.0f) + RMS_EPS);
            bf16* orow = Ob + (size_t)(t0 + 32 * ib + r32) * OP + 1024 + h * 64;
#pragma unroll
            for (int j = 0; j < 2; ++j)
#pragma unroll
                for (int rr = 0; rr < 4; ++rr) { const int e0 = 32 * j + 8 * rr + 4 * hi; const f32x4 g4 = *(const f32x4*)(gn + h * 64 + e0);
                    const u32x2 cw = *(const LAS u32x2*)(CG + (32 * ib + r32) * HP + e0);
                    const float o0 = oacc[j][4 * rr] * rstd * g4[0] * sigmoidf_(bflo(cw.x)), o1 = oacc[j][4 * rr + 1] * rstd * g4[1] * sigmoidf_(bfhi(cw.x));
                    const float o2 = oacc[j][4 * rr + 2] * rstd * g4[2] * sigmoidf_(bflo(cw.y)), o3 = oacc[j][4 * rr + 3] * rstd * g4[3] * sigmoidf_(bfhi(cw.y));
                    *(u32x2*)(orow + e0) = (u32x2){cvtpk(o0, o1), cvtpk(o2, o3)}; }
        }
        WG_BAR();
    }
}

constexpr int RT_LG = 0, RT_HIST = 8 * 2048, RT_END = RT_HIST + 1024;
static_assert(RT_END <= SCR_BYTES, "router LDS");
typedef short bf16x8_t __attribute__((ext_vector_type(8)));
__device__ __forceinline__ void split_hi_lo(const f32x4 a, const f32x4 b, bf16x8_t& hi, bf16x8_t& lo) {
    const float v[8] = {a.x, a.y, a.z, a.w, b.x, b.y, b.z, b.w}; unsigned h[8], l[8];
#pragma unroll
    for (int i = 0; i < 8; ++i) { h[i] = f2bf(v[i]); l[i] = f2bf(v[i] - bf2f(h[i])); }
    const u32x4 hw = {h[0] | (h[1] << 16), h[2] | (h[3] << 16), h[4] | (h[5] << 16), h[6] | (h[7] << 16)}, lw = {l[0] | (l[1] << 16), l[2] | (l[3] << 16), l[4] | (l[5] << 16), l[6] | (l[7] << 16)};
    hi = __builtin_bit_cast(bf16x8_t, hw); lo = __builtin_bit_cast(bf16x8_t, lw);
}
__device__ __forceinline__ void ln1_phase(KP p, int l, const float* xin, LAS unsigned char* lds, int G, int tid, int wave, int lane) {
    unsigned char* ws = p->ws; const float* mix = (const float*)(ws + WS_MIX); float* x1 = (float*)(ws + WS_X1); bf16* x1b = (bf16*)(ws + WS_X1B);
    int* tke = (int*)(ws + WS_TKE); float* tkg = (float*)(ws + WS_TKG); int* wgcnt = (int*)(ws + WS_WGCNT);
    LAS float* LG = (LAS float*)(lds + RT_LG) + wave * 512; LAS unsigned* hist = (LAS unsigned*)(lds + RT_HIST);
    if (tid < 32) hist[tid] = 0u;
    WG_BAR();
    const float* lg = p->ln1_g + l * 1024; const float* lb = p->ln1_b + l * 1024;
    f32x4 gv[4], bv[4];
#pragma unroll
    for (int j = 0; j < 4; ++j) { gv[j] = *(const f32x4*)(lg + 4 * lane + 256 * j); bv[j] = *(const f32x4*)(lb + 4 * lane + 256 * j); }
    const int m0 = blockIdx.x * NWAVES + wave, mstride = G * NWAVES;
    for (int mb = m0; mb < NTOK; mb += 16 * mstride) {
        f32x4 xa[4], xm[4];
        { const f32x4* xr = (const f32x4*)(xin + (size_t)mb * DM) + lane; const f32x4* mr = (const f32x4*)(mix + (size_t)mb * DM) + lane;
#pragma unroll
          for (int j = 0; j < 4; ++j) { xa[j] = xr[64 * j]; xm[j] = mr[64 * j]; } }
#pragma unroll 1
        for (int i = 0; i < 16; ++i) { const int m = mb + i * mstride; if (m >= NTOK) break;
            f32x4 v[4]; float s = 0.f;
#pragma unroll
            for (int j = 0; j < 4; ++j) { v[j] = xa[j] * ALPHA + xm[j]; s += (v[j].x + v[j].y) + (v[j].z + v[j].w); }
            { const int mn = (m + mstride < NTOK) ? m + mstride : m;
              const f32x4* xr = (const f32x4*)(xin + (size_t)mn * DM) + lane; const f32x4* mr = (const f32x4*)(mix + (size_t)mn * DM) + lane;
#pragma unroll
              for (int j = 0; j < 4; ++j) { xa[j] = xr[64 * j]; xm[j] = mr[64 * j]; } }
            const float mean = wave_sum(s) * (1.f / DM); float s2 = 0.f;
#pragma unroll
            for (int j = 0; j < 4; ++j) { v[j] = v[j] - mean; s2 += (v[j].x * v[j].x + v[j].y * v[j].y) + (v[j].z * v[j].z + v[j].w * v[j].w); }
            const float rstd = 1.f / sqrtf(wave_sum(s2) * (1.f / DM) + LN_EPS);
            f32x4* o4 = (f32x4*)(x1 + (size_t)m * DM) + lane; unsigned* o1 = (unsigned*)((unsigned char*)x1b + (size_t)m * DM) + lane;
#pragma unroll
            for (int j = 0; j < 4; ++j) { v[j] = v[j] * rstd * gv[j] + bv[j]; o4[64 * j] = v[j]; int w8 = __builtin_amdgcn_cvt_pk_fp8_f32(v[j].x, v[j].y, 0, false); w8 = __builtin_amdgcn_cvt_pk_fp8_f32(v[j].z, v[j].w, w8, true); o1[64 * j] = (unsigned)w8; } }
        asm volatile("s_waitcnt vmcnt(0)" ::: "memory"); __builtin_amdgcn_fence(__ATOMIC_ACQUIRE, "agent"); asm volatile("s_waitcnt vmcnt(0)" ::: "memory");
        { const int ti = lane & 15, kg = lane >> 4; int mt = mb + ti * mstride; if (mt >= NTOK) mt = mb;
          const float* xr = x1 + (size_t)mt * DM + 8 * kg; const bf16* wf = (const bf16*)(ws + WS_WRF) + (size_t)l * 32 * 2 * 2 * 512 + lane * 8;
          f32x4 acc0 = {0.f, 0.f, 0.f, 0.f}, acc1 = {0.f, 0.f, 0.f, 0.f};
#pragma unroll 4
          for (int s = 0; s < 32; ++s) { const f32x4 a0 = *(const f32x4*)(xr + 32 * s), a1 = *(const f32x4*)(xr + 32 * s + 4); bf16x8_t ah, al; split_hi_lo(a0, a1, ah, al);
              const bf16x8_t w0h = *(const bf16x8_t*)(wf + (size_t)(s * 4 + 0) * 512), w0l = *(const bf16x8_t*)(wf + (size_t)(s * 4 + 1) * 512), w1h = *(const bf16x8_t*)(wf + (size_t)(s * 4 + 2) * 512), w1l = *(const bf16x8_t*)(wf + (size_t)(s * 4 + 3) * 512);
              acc0 = __builtin_amdgcn_mfma_f32_16x16x32_bf16(ah, w0h, acc0, 0, 0, 0); acc0 = __builtin_amdgcn_mfma_f32_16x16x32_bf16(al, w0h, acc0, 0, 0, 0); acc0 = __builtin_amdgcn_mfma_f32_16x16x32_bf16(ah, w0l, acc0, 0, 0, 0);
              acc1 = __builtin_amdgcn_mfma_f32_16x16x32_bf16(ah, w1h, acc1, 0, 0, 0); acc1 = __builtin_amdgcn_mfma_f32_16x16x32_bf16(al, w1h, acc1, 0, 0, 0); acc1 = __builtin_amdgcn_mfma_f32_16x16x32_bf16(ah, w1l, acc1, 0, 0, 0); }
#pragma unroll
          for (int r = 0; r < 4; ++r) { LG[(4 * kg + r) * 32 + ti] = acc0[r]; LG[(4 * kg + r) * 32 + 16 + ti] = acc1[r]; } }
        LDS_WAIT();
        if (lane < 16) { const int m = mb + lane * mstride;
            if (m < NTOK) { float tv0 = -3e38f, tv1 = -3e38f, tv2 = -3e38f, tv3 = -3e38f; int ti0 = 0, ti1 = 0, ti2 = 0, ti3 = 0;
#pragma unroll
                for (int e4 = 0; e4 < 8; ++e4) { const f32x4 lv = *(const LAS f32x4*)(LG + lane * 32 + 4 * e4); const f32x4 bb = *(const f32x4*)(p->b_router + l * 32 + 4 * e4);
#pragma unroll
                    for (int i = 0; i < 4; ++i) { const float g = lv[i] + bb[i]; const int e = 4 * e4 + i;
                        if (g > tv0) { tv3 = tv2; ti3 = ti2; tv2 = tv1; ti2 = ti1; tv1 = tv0; ti1 = ti0; tv0 = g; ti0 = e; }
                        else if (g > tv1) { tv3 = tv2; ti3 = ti2; tv2 = tv1; ti2 = ti1; tv1 = g; ti1 = e; }
                        else if (g > tv2) { tv3 = tv2; ti3 = ti2; tv2 = g; ti2 = e; }
                        else if (g > tv3) { tv3 = g; ti3 = e; } } }
                const float e1 = __expf(tv1 - tv0), e2 = __expf(tv2 - tv0), e3 = __expf(tv3 - tv0); const float inv = 1.f / (1.f + e1 + e2 + e3);
                *(int4*)(tke + m * 4) = make_int4(ti0, ti1, ti2, ti3); *(f32x4*)(tkg + m * 4) = (f32x4){inv, e1 * inv, e2 * inv, e3 * inv};
                __hip_atomic_fetch_add(hist + ti0, 1u, __ATOMIC_RELAXED, __HIP_MEMORY_SCOPE_WORKGROUP); __hip_atomic_fetch_add(hist + ti1, 1u, __ATOMIC_RELAXED, __HIP_MEMORY_SCOPE_WORKGROUP);
                __hip_atomic_fetch_add(hist + ti2, 1u, __ATOMIC_RELAXED, __HIP_MEMORY_SCOPE_WORKGROUP); __hip_atomic_fetch_add(hist + ti3, 1u, __ATOMIC_RELAXED, __HIP_MEMORY_SCOPE_WORKGROUP); } }
        LDS_WAIT();
    }
    WG_BAR();
    if (tid < 32) wgcnt[blockIdx.x * 32 + tid] = (int)hist[tid];
}

__device__ __forceinline__ void slot_phase(KP p, LAS unsigned char* lds, int G, int tid, int wave, int lane) {
    unsigned char* ws = p->ws; const int* wgcnt = (const int*)(ws + WS_WGCNT); int* blk = (int*)(ws + WS_BLK);
    const int* tke = (const int*)(ws + WS_TKE); const float* tkg = (const float*)(ws + WS_TKG); int* tokslot = (int*)(ws + WS_TOKSLOT); float* gslot = (float*)(ws + WS_GSLOT);
    LAS unsigned* tot = (LAS unsigned*)lds; LAS unsigned* mine = tot + 32; LAS unsigned* cur = tot + 64;
    if (tid < 96) tot[tid] = 0u;
    WG_BAR();
    { const int e = tid & 31, part = tid >> 5; unsigned sa = 0u, sb = 0u;
      for (int w = part; w < G; w += 16) { const unsigned c = (unsigned)wgcnt[w * 32 + e]; sa += c; if (w < (int)blockIdx.x) sb += c; }
      __hip_atomic_fetch_add(tot + e, sa, __ATOMIC_RELAXED, __HIP_MEMORY_SCOPE_WORKGROUP); __hip_atomic_fetch_add(mine + e, sb, __ATOMIC_RELAXED, __HIP_MEMORY_SCOPE_WORKGROUP); }
    WG_BAR();
    if (tid == 0) { unsigned off = 0u;
#pragma unroll 1
        for (int e = 0; e < 32; ++e) { const unsigned padded = (tot[e] + 255u) & ~255u; cur[e] = off + mine[e];
            if (blockIdx.x == 0) { blk[BST_OFF + e] = (int)(off >> 8);
#pragma unroll 1
                for (unsigned bb = off >> 8; bb < ((off + padded) >> 8); ++bb) blk[16 + bb] = e; }
            off += padded; }
        if (blockIdx.x == 0) { blk[0] = (int)(off >> 8); blk[BST_OFF + 32] = (int)(off >> 8); } }
    WG_BAR();
    int* slottok = (int*)(ws + WS_SLOTTOK);
    if (blockIdx.x == 0 && tid < 32) { const unsigned ps = cur[tid], n = tot[tid];
        int zero_ = 0; asm volatile("" : "+v"(zero_));
#pragma unroll 1
        for (unsigned s = ps + n; s < ps + ((n + 255u) & ~255u); ++s) slottok[s] = zero_; }
    WG_BAR();
    for (int m = blockIdx.x * NWAVES + wave; m < NTOK; m += G * NWAVES) {
        if (lane < 4) { const int e = tke[m * 4 + lane]; const int slot = (int)__hip_atomic_fetch_add(cur + e, 1u, __ATOMIC_RELAXED, __HIP_MEMORY_SCOPE_WORKGROUP); tokslot[m * 4 + lane] = slot; gslot[slot] = tkg[m * 4 + lane]; slottok[slot] = m; }
    }
}

__device__ __forceinline__ void comb_phase(KP p, int l, float* xout, int G, int wave, int lane) {
    unsigned char* ws = p->ws; const float* x1 = (const float*)(ws + WS_X1); const bf16* y = (const bf16*)(ws + WS_Y); const int* tokslot = (const int*)(ws + WS_TOKSLOT); bf16* xb = (bf16*)(ws + WS_XB);
    const float* lg = p->ln2_g + l * 1024; const float* lb = p->ln2_b + l * 1024;
    f32x4 gv[4], bv[4];
#pragma unroll
    for (int j = 0; j < 4; ++j) { gv[j] = *(const f32x4*)(lg + 4 * lane + 256 * j); bv[j] = *(const f32x4*)(lb + 4 * lane + 256 * j); }
    for (int m = blockIdx.x * NWAVES + wave; m < NTOK; m += G * NWAVES) {
        const f32x4* xr = (const f32x4*)(x1 + (size_t)m * DM) + lane;
        f32x4 v[4];
#pragma unroll
        for (int j = 0; j < 4; ++j) v[j] = xr[64 * j] * ALPHA;
#pragma unroll
        for (int k = 0; k < 4; ++k) { const int sk = __builtin_amdgcn_readfirstlane(tokslot[m * 4 + k]); const u32x2* yr = (const u32x2*)(y + (size_t)sk * DM) + lane;
#pragma unroll
            for (int j = 0; j < 4; ++j) { const u32x2 w = yr[64 * j]; v[j].x += bflo(w.x); v[j].y += bfhi(w.x); v[j].z += bflo(w.y); v[j].w += bfhi(w.y); } }
        float s = 0.f;
#pragma unroll
        for (int j = 0; j < 4; ++j) s += (v[j].x + v[j].y) + (v[j].z + v[j].w);
        const float mean = wave_sum(s) * (1.f / DM); float s2 = 0.f;
#pragma unroll
        for (int j = 0; j < 4; ++j) { v[j] = v[j] - mean; s2 += (v[j].x * v[j].x + v[j].y * v[j].y) + (v[j].z * v[j].z + v[j].w * v[j].w); }
        const float rstd = 1.f / sqrtf(wave_sum(s2) * (1.f / DM) + LN_EPS);
        f32x4* o4 = (f32x4*)(xout + (size_t)m * DM) + lane; u32x2* o2 = (u32x2*)(xb + (size_t)m * DM) + lane;
#pragma unroll
        for (int j = 0; j < 4; ++j) { v[j] = v[j] * rstd * gv[j] + bv[j]; o4[64 * j] = v[j]; o2[64 * j] = (u32x2){pk2(v[j].x, v[j].y), pk2(v[j].z, v[j].w)}; }
    }
}

#ifndef ONE_LAUNCH
#define ONE_LAUNCH 1
#endif
__global__ void __launch_bounds__(NTHR, 2) fwd(Params p) {
    extern __shared__ __attribute__((aligned(16))) unsigned char lds_raw[];
    LAS unsigned char* lds = (LAS unsigned char*)lds_raw;
    volatile LAS unsigned* MISC = (volatile LAS unsigned*)(lds + MISC_OFF);
    const int tid = threadIdx.x, lane = tid & 63, wave = __builtin_amdgcn_readfirstlane(tid >> 6); const int wave0 = wave;
    const int G = gridDim.x; const int bx = blockIdx.x; const int vcu = (G % 8 == 0) ? (bx % 8) * (G / 8) + bx / 8 : bx;
    if (tid < 64) MISC[tid] = 0u;
    __syncthreads();
    if (p.use_bar) (void)xcd_barrier_post((unsigned*)(p.ws + WS_CTL) + CW_BAR, MISC + 8);
    const int lo = p.ph_lo, hi = p.ph_hi;
#ifndef PHSEL
#define PHSEL(k) true
#endif
#define IN(k) (PHSEL(k) && lo <= (k) && (k) < hi)
#define SEAM(k) do { if (lo <= (k) && (k) + 1 < hi) { KP qb_ = load_params(); XcdBarrier b_; b_.bar = (unsigned*)(qb_->ws + WS_CTL) + CW_BAR; b_.x = xb_xcc_id(); b_.st = MISC + 8; xcd_barrier(b_); } } while (0)
    const int gw0 = vcu * NWAVES + wave, NGW = G * NWAVES;
#define PH_IDS const int lane = lane_id(), wave = wave0, tid = wave0 * 64 + lane, gw = vcu * NWAVES + wave; (void)lane; (void)gw; (void)gw0;

    if (IN(0)) { PH_IDS KP q = load_params(); p0_prologue(q, lds, gw, NGW, wave, lane); SEAM(0); }

    for (int l = 0; l < DEPTH; ++l) {
        const int pb = 1 + l * NPH_LAYER;

        if (IN(pb + PH_INPROJ)) {
            KP q = load_params(); unsigned char* w = q->ws;
            pg8::Gemm g{(const bf16*)(w + WS_XB), (const bf16*)(w + WS_WIN) + (size_t)l * ZP * 1024, NTOK, ZP, 1024}; pg8::StaticOrder S; S.init(NTOK, ZP, G, bx);
            pg8::EpiZ E{(bf16*)(w + WS_Z), ZP, (const float*)(w + WS_TRIG)};
            pg8::gemm_phase<pg8::EpiZ, pg8::StaticOrder, true, true>(lds, g, S, E, wave0);
            SEAM(pb + PH_INPROJ);
        }
        if (IN(pb + PH_IDX)) { PH_IDS KP q = load_params(); idx_phase(q, l, lds, vcu, G, tid, wave, lane); SEAM(pb + PH_IDX); }
        if (IN(pb + PH_ATTN)) { PH_IDS KP q = load_params(); attn_phase(q, lds, vcu, G, wave0); SEAM(pb + PH_ATTN); }
        if (IN(pb + PH_H1)) { PH_IDS KP q = load_params(); h1_phase(q, l, lds, vcu, G, tid, wave, lane); SEAM(pb + PH_H1); }
        if (IN(pb + PH_H2)) { PH_IDS KP q = load_params(); h2_phase(q, G, tid); SEAM(pb + PH_H2); }
        if (IN(pb + PH_H3)) { PH_IDS KP q = load_params(); h3_phase(q, l, lds, vcu, G, tid, wave, lane); SEAM(pb + PH_H3); }
        if (IN(pb + PH_MERGE)) {
            KP q = load_params(); unsigned char* w = q->ws;
            pg8::Gemm g{(const bf16*)(w + WS_OBUF), (const bf16*)(w + WS_WP) + (size_t)l * 1024 * 1536, NTOK, 1024, 1536}; pg8::StaticOrder S; S.init(NTOK, 1024, G, bx);
            pg8::EpiMerge E{(const bf16*)(w + WS_Z) + Z_GT, ZP, (bf16*)(w + WS_MERGED), 1024};
            pg8::gemm_phase<pg8::EpiMerge, pg8::StaticOrder, true, true>(lds, g, S, E, wave0);
            SEAM(pb + PH_MERGE);
        }
        if (IN(pb + PH_WOUT)) {
            KP q = load_params(); unsigned char* w = q->ws;
            pg8::Gemm g{(const bf16*)(w + WS_MERGED), (const bf16*)(w + WS_WOUT) + (size_t)l * 1024 * 1024, NTOK, 1024, 1024}; pg8::StaticOrder S; S.init(NTOK, 1024, G, bx);
            pg8::EpiF32 E{(float*)(w + WS_MIX), 1024};
            pg8::gemm_phase<pg8::EpiF32, pg8::StaticOrder, true, true>(lds, g, S, E, wave0);
            SEAM(pb + PH_WOUT);
        }
        if (IN(pb + PH_LN1)) { PH_IDS KP q = load_params(); const float* xin = (l == 0) ? q->x : (const float*)(q->ws + WS_XCUR); ln1_phase(q, l, xin, lds, G, tid, wave, lane); SEAM(pb + PH_LN1); }
        if (IN(pb + PH_SLOT)) { PH_IDS KP q = load_params(); slot_phase(q, lds, G, tid, wave, lane); SEAM(pb + PH_SLOT); }
        if (IN(pb + PH_GU)) {
            KP q = load_params(); unsigned char* w = q->ws;
            pg8::Gemm g{(const bf16*)(w + WS_X1B), (const bf16*)(w + WS_WGU + (size_t)l * 32 * 2048 * 1024), MAXSLOT, 32 * 2048, 1024};
            pg8::moe_build_list((LAS int*)(lds + pg8::STAGE_BYTES), (const int*)(w + WS_BLK), 8, G, bx, wave0 * 64 + lane_id()); pg8::MoeOrderG S{(const LAS int*)(lds + pg8::STAGE_BYTES), (const int*)(w + WS_SLOTTOK)};
            pg8::EpiSwiGLU E{(bf16*)(w + WS_ACT), (const float*)(w + WS_BGU) + (size_t)l * 32 * 2048, 8};
            pg8::gemm_phase<pg8::EpiSwiGLU, pg8::MoeOrderG, true, true, true, W8_E8M0>(lds, g, S, E, wave0);
            SEAM(pb + PH_GU);
        }
        if (IN(pb + PH_DOWN)) {
            KP q = load_params(); unsigned char* w = q->ws;
            pg8::Gemm g{(const bf16*)(w + WS_ACT), (const bf16*)(w + WS_WDN + (size_t)l * 32 * 1024 * 1024), MAXSLOT, 32 * 1024, 1024};
            pg8::moe_build_list((LAS int*)(lds + pg8::STAGE_BYTES), (const int*)(w + WS_BLK), 4, G, bx, wave0 * 64 + lane_id()); pg8::MoeOrder S{(const LAS int*)(lds + pg8::STAGE_BYTES), nullptr};
            pg8::EpiDown E{(bf16*)(w + WS_Y), q->b_down + (size_t)l * 32 * 1024, (const float*)(w + WS_GSLOT), 4};
            pg8::gemm_phase<pg8::EpiDown, pg8::MoeOrder, true, true, true, W8_E8M0>(lds, g, S, E, wave0);
            SEAM(pb + PH_DOWN);
        }
        if (IN(pb + PH_COMB)) { PH_IDS KP q = load_params(); float* xout = (l == DEPTH - 1) ? q->out : (float*)(q->ws + WS_XCUR); comb_phase(q, l, xout, G, wave, lane); SEAM(pb + PH_COMB); }
    }
#undef IN
#undef SEAM
}

#ifndef DBG
#define DBG 0
#endif
#if DBG
constexpr int CW_DBG = 64;
__device__ __forceinline__ unsigned hsh(unsigned a) { a ^= a >> 16; a *= 0x7feb352du; a ^= a >> 15; a *= 0x846ca68bu; a ^= a >> 16; return a; }
__device__ __forceinline__ void dbg_fail(Params& p, int id) { atomicMin((int*)(p.ws + WS_CTL) + CW_DBG, id); }
__device__ __forceinline__ bool bad(float a, float ref, float rel, float abs_) { return !(fabsf(a - ref) <= rel * fabsf(ref) + abs_); }
__device__ __forceinline__ float dotx(const float* xr, const float* W, int ld, int col, int K) { float s = 0.f; for (int k = 0; k < K; ++k) s += xr[k] * W[(size_t)k * ld + col]; return s; }

__global__ void __launch_bounds__(64) chk(Params p, int l, int which) {
    __shared__ float Ssh[64 * 65];
    unsigned char* ws = p.ws; const int gt_ = blockIdx.x * 64 + threadIdx.x; const unsigned h0 = hsh(gt_ * 2654435761u + which * 97u + 12345u), h1 = hsh(h0 + 0x9e3779b9u), h2 = hsh(h1 + 77u);
    const float* xin = (l == 0) ? p.x : (const float*)(ws + WS_XCUR);
    const bf16* Z = (const bf16*)(ws + WS_Z);
    const int id = (l * 20 + which) * 4;
    const float* win = p.w_in + (size_t)l * 1024 * D_IN;
    if (which == 1) {
        const int t = h0 % NTOK, n = h1 % D_IN; const int sc = zcol_src(n); const float scale = (n < 512 || (n >= Z_FQ && n < Z_FK)) ? QSCALE : 1.f;
        const float ref = dotx(xin + (size_t)t * DM, win, D_IN, sc, 1024) * scale;
        if (bad(bf2f(Z[(size_t)t * ZP + n]), ref, 0.03f, 0.03f)) dbg_fail(p, id);
    } else if (which == 2) {
        const int t = h0 % NTOK, pos = t & (SEQ - 1), b = t >> 13; const float* xr = xin + (size_t)t * DM;
        { const int hh = h1 % 21, i = h2 & 31; const int col = hh < 8 ? Z_AQ + hh * 64 : hh < 16 ? Z_AK + (hh - 8) * 64 : hh < 20 ? Z_IQ + (hh - 16) * 64 : Z_IK;
          const float sc = hh < 8 ? QSCALE : 1.f; const float t1 = dotx(xr, win, D_IN, zcol_src(col + i), 1024) * sc, t2 = dotx(xr, win, D_IN, zcol_src(col + i + 32), 1024) * sc;
          const float inv = powf(10000.f, -(float)i / 32.f); const float ang = (float)pos * inv; const double rev = (double)ang * 0.15915494309189535; const float fr = (float)(rev - __builtin_rint(rev));
          const float c = __builtin_amdgcn_cosf(fr), s = __builtin_amdgcn_sinf(fr);
          if (bad(bf2f(Z[(size_t)t * ZP + col + i]), t1 * c - t2 * s, 0.03f, 0.03f) || bad(bf2f(Z[(size_t)t * ZP + col + i + 32]), t2 * c + t1 * s, 0.03f, 0.03f)) dbg_fail(p, id); }
        { const int c = h2 % 1024; const float a0 = dotx(xr, win, D_IN, 5452 + c, 1024), a1 = dotx(xr, win, D_IN, 5452 + 1024 + c, 1024), a2 = dotx(xr, win, D_IN, 5452 + 2048 + c, 1024);
          const float g0 = sigmoidf_(a0), g1 = sigmoidf_(a1), g2 = sigmoidf_(a2);
          if (bad(bf2f(Z[(size_t)t * ZP + Z_GT + c]), g0 / g1, 0.05f, 0.01f) || bad(bf2f(Z[(size_t)t * ZP + Z_GT + 1024 + c]), g1 / g2, 0.05f, 0.01f) || bad(bf2f(Z[(size_t)t * ZP + Z_GT + 2048 + c]), g2, 0.05f, 0.01f)) dbg_fail(p, id + 1); }
        { const int hh = h1 & 7; const float v = dotx(xr, win, D_IN, 3396 + hh, 1024) + p.b_fox[l * 8 + hh]; const float ls = -log1pf(expf(-v)) * LOG2E;
          if (bad(((const float*)(ws + WS_LFT))[(size_t)(b * 8 + hh) * SEQ + pos], ls, 0.05f, 0.003f)) dbg_fail(p, id + 2); }
    } else if (which == 3) {
        { const int bh = h0 & 31, t = h1 % SEQ; const float* lf = (const float*)(ws + WS_LFT) + (size_t)bh * SEQ; float s = 0.f; for (int i = 0; i <= t; ++i) s += lf[i];
          if (bad(((const float*)(ws + WS_CT))[(size_t)bh * SEQ + t], s, 1e-3f, 1e-2f)) dbg_fail(p, id); }
        if (gt_ < 192) { const int b = h1 & 3, q = (gt_ < 32) ? (int)(h2 % 512) : (int)(h2 % SEQ); const int nadm = ((q >> 6) + 1) * 64; const u64* mw = (const u64*)(ws + WS_MASKW) + (size_t)(b * SEQ + q) * 128;
          int pc = 0; bool oob = false; for (int w = 0; w < 128; ++w) { const u64 m = mw[w]; pc += __popcll(m); if (w * 64 >= nadm && m) oob = true; }
          if (pc != (nadm < 256 ? nadm : 256) || oob) dbg_fail(p, id + 1);
          const bf16* qr = Z + (size_t)(b * SEQ + q) * ZP; float minsel = 3e38f, maxun = -3e38f;
          for (int s = 0; s < nadm; ++s) { const bf16* kr = Z + (size_t)(b * SEQ + s) * ZP + Z_IK; float sc = 0.f;
              for (int hd = 0; hd < 4; ++hd) { float d = 0.f; for (int k = 0; k < 64; ++k) d += bf2f(qr[Z_IQ + hd * 64 + k]) * bf2f(kr[k]); sc += bf2f(qr[Z_IW + hd]) * 0.0625f * fmaxf(d, 0.f); }
              if ((mw[s >> 6] >> (s & 63)) & 1ull) minsel = fminf(minsel, sc); else maxun = fmaxf(maxun, sc); }
          if (nadm > 256 && !(maxun <= minsel + 0.02f * fabsf(minsel) + 2e-3f)) dbg_fail(p, id + 2); }
    } else if (which == 4) {
        if (gt_ == 0 && l == 0) { const bf16* ob = (const bf16*)(ws + WS_OBUF) + 512;
            const float a0 = bf2f(ob[0]), a1 = bf2f(ob[1]), a3 = bf2f(ob[3]), b0 = bf2f(ob[8]), b1 = bf2f(ob[9]), b3 = bf2f(ob[11]), m0 = bf2f(ob[4]), m1 = bf2f(ob[12]);
            auto tr = [](float v) { return v == 0.f ? 0.f : v == 1.f ? 1.f : 2.f; };
            ((float*)(ws + WS_CTL))[CW_DBG + 2] = 10.f * (tr(a0) + 3.f * tr(b0) + 9.f * tr(a1) + 27.f * tr(b1));
            ((float*)(ws + WS_CTL))[CW_DBG + 3] = sqrtf(10.f * (tr(a3) + 3.f * tr(b3) + 9.f * (m0 == m1 ? 1.f : 0.f) + 27.f * (m0 > -1e20f ? 1.f : 0.f))); }
        const int mode = gt_ & 1, b = h0 & 3, h = (h0 >> 2) & 7, q = (gt_ < 64) ? (int)(h1 % 300) : (int)(h1 % SEQ), d = h2 & 63;
        const int QC = mode == 0 ? Z_FQ : Z_AQ, KC = mode == 0 ? Z_FK : Z_AK, VC = mode == 0 ? Z_FV : Z_AV, OC = mode == 0 ? 512 : 0;
        const bf16* qr = Z + (size_t)(b * SEQ + q) * ZP + QC + h * 64; const float* c = (const float*)(ws + WS_CT) + (size_t)(b * 8 + h) * SEQ; const u64* mw = (const u64*)(ws + WS_MASKW) + (size_t)(b * SEQ + q) * 128;
        const int ns = mode == 0 ? q + 1 : ((q >> 6) + 1) * 64; float mx = -3e38f, mx2 = -3e38f; float ref = 0.f, ref2 = 0.f;
        for (int pass = 0; pass < 2; ++pass) { float den = 0.f, num = 0.f, den2 = 0.f, num2 = 0.f;
            for (int s = 0; s < ns; ++s) { if (mode == 1 && !((mw[s >> 6] >> (s & 63)) & 1ull)) continue;
                const bf16* kr = Z + (size_t)(b * SEQ + s) * ZP + KC + h * 64; float lg = 0.f; for (int k = 0; k < 64; ++k) lg += bf2f(qr[k]) * bf2f(kr[k]);
                const float lg2 = lg; if (mode == 0) lg += c[q] - c[s];
                if (pass == 0) { mx = fmaxf(mx, lg); mx2 = fmaxf(mx2, lg2); } else { const float vv = bf2f(Z[(size_t)(b * SEQ + s) * ZP + VC + h * 64 + d]); const float pp = exp2f(lg - mx), pq = exp2f(lg2 - mx2); den += pp; num += pp * vv; den2 += pq; num2 += pq * vv; } }
            if (pass == 1) { ref = num / den; ref2 = num2 / den2; } }
        const float got = bf2f(((const bf16*)(ws + WS_OBUF))[(size_t)(b * SEQ + q) * OP + OC + h * 64 + d]);
        if (bad(got, ref, 0.04f, 0.03f)) { dbg_fail(p, id + mode);
            int m = 0; if (mode == 0 && q == 0) m |= 1; if (mode == 0 && q < 32) m |= 2; if (mode == 1 && q < 64) m |= 4; if (mode == 1 && q >= 64) m |= 8; atomicOr((int*)(p.ws + WS_CTL) + CW_DBG + 1, m); }
    } else if (which == 7) {
        const int b = blockIdx.x & 3, h = (blockIdx.x >> 2) & 7, e = threadIdx.x;
        for (int d = 0; d < 64; ++d) Ssh[d * 65 + e] = 0.f;
        const float lbv_e = 0.f; (void)lbv_e;
        for (int t = 0; t < 200; ++t) { const bf16* zr = Z + (size_t)(b * SEQ + t) * ZP + h * 64; float o = 0.f; const float ve = bf2f(zr[Z_CI + e]);
            for (int d = 0; d < 64; ++d) { const int dd = h * 64 + d; const float lb = (l == 0) ? 0.f : sigmoidf_(p.lb_logits[512 + dd] - p.lb_logits[dd]);
                const float sg = sigmoidf_(bf2f(zr[Z_CF + d])); const float f = lb + (1.f - lb) * sg, kk = (1.f - lb) * (1.f - sg);
                const float S = f * Ssh[d * 65 + e] + kk * ve; Ssh[d * 65 + e] = S; o += bf2f(zr[Z_CQ + d]) * S; }
            const float ss = wave_sum(o * o); const float ref = o * (1.f / sqrtf(ss * (1.f / 64.f) + RMS_EPS)) * p.norm_g[l * 512 + h * 64 + e] * sigmoidf_(bf2f(zr[Z_CG + e]));
            if (bad(bf2f(((const bf16*)(ws + WS_OBUF))[(size_t)(b * SEQ + t) * OP + 1024 + h * 64 + e]), ref, 0.06f, 0.05f)) { const int n = atomicAdd((int*)(p.ws + WS_CTL) + CW_DBG + 4 + (t >= 64 ? 1 : 0), 1); if (n >= 40) dbg_fail(p, id + (t >= 64 ? 1 : 0)); } }
    } else if (which == 8) {
        const int t = h0 % NTOK, c = h1 % 1024; const bf16* zr = Z + (size_t)t * ZP + Z_GT; const float g2 = bf2f(zr[2048 + c]), g1 = bf2f(zr[1024 + c]) * g2, g0 = bf2f(zr[c]) * g1;
        const bf16* ob = (const bf16*)(ws + WS_OBUF) + (size_t)t * OP; float sa = 0.f, sb = 0.f, sc = 0.f;
        for (int k = 0; k < 512; ++k) { sa += bf2f(ob[k]) * p.w_pa[((size_t)l * 512 + k) * 1024 + c]; sb += bf2f(ob[512 + k]) * p.w_pb[((size_t)l * 512 + k) * 1024 + c]; sc += bf2f(ob[1024 + k]) * p.w_pc[((size_t)l * 512 + k) * 1024 + c]; }
        if (bad(bf2f(((const bf16*)(ws + WS_MERGED))[(size_t)t * 1024 + c]), g0 * sa + g1 * sb + g2 * sc, 0.04f, 0.01f)) dbg_fail(p, id);
    } else if (which == 9) {
        const int t = h0 % NTOK, c = h1 % 1024; const bf16* mr = (const bf16*)(ws + WS_MERGED) + (size_t)t * 1024; float s = 0.f;
        for (int k = 0; k < 1024; ++k) s += bf2f(mr[k]) * p.w_out[((size_t)l * 1024 + k) * 1024 + c];
        if (bad(((const float*)(ws + WS_MIX))[(size_t)t * 1024 + c], s, 0.03f, 0.005f)) dbg_fail(p, id);
    } else if (which == 10) {
        const int t = h0 % NTOK, c = h1 % 1024; const float* xr = xin + (size_t)t * DM; const float* mr = (const float*)(ws + WS_MIX) + (size_t)t * DM; const float* x1 = (const float*)(ws + WS_X1) + (size_t)t * DM;
        float mean = 0.f; for (int k = 0; k < 1024; ++k) mean += ALPHA * xr[k] + mr[k]; mean *= (1.f / 1024.f);
        float var = 0.f; for (int k = 0; k < 1024; ++k) { const float dlt = ALPHA * xr[k] + mr[k] - mean; var += dlt * dlt; } var *= (1.f / 1024.f);
        const float ref = (ALPHA * xr[c] + mr[c] - mean) / sqrtf(var + LN_EPS) * p.ln1_g[l * 1024 + c] + p.ln1_b[l * 1024 + c];
        if (bad(x1[c], ref, 1e-3f, 1e-3f) || bad(bf2f(((const bf16*)(ws + WS_X1B))[(size_t)t * DM + c]), ref, 0.01f, 0.01f)) dbg_fail(p, id);
        float tv0 = -3e38f, tv1 = -3e38f, tv2 = -3e38f, tv3 = -3e38f; int ti0 = -1, ti1 = -1, ti2 = -1, ti3 = -1;
        for (int e = 0; e < 32; ++e) { float lg = p.b_router[l * 32 + e]; for (int k = 0; k < 1024; ++k) lg += x1[k] * p.w_router[((size_t)l * 1024 + k) * 32 + e];
            if (lg > tv0) { tv3 = tv2; ti3 = ti2; tv2 = tv1; ti2 = ti1; tv1 = tv0; ti1 = ti0; tv0 = lg; ti0 = e; } else if (lg > tv1) { tv3 = tv2; ti3 = ti2; tv2 = tv1; ti2 = ti1; tv1 = lg; ti1 = e; }
            else if (lg > tv2) { tv3 = tv2; ti3 = ti2; tv2 = lg; ti2 = e; } else if (lg > tv3) { tv3 = lg; ti3 = e; } }
        const int* tke = (const int*)(ws + WS_TKE) + t * 4; const float* tkg = (const float*)(ws + WS_TKG) + t * 4;
        const float den = 1.f + expf(tv1 - tv0) + expf(tv2 - tv0) + expf(tv3 - tv0);
        if (tv2 - tv3 > 1e-3f && tv1 - tv2 > 1e-3f && tv0 - tv1 > 1e-3f) { if (tke[0] != ti0 || tke[1] != ti1 || tke[2] != ti2 || tke[3] != ti3) dbg_fail(p, id + 1);
            if (bad(tkg[0], 1.f / den, 1e-2f, 1e-3f) || bad(tkg[3], expf(tv3 - tv0) / den, 1e-2f, 1e-3f)) dbg_fail(p, id + 2); }
    } else if (which == 11) {
        const int t = h0 % NTOK, k = h1 & 3, c = h2 % 1024; const int slot = ((const int*)(ws + WS_TOKSLOT))[t * 4 + k], e = ((const int*)(ws + WS_TKE))[t * 4 + k]; const int* blk = (const int*)(ws + WS_BLK);
        if (slot < 0 || slot >= blk[0] * 256 || blk[0] > MAXBLK) { dbg_fail(p, id); return; }
        if (blk[16 + (slot >> 8)] != e) dbg_fail(p, id + 1);
        if (((const float*)(ws + WS_GSLOT))[slot] != ((const float*)(ws + WS_TKG))[t * 4 + k]) dbg_fail(p, id + 2);
        if (((const bf16*)(ws + WS_XG))[(size_t)slot * DM + c] != ((const bf16*)(ws + WS_X1B))[(size_t)t * DM + c]) dbg_fail(p, id + 3);
    } else if (which == 12) {
        const int t = h0 % NTOK, k = h1 & 3, j = h2 % 1024; const int slot = ((const int*)(ws + WS_TOKSLOT))[t * 4 + k], e = ((const int*)(ws + WS_TKE))[t * 4 + k];
        const bf16* xr = (const bf16*)(ws + WS_XG) + (size_t)slot * DM; const float* W = p.w_gu + (size_t)(l * 32 + e) * 1024 * 2048; float g = p.b_gu[(size_t)(l * 32 + e) * 2048 + j], u = p.b_gu[(size_t)(l * 32 + e) * 2048 + 1024 + j];
        for (int kk = 0; kk < 1024; ++kk) { const float xv = bf2f(xr[kk]); g += xv * W[(size_t)kk * 2048 + j]; u += xv * W[(size_t)kk * 2048 + 1024 + j]; }
        g = fminf(g, 7.f); u = fminf(fmaxf(u, -7.f), 7.f); const float ref = g * sigmoidf_(1.702f * g) * (u + 1.f);
        if (bad(bf2f(((const bf16*)(ws + WS_ACT))[(size_t)slot * 1024 + j]), ref, 0.04f, 0.02f)) dbg_fail(p, id);
    } else if (which == 13) {
        const int t = h0 % NTOK, k = h1 & 3, n = h2 % 1024; const int slot = ((const int*)(ws + WS_TOKSLOT))[t * 4 + k], e = ((const int*)(ws + WS_TKE))[t * 4 + k];
        const bf16* ar = (const bf16*)(ws + WS_ACT) + (size_t)slot * 1024; const float* W = p.w_down + (size_t)(l * 32 + e) * 1024 * 1024; float s = p.b_down[(size_t)(l * 32 + e) * 1024 + n];
        for (int kk = 0; kk < 1024; ++kk) s += bf2f(ar[kk]) * W[(size_t)kk * 1024 + n];
        if (bad(bf2f(((const bf16*)(ws + WS_Y))[(size_t)slot * 1024 + n]), s * ((const float*)(ws + WS_GSLOT))[slot], 0.04f, 0.005f)) dbg_fail(p, id);
    } else if (which == 14) {
        const int t = h0 % NTOK, c = h1 % 1024; const float* x1 = (const float*)(ws + WS_X1) + (size_t)t * DM; const bf16* y = (const bf16*)(ws + WS_Y); const int* ts = (const int*)(ws + WS_TOKSLOT) + t * 4;
        const float* xo = ((l == DEPTH - 1) ? p.out : (float*)(ws + WS_XCUR)) + (size_t)t * DM;
        float mean = 0.f; for (int k = 0; k < 1024; ++k) { float v = ALPHA * x1[k]; for (int j = 0; j < 4; ++j) v += bf2f(y[(size_t)ts[j] * 1024 + k]); mean += v; } mean *= (1.f / 1024.f);
        float var = 0.f, vc = 0.f; for (int k = 0; k < 1024; ++k) { float v = ALPHA * x1[k]; for (int j = 0; j < 4; ++j) v += bf2f(y[(size_t)ts[j] * 1024 + k]); var += (v - mean) * (v - mean); if (k == c) vc = v; } var *= (1.f / 1024.f);
        if (bad(xo[c], (vc - mean) / sqrtf(var + LN_EPS) * p.ln2_g[l * 1024 + c] + p.ln2_b[l * 1024 + c], 2e-3f, 2e-3f)) dbg_fail(p, id);
    }
}
__global__ void dbg_init(Params p) { if (threadIdx.x == 0 && blockIdx.x == 0) { ((int*)(p.ws + WS_CTL))[CW_DBG] = 0x7fffffff; ((int*)(p.ws + WS_CTL))[CW_DBG + 1] = 0; ((int*)(p.ws + WS_CTL))[CW_DBG + 4] = 0; ((int*)(p.ws + WS_CTL))[CW_DBG + 5] = 0; } }
__global__ void dbg_fill(Params p, int n) {
    const int code = ((const int*)(p.ws + WS_CTL))[CW_DBG]; if (code == 0x7fffffff) return;
    const int sub = code & 3, lw = code >> 2, l = lw / 20, which = lw % 20; const int k = l * 16 + which + 32 * sub;
    const float c = sqrtf(exp2f((float)k));
    const int msk = ((const int*)(p.ws + WS_CTL))[CW_DBG + 1];
    for (int i = blockIdx.x * blockDim.x + threadIdx.x; i < n; i += gridDim.x * blockDim.x) p.out[i] = (i == 0) ? 16.f * (float)(1 + msk) : c;
}
#endif

extern "C" void kernel_launch(void* const* d_in, const int* in_sizes, int n_in, void* d_out, int out_size, void* d_ws, size_t ws_size, hipStream_t stream) {
    static int grid = 0;
    if (grid == 0) {
        if (n_in != 19 || ws_size < WS_END) { fprintf(stderr, "kernel_launch: need 19 inputs and >= %zu bytes of workspace; got %d, %zu\n", (size_t)WS_END, n_in, ws_size); grid = -1; return; }
        int dev = 0, cus = 0, per_cu = 0;
        if (hipGetDevice(&dev) != hipSuccess || hipDeviceGetAttribute(&cus, hipDeviceAttributeMultiprocessorCount, dev) != hipSuccess) { grid = -1; return; }
        if (hipFuncSetAttribute((const void*)fwd, hipFuncAttributeMaxDynamicSharedMemorySize, LDS_BYTES) != hipSuccess) { fprintf(stderr, "kernel_launch: hipFuncSetAttribute failed\n"); grid = -1; return; }
        if (hipOccupancyMaxActiveBlocksPerMultiprocessor(&per_cu, (const void*)fwd, NTHR, LDS_BYTES) != hipSuccess || per_cu < 1) fprintf(stderr, "kernel_launch: occupancy query reports %d\n", per_cu);
        (void)hipGetLastError();
        grid = cus;
    }
    if (grid < 0) return;
    (void)hipMemsetAsync((char*)d_ws + WS_CTL, 0, CTL_ZERO_BYTES, stream);
    Params p{};
    const float** f = (const float**)&p;
    for (int i = 0; i < 19; ++i) f[i] = (const float*)d_in[i];
    p.out = (float*)d_out; p.ws = (unsigned char*)d_ws;
#if ONE_LAUNCH
    p.ph_lo = 0; p.ph_hi = NPHASES; p.use_bar = 1; p.pad = 0;
    hipLaunchKernelGGL(fwd, dim3(grid), dim3(NTHR), LDS_BYTES, stream, p);
#else
#if DBG
    hipLaunchKernelGGL(dbg_init, dim3(1), dim3(64), 0, stream, p);
#endif
    for (int ph = 0; ph < NPHASES; ++ph) { p.ph_lo = ph; p.ph_hi = ph + 1; p.use_bar = 0; p.pad = 0;
        hipLaunchKernelGGL(fwd, dim3(grid), dim3(NTHR), LDS_BYTES, stream, p);
#if DBG
        if (ph >= 1) { const int l = (ph - 1) / NPH_LAYER, k = (ph - 1) % NPH_LAYER; static const int wmap[NPH_LAYER] = {1, 2, 3, 4, 0, 0, 7, 8, 9, 10, 11, 12, 13, 14}; const int w = wmap[k];
            if (w) { const int nb = (w == 7) ? 32 : (w == 3) ? 4 : (w == 4) ? 2 : 16; hipLaunchKernelGGL(chk, dim3(nb), dim3(64), 0, stream, p, l, w); } }
#endif
    }
#if DBG
    hipLaunchKernelGGL(dbg_fill, dim3(1024), dim3(256), 0, stream, p, out_size);
#endif
#endif
}
```

```cpp
#include <hip/hip_runtime.h>
#include <cstdio>
#include <cstdint>

#define GAS __attribute__((address_space(1)))
#define LAS __attribute__((address_space(3)))
typedef unsigned short bf16;
typedef short bf16x8 __attribute__((ext_vector_type(8)));
typedef short s16x4 __attribute__((ext_vector_type(4)));
typedef float f32x2 __attribute__((ext_vector_type(2)));
typedef float f32x4 __attribute__((ext_vector_type(4)));
typedef float f32x16 __attribute__((ext_vector_type(16)));
typedef unsigned u32x2 __attribute__((ext_vector_type(2)));
typedef unsigned u32x4 __attribute__((ext_vector_type(4)));
typedef unsigned long long u64;

__device__ __forceinline__ unsigned f2bf(float f) { unsigned u = __builtin_bit_cast(unsigned, f); return (u + 0x7fffu + ((u >> 16) & 1u)) >> 16; }
__device__ __forceinline__ unsigned pk2(float lo, float hi) { return f2bf(lo) | (f2bf(hi) << 16); }
__device__ __forceinline__ float bf2f(unsigned b) { return __builtin_bit_cast(float, b << 16); }
__device__ __forceinline__ float bflo(unsigned w) { return __builtin_bit_cast(float, w << 16); }
__device__ __forceinline__ float bfhi(unsigned w) { return __builtin_bit_cast(float, w & 0xffff0000u); }
__device__ __forceinline__ float sigmoidf_(float x) { return 1.0f / (1.0f + __expf(-x)); }

namespace pg8 {
#define PG8_LAS __attribute__((address_space(3)))
typedef unsigned short bf16_t;
typedef short bf16x8 __attribute__((ext_vector_type(8)));
typedef float f32x4 __attribute__((ext_vector_type(4)));
typedef unsigned u32x4 __attribute__((ext_vector_type(4)));
constexpr int BM = 256, BK = 64, HALF = 128, HTB = HALF * BK * 2  , STAGE_BYTES = 8 * HTB, NXCD = 8, WGM = 8;

__host__ __device__ __forceinline__ int lds_byte(int r, int c) { const int st = (r >> 4) * 2 + (c >> 5), rr = r & 15, cc = c & 31, ob = rr * 64 + cc * 2; return st * 1024 + (ob ^ (((ob >> 9) & 1) << 5)); }
__host__ __device__ __forceinline__ void stage_rc(int b, int& R, int& C) { const int st = b / 1024, sb = b % 1024, swz = sb ^ (((sb >> 9) & 1) << 5); R = (st >> 1) * 16 + swz / 64; C = (st & 1) * 32 + (swz % 64) / 2; }
__host__ __device__ __forceinline__ int perm32(int rho) { const int n = rho >> 4, i = rho & 15; return 8 * (i >> 2) + 4 * n + (i & 3); }

struct Unit { int pm, pn; };
struct Gemm { const bf16_t* A; const bf16_t* Bt; int M, N, K; };

struct StaticOrder {
    static constexpr bool GATHER = false; const int* tok = nullptr;
    int nM, nN, nwg, G, c;
    __host__ __device__ void init(int M, int N, int G_, int c_) { nM = M / BM; nN = N / BM; nwg = nM * nN; G = G_; c = c_; }
    __host__ __device__ bool next(int i, Unit& u) const {
        const long L = (long)i * G + c; if (L >= nwg) return false;
        int wgid = (int)L; { const int q = nwg / NXCD, r = nwg % NXCD, xcd = wgid % NXCD, off = wgid / NXCD; wgid = (xcd < r ? xcd * (q + 1) : r * (q + 1) + (xcd - r) * q) + off; }
        const int nig = WGM * nN, gid = wgid / nig, fm = gid * WGM, gsz = (nM - fm) < WGM ? (nM - fm) : WGM;
        u.pm = fm + ((wgid % nig) % gsz); u.pn = (wgid % nig) / gsz; return true;
    }
    __device__ __forceinline__ void a_ready(const Unit&) const {}
    __device__ __forceinline__ void done(const Unit&) const {}
};
template <bool GATHER_> struct MoeOrderT {
    static constexpr bool GATHER = GATHER_;
    const PG8_LAS int* list; const int* tok;
    __device__ bool next(int i, Unit& u) const {
        if (i >= __builtin_amdgcn_readfirstlane(list[0])) return false;
        u.pm = __builtin_amdgcn_readfirstlane(list[2 + 2 * i]); u.pn = __builtin_amdgcn_readfirstlane(list[3 + 2 * i]); return true;
    }
    __device__ __forceinline__ void a_ready(const Unit&) const {}
    __device__ __forceinline__ void done(const Unit&) const {}
};
typedef MoeOrderT<false> MoeOrder; typedef MoeOrderT<true> MoeOrderG;
__device__ __forceinline__ void moe_build_list(PG8_LAS int* list, const int* blk, int nN, int G, int c, int tid) {
    if (tid == 0) { const int* bst = blk + 16 + 544 + 16; int n = 0;
        if (G % 8 == 0) { const int W = G / 8, j = c / 8, x = c % 8;
            for (int i = 0; i < 64; ++i) { const int uu = i * W + j; const int bi = uu / nN, pl = uu - bi * nN; int rem = bi; bool ok = false;
                for (int k = 0; k < 4 && !ok; ++k) { const int e = x + 8 * k; const int b0 = bst[e], b1 = bst[e + 1]; if (rem < b1 - b0) { list[2 + 2 * n] = b0 + rem; list[3 + 2 * n] = e * nN + pl; ++n; ok = true; } else rem -= b1 - b0; }
                if (!ok) break; }
        } else { const int nb = bst[32];
            for (int i = 0; i < 64; ++i) { const int uu = i * G + c; const int bi = uu / nN, pl = uu - bi * nN; if (bi >= nb) break; int e = 0; for (int k = 1; k < 32; ++k) if (bi >= bst[k]) e = k; list[2 + 2 * n] = bi; list[3 + 2 * n] = e * nN + pl; ++n; } }
        list[0] = n; }
    asm volatile("s_waitcnt lgkmcnt(0)\n\ts_barrier" ::: "memory");
}

__device__ __forceinline__ unsigned cvt_pk_bf16(float lo, float hi) { unsigned r; asm volatile("v_cvt_pk_bf16_f32 %0, %1, %2" : "=v"(r) : "v"(lo), "v"(hi)); return r; }

struct EpiZ {
    static constexpr bool PERM = true, AFTER_DRAIN = false, MIDK = false;
    bf16_t* O; int ldc; const float* trig;
    __device__ __forceinline__ void operator()(const f32x4 (&acc)[2][2][4][2], const Unit& u, int wr, int wc, int fr, int fq) const {
        asm volatile("" : "+v"(fr), "+v"(fq));
        const int row0 = u.pm * BM + wr * 64 + fr; const int col0 = u.pn * BM + wc * 32 + 8 * fq;
        const bool rot_all = (u.pn < 4) || (u.pn == 32); const bool rot_b0 = rot_all || (u.pn == 33 && wc < 2);
        const int i0 = (wc & 1) * 16 + 4 * fq;
#pragma unroll
        for (int ai = 0; ai < 2; ++ai)
#pragma unroll
            for (int m = 0; m < 4; ++m) { const int row = row0 + ai * HALF + m * 16; bf16_t* rowp = O + (size_t)row * ldc + col0;
                f32x4 ca = {1.f, 0.f, 1.f, 0.f}, cb = {1.f, 0.f, 1.f, 0.f};
                if (rot_b0) { const float* tp = trig + ((size_t)(row & 8191) * 32 + i0) * 2; ca = *(const f32x4*)tp; cb = *(const f32x4*)(tp + 4); }
#pragma unroll
                for (int bj = 0; bj < 2; ++bj) { f32x4 v0 = acc[ai][bj][m][0], v1 = acc[ai][bj][m][1];
                    if (bj == 0 ? rot_b0 : rot_all) {
                        const f32x4 r0 = {v0[0] * ca[0] - v0[1] * ca[1], v0[1] * ca[0] + v0[0] * ca[1], v0[2] * ca[2] - v0[3] * ca[3], v0[3] * ca[2] + v0[2] * ca[3]};
                        const f32x4 r1 = {v1[0] * cb[0] - v1[1] * cb[1], v1[1] * cb[0] + v1[0] * cb[1], v1[2] * cb[2] - v1[3] * cb[3], v1[3] * cb[2] + v1[2] * cb[3]};
                        v0 = r0; v1 = r1; }
                    u32x4 w; w.x = cvt_pk_bf16(v0[0], v0[1]); w.y = cvt_pk_bf16(v0[2], v0[3]); w.z = cvt_pk_bf16(v1[0], v1[1]); w.w = cvt_pk_bf16(v1[2], v1[3]);
                    *(u32x4*)(rowp + bj * HALF) = w; } }
    }
};
struct EpiF32 {
    static constexpr bool PERM = true, AFTER_DRAIN = false, MIDK = false;
    float* O; int ldc;
    __device__ __forceinline__ void operator()(const f32x4 (&acc)[2][2][4][2], const Unit& u, int wr, int wc, int fr, int fq) const {
        asm volatile("" : "+v"(fr), "+v"(fq));
        const int row0 = u.pm * BM + wr * 64 + fr; const int col0 = u.pn * BM + wc * 32 + 8 * fq;
#pragma unroll
        for (int ai = 0; ai < 2; ++ai)
#pragma unroll
            for (int m = 0; m < 4; ++m) { float* rowp = O + (size_t)(row0 + ai * HALF + m * 16) * ldc + col0;
#pragma unroll
                for (int bj = 0; bj < 2; ++bj) { *(f32x4*)(rowp + bj * HALF) = acc[ai][bj][m][0]; *(f32x4*)(rowp + bj * HALF + 4) = acc[ai][bj][m][1]; } }
    }
};
struct EpiMerge {
    static constexpr bool PERM = true, AFTER_DRAIN = false, MIDK = true;
    const bf16_t* Gz; int gp; bf16_t* O; int ldc;
    __device__ __forceinline__ void scale(f32x4 (&acc)[2][2][4][2], const Unit& u, int idx, int wr, int wc, int fr, int fq) const {
        asm volatile("" : "+v"(fr), "+v"(fq));
        const int row0 = u.pm * BM + wr * 64 + fr; const int col0 = u.pn * BM + wc * 32 + 8 * fq;
        const int pa = (idx == 2) ? 2048 : (idx == 1) ? 2048 : 1024, pb = (idx == 1) ? 1024 : 0;
#pragma unroll
        for (int ai = 0; ai < 2; ++ai)
#pragma unroll
            for (int m = 0; m < 4; ++m) { const bf16_t* rowp = Gz + (size_t)(row0 + ai * HALF + m * 16) * gp + col0;
#pragma unroll
                for (int bj = 0; bj < 2; ++bj) { const u32x4 wa = *(const u32x4*)(rowp + pa + bj * HALF); u32x4 wb = wa; if (idx != 2) wb = *(const u32x4*)(rowp + pb + bj * HALF);
                    float s[8];
#pragma unroll
                    for (int i = 0; i < 4; ++i) { const float ea0 = __expf(-bflo(wa[i])), ea1 = __expf(-bfhi(wa[i]));
                        if (idx == 2) { s[2 * i] = __builtin_amdgcn_rcpf(1.f + ea0); s[2 * i + 1] = __builtin_amdgcn_rcpf(1.f + ea1); }
                        else { const float eb0 = __expf(-bflo(wb[i])), eb1 = __expf(-bfhi(wb[i])); s[2 * i] = (1.f + ea0) * __builtin_amdgcn_rcpf(1.f + eb0); s[2 * i + 1] = (1.f + ea1) * __builtin_amdgcn_rcpf(1.f + eb1); } }
                    acc[ai][bj][m][0] = acc[ai][bj][m][0] * (f32x4){s[0], s[1], s[2], s[3]}; acc[ai][bj][m][1] = acc[ai][bj][m][1] * (f32x4){s[4], s[5], s[6], s[7]}; }
                asm volatile("" ::: "memory"); }
    }
    __device__ __forceinline__ void mid(f32x4 (&acc)[2][2][4][2], const Unit& u, int idx, int wr, int wc, int fr, int fq) const { scale(acc, u, idx, wr, wc, fr, fq); }
    __device__ __forceinline__ void operator()(f32x4 (&acc)[2][2][4][2], const Unit& u, int wr, int wc, int fr, int fq) const {
        scale(acc, u, 2, wr, wc, fr, fq);
        asm volatile("" : "+v"(fr), "+v"(fq));
        const int row0 = u.pm * BM + wr * 64 + fr; const int col0 = u.pn * BM + wc * 32 + 8 * fq;
#pragma unroll
        for (int ai = 0; ai < 2; ++ai)
#pragma unroll
            for (int m = 0; m < 4; ++m) { bf16_t* rowp = O + (size_t)(row0 + ai * HALF + m * 16) * ldc + col0;
#pragma unroll
                for (int bj = 0; bj < 2; ++bj) { const f32x4 v0 = acc[ai][bj][m][0], v1 = acc[ai][bj][m][1];
                    u32x4 w; w.x = cvt_pk_bf16(v0[0], v0[1]); w.y = cvt_pk_bf16(v0[2], v0[3]); w.z = cvt_pk_bf16(v1[0], v1[1]); w.w = cvt_pk_bf16(v1[2], v1[3]);
                    *(u32x4*)(rowp + bj * HALF) = w; } }
    }
};
struct EpiSwiGLU {
    static constexpr bool PERM = true, AFTER_DRAIN = false, MIDK = false;
    bf16_t* O; const float* bias; int nN;
    __device__ __forceinline__ void operator()(const f32x4 (&acc)[2][2][4][2], const Unit& u, int wr, int wc, int fr, int fq) const {
        const int e = u.pn / nN, pl = u.pn - e * nN;
        asm volatile("" : "+v"(fr), "+v"(fq));
        const int row0 = u.pm * BM + wr * 64 + fr; const int colt = pl * BM + wc * 32 + 8 * fq;
        const float* bp = bias + (size_t)e * 2048 + colt;
        f32x4 bv[2][2];
#pragma unroll
        for (int bj = 0; bj < 2; ++bj) { bv[bj][0] = *(const f32x4*)(bp + bj * HALF); bv[bj][1] = *(const f32x4*)(bp + bj * HALF + 4); }
#pragma unroll
        for (int ai = 0; ai < 2; ++ai)
#pragma unroll
            for (int m = 0; m < 4; ++m) { unsigned char* rowp = (unsigned char*)O + (size_t)(row0 + ai * HALF + m * 16) * 1024 + (colt >> 1);
#pragma unroll
                for (int bj = 0; bj < 2; ++bj) { const f32x4 v0 = acc[ai][bj][m][0] + bv[bj][0], v1 = acc[ai][bj][m][1] + bv[bj][1];
                    float a[4];
                    const float gt[4] = {v0[0], v0[2], v1[0], v1[2]}, up[4] = {v0[1], v0[3], v1[1], v1[3]};
#pragma unroll
                    for (int i = 0; i < 4; ++i) { const float g = fminf(gt[i], 7.0f); const float uu = fminf(fmaxf(up[i], -7.0f), 7.0f);
                        a[i] = g * (1.0f / (1.0f + __expf(-1.702f * g))) * (uu + 1.0f); }
                    int w8 = __builtin_amdgcn_cvt_pk_fp8_f32(a[0], a[1], 0, false); w8 = __builtin_amdgcn_cvt_pk_fp8_f32(a[2], a[3], w8, true);
                    *(unsigned*)(rowp + bj * (HALF / 2)) = (unsigned)w8; } }
    }
};
struct EpiDown {
    static constexpr bool PERM = true, AFTER_DRAIN = false, MIDK = false;
    bf16_t* O; const float* bias; const float* gate; int nN;
    __device__ __forceinline__ void operator()(const f32x4 (&acc)[2][2][4][2], const Unit& u, int wr, int wc, int fr, int fq) const {
        const int e = u.pn / nN, pl = u.pn - e * nN;
        asm volatile("" : "+v"(fr), "+v"(fq));
        const int row0 = u.pm * BM + wr * 64 + fr; const int colt = pl * BM + wc * 32 + 8 * fq;
        const float* bp = bias + (size_t)e * 1024 + colt;
        f32x4 bv[2][2];
#pragma unroll
        for (int bj = 0; bj < 2; ++bj) { bv[bj][0] = *(const f32x4*)(bp + bj * HALF); bv[bj][1] = *(const f32x4*)(bp + bj * HALF + 4); }
#pragma unroll
        for (int ai = 0; ai < 2; ++ai)
#pragma unroll
            for (int m = 0; m < 4; ++m) { const int row = row0 + ai * HALF + m * 16; const float gs = gate[row]; bf16_t* rowp = O + (size_t)row * 1024 + colt;
#pragma unroll
                for (int bj = 0; bj < 2; ++bj) { const f32x4 v0 = (acc[ai][bj][m][0] + bv[bj][0]) * gs, v1 = (acc[ai][bj][m][1] + bv[bj][1]) * gs;
                    u32x4 w; w.x = cvt_pk_bf16(v0[0], v0[1]); w.y = cvt_pk_bf16(v0[2], v0[3]); w.z = cvt_pk_bf16(v1[0], v1[1]); w.w = cvt_pk_bf16(v1[2], v1[3]);
                    *(u32x4*)(rowp + bj * HALF) = w; } }
    }
};

template <class Epi, class Sched, bool ALIGN_EPI = false, bool SP2 = false, bool FP8 = false, int SCALE_B = 127>
__device__ __forceinline__ void gemm_phase(PG8_LAS unsigned char* lds, const Gemm g, const Sched& S, const Epi& E, int wv) {
    int tid_l = (int)__builtin_amdgcn_mbcnt_hi(~0u, __builtin_amdgcn_mbcnt_lo(~0u, 0u)); asm volatile("" : "+v"(tid_l)); tid_l += wv * 64;
    const int tid = tid_l, wid = __builtin_amdgcn_readfirstlane(tid >> 6), lane = tid & 63, wr = wid >> 2, wc = wid & 3, fr = lane & 15, fq = lane >> 4;
    const int K = g.K; const int KB = FP8 ? K : 2 * K;
    const int nt = KB / (2 * BK);
    unsigned voffA[2], voffB[2];
#pragma unroll
    for (int i = 0; i < 2; ++i) { int R, C; stage_rc(tid * 16 + i * 8192, R, C); const int Rb = Epi::PERM ? ((R & ~31) + perm32(R & 31)) : R;
        voffA[i] = (unsigned)(R * KB + 2 * C); voffB[i] = (unsigned)(Rb * KB + 2 * C); }
    unsigned voGc[2][2]; PG8_LAS unsigned* voGn_l = (PG8_LAS unsigned*)(lds + STAGE_BYTES + 1024) + tid;
#define PG8_GOFF(dst, pmv) do { if constexpr (Sched::GATHER) { _Pragma("unroll") for (int _h = 0; _h < 2; ++_h) _Pragma("unroll") for (int _i = 0; _i < 2; ++_i) { \
        const unsigned _R = voffA[_i] / (unsigned)KB, _cb = voffA[_i] % (unsigned)KB; dst[_h][_i] = (unsigned)S.tok[(pmv) * BM + _h * HALF + (int)_R] * (unsigned)KB + _cb; } } } while (0)
    const size_t kstep = (size_t)(BK * 2);
    const size_t hstep = (size_t)HALF * KB;
    const size_t tstep = 2 * hstep;
    const unsigned ldsw = (unsigned)wid * 1024u;
    const int aoff = lds_byte(wr * 64 + fr, FP8 ? fq * 16 : fq * 8), boff = lds_byte(wc * 32 + fr, FP8 ? fq * 16 : fq * 8);
    const int aoff1 = FP8 ? lds_byte(wr * 64 + fr, fq * 16 + 8) - aoff : 1024, boff1 = FP8 ? lds_byte(wc * 32 + fr, fq * 16 + 8) - boff : 1024;
#define PG8_SA(b, h) (((b) * 2 + (h)) * HTB)
#define PG8_SB(b, h) ((4 + (b) * 2 + (h)) * HTB)
#define PG8_STAGE(bufoff, gbase, voff) do { _Pragma("unroll") for (int _i = 0; _i < 2; ++_i) \
        __builtin_amdgcn_global_load_lds((const unsigned*)((const char*)(gbase) + (voff)[_i]), (PG8_LAS unsigned*)(lds + (bufoff) + ldsw + _i * 8192), 16, 0, 0); } while (0)
#define PG8_STAGE_A(bufoff, base, h, nx) do { if constexpr (Sched::GATHER) { unsigned _vo[2] = {voGc[h][0], voGc[h][1]}; if (nx) { _vo[0] = voGn_l[((h) * 2 + 0) * 512]; _vo[1] = voGn_l[((h) * 2 + 1) * 512]; } PG8_STAGE(bufoff, base, _vo); } else { PG8_STAGE(bufoff, (base) + (h) * hstep, voffA); } } while (0)
#define PG8_LD8(dst8, n_, base_, off_, off1_) do { _Pragma("unroll") for (int q_ = 0; q_ < n_; ++q_) { const v4i_ lo_ = *(const PG8_LAS v4i_*)(lds + (base_) + (off_) + q_ * 2048), hi_ = *(const PG8_LAS v4i_*)(lds + (base_) + (off_) + q_ * 2048 + (off1_)); \
        dst8[q_] = __builtin_shufflevector(lo_, hi_, 0, 1, 2, 3, 4, 5, 6, 7); } } while (0)
#define PG8_LDA(dst, b, h) do { if constexpr (FP8) { PG8_LD8(dst##8, 4, PG8_SA(b, h), aoff, aoff1); } else { _Pragma("unroll") for (int m = 0; m < 4; ++m) _Pragma("unroll") for (int k = 0; k < 2; ++k) dst[m][k] = *(const PG8_LAS bf16x8*)(lds + PG8_SA(b, h) + aoff + m * 2048 + k * aoff1); } } while (0)
#define PG8_LDB(dst, b, h) do { if constexpr (FP8) { PG8_LD8(dst##8, 2, PG8_SB(b, h), boff, boff1); } else { _Pragma("unroll") for (int n = 0; n < 2; ++n) _Pragma("unroll") for (int k = 0; k < 2; ++k) dst[n][k] = *(const PG8_LAS bf16x8*)(lds + PG8_SB(b, h) + boff + n * 2048 + k * boff1); } } while (0)
#define PG8_MMA(ai, bj, At, Bt) do { if constexpr (FP8) __builtin_amdgcn_sched_barrier(0); __builtin_amdgcn_s_setprio(1); _Pragma("unroll") for (int m = 0; m < 4; ++m) _Pragma("unroll") for (int n = 0; n < 2; ++n) { \
        if constexpr (FP8) { asm volatile("v_mfma_scale_f32_16x16x128_f8f6f4 %0, %1, %2, %0, %3, %4 op_sel_hi:[0,0,0]" : "+v"(acc[ai][bj][m][n]) : "v"(Bt##8[n]), "v"(At##8[m]), "v"(sclB), "v"(sclA)); } \
        else { _Pragma("unroll") for (int k = 0; k < 2; ++k) acc[ai][bj][m][n] = __builtin_amdgcn_mfma_f32_16x16x32_bf16(Bt[n][k], At[m][k], acc[ai][bj][m][n], 0, 0, 0); } } \
        __builtin_amdgcn_s_setprio(0); if constexpr (FP8) __builtin_amdgcn_sched_barrier(0); } while (0)
#define PG8_WAIT_V(n) asm volatile("s_waitcnt vmcnt(" #n ")" ::: "memory")
#define PG8_WAIT_L(n) asm volatile("s_waitcnt lgkmcnt(" #n ")" ::: "memory")
#define PG8_BAR __builtin_amdgcn_s_barrier()
#define PG8_SCHED __builtin_amdgcn_sched_barrier(0)
    Unit cur, nxt; int ui = 0;
    if (!S.next(0, cur)) return;
    f32x4 acc[2][2][4][2];
#pragma unroll
    for (int a = 0; a < 2; ++a)
#pragma unroll
        for (int b = 0; b < 2; ++b)
#pragma unroll
            for (int m = 0; m < 4; ++m)
#pragma unroll
                for (int n = 0; n < 2; ++n) acc[a][b][m][n] = (f32x4){0.f, 0.f, 0.f, 0.f};
    bf16x8 At[4][2], B0[2][2], B1[2][2];
    typedef int v8i_ __attribute__((ext_vector_type(8))); typedef int v4i_ __attribute__((ext_vector_type(4)));
    int sclB = SCALE_B * 0x01010101, sclA = 0x7f7f7f7f; asm volatile("" : "+v"(sclB), "+v"(sclA));
    v8i_ At8[4], B08[2], B18[2];
    const char* cA = (const char*)g.A + (Sched::GATHER ? (size_t)0 : (size_t)cur.pm * tstep); const char* cB = (const char*)g.Bt + (size_t)cur.pn * tstep;
    PG8_GOFF(voGc, cur.pm);
    S.a_ready(cur);
    if constexpr (SP2) {
        PG8_STAGE(PG8_SB(0, 0), cB, voffB); PG8_STAGE(PG8_SB(0, 1), cB + hstep, voffB); PG8_STAGE_A(PG8_SA(0, 0), cA, 0, false); PG8_STAGE_A(PG8_SA(0, 1), cA, 1, false);
        if (wr == 1) PG8_BAR;
        PG8_WAIT_V(2); PG8_BAR;
        PG8_STAGE(PG8_SB(1, 0), cB + kstep, voffB); PG8_STAGE_A(PG8_SA(1, 0), cA + kstep, 0, false); PG8_STAGE(PG8_SB(1, 1), cB + hstep + kstep, voffB);
        PG8_WAIT_V(6); PG8_BAR;
    } else {
        PG8_STAGE(PG8_SB(0, 0), cB, voffB); PG8_STAGE_A(PG8_SA(0, 0), cA, 0, false); PG8_STAGE(PG8_SB(0, 1), cB + hstep, voffB); PG8_STAGE_A(PG8_SA(0, 1), cA, 1, false);
        if (wr == 1) PG8_BAR;
        PG8_WAIT_V(4); PG8_BAR;
        PG8_STAGE(PG8_SB(1, 0), cB + kstep, voffB); PG8_STAGE_A(PG8_SA(1, 0), cA + kstep, 0, false); PG8_STAGE(PG8_SB(1, 1), cB + hstep + kstep, voffB);
        PG8_WAIT_V(6); PG8_BAR;
    }
    for (;;) {
        const bool has_next = S.next(ui + 1, nxt);
        const char* nA = has_next ? (const char*)g.A + (Sched::GATHER ? (size_t)0 : (size_t)nxt.pm * tstep) : cA;
        if constexpr (Sched::GATHER) { unsigned _vn[2][2]; if (has_next) { PG8_GOFF(_vn, nxt.pm); } else { _Pragma("unroll") for (int _h = 0; _h < 2; ++_h) _Pragma("unroll") for (int _i = 0; _i < 2; ++_i) _vn[_h][_i] = voGc[_h][_i]; }
            _Pragma("unroll") for (int _h = 0; _h < 2; ++_h) _Pragma("unroll") for (int _i = 0; _i < 2; ++_i) voGn_l[(_h * 2 + _i) * 512] = _vn[_h][_i]; } const char* nB = has_next ? (const char*)g.Bt + (size_t)nxt.pn * tstep : cB;
        for (int t = 0; t < nt; t += 2) {
            const bool last = (t == nt - 2);
            const char* a1 = cA + (size_t)(t + 1) * kstep;
            const char* a2 = last ? nA : cA + (size_t)(t + 2) * kstep; const char* b2 = last ? nB : cB + (size_t)(t + 2) * kstep;
            const char* a3 = a2 + kstep; const char* b3 = b2 + kstep;
            if (last && has_next) S.a_ready(nxt);
            if constexpr (SP2) {
            PG8_LDB(B0, 0, 0); PG8_LDB(B1, 0, 1); PG8_SCHED; PG8_LDA(At, 0, 0); PG8_STAGE_A(PG8_SA(1, 1), a1, 1, false);
            PG8_WAIT_V(8); PG8_WAIT_L(0); PG8_BAR; PG8_MMA(0, 0, At, B0); PG8_MMA(0, 1, At, B1); PG8_BAR; PG8_SCHED;
            PG8_LDA(At, 0, 1); PG8_STAGE(PG8_SB(0, 0), b2, voffB); PG8_STAGE(PG8_SB(0, 1), b2 + hstep, voffB); PG8_STAGE_A(PG8_SA(0, 0), a2, 0, last);
            PG8_WAIT_V(8); PG8_WAIT_L(0); PG8_BAR; PG8_MMA(1, 0, At, B0); PG8_MMA(1, 1, At, B1); PG8_BAR; PG8_SCHED;
            PG8_LDB(B0, 1, 0); PG8_LDB(B1, 1, 1); PG8_SCHED; PG8_LDA(At, 1, 0); PG8_STAGE_A(PG8_SA(0, 1), a2, 1, last);
            PG8_WAIT_V(8); PG8_WAIT_L(0); PG8_BAR; PG8_MMA(0, 0, At, B0); PG8_MMA(0, 1, At, B1); PG8_BAR; PG8_SCHED;
            PG8_LDA(At, 1, 1); PG8_STAGE(PG8_SB(1, 0), b3, voffB); PG8_STAGE(PG8_SB(1, 1), b3 + hstep, voffB); PG8_STAGE_A(PG8_SA(1, 0), a3, 0, last);
            PG8_WAIT_V(8); PG8_WAIT_L(0); PG8_BAR; PG8_MMA(1, 0, At, B0); PG8_MMA(1, 1, At, B1); PG8_BAR; PG8_SCHED;
            } else {
            PG8_LDB(B0, 0, 0); PG8_SCHED; PG8_LDA(At, 0, 0); PG8_STAGE_A(PG8_SA(1, 1), a1, 1, false);
            PG8_WAIT_L(8); PG8_BAR; PG8_WAIT_L(0); PG8_MMA(0, 0, At, B0); PG8_BAR; PG8_SCHED;
            PG8_LDB(B1, 0, 1); PG8_STAGE(PG8_SB(0, 0), b2, voffB);
            PG8_BAR; PG8_WAIT_L(0); PG8_MMA(0, 1, At, B1); PG8_BAR;
            PG8_LDA(At, 0, 1); PG8_STAGE_A(PG8_SA(0, 0), a2, 0, last);
            PG8_BAR; PG8_WAIT_L(0); PG8_MMA(1, 0, At, B0); PG8_BAR; PG8_SCHED;
            PG8_STAGE(PG8_SB(0, 1), b2 + hstep, voffB);
            PG8_WAIT_V(6); PG8_BAR; PG8_MMA(1, 1, At, B1); PG8_BAR;
            PG8_LDB(B0, 1, 0); PG8_SCHED; PG8_LDA(At, 1, 0); PG8_STAGE_A(PG8_SA(0, 1), a2, 1, last);
            PG8_WAIT_L(8); PG8_BAR; PG8_WAIT_L(0); PG8_MMA(0, 0, At, B0); PG8_BAR; PG8_SCHED;
            PG8_LDB(B1, 1, 1); PG8_STAGE(PG8_SB(1, 0), b3, voffB);
            PG8_BAR; PG8_WAIT_L(0); PG8_MMA(0, 1, At, B1); PG8_BAR;
            PG8_LDA(At, 1, 1); PG8_STAGE_A(PG8_SA(1, 0), a3, 0, last);
            PG8_BAR; PG8_WAIT_L(0); PG8_MMA(1, 0, At, B0); PG8_BAR; PG8_SCHED;
            PG8_STAGE(PG8_SB(1, 1), b3 + hstep, voffB);
            PG8_WAIT_V(6); PG8_BAR; PG8_MMA(1, 1, At, B1); PG8_BAR;
            }
            if constexpr (Epi::MIDK) { if (((t + 2) & 7) == 0 && t + 2 < nt) E.mid(acc, cur, ((t + 2) >> 3) - 1, wr, wc, fr, fq); }
        }
        if constexpr (FP8) asm volatile("s_nop 15\n\ts_nop 15" ::: "memory");
        if constexpr (ALIGN_EPI) { if (wr == 0) PG8_BAR; }
        if constexpr (!Epi::AFTER_DRAIN) { E(acc, cur, wr, wc, fr, fq); S.done(cur); }
        if (!has_next) break;
#pragma unroll
        for (int a = 0; a < 2; ++a)
#pragma unroll
            for (int b = 0; b < 2; ++b)
#pragma unroll
                for (int m = 0; m < 4; ++m)
#pragma unroll
                    for (int n = 0; n < 2; ++n) acc[a][b][m][n] = (f32x4){0.f, 0.f, 0.f, 0.f};
        cur = nxt; cA = nA; cB = nB; ++ui;
        if constexpr (Sched::GATHER) { _Pragma("unroll") for (int _h = 0; _h < 2; ++_h) _Pragma("unroll") for (int _i = 0; _i < 2; ++_i) voGc[_h][_i] = voGn_l[(_h * 2 + _i) * 512]; }
        if constexpr (ALIGN_EPI) { if (wr == 1) PG8_BAR; }
    }
    PG8_WAIT_V(0);
    if constexpr (!ALIGN_EPI) { if (wr == 0) PG8_BAR; }
    PG8_BAR;
#undef PG8_SA
#undef PG8_SB
#undef PG8_STAGE
#undef PG8_STAGE_A
#undef PG8_GOFF
#undef PG8_LDA
#undef PG8_LD8
#undef PG8_LDB
#undef PG8_MMA
#undef PG8_WAIT_V
#undef PG8_WAIT_L
#undef PG8_BAR
#undef PG8_SCHED
}
}
constexpr int BATCH = 4, SEQ = 8192, DM = 1024, NTOK = BATCH * SEQ, DEPTH = 2, NEXP = 32;
constexpr int D_IN = 8524, ZP = 8704;
constexpr int Z_AQ = 0, Z_AK = 512, Z_AV = 1024, Z_FQ = 1536, Z_FK = 2048, Z_FV = 2560, Z_CQ = 3072, Z_CF = 3584, Z_CI = 4096, Z_CG = 4608, Z_GT = 5120, Z_IQ = 8192, Z_IK = 8448, Z_IW = 8512, Z_FF = 8516;
constexpr int OP = 1536;
constexpr int MAXBLK = 544, MAXSLOT = MAXBLK * 256;
constexpr int BST_OFF = 16 + MAXBLK + 16;
constexpr float LOG2E = 1.4426950408889634f;
constexpr float QSCALE = 0.125f * LOG2E;
constexpr float ALPHA = 1.4142135623730951f;
constexpr float LN_EPS = 1e-5f, RMS_EPS = 1e-6f;
constexpr int NWAVES = 8, NTHR = 512;
constexpr float W8_SCALE = 64.0f; constexpr int W8_E8M0 = 127 - 6;
constexpr int NPH_LAYER = 14, NPHASES = 1 + DEPTH * NPH_LAYER;
enum { PH_INPROJ = 0, PH_PREP, PH_IDX, PH_ATTN, PH_H1, PH_H2, PH_H3, PH_MERGE, PH_WOUT, PH_LN1, PH_SLOT, PH_GU, PH_DOWN, PH_COMB };

__host__ __device__ __forceinline__ int zcol_src(int n) {
    if (n < 1024 || (n >= 8192 && n < 8512)) { const int p = n & 63; n = (n & ~63) + ((p & 1) ? 32 + (p >> 1) : (p >> 1)); }
    if (n < 1536) return n;
    if (n < 3072) return 1860 + (n - 1536);
    if (n < 5120) return 3404 + (n - 3072);
    if (n < 8192) return 5452 + (n - 5120);
    if (n < 8448) return 1536 + (n - 8192);
    if (n < 8512) return 1792 + (n - 8448);
    if (n < 8516) return 1856 + (n - 8512);
    if (n < 8524) return 3396 + (n - 8516);
    return -1;
}

constexpr size_t MiB = 1u << 20;
constexpr size_t WS_CTL = 0, CTL_ZERO_BYTES = 1 * MiB;
constexpr size_t WS_TRIG = 1 * MiB;
constexpr size_t WS_LFT = 3 * MiB;
constexpr size_t WS_CT = 4 * MiB;
constexpr size_t WS_DG = 5 * MiB, WS_D2G = 6 * MiB;
constexpr size_t WS_WGCNT = 7 * MiB;
constexpr size_t WS_BLK = 7 * MiB + 64 * 1024;
constexpr size_t WS_BGU = 7 * MiB + 128 * 1024;
constexpr size_t WS_TKE = 8 * MiB, WS_TKG = 8 * MiB + 512 * 1024, WS_TOKSLOT = 9 * MiB, WS_GSLOT = 9 * MiB + 512 * 1024;
constexpr size_t WS_SLOTTOK = 10 * MiB + 512 * 1024;
constexpr size_t WS_WRF = 11 * MiB;
constexpr size_t WS_WIN = 12 * MiB;
constexpr size_t WS_WP = 46 * MiB;
constexpr size_t WS_WOUT = 52 * MiB;
constexpr size_t WS_WGU = 56 * MiB;
constexpr size_t WS_WDN = 312 * MiB;
constexpr size_t WS_Z = 440 * MiB;
constexpr size_t WS_XG = WS_Z, WS_ACT = WS_Z + 272 * MiB;
constexpr size_t WS_OBUF = 984 * MiB;
constexpr size_t WS_MERGED = 1080 * MiB;
constexpr size_t WS_MIX = 1144 * MiB;
constexpr size_t WS_Y = WS_OBUF;
constexpr size_t WS_X1 = 1272 * MiB;
constexpr size_t WS_X1B = 1400 * MiB;
constexpr size_t WS_XCUR = 1464 * MiB;
constexpr size_t WS_XB = 1592 * MiB;
constexpr size_t WS_MASKW = 1656 * MiB;
constexpr size_t WS_UG = 1688 * MiB;
constexpr size_t WS_SST = 1752 * MiB;
constexpr size_t WS_SB = 7 * MiB + 768 * 1024;
constexpr size_t WS_KA = 1784 * MiB;
constexpr size_t WS_END = 1792 * MiB;
static_assert(WS_Y + (size_t)MAXSLOT * 1024 * 2 <= WS_X1 && WS_ACT + (size_t)MAXSLOT * 1024 * 2 <= WS_OBUF, "ws map");
constexpr int CW_TMO = 0;
constexpr int CW_BAR = 4096;
constexpr int CW_SB = 512;

constexpr int SCR_BYTES = 153600;
constexpr int MISC_OFF = SCR_BYTES;
constexpr int LDS_BYTES = SCR_BYTES + 256;

#define RLX_AGENT __ATOMIC_RELAXED, __HIP_MEMORY_SCOPE_AGENT
#define LDS_WAIT() asm volatile("s_waitcnt lgkmcnt(0)" ::: "memory")
#define VM_WAIT() asm volatile("s_waitcnt vmcnt(0)" ::: "memory")
#define WG_BAR() asm volatile("s_waitcnt vmcnt(0) lgkmcnt(0)\n\ts_barrier" ::: "memory")
#define WG_BAR_LDS() asm volatile("s_waitcnt lgkmcnt(0)\n\ts_barrier" ::: "memory")

#define XB_TMO      128
#define XB_XCNT(j)  (256  + 64 * (j))
#define XB_XSUB(j)  (1280 + 64 * (j))
#define XB_XGEN(j)  (2304 + 64 * (j))
#define XB_TOP      3328
#define XB_TOPGEN   3392
#define XCD_BAR_WORDS 3456
#define XB_SPIN_CAP (1u << 18)

__device__ __forceinline__ unsigned xb_ld(unsigned* p)              { return __hip_atomic_load(p, __ATOMIC_RELAXED, __HIP_MEMORY_SCOPE_AGENT); }
__device__ __forceinline__ unsigned xb_add(unsigned* p, unsigned v) { return __hip_atomic_fetch_add(p, v, __ATOMIC_RELAXED, __HIP_MEMORY_SCOPE_AGENT); }
__device__ __forceinline__ unsigned xb_xcc_id() { return (unsigned)__builtin_amdgcn_s_getreg((3 << 11) | 20) & 0xFu; }
#define XB_SPIN(cond, bar) do { unsigned _sp = 0; while (cond) { __builtin_amdgcn_s_sleep(1); \
    if ((++_sp & 255u) == 0u) { if (xb_ld(&(bar)[XB_TMO])) break; if (_sp > XB_SPIN_CAP) { atomicAdd(&(bar)[XB_TMO], 1u); break; } } } } while (0)

struct XcdBarrier {
    unsigned* bar; unsigned x;
    volatile LAS unsigned* st;
};

__device__ __forceinline__ XcdBarrier xcd_barrier_post(unsigned* bar, volatile LAS unsigned* st) {
    XcdBarrier b; b.bar = bar; b.x = xb_xcc_id(); b.st = st;
    if (threadIdx.x == 0) (void)xb_add(&bar[XB_XCNT(b.x)], 1u);
    return b;
}
__device__ __forceinline__ void xcd_barrier_complete(unsigned* bar, unsigned x, unsigned& nloc, unsigned& nx) {
    const unsigned G = gridDim.x * gridDim.y * gridDim.z;
    unsigned sum, cnt, mine, sp = 0u;
    for (;;) {
        sum = 0u; cnt = 0u; mine = 0u;
#pragma unroll
        for (unsigned j = 0; j < 16; ++j) { const unsigned c = xb_ld(&bar[XB_XCNT(j)]); sum += c; cnt += (c > 0u) ? 1u : 0u; mine = (j == x) ? c : mine; }
        if (sum == G) break;
        __builtin_amdgcn_s_sleep(1);
        if ((++sp & 255u) == 0u) { if (xb_ld(&bar[XB_TMO])) break; if (sp > XB_SPIN_CAP) { atomicAdd(&bar[XB_TMO], 1u); break; } }
    }
    nloc = mine > 0u ? mine : 1u; nx = cnt > 0u ? cnt : 1u;
}

__device__ __forceinline__ void xcd_barrier(const XcdBarrier& b) {
    asm volatile("s_waitcnt vmcnt(0)" ::: "memory");
    __syncthreads();
    if (threadIdx.x == 0) {
        unsigned* bar = b.bar;
        __builtin_amdgcn_s_waitcnt(0);
        unsigned nloc = b.st[0], nx = b.st[1];
        if (nloc == 0u) { xcd_barrier_complete(bar, b.x, nloc, nx); b.st[0] = nloc; b.st[1] = nx; }
        const unsigned old = xb_add(&bar[XB_XSUB(b.x)], 1u);
        const unsigned gen = old / nloc;
        if (old + 1u == (gen + 1u) * nloc) {
            __builtin_amdgcn_fence(__ATOMIC_RELEASE, "agent");
            asm volatile("s_waitcnt vmcnt(0)" ::: "memory");
            const unsigned og = xb_add(&bar[XB_TOP], 1u);
            const unsigned tg = og / nx;
            if (og + 1u == (tg + 1u) * nx) xb_add(&bar[XB_TOPGEN], 1u);
            else XB_SPIN(xb_ld(&bar[XB_TOPGEN]) == tg, bar);
            __builtin_amdgcn_fence(__ATOMIC_ACQUIRE, "agent");
            xb_add(&bar[XB_XGEN(b.x)], 1u);
            asm volatile("s_waitcnt vmcnt(0)" ::: "memory");
        } else {
            XB_SPIN(xb_ld(&bar[XB_XGEN(b.x)]) == gen, bar);
            __builtin_amdgcn_fence(__ATOMIC_ACQUIRE, "agent");
            asm volatile("s_waitcnt vmcnt(0)" ::: "memory");
        }
    }
    __syncthreads();
}
__device__ __forceinline__ int lane_id() { int l = (int)__builtin_amdgcn_mbcnt_hi(~0u, __builtin_amdgcn_mbcnt_lo(~0u, 0u)); asm volatile("" : "+v"(l)); return l; }
__device__ __forceinline__ float wave_sum(float v) {
#pragma unroll
    for (int o = 1; o < 64; o <<= 1) v += __shfl_xor(v, o);
    return v;
}
__device__ __forceinline__ int crow(int r, int hi) { return (r & 3) + 8 * (r >> 2) + 4 * hi; }
__device__ __forceinline__ void glds16(const void* gsrc, unsigned lds_dst) { unsigned keep;
    asm volatile("s_mov_b32 %0, m0\n\ts_mov_b32 m0, %2\n\ts_nop 0\n\tglobal_load_lds_dwordx4 %1, off\n\ts_mov_b32 m0, %0" : "=&s"(keep) : "v"(gsrc), "s"(lds_dst) : "memory"); }
__device__ __forceinline__ void glds4(const void* gsrc, unsigned lds_dst) { unsigned keep;
    asm volatile("s_mov_b32 %0, m0\n\ts_mov_b32 m0, %2\n\ts_nop 0\n\tglobal_load_lds_dword %1, off\n\ts_mov_b32 m0, %0" : "=&s"(keep) : "v"(gsrc), "s"(lds_dst) : "memory"); }
typedef __bf16 bf16x2_t __attribute__((ext_vector_type(2)));
__device__ __forceinline__ unsigned cvtpk(float lo, float hi) { const f32x2 v = {lo, hi}; const bf16x2_t b = __builtin_convertvector(v, bf16x2_t); return __builtin_bit_cast(unsigned, b); }
typedef short v4i16_t __attribute__((ext_vector_type(4)));
__device__ __forceinline__ s16x4 vtr(const LAS char* p) { return __builtin_bit_cast(s16x4, __builtin_amdgcn_ds_read_tr16_b64_v4i16((LAS v4i16_t*)p)); }
__device__ __forceinline__ void plswap(float& a, float& b) { asm volatile("s_nop 1\n\tv_permlane32_swap_b32 %0, %1\n\ts_nop 1" : "+v"(a), "+v"(b)); }
__device__ __forceinline__ float swapmax(float m) { float a = m, b = m; plswap(a, b); return fmaxf(a, b); }
__device__ __forceinline__ float swapsum(float m) { float a = m, b = m; plswap(a, b); return a + b; }
#define MFMA32(a, b, c) __builtin_amdgcn_mfma_f32_32x32x16_bf16((a), (b), (c), 0, 0, 0)

struct Params {
    const float* x; const float* w_in; const float* b_fox; const float* lb_logits; const float* norm_g; const float* w_pa; const float* w_pb; const float* w_pc; const float* w_out;
    const float* ln1_g; const float* ln1_b; const float* w_router; const float* b_router; const float* w_gu; const float* b_gu; const float* w_down; const float* b_down; const float* ln2_g; const float* ln2_b;
    float* out; unsigned char* ws; int ph_lo, ph_hi, use_bar, pad;
};

typedef const __attribute__((address_space(4))) Params* KP;
__device__ __forceinline__ KP load_params() { KP kp = (KP)__builtin_amdgcn_kernarg_segment_ptr(); asm volatile("" : "+s"(kp)); return kp; }

template <class F> __device__ __forceinline__ void cvt_tile(const float* W, size_t ldsrc, int k0, bf16* WT, size_t ldw, int kd0, int n0, const F& f, LAS float* scr, int lane) {
    const int c = lane & 31; int sc; float scale; f(n0 + c, sc, scale);
#pragma unroll 8
    for (int i = 0; i < 32; ++i) { const int kk = 2 * i + (lane >> 5); scr[kk * 33 + c] = sc >= 0 ? W[(size_t)(k0 + kk) * ldsrc + sc] * scale : 0.f; }
    LDS_WAIT(); asm volatile("" ::: "memory");
    const int ch = lane & 7;
#pragma unroll
    for (int j = 0; j < 4; ++j) { const int n = (lane >> 3) + 8 * j; const LAS float* s = scr + (8 * ch) * 33 + n;
        u32x4 o; o.x = pk2(s[0 * 33], s[1 * 33]); o.y = pk2(s[2 * 33], s[3 * 33]); o.z = pk2(s[4 * 33], s[5 * 33]); o.w = pk2(s[6 * 33], s[7 * 33]);
        *(u32x4*)(WT + (size_t)(n0 + n) * ldw + kd0 + 8 * ch) = o; }
    LDS_WAIT(); asm volatile("" ::: "memory");
}
template <class F> __device__ __forceinline__ void cvt_tile8(const float* W, size_t ldsrc, int k0, unsigned char* WT, size_t ldw, int n0, const F& f, float wscale, LAS float* scr, int lane) {
    const int c = lane & 31; int sc; float scale; f(n0 + c, sc, scale); scale *= wscale;
#pragma unroll 8
    for (int i = 0; i < 32; ++i) { const int kk = 2 * i + (lane >> 5); scr[kk * 33 + c] = sc >= 0 ? W[(size_t)(k0 + kk) * ldsrc + sc] * scale : 0.f; }
    LDS_WAIT(); asm volatile("" ::: "memory");
    const int ch = lane & 7;
#pragma unroll
    for (int j = 0; j < 4; ++j) { const int n = (lane >> 3) + 8 * j; const LAS float* s = scr + (8 * ch) * 33 + n;
        int w0 = __builtin_amdgcn_cvt_pk_fp8_f32(s[0 * 33], s[1 * 33], 0, false); w0 = __builtin_amdgcn_cvt_pk_fp8_f32(s[2 * 33], s[3 * 33], w0, true);
        int w1 = __builtin_amdgcn_cvt_pk_fp8_f32(s[4 * 33], s[5 * 33], 0, false); w1 = __builtin_amdgcn_cvt_pk_fp8_f32(s[6 * 33], s[7 * 33], w1, true);
        *(u32x2*)(WT + (size_t)(n0 + n) * ldw + k0 + 8 * ch) = (u32x2){(unsigned)w0, (unsigned)w1}; }
    LDS_WAIT(); asm volatile("" ::: "memory");
}
struct MapIn { __device__ __forceinline__ void operator()(int n, int& sc, float& s) const { sc = zcol_src(n); s = (n < 512 || (n >= Z_FQ && n < Z_FK)) ? QSCALE : 1.0f; } };
struct MapGu { __device__ __forceinline__ void operator()(int n, int& sc, float& s) const { sc = (n & 1) ? 1024 + (n >> 1) : (n >> 1); s = 1.0f; } };
struct MapId { __device__ __forceinline__ void operator()(int n, int& sc, float& s) const { sc = n; s = 1.0f; } };

__device__ __forceinline__ void p0_prologue(KP p, LAS unsigned char* lds, int gw, int NGW, int wave, int lane) {
    LAS float* scr = (LAS float*)(lds + wave * 16384);
    unsigned char* ws = p->ws;
    constexpr int I_IN = 16 * 272, I_GU = 32 * 16 * 64, I_DN = 32 * 16 * 32, I_P = 3 * 8 * 32, I_OUT = 16 * 32, I_LAYER = I_IN + I_GU + I_DN + I_P + I_OUT;
    for (int it = gw; it < DEPTH * I_LAYER; it += NGW) {
        const int l = it / I_LAYER; int r = it - l * I_LAYER;
        if (r < I_IN) { const int kb = r / 272, nb = r % 272;
            cvt_tile(p->w_in + (size_t)l * 1024 * D_IN, D_IN, 64 * kb, (bf16*)(ws + WS_WIN) + (size_t)l * ZP * 1024, 1024, 64 * kb, 32 * nb, MapIn{}, scr, lane); continue; } r -= I_IN;
        if (r < I_GU) { const int e = r >> 10, r2 = r & 1023, kb = r2 >> 6, nb = r2 & 63;
            cvt_tile8(p->w_gu + (size_t)(l * 32 + e) * 1024 * 2048, 2048, 64 * kb, (unsigned char*)(ws + WS_WGU) + (size_t)(l * 32 + e) * 2048 * 1024, 1024, 32 * nb, MapGu{}, W8_SCALE, scr, lane); continue; } r -= I_GU;
        if (r < I_DN) { const int e = r >> 9, r2 = r & 511, kb = r2 >> 5, nb = r2 & 31;
            cvt_tile8(p->w_down + (size_t)(l * 32 + e) * 1024 * 1024, 1024, 64 * kb, (unsigned char*)(ws + WS_WDN) + (size_t)(l * 32 + e) * 1024 * 1024, 1024, 32 * nb, MapId{}, W8_SCALE, scr, lane); continue; } r -= I_DN;
        if (r < I_P) { const int br = r >> 8, r2 = r & 255, kb = r2 >> 5, nb = r2 & 31; const float* W = (br == 0 ? p->w_pa : br == 1 ? p->w_pb : p->w_pc) + (size_t)l * 512 * 1024;
            cvt_tile(W, 1024, 64 * kb, (bf16*)(ws + WS_WP) + (size_t)l * 1024 * 1536, 1536, br * 512 + 64 * kb, 32 * nb, MapId{}, scr, lane); continue; } r -= I_P;
        { const int kb = r >> 5, nb = r & 31;
            cvt_tile(p->w_out + (size_t)l * 1024 * 1024, 1024, 64 * kb, (bf16*)(ws + WS_WOUT) + (size_t)l * 1024 * 1024, 1024, 64 * kb, 32 * nb, MapId{}, scr, lane); }
    }
    { float* bg = (float*)(ws + WS_BGU);
      for (int i = gw * 64 + lane; i < DEPTH * 32 * 2048; i += NGW * 64) { const int n = i & 2047, le = i >> 11; bg[i] = p->b_gu[(size_t)le * 2048 + ((n & 1) ? 1024 + (n >> 1) : (n >> 1))]; } }
    { bf16* wf = (bf16*)(ws + WS_WRF);
      for (int i = gw * 64 + lane; i < DEPTH * 32 * 2 * 64 * 8; i += NGW * 64) { const int ii = i & 7, ln = (i >> 3) & 63, nt = (i >> 9) & 1, s = (i >> 10) & 31, l = i >> 15;
          const int k = 32 * s + 8 * (ln >> 4) + ii, e = 16 * nt + (ln & 15); const float w = p->w_router[((size_t)l * 1024 + k) * 32 + e];
          const unsigned hb = f2bf(w); const float lo = w - bf2f(hb);
          const size_t base = ((((size_t)l * 32 + s) * 2 + nt) * 2) * 512 + ln * 8 + ii; wf[base] = (bf16)hb; wf[base + 512] = (bf16)f2bf(lo); } }
    { f32x2* tg = (f32x2*)(ws + WS_TRIG);
      for (int i = gw * 64 + lane; i < SEQ * 32; i += NGW * 64) { const int pos = i >> 5, k = i & 31;
          const float inv = exp2f(-(float)k * (13.287712379549449f / 32.0f)); const float ang = (float)pos * inv;
          const double rev = (double)ang * 0.15915494309189535; const float fr = (float)(rev - __builtin_rint(rev));
          tg[i] = (f32x2){__builtin_amdgcn_cosf(fr), __builtin_amdgcn_sinf(fr)}; } }
    { bf16* xb = (bf16*)(ws + WS_XB);
      for (int m = gw; m < NTOK; m += NGW) { const f32x4* xr = (const f32x4*)(p->x + (size_t)m * DM) + lane; u32x2* o = (u32x2*)(xb + (size_t)m * DM) + lane;
#pragma unroll
          for (int j = 0; j < 4; ++j) { const f32x4 v = xr[64 * j]; o[64 * j] = (u32x2){pk2(v.x, v.y), pk2(v.z, v.w)}; } } }
}

__device__ __forceinline__ void prep_phase(KP p, int l, int gw, int NGW, int lane) {
    unsigned char* ws = p->ws; bf16* Z = (bf16*)(ws + WS_Z); const f32x2* tg = (const f32x2*)(ws + WS_TRIG); float* lfT = (float*)(ws + WS_LFT);
    const float bf_l = (lane < 8) ? p->b_fox[l * 8 + lane] : 0.f;
    for (int m = gw; m < NTOK; m += NGW) {
        bf16* zr = Z + (size_t)m * ZP; const int pos = m & (SEQ - 1), b = m >> 13;
        const f32x2 cs = tg[pos * 32 + (lane & 31)];
        unsigned short ta[11], tb[11];
#pragma unroll
        for (int it = 0; it < 11; ++it) { const int hh = 2 * it + (lane >> 5); const int hc = hh < 21 ? hh : 20;
            const int col = hc < 8 ? Z_AQ + hc * 64 : hc < 16 ? Z_AK + (hc - 8) * 64 : hc < 20 ? Z_IQ + (hc - 16) * 64 : Z_IK;
            const bf16* q = zr + col + (lane & 31); ta[it] = q[0]; tb[it] = q[32]; }
#pragma unroll
        for (int it = 0; it < 11; ++it) { const int hh = 2 * it + (lane >> 5);
            if (hh < 21) { const int col = hh < 8 ? Z_AQ + hh * 64 : hh < 16 ? Z_AK + (hh - 8) * 64 : hh < 20 ? Z_IQ + (hh - 16) * 64 : Z_IK;
                bf16* q = zr + col + (lane & 31); const float t1 = bf2f(ta[it]), t2 = bf2f(tb[it]);
                q[0] = (bf16)f2bf(t1 * cs.x - t2 * cs.y); q[32] = (bf16)f2bf(t2 * cs.x + t1 * cs.y); } }
#pragma unroll
        for (int j = 0; j < 2; ++j) { bf16* g0p = zr + Z_GT + lane * 8 + j * 512; const u32x4 a = *(const u32x4*)g0p, bb = *(const u32x4*)(g0p + 1024), cc = *(const u32x4*)(g0p + 2048);
            u32x4 o0, o1, o2;
#pragma unroll
            for (int i = 0; i < 4; ++i) {
                const float e0l = __expf(-bflo(a[i])), e0h = __expf(-bfhi(a[i])), e1l = __expf(-bflo(bb[i])), e1h = __expf(-bfhi(bb[i])), e2l = __expf(-bflo(cc[i])), e2h = __expf(-bfhi(cc[i]));
                o0[i] = pk2((1.f + e1l) / (1.f + e0l), (1.f + e1h) / (1.f + e0h));
                o1[i] = pk2((1.f + e2l) / (1.f + e1l), (1.f + e2h) / (1.f + e1h));
                o2[i] = pk2(1.f / (1.f + e2l), 1.f / (1.f + e2h)); }
            *(u32x4*)g0p = o0; *(u32x4*)(g0p + 1024) = o1; *(u32x4*)(g0p + 2048) = o2; }
        if (lane < 8) { const float v = bf2f(zr[Z_FF + lane]) + bf_l; const float ls = fminf(v, 0.f) - __logf(1.0f + __expf(-fabsf(v))); lfT[(size_t)(b * 8 + lane) * SEQ + pos] = ls * LOG2E; }
    }
}

constexpr int IX_CAP = 1024, IX_TRIG = 768, IX_CAND = 0, IX_BM = 0  , IX_HIST = 32 * IX_CAP * 4, IX_CNT = IX_HIST + 8 * 1024, IX_TAU = IX_CNT + 128, IX_FLAG = IX_TAU + 128, IX_END = IX_FLAG + 64;
static_assert(IX_END <= SCR_BYTES, "indexer LDS");

__device__ __forceinline__ unsigned wave_select256(LAS unsigned* cand, int n, LAS unsigned* hist, int lane) {
    unsigned x[16];
#pragma unroll
    for (int k = 0; k < 16; ++k) { const int i = lane + 64 * k; x[k] = (i < n) ? cand[i] : 0u; }
    unsigned prefix = 0u; int need = 256;
#pragma unroll
    for (int pass = 3; pass >= 0; --pass) { const int shift = 8 * pass;
        ((LAS u32x4*)hist)[lane] = (u32x4){0u, 0u, 0u, 0u};
#pragma unroll
        for (int k = 0; k < 16; ++k) { const bool ok = (lane + 64 * k < n) && (pass == 3 || (x[k] >> (shift + 8)) == (prefix >> (shift + 8)));
            if (ok) (void)__hip_atomic_fetch_add(hist + ((x[k] >> shift) & 255u), 1u, __ATOMIC_RELAXED, __HIP_MEMORY_SCOPE_WORKGROUP); }
        LDS_WAIT();
        const u32x4 b = ((const LAS u32x4*)hist)[lane];
        const int s = (int)(b.x + b.y + b.z + b.w); int suf = s;
#pragma unroll
        for (int o = 1; o < 64; o <<= 1) { const int t = __shfl_down(suf, o); if (lane + o < 64) suf += t; }
        const int above = suf - s; const bool found = (above < need) && (suf >= need);
        const int c3 = above + (int)b.w, c2 = c3 + (int)b.z, c1 = c2 + (int)b.y;
        const int d = (c3 >= need) ? 3 : (c2 >= need) ? 2 : (c1 >= need) ? 1 : 0; const int nn = need - ((d == 3) ? above : (d == 2) ? c3 : (d == 1) ? c2 : c1);
        const u64 fm = __ballot(found); const int src = (int)__builtin_ctzll(fm);
        const int digit = __builtin_amdgcn_readlane(4 * lane + d, src); need = __builtin_amdgcn_readlane(nn, src);
        prefix |= (unsigned)digit << shift;
        LDS_WAIT();
    }
    int base = 0; const u64 lt = (1ull << lane) - 1ull;
#pragma unroll
    for (int k = 0; k < 16; ++k) { const bool keep = x[k] >= prefix; const u64 mk = __ballot(keep);
        if (keep) cand[base + __popcll(mk & lt)] = x[k]; base += __popcll(mk); }
    return prefix;
}

__device__ __forceinline__ void idx_phase(KP p, int l, LAS unsigned char* lds, int vcu, int G, int tid, int wave, int lane) {
    unsigned char* ws = p->ws; const bf16* Z = (const bf16*)(ws + WS_Z);
    { unsigned* sbr = (unsigned*)(ws + WS_CTL) + CW_SB + l * 64; LAS float* wt = (LAS float*)lds;
      for (int task = blockIdx.x; task < 256; task += G) { const int bh = task >> 3, part = task & 7; float qm = 0.f, km = 0.f;
          const bf16* zr = Z + (size_t)((bh >> 3) * SEQ + part * 1024 + tid * 2) * ZP + (bh & 7) * 64;
#pragma unroll
          for (int i = 0; i < 2; ++i) { float qs = 0.f, ks = 0.f;
#pragma unroll
              for (int c8 = 0; c8 < 8; ++c8) { const u32x4 a = *(const u32x4*)(zr + (size_t)i * ZP + Z_FQ + c8 * 8), kq = *(const u32x4*)(zr + (size_t)i * ZP + Z_FK + c8 * 8);
#pragma unroll
                  for (int w4 = 0; w4 < 4; ++w4) { qs += bflo(a[w4]) * bflo(a[w4]) + bfhi(a[w4]) * bfhi(a[w4]); ks += bflo(kq[w4]) * bflo(kq[w4]) + bfhi(kq[w4]) * bfhi(kq[w4]); } }
              qm = fmaxf(qm, qs); km = fmaxf(km, ks); }
#pragma unroll
          for (int o = 1; o < 64; o <<= 1) { qm = fmaxf(qm, __shfl_xor(qm, o)); km = fmaxf(km, __shfl_xor(km, o)); }
          if (lane == 0) { __hip_atomic_fetch_max(sbr + 2 * bh, __builtin_bit_cast(unsigned, qm), __ATOMIC_RELAXED, __HIP_MEMORY_SCOPE_AGENT); __hip_atomic_fetch_max(sbr + 2 * bh + 1, __builtin_bit_cast(unsigned, km), __ATOMIC_RELAXED, __HIP_MEMORY_SCOPE_AGENT); } }
      (void)wt; }
    for (int bh = blockIdx.x; bh < 32; bh += G) {
        float* dst = (float*)(ws + WS_CT) + (size_t)bh * SEQ;
        LAS float* wt = (LAS float*)lds;
        const float bfx = p->b_fox[l * 8 + (bh & 7)]; const bf16* zf = Z + (size_t)((bh >> 3) * SEQ + tid * 16) * ZP + Z_FF + (bh & 7);
        f32x4 v[4]; float run = 0.f;
#pragma unroll
        for (int j = 0; j < 4; ++j) {
#pragma unroll
            for (int i = 0; i < 4; ++i) { const float t = bf2f(zf[(size_t)(4 * j + i) * ZP]) + bfx; v[j][i] = (fminf(t, 0.f) - __logf(1.0f + __expf(-fabsf(t)))) * LOG2E; }
            v[j].x += run; v[j].y += v[j].x; v[j].z += v[j].y; v[j].w += v[j].z; run = v[j].w; }
        float inc = run;
#pragma unroll
        for (int o = 1; o < 64; o <<= 1) { const float t = __shfl_up(inc, o); if (lane >= o) inc += t; }
        if (lane == 63) wt[wave] = inc;
        WG_BAR();
        float off = inc - run;
        for (int w = 0; w < wave; ++w) off += wt[w];
        { u32x4* ka = (u32x4*)((bf16*)(ws + WS_KA) + ((size_t)bh * SEQ + tid * 16) * 16);
#pragma unroll
          for (int j = 0; j < 4; ++j) { const f32x4 c4 = v[j] + off; *(f32x4*)(dst + tid * 16 + 4 * j) = c4;
#pragma unroll
              for (int i = 0; i < 4; ++i) { const float c = c4[i]; const unsigned h1 = f2bf(c); const float r1 = c - bf2f(h1); const unsigned h2 = f2bf(r1); const unsigned h3 = f2bf(r1 - bf2f(h2));
                  unsigned z0 = 0u; asm volatile("" : "+v"(z0));
                  ka[(4 * j + i) * 2] = (u32x4){h1 | (h2 << 16), h3 | 0x3f800000u, z0, z0}; ka[(4 * j + i) * 2 + 1] = (u32x4){z0, z0, z0, z0}; } } }
        WG_BAR();
    }
    LAS unsigned* cand = (LAS unsigned*)(lds + IX_CAND); LAS unsigned* BM = (LAS unsigned*)(lds + IX_BM);
    LAS unsigned* cnt = (LAS unsigned*)(lds + IX_CNT); LAS unsigned* tau = (LAS unsigned*)(lds + IX_TAU); LAS unsigned* hist = (LAS unsigned*)(lds + IX_HIST); LAS unsigned* flg = (LAS unsigned*)(lds + IX_FLAG);
    u64* MW = (u64*)(ws + WS_MASKW);
    const int r32 = lane & 31, hi = lane >> 5;
    for (int U = vcu; U < 1024; U += G) {
        const int v = U & 255, i4 = U >> 8; const int b = v & 3, a = v >> 2;
        const int hc = (i4 == 0) ? a : (i4 == 1) ? 255 - a : (i4 == 2) ? 64 + a : 191 - a;
        const int qbase = b * SEQ + hc * 32; const int nadm = ((hc >> 1) + 1) * 64;
        if (nadm <= 256) {
            const int nw = nadm >> 6;
            for (int i = tid; i < 32 * 128; i += NTHR) { const int q = i >> 7, w = i & 127; unsigned on = (w < nw) ? 0xffffffffu : 0u; asm volatile("" : "+v"(on));
                MW[(size_t)(qbase + q) * 128 + w] = (u64)on | ((u64)on << 32); }
            continue;
        }
        const bf16* qrow = Z + (size_t)(qbase + r32) * ZP;
        bf16x8 iqf[4][4];
#pragma unroll
        for (int hd = 0; hd < 4; ++hd)
#pragma unroll
            for (int j = 0; j < 4; ++j) iqf[hd][j] = *(const bf16x8*)(qrow + Z_IQ + hd * 64 + j * 16 + hi * 8);
        float wq[4];
#pragma unroll
        for (int hd = 0; hd < 4; ++hd) wq[hd] = bf2f(qrow[Z_IW + hd]) * (0.5f * 0.125f);
        if (tid < 32) { cnt[tid] = 0u; tau[tid] = 0u; } if (tid < 3) flg[tid] = 0u;
        const int ntiles = nadm >> 5, nrounds = (ntiles + 7) >> 3;
        const bf16* kbase = Z + (size_t)(b * SEQ) * ZP + Z_IK + hi * 8;
        bf16x8 kf[4];
        WG_BAR();
        for (int rd = 0; rd < nrounds; ++rd) {
            const int tile = rd * 8 + wave;
            if (tile < ntiles) {
#pragma unroll
                for (int j = 0; j < 4; ++j) kf[j] = *(const bf16x8*)(kbase + (size_t)(tile * 32 + r32) * ZP + j * 16);
                f32x16 sc = {};
#pragma unroll
                for (int hd = 0; hd < 4; ++hd) { f32x16 pp = {};
#pragma unroll
                    for (int j = 0; j < 4; ++j) pp = MFMA32(kf[j], iqf[hd][j], pp);
#pragma unroll
                    for (int r = 0; r < 16; ++r) sc[r] = __builtin_fmaf(wq[hd], fmaxf(pp[r], 0.f), sc[r]); }
                const unsigned tq = tau[r32];
                typedef unsigned u32x16_t __attribute__((ext_vector_type(16))); u32x16_t comp, posv; bool anyp = false;
#pragma unroll
                for (int r = 0; r < 16; ++r) { const int key = tile * 32 + crow(r, hi);
                    unsigned u = __builtin_bit_cast(unsigned, sc[r] + 0.0f); u ^= (u >> 31) ? 0xffffffffu : 0x80000000u;
                    comp[r] = (u & 0xffffe000u) | (unsigned)(8191 - key); posv[r] = 0u;
                    if (comp[r] > tq) { posv[r] = __hip_atomic_fetch_add(cnt + r32, 1u, __ATOMIC_RELAXED, __HIP_MEMORY_SCOPE_WORKGROUP); anyp = true; } }
                LAS unsigned* cq_ = cand + r32 * IX_CAP; bool trig = false;
#pragma unroll
                for (int r = 0; r < 16; ++r) if (comp[r] > tq) { cq_[posv[r]] = comp[r]; trig = trig || (posv[r] >= (unsigned)IX_TRIG); }
                if (trig) flg[rd % 3] = 1u; (void)anyp;
            }
            WG_BAR_LDS();
            const bool need_any = flg[rd % 3] != 0u;
            if (tid == 0) flg[(rd + 2) % 3] = 0u;
            if (need_any) {
#pragma unroll 1
                for (int i = 0; i < 4; ++i) { const int qq = wave * 4 + i; const int n = (int)cnt[qq];
                    if (n > 256) { const unsigned th = wave_select256(cand + qq * IX_CAP, n, hist + wave * 256, lane); if (lane == 0) { cnt[qq] = 256u; tau[qq] = th; } } }
                WG_BAR_LDS();
            }
        }
#pragma unroll 1
        for (int i = 0; i < 4; ++i) { const int qq = wave * 4 + i; const int n = (int)cnt[qq];
            if (n > 256) { (void)wave_select256(cand + qq * IX_CAP, n, hist + wave * 256, lane); } }
        LDS_WAIT();
        unsigned fin[4][4];
#pragma unroll
        for (int i = 0; i < 4; ++i)
#pragma unroll
            for (int k = 0; k < 4; ++k) fin[i][k] = cand[(wave * 4 + i) * IX_CAP + lane + 64 * k];
        WG_BAR();
        for (int i = tid; i < 32 * 256; i += NTHR) BM[i] = 0u;
        WG_BAR();
#pragma unroll
        for (int i = 0; i < 4; ++i) { const int qq = wave * 4 + i;
#pragma unroll
            for (int k = 0; k < 4; ++k) { const int key = 8191 - (int)(fin[i][k] & 8191u);
                __hip_atomic_fetch_or(BM + qq * 256 + (key >> 5), 1u << (key & 31), __ATOMIC_RELAXED, __HIP_MEMORY_SCOPE_WORKGROUP); } }
        WG_BAR();
        for (int i = tid; i < 32 * 128; i += NTHR) { const int q = i >> 7, w = i & 127; MW[(size_t)(qbase + q) * 128 + w] = (u64)BM[q * 256 + 2 * w] | ((u64)BM[q * 256 + 2 * w + 1] << 32); }
        WG_BAR();
    }
}

constexpr int AT_K = 0, AT_V = 2 * 8192, AT_WS = 4 * 8192, AT_OST = AT_WS + 4096, AT_MW = AT_OST + 8 * 4096, AT_KA = AT_MW + 2 * 8 * 512, AT_END = AT_KA + 2 * 2048;
static_assert(AT_END <= SCR_BYTES, "attention LDS");
#ifndef DBG_ATT_L
#define DBG_ATT_L 0
#endif

template <int MODE>
__device__ __forceinline__ void attn_unit(int b, int h, int qb, const bf16* Z, bf16* Ob, const float* cT, const u64* MW, const void* KA, const void* SBp, LAS char* shm, int wv) {
    int tid_l = lane_id() + wv * 64;
    const int tid = tid_l, lane = tid & 63, r32 = lane & 31, hi = lane >> 5; const int wid = __builtin_amdgcn_readfirstlane(tid >> 6);
    constexpr int QC = MODE == 0 ? Z_FQ : Z_AQ, KC = MODE == 0 ? Z_FK : Z_AK, VC = MODE == 0 ? Z_FV : Z_AV, OC = MODE == 0 ? 512 : 0;
    const long rowbase = (long)b * SEQ; const int q0 = qb * 512;
    const bf16* Qw = Z + (rowbase + q0 + wid * 64) * ZP + QC + h * 64;
    const bf16* Kh = Z + rowbase * ZP + KC + h * 64; const bf16* Vh = Z + rowbase * ZP + VC + h * 64;
    const unsigned lds0 = (unsigned)(uintptr_t)shm;
    LAS float* wsf = (LAS float*)(shm + AT_WS) + wid * 128;
    const int NT = 8 * (qb + 1); const int tlast = 8 * qb + wid;
    const bf16* ksrc = Kh + (long)lane * ZP + wid * 8;
    const bf16* vsrc = Vh + (long)(16 * (wid & 3) + (lane >> 2)) * ZP + (wid >> 2) * 32 + (lane & 3) * 8;
    const unsigned kdst = lds0 + AT_K + wid * 1024, vdst = lds0 + AT_V + wid * 1024, mdst = lds0 + AT_MW + wid * 512;
    const unsigned kadst = lds0 + AT_KA + (wid & 1) * 1024;
#define DMA_KA(t, sl) do { if (MODE == 0 && wid < 2) { const int ln_ = lane_id();     \
        glds16((const bf16*)KA + ((size_t)(b * 8 + h) * SEQ + (t) * 64 + 32 * wid + (ln_ >> 1)) * 16 + (ln_ & 1) * 8, (unsigned)__builtin_amdgcn_readfirstlane(kadst + (sl) * 2048)); } } while (0)
#define DMA_K(t, slotb) glds16(ksrc + (long)(t) * 64 * ZP, (unsigned)__builtin_amdgcn_readfirstlane(kdst + (slotb)))
#define DMA_V(t, slotb) glds16(vsrc + (long)(t) * 64 * ZP, (unsigned)__builtin_amdgcn_readfirstlane(vdst + (slotb)))
#define DMA_M(t, sl) do { const int ln_ = lane_id(); const unsigned* msrcA = (const unsigned*)(MW + (size_t)(rowbase + q0 + wid * 64 + (ln_ & 31)) * 128) + (ln_ >> 5);     \
        glds4(msrcA + 2 * (t), (unsigned)__builtin_amdgcn_readfirstlane(mdst + (sl) * 4096)); glds4(msrcA + 32 * 256 + 2 * (t), (unsigned)__builtin_amdgcn_readfirstlane(mdst + (sl) * 4096 + 256)); } while (0)
    int t_start = 0, t_first = 0;
    if (MODE == 0) { const float* cg = cT + (size_t)(b * 8 + h) * SEQ; const float th = 2.0f * (sqrtf(((const float*)SBp)[2 * (b * 8 + h)]) * sqrtf(((const float*)SBp)[2 * (b * 8 + h) + 1]) * 1.01f + 1.0f) + 40.0f; const int ln_ = lane_id();
        const float c0 = cg[q0], cw = cg[q0 + wid * 64];
        const float ca = (ln_ < NT) ? cg[64 * ln_ + 63] : -3e38f, cb = (ln_ + 64 < NT) ? cg[64 * (ln_ + 64) + 63] : -3e38f;
        { const u64 m0 = __ballot(ca <= c0 + th), m1 = __ballot(cb <= c0 + th); t_start = m0 ? (int)__builtin_ctzll(m0) : 64 + (int)__builtin_ctzll(m1 | (1ull << 63)); }
        { const u64 m0 = __ballot(ca <= cw + th), m1 = __ballot(cb <= cw + th); t_first = m0 ? (int)__builtin_ctzll(m0) : 64 + (int)__builtin_ctzll(m1 | (1ull << 63)); }
        if (t_start > 8 * qb) t_start = 8 * qb; if (t_first > tlast) t_first = tlast; }
    DMA_K(t_start, 0); DMA_V(t_start, 0); if (MODE == 1) DMA_M(0, 0); DMA_KA(t_start, 0);
    bf16x8 qA[4], qB[4];
#pragma unroll
    for (int d0 = 0; d0 < 4; ++d0) { qA[d0] = *(const bf16x8*)(Qw + (long)r32 * ZP + d0 * 16 + hi * 8); qB[d0] = *(const bf16x8*)(Qw + (long)(32 + r32) * ZP + d0 * 16 + hi * 8); }
    float mA = 0.f, mB = 0.f, lA = 0.f, lB = 0.f;
    const unsigned qa0 = (MODE == 0 && hi == 0) ? 0xbf80bf80u : 0u; const unsigned qa1c = (MODE == 0 && hi == 0) ? 0xbf80u : 0u;
    u32x4 qaA = {qa0, qa1c, 0u, 0u}, qaB = {qa0, qa1c, 0u, 0u};
    f32x16 oA[2], oB[2]; oA[0] = f32x16{}; oA[1] = f32x16{}; oB[0] = f32x16{}; oB[1] = f32x16{};
    const int qrelA = wid * 64 + r32;
    const LAS char* kp0 = shm + AT_K + hi * 1024 + r32 * 16;
    const LAS char* vp0 = shm + AT_V + ((lane >> 4) & 1) * 32 + (lane & 3) * 8 + (4 * hi + ((lane & 15) >> 2)) * 64;
    const LAS unsigned* mwp = (const LAS unsigned*)(shm + AT_MW + wid * 512);
    const LAS char* kap0 = shm + AT_KA + r32 * 32 + hi * 16;
    int slot = 0;
#define SOFTMAX(P0, P1, MH, LR, OO, QA, QREL, WSOFF, MWOFF, PW) do { \
        if (MODE == 0) { \
            if (t == tlast) { _Pragma("unroll") for (int r = 0; r < 16; ++r) { const int kv = crow(r, hi); if (kv > (QREL) - wid * 64) P0[r] = -INFINITY; if (kv + 32 > (QREL) - wid * 64) P1[r] = -INFINITY; } } \
        } else { const unsigned mlo = mwp[slot * 1024 + (MWOFF) + r32], mhi = mwp[slot * 1024 + (MWOFF) + 32 + r32]; \
            _Pragma("unroll") for (int r = 0; r < 16; ++r) { const int bitp = crow(r, hi); if (!((mlo >> bitp) & 1u)) P0[r] = -INFINITY; if (!((mhi >> bitp) & 1u)) P1[r] = -INFINITY; } } \
        float rm = __builtin_fmaxf(__builtin_fmaxf(P0[0], P0[1]), P1[0]), rm2 = __builtin_fmaxf(__builtin_fmaxf(P0[2], P0[3]), P1[1]); rm = __builtin_fmaxf(__builtin_fmaxf(rm, P1[2]), P1[3]); \
        _Pragma("unroll") for (int r = 4; r < 16; r += 4) { rm = __builtin_fmaxf(__builtin_fmaxf(rm, P0[r]), P0[r + 1]); rm2 = __builtin_fmaxf(__builtin_fmaxf(rm2, P0[r + 2]), P0[r + 3]); rm = __builtin_fmaxf(__builtin_fmaxf(rm, P1[r]), P1[r + 1]); rm2 = __builtin_fmaxf(__builtin_fmaxf(rm2, P1[r + 2]), P1[r + 3]); } \
        rm = __builtin_fmaxf(rm, rm2); \
        rm = swapmax(rm);                            \
        if (__any(rm > 8.0f)) { const bool big_ = __builtin_fabsf(MH) + __builtin_fabsf(rm > 0.f ? rm : 0.f) > 1800.0f;     \
            const float dl = rm > 0.f ? (big_ ? 64.0f * __builtin_ceilf((MH + rm) * (1.0f / 64.0f)) - MH : 8.0f * __builtin_ceilf(rm * 0.125f)) : 0.f; const float f = __builtin_amdgcn_exp2f(-dl); LR *= f; MH += dl; \
            QA[1] = (QA[1] & 0xffffu) | ((hi == 0) ? (f2bf(-MH) << 16) : 0u); \
            _Pragma("unroll") for (int r = 0; r < 16; ++r) { P0[r] -= dl; P1[r] -= dl; } \
            if (hi == 0) wsf[(WSOFF) + r32] = f; \
            LDS_WAIT(); \
            _Pragma("unroll") for (int j = 0; j < 4; ++j) { const f32x4 ff = *(const LAS f32x4*)(wsf + (WSOFF) + 8 * j + 4 * hi); \
                _Pragma("unroll") for (int i = 0; i < 4; ++i) { OO[0][4 * j + i] *= ff[i]; OO[1][4 * j + i] *= ff[i]; } } } \
        float sacc = 0.f; \
        _Pragma("unroll") for (int r = 0; r < 16; ++r) { P0[r] = __builtin_amdgcn_exp2f(P0[r]); P1[r] = __builtin_amdgcn_exp2f(P1[r]); sacc += P0[r] + P1[r]; } \
        LR += sacc; \
        _Pragma("unroll") for (int i = 0; i < 4; ++i) { PW[0][i] = cvtpk(P0[2 * i], P0[2 * i + 1]); PW[1][i] = cvtpk(P0[8 + 2 * i], P0[8 + 2 * i + 1]); PW[2][i] = cvtpk(P1[2 * i], P1[2 * i + 1]); PW[3][i] = cvtpk(P1[8 + 2 * i], P1[8 + 2 * i + 1]); } \
    } while (0)
#define PVMM(OO, PW) do { const LAS char* vp = vp0 + slot * 8192; \
        _Pragma("unroll") for (int d0 = 0; d0 < 2; ++d0) { s16x4 lo_[4], hh_[4]; \
            _Pragma("unroll") for (int ks = 0; ks < 4; ++ks) { lo_[ks] = vtr(vp + d0 * 4096 + ks * 1024); hh_[ks] = vtr(vp + d0 * 4096 + ks * 1024 + 512); } \
            _Pragma("unroll") for (int ks = 0; ks < 4; ++ks) { const bf16x8 vf = {lo_[ks][0], lo_[ks][1], lo_[ks][2], lo_[ks][3], hh_[ks][0], hh_[ks][1], hh_[ks][2], hh_[ks][3]}; \
                OO[d0] = MFMA32(__builtin_bit_cast(bf16x8, PW[ks]), vf, OO[d0]); } } } while (0)
    for (int t = t_start; t < NT; ++t) {
        asm volatile("s_waitcnt vmcnt(0) lgkmcnt(0)\n\ts_barrier" ::: "memory");
        if (t + 1 < NT) { DMA_K(t + 1, (slot ^ 1) * 8192); DMA_V(t + 1, (slot ^ 1) * 8192); if (MODE == 1) DMA_M(t + 1, slot ^ 1); DMA_KA(t + 1, slot ^ 1); }
        if (t <= tlast && t >= t_first) {
            f32x16 a0 = {}, a1 = {}, b0 = {}, b1 = {};
            { const LAS char* kb = kp0 + slot * 8192;
#pragma unroll
              for (int d0 = 0; d0 < 4; ++d0) { const bf16x8 k0 = *(const LAS bf16x8*)(kb + d0 * 2048), k1 = *(const LAS bf16x8*)(kb + d0 * 2048 + 512);
                  a0 = MFMA32(k0, qA[d0], a0); a1 = MFMA32(k1, qA[d0], a1); b0 = MFMA32(k0, qB[d0], b0); b1 = MFMA32(k1, qB[d0], b1); }
              bf16x8 x0, x1;
              if (MODE == 0) { x0 = *(const LAS bf16x8*)(kap0 + slot * 2048); x1 = *(const LAS bf16x8*)(kap0 + slot * 2048 + 1024); }
              else { const u32x4 cw = {0u, (hi == 0) ? 0x3f800000u : 0u, 0u, 0u}; x0 = __builtin_bit_cast(bf16x8, cw); x1 = x0; }
              a0 = MFMA32(x0, __builtin_bit_cast(bf16x8, qaA), a0); a1 = MFMA32(x1, __builtin_bit_cast(bf16x8, qaA), a1); b0 = MFMA32(x0, __builtin_bit_cast(bf16x8, qaB), b0); b1 = MFMA32(x1, __builtin_bit_cast(bf16x8, qaB), b1); }
            u32x4 pwA[4], pwB[4];
            SOFTMAX(a0, a1, mA, lA, oA, qaA, qrelA, 0, 0, pwA);
            PVMM(oA, pwA);
            SOFTMAX(b0, b1, mB, lB, oB, qaB, qrelA + 32, 32, 64, pwB);
            PVMM(oB, pwB);
        }
        slot ^= 1;
    }
#define EPILOG(OO, LR, WSOFF, ROWOFF) do { float l_ = swapsum(LR); if (hi == 0) wsf[64 + (WSOFF) + r32] = l_; LDS_WAIT(); float rli[16]; \
        _Pragma("unroll") for (int r = 0; r < 16; ++r) rli[r] = __builtin_amdgcn_rcpf(wsf[64 + (WSOFF) + crow(r, hi)]); \
        bf16* Ow = Ob + (rowbase + q0 + wid * 64 + (ROWOFF)) * OP + OC + h * 64; LAS bf16* stg = (LAS bf16*)(shm + AT_OST) + wid * 2048; \
        _Pragma("unroll") for (int r = 0; r < 16; ++r) { const int orow = crow(r, hi); _Pragma("unroll") for (int d0 = 0; d0 < 2; ++d0) stg[orow * 64 + d0 * 32 + r32] = (bf16)f2bf(OO[d0][r] * rli[r]); } \
        LDS_WAIT(); \
        _Pragma("unroll") for (int i = 0; i < 4; ++i) { const int row = i * 8 + (lane >> 3), ch = lane & 7; const u32x4 v = *(const LAS u32x4*)(stg + row * 64 + ch * 8); *(u32x4*)(Ow + (long)row * OP + ch * 8) = v; } \
        LDS_WAIT(); } while (0)
    EPILOG(oA, lA, 0, 0);
    EPILOG(oB, lB, 32, 32);
    asm volatile("s_waitcnt lgkmcnt(0)\n\ts_barrier" ::: "memory");
#undef DMA_K
#undef DMA_V
#undef DMA_M
#undef DMA_KA
#undef SOFTMAX
#undef PVMM
#undef EPILOG
}

__device__ __forceinline__ void attn_phase(KP p, int l, LAS unsigned char* lds, int vcu, int G, int wv) {
    unsigned char* ws = p->ws; const bf16* Z = (const bf16*)(ws + WS_Z); bf16* Ob = (bf16*)(ws + WS_OBUF); const float* cT = (const float*)(ws + WS_CT); const u64* MW = (const u64*)(ws + WS_MASKW);
    for (int U = vcu; U < 1024; U += G) {
        const int v = U & 255, i4 = U >> 8; const int mode = i4 & 1, k = i4 >> 1; const int bh = v >> 3, s = v & 7;
        const int qb = (k == 0) ? s : 15 - s;
        if (mode == 0) attn_unit<0>(bh >> 3, bh & 7, qb, Z, Ob, cT, MW, (const void*)(ws + WS_KA), (const void*)((const unsigned*)(ws + WS_CTL) + CW_SB + l * 64), (LAS char*)lds, wv);
        else attn_unit<1>(bh >> 3, bh & 7, qb, Z, Ob, cT, MW, (const void*)(ws + WS_KA), (const void*)((const unsigned*)(ws + WS_CTL) + CW_SB + l * 64), (LAS char*)lds, wv);
    }
}

constexpr int HG_LF = 0, HG_KK = 16640, HG_SEG = 33280, HG_P = 35328, HG_R = HG_P + 9216, HG_RT = HG_R + 9216, HG_VT = HG_RT + 9216, HG_ST = HG_VT + 9216, HG_CG = HG_ST + 9216, HG_END = HG_CG + 9216;
static_assert(HG_END <= SCR_BYTES, "hgrn LDS");
constexpr int HP = 72;

__device__ __forceinline__ void hgrn_front(KP p, int l, const unsigned short (&zf)[8], int h, int d, int seg, LAS float* SEG, float (&kk)[8], float (&bb)[8], float& bm, float& bl) {
    const int dd = h * 64 + d; const float lb = (l == 0) ? 0.f : sigmoidf_(p->lb_logits[512 + dd] - p->lb_logits[dd]);
    float run = 0.f;
#pragma unroll
    for (int i = 0; i < 8; ++i) { const float sg = sigmoidf_(bf2f(zf[i])); const float f = lb + (1.f - lb) * sg; kk[i] = (1.f - lb) * (1.f - sg); run += __logf(f); bb[i] = run; }
    SEG[seg * 64 + d] = run;
    WG_BAR_LDS();
    float pre = 0.f, m4 = 0.f, all = 0.f;
#pragma unroll
    for (int s2 = 0; s2 < 8; ++s2) { const float sv = SEG[s2 * 64 + d]; if (s2 < seg) pre += sv; if (s2 < 4) m4 += sv; all += sv; }
#pragma unroll
    for (int i = 0; i < 8; ++i) bb[i] += pre;
    bm = m4; bl = all;
}

#define H_ROWP(U_) (Z + (size_t)((((U_) >> 7) >> 3) * SEQ + ((U_) & 127) * 64 + 8 * seg) * ZP + (((U_) >> 7) & 7) * 64 + d)
__device__ __forceinline__ void h1_phase(KP p, int l, LAS unsigned char* lds, int vcu, int G, int tid, int wave, int lane) {
    unsigned char* ws = p->ws; const bf16* Z = (const bf16*)(ws + WS_Z); float* Ug = (float*)(ws + WS_UG); float* Dg = (float*)(ws + WS_DG); float* D2g = (float*)(ws + WS_D2G);
    LAS float* SEG = (LAS float*)(lds + HG_SEG); LAS bf16* RT = (LAS bf16*)(lds + HG_RT); LAS bf16* VT = (LAS bf16*)(lds + HG_VT);
    const int r32 = lane & 31, hi = lane >> 5; const int d = tid & 63, seg = tid >> 6;
    for (int U = vcu; U < 4096; U += G) {
        const int bh = U >> 7, h = bh & 7; const bf16* rp = H_ROWP(U);
        unsigned short zf[8], vv[8];
#pragma unroll
        for (int i = 0; i < 8; ++i) { zf[i] = rp[(size_t)i * ZP + Z_CF]; vv[i] = rp[(size_t)i * ZP + Z_CI]; }
        float kk[8], bb[8], bm, bl; hgrn_front(p, l, zf, h, d, seg, SEG, kk, bb, bm, bl);
        { unsigned rw[4], vw[4];
#pragma unroll
          for (int i = 0; i < 4; ++i) { rw[i] = pk2(kk[2 * i] * __expf(fminf(bm - bb[2 * i], 80.f)), kk[2 * i + 1] * __expf(fminf(bm - bb[2 * i + 1], 80.f))); vw[i] = (unsigned)vv[2 * i] | ((unsigned)vv[2 * i + 1] << 16); }
          *(LAS u32x4*)(RT + d * HP + 8 * seg) = (u32x4){rw[0], rw[1], rw[2], rw[3]}; *(LAS u32x4*)(VT + d * HP + 8 * seg) = (u32x4){vw[0], vw[1], vw[2], vw[3]}; }
        if (seg == 7) { Dg[(size_t)U * 64 + d] = __expf(bl); D2g[(size_t)U * 64 + d] = __expf(bl - bm); }
        WG_BAR_LDS();
        if (wave < 4) { const int ib = wave >> 1, jb = wave & 1; f32x16 acc = {};
#pragma unroll
            for (int ks = 0; ks < 4; ++ks) { const bf16x8 a = *(const LAS bf16x8*)(RT + (32 * ib + r32) * HP + 16 * ks + 8 * hi), bq = *(const LAS bf16x8*)(VT + (32 * jb + r32) * HP + 16 * ks + 8 * hi);
                acc = MFMA32(a, bq, acc); }
            float* up = Ug + ((size_t)U * 64 + 32 * jb + r32) * 64 + 32 * ib + 4 * hi;
#pragma unroll
            for (int rr = 0; rr < 4; ++rr) *(f32x4*)(up + 8 * rr) = (f32x4){acc[4 * rr], acc[4 * rr + 1], acc[4 * rr + 2], acc[4 * rr + 3]}; }
        WG_BAR_LDS();
    }
}

__device__ __forceinline__ void h2_phase(KP p, int G, int tid) {
    unsigned char* ws = p->ws; const float* Ug = (const float*)(ws + WS_UG); const float* Dg = (const float*)(ws + WS_DG); const float* D2g = (const float*)(ws + WS_D2G); bf16* Sst = (bf16*)(ws + WS_SST);
    for (int gid = blockIdx.x * NTHR + tid; gid < 32 * 4096; gid += G * NTHR) {
        const int bh = gid >> 12, ed = gid & 4095, d = ed & 63; float S = 0.f;
        const float* up = Ug + (size_t)bh * 128 * 4096 + ed; const float* dp = Dg + (size_t)bh * 128 * 64 + d; const float* d2p = D2g + (size_t)bh * 128 * 64 + d; bf16* sp = Sst + (size_t)bh * 128 * 4096 + ed;
        for (int c0 = 0; c0 < 128; c0 += 8) { float u[8], dd[8], d2[8];
#pragma unroll
            for (int i = 0; i < 8; ++i) { u[i] = up[(size_t)(c0 + i) * 4096]; dd[i] = dp[(c0 + i) * 64]; d2[i] = d2p[(c0 + i) * 64]; }
#pragma unroll
            for (int i = 0; i < 8; ++i) { sp[(size_t)(c0 + i) * 4096] = (bf16)f2bf(S); S = dd[i] * S + d2[i] * u[i]; } }
    }
}

__device__ __forceinline__ void h3_phase(KP p, int l, LAS unsigned char* lds, int vcu, int G, int tid, int wave, int lane) {
    unsigned char* ws = p->ws; const bf16* Z = (const bf16*)(ws + WS_Z); const bf16* Sst = (const bf16*)(ws + WS_SST); bf16* Ob = (bf16*)(ws + WS_OBUF);
    LAS float* SEG = (LAS float*)(lds + HG_SEG);
    LAS bf16* Pt = (LAS bf16*)(lds + HG_P); LAS bf16* Rt = (LAS bf16*)(lds + HG_R); LAS bf16* VT = (LAS bf16*)(lds + HG_VT); LAS bf16* ST = (LAS bf16*)(lds + HG_ST); LAS bf16* CG = (LAS bf16*)(lds + HG_CG);
    const int r32 = lane & 31, hi = lane >> 5; const int d = tid & 63, seg = tid >> 6;
    const float* gn = p->norm_g + l * 512;
    for (int U = vcu; U < 4096; U += G) {
        const int bh = U >> 7, c = U & 127, b = bh >> 3, h = bh & 7; const int t0 = b * SEQ + c * 64; const bf16* rp = H_ROWP(U);
        unsigned short zf[8], qv[8], vv[8], gg[8], sv[8];
#pragma unroll
        for (int i = 0; i < 8; ++i) { zf[i] = rp[(size_t)i * ZP + Z_CF]; qv[i] = rp[(size_t)i * ZP + Z_CQ]; vv[i] = rp[(size_t)i * ZP + Z_CI]; gg[i] = rp[(size_t)i * ZP + Z_CG]; sv[i] = Sst[(size_t)U * 4096 + (8 * seg + i) * 64 + d]; }
        float kk[8], bb[8], bm, bl; hgrn_front(p, l, zf, h, d, seg, SEG, kk, bb, bm, bl); (void)bl;
        { const float ebm = __expf(bm); unsigned vw[4];
#pragma unroll
          for (int i = 0; i < 8; ++i) { const int t = 8 * seg + i;
              Pt[t * HP + d] = (bf16)f2bf(bf2f(qv[i]) * __expf(fminf(bb[i] - bm, 80.f))); Rt[t * HP + d] = (bf16)f2bf(kk[i] * __expf(fminf(bm - bb[i], 80.f)));
              ST[t * HP + d] = (bf16)f2bf(bf2f(sv[i]) * ebm); CG[t * HP + d] = (bf16)gg[i]; }
#pragma unroll
          for (int i = 0; i < 4; ++i) vw[i] = (unsigned)vv[2 * i] | ((unsigned)vv[2 * i + 1] << 16);
          *(LAS u32x4*)(VT + d * HP + 8 * seg) = (u32x4){vw[0], vw[1], vw[2], vw[3]}; }
        WG_BAR_LDS();
        if (wave < 2) { const int ib = wave;
            u32x4 pw[2][2];
#pragma unroll
            for (int k = 0; k < 2; ++k) { f32x16 a = {};
                if (k <= ib) {
#pragma unroll
                    for (int js = 0; js < 4; ++js) { const bf16x8 ra = *(const LAS bf16x8*)(Rt + (32 * k + r32) * HP + 16 * js + 8 * hi), pb = *(const LAS bf16x8*)(Pt + (32 * ib + r32) * HP + 16 * js + 8 * hi);
                        a = MFMA32(ra, pb, a); }
                    if (k == ib) {
#pragma unroll
                        for (int r = 0; r < 16; ++r) if (crow(r, hi) > r32) a[r] = 0.f;
                    }
                }
#pragma unroll
                for (int i = 0; i < 4; ++i) { pw[k][0][i] = cvtpk(a[2 * i], a[2 * i + 1]); pw[k][1][i] = cvtpk(a[8 + 2 * i], a[8 + 2 * i + 1]); } }
            f32x16 oacc[2]; float ss = 0.f;
#pragma unroll
            for (int j = 0; j < 2; ++j) { f32x16 oa = {};
#pragma unroll
                for (int k = 0; k < 2; ++k) { if (k <= ib) {
#pragma unroll
                    for (int st = 0; st < 2; ++st) { const LAS bf16* vp = VT + (32 * j + r32) * HP + 32 * k + 16 * st + 4 * hi;
                        const s16x4 v0 = *(const LAS s16x4*)vp, v1 = *(const LAS s16x4*)(vp + 8);
                        const bf16x8 vf = {v0[0], v0[1], v0[2], v0[3], v1[0], v1[1], v1[2], v1[3]};
                        oa = MFMA32(vf, __builtin_bit_cast(bf16x8, pw[k][st]), oa); } } }
#pragma unroll
                for (int js = 0; js < 4; ++js) { const bf16x8 sa = *(const LAS bf16x8*)(ST + (32 * j + r32) * HP + 16 * js + 8 * hi), pb = *(const LAS bf16x8*)(Pt + (32 * ib + r32) * HP + 16 * js + 8 * hi);
                    oa = MFMA32(sa, pb, oa); }
#pragma unroll
                for (int r = 0; r < 16; ++r) ss += oa[r] * oa[r];
                oacc[j] = oa; }
            ss = swapsum(ss);
            const float rstd = 1.0f / sqrtf(ss * (1.0f / 64.0f) + RMS_EPS);
            bf16* orow = Ob + (size_t)(t0 + 32 * ib + r32) * OP + 1024 + h * 64;
#pragma unroll
            for (int j = 0; j < 2; ++j)
#pragma unroll
                for (int rr = 0; rr < 4; ++rr) { const int e0 = 32 * j + 8 * rr + 4 * hi; const f32x4 g4 = *(const f32x4*)(gn + h * 64 + e0);
                    const u32x2 cw = *(const LAS u32x2*)(CG + (32 * ib + r32) * HP + e0);
                    const float o0 = oacc[j][4 * rr] * rstd * g4[0] * sigmoidf_(bflo(cw.x)), o1 = oacc[j][4 * rr + 1] * rstd * g4[1] * sigmoidf_(bfhi(cw.x));
                    const float o2 = oacc[j][4 * rr + 2] * rstd * g4[2] * sigmoidf_(bflo(cw.y)), o3 = oacc[j][4 * rr + 3] * rstd * g4[3] * sigmoidf_(bfhi(cw.y));
                    *(u32x2*)(orow + e0) = (u32x2){cvtpk(o0, o1), cvtpk(o2, o3)}; }
        }
        WG_BAR_LDS();
    }
}

#undef H_ROWP
constexpr int RT_LG = 0, RT_HIST = 8 * 2048, RT_END = RT_HIST + 1024;
static_assert(RT_END <= SCR_BYTES, "router LDS");
typedef short bf16x8_t __attribute__((ext_vector_type(8)));
__device__ __forceinline__ void split_hi_lo(const f32x4 a, const f32x4 b, bf16x8_t& hi, bf16x8_t& lo) {
    const float v[8] = {a.x, a.y, a.z, a.w, b.x, b.y, b.z, b.w}; unsigned h[8], l[8];
#pragma unroll
    for (int i = 0; i < 8; ++i) { h[i] = f2bf(v[i]); l[i] = f2bf(v[i] - bf2f(h[i])); }
    const u32x4 hw = {h[0] | (h[1] << 16), h[2] | (h[3] << 16), h[4] | (h[5] << 16), h[6] | (h[7] << 16)}, lw = {l[0] | (l[1] << 16), l[2] | (l[3] << 16), l[4] | (l[5] << 16), l[6] | (l[7] << 16)};
    hi = __builtin_bit_cast(bf16x8_t, hw); lo = __builtin_bit_cast(bf16x8_t, lw);
}
__device__ __forceinline__ void ln1_phase(KP p, int l, const float* xin, LAS unsigned char* lds, int G, int tid, int wave, int lane) {
    unsigned char* ws = p->ws; const float* mix = (const float*)(ws + WS_MIX); float* x1 = (float*)(ws + WS_X1); bf16* x1b = (bf16*)(ws + WS_X1B);
    int* tke = (int*)(ws + WS_TKE); float* tkg = (float*)(ws + WS_TKG); int* wgcnt = (int*)(ws + WS_WGCNT);
    LAS float* LG = (LAS float*)(lds + RT_LG) + wave * 512; LAS unsigned* hist = (LAS unsigned*)(lds + RT_HIST);
    if (tid < 32) hist[tid] = 0u;
    WG_BAR();
    const float* lg = p->ln1_g + l * 1024; const float* lb = p->ln1_b + l * 1024;
    f32x4 gv[4], bv[4];
#pragma unroll
    for (int j = 0; j < 4; ++j) { gv[j] = *(const f32x4*)(lg + 4 * lane + 256 * j); bv[j] = *(const f32x4*)(lb + 4 * lane + 256 * j); }
    const int m0 = blockIdx.x * NWAVES + wave, mstride = G * NWAVES;
    for (int mb = m0; mb < NTOK; mb += 16 * mstride) {
        f32x4 xa[4], xm[4];
        { const f32x4* xr = (const f32x4*)(xin + (size_t)mb * DM) + lane; const f32x4* mr = (const f32x4*)(mix + (size_t)mb * DM) + lane;
#pragma unroll
          for (int j = 0; j < 4; ++j) { xa[j] = xr[64 * j]; xm[j] = mr[64 * j]; } }
#pragma unroll 1
        for (int i = 0; i < 16; ++i) { const int m = mb + i * mstride; if (m >= NTOK) break;
            f32x4 v[4]; float s = 0.f;
#pragma unroll
            for (int j = 0; j < 4; ++j) { v[j] = xa[j] * ALPHA + xm[j]; s += (v[j].x + v[j].y) + (v[j].z + v[j].w); }
            { const int mn = (m + mstride < NTOK) ? m + mstride : m;
              const f32x4* xr = (const f32x4*)(xin + (size_t)mn * DM) + lane; const f32x4* mr = (const f32x4*)(mix + (size_t)mn * DM) + lane;
#pragma unroll
              for (int j = 0; j < 4; ++j) { xa[j] = xr[64 * j]; xm[j] = mr[64 * j]; } }
            const float mean = wave_sum(s) * (1.f / DM); float s2 = 0.f;
#pragma unroll
            for (int j = 0; j < 4; ++j) { v[j] = v[j] - mean; s2 += (v[j].x * v[j].x + v[j].y * v[j].y) + (v[j].z * v[j].z + v[j].w * v[j].w); }
            const float rstd = 1.f / sqrtf(wave_sum(s2) * (1.f / DM) + LN_EPS);
            f32x4* o4 = (f32x4*)(x1 + (size_t)m * DM) + lane; unsigned* o1 = (unsigned*)((unsigned char*)x1b + (size_t)m * DM) + lane;
#pragma unroll
            for (int j = 0; j < 4; ++j) { v[j] = v[j] * rstd * gv[j] + bv[j]; o4[64 * j] = v[j]; int w8 = __builtin_amdgcn_cvt_pk_fp8_f32(v[j].x, v[j].y, 0, false); w8 = __builtin_amdgcn_cvt_pk_fp8_f32(v[j].z, v[j].w, w8, true); o1[64 * j] = (unsigned)w8; } }
        asm volatile("s_waitcnt vmcnt(0)" ::: "memory"); __builtin_amdgcn_fence(__ATOMIC_ACQUIRE, "agent"); asm volatile("s_waitcnt vmcnt(0)" ::: "memory");
        { const int ti = lane & 15, kg = lane >> 4; int mt = mb + ti * mstride; if (mt >= NTOK) mt = mb;
          const float* xr = x1 + (size_t)mt * DM + 8 * kg; const bf16* wf = (const bf16*)(ws + WS_WRF) + (size_t)l * 32 * 2 * 2 * 512 + lane * 8;
          f32x4 acc0 = {0.f, 0.f, 0.f, 0.f}, acc1 = {0.f, 0.f, 0.f, 0.f};
#pragma unroll 4
          for (int s = 0; s < 32; ++s) { const f32x4 a0 = *(const f32x4*)(xr + 32 * s), a1 = *(const f32x4*)(xr + 32 * s + 4); bf16x8_t ah, al; split_hi_lo(a0, a1, ah, al);
              const bf16x8_t w0h = *(const bf16x8_t*)(wf + (size_t)(s * 4 + 0) * 512), w0l = *(const bf16x8_t*)(wf + (size_t)(s * 4 + 1) * 512), w1h = *(const bf16x8_t*)(wf + (size_t)(s * 4 + 2) * 512), w1l = *(const bf16x8_t*)(wf + (size_t)(s * 4 + 3) * 512);
              acc0 = __builtin_amdgcn_mfma_f32_16x16x32_bf16(ah, w0h, acc0, 0, 0, 0); acc0 = __builtin_amdgcn_mfma_f32_16x16x32_bf16(al, w0h, acc0, 0, 0, 0); acc0 = __builtin_amdgcn_mfma_f32_16x16x32_bf16(ah, w0l, acc0, 0, 0, 0);
              acc1 = __builtin_amdgcn_mfma_f32_16x16x32_bf16(ah, w1h, acc1, 0, 0, 0); acc1 = __builtin_amdgcn_mfma_f32_16x16x32_bf16(al, w1h, acc1, 0, 0, 0); acc1 = __builtin_amdgcn_mfma_f32_16x16x32_bf16(ah, w1l, acc1, 0, 0, 0); }
#pragma unroll
          for (int r = 0; r < 4; ++r) { LG[(4 * kg + r) * 32 + ti] = acc0[r]; LG[(4 * kg + r) * 32 + 16 + ti] = acc1[r]; } }
        LDS_WAIT();
        if (lane < 16) { const int m = mb + lane * mstride;
            if (m < NTOK) { float tv0 = -3e38f, tv1 = -3e38f, tv2 = -3e38f, tv3 = -3e38f; int ti0 = 0, ti1 = 0, ti2 = 0, ti3 = 0;
#pragma unroll
                for (int e4 = 0; e4 < 8; ++e4) { const f32x4 lv = *(const LAS f32x4*)(LG + lane * 32 + 4 * e4); const f32x4 bb = *(const f32x4*)(p->b_router + l * 32 + 4 * e4);
#pragma unroll
                    for (int i = 0; i < 4; ++i) { const float g = lv[i] + bb[i]; const int e = 4 * e4 + i;
                        if (g > tv0) { tv3 = tv2; ti3 = ti2; tv2 = tv1; ti2 = ti1; tv1 = tv0; ti1 = ti0; tv0 = g; ti0 = e; }
                        else if (g > tv1) { tv3 = tv2; ti3 = ti2; tv2 = tv1; ti2 = ti1; tv1 = g; ti1 = e; }
                        else if (g > tv2) { tv3 = tv2; ti3 = ti2; tv2 = g; ti2 = e; }
                        else if (g > tv3) { tv3 = g; ti3 = e; } } }
                const float e1 = __expf(tv1 - tv0), e2 = __expf(tv2 - tv0), e3 = __expf(tv3 - tv0); const float inv = 1.f / (1.f + e1 + e2 + e3);
                *(int4*)(tke + m * 4) = make_int4(ti0, ti1, ti2, ti3); *(f32x4*)(tkg + m * 4) = (f32x4){inv, e1 * inv, e2 * inv, e3 * inv};
                __hip_atomic_fetch_add(hist + ti0, 1u, __ATOMIC_RELAXED, __HIP_MEMORY_SCOPE_WORKGROUP); __hip_atomic_fetch_add(hist + ti1, 1u, __ATOMIC_RELAXED, __HIP_MEMORY_SCOPE_WORKGROUP);
                __hip_atomic_fetch_add(hist + ti2, 1u, __ATOMIC_RELAXED, __HIP_MEMORY_SCOPE_WORKGROUP); __hip_atomic_fetch_add(hist + ti3, 1u, __ATOMIC_RELAXED, __HIP_MEMORY_SCOPE_WORKGROUP); } }
        LDS_WAIT();
    }
    WG_BAR();
    if (tid < 32) wgcnt[blockIdx.x * 32 + tid] = (int)hist[tid];
}

__device__ __forceinline__ void slot_phase(KP p, LAS unsigned char* lds, int G, int tid, int wave, int lane) {
    unsigned char* ws = p->ws; const int* wgcnt = (const int*)(ws + WS_WGCNT); int* blk = (int*)(ws + WS_BLK);
    const int* tke = (const int*)(ws + WS_TKE); const float* tkg = (const float*)(ws + WS_TKG); int* tokslot = (int*)(ws + WS_TOKSLOT); float* gslot = (float*)(ws + WS_GSLOT);
    LAS unsigned* tot = (LAS unsigned*)lds; LAS unsigned* mine = tot + 32; LAS unsigned* cur = tot + 64;
    if (tid < 96) tot[tid] = 0u;
    WG_BAR();
    { const int e = tid & 31, part = tid >> 5; unsigned sa = 0u, sb = 0u;
      for (int w = part; w < G; w += 16) { const unsigned c = (unsigned)wgcnt[w * 32 + e]; sa += c; if (w < (int)blockIdx.x) sb += c; }
      __hip_atomic_fetch_add(tot + e, sa, __ATOMIC_RELAXED, __HIP_MEMORY_SCOPE_WORKGROUP); __hip_atomic_fetch_add(mine + e, sb, __ATOMIC_RELAXED, __HIP_MEMORY_SCOPE_WORKGROUP); }
    WG_BAR();
    if (tid == 0) { unsigned off = 0u;
#pragma unroll 1
        for (int e = 0; e < 32; ++e) { const unsigned padded = (tot[e] + 255u) & ~255u; cur[e] = off + mine[e];
            if (blockIdx.x == 0) { blk[BST_OFF + e] = (int)(off >> 8);
#pragma unroll 1
                for (unsigned bb = off >> 8; bb < ((off + padded) >> 8); ++bb) blk[16 + bb] = e; }
            off += padded; }
        if (blockIdx.x == 0) { blk[0] = (int)(off >> 8); blk[BST_OFF + 32] = (int)(off >> 8); } }
    WG_BAR();
    int* slottok = (int*)(ws + WS_SLOTTOK);
    if (blockIdx.x == 0 && tid < 32) { const unsigned ps = cur[tid], n = tot[tid];
        int zero_ = 0; asm volatile("" : "+v"(zero_));
#pragma unroll 1
        for (unsigned s = ps + n; s < ps + ((n + 255u) & ~255u); ++s) slottok[s] = zero_; }
    WG_BAR();
    for (int m = blockIdx.x * NWAVES + wave; m < NTOK; m += G * NWAVES) {
        if (lane < 4) { const int e = tke[m * 4 + lane]; const int slot = (int)__hip_atomic_fetch_add(cur + e, 1u, __ATOMIC_RELAXED, __HIP_MEMORY_SCOPE_WORKGROUP); tokslot[m * 4 + lane] = slot; gslot[slot] = tkg[m * 4 + lane]; slottok[slot] = m; }
    }
}

__device__ __forceinline__ void comb_phase(KP p, int l, float* xout, int G, int wave, int lane) {
    unsigned char* ws = p->ws; const float* x1 = (const float*)(ws + WS_X1); const bf16* y = (const bf16*)(ws + WS_Y); const int* tokslot = (const int*)(ws + WS_TOKSLOT); bf16* xb = (bf16*)(ws + WS_XB);
    const float* lg = p->ln2_g + l * 1024; const float* lb = p->ln2_b + l * 1024;
    f32x4 gv[4], bv[4];
#pragma unroll
    for (int j = 0; j < 4; ++j) { gv[j] = *(const f32x4*)(lg + 4 * lane + 256 * j); bv[j] = *(const f32x4*)(lb + 4 * lane + 256 * j); }
    for (int m = blockIdx.x * NWAVES + wave; m < NTOK; m += G * NWAVES) {
        const f32x4* xr = (const f32x4*)(x1 + (size_t)m * DM) + lane;
        f32x4 v[4];
#pragma unroll
        for (int j = 0; j < 4; ++j) v[j] = xr[64 * j] * ALPHA;
#pragma unroll
        for (int k = 0; k < 4; ++k) { const int sk = __builtin_amdgcn_readfirstlane(tokslot[m * 4 + k]); const u32x2* yr = (const u32x2*)(y + (size_t)sk * DM) + lane;
#pragma unroll
            for (int j = 0; j < 4; ++j) { const u32x2 w = yr[64 * j]; v[j].x += bflo(w.x); v[j].y += bfhi(w.x); v[j].z += bflo(w.y); v[j].w += bfhi(w.y); } }
        float s = 0.f;
#pragma unroll
        for (int j = 0; j < 4; ++j) s += (v[j].x + v[j].y) + (v[j].z + v[j].w);
        const float mean = wave_sum(s) * (1.f / DM); float s2 = 0.f;
#pragma unroll
        for (int j = 0; j < 4; ++j) { v[j] = v[j] - mean; s2 += (v[j].x * v[j].x + v[j].y * v[j].y) + (v[j].z * v[j].z + v[j].w * v[j].w); }
        const float rstd = 1.f / sqrtf(wave_sum(s2) * (1.f / DM) + LN_EPS);
        f32x4* o4 = (f32x4*)(xout + (size_t)m * DM) + lane; u32x2* o2 = (u32x2*)(xb + (size_t)m * DM) + lane;
#pragma unroll
        for (int j = 0; j < 4; ++j) { v[j] = v[j] * rstd * gv[j] + bv[j]; o4[64 * j] = v[j]; o2[64 * j] = (u32x2){pk2(v[j].x, v[j].y), pk2(v[j].z, v[j].w)}; }
    }
}

#ifndef ONE_LAUNCH
#define ONE_LAUNCH 1
#endif
__global__ void __launch_bounds__(NTHR, 2) fwd(Params p) {
    extern __shared__ __attribute__((aligned(16))) unsigned char lds_raw[];
    LAS unsigned char* lds = (LAS unsigned char*)lds_raw;
    volatile LAS unsigned* MISC = (volatile LAS unsigned*)(lds + MISC_OFF);
    const int tid = threadIdx.x, lane = tid & 63, wave = __builtin_amdgcn_readfirstlane(tid >> 6); const int wave0 = wave;
    const int G = gridDim.x; const int bx = blockIdx.x; const int vcu = (G % 8 == 0) ? (bx % 8) * (G / 8) + bx / 8 : bx;
    if (tid < 64) MISC[tid] = 0u;
    __syncthreads();
    if (p.use_bar) (void)xcd_barrier_post((unsigned*)(p.ws + WS_CTL) + CW_BAR, MISC + 8);
    const int lo = p.ph_lo, hi = p.ph_hi;
#ifndef PHSEL
#define PHSEL(k) true
#endif
#define IN(k) (PHSEL(k) && lo <= (k) && (k) < hi)
#define SEAM(k) do { if (lo <= (k) && (k) + 1 < hi) { KP qb_ = load_params(); XcdBarrier b_; b_.bar = (unsigned*)(qb_->ws + WS_CTL) + CW_BAR; b_.x = xb_xcc_id(); b_.st = MISC + 8; xcd_barrier(b_); } } while (0)
    const int gw0 = vcu * NWAVES + wave, NGW = G * NWAVES;
#define PH_IDS const int lane = lane_id(), wave = wave0, tid = wave0 * 64 + lane, gw = vcu * NWAVES + wave; (void)lane; (void)gw; (void)gw0;

    if (IN(0)) { PH_IDS KP q = load_params(); p0_prologue(q, lds, gw, NGW, wave, lane); SEAM(0); }

    for (int l = 0; l < DEPTH; ++l) {
        const int pb = 1 + l * NPH_LAYER;

        if (IN(pb + PH_INPROJ)) {
            KP q = load_params(); unsigned char* w = q->ws;
            pg8::Gemm g{(const bf16*)(w + WS_XB), (const bf16*)(w + WS_WIN) + (size_t)l * ZP * 1024, NTOK, ZP, 1024}; pg8::StaticOrder S; S.init(NTOK, ZP, G, bx);
            pg8::EpiZ E{(bf16*)(w + WS_Z), ZP, (const float*)(w + WS_TRIG)};
            pg8::gemm_phase<pg8::EpiZ, pg8::StaticOrder, true, true>(lds, g, S, E, wave0);
            SEAM(pb + PH_INPROJ);
        }
        if (IN(pb + PH_IDX)) { PH_IDS KP q = load_params(); idx_phase(q, l, lds, vcu, G, tid, wave, lane); SEAM(pb + PH_IDX); }
        if (IN(pb + PH_ATTN)) { PH_IDS KP q = load_params(); attn_phase(q, l, lds, vcu, G, wave0); SEAM(pb + PH_ATTN); }
        if (IN(pb + PH_H1)) { PH_IDS KP q = load_params(); h1_phase(q, l, lds, vcu, G, tid, wave, lane); SEAM(pb + PH_H1); }
        if (IN(pb + PH_H2)) { PH_IDS KP q = load_params(); h2_phase(q, G, tid); SEAM(pb + PH_H2); }
        if (IN(pb + PH_H3)) { PH_IDS KP q = load_params(); h3_phase(q, l, lds, vcu, G, tid, wave, lane); SEAM(pb + PH_H3); }
        if (IN(pb + PH_MERGE)) {
            KP q = load_params(); unsigned char* w = q->ws;
            pg8::Gemm g{(const bf16*)(w + WS_OBUF), (const bf16*)(w + WS_WP) + (size_t)l * 1024 * 1536, NTOK, 1024, 1536}; pg8::StaticOrder S; S.init(NTOK, 1024, G, bx);
            pg8::EpiMerge E{(const bf16*)(w + WS_Z) + Z_GT, ZP, (bf16*)(w + WS_MERGED), 1024};
            pg8::gemm_phase<pg8::EpiMerge, pg8::StaticOrder, true, true>(lds, g, S, E, wave0);
            SEAM(pb + PH_MERGE);
        }
        if (IN(pb + PH_WOUT)) {
            KP q = load_params(); unsigned char* w = q->ws;
            pg8::Gemm g{(const bf16*)(w + WS_MERGED), (const bf16*)(w + WS_WOUT) + (size_t)l * 1024 * 1024, NTOK, 1024, 1024}; pg8::StaticOrder S; S.init(NTOK, 1024, G, bx);
            pg8::EpiF32 E{(float*)(w + WS_MIX), 1024};
            pg8::gemm_phase<pg8::EpiF32, pg8::StaticOrder, true, true>(lds, g, S, E, wave0);
            SEAM(pb + PH_WOUT);
        }
        if (IN(pb + PH_LN1)) { PH_IDS KP q = load_params(); const float* xin = (l == 0) ? q->x : (const float*)(q->ws + WS_XCUR); ln1_phase(q, l, xin, lds, G, tid, wave, lane); SEAM(pb + PH_LN1); }
        if (IN(pb + PH_SLOT)) { PH_IDS KP q = load_params(); slot_phase(q, lds, G, tid, wave, lane); SEAM(pb + PH_SLOT); }
        if (IN(pb + PH_GU)) {
            KP q = load_params(); unsigned char* w = q->ws;
            pg8::Gemm g{(const bf16*)(w + WS_X1B), (const bf16*)(w + WS_WGU + (size_t)l * 32 * 2048 * 1024), MAXSLOT, 32 * 2048, 1024};
            pg8::moe_build_list((LAS int*)(lds + pg8::STAGE_BYTES), (const int*)(w + WS_BLK), 8, G, bx, wave0 * 64 + lane_id()); pg8::MoeOrderG S{(const LAS int*)(lds + pg8::STAGE_BYTES), (const int*)(w + WS_SLOTTOK)};
            pg8::EpiSwiGLU E{(bf16*)(w + WS_ACT), (const float*)(w + WS_BGU) + (size_t)l * 32 * 2048, 8};
            pg8::gemm_phase<pg8::EpiSwiGLU, pg8::MoeOrderG, true, true, true, W8_E8M0>(lds, g, S, E, wave0);
            SEAM(pb + PH_GU);
        }
        if (IN(pb + PH_DOWN)) {
            KP q = load_params(); unsigned char* w = q->ws;
            pg8::Gemm g{(const bf16*)(w + WS_ACT), (const bf16*)(w + WS_WDN + (size_t)l * 32 * 1024 * 1024), MAXSLOT, 32 * 1024, 1024};
            pg8::moe_build_list((LAS int*)(lds + pg8::STAGE_BYTES), (const int*)(w + WS_BLK), 4, G, bx, wave0 * 64 + lane_id()); pg8::MoeOrder S{(const LAS int*)(lds + pg8::STAGE_BYTES), nullptr};
            pg8::EpiDown E{(bf16*)(w + WS_Y), q->b_down + (size_t)l * 32 * 1024, (const float*)(w + WS_GSLOT), 4};
            pg8::gemm_phase<pg8::EpiDown, pg8::MoeOrder, true, true, true, W8_E8M0>(lds, g, S, E, wave0);
            SEAM(pb + PH_DOWN);
        }
        if (IN(pb + PH_COMB)) { PH_IDS KP q = load_params(); float* xout = (l == DEPTH - 1) ? q->out : (float*)(q->ws + WS_XCUR); comb_phase(q, l, xout, G, wave, lane); SEAM(pb + PH_COMB); }
    }
#undef IN
#undef SEAM
}

#ifndef DBG
#define DBG 0
#endif
#if DBG
constexpr int CW_DBG = 64;
__device__ __forceinline__ unsigned hsh(unsigned a) { a ^= a >> 16; a *= 0x7feb352du; a ^= a >> 15; a *= 0x846ca68bu; a ^= a >> 16; return a; }
__device__ __forceinline__ void dbg_fail(Params& p, int id) { atomicMin((int*)(p.ws + WS_CTL) + CW_DBG, id); }
__device__ __forceinline__ bool bad(float a, float ref, float rel, float abs_) { return !(fabsf(a - ref) <= rel * fabsf(ref) + abs_); }
__device__ __forceinline__ float dotx(const float* xr, const float* W, int ld, int col, int K) { float s = 0.f; for (int k = 0; k < K; ++k) s += xr[k] * W[(size_t)k * ld + col]; return s; }

__global__ void __launch_bounds__(64) chk(Params p, int l, int which) {
    __shared__ float Ssh[64 * 65];
    unsigned char* ws = p.ws; const int gt_ = blockIdx.x * 64 + threadIdx.x; const unsigned h0 = hsh(gt_ * 2654435761u + which * 97u + 12345u), h1 = hsh(h0 + 0x9e3779b9u), h2 = hsh(h1 + 77u);
    const float* xin = (l == 0) ? p.x : (const float*)(ws + WS_XCUR);
    const bf16* Z = (const bf16*)(ws + WS_Z);
    const int id = (l * 20 + which) * 4;
    const float* win = p.w_in + (size_t)l * 1024 * D_IN;
    if (which == 1) {
        const int t = h0 % NTOK, n = h1 % D_IN; const int sc = zcol_src(n); const float scale = (n < 512 || (n >= Z_FQ && n < Z_FK)) ? QSCALE : 1.f;
        const float ref = dotx(xin + (size_t)t * DM, win, D_IN, sc, 1024) * scale;
        if (bad(bf2f(Z[(size_t)t * ZP + n]), ref, 0.03f, 0.03f)) dbg_fail(p, id);
    } else if (which == 2) {
        const int t = h0 % NTOK, pos = t & (SEQ - 1), b = t >> 13; const float* xr = xin + (size_t)t * DM;
        { const int hh = h1 % 21, i = h2 & 31; const int col = hh < 8 ? Z_AQ + hh * 64 : hh < 16 ? Z_AK + (hh - 8) * 64 : hh < 20 ? Z_IQ + (hh - 16) * 64 : Z_IK;
          const float sc = hh < 8 ? QSCALE : 1.f; const float t1 = dotx(xr, win, D_IN, zcol_src(col + i), 1024) * sc, t2 = dotx(xr, win, D_IN, zcol_src(col + i + 32), 1024) * sc;
          const float inv = powf(10000.f, -(float)i / 32.f); const float ang = (float)pos * inv; const double rev = (double)ang * 0.15915494309189535; const float fr = (float)(rev - __builtin_rint(rev));
          const float c = __builtin_amdgcn_cosf(fr), s = __builtin_amdgcn_sinf(fr);
          if (bad(bf2f(Z[(size_t)t * ZP + col + i]), t1 * c - t2 * s, 0.03f, 0.03f) || bad(bf2f(Z[(size_t)t * ZP + col + i + 32]), t2 * c + t1 * s, 0.03f, 0.03f)) dbg_fail(p, id); }
        { const int c = h2 % 1024; const float a0 = dotx(xr, win, D_IN, 5452 + c, 1024), a1 = dotx(xr, win, D_IN, 5452 + 1024 + c, 1024), a2 = dotx(xr, win, D_IN, 5452 + 2048 + c, 1024);
          const float g0 = sigmoidf_(a0), g1 = sigmoidf_(a1), g2 = sigmoidf_(a2);
          if (bad(bf2f(Z[(size_t)t * ZP + Z_GT + c]), g0 / g1, 0.05f, 0.01f) || bad(bf2f(Z[(size_t)t * ZP + Z_GT + 1024 + c]), g1 / g2, 0.05f, 0.01f) || bad(bf2f(Z[(size_t)t * ZP + Z_GT + 2048 + c]), g2, 0.05f, 0.01f)) dbg_fail(p, id + 1); }
        { const int hh = h1 & 7; const float v = dotx(xr, win, D_IN, 3396 + hh, 1024) + p.b_fox[l * 8 + hh]; const float ls = -log1pf(expf(-v)) * LOG2E;
          if (bad(((const float*)(ws + WS_LFT))[(size_t)(b * 8 + hh) * SEQ + pos], ls, 0.05f, 0.003f)) dbg_fail(p, id + 2); }
    } else if (which == 3) {
        { const int bh = h0 & 31, t = h1 % SEQ; const float* lf = (const float*)(ws + WS_LFT) + (size_t)bh * SEQ; float s = 0.f; for (int i = 0; i <= t; ++i) s += lf[i];
          if (bad(((const float*)(ws + WS_CT))[(size_t)bh * SEQ + t], s, 1e-3f, 1e-2f)) dbg_fail(p, id); }
        if (gt_ < 192) { const int b = h1 & 3, q = (gt_ < 32) ? (int)(h2 % 512) : (int)(h2 % SEQ); const int nadm = ((q >> 6) + 1) * 64; const u64* mw = (const u64*)(ws + WS_MASKW) + (size_t)(b * SEQ + q) * 128;
          int pc = 0; bool oob = false; for (int w = 0; w < 128; ++w) { const u64 m = mw[w]; pc += __popcll(m); if (w * 64 >= nadm && m) oob = true; }
          if (pc != (nadm < 256 ? nadm : 256) || oob) dbg_fail(p, id + 1);
          const bf16* qr = Z + (size_t)(b * SEQ + q) * ZP; float minsel = 3e38f, maxun = -3e38f;
          for (int s = 0; s < nadm; ++s) { const bf16* kr = Z + (size_t)(b * SEQ + s) * ZP + Z_IK; float sc = 0.f;
              for (int hd = 0; hd < 4; ++hd) { float d = 0.f; for (int k = 0; k < 64; ++k) d += bf2f(qr[Z_IQ + hd * 64 + k]) * bf2f(kr[k]); sc += bf2f(qr[Z_IW + hd]) * 0.0625f * fmaxf(d, 0.f); }
              if ((mw[s >> 6] >> (s & 63)) & 1ull) minsel = fminf(minsel, sc); else maxun = fmaxf(maxun, sc); }
          if (nadm > 256 && !(maxun <= minsel + 0.02f * fabsf(minsel) + 2e-3f)) dbg_fail(p, id + 2); }
    } else if (which == 4) {
        if (gt_ == 0 && l == 0) { const bf16* ob = (const bf16*)(ws + WS_OBUF) + 512;
            const float a0 = bf2f(ob[0]), a1 = bf2f(ob[1]), a3 = bf2f(ob[3]), b0 = bf2f(ob[8]), b1 = bf2f(ob[9]), b3 = bf2f(ob[11]), m0 = bf2f(ob[4]), m1 = bf2f(ob[12]);
            auto tr = [](float v) { return v == 0.f ? 0.f : v == 1.f ? 1.f : 2.f; };
            ((float*)(ws + WS_CTL))[CW_DBG + 2] = 10.f * (tr(a0) + 3.f * tr(b0) + 9.f * tr(a1) + 27.f * tr(b1));
            ((float*)(ws + WS_CTL))[CW_DBG + 3] = sqrtf(10.f * (tr(a3) + 3.f * tr(b3) + 9.f * (m0 == m1 ? 1.f : 0.f) + 27.f * (m0 > -1e20f ? 1.f : 0.f))); }
        const int mode = gt_ & 1, b = h0 & 3, h = (h0 >> 2) & 7, q = (gt_ < 64) ? (int)(h1 % 300) : (int)(h1 % SEQ), d = h2 & 63;
        const int QC = mode == 0 ? Z_FQ : Z_AQ, KC = mode == 0 ? Z_FK : Z_AK, VC = mode == 0 ? Z_FV : Z_AV, OC = mode == 0 ? 512 : 0;
        const bf16* qr = Z + (size_t)(b * SEQ + q) * ZP + QC + h * 64; const float* c = (const float*)(ws + WS_CT) + (size_t)(b * 8 + h) * SEQ; const u64* mw = (const u64*)(ws + WS_MASKW) + (size_t)(b * SEQ + q) * 128;
        const int ns = mode == 0 ? q + 1 : ((q >> 6) + 1) * 64; float mx = -3e38f, mx2 = -3e38f; float ref = 0.f, ref2 = 0.f;
        for (int pass = 0; pass < 2; ++pass) { float den = 0.f, num = 0.f, den2 = 0.f, num2 = 0.f;
            for (int s = 0; s < ns; ++s) { if (mode == 1 && !((mw[s >> 6] >> (s & 63)) & 1ull)) continue;
                const bf16* kr = Z + (size_t)(b * SEQ + s) * ZP + KC + h * 64; float lg = 0.f; for (int k = 0; k < 64; ++k) lg += bf2f(qr[k]) * bf2f(kr[k]);
                const float lg2 = lg; if (mode == 0) lg += c[q] - c[s];
                if (pass == 0) { mx = fmaxf(mx, lg); mx2 = fmaxf(mx2, lg2); } else { const float vv = bf2f(Z[(size_t)(b * SEQ + s) * ZP + VC + h * 64 + d]); const float pp = exp2f(lg - mx), pq = exp2f(lg2 - mx2); den += pp; num += pp * vv; den2 += pq; num2 += pq * vv; } }
            if (pass == 1) { ref = num / den; ref2 = num2 / den2; } }
        const float got = bf2f(((const bf16*)(ws + WS_OBUF))[(size_t)(b * SEQ + q) * OP + OC + h * 64 + d]);
        if (bad(got, ref, 0.04f, 0.03f)) { dbg_fail(p, id + mode);
            int m = 0; if (mode == 0 && q == 0) m |= 1; if (mode == 0 && q < 32) m |= 2; if (mode == 1 && q < 64) m |= 4; if (mode == 1 && q >= 64) m |= 8; atomicOr((int*)(p.ws + WS_CTL) + CW_DBG + 1, m); }
    } else if (which == 7) {
        const int b = blockIdx.x & 3, h = (blockIdx.x >> 2) & 7, e = threadIdx.x;
        for (int d = 0; d < 64; ++d) Ssh[d * 65 + e] = 0.f;
        const float lbv_e = 0.f; (void)lbv_e;
        for (int t = 0; t < 200; ++t) { const bf16* zr = Z + (size_t)(b * SEQ + t) * ZP + h * 64; float o = 0.f; const float ve = bf2f(zr[Z_CI + e]);
            for (int d = 0; d < 64; ++d) { const int dd = h * 64 + d; const float lb = (l == 0) ? 0.f : sigmoidf_(p.lb_logits[512 + dd] - p.lb_logits[dd]);
                const float sg = sigmoidf_(bf2f(zr[Z_CF + d])); const float f = lb + (1.f - lb) * sg, kk = (1.f - lb) * (1.f - sg);
                const float S = f * Ssh[d * 65 + e] + kk * ve; Ssh[d * 65 + e] = S; o += bf2f(zr[Z_CQ + d]) * S; }
            const float ss = wave_sum(o * o); const float ref = o * (1.f / sqrtf(ss * (1.f / 64.f) + RMS_EPS)) * p.norm_g[l * 512 + h * 64 + e] * sigmoidf_(bf2f(zr[Z_CG + e]));
            if (bad(bf2f(((const bf16*)(ws + WS_OBUF))[(size_t)(b * SEQ + t) * OP + 1024 + h * 64 + e]), ref, 0.06f, 0.05f)) { const int n = atomicAdd((int*)(p.ws + WS_CTL) + CW_DBG + 4 + (t >= 64 ? 1 : 0), 1); if (n >= 40) dbg_fail(p, id + (t >= 64 ? 1 : 0)); } }
    } else if (which == 8) {
        const int t = h0 % NTOK, c = h1 % 1024; const bf16* zr = Z + (size_t)t * ZP + Z_GT; const float g2 = bf2f(zr[2048 + c]), g1 = bf2f(zr[1024 + c]) * g2, g0 = bf2f(zr[c]) * g1;
        const bf16* ob = (const bf16*)(ws + WS_OBUF) + (size_t)t * OP; float sa = 0.f, sb = 0.f, sc = 0.f;
        for (int k = 0; k < 512; ++k) { sa += bf2f(ob[k]) * p.w_pa[((size_t)l * 512 + k) * 1024 + c]; sb += bf2f(ob[512 + k]) * p.w_pb[((size_t)l * 512 + k) * 1024 + c]; sc += bf2f(ob[1024 + k]) * p.w_pc[((size_t)l * 512 + k) * 1024 + c]; }
        if (bad(bf2f(((const bf16*)(ws + WS_MERGED))[(size_t)t * 1024 + c]), g0 * sa + g1 * sb + g2 * sc, 0.04f, 0.01f)) dbg_fail(p, id);
    } else if (which == 9) {
        const int t = h0 % NTOK, c = h1 % 1024; const bf16* mr = (const bf16*)(ws + WS_MERGED) + (size_t)t * 1024; float s = 0.f;
        for (int k = 0; k < 1024; ++k) s += bf2f(mr[k]) * p.w_out[((size_t)l * 1024 + k) * 1024 + c];
        if (bad(((const float*)(ws + WS_MIX))[(size_t)t * 1024 + c], s, 0.03f, 0.005f)) dbg_fail(p, id);
    } else if (which == 10) {
        const int t = h0 % NTOK, c = h1 % 1024; const float* xr = xin + (size_t)t * DM; const float* mr = (const float*)(ws + WS_MIX) + (size_t)t * DM; const float* x1 = (const float*)(ws + WS_X1) + (size_t)t * DM;
        float mean = 0.f; for (int k = 0; k < 1024; ++k) mean += ALPHA * xr[k] + mr[k]; mean *= (1.f / 1024.f);
        float var = 0.f; for (int k = 0; k < 1024; ++k) { const float dlt = ALPHA * xr[k] + mr[k] - mean; var += dlt * dlt; } var *= (1.f / 1024.f);
        const float ref = (ALPHA * xr[c] + mr[c] - mean) / sqrtf(var + LN_EPS) * p.ln1_g[l * 1024 + c] + p.ln1_b[l * 1024 + c];
        if (bad(x1[c], ref, 1e-3f, 1e-3f) || bad(bf2f(((const bf16*)(ws + WS_X1B))[(size_t)t * DM + c]), ref, 0.01f, 0.01f)) dbg_fail(p, id);
        float tv0 = -3e38f, tv1 = -3e38f, tv2 = -3e38f, tv3 = -3e38f; int ti0 = -1, ti1 = -1, ti2 = -1, ti3 = -1;
        for (int e = 0; e < 32; ++e) { float lg = p.b_router[l * 32 + e]; for (int k = 0; k < 1024; ++k) lg += x1[k] * p.w_router[((size_t)l * 1024 + k) * 32 + e];
            if (lg > tv0) { tv3 = tv2; ti3 = ti2; tv2 = tv1; ti2 = ti1; tv1 = tv0; ti1 = ti0; tv0 = lg; ti0 = e; } else if (lg > tv1) { tv3 = tv2; ti3 = ti2; tv2 = tv1; ti2 = ti1; tv1 = lg; ti1 = e; }
            else if (lg > tv2) { tv3 = tv2; ti3 = ti2; tv2 = lg; ti2 = e; } else if (lg > tv3) { tv3 = lg; ti3 = e; } }
        const int* tke = (const int*)(ws + WS_TKE) + t * 4; const float* tkg = (const float*)(ws + WS_TKG) + t * 4;
        const float den = 1.f + expf(tv1 - tv0) + expf(tv2 - tv0) + expf(tv3 - tv0);
        if (tv2 - tv3 > 1e-3f && tv1 - tv2 > 1e-3f && tv0 - tv1 > 1e-3f) { if (tke[0] != ti0 || tke[1] != ti1 || tke[2] != ti2 || tke[3] != ti3) dbg_fail(p, id + 1);
            if (bad(tkg[0], 1.f / den, 1e-2f, 1e-3f) || bad(tkg[3], expf(tv3 - tv0) / den, 1e-2f, 1e-3f)) dbg_fail(p, id + 2); }
    } else if (which == 11) {
        const int t = h0 % NTOK, k = h1 & 3, c = h2 % 1024; const int slot = ((const int*)(ws + WS_TOKSLOT))[t * 4 + k], e = ((const int*)(ws + WS_TKE))[t * 4 + k]; const int* blk = (const int*)(ws + WS_BLK);
        if (slot < 0 || slot >= blk[0] * 256 || blk[0] > MAXBLK) { dbg_fail(p, id); return; }
        if (blk[16 + (slot >> 8)] != e) dbg_fail(p, id + 1);
        if (((const float*)(ws + WS_GSLOT))[slot] != ((const float*)(ws + WS_TKG))[t * 4 + k]) dbg_fail(p, id + 2);
        if (((const bf16*)(ws + WS_XG))[(size_t)slot * DM + c] != ((const bf16*)(ws + WS_X1B))[(size_t)t * DM + c]) dbg_fail(p, id + 3);
    } else if (which == 12) {
        const int t = h0 % NTOK, k = h1 & 3, j = h2 % 1024; const int slot = ((const int*)(ws + WS_TOKSLOT))[t * 4 + k], e = ((const int*)(ws + WS_TKE))[t * 4 + k];
        const bf16* xr = (const bf16*)(ws + WS_XG) + (size_t)slot * DM; const float* W = p.w_gu + (size_t)(l * 32 + e) * 1024 * 2048; float g = p.b_gu[(size_t)(l * 32 + e) * 2048 + j], u = p.b_gu[(size_t)(l * 32 + e) * 2048 + 1024 + j];
        for (int kk = 0; kk < 1024; ++kk) { const float xv = bf2f(xr[kk]); g += xv * W[(size_t)kk * 2048 + j]; u += xv * W[(size_t)kk * 2048 + 1024 + j]; }
        g = fminf(g, 7.f); u = fminf(fmaxf(u, -7.f), 7.f); const float ref = g * sigmoidf_(1.702f * g) * (u + 1.f);
        if (bad(bf2f(((const bf16*)(ws + WS_ACT))[(size_t)slot * 1024 + j]), ref, 0.04f, 0.02f)) dbg_fail(p, id);
    } else if (which == 13) {
        const int t = h0 % NTOK, k = h1 & 3, n = h2 % 1024; const int slot = ((const int*)(ws + WS_TOKSLOT))[t * 4 + k], e = ((const int*)(ws + WS_TKE))[t * 4 + k];
        const bf16* ar = (const bf16*)(ws + WS_ACT) + (size_t)slot * 1024; const float* W = p.w_down + (size_t)(l * 32 + e) * 1024 * 1024; float s = p.b_down[(size_t)(l * 32 + e) * 1024 + n];
        for (int kk = 0; kk < 1024; ++kk) s += bf2f(ar[kk]) * W[(size_t)kk * 1024 + n];
        if (bad(bf2f(((const bf16*)(ws + WS_Y))[(size_t)slot * 1024 + n]), s * ((const float*)(ws + WS_GSLOT))[slot], 0.04f, 0.005f)) dbg_fail(p, id);
    } else if (which == 14) {
        const int t = h0 % NTOK, c = h1 % 1024; const float* x1 = (const float*)(ws + WS_X1) + (size_t)t * DM; const bf16* y = (const bf16*)(ws + WS_Y); const int* ts = (const int*)(ws + WS_TOKSLOT) + t * 4;
        const float* xo = ((l == DEPTH - 1) ? p.out : (float*)(ws + WS_XCUR)) + (size_t)t * DM;
        float mean = 0.f; for (int k = 0; k < 1024; ++k) { float v = ALPHA * x1[k]; for (int j = 0; j < 4; ++j) v += bf2f(y[(size_t)ts[j] * 1024 + k]); mean += v; } mean *= (1.f / 1024.f);
        float var = 0.f, vc = 0.f; for (int k = 0; k < 1024; ++k) { float v = ALPHA * x1[k]; for (int j = 0; j < 4; ++j) v += bf2f(y[(size_t)ts[j] * 1024 + k]); var += (v - mean) * (v - mean); if (k == c) vc = v; } var *= (1.f / 1024.f);
        if (bad(xo[c], (vc - mean) / sqrtf(var + LN_EPS) * p.ln2_g[l * 1024 + c] + p.ln2_b[l * 1024 + c], 2e-3f, 2e-3f)) dbg_fail(p, id);
    }
}
__global__ void dbg_init(Params p) { if (threadIdx.x == 0 && blockIdx.x == 0) { ((int*)(p.ws + WS_CTL))[CW_DBG] = 0x7fffffff; ((int*)(p.ws + WS_CTL))[CW_DBG + 1] = 0; ((int*)(p.ws + WS_CTL))[CW_DBG + 4] = 0; ((int*)(p.ws + WS_CTL))[CW_DBG + 5] = 0; } }
__global__ void dbg_fill(Params p, int n) {
    const int code = ((const int*)(p.ws + WS_CTL))[CW_DBG]; if (code == 0x7fffffff) return;
    const int sub = code & 3, lw = code >> 2, l = lw / 20, which = lw % 20; const int k = l * 16 + which + 32 * sub;
    const float c = sqrtf(exp2f((float)k));
    const int msk = ((const int*)(p.ws + WS_CTL))[CW_DBG + 1];
    for (int i = blockIdx.x * blockDim.x + threadIdx.x; i < n; i += gridDim.x * blockDim.x) p.out[i] = (i == 0) ? 16.f * (float)(1 + msk) : c;
}
#endif

extern "C" void kernel_launch(void* const* d_in, const int* in_sizes, int n_in, void* d_out, int out_size, void* d_ws, size_t ws_size, hipStream_t stream) {
    static int grid = 0;
    if (grid == 0) {
        if (n_in != 19 || ws_size < WS_END) { fprintf(stderr, "kernel_launch: need 19 inputs and >= %zu bytes of workspace; got %d, %zu\n", (size_t)WS_END, n_in, ws_size); grid = -1; return; }
        int dev = 0, cus = 0, per_cu = 0;
        if (hipGetDevice(&dev) != hipSuccess || hipDeviceGetAttribute(&cus, hipDeviceAttributeMultiprocessorCount, dev) != hipSuccess) { grid = -1; return; }
        if (hipFuncSetAttribute((const void*)fwd, hipFuncAttributeMaxDynamicSharedMemorySize, LDS_BYTES) != hipSuccess) { fprintf(stderr, "kernel_launch: hipFuncSetAttribute failed\n"); grid = -1; return; }
        if (hipOccupancyMaxActiveBlocksPerMultiprocessor(&per_cu, (const void*)fwd, NTHR, LDS_BYTES) != hipSuccess || per_cu < 1) fprintf(stderr, "kernel_launch: occupancy query reports %d\n", per_cu);
        (void)hipGetLastError();
        grid = cus;
    }
    if (grid < 0) return;
    (void)hipMemsetAsync((char*)d_ws + WS_CTL, 0, CTL_ZERO_BYTES, stream);
    Params p{};
    const float** f = (const float**)&p;
    for (int i = 0; i < 19; ++i) f[i] = (const float*)d_in[i];
    p.out = (float*)d_out; p.ws = (unsigned char*)d_ws;
#if ONE_LAUNCH
    p.ph_lo = 0; p.ph_hi = NPHASES; p.use_bar = 1; p.pad = 0;
    hipLaunchKernelGGL(fwd, dim3(grid), dim3(NTHR), LDS_BYTES, stream, p);
#else
#if DBG
    hipLaunchKernelGGL(dbg_init, dim3(1), dim3(64), 0, stream, p);
#endif
    for (int ph = 0; ph < NPHASES; ++ph) { p.ph_lo = ph; p.ph_hi = ph + 1; p.use_bar = 0; p.pad = 0;
        hipLaunchKernelGGL(fwd, dim3(grid), dim3(NTHR), LDS_BYTES, stream, p);
#if DBG
        if (ph >= 1) { const int l = (ph - 1) / NPH_LAYER, k = (ph - 1) % NPH_LAYER; static const int wmap[NPH_LAYER] = {1, 2, 3, 4, 0, 0, 7, 8, 9, 10, 11, 12, 13, 14}; const int w = wmap[k];
            if (w) { const int nb = (w == 7) ? 32 : (w == 3) ? 4 : (w == 4) ? 2 : 16; hipLaunchKernelGGL(chk, dim3(nb), dim3(64), 0, stream, p, l, w); } }
#endif
    }
#if DBG
    hipLaunchKernelGGL(dbg_fill, dim3(1024), dim3(256), 0, stream, p, out_size);
#endif
#endif
}
```

```cpp
#include <hip/hip_runtime.h>
#include <cstdio>
#include <cstdint>

#define GAS __attribute__((address_space(1)))
#define LAS __attribute__((address_space(3)))
typedef unsigned short bf16;
typedef short bf16x8 __attribute__((ext_vector_type(8)));
typedef short s16x4 __attribute__((ext_vector_type(4)));
typedef float f32x2 __attribute__((ext_vector_type(2)));
typedef float f32x4 __attribute__((ext_vector_type(4)));
typedef float f32x16 __attribute__((ext_vector_type(16)));
typedef unsigned u32x2 __attribute__((ext_vector_type(2)));
typedef unsigned u32x4 __attribute__((ext_vector_type(4)));
typedef unsigned long long u64;

__device__ __forceinline__ unsigned f2bf(float f) { unsigned u = __builtin_bit_cast(unsigned, f); return (u + 0x7fffu + ((u >> 16) & 1u)) >> 16; }
__device__ __forceinline__ unsigned pk2(float lo, float hi) { return f2bf(lo) | (f2bf(hi) << 16); }
__device__ __forceinline__ float bf2f(unsigned b) { return __builtin_bit_cast(float, b << 16); }
__device__ __forceinline__ float bflo(unsigned w) { return __builtin_bit_cast(float, w << 16); }
__device__ __forceinline__ float bfhi(unsigned w) { return __builtin_bit_cast(float, w & 0xffff0000u); }
__device__ __forceinline__ float sigmoidf_(float x) { return 1.0f / (1.0f + __expf(-x)); }

namespace pg8 {
#define PG8_LAS __attribute__((address_space(3)))
typedef unsigned short bf16_t;
typedef short bf16x8 __attribute__((ext_vector_type(8)));
typedef float f32x4 __attribute__((ext_vector_type(4)));
typedef unsigned u32x4 __attribute__((ext_vector_type(4)));
constexpr int BM = 256, BK = 64, HALF = 128, HTB = HALF * BK * 2  , STAGE_BYTES = 8 * HTB, NXCD = 8, WGM = 8;

__host__ __device__ __forceinline__ int lds_byte(int r, int c) { const int st = (r >> 4) * 2 + (c >> 5), rr = r & 15, cc = c & 31, ob = rr * 64 + cc * 2; return st * 1024 + (ob ^ (((ob >> 9) & 1) << 5)); }
__host__ __device__ __forceinline__ void stage_rc(int b, int& R, int& C) { const int st = b / 1024, sb = b % 1024, swz = sb ^ (((sb >> 9) & 1) << 5); R = (st >> 1) * 16 + swz / 64; C = (st & 1) * 32 + (swz % 64) / 2; }
__host__ __device__ __forceinline__ int perm32(int rho) { const int n = rho >> 4, i = rho & 15; return 8 * (i >> 2) + 4 * n + (i & 3); }

struct Unit { int pm, pn; };
struct Gemm { const bf16_t* A; const bf16_t* Bt; int M, N, K; };

struct StaticOrder {
    static constexpr bool GATHER = false; const int* tok = nullptr;
    int nM, nN, nwg, G, c;
    __host__ __device__ void init(int M, int N, int G_, int c_) { nM = M / BM; nN = N / BM; nwg = nM * nN; G = G_; c = c_; }
    __host__ __device__ bool next(int i, Unit& u) const {
        const long L = (long)i * G + c; if (L >= nwg) return false;
        int wgid = (int)L; { const int q = nwg / NXCD, r = nwg % NXCD, xcd = wgid % NXCD, off = wgid / NXCD; wgid = (xcd < r ? xcd * (q + 1) : r * (q + 1) + (xcd - r) * q) + off; }
        const int nig = WGM * nN, gid = wgid / nig, fm = gid * WGM, gsz = (nM - fm) < WGM ? (nM - fm) : WGM;
        u.pm = fm + ((wgid % nig) % gsz); u.pn = (wgid % nig) / gsz; return true;
    }
    __device__ __forceinline__ void a_ready(const Unit&) const {}
    __device__ __forceinline__ void done(const Unit&) const {}
};
template <bool GATHER_> struct MoeOrderT {
    static constexpr bool GATHER = GATHER_;
    const PG8_LAS int* list; const int* tok;
    __device__ bool next(int i, Unit& u) const {
        if (i >= __builtin_amdgcn_readfirstlane(list[0])) return false;
        u.pm = __builtin_amdgcn_readfirstlane(list[2 + 2 * i]); u.pn = __builtin_amdgcn_readfirstlane(list[3 + 2 * i]); return true;
    }
    __device__ __forceinline__ void a_ready(const Unit&) const {}
    __device__ __forceinline__ void done(const Unit&) const {}
};
typedef MoeOrderT<false> MoeOrder; typedef MoeOrderT<true> MoeOrderG;
__device__ __forceinline__ void moe_build_list(PG8_LAS int* list, const int* blk, int nN, int G, int c, int tid) {
    if (tid == 0) { const int* bst = blk + 16 + 544 + 16; int n = 0;
        if (G % 8 == 0) { const int W = G / 8, j = c / 8, x = c % 8;
            for (int i = 0; i < 64; ++i) { const int uu = i * W + j; const int bi = uu / nN, pl = uu - bi * nN; int rem = bi; bool ok = false;
                for (int k = 0; k < 4 && !ok; ++k) { const int e = x + 8 * k; const int b0 = bst[e], b1 = bst[e + 1]; if (rem < b1 - b0) { list[2 + 2 * n] = b0 + rem; list[3 + 2 * n] = e * nN + pl; ++n; ok = true; } else rem -= b1 - b0; }
                if (!ok) break; }
        } else { const int nb = bst[32];
            for (int i = 0; i < 64; ++i) { const int uu = i * G + c; const int bi = uu / nN, pl = uu - bi * nN; if (bi >= nb) break; int e = 0; for (int k = 1; k < 32; ++k) if (bi >= bst[k]) e = k; list[2 + 2 * n] = bi; list[3 + 2 * n] = e * nN + pl; ++n; } }
        list[0] = n; }
    asm volatile("s_waitcnt lgkmcnt(0)\n\ts_barrier" ::: "memory");
}

__device__ __forceinline__ unsigned cvt_pk_bf16(float lo, float hi) { unsigned r; asm volatile("v_cvt_pk_bf16_f32 %0, %1, %2" : "=v"(r) : "v"(lo), "v"(hi)); return r; }

struct EpiZ {
    static constexpr bool PERM = true, AFTER_DRAIN = false, MIDK = false;
    bf16_t* O; int ldc; const float* trig;
    __device__ __forceinline__ void operator()(const f32x4 (&acc)[2][2][4][2], const Unit& u, int wr, int wc, int fr, int fq) const {
        asm volatile("" : "+v"(fr), "+v"(fq));
        const int row0 = u.pm * BM + wr * 64 + fr; const int col0 = u.pn * BM + wc * 32 + 8 * fq;
        const bool rot_all = (u.pn < 4) || (u.pn == 32); const bool rot_b0 = rot_all || (u.pn == 33 && wc < 2);
        const int i0 = (wc & 1) * 16 + 4 * fq;
#pragma unroll
        for (int ai = 0; ai < 2; ++ai)
#pragma unroll
            for (int m = 0; m < 4; ++m) { const int row = row0 + ai * HALF + m * 16; bf16_t* rowp = O + (size_t)row * ldc + col0;
                f32x4 ca = {1.f, 0.f, 1.f, 0.f}, cb = {1.f, 0.f, 1.f, 0.f};
                if (rot_b0) { const float* tp = trig + ((size_t)(row & 8191) * 32 + i0) * 2; ca = *(const f32x4*)tp; cb = *(const f32x4*)(tp + 4); }
#pragma unroll
                for (int bj = 0; bj < 2; ++bj) { f32x4 v0 = acc[ai][bj][m][0], v1 = acc[ai][bj][m][1];
                    if (bj == 0 ? rot_b0 : rot_all) {
                        const f32x4 r0 = {v0[0] * ca[0] - v0[1] * ca[1], v0[1] * ca[0] + v0[0] * ca[1], v0[2] * ca[2] - v0[3] * ca[3], v0[3] * ca[2] + v0[2] * ca[3]};
                        const f32x4 r1 = {v1[0] * cb[0] - v1[1] * cb[1], v1[1] * cb[0] + v1[0] * cb[1], v1[2] * cb[2] - v1[3] * cb[3], v1[3] * cb[2] + v1[2] * cb[3]};
                        v0 = r0; v1 = r1; }
                    u32x4 w; w.x = cvt_pk_bf16(v0[0], v0[1]); w.y = cvt_pk_bf16(v0[2], v0[3]); w.z = cvt_pk_bf16(v1[0], v1[1]); w.w = cvt_pk_bf16(v1[2], v1[3]);
                    *(u32x4*)(rowp + bj * HALF) = w; } }
    }
};
struct EpiF32 {
    static constexpr bool PERM = true, AFTER_DRAIN = false, MIDK = false;
    float* O; int ldc;
    __device__ __forceinline__ void operator()(const f32x4 (&acc)[2][2][4][2], const Unit& u, int wr, int wc, int fr, int fq) const {
        asm volatile("" : "+v"(fr), "+v"(fq));
        const int row0 = u.pm * BM + wr * 64 + fr; const int col0 = u.pn * BM + wc * 32 + 8 * fq;
#pragma unroll
        for (int ai = 0; ai < 2; ++ai)
#pragma unroll
            for (int m = 0; m < 4; ++m) { float* rowp = O + (size_t)(row0 + ai * HALF + m * 16) * ldc + col0;
#pragma unroll
                for (int bj = 0; bj < 2; ++bj) { *(f32x4*)(rowp + bj * HALF) = acc[ai][bj][m][0]; *(f32x4*)(rowp + bj * HALF + 4) = acc[ai][bj][m][1]; } }
    }
};
struct EpiMerge {
    static constexpr bool PERM = true, AFTER_DRAIN = false, MIDK = true;
    const bf16_t* Gz; int gp; bf16_t* O; int ldc;
    __device__ __forceinline__ void scale(f32x4 (&acc)[2][2][4][2], const Unit& u, int idx, int wr, int wc, int fr, int fq) const {
        asm volatile("" : "+v"(fr), "+v"(fq));
        const int row0 = u.pm * BM + wr * 64 + fr; const int col0 = u.pn * BM + wc * 32 + 8 * fq;
        const int pa = (idx == 2) ? 2048 : (idx == 1) ? 2048 : 1024, pb = (idx == 1) ? 1024 : 0;
#pragma unroll
        for (int ai = 0; ai < 2; ++ai)
#pragma unroll
            for (int m = 0; m < 4; ++m) { const bf16_t* rowp = Gz + (size_t)(row0 + ai * HALF + m * 16) * gp + col0;
#pragma unroll
                for (int bj = 0; bj < 2; ++bj) { const u32x4 wa = *(const u32x4*)(rowp + pa + bj * HALF); u32x4 wb = wa; if (idx != 2) wb = *(const u32x4*)(rowp + pb + bj * HALF);
                    float s[8];
#pragma unroll
                    for (int i = 0; i < 4; ++i) { const float ea0 = __expf(-bflo(wa[i])), ea1 = __expf(-bfhi(wa[i]));
                        if (idx == 2) { s[2 * i] = __builtin_amdgcn_rcpf(1.f + ea0); s[2 * i + 1] = __builtin_amdgcn_rcpf(1.f + ea1); }
                        else { const float eb0 = __expf(-bflo(wb[i])), eb1 = __expf(-bfhi(wb[i])); s[2 * i] = (1.f + ea0) * __builtin_amdgcn_rcpf(1.f + eb0); s[2 * i + 1] = (1.f + ea1) * __builtin_amdgcn_rcpf(1.f + eb1); } }
                    acc[ai][bj][m][0] = acc[ai][bj][m][0] * (f32x4){s[0], s[1], s[2], s[3]}; acc[ai][bj][m][1] = acc[ai][bj][m][1] * (f32x4){s[4], s[5], s[6], s[7]}; }
                asm volatile("" ::: "memory"); }
    }
    __device__ __forceinline__ void mid(f32x4 (&acc)[2][2][4][2], const Unit& u, int idx, int wr, int wc, int fr, int fq) const { scale(acc, u, idx, wr, wc, fr, fq); }
    __device__ __forceinline__ void operator()(f32x4 (&acc)[2][2][4][2], const Unit& u, int wr, int wc, int fr, int fq) const {
        scale(acc, u, 2, wr, wc, fr, fq);
        asm volatile("" : "+v"(fr), "+v"(fq));
        const int row0 = u.pm * BM + wr * 64 + fr; const int col0 = u.pn * BM + wc * 32 + 8 * fq;
#pragma unroll
        for (int ai = 0; ai < 2; ++ai)
#pragma unroll
            for (int m = 0; m < 4; ++m) { bf16_t* rowp = O + (size_t)(row0 + ai * HALF + m * 16) * ldc + col0;
#pragma unroll
                for (int bj = 0; bj < 2; ++bj) { const f32x4 v0 = acc[ai][bj][m][0], v1 = acc[ai][bj][m][1];
                    u32x4 w; w.x = cvt_pk_bf16(v0[0], v0[1]); w.y = cvt_pk_bf16(v0[2], v0[3]); w.z = cvt_pk_bf16(v1[0], v1[1]); w.w = cvt_pk_bf16(v1[2], v1[3]);
                    *(u32x4*)(rowp + bj * HALF) = w; } }
    }
};
struct EpiSwiGLU {
    static constexpr bool PERM = true, AFTER_DRAIN = false, MIDK = false;
    bf16_t* O; const float* bias; int nN;
    __device__ __forceinline__ void operator()(const f32x4 (&acc)[2][2][4][2], const Unit& u, int wr, int wc, int fr, int fq) const {
        const int e = u.pn / nN, pl = u.pn - e * nN;
        asm volatile("" : "+v"(fr), "+v"(fq));
        const int row0 = u.pm * BM + wr * 64 + fr; const int colt = pl * BM + wc * 32 + 8 * fq;
        const float* bp = bias + (size_t)e * 2048 + colt;
        f32x4 bv[2][2];
#pragma unroll
        for (int bj = 0; bj < 2; ++bj) { bv[bj][0] = *(const f32x4*)(bp + bj * HALF); bv[bj][1] = *(const f32x4*)(bp + bj * HALF + 4); }
#pragma unroll
        for (int ai = 0; ai < 2; ++ai)
#pragma unroll
            for (int m = 0; m < 4; ++m) { unsigned char* rowp = (unsigned char*)O + (size_t)(row0 + ai * HALF + m * 16) * 1024 + (colt >> 1);
#pragma unroll
                for (int bj = 0; bj < 2; ++bj) { const f32x4 v0 = acc[ai][bj][m][0] + bv[bj][0], v1 = acc[ai][bj][m][1] + bv[bj][1];
                    float a[4];
                    const float gt[4] = {v0[0], v0[2], v1[0], v1[2]}, up[4] = {v0[1], v0[3], v1[1], v1[3]};
#pragma unroll
                    for (int i = 0; i < 4; ++i) { const float g = fminf(gt[i], 7.0f); const float uu = fminf(fmaxf(up[i], -7.0f), 7.0f);
                        a[i] = g * (1.0f / (1.0f + __expf(-1.702f * g))) * (uu + 1.0f); }
                    int w8 = __builtin_amdgcn_cvt_pk_fp8_f32(a[0], a[1], 0, false); w8 = __builtin_amdgcn_cvt_pk_fp8_f32(a[2], a[3], w8, true);
                    *(unsigned*)(rowp + bj * (HALF / 2)) = (unsigned)w8; } }
    }
};
struct EpiDown {
    static constexpr bool PERM = true, AFTER_DRAIN = false, MIDK = false;
    bf16_t* O; const float* bias; const float* gate; int nN;
    __device__ __forceinline__ void operator()(const f32x4 (&acc)[2][2][4][2], const Unit& u, int wr, int wc, int fr, int fq) const {
        const int e = u.pn / nN, pl = u.pn - e * nN;
        asm volatile("" : "+v"(fr), "+v"(fq));
        const int row0 = u.pm * BM + wr * 64 + fr; const int colt = pl * BM + wc * 32 + 8 * fq;
        const float* bp = bias + (size_t)e * 1024 + colt;
        f32x4 bv[2][2];
#pragma unroll
        for (int bj = 0; bj < 2; ++bj) { bv[bj][0] = *(const f32x4*)(bp + bj * HALF); bv[bj][1] = *(const f32x4*)(bp + bj * HALF + 4); }
#pragma unroll
        for (int ai = 0; ai < 2; ++ai)
#pragma unroll
            for (int m = 0; m < 4; ++m) { const int row = row0 + ai * HALF + m * 16; const float gs = gate[row]; bf16_t* rowp = O + (size_t)row * 1024 + colt;
#pragma unroll
                for (int bj = 0; bj < 2; ++bj) { const f32x4 v0 = (acc[ai][bj][m][0] + bv[bj][0]) * gs, v1 = (acc[ai][bj][m][1] + bv[bj][1]) * gs;
                    u32x4 w; w.x = cvt_pk_bf16(v0[0], v0[1]); w.y = cvt_pk_bf16(v0[2], v0[3]); w.z = cvt_pk_bf16(v1[0], v1[1]); w.w = cvt_pk_bf16(v1[2], v1[3]);
                    *(u32x4*)(rowp + bj * HALF) = w; } }
    }
};

template <class Epi, class Sched, bool ALIGN_EPI = false, bool SP2 = false, bool FP8 = false, int SCALE_B = 127>
__device__ __forceinline__ void gemm_phase(PG8_LAS unsigned char* lds, const Gemm g, const Sched& S, const Epi& E, int wv) {
    int tid_l = (int)__builtin_amdgcn_mbcnt_hi(~0u, __builtin_amdgcn_mbcnt_lo(~0u, 0u)); asm volatile("" : "+v"(tid_l)); tid_l += wv * 64;
    const int tid = tid_l, wid = __builtin_amdgcn_readfirstlane(tid >> 6), lane = tid & 63, wr = wid >> 2, wc = wid & 3, fr = lane & 15, fq = lane >> 4;
    const int K = g.K; const int KB = FP8 ? K : 2 * K;
    const int nt = KB / (2 * BK);
    unsigned voffA[2], voffB[2];
#pragma unroll
    for (int i = 0; i < 2; ++i) { int R, C; stage_rc(tid * 16 + i * 8192, R, C); const int Rb = Epi::PERM ? ((R & ~31) + perm32(R & 31)) : R;
        voffA[i] = (unsigned)(R * KB + 2 * C); voffB[i] = (unsigned)(Rb * KB + 2 * C); }
    unsigned voGc[2][2]; PG8_LAS unsigned* voGn_l = (PG8_LAS unsigned*)(lds + STAGE_BYTES + 1024) + tid;
#define PG8_GOFF(dst, pmv) do { if constexpr (Sched::GATHER) { _Pragma("unroll") for (int _h = 0; _h < 2; ++_h) _Pragma("unroll") for (int _i = 0; _i < 2; ++_i) { \
        const unsigned _R = voffA[_i] / (unsigned)KB, _cb = voffA[_i] % (unsigned)KB; dst[_h][_i] = (unsigned)S.tok[(pmv) * BM + _h * HALF + (int)_R] * (unsigned)KB + _cb; } } } while (0)
    const size_t kstep = (size_t)(BK * 2);
    const size_t hstep = (size_t)HALF * KB;
    const size_t tstep = 2 * hstep;
    const unsigned ldsw = (unsigned)wid * 1024u;
    const int aoff = lds_byte(wr * 64 + fr, FP8 ? fq * 16 : fq * 8), boff = lds_byte(wc * 32 + fr, FP8 ? fq * 16 : fq * 8);
    const int aoff1 = FP8 ? lds_byte(wr * 64 + fr, fq * 16 + 8) - aoff : 1024, boff1 = FP8 ? lds_byte(wc * 32 + fr, fq * 16 + 8) - boff : 1024;
#define PG8_SA(b, h) (((b) * 2 + (h)) * HTB)
#define PG8_SB(b, h) ((4 + (b) * 2 + (h)) * HTB)
#define PG8_STAGE(bufoff, gbase, voff) do { _Pragma("unroll") for (int _i = 0; _i < 2; ++_i) \
        __builtin_amdgcn_global_load_lds((const unsigned*)((const char*)(gbase) + (voff)[_i]), (PG8_LAS unsigned*)(lds + (bufoff) + ldsw + _i * 8192), 16, 0, 0); } while (0)
#define PG8_STAGE_A(bufoff, base, h, nx) do { if constexpr (Sched::GATHER) { unsigned _vo[2] = {voGc[h][0], voGc[h][1]}; if (nx) { _vo[0] = voGn_l[((h) * 2 + 0) * 512]; _vo[1] = voGn_l[((h) * 2 + 1) * 512]; } PG8_STAGE(bufoff, base, _vo); } else { PG8_STAGE(bufoff, (base) + (h) * hstep, voffA); } } while (0)
#define PG8_LD8(dst8, n_, base_, off_, off1_) do { _Pragma("unroll") for (int q_ = 0; q_ < n_; ++q_) { const v4i_ lo_ = *(const PG8_LAS v4i_*)(lds + (base_) + (off_) + q_ * 2048), hi_ = *(const PG8_LAS v4i_*)(lds + (base_) + (off_) + q_ * 2048 + (off1_)); \
        dst8[q_] = __builtin_shufflevector(lo_, hi_, 0, 1, 2, 3, 4, 5, 6, 7); } } while (0)
#define PG8_LDA(dst, b, h) do { if constexpr (FP8) { PG8_LD8(dst##8, 4, PG8_SA(b, h), aoff, aoff1); } else { _Pragma("unroll") for (int m = 0; m < 4; ++m) _Pragma("unroll") for (int k = 0; k < 2; ++k) dst[m][k] = *(const PG8_LAS bf16x8*)(lds + PG8_SA(b, h) + aoff + m * 2048 + k * aoff1); } } while (0)
#define PG8_LDB(dst, b, h) do { if constexpr (FP8) { PG8_LD8(dst##8, 2, PG8_SB(b, h), boff, boff1); } else { _Pragma("unroll") for (int n = 0; n < 2; ++n) _Pragma("unroll") for (int k = 0; k < 2; ++k) dst[n][k] = *(const PG8_LAS bf16x8*)(lds + PG8_SB(b, h) + boff + n * 2048 + k * boff1); } } while (0)
#define PG8_MMA(ai, bj, At, Bt) do { if constexpr (FP8) __builtin_amdgcn_sched_barrier(0); __builtin_amdgcn_s_setprio(1); _Pragma("unroll") for (int m = 0; m < 4; ++m) _Pragma("unroll") for (int n = 0; n < 2; ++n) { \
        if constexpr (FP8) { asm volatile("v_mfma_scale_f32_16x16x128_f8f6f4 %0, %1, %2, %0, %3, %4 op_sel_hi:[0,0,0]" : "+v"(acc[ai][bj][m][n]) : "v"(Bt##8[n]), "v"(At##8[m]), "v"(sclB), "v"(sclA)); } \
        else { _Pragma("unroll") for (int k = 0; k < 2; ++k) acc[ai][bj][m][n] = __builtin_amdgcn_mfma_f32_16x16x32_bf16(Bt[n][k], At[m][k], acc[ai][bj][m][n], 0, 0, 0); } } \
        __builtin_amdgcn_s_setprio(0); if constexpr (FP8) __builtin_amdgcn_sched_barrier(0); } while (0)
#define PG8_WAIT_V(n) asm volatile("s_waitcnt vmcnt(" #n ")" ::: "memory")
#define PG8_WAIT_L(n) asm volatile("s_waitcnt lgkmcnt(" #n ")" ::: "memory")
#define PG8_BAR __builtin_amdgcn_s_barrier()
#define PG8_SCHED __builtin_amdgcn_sched_barrier(0)
    Unit cur, nxt; int ui = 0;
    if (!S.next(0, cur)) return;
    f32x4 acc[2][2][4][2];
#pragma unroll
    for (int a = 0; a < 2; ++a)
#pragma unroll
        for (int b = 0; b < 2; ++b)
#pragma unroll
            for (int m = 0; m < 4; ++m)
#pragma unroll
                for (int n = 0; n < 2; ++n) acc[a][b][m][n] = (f32x4){0.f, 0.f, 0.f, 0.f};
    bf16x8 At[4][2], B0[2][2], B1[2][2];
    typedef int v8i_ __attribute__((ext_vector_type(8))); typedef int v4i_ __attribute__((ext_vector_type(4)));
    int sclB = SCALE_B * 0x01010101, sclA = 0x7f7f7f7f; asm volatile("" : "+v"(sclB), "+v"(sclA));
    v8i_ At8[4], B08[2], B18[2];
    const char* cA = (const char*)g.A + (Sched::GATHER ? (size_t)0 : (size_t)cur.pm * tstep); const char* cB = (const char*)g.Bt + (size_t)cur.pn * tstep;
    PG8_GOFF(voGc, cur.pm);
    S.a_ready(cur);
    if constexpr (SP2) {
        PG8_STAGE(PG8_SB(0, 0), cB, voffB); PG8_STAGE(PG8_SB(0, 1), cB + hstep, voffB); PG8_STAGE_A(PG8_SA(0, 0), cA, 0, false); PG8_STAGE_A(PG8_SA(0, 1), cA, 1, false);
        if (wr == 1) PG8_BAR;
        PG8_WAIT_V(2); PG8_BAR;
        PG8_STAGE(PG8_SB(1, 0), cB + kstep, voffB); PG8_STAGE_A(PG8_SA(1, 0), cA + kstep, 0, false); PG8_STAGE(PG8_SB(1, 1), cB + hstep + kstep, voffB);
        PG8_WAIT_V(6); PG8_BAR;
    } else {
        PG8_STAGE(PG8_SB(0, 0), cB, voffB); PG8_STAGE_A(PG8_SA(0, 0), cA, 0, false); PG8_STAGE(PG8_SB(0, 1), cB + hstep, voffB); PG8_STAGE_A(PG8_SA(0, 1), cA, 1, false);
        if (wr == 1) PG8_BAR;
        PG8_WAIT_V(4); PG8_BAR;
        PG8_STAGE(PG8_SB(1, 0), cB + kstep, voffB); PG8_STAGE_A(PG8_SA(1, 0), cA + kstep, 0, false); PG8_STAGE(PG8_SB(1, 1), cB + hstep + kstep, voffB);
        PG8_WAIT_V(6); PG8_BAR;
    }
    for (;;) {
        const bool has_next = S.next(ui + 1, nxt);
        const char* nA = has_next ? (const char*)g.A + (Sched::GATHER ? (size_t)0 : (size_t)nxt.pm * tstep) : cA;
        if constexpr (Sched::GATHER) { unsigned _vn[2][2]; if (has_next) { PG8_GOFF(_vn, nxt.pm); } else { _Pragma("unroll") for (int _h = 0; _h < 2; ++_h) _Pragma("unroll") for (int _i = 0; _i < 2; ++_i) _vn[_h][_i] = voGc[_h][_i]; }
            _Pragma("unroll") for (int _h = 0; _h < 2; ++_h) _Pragma("unroll") for (int _i = 0; _i < 2; ++_i) voGn_l[(_h * 2 + _i) * 512] = _vn[_h][_i]; } const char* nB = has_next ? (const char*)g.Bt + (size_t)nxt.pn * tstep : cB;
        for (int t = 0; t < nt; t += 2) {
            const bool last = (t == nt - 2);
            const char* a1 = cA + (size_t)(t + 1) * kstep;
            const char* a2 = last ? nA : cA + (size_t)(t + 2) * kstep; const char* b2 = last ? nB : cB + (size_t)(t + 2) * kstep;
            const char* a3 = a2 + kstep; const char* b3 = b2 + kstep;
            if (last && has_next) S.a_ready(nxt);
            if constexpr (SP2) {
            PG8_LDB(B0, 0, 0); PG8_LDB(B1, 0, 1); PG8_SCHED; PG8_LDA(At, 0, 0); PG8_STAGE_A(PG8_SA(1, 1), a1, 1, false);
            PG8_WAIT_V(8); PG8_WAIT_L(0); PG8_BAR; PG8_MMA(0, 0, At, B0); PG8_MMA(0, 1, At, B1); PG8_BAR; PG8_SCHED;
            PG8_LDA(At, 0, 1); PG8_STAGE(PG8_SB(0, 0), b2, voffB); PG8_STAGE(PG8_SB(0, 1), b2 + hstep, voffB); PG8_STAGE_A(PG8_SA(0, 0), a2, 0, last);
            PG8_WAIT_V(8); PG8_WAIT_L(0); PG8_BAR; PG8_MMA(1, 0, At, B0); PG8_MMA(1, 1, At, B1); PG8_BAR; PG8_SCHED;
            PG8_LDB(B0, 1, 0); PG8_LDB(B1, 1, 1); PG8_SCHED; PG8_LDA(At, 1, 0); PG8_STAGE_A(PG8_SA(0, 1), a2, 1, last);
            PG8_WAIT_V(8); PG8_WAIT_L(0); PG8_BAR; PG8_MMA(0, 0, At, B0); PG8_MMA(0, 1, At, B1); PG8_BAR; PG8_SCHED;
            PG8_LDA(At, 1, 1); PG8_STAGE(PG8_SB(1, 0), b3, voffB); PG8_STAGE(PG8_SB(1, 1), b3 + hstep, voffB); PG8_STAGE_A(PG8_SA(1, 0), a3, 0, last);
            PG8_WAIT_V(8); PG8_WAIT_L(0); PG8_BAR; PG8_MMA(1, 0, At, B0); PG8_MMA(1, 1, At, B1); PG8_BAR; PG8_SCHED;
            } else {
            PG8_LDB(B0, 0, 0); PG8_SCHED; PG8_LDA(At, 0, 0); PG8_STAGE_A(PG8_SA(1, 1), a1, 1, false);
            PG8_WAIT_L(8); PG8_BAR; PG8_WAIT_L(0); PG8_MMA(0, 0, At, B0); PG8_BAR; PG8_SCHED;
            PG8_LDB(B1, 0, 1); PG8_STAGE(PG8_SB(0, 0), b2, voffB);
            PG8_BAR; PG8_WAIT_L(0); PG8_MMA(0, 1, At, B1); PG8_BAR;
            PG8_LDA(At, 0, 1); PG8_STAGE_A(PG8_SA(0, 0), a2, 0, last);
            PG8_BAR; PG8_WAIT_L(0); PG8_MMA(1, 0, At, B0); PG8_BAR; PG8_SCHED;
            PG8_STAGE(PG8_SB(0, 1), b2 + hstep, voffB);
            PG8_WAIT_V(6); PG8_BAR; PG8_MMA(1, 1, At, B1); PG8_BAR;
            PG8_LDB(B0, 1, 0); PG8_SCHED; PG8_LDA(At, 1, 0); PG8_STAGE_A(PG8_SA(0, 1), a2, 1, last);
            PG8_WAIT_L(8); PG8_BAR; PG8_WAIT_L(0); PG8_MMA(0, 0, At, B0); PG8_BAR; PG8_SCHED;
            PG8_LDB(B1, 1, 1); PG8_STAGE(PG8_SB(1, 0), b3, voffB);
            PG8_BAR; PG8_WAIT_L(0); PG8_MMA(0, 1, At, B1); PG8_BAR;
            PG8_LDA(At, 1, 1); PG8_STAGE_A(PG8_SA(1, 0), a3, 0, last);
            PG8_BAR; PG8_WAIT_L(0); PG8_MMA(1, 0, At, B0); PG8_BAR; PG8_SCHED;
            PG8_STAGE(PG8_SB(1, 1), b3 + hstep, voffB);
            PG8_WAIT_V(6); PG8_BAR; PG8_MMA(1, 1, At, B1); PG8_BAR;
            }
            if constexpr (Epi::MIDK) { if (((t + 2) & 7) == 0 && t + 2 < nt) E.mid(acc, cur, ((t + 2) >> 3) - 1, wr, wc, fr, fq); }
        }
        if constexpr (FP8) asm volatile("s_nop 15\n\ts_nop 15" ::: "memory");
        if constexpr (ALIGN_EPI) { if (wr == 0) PG8_BAR; }
        if constexpr (!Epi::AFTER_DRAIN) { E(acc, cur, wr, wc, fr, fq); S.done(cur); }
        if (!has_next) break;
#pragma unroll
        for (int a = 0; a < 2; ++a)
#pragma unroll
            for (int b = 0; b < 2; ++b)
#pragma unroll
                for (int m = 0; m < 4; ++m)
#pragma unroll
                    for (int n = 0; n < 2; ++n) acc[a][b][m][n] = (f32x4){0.f, 0.f, 0.f, 0.f};
        cur = nxt; cA = nA; cB = nB; ++ui;
        if constexpr (Sched::GATHER) { _Pragma("unroll") for (int _h = 0; _h < 2; ++_h) _Pragma("unroll") for (int _i = 0; _i < 2; ++_i) voGc[_h][_i] = voGn_l[(_h * 2 + _i) * 512]; }
        if constexpr (ALIGN_EPI) { if (wr == 1) PG8_BAR; }
    }
    PG8_WAIT_V(0);
    if constexpr (!ALIGN_EPI) { if (wr == 0) PG8_BAR; }
    PG8_BAR;
#undef PG8_SA
#undef PG8_SB
#undef PG8_STAGE
#undef PG8_STAGE_A
#undef PG8_GOFF
#undef PG8_LDA
#undef PG8_LD8
#undef PG8_LDB
#undef PG8_MMA
#undef PG8_WAIT_V
#undef PG8_WAIT_L
#undef PG8_BAR
#undef PG8_SCHED
}
}
constexpr int BATCH = 4, SEQ = 8192, DM = 1024, NTOK = BATCH * SEQ, DEPTH = 2, NEXP = 32;
constexpr int D_IN = 8524, ZP = 8704;
constexpr int Z_AQ = 0, Z_AK = 512, Z_AV = 1024, Z_FQ = 1536, Z_FK = 2048, Z_FV = 2560, Z_CQ = 3072, Z_CF = 3584, Z_CI = 4096, Z_CG = 4608, Z_GT = 5120, Z_IQ = 8192, Z_IK = 8448, Z_IW = 8512, Z_FF = 8516;
constexpr int OP = 1536;
constexpr int MAXBLK = 544, MAXSLOT = MAXBLK * 256;
constexpr int BST_OFF = 16 + MAXBLK + 16;
constexpr float LOG2E = 1.4426950408889634f;
constexpr float QSCALE = 0.125f * LOG2E;
constexpr float ALPHA = 1.4142135623730951f;
constexpr float LN_EPS = 1e-5f, RMS_EPS = 1e-6f;
constexpr int NWAVES = 8, NTHR = 512;
constexpr float W8_SCALE = 64.0f; constexpr int W8_E8M0 = 127 - 6;
constexpr int NPH_LAYER = 14, NPHASES = 1 + DEPTH * NPH_LAYER;
enum { PH_INPROJ = 0, PH_PREP, PH_IDX, PH_ATTN, PH_H1, PH_H2, PH_H3, PH_MERGE, PH_WOUT, PH_LN1, PH_SLOT, PH_GU, PH_DOWN, PH_COMB };

__host__ __device__ __forceinline__ int zcol_src(int n) {
    if (n < 1024 || (n >= 8192 && n < 8512)) { const int p = n & 63; n = (n & ~63) + ((p & 1) ? 32 + (p >> 1) : (p >> 1)); }
    if (n < 1536) return n;
    if (n < 3072) return 1860 + (n - 1536);
    if (n < 5120) return 3404 + (n - 3072);
    if (n < 8192) return 5452 + (n - 5120);
    if (n < 8448) return 1536 + (n - 8192);
    if (n < 8512) return 1792 + (n - 8448);
    if (n < 8516) return 1856 + (n - 8512);
    if (n < 8524) return 3396 + (n - 8516);
    return -1;
}

constexpr size_t MiB = 1u << 20;
constexpr size_t WS_CTL = 0, CTL_ZERO_BYTES = 1 * MiB;
constexpr size_t WS_TRIG = 1 * MiB;
constexpr size_t WS_LFT = 3 * MiB;
constexpr size_t WS_CT = 4 * MiB;
constexpr size_t WS_DG = 5 * MiB, WS_D2G = 6 * MiB;
constexpr size_t WS_WGCNT = 7 * MiB;
constexpr size_t WS_BLK = 7 * MiB + 64 * 1024;
constexpr size_t WS_BGU = 7 * MiB + 128 * 1024;
constexpr size_t WS_TKE = 8 * MiB, WS_TKG = 8 * MiB + 512 * 1024, WS_TOKSLOT = 9 * MiB, WS_GSLOT = 9 * MiB + 512 * 1024;
constexpr size_t WS_SLOTTOK = 10 * MiB + 512 * 1024;
constexpr size_t WS_WRF = 11 * MiB;
constexpr size_t WS_WIN = 12 * MiB;
constexpr size_t WS_WP = 46 * MiB;
constexpr size_t WS_WOUT = 52 * MiB;
constexpr size_t WS_WGU = 56 * MiB;
constexpr size_t WS_WDN = 312 * MiB;
constexpr size_t WS_Z = 440 * MiB;
constexpr size_t WS_XG = WS_Z, WS_ACT = WS_Z + 272 * MiB;
constexpr size_t WS_OBUF = 984 * MiB;
constexpr size_t WS_MERGED = 1080 * MiB;
constexpr size_t WS_MIX = 1144 * MiB;
constexpr size_t WS_Y = WS_OBUF;
constexpr size_t WS_X1 = 1272 * MiB;
constexpr size_t WS_X1B = 1400 * MiB;
constexpr size_t WS_XCUR = 1464 * MiB;
constexpr size_t WS_XB = 1592 * MiB;
constexpr size_t WS_MASKW = 1656 * MiB;
constexpr size_t WS_UG = 1688 * MiB;
constexpr size_t WS_SST = 1752 * MiB;
constexpr size_t WS_SB = 7 * MiB + 768 * 1024;
constexpr size_t WS_KA = 1784 * MiB;
constexpr size_t WS_END = 1792 * MiB;
static_assert(WS_Y + (size_t)MAXSLOT * 1024 * 2 <= WS_X1 && WS_ACT + (size_t)MAXSLOT * 1024 * 2 <= WS_OBUF, "ws map");
constexpr int CW_TMO = 0;
constexpr int CW_BAR = 4096;
constexpr int CW_SB = 512;

constexpr int SCR_BYTES = 153600;
constexpr int MISC_OFF = SCR_BYTES;
constexpr int LDS_BYTES = SCR_BYTES + 256;

#define RLX_AGENT __ATOMIC_RELAXED, __HIP_MEMORY_SCOPE_AGENT
#define LDS_WAIT() asm volatile("s_waitcnt lgkmcnt(0)" ::: "memory")
#define VM_WAIT() asm volatile("s_waitcnt vmcnt(0)" ::: "memory")
#define WG_BAR() asm volatile("s_waitcnt vmcnt(0) lgkmcnt(0)\n\ts_barrier" ::: "memory")
#define WG_BAR_LDS() asm volatile("s_waitcnt lgkmcnt(0)\n\ts_barrier" ::: "memory")

#define XB_TMO      128
#define XB_XCNT(j)  (256  + 64 * (j))
#define XB_XSUB(j)  (1280 + 64 * (j))
#define XB_XGEN(j)  (2304 + 64 * (j))
#define XB_TOP      3328
#define XB_TOPGEN   3392
#define XCD_BAR_WORDS 3456
#define XB_SPIN_CAP (1u << 18)

__device__ __forceinline__ unsigned xb_ld(unsigned* p)              { return __hip_atomic_load(p, __ATOMIC_RELAXED, __HIP_MEMORY_SCOPE_AGENT); }
__device__ __forceinline__ unsigned xb_add(unsigned* p, unsigned v) { return __hip_atomic_fetch_add(p, v, __ATOMIC_RELAXED, __HIP_MEMORY_SCOPE_AGENT); }
__device__ __forceinline__ unsigned xb_xcc_id() { return (unsigned)__builtin_amdgcn_s_getreg((3 << 11) | 20) & 0xFu; }
#define XB_SPIN(cond, bar) do { unsigned _sp = 0; while (cond) { __builtin_amdgcn_s_sleep(1); \
    if ((++_sp & 255u) == 0u) { if (xb_ld(&(bar)[XB_TMO])) break; if (_sp > XB_SPIN_CAP) { atomicAdd(&(bar)[XB_TMO], 1u); break; } } } } while (0)

struct XcdBarrier {
    unsigned* bar; unsigned x;
    volatile LAS unsigned* st;
};

__device__ __forceinline__ XcdBarrier xcd_barrier_post(unsigned* bar, volatile LAS unsigned* st) {
    XcdBarrier b; b.bar = bar; b.x = xb_xcc_id(); b.st = st;
    if (threadIdx.x == 0) (void)xb_add(&bar[XB_XCNT(b.x)], 1u);
    return b;
}
__device__ __forceinline__ void xcd_barrier_complete(unsigned* bar, unsigned x, unsigned& nloc, unsigned& nx) {
    const unsigned G = gridDim.x * gridDim.y * gridDim.z;
    unsigned sum, cnt, mine, sp = 0u;
    for (;;) {
        sum = 0u; cnt = 0u; mine = 0u;
#pragma unroll
        for (unsigned j = 0; j < 16; ++j) { const unsigned c = xb_ld(&bar[XB_XCNT(j)]); sum += c; cnt += (c > 0u) ? 1u : 0u; mine = (j == x) ? c : mine; }
        if (sum == G) break;
        __builtin_amdgcn_s_sleep(1);
        if ((++sp & 255u) == 0u) { if (xb_ld(&bar[XB_TMO])) break; if (sp > XB_SPIN_CAP) { atomicAdd(&bar[XB_TMO], 1u); break; } }
    }
    nloc = mine > 0u ? mine : 1u; nx = cnt > 0u ? cnt : 1u;
}

__device__ __forceinline__ void xcd_barrier(const XcdBarrier& b) {
    asm volatile("s_waitcnt vmcnt(0)" ::: "memory");
    __syncthreads();
    if (threadIdx.x == 0) {
        unsigned* bar = b.bar;
        __builtin_amdgcn_s_waitcnt(0);
        unsigned nloc = b.st[0], nx = b.st[1];
        if (nloc == 0u) { xcd_barrier_complete(bar, b.x, nloc, nx); b.st[0] = nloc; b.st[1] = nx; }
        const unsigned old = xb_add(&bar[XB_XSUB(b.x)], 1u);
        const unsigned gen = old / nloc;
        if (old + 1u == (gen + 1u) * nloc) {
            __builtin_amdgcn_fence(__ATOMIC_RELEASE, "agent");
            asm volatile("s_waitcnt vmcnt(0)" ::: "memory");
            const unsigned og = xb_add(&bar[XB_TOP], 1u);
            const unsigned tg = og / nx;
            if (og + 1u == (tg + 1u) * nx) xb_add(&bar[XB_TOPGEN], 1u);
            else XB_SPIN(xb_ld(&bar[XB_TOPGEN]) == tg, bar);
            __builtin_amdgcn_fence(__ATOMIC_ACQUIRE, "agent");
            xb_add(&bar[XB_XGEN(b.x)], 1u);
            asm volatile("s_waitcnt vmcnt(0)" ::: "memory");
        } else {
            XB_SPIN(xb_ld(&bar[XB_XGEN(b.x)]) == gen, bar);
            __builtin_amdgcn_fence(__ATOMIC_ACQUIRE, "agent");
            asm volatile("s_waitcnt vmcnt(0)" ::: "memory");
        }
    }
    __syncthreads();
}
__device__ __forceinline__ int lane_id() { int l = (int)__builtin_amdgcn_mbcnt_hi(~0u, __builtin_amdgcn_mbcnt_lo(~0u, 0u)); asm volatile("" : "+v"(l)); return l; }
__device__ __forceinline__ float wave_sum(float v) {
#pragma unroll
    for (int o = 1; o < 64; o <<= 1) v += __shfl_xor(v, o);
    return v;
}
__device__ __forceinline__ int crow(int r, int hi) { return (r & 3) + 8 * (r >> 2) + 4 * hi; }
__device__ __forceinline__ void glds16(const void* gsrc, unsigned lds_dst) { unsigned keep;
    asm volatile("s_mov_b32 %0, m0\n\ts_mov_b32 m0, %2\n\ts_nop 0\n\tglobal_load_lds_dwordx4 %1, off\n\ts_mov_b32 m0, %0" : "=&s"(keep) : "v"(gsrc), "s"(lds_dst) : "memory"); }
__device__ __forceinline__ void glds4(const void* gsrc, unsigned lds_dst) { unsigned keep;
    asm volatile("s_mov_b32 %0, m0\n\ts_mov_b32 m0, %2\n\ts_nop 0\n\tglobal_load_lds_dword %1, off\n\ts_mov_b32 m0, %0" : "=&s"(keep) : "v"(gsrc), "s"(lds_dst) : "memory"); }
typedef __bf16 bf16x2_t __attribute__((ext_vector_type(2)));
__device__ __forceinline__ unsigned cvtpk(float lo, float hi) { const f32x2 v = {lo, hi}; const bf16x2_t b = __builtin_convertvector(v, bf16x2_t); return __builtin_bit_cast(unsigned, b); }
typedef short v4i16_t __attribute__((ext_vector_type(4)));
__device__ __forceinline__ s16x4 vtr(const LAS char* p) { return __builtin_bit_cast(s16x4, __builtin_amdgcn_ds_read_tr16_b64_v4i16((LAS v4i16_t*)p)); }
__device__ __forceinline__ void plswap(float& a, float& b) { asm volatile("s_nop 1\n\tv_permlane32_swap_b32 %0, %1\n\ts_nop 1" : "+v"(a), "+v"(b)); }
__device__ __forceinline__ float swapmax(float m) { float a = m, b = m; plswap(a, b); return fmaxf(a, b); }
__device__ __forceinline__ float swapsum(float m) { float a = m, b = m; plswap(a, b); return a + b; }
#define MFMA32(a, b, c) __builtin_amdgcn_mfma_f32_32x32x16_bf16((a), (b), (c), 0, 0, 0)

struct Params {
    const float* x; const float* w_in; const float* b_fox; const float* lb_logits; const float* norm_g; const float* w_pa; const float* w_pb; const float* w_pc; const float* w_out;
    const float* ln1_g; const float* ln1_b; const float* w_router; const float* b_router; const float* w_gu; const float* b_gu; const float* w_down; const float* b_down; const float* ln2_g; const float* ln2_b;
    float* out; unsigned char* ws; int ph_lo, ph_hi, use_bar, pad;
};

typedef const __attribute__((address_space(4))) Params* KP;
__device__ __forceinline__ KP load_params() { KP kp = (KP)__builtin_amdgcn_kernarg_segment_ptr(); asm volatile("" : "+s"(kp)); return kp; }

template <class F> __device__ __forceinline__ void cvt_tile(const float* W, size_t ldsrc, int k0, bf16* WT, size_t ldw, int kd0, int n0, const F& f, LAS float* scr, int lane) {
    const int c = lane & 31; int sc; float scale; f(n0 + c, sc, scale);
#pragma unroll 8
    for (int i = 0; i < 32; ++i) { const int kk = 2 * i + (lane >> 5); scr[kk * 33 + c] = sc >= 0 ? W[(size_t)(k0 + kk) * ldsrc + sc] * scale : 0.f; }
    LDS_WAIT(); asm volatile("" ::: "memory");
    const int ch = lane & 7;
#pragma unroll
    for (int j = 0; j < 4; ++j) { const int n = (lane >> 3) + 8 * j; const LAS float* s = scr + (8 * ch) * 33 + n;
        u32x4 o; o.x = pk2(s[0 * 33], s[1 * 33]); o.y = pk2(s[2 * 33], s[3 * 33]); o.z = pk2(s[4 * 33], s[5 * 33]); o.w = pk2(s[6 * 33], s[7 * 33]);
        *(u32x4*)(WT + (size_t)(n0 + n) * ldw + kd0 + 8 * ch) = o; }
    LDS_WAIT(); asm volatile("" ::: "memory");
}
template <class F> __device__ __forceinline__ void cvt_tile8(const float* W, size_t ldsrc, int k0, unsigned char* WT, size_t ldw, int n0, const F& f, float wscale, LAS float* scr, int lane) {
    const int c = lane & 31; int sc; float scale; f(n0 + c, sc, scale); scale *= wscale;
#pragma unroll 8
    for (int i = 0; i < 32; ++i) { const int kk = 2 * i + (lane >> 5); scr[kk * 33 + c] = sc >= 0 ? W[(size_t)(k0 + kk) * ldsrc + sc] * scale : 0.f; }
    LDS_WAIT(); asm volatile("" ::: "memory");
    const int ch = lane & 7;
#pragma unroll
    for (int j = 0; j < 4; ++j) { const int n = (lane >> 3) + 8 * j; const LAS float* s = scr + (8 * ch) * 33 + n;
        int w0 = __builtin_amdgcn_cvt_pk_fp8_f32(s[0 * 33], s[1 * 33], 0, false); w0 = __builtin_amdgcn_cvt_pk_fp8_f32(s[2 * 33], s[3 * 33], w0, true);
        int w1 = __builtin_amdgcn_cvt_pk_fp8_f32(s[4 * 33], s[5 * 33], 0, false); w1 = __builtin_amdgcn_cvt_pk_fp8_f32(s[6 * 33], s[7 * 33], w1, true);
        *(u32x2*)(WT + (size_t)(n0 + n) * ldw + k0 + 8 * ch) = (u32x2){(unsigned)w0, (unsigned)w1}; }
    LDS_WAIT(); asm volatile("" ::: "memory");
}
struct MapIn { __device__ __forceinline__ void operator()(int n, int& sc, float& s) const { sc = zcol_src(n); s = (n < 512 || (n >= Z_FQ && n < Z_FK)) ? QSCALE : 1.0f; } };
struct MapGu { __device__ __forceinline__ void operator()(int n, int& sc, float& s) const { sc = (n & 1) ? 1024 + (n >> 1) : (n >> 1); s = 1.0f; } };
struct MapId { __device__ __forceinline__ void operator()(int n, int& sc, float& s) const { sc = n; s = 1.0f; } };

__device__ __forceinline__ void p0_prologue(KP p, LAS unsigned char* lds, int gw, int NGW, int wave, int lane) {
    LAS float* scr = (LAS float*)(lds + wave * 16384);
    unsigned char* ws = p->ws;
    constexpr int I_IN = 16 * 272, I_GU = 32 * 16 * 64, I_DN = 32 * 16 * 32, I_P = 3 * 8 * 32, I_OUT = 16 * 32, I_LAYER = I_IN + I_GU + I_DN + I_P + I_OUT;
    for (int it = gw; it < DEPTH * I_LAYER; it += NGW) {
        const int l = it / I_LAYER; int r = it - l * I_LAYER;
        if (r < I_IN) { const int kb = r / 272, nb = r % 272;
            cvt_tile(p->w_in + (size_t)l * 1024 * D_IN, D_IN, 64 * kb, (bf16*)(ws + WS_WIN) + (size_t)l * ZP * 1024, 1024, 64 * kb, 32 * nb, MapIn{}, scr, lane); continue; } r -= I_IN;
        if (r < I_GU) { const int e = r >> 10, r2 = r & 1023, kb = r2 >> 6, nb = r2 & 63;
            cvt_tile8(p->w_gu + (size_t)(l * 32 + e) * 1024 * 2048, 2048, 64 * kb, (unsigned char*)(ws + WS_WGU) + (size_t)(l * 32 + e) * 2048 * 1024, 1024, 32 * nb, MapGu{}, W8_SCALE, scr, lane); continue; } r -= I_GU;
        if (r < I_DN) { const int e = r >> 9, r2 = r & 511, kb = r2 >> 5, nb = r2 & 31;
            cvt_tile8(p->w_down + (size_t)(l * 32 + e) * 1024 * 1024, 1024, 64 * kb, (unsigned char*)(ws + WS_WDN) + (size_t)(l * 32 + e) * 1024 * 1024, 1024, 32 * nb, MapId{}, W8_SCALE, scr, lane); continue; } r -= I_DN;
        if (r < I_P) { const int br = r >> 8, r2 = r & 255, kb = r2 >> 5, nb = r2 & 31; const float* W = (br == 0 ? p->w_pa : br == 1 ? p->w_pb : p->w_pc) + (size_t)l * 512 * 1024;
            cvt_tile(W, 1024, 64 * kb, (bf16*)(ws + WS_WP) + (size_t)l * 1024 * 1536, 1536, br * 512 + 64 * kb, 32 * nb, MapId{}, scr, lane); continue; } r -= I_P;
        { const int kb = r >> 5, nb = r & 31;
            cvt_tile(p->w_out + (size_t)l * 1024 * 1024, 1024, 64 * kb, (bf16*)(ws + WS_WOUT) + (size_t)l * 1024 * 1024, 1024, 64 * kb, 32 * nb, MapId{}, scr, lane); }
    }
    { float* bg = (float*)(ws + WS_BGU);
      for (int i = gw * 64 + lane; i < DEPTH * 32 * 2048; i += NGW * 64) { const int n = i & 2047, le = i >> 11; bg[i] = p->b_gu[(size_t)le * 2048 + ((n & 1) ? 1024 + (n >> 1) : (n >> 1))]; } }
    { bf16* wf = (bf16*)(ws + WS_WRF);
      for (int i = gw * 64 + lane; i < DEPTH * 32 * 2 * 64 * 8; i += NGW * 64) { const int ii = i & 7, ln = (i >> 3) & 63, nt = (i >> 9) & 1, s = (i >> 10) & 31, l = i >> 15;
          const int k = 32 * s + 8 * (ln >> 4) + ii, e = 16 * nt + (ln & 15); const float w = p->w_router[((size_t)l * 1024 + k) * 32 + e];
          const unsigned hb = f2bf(w); const float lo = w - bf2f(hb);
          const size_t base = ((((size_t)l * 32 + s) * 2 + nt) * 2) * 512 + ln * 8 + ii; wf[base] = (bf16)hb; wf[base + 512] = (bf16)f2bf(lo); } }
    { f32x2* tg = (f32x2*)(ws + WS_TRIG);
      for (int i = gw * 64 + lane; i < SEQ * 32; i += NGW * 64) { const int pos = i >> 5, k = i & 31;
          const float inv = exp2f(-(float)k * (13.287712379549449f / 32.0f)); const float ang = (float)pos * inv;
          const double rev = (double)ang * 0.15915494309189535; const float fr = (float)(rev - __builtin_rint(rev));
          tg[i] = (f32x2){__builtin_amdgcn_cosf(fr), __builtin_amdgcn_sinf(fr)}; } }
    { bf16* xb = (bf16*)(ws + WS_XB);
      for (int m = gw; m < NTOK; m += NGW) { const f32x4* xr = (const f32x4*)(p->x + (size_t)m * DM) + lane; u32x2* o = (u32x2*)(xb + (size_t)m * DM) + lane;
#pragma unroll
          for (int j = 0; j < 4; ++j) { const f32x4 v = xr[64 * j]; o[64 * j] = (u32x2){pk2(v.x, v.y), pk2(v.z, v.w)}; } } }
}

__device__ __forceinline__ void prep_phase(KP p, int l, int gw, int NGW, int lane) {
    unsigned char* ws = p->ws; bf16* Z = (bf16*)(ws + WS_Z); const f32x2* tg = (const f32x2*)(ws + WS_TRIG); float* lfT = (float*)(ws + WS_LFT);
    const float bf_l = (lane < 8) ? p->b_fox[l * 8 + lane] : 0.f;
    for (int m = gw; m < NTOK; m += NGW) {
        bf16* zr = Z + (size_t)m * ZP; const int pos = m & (SEQ - 1), b = m >> 13;
        const f32x2 cs = tg[pos * 32 + (lane & 31)];
        unsigned short ta[11], tb[11];
#pragma unroll
        for (int it = 0; it < 11; ++it) { const int hh = 2 * it + (lane >> 5); const int hc = hh < 21 ? hh : 20;
            const int col = hc < 8 ? Z_AQ + hc * 64 : hc < 16 ? Z_AK + (hc - 8) * 64 : hc < 20 ? Z_IQ + (hc - 16) * 64 : Z_IK;
            const bf16* q = zr + col + (lane & 31); ta[it] = q[0]; tb[it] = q[32]; }
#pragma unroll
        for (int it = 0; it < 11; ++it) { const int hh = 2 * it + (lane >> 5);
            if (hh < 21) { const int col = hh < 8 ? Z_AQ + hh * 64 : hh < 16 ? Z_AK + (hh - 8) * 64 : hh < 20 ? Z_IQ + (hh - 16) * 64 : Z_IK;
                bf16* q = zr + col + (lane & 31); const float t1 = bf2f(ta[it]), t2 = bf2f(tb[it]);
                q[0] = (bf16)f2bf(t1 * cs.x - t2 * cs.y); q[32] = (bf16)f2bf(t2 * cs.x + t1 * cs.y); } }
#pragma unroll
        for (int j = 0; j < 2; ++j) { bf16* g0p = zr + Z_GT + lane * 8 + j * 512; const u32x4 a = *(const u32x4*)g0p, bb = *(const u32x4*)(g0p + 1024), cc = *(const u32x4*)(g0p + 2048);
            u32x4 o0, o1, o2;
#pragma unroll
            for (int i = 0; i < 4; ++i) {
                const float e0l = __expf(-bflo(a[i])), e0h = __expf(-bfhi(a[i])), e1l = __expf(-bflo(bb[i])), e1h = __expf(-bfhi(bb[i])), e2l = __expf(-bflo(cc[i])), e2h = __expf(-bfhi(cc[i]));
                o0[i] = pk2((1.f + e1l) / (1.f + e0l), (1.f + e1h) / (1.f + e0h));
                o1[i] = pk2((1.f + e2l) / (1.f + e1l), (1.f + e2h) / (1.f + e1h));
                o2[i] = pk2(1.f / (1.f + e2l), 1.f / (1.f + e2h)); }
            *(u32x4*)g0p = o0; *(u32x4*)(g0p + 1024) = o1; *(u32x4*)(g0p + 2048) = o2; }
        if (lane < 8) { const float v = bf2f(zr[Z_FF + lane]) + bf_l; const float ls = fminf(v, 0.f) - __logf(1.0f + __expf(-fabsf(v))); lfT[(size_t)(b * 8 + lane) * SEQ + pos] = ls * LOG2E; }
    }
}

constexpr int IX_CAP = 1024, IX_TRIG = 768, IX_CAND = 0, IX_BM = 0  , IX_HIST = 32 * IX_CAP * 4, IX_CNT = IX_HIST + 8 * 1024, IX_TAU = IX_CNT + 128, IX_FLAG = IX_TAU + 128, IX_END = IX_FLAG + 64;
static_assert(IX_END <= SCR_BYTES, "indexer LDS");

__device__ __forceinline__ int wave_incl_sum(int v) {
    v += __builtin_amdgcn_update_dpp(0, v, 0x111, 0xf, 0xf, false);
    v += __builtin_amdgcn_update_dpp(0, v, 0x112, 0xf, 0xf, false);
    v += __builtin_amdgcn_update_dpp(0, v, 0x114, 0xf, 0xf, false);
    v += __builtin_amdgcn_update_dpp(0, v, 0x118, 0xf, 0xf, false);
    v += __builtin_amdgcn_update_dpp(0, v, 0x142, 0xa, 0xf, false);
    v += __builtin_amdgcn_update_dpp(0, v, 0x143, 0xc, 0xf, false);
    return v;
}
__device__ __forceinline__ unsigned wave_or63(unsigned v) {
    v |= (unsigned)__builtin_amdgcn_update_dpp(0, (int)v, 0x111, 0xf, 0xf, false);
    v |= (unsigned)__builtin_amdgcn_update_dpp(0, (int)v, 0x112, 0xf, 0xf, false);
    v |= (unsigned)__builtin_amdgcn_update_dpp(0, (int)v, 0x114, 0xf, 0xf, false);
    v |= (unsigned)__builtin_amdgcn_update_dpp(0, (int)v, 0x118, 0xf, 0xf, false);
    v |= (unsigned)__builtin_amdgcn_update_dpp(0, (int)v, 0x142, 0xa, 0xf, false);
    v |= (unsigned)__builtin_amdgcn_update_dpp(0, (int)v, 0x143, 0xc, 0xf, false);
    return v;
}
__device__ __forceinline__ int count_ge8(const unsigned (&x)[16], int k0, unsigned t) {
    u64 m0, m1, m2, m3, m4, m5, m6, m7;
    asm("v_cmp_ge_u32_e64 %0, %8, %16\n\tv_cmp_ge_u32_e64 %1, %9, %16\n\tv_cmp_ge_u32_e64 %2, %10, %16\n\tv_cmp_ge_u32_e64 %3, %11, %16\n\t"
        "v_cmp_ge_u32_e64 %4, %12, %16\n\tv_cmp_ge_u32_e64 %5, %13, %16\n\tv_cmp_ge_u32_e64 %6, %14, %16\n\tv_cmp_ge_u32_e64 %7, %15, %16"
        : "=&s"(m0), "=&s"(m1), "=&s"(m2), "=&s"(m3), "=&s"(m4), "=&s"(m5), "=&s"(m6), "=&s"(m7)
        : "v"(x[k0]), "v"(x[k0 + 1]), "v"(x[k0 + 2]), "v"(x[k0 + 3]), "v"(x[k0 + 4]), "v"(x[k0 + 5]), "v"(x[k0 + 6]), "v"(x[k0 + 7]), "v"(t));
    return (int)(__popcll(m0) + __popcll(m1) + __popcll(m2) + __popcll(m3) + __popcll(m4) + __popcll(m5) + __popcll(m6) + __popcll(m7));
}
template <bool EXACT>
__device__ __forceinline__ unsigned wave_select256(LAS unsigned* cand, int n, int lane, int& kept) {
    unsigned x[16];
#pragma unroll
    for (int k = 0; k < 16; ++k) { const int i = lane + 64 * k; x[k] = (i < n) ? cand[i] : 0u; }
    const unsigned xr = (unsigned)__builtin_amdgcn_readfirstlane((int)x[0]); unsigned df = 0u;
#pragma unroll
    for (int k = 0; k < 16; ++k) df |= (x[k] != 0u) ? (x[k] ^ xr) : 0u;
    df = (unsigned)__builtin_amdgcn_readlane((int)wave_or63(df), 63);
    const int hb = 31 - (int)__builtin_clz(df | 1u);
    unsigned prefix = xr & ~((2u << hb) - 1u);
#pragma unroll 1
    for (int bit = hb; bit >= 0; --bit) { const unsigned trial = prefix | (1u << bit); const int c = count_ge8(x, 0, trial) + count_ge8(x, 8, trial);
        if (c >= 256) { prefix = trial; if (EXACT ? (c == 256) : (c <= 384)) break; } }
    int base = 0;
#pragma unroll
    for (int k = 0; k < 16; ++k) { const bool keep = x[k] >= prefix; const u64 mk = __ballot(keep);
        if (keep) cand[__builtin_amdgcn_mbcnt_hi((unsigned)(mk >> 32), __builtin_amdgcn_mbcnt_lo((unsigned)mk, (unsigned)base))] = x[k]; base += __popcll(mk); }
    kept = base;
    return prefix;
}

__device__ __forceinline__ void idx_phase(KP p, int l, LAS unsigned char* lds, int vcu, int G, int tid, int wave, int lane) {
    unsigned char* ws = p->ws; const bf16* Z = (const bf16*)(ws + WS_Z);
    { unsigned* sbr = (unsigned*)(ws + WS_CTL) + CW_SB + l * 64; LAS float* wt = (LAS float*)lds;
      for (int task = blockIdx.x; task < 256; task += G) { const int bh = task >> 3, part = task & 7; float qm = 0.f, km = 0.f;
          const bf16* zr = Z + (size_t)((bh >> 3) * SEQ + part * 1024 + tid * 2) * ZP + (bh & 7) * 64;
#pragma unroll
          for (int i = 0; i < 2; ++i) { float qs = 0.f, ks = 0.f;
#pragma unroll
              for (int c8 = 0; c8 < 8; ++c8) { const u32x4 a = *(const u32x4*)(zr + (size_t)i * ZP + Z_FQ + c8 * 8), kq = *(const u32x4*)(zr + (size_t)i * ZP + Z_FK + c8 * 8);
#pragma unroll
                  for (int w4 = 0; w4 < 4; ++w4) { qs += bflo(a[w4]) * bflo(a[w4]) + bfhi(a[w4]) * bfhi(a[w4]); ks += bflo(kq[w4]) * bflo(kq[w4]) + bfhi(kq[w4]) * bfhi(kq[w4]); } }
              qm = fmaxf(qm, qs); km = fmaxf(km, ks); }
#pragma unroll
          for (int o = 1; o < 64; o <<= 1) { qm = fmaxf(qm, __shfl_xor(qm, o)); km = fmaxf(km, __shfl_xor(km, o)); }
          if (lane == 0) { __hip_atomic_fetch_max(sbr + 2 * bh, __builtin_bit_cast(unsigned, qm), __ATOMIC_RELAXED, __HIP_MEMORY_SCOPE_AGENT); __hip_atomic_fetch_max(sbr + 2 * bh + 1, __builtin_bit_cast(unsigned, km), __ATOMIC_RELAXED, __HIP_MEMORY_SCOPE_AGENT); } }
      (void)wt; }
    for (int bh = blockIdx.x; bh < 32; bh += G) {
        float* dst = (float*)(ws + WS_CT) + (size_t)bh * SEQ;
        LAS float* wt = (LAS float*)lds;
        const float bfx = p->b_fox[l * 8 + (bh & 7)]; const bf16* zf = Z + (size_t)((bh >> 3) * SEQ + tid * 16) * ZP + Z_FF + (bh & 7);
        f32x4 v[4]; float run = 0.f;
#pragma unroll
        for (int j = 0; j < 4; ++j) {
#pragma unroll
            for (int i = 0; i < 4; ++i) { const float t = bf2f(zf[(size_t)(4 * j + i) * ZP]) + bfx; v[j][i] = (fminf(t, 0.f) - __logf(1.0f + __expf(-fabsf(t)))) * LOG2E; }
            v[j].x += run; v[j].y += v[j].x; v[j].z += v[j].y; v[j].w += v[j].z; run = v[j].w; }
        float inc = run;
#pragma unroll
        for (int o = 1; o < 64; o <<= 1) { const float t = __shfl_up(inc, o); if (lane >= o) inc += t; }
        if (lane == 63) wt[wave] = inc;
        WG_BAR();
        float off = inc - run;
        for (int w = 0; w < wave; ++w) off += wt[w];
        { u32x4* ka = (u32x4*)((bf16*)(ws + WS_KA) + ((size_t)bh * SEQ + tid * 16) * 16);
#pragma unroll
          for (int j = 0; j < 4; ++j) { const f32x4 c4 = v[j] + off; *(f32x4*)(dst + tid * 16 + 4 * j) = c4;
#pragma unroll
              for (int i = 0; i < 4; ++i) { const float c = c4[i]; const unsigned h1 = f2bf(c); const float r1 = c - bf2f(h1); const unsigned h2 = f2bf(r1); const unsigned h3 = f2bf(r1 - bf2f(h2));
                  unsigned z0 = 0u; asm volatile("" : "+v"(z0));
                  ka[(4 * j + i) * 2] = (u32x4){h1 | (h2 << 16), h3 | 0x3f800000u, z0, z0}; ka[(4 * j + i) * 2 + 1] = (u32x4){z0, z0, z0, z0}; } } }
        WG_BAR();
    }
    LAS unsigned* cand = (LAS unsigned*)(lds + IX_CAND); LAS unsigned* BM = (LAS unsigned*)(lds + IX_BM);
    LAS unsigned* cnt = (LAS unsigned*)(lds + IX_CNT); LAS unsigned* tau = (LAS unsigned*)(lds + IX_TAU); LAS unsigned* hist = (LAS unsigned*)(lds + IX_HIST); LAS unsigned* flg = (LAS unsigned*)(lds + IX_FLAG);
    u64* MW = (u64*)(ws + WS_MASKW);
    const int r32 = lane & 31, hi = lane >> 5;
    for (int U = vcu; U < 1024; U += G) {
        const int v = U & 255, i4 = U >> 8; const int b = v & 3, a = v >> 2;
        const int hc = (i4 == 0) ? a : (i4 == 1) ? 255 - a : (i4 == 2) ? 64 + a : 191 - a;
        const int qbase = b * SEQ + hc * 32; const int nadm = ((hc >> 1) + 1) * 64;
        if (nadm <= 256) {
            const int nw = nadm >> 6;
            for (int i = tid; i < 32 * 128; i += NTHR) { const int q = i >> 7, w = i & 127; unsigned on = (w < nw) ? 0xffffffffu : 0u; asm volatile("" : "+v"(on));
                MW[(size_t)(qbase + q) * 128 + w] = (u64)on | ((u64)on << 32); }
            continue;
        }
        const bf16* qrow = Z + (size_t)(qbase + r32) * ZP;
        bf16x8 iqf[4][4];
#pragma unroll
        for (int hd = 0; hd < 4; ++hd)
#pragma unroll
            for (int j = 0; j < 4; ++j) iqf[hd][j] = *(const bf16x8*)(qrow + Z_IQ + hd * 64 + j * 16 + hi * 8);
        float wq[4];
#pragma unroll
        for (int hd = 0; hd < 4; ++hd) wq[hd] = bf2f(qrow[Z_IW + hd]) * (0.5f * 0.125f);
        if (tid < 32) { cnt[tid] = 0u; tau[tid] = 0u; } if (tid < 3) flg[tid] = 0u;
        const int ntiles = nadm >> 5, nrounds = (ntiles + 7) >> 3;
        const bf16* kbase = Z + (size_t)(b * SEQ) * ZP + Z_IK + hi * 8;
        bf16x8 kf[4];
        WG_BAR();
        for (int rd = 0; rd < nrounds; ++rd) {
            const int tile = rd * 8 + wave;
            if (tile < ntiles) {
#pragma unroll
                for (int j = 0; j < 4; ++j) kf[j] = *(const bf16x8*)(kbase + (size_t)(tile * 32 + r32) * ZP + j * 16);
                f32x16 sc = {};
#pragma unroll
                for (int hd = 0; hd < 4; ++hd) { f32x16 pp = {};
#pragma unroll
                    for (int j = 0; j < 4; ++j) pp = MFMA32(kf[j], iqf[hd][j], pp);
#pragma unroll
                    for (int r = 0; r < 16; ++r) sc[r] = __builtin_fmaf(wq[hd], fmaxf(pp[r], 0.f), sc[r]); }
                const unsigned tq = tau[r32];
                typedef unsigned u32x16_t __attribute__((ext_vector_type(16))); u32x16_t comp, posv; bool anyp = false;
#pragma unroll
                for (int r = 0; r < 16; ++r) { const int key = tile * 32 + crow(r, hi);
                    unsigned u = __builtin_bit_cast(unsigned, sc[r] + 0.0f); u ^= (u >> 31) ? 0xffffffffu : 0x80000000u;
                    comp[r] = (u & 0xffffe000u) | (unsigned)(8191 - key); posv[r] = 0u;
                    if (comp[r] > tq) { posv[r] = __hip_atomic_fetch_add(cnt + r32, 1u, __ATOMIC_RELAXED, __HIP_MEMORY_SCOPE_WORKGROUP); anyp = true; } }
                LAS unsigned* cq_ = cand + r32 * IX_CAP; bool trig = false;
#pragma unroll
                for (int r = 0; r < 16; ++r) if (comp[r] > tq) { cq_[posv[r]] = comp[r]; trig = trig || (posv[r] >= (unsigned)IX_TRIG); }
                if (trig) flg[rd % 3] = 1u; (void)anyp;
            }
            WG_BAR_LDS();
            const bool need_any = flg[rd % 3] != 0u;
            if (tid == 0) flg[(rd + 2) % 3] = 0u;
            if (need_any) {
#pragma unroll 1
                for (int i = 0; i < 4; ++i) { const int qq = wave * 4 + i; const int n = __builtin_amdgcn_readfirstlane((int)cnt[qq]);
                    if (n > 256) { int kept; const unsigned th = wave_select256<false>(cand + qq * IX_CAP, n, lane, kept); if (lane == 0) { cnt[qq] = (unsigned)kept; tau[qq] = th ? th - 1u : 0u; } } }
                WG_BAR_LDS();
            }
        }
#pragma unroll 1
        for (int i = 0; i < 4; ++i) { const int qq = wave * 4 + i; const int n = __builtin_amdgcn_readfirstlane((int)cnt[qq]);
            if (n > 256) { int kept; (void)wave_select256<true>(cand + qq * IX_CAP, n, lane, kept); } }
        LDS_WAIT();
        unsigned fin[4][4];
#pragma unroll
        for (int i = 0; i < 4; ++i)
#pragma unroll
            for (int k = 0; k < 4; ++k) fin[i][k] = cand[(wave * 4 + i) * IX_CAP + lane + 64 * k];
        WG_BAR();
        for (int i = tid; i < 32 * 256; i += NTHR) BM[i] = 0u;
        WG_BAR();
#pragma unroll
        for (int i = 0; i < 4; ++i) { const int qq = wave * 4 + i;
#pragma unroll
            for (int k = 0; k < 4; ++k) { const int key = 8191 - (int)(fin[i][k] & 8191u);
                __hip_atomic_fetch_or(BM + qq * 256 + (key >> 5), 1u << (key & 31), __ATOMIC_RELAXED, __HIP_MEMORY_SCOPE_WORKGROUP); } }
        WG_BAR();
        for (int i = tid; i < 32 * 128; i += NTHR) { const int q = i >> 7, w = i & 127; MW[(size_t)(qbase + q) * 128 + w] = (u64)BM[q * 256 + 2 * w] | ((u64)BM[q * 256 + 2 * w + 1] << 32); }
        WG_BAR();
    }
}

constexpr int AT_K = 0, AT_V = 2 * 8192, AT_WS = 4 * 8192, AT_OST = AT_WS + 4096, AT_MW = AT_OST + 8 * 4096, AT_KA = AT_MW + 2 * 8 * 512, AT_END = AT_KA + 2 * 2048;
static_assert(AT_END <= SCR_BYTES, "attention LDS");
#ifndef DBG_ATT_L
#define DBG_ATT_L 0
#endif

template <int MODE>
__device__ __forceinline__ void attn_unit(int b, int h, int qb, const bf16* Z, bf16* Ob, const float* cT, const u64* MW, const void* KA, const void* SBp, LAS char* shm, int wv) {
    int tid_l = lane_id() + wv * 64;
    const int tid = tid_l, lane = tid & 63, r32 = lane & 31, hi = lane >> 5; const int wid = __builtin_amdgcn_readfirstlane(tid >> 6);
    constexpr int QC = MODE == 0 ? Z_FQ : Z_AQ, KC = MODE == 0 ? Z_FK : Z_AK, VC = MODE == 0 ? Z_FV : Z_AV, OC = MODE == 0 ? 512 : 0;
    const long rowbase = (long)b * SEQ; const int q0 = qb * 512;
    const bf16* Qw = Z + (rowbase + q0 + wid * 64) * ZP + QC + h * 64;
    const bf16* Kh = Z + rowbase * ZP + KC + h * 64; const bf16* Vh = Z + rowbase * ZP + VC + h * 64;
    const unsigned lds0 = (unsigned)(uintptr_t)shm;
    LAS float* wsf = (LAS float*)(shm + AT_WS) + wid * 128;
    const int NT = 8 * (qb + 1); const int tlast = 8 * qb + wid;
    const bf16* ksrc = Kh + (long)lane * ZP + wid * 8;
    const bf16* vsrc = Vh + (long)(16 * (wid & 3) + (lane >> 2)) * ZP + (wid >> 2) * 32 + (lane & 3) * 8;
    const unsigned kdst = lds0 + AT_K + wid * 1024, vdst = lds0 + AT_V + wid * 1024, mdst = lds0 + AT_MW + wid * 512;
    const unsigned kadst = lds0 + AT_KA + (wid & 1) * 1024;
#define DMA_KA(t, sl) do { if (MODE == 0 && wid < 2) { const int ln_ = lane_id();     \
        glds16((const bf16*)KA + ((size_t)(b * 8 + h) * SEQ + (t) * 64 + 32 * wid + (ln_ >> 1)) * 16 + (ln_ & 1) * 8, (unsigned)__builtin_amdgcn_readfirstlane(kadst + (sl) * 2048)); } } while (0)
#define DMA_K(t, slotb) glds16(ksrc + (long)(t) * 64 * ZP, (unsigned)__builtin_amdgcn_readfirstlane(kdst + (slotb)))
#define DMA_V(t, slotb) glds16(vsrc + (long)(t) * 64 * ZP, (unsigned)__builtin_amdgcn_readfirstlane(vdst + (slotb)))
#define DMA_M(t, sl) do { const int ln_ = lane_id(); const unsigned* msrcA = (const unsigned*)(MW + (size_t)(rowbase + q0 + wid * 64 + (ln_ & 31)) * 128) + (ln_ >> 5);     \
        glds4(msrcA + 2 * (t), (unsigned)__builtin_amdgcn_readfirstlane(mdst + (sl) * 4096)); glds4(msrcA + 32 * 256 + 2 * (t), (unsigned)__builtin_amdgcn_readfirstlane(mdst + (sl) * 4096 + 256)); } while (0)
    int t_start = 0, t_first = 0;
    if (MODE == 0) { const float* cg = cT + (size_t)(b * 8 + h) * SEQ; const float th = 2.0f * (sqrtf(((const float*)SBp)[2 * (b * 8 + h)]) * sqrtf(((const float*)SBp)[2 * (b * 8 + h) + 1]) * 1.01f + 1.0f) + 40.0f; const int ln_ = lane_id();
        const float c0 = cg[q0], cw = cg[q0 + wid * 64];
        const float ca = (ln_ < NT) ? cg[64 * ln_ + 63] : -3e38f, cb = (ln_ + 64 < NT) ? cg[64 * (ln_ + 64) + 63] : -3e38f;
        { const u64 m0 = __ballot(ca <= c0 + th), m1 = __ballot(cb <= c0 + th); t_start = m0 ? (int)__builtin_ctzll(m0) : 64 + (int)__builtin_ctzll(m1 | (1ull << 63)); }
        { const u64 m0 = __ballot(ca <= cw + th), m1 = __ballot(cb <= cw + th); t_first = m0 ? (int)__builtin_ctzll(m0) : 64 + (int)__builtin_ctzll(m1 | (1ull << 63)); }
        if (t_start > 8 * qb) t_start = 8 * qb; if (t_first > tlast) t_first = tlast; }
    DMA_K(t_start, 0); DMA_V(t_start, 0); if (MODE == 1) DMA_M(0, 0); DMA_KA(t_start, 0);
    bf16x8 qA[4], qB[4];
#pragma unroll
    for (int d0 = 0; d0 < 4; ++d0) { qA[d0] = *(const bf16x8*)(Qw + (long)r32 * ZP + d0 * 16 + hi * 8); qB[d0] = *(const bf16x8*)(Qw + (long)(32 + r32) * ZP + d0 * 16 + hi * 8); }
    float mA = 0.f, mB = 0.f, lA = 0.f, lB = 0.f;
    const unsigned qa0 = (MODE == 0 && hi == 0) ? 0xbf80bf80u : 0u; const unsigned qa1c = (MODE == 0 && hi == 0) ? 0xbf80u : 0u;
    u32x4 qaA = {qa0, qa1c, 0u, 0u}, qaB = {qa0, qa1c, 0u, 0u};
    f32x16 oA[2], oB[2]; oA[0] = f32x16{}; oA[1] = f32x16{}; oB[0] = f32x16{}; oB[1] = f32x16{};
    const int qrelA = wid * 64 + r32;
    const LAS char* kp0 = shm + AT_K + hi * 1024 + r32 * 16;
    const LAS char* vp0 = shm + AT_V + ((lane >> 4) & 1) * 32 + (lane & 3) * 8 + (4 * hi + ((lane & 15) >> 2)) * 64;
    const LAS unsigned* mwp = (const LAS unsigned*)(shm + AT_MW + wid * 512);
    const LAS char* kap0 = shm + AT_KA + r32 * 32 + hi * 16;
    int slot = 0;
#define SOFTMAX(P0, P1, MH, LR, OO, QA, QREL, WSOFF, MWOFF, PW) do { \
        if (MODE == 0) { \
            if (t == tlast) { _Pragma("unroll") for (int r = 0; r < 16; ++r) { const int kv = crow(r, hi); if (kv > (QREL) - wid * 64) P0[r] = -INFINITY; if (kv + 32 > (QREL) - wid * 64) P1[r] = -INFINITY; } } \
        } else { const unsigned mlo = mwp[slot * 1024 + (MWOFF) + r32], mhi = mwp[slot * 1024 + (MWOFF) + 32 + r32]; \
            _Pragma("unroll") for (int r = 0; r < 16; ++r) { const int bitp = crow(r, hi); if (!((mlo >> bitp) & 1u)) P0[r] = -INFINITY; if (!((mhi >> bitp) & 1u)) P1[r] = -INFINITY; } } \
        float rm = __builtin_fmaxf(__builtin_fmaxf(P0[0], P0[1]), P1[0]), rm2 = __builtin_fmaxf(__builtin_fmaxf(P0[2], P0[3]), P1[1]); rm = __builtin_fmaxf(__builtin_fmaxf(rm, P1[2]), P1[3]); \
        _Pragma("unroll") for (int r = 4; r < 16; r += 4) { rm = __builtin_fmaxf(__builtin_fmaxf(rm, P0[r]), P0[r + 1]); rm2 = __builtin_fmaxf(__builtin_fmaxf(rm2, P0[r + 2]), P0[r + 3]); rm = __builtin_fmaxf(__builtin_fmaxf(rm, P1[r]), P1[r + 1]); rm2 = __builtin_fmaxf(__builtin_fmaxf(rm2, P1[r + 2]), P1[r + 3]); } \
        rm = __builtin_fmaxf(rm, rm2); \
        rm = swapmax(rm);                            \
        if (__any(rm > 8.0f)) { const bool big_ = __builtin_fabsf(MH) + __builtin_fabsf(rm > 0.f ? rm : 0.f) > 1800.0f;     \
            const float dl = rm > 0.f ? (big_ ? 64.0f * __builtin_ceilf((MH + rm) * (1.0f / 64.0f)) - MH : 8.0f * __builtin_ceilf(rm * 0.125f)) : 0.f; const float f = __builtin_amdgcn_exp2f(-dl); LR *= f; MH += dl; \
            QA[1] = (QA[1] & 0xffffu) | ((hi == 0) ? (f2bf(-MH) << 16) : 0u); \
            _Pragma("unroll") for (int r = 0; r < 16; ++r) { P0[r] -= dl; P1[r] -= dl; } \
            if (hi == 0) wsf[(WSOFF) + r32] = f; \
            LDS_WAIT(); \
            _Pragma("unroll") for (int j = 0; j < 4; ++j) { const f32x4 ff = *(const LAS f32x4*)(wsf + (WSOFF) + 8 * j + 4 * hi); \
                _Pragma("unroll") for (int i = 0; i < 4; ++i) { OO[0][4 * j + i] *= ff[i]; OO[1][4 * j + i] *= ff[i]; } } } \
        float sacc = 0.f; \
        _Pragma("unroll") for (int r = 0; r < 16; ++r) { P0[r] = __builtin_amdgcn_exp2f(P0[r]); P1[r] = __builtin_amdgcn_exp2f(P1[r]); sacc += P0[r] + P1[r]; } \
        LR += sacc; \
        _Pragma("unroll") for (int i = 0; i < 4; ++i) { PW[0][i] = cvtpk(P0[2 * i], P0[2 * i + 1]); PW[1][i] = cvtpk(P0[8 + 2 * i], P0[8 + 2 * i + 1]); PW[2][i] = cvtpk(P1[2 * i], P1[2 * i + 1]); PW[3][i] = cvtpk(P1[8 + 2 * i], P1[8 + 2 * i + 1]); } \
    } while (0)
#define PVMM(OO, PW) do { const LAS char* vp = vp0 + slot * 8192; \
        _Pragma("unroll") for (int d0 = 0; d0 < 2; ++d0) { s16x4 lo_[4], hh_[4]; \
            _Pragma("unroll") for (int ks = 0; ks < 4; ++ks) { lo_[ks] = vtr(vp + d0 * 4096 + ks * 1024); hh_[ks] = vtr(vp + d0 * 4096 + ks * 1024 + 512); } \
            _Pragma("unroll") for (int ks = 0; ks < 4; ++ks) { const bf16x8 vf = {lo_[ks][0], lo_[ks][1], lo_[ks][2], lo_[ks][3], hh_[ks][0], hh_[ks][1], hh_[ks][2], hh_[ks][3]}; \
                OO[d0] = MFMA32(__builtin_bit_cast(bf16x8, PW[ks]), vf, OO[d0]); } } } while (0)
    for (int t = t_start; t < NT; ++t) {
        asm volatile("s_waitcnt vmcnt(0) lgkmcnt(0)\n\ts_barrier" ::: "memory");
        if (t + 1 < NT) { DMA_K(t + 1, (slot ^ 1) * 8192); DMA_V(t + 1, (slot ^ 1) * 8192); if (MODE == 1) DMA_M(t + 1, slot ^ 1); DMA_KA(t + 1, slot ^ 1); }
        if (t <= tlast && t >= t_first) {
            f32x16 a0 = {}, a1 = {}, b0 = {}, b1 = {};
            { const LAS char* kb = kp0 + slot * 8192;
#pragma unroll
              for (int d0 = 0; d0 < 4; ++d0) { const bf16x8 k0 = *(const LAS bf16x8*)(kb + d0 * 2048), k1 = *(const LAS bf16x8*)(kb + d0 * 2048 + 512);
                  a0 = MFMA32(k0, qA[d0], a0); a1 = MFMA32(k1, qA[d0], a1); b0 = MFMA32(k0, qB[d0], b0); b1 = MFMA32(k1, qB[d0], b1); }
              bf16x8 x0, x1;
              if (MODE == 0) { x0 = *(const LAS bf16x8*)(kap0 + slot * 2048); x1 = *(const LAS bf16x8*)(kap0 + slot * 2048 + 1024); }
              else { const u32x4 cw = {0u, (hi == 0) ? 0x3f800000u : 0u, 0u, 0u}; x0 = __builtin_bit_cast(bf16x8, cw); x1 = x0; }
              a0 = MFMA32(x0, __builtin_bit_cast(bf16x8, qaA), a0); a1 = MFMA32(x1, __builtin_bit_cast(bf16x8, qaA), a1); b0 = MFMA32(x0, __builtin_bit_cast(bf16x8, qaB), b0); b1 = MFMA32(x1, __builtin_bit_cast(bf16x8, qaB), b1); }
            u32x4 pwA[4], pwB[4];
            SOFTMAX(a0, a1, mA, lA, oA, qaA, qrelA, 0, 0, pwA);
            PVMM(oA, pwA);
            SOFTMAX(b0, b1, mB, lB, oB, qaB, qrelA + 32, 32, 64, pwB);
            PVMM(oB, pwB);
        }
        slot ^= 1;
    }
#define EPILOG(OO, LR, WSOFF, ROWOFF) do { float l_ = swapsum(LR); if (hi == 0) wsf[64 + (WSOFF) + r32] = l_; LDS_WAIT(); float rli[16]; \
        _Pragma("unroll") for (int r = 0; r < 16; ++r) rli[r] = __builtin_amdgcn_rcpf(wsf[64 + (WSOFF) + crow(r, hi)]); \
        bf16* Ow = Ob + (rowbase + q0 + wid * 64 + (ROWOFF)) * OP + OC + h * 64; LAS bf16* stg = (LAS bf16*)(shm + AT_OST) + wid * 2048; \
        _Pragma("unroll") for (int r = 0; r < 16; ++r) { const int orow = crow(r, hi); _Pragma("unroll") for (int d0 = 0; d0 < 2; ++d0) stg[orow * 64 + d0 * 32 + r32] = (bf16)f2bf(OO[d0][r] * rli[r]); } \
        LDS_WAIT(); \
        _Pragma("unroll") for (int i = 0; i < 4; ++i) { const int row = i * 8 + (lane >> 3), ch = lane & 7; const u32x4 v = *(const LAS u32x4*)(stg + row * 64 + ch * 8); *(u32x4*)(Ow + (long)row * OP + ch * 8) = v; } \
        LDS_WAIT(); } while (0)
    EPILOG(oA, lA, 0, 0);
    EPILOG(oB, lB, 32, 32);
    asm volatile("s_waitcnt lgkmcnt(0)\n\ts_barrier" ::: "memory");
#undef DMA_K
#undef DMA_V
#undef DMA_M
#undef DMA_KA
#undef SOFTMAX
#undef PVMM
#undef EPILOG
}

__device__ __forceinline__ void attn_phase(KP p, int l, LAS unsigned char* lds, int vcu, int G, int wv) {
    unsigned char* ws = p->ws; const bf16* Z = (const bf16*)(ws + WS_Z); bf16* Ob = (bf16*)(ws + WS_OBUF); const float* cT = (const float*)(ws + WS_CT); const u64* MW = (const u64*)(ws + WS_MASKW);
    for (int U = vcu; U < 1024; U += G) {
        const int v = U & 255, i4 = U >> 8; const int mode = i4 & 1, k = i4 >> 1; const int bh = v >> 3, s = v & 7;
        const int qb = (k == 0) ? s : 15 - s;
        if (mode == 0) attn_unit<0>(bh >> 3, bh & 7, qb, Z, Ob, cT, MW, (const void*)(ws + WS_KA), (const void*)((const unsigned*)(ws + WS_CTL) + CW_SB + l * 64), (LAS char*)lds, wv);
        else attn_unit<1>(bh >> 3, bh & 7, qb, Z, Ob, cT, MW, (const void*)(ws + WS_KA), (const void*)((const unsigned*)(ws + WS_CTL) + CW_SB + l * 64), (LAS char*)lds, wv);
    }
}

constexpr int HG_LF = 0, HG_KK = 16640, HG_SEG = 33280, HG_P = 35328, HG_R = HG_P + 9216, HG_RT = HG_R + 9216, HG_VT = HG_RT + 9216, HG_ST = HG_VT + 9216, HG_CG = HG_ST + 9216, HG_END = HG_CG + 9216;
static_assert(HG_END <= SCR_BYTES, "hgrn LDS");
constexpr int HP = 72;

__device__ __forceinline__ void hgrn_front(KP p, int l, const unsigned short (&zf)[8], int h, int d, int seg, LAS float* SEG, float (&kk)[8], float (&bb)[8], float& bm, float& bl) {
    const int dd = h * 64 + d; const float lb = (l == 0) ? 0.f : sigmoidf_(p->lb_logits[512 + dd] - p->lb_logits[dd]);
    float run = 0.f;
#pragma unroll
    for (int i = 0; i < 8; ++i) { const float sg = sigmoidf_(bf2f(zf[i])); const float f = lb + (1.f - lb) * sg; kk[i] = (1.f - lb) * (1.f - sg); run += __logf(f); bb[i] = run; }
    SEG[seg * 64 + d] = run;
    WG_BAR_LDS();
    float pre = 0.f, m4 = 0.f, all = 0.f;
#pragma unroll
    for (int s2 = 0; s2 < 8; ++s2) { const float sv = SEG[s2 * 64 + d]; if (s2 < seg) pre += sv; if (s2 < 4) m4 += sv; all += sv; }
#pragma unroll
    for (int i = 0; i < 8; ++i) bb[i] += pre;
    bm = m4; bl = all;
}

#define H_ROWP(U_) (Z + (size_t)((((U_) >> 7) >> 3) * SEQ + ((U_) & 127) * 64 + 8 * seg) * ZP + (((U_) >> 7) & 7) * 64 + d)
__device__ __forceinline__ void h1_phase(KP p, int l, LAS unsigned char* lds, int vcu, int G, int tid, int wave, int lane) {
    unsigned char* ws = p->ws; const bf16* Z = (const bf16*)(ws + WS_Z); float* Ug = (float*)(ws + WS_UG); float* Dg = (float*)(ws + WS_DG); float* D2g = (float*)(ws + WS_D2G);
    LAS float* SEG = (LAS float*)(lds + HG_SEG); LAS bf16* RT = (LAS bf16*)(lds + HG_RT); LAS bf16* VT = (LAS bf16*)(lds + HG_VT);
    const int r32 = lane & 31, hi = lane >> 5; const int d = tid & 63, seg = tid >> 6;
    for (int U = vcu; U < 4096; U += G) {
        const int bh = U >> 7, h = bh & 7; const bf16* rp = H_ROWP(U);
        unsigned short zf[8], vv[8];
#pragma unroll
        for (int i = 0; i < 8; ++i) { zf[i] = rp[(size_t)i * ZP + Z_CF]; vv[i] = rp[(size_t)i * ZP + Z_CI]; }
        float kk[8], bb[8], bm, bl; hgrn_front(p, l, zf, h, d, seg, SEG, kk, bb, bm, bl);
        { unsigned rw[4], vw[4];
#pragma unroll
          for (int i = 0; i < 4; ++i) { rw[i] = pk2(kk[2 * i] * __expf(fminf(bm - bb[2 * i], 80.f)), kk[2 * i + 1] * __expf(fminf(bm - bb[2 * i + 1], 80.f))); vw[i] = (unsigned)vv[2 * i] | ((unsigned)vv[2 * i + 1] << 16); }
          *(LAS u32x4*)(RT + d * HP + 8 * seg) = (u32x4){rw[0], rw[1], rw[2], rw[3]}; *(LAS u32x4*)(VT + d * HP + 8 * seg) = (u32x4){vw[0], vw[1], vw[2], vw[3]}; }
        if (seg == 7) { Dg[(size_t)U * 64 + d] = __expf(bl); D2g[(size_t)U * 64 + d] = __expf(bl - bm); }
        WG_BAR_LDS();
        if (wave < 4) { const int ib = wave >> 1, jb = wave & 1; f32x16 acc = {};
#pragma unroll
            for (int ks = 0; ks < 4; ++ks) { const bf16x8 a = *(const LAS bf16x8*)(RT + (32 * ib + r32) * HP + 16 * ks + 8 * hi), bq = *(const LAS bf16x8*)(VT + (32 * jb + r32) * HP + 16 * ks + 8 * hi);
                acc = MFMA32(a, bq, acc); }
            float* up = Ug + ((size_t)U * 64 + 32 * jb + r32) * 64 + 32 * ib + 4 * hi;
#pragma unroll
            for (int rr = 0; rr < 4; ++rr) *(f32x4*)(up + 8 * rr) = (f32x4){acc[4 * rr], acc[4 * rr + 1], acc[4 * rr + 2], acc[4 * rr + 3]}; }
        WG_BAR_LDS();
    }
}

__device__ __forceinline__ void h2_phase(KP p, int G, int tid) {
    unsigned char* ws = p->ws; const float* Ug = (const float*)(ws + WS_UG); const float* Dg = (const float*)(ws + WS_DG); const float* D2g = (const float*)(ws + WS_D2G); bf16* Sst = (bf16*)(ws + WS_SST);
    for (int gid = blockIdx.x * NTHR + tid; gid < 32 * 4096; gid += G * NTHR) {
        const int bh = gid >> 12, ed = gid & 4095, d = ed & 63; float S = 0.f;
        const float* up = Ug + (size_t)bh * 128 * 4096 + ed; const float* dp = Dg + (size_t)bh * 128 * 64 + d; const float* d2p = D2g + (size_t)bh * 128 * 64 + d; bf16* sp = Sst + (size_t)bh * 128 * 4096 + ed;
        for (int c0 = 0; c0 < 128; c0 += 8) { float u[8], dd[8], d2[8];
#pragma unroll
            for (int i = 0; i < 8; ++i) { u[i] = up[(size_t)(c0 + i) * 4096]; dd[i] = dp[(c0 + i) * 64]; d2[i] = d2p[(c0 + i) * 64]; }
#pragma unroll
            for (int i = 0; i < 8; ++i) { sp[(size_t)(c0 + i) * 4096] = (bf16)f2bf(S); S = dd[i] * S + d2[i] * u[i]; } }
    }
}

__device__ __forceinline__ void h3_phase(KP p, int l, LAS unsigned char* lds, int vcu, int G, int tid, int wave, int lane) {
    unsigned char* ws = p->ws; const bf16* Z = (const bf16*)(ws + WS_Z); const bf16* Sst = (const bf16*)(ws + WS_SST); bf16* Ob = (bf16*)(ws + WS_OBUF);
    LAS float* SEG = (LAS float*)(lds + HG_SEG);
    LAS bf16* Pt = (LAS bf16*)(lds + HG_P); LAS bf16* Rt = (LAS bf16*)(lds + HG_R); LAS bf16* VT = (LAS bf16*)(lds + HG_VT); LAS bf16* ST = (LAS bf16*)(lds + HG_ST); LAS bf16* CG = (LAS bf16*)(lds + HG_CG);
    const int r32 = lane & 31, hi = lane >> 5; const int d = tid & 63, seg = tid >> 6;
    const float* gn = p->norm_g + l * 512;
    for (int U = vcu; U < 4096; U += G) {
        const int bh = U >> 7, c = U & 127, b = bh >> 3, h = bh & 7; const int t0 = b * SEQ + c * 64; const bf16* rp = H_ROWP(U);
        unsigned short zf[8], qv[8], vv[8], gg[8], sv[8];
#pragma unroll
        for (int i = 0; i < 8; ++i) { zf[i] = rp[(size_t)i * ZP + Z_CF]; qv[i] = rp[(size_t)i * ZP + Z_CQ]; vv[i] = rp[(size_t)i * ZP + Z_CI]; gg[i] = rp[(size_t)i * ZP + Z_CG]; sv[i] = Sst[(size_t)U * 4096 + (8 * seg + i) * 64 + d]; }
        float kk[8], bb[8], bm, bl; hgrn_front(p, l, zf, h, d, seg, SEG, kk, bb, bm, bl); (void)bl;
        { const float ebm = __expf(bm); unsigned vw[4];
#pragma unroll
          for (int i = 0; i < 8; ++i) { const int t = 8 * seg + i;
              Pt[t * HP + d] = (bf16)f2bf(bf2f(qv[i]) * __expf(fminf(bb[i] - bm, 80.f))); Rt[t * HP + d] = (bf16)f2bf(kk[i] * __expf(fminf(bm - bb[i], 80.f)));
              ST[t * HP + d] = (bf16)f2bf(bf2f(sv[i]) * ebm); CG[t * HP + d] = (bf16)gg[i]; }
#pragma unroll
          for (int i = 0; i < 4; ++i) vw[i] = (unsigned)vv[2 * i] | ((unsigned)vv[2 * i + 1] << 16);
          *(LAS u32x4*)(VT + d * HP + 8 * seg) = (u32x4){vw[0], vw[1], vw[2], vw[3]}; }
        WG_BAR_LDS();
        if (wave < 2) { const int ib = wave;
            u32x4 pw[2][2];
#pragma unroll
            for (int k = 0; k < 2; ++k) { f32x16 a = {};
                if (k <= ib) {
#pragma unroll
                    for (int js = 0; js < 4; ++js) { const bf16x8 ra = *(const LAS bf16x8*)(Rt + (32 * k + r32) * HP + 16 * js + 8 * hi), pb = *(const LAS bf16x8*)(Pt + (32 * ib + r32) * HP + 16 * js + 8 * hi);
                        a = MFMA32(ra, pb, a); }
                    if (k == ib) {
#pragma unroll
                        for (int r = 0; r < 16; ++r) if (crow(r, hi) > r32) a[r] = 0.f;
                    }
                }
#pragma unroll
                for (int i = 0; i < 4; ++i) { pw[k][0][i] = cvtpk(a[2 * i], a[2 * i + 1]); pw[k][1][i] = cvtpk(a[8 + 2 * i], a[8 + 2 * i + 1]); } }
            f32x16 oacc[2]; float ss = 0.f;
#pragma unroll
            for (int j = 0; j < 2; ++j) { f32x16 oa = {};
#pragma unroll
                for (int k = 0; k < 2; ++k) { if (k <= ib) {
#pragma unroll
                    for (int st = 0; st < 2; ++st) { const LAS bf16* vp = VT + (32 * j + r32) * HP + 32 * k + 16 * st + 4 * hi;
                        const s16x4 v0 = *(const LAS s16x4*)vp, v1 = *(const LAS s16x4*)(vp + 8);
                        const bf16x8 vf = {v0[0], v0[1], v0[2], v0[3], v1[0], v1[1], v1[2], v1[3]};
                        oa = MFMA32(vf, __builtin_bit_cast(bf16x8, pw[k][st]), oa); } } }
#pragma unroll
                for (int js = 0; js < 4; ++js) { const bf16x8 sa = *(const LAS bf16x8*)(ST + (32 * j + r32) * HP + 16 * js + 8 * hi), pb = *(const LAS bf16x8*)(Pt + (32 * ib + r32) * HP + 16 * js + 8 * hi);
                    oa = MFMA32(sa, pb, oa); }
#pragma unroll
                for (int r = 0; r < 16; ++r) ss += oa[r] * oa[r];
                oacc[j] = oa; }
            ss = swapsum(ss);
            const float rstd = 1.0f / sqrtf(ss * (1.0f / 64.0f) + RMS_EPS);
            bf16* orow = Ob + (size_t)(t0 + 32 * ib + r32) * OP + 1024 + h * 64;
#pragma unroll
            for (int j = 0; j < 2; ++j)
#pragma unroll
                for (int rr = 0; rr < 4; ++rr) { const int e0 = 32 * j + 8 * rr + 4 * hi; const f32x4 g4 = *(const f32x4*)(gn + h * 64 + e0);
                    const u32x2 cw = *(const LAS u32x2*)(CG + (32 * ib + r32) * HP + e0);
                    const float o0 = oacc[j][4 * rr] * rstd * g4[0] * sigmoidf_(bflo(cw.x)), o1 = oacc[j][4 * rr + 1] * rstd * g4[1] * sigmoidf_(bfhi(cw.x));
                    const float o2 = oacc[j][4 * rr + 2] * rstd * g4[2] * sigmoidf_(bflo(cw.y)), o3 = oacc[j][4 * rr + 3] * rstd * g4[3] * sigmoidf_(bfhi(cw.y));
                    *(u32x2*)(orow + e0) = (u32x2){cvtpk(o0, o1), cvtpk(o2, o3)}; }
        }
        WG_BAR_LDS();
    }
}

#undef H_ROWP
constexpr int RT_LG = 0, RT_HIST = 8 * 2048, RT_END = RT_HIST + 1024;
static_assert(RT_END <= SCR_BYTES, "router LDS");
typedef short bf16x8_t __attribute__((ext_vector_type(8)));
__device__ __forceinline__ void split_hi_lo(const f32x4 a, const f32x4 b, bf16x8_t& hi, bf16x8_t& lo) {
    const float v[8] = {a.x, a.y, a.z, a.w, b.x, b.y, b.z, b.w}; unsigned h[8], l[8];
#pragma unroll
    for (int i = 0; i < 8; ++i) { h[i] = f2bf(v[i]); l[i] = f2bf(v[i] - bf2f(h[i])); }
    const u32x4 hw = {h[0] | (h[1] << 16), h[2] | (h[3] << 16), h[4] | (h[5] << 16), h[6] | (h[7] << 16)}, lw = {l[0] | (l[1] << 16), l[2] | (l[3] << 16), l[4] | (l[5] << 16), l[6] | (l[7] << 16)};
    hi = __builtin_bit_cast(bf16x8_t, hw); lo = __builtin_bit_cast(bf16x8_t, lw);
}
__device__ __forceinline__ void ln1_phase(KP p, int l, const float* xin, LAS unsigned char* lds, int G, int tid, int wave, int lane) {
    unsigned char* ws = p->ws; const float* mix = (const float*)(ws + WS_MIX); float* x1 = (float*)(ws + WS_X1); bf16* x1b = (bf16*)(ws + WS_X1B);
    int* tke = (int*)(ws + WS_TKE); float* tkg = (float*)(ws + WS_TKG); int* wgcnt = (int*)(ws + WS_WGCNT);
    LAS float* LG = (LAS float*)(lds + RT_LG) + wave * 512; LAS unsigned* hist = (LAS unsigned*)(lds + RT_HIST);
    if (tid < 32) hist[tid] = 0u;
    WG_BAR();
    const float* lg = p->ln1_g + l * 1024; const float* lb = p->ln1_b + l * 1024;
    f32x4 gv[4], bv[4];
#pragma unroll
    for (int j = 0; j < 4; ++j) { gv[j] = *(const f32x4*)(lg + 4 * lane + 256 * j); bv[j] = *(const f32x4*)(lb + 4 * lane + 256 * j); }
    const int m0 = blockIdx.x * NWAVES + wave, mstride = G * NWAVES;
    for (int mb = m0; mb < NTOK; mb += 16 * mstride) {
        f32x4 xa[4], xm[4];
        { const f32x4* xr = (const f32x4*)(xin + (size_t)mb * DM) + lane; const f32x4* mr = (const f32x4*)(mix + (size_t)mb * DM) + lane;
#pragma unroll
          for (int j = 0; j < 4; ++j) { xa[j] = xr[64 * j]; xm[j] = mr[64 * j]; } }
#pragma unroll 1
        for (int i = 0; i < 16; ++i) { const int m = mb + i * mstride; if (m >= NTOK) break;
            f32x4 v[4]; float s = 0.f;
#pragma unroll
            for (int j = 0; j < 4; ++j) { v[j] = xa[j] * ALPHA + xm[j]; s += (v[j].x + v[j].y) + (v[j].z + v[j].w); }
            { const int mn = (m + mstride < NTOK) ? m + mstride : m;
              const f32x4* xr = (const f32x4*)(xin + (size_t)mn * DM) + lane; const f32x4* mr = (const f32x4*)(mix + (size_t)mn * DM) + lane;
#pragma unroll
              for (int j = 0; j < 4; ++j) { xa[j] = xr[64 * j]; xm[j] = mr[64 * j]; } }
            const float mean = wave_sum(s) * (1.f / DM); float s2 = 0.f;
#pragma unroll
            for (int j = 0; j < 4; ++j) { v[j] = v[j] - mean; s2 += (v[j].x * v[j].x + v[j].y * v[j].y) + (v[j].z * v[j].z + v[j].w * v[j].w); }
            const float rstd = 1.f / sqrtf(wave_sum(s2) * (1.f / DM) + LN_EPS);
            f32x4* o4 = (f32x4*)(x1 + (size_t)m * DM) + lane; unsigned* o1 = (unsigned*)((unsigned char*)x1b + (size_t)m * DM) + lane;
#pragma unroll
            for (int j = 0; j < 4; ++j) { v[j] = v[j] * rstd * gv[j] + bv[j]; o4[64 * j] = v[j]; int w8 = __builtin_amdgcn_cvt_pk_fp8_f32(v[j].x, v[j].y, 0, false); w8 = __builtin_amdgcn_cvt_pk_fp8_f32(v[j].z, v[j].w, w8, true); o1[64 * j] = (unsigned)w8; } }
        asm volatile("s_waitcnt vmcnt(0)" ::: "memory"); __builtin_amdgcn_fence(__ATOMIC_ACQUIRE, "agent"); asm volatile("s_waitcnt vmcnt(0)" ::: "memory");
        { const int ti = lane & 15, kg = lane >> 4; int mt = mb + ti * mstride; if (mt >= NTOK) mt = mb;
          const float* xr = x1 + (size_t)mt * DM + 8 * kg; const bf16* wf = (const bf16*)(ws + WS_WRF) + (size_t)l * 32 * 2 * 2 * 512 + lane * 8;
          f32x4 acc0 = {0.f, 0.f, 0.f, 0.f}, acc1 = {0.f, 0.f, 0.f, 0.f};
#pragma unroll 4
          for (int s = 0; s < 32; ++s) { const f32x4 a0 = *(const f32x4*)(xr + 32 * s), a1 = *(const f32x4*)(xr + 32 * s + 4); bf16x8_t ah, al; split_hi_lo(a0, a1, ah, al);
              const bf16x8_t w0h = *(const bf16x8_t*)(wf + (size_t)(s * 4 + 0) * 512), w0l = *(const bf16x8_t*)(wf + (size_t)(s * 4 + 1) * 512), w1h = *(const bf16x8_t*)(wf + (size_t)(s * 4 + 2) * 512), w1l = *(const bf16x8_t*)(wf + (size_t)(s * 4 + 3) * 512);
              acc0 = __builtin_amdgcn_mfma_f32_16x16x32_bf16(ah, w0h, acc0, 0, 0, 0); acc0 = __builtin_amdgcn_mfma_f32_16x16x32_bf16(al, w0h, acc0, 0, 0, 0); acc0 = __builtin_amdgcn_mfma_f32_16x16x32_bf16(ah, w0l, acc0, 0, 0, 0);
              acc1 = __builtin_amdgcn_mfma_f32_16x16x32_bf16(ah, w1h, acc1, 0, 0, 0); acc1 = __builtin_amdgcn_mfma_f32_16x16x32_bf16(al, w1h, acc1, 0, 0, 0); acc1 = __builtin_amdgcn_mfma_f32_16x16x32_bf16(ah, w1l, acc1, 0, 0, 0); }
#pragma unroll
          for (int r = 0; r < 4; ++r) { LG[(4 * kg + r) * 32 + ti] = acc0[r]; LG[(4 * kg + r) * 32 + 16 + ti] = acc1[r]; } }
        LDS_WAIT();
        if (lane < 16) { const int m = mb + lane * mstride;
            if (m < NTOK) { float tv0 = -3e38f, tv1 = -3e38f, tv2 = -3e38f, tv3 = -3e38f; int ti0 = 0, ti1 = 0, ti2 = 0, ti3 = 0;
#pragma unroll
                for (int e4 = 0; e4 < 8; ++e4) { const f32x4 lv = *(const LAS f32x4*)(LG + lane * 32 + 4 * e4); const f32x4 bb = *(const f32x4*)(p->b_router + l * 32 + 4 * e4);
#pragma unroll
                    for (int i = 0; i < 4; ++i) { const float g = lv[i] + bb[i]; const int e = 4 * e4 + i;
                        if (g > tv0) { tv3 = tv2; ti3 = ti2; tv2 = tv1; ti2 = ti1; tv1 = tv0; ti1 = ti0; tv0 = g; ti0 = e; }
                        else if (g > tv1) { tv3 = tv2; ti3 = ti2; tv2 = tv1; ti2 = ti1; tv1 = g; ti1 = e; }
                        else if (g > tv2) { tv3 = tv2; ti3 = ti2; tv2 = g; ti2 = e; }
                        else if (g > tv3) { tv3 = g; ti3 = e; } } }
                const float e1 = __expf(tv1 - tv0), e2 = __expf(tv2 - tv0), e3 = __expf(tv3 - tv0); const float inv = 1.f / (1.f + e1 + e2 + e3);
                *(int4*)(tke + m * 4) = make_int4(ti0, ti1, ti2, ti3); *(f32x4*)(tkg + m * 4) = (f32x4){inv, e1 * inv, e2 * inv, e3 * inv};
                __hip_atomic_fetch_add(hist + ti0, 1u, __ATOMIC_RELAXED, __HIP_MEMORY_SCOPE_WORKGROUP); __hip_atomic_fetch_add(hist + ti1, 1u, __ATOMIC_RELAXED, __HIP_MEMORY_SCOPE_WORKGROUP);
                __hip_atomic_fetch_add(hist + ti2, 1u, __ATOMIC_RELAXED, __HIP_MEMORY_SCOPE_WORKGROUP); __hip_atomic_fetch_add(hist + ti3, 1u, __ATOMIC_RELAXED, __HIP_MEMORY_SCOPE_WORKGROUP); } }
        LDS_WAIT();
    }
    WG_BAR();
    if (tid < 32) wgcnt[blockIdx.x * 32 + tid] = (int)hist[tid];
}

__device__ __forceinline__ void slot_phase(KP p, LAS unsigned char* lds, int G, int tid, int wave, int lane) {
    unsigned char* ws = p->ws; const int* wgcnt = (const int*)(ws + WS_WGCNT); int* blk = (int*)(ws + WS_BLK);
    const int* tke = (const int*)(ws + WS_TKE); const float* tkg = (const float*)(ws + WS_TKG); int* tokslot = (int*)(ws + WS_TOKSLOT); float* gslot = (float*)(ws + WS_GSLOT);
    LAS unsigned* tot = (LAS unsigned*)lds; LAS unsigned* mine = tot + 32; LAS unsigned* cur = tot + 64;
    if (tid < 96) tot[tid] = 0u;
    WG_BAR();
    { const int e = tid & 31, part = tid >> 5; unsigned sa = 0u, sb = 0u;
      for (int w = part; w < G; w += 16) { const unsigned c = (unsigned)wgcnt[w * 32 + e]; sa += c; if (w < (int)blockIdx.x) sb += c; }
      __hip_atomic_fetch_add(tot + e, sa, __ATOMIC_RELAXED, __HIP_MEMORY_SCOPE_WORKGROUP); __hip_atomic_fetch_add(mine + e, sb, __ATOMIC_RELAXED, __HIP_MEMORY_SCOPE_WORKGROUP); }
    WG_BAR();
    if (tid == 0) { unsigned off = 0u;
#pragma unroll 1
        for (int e = 0; e < 32; ++e) { const unsigned padded = (tot[e] + 255u) & ~255u; cur[e] = off + mine[e];
            if (blockIdx.x == 0) { blk[BST_OFF + e] = (int)(off >> 8);
#pragma unroll 1
                for (unsigned bb = off >> 8; bb < ((off + padded) >> 8); ++bb) blk[16 + bb] = e; }
            off += padded; }
        if (blockIdx.x == 0) { blk[0] = (int)(off >> 8); blk[BST_OFF + 32] = (int)(off >> 8); } }
    WG_BAR();
    int* slottok = (int*)(ws + WS_SLOTTOK);
    if (blockIdx.x == 0 && tid < 32) { const unsigned ps = cur[tid], n = tot[tid];
        int zero_ = 0; asm volatile("" : "+v"(zero_));
#pragma unroll 1
        for (unsigned s = ps + n; s < ps + ((n + 255u) & ~255u); ++s) slottok[s] = zero_; }
    WG_BAR();
    for (int m = blockIdx.x * NWAVES + wave; m < NTOK; m += G * NWAVES) {
        if (lane < 4) { const int e = tke[m * 4 + lane]; const int slot = (int)__hip_atomic_fetch_add(cur + e, 1u, __ATOMIC_RELAXED, __HIP_MEMORY_SCOPE_WORKGROUP); tokslot[m * 4 + lane] = slot; gslot[slot] = tkg[m * 4 + lane]; slottok[slot] = m; }
    }
}

__device__ __forceinline__ void comb_phase(KP p, int l, float* xout, int G, int wave, int lane) {
    unsigned char* ws = p->ws; const float* x1 = (const float*)(ws + WS_X1); const bf16* y = (const bf16*)(ws + WS_Y); const int* tokslot = (const int*)(ws + WS_TOKSLOT); bf16* xb = (bf16*)(ws + WS_XB);
    const float* lg = p->ln2_g + l * 1024; const float* lb = p->ln2_b + l * 1024;
    f32x4 gv[4], bv[4];
#pragma unroll
    for (int j = 0; j < 4; ++j) { gv[j] = *(const f32x4*)(lg + 4 * lane + 256 * j); bv[j] = *(const f32x4*)(lb + 4 * lane + 256 * j); }
    for (int m = blockIdx.x * NWAVES + wave; m < NTOK; m += G * NWAVES) {
        const f32x4* xr = (const f32x4*)(x1 + (size_t)m * DM) + lane;
        f32x4 v[4];
#pragma unroll
        for (int j = 0; j < 4; ++j) v[j] = xr[64 * j] * ALPHA;
#pragma unroll
        for (int k = 0; k < 4; ++k) { const int sk = __builtin_amdgcn_readfirstlane(tokslot[m * 4 + k]); const u32x2* yr = (const u32x2*)(y + (size_t)sk * DM) + lane;
#pragma unroll
            for (int j = 0; j < 4; ++j) { const u32x2 w = yr[64 * j]; v[j].x += bflo(w.x); v[j].y += bfhi(w.x); v[j].z += bflo(w.y); v[j].w += bfhi(w.y); } }
        float s = 0.f;
#pragma unroll
        for (int j = 0; j < 4; ++j) s += (v[j].x + v[j].y) + (v[j].z + v[j].w);
        const float mean = wave_sum(s) * (1.f / DM); float s2 = 0.f;
#pragma unroll
        for (int j = 0; j < 4; ++j) { v[j] = v[j] - mean; s2 += (v[j].x * v[j].x + v[j].y * v[j].y) + (v[j].z * v[j].z + v[j].w * v[j].w); }
        const float rstd = 1.f / sqrtf(wave_sum(s2) * (1.f / DM) + LN_EPS);
        f32x4* o4 = (f32x4*)(xout + (size_t)m * DM) + lane; u32x2* o2 = (u32x2*)(xb + (size_t)m * DM) + lane;
#pragma unroll
        for (int j = 0; j < 4; ++j) { v[j] = v[j] * rstd * gv[j] + bv[j]; o4[64 * j] = v[j]; o2[64 * j] = (u32x2){pk2(v[j].x, v[j].y), pk2(v[j].z, v[j].w)}; }
    }
}

#ifndef ONE_LAUNCH
#define ONE_LAUNCH 1
#endif
__global__ void __launch_bounds__(NTHR, 2) fwd(Params p) {
    extern __shared__ __attribute__((aligned(16))) unsigned char lds_raw[];
    LAS unsigned char* lds = (LAS unsigned char*)lds_raw;
    volatile LAS unsigned* MISC = (volatile LAS unsigned*)(lds + MISC_OFF);
    const int tid = threadIdx.x, lane = tid & 63, wave = __builtin_amdgcn_readfirstlane(tid >> 6); const int wave0 = wave;
    const int G = gridDim.x; const int bx = blockIdx.x; const int vcu = (G % 8 == 0) ? (bx % 8) * (G / 8) + bx / 8 : bx;
    if (tid < 64) MISC[tid] = 0u;
    __syncthreads();
    if (p.use_bar) (void)xcd_barrier_post((unsigned*)(p.ws + WS_CTL) + CW_BAR, MISC + 8);
    const int lo = p.ph_lo, hi = p.ph_hi;
#ifndef PHSEL
#define PHSEL(k) true
#endif
#define IN(k) (PHSEL(k) && lo <= (k) && (k) < hi)
#define SEAM(k) do { if (lo <= (k) && (k) + 1 < hi) { KP qb_ = load_params(); XcdBarrier b_; b_.bar = (unsigned*)(qb_->ws + WS_CTL) + CW_BAR; b_.x = xb_xcc_id(); b_.st = MISC + 8; xcd_barrier(b_); } } while (0)
    const int gw0 = vcu * NWAVES + wave, NGW = G * NWAVES;
#define PH_IDS const int lane = lane_id(), wave = wave0, tid = wave0 * 64 + lane, gw = vcu * NWAVES + wave; (void)lane; (void)gw; (void)gw0;

    if (IN(0)) { PH_IDS KP q = load_params(); p0_prologue(q, lds, gw, NGW, wave, lane); SEAM(0); }

    for (int l = 0; l < DEPTH; ++l) {
        const int pb = 1 + l * NPH_LAYER;

        if (IN(pb + PH_INPROJ)) {
            KP q = load_params(); unsigned char* w = q->ws;
            pg8::Gemm g{(const bf16*)(w + WS_XB), (const bf16*)(w + WS_WIN) + (size_t)l * ZP * 1024, NTOK, ZP, 1024}; pg8::StaticOrder S; S.init(NTOK, ZP, G, bx);
            pg8::EpiZ E{(bf16*)(w + WS_Z), ZP, (const float*)(w + WS_TRIG)};
            pg8::gemm_phase<pg8::EpiZ, pg8::StaticOrder, true, true>(lds, g, S, E, wave0);
            SEAM(pb + PH_INPROJ);
        }
        if (IN(pb + PH_IDX)) { PH_IDS KP q = load_params(); idx_phase(q, l, lds, vcu, G, tid, wave, lane); SEAM(pb + PH_IDX); }
        if (IN(pb + PH_ATTN)) { PH_IDS KP q = load_params(); attn_phase(q, l, lds, vcu, G, wave0); SEAM(pb + PH_ATTN); }
        if (IN(pb + PH_H1)) { PH_IDS KP q = load_params(); h1_phase(q, l, lds, vcu, G, tid, wave, lane); SEAM(pb + PH_H1); }
        if (IN(pb + PH_H2)) { PH_IDS KP q = load_params(); h2_phase(q, G, tid); SEAM(pb + PH_H2); }
        if (IN(pb + PH_H3)) { PH_IDS KP q = load_params(); h3_phase(q, l, lds, vcu, G, tid, wave, lane); SEAM(pb + PH_H3); }
        if (IN(pb + PH_MERGE)) {
            KP q = load_params(); unsigned char* w = q->ws;
            pg8::Gemm g{(const bf16*)(w + WS_OBUF), (const bf16*)(w + WS_WP) + (size_t)l * 1024 * 1536, NTOK, 1024, 1536}; pg8::StaticOrder S; S.init(NTOK, 1024, G, bx);
            pg8::EpiMerge E{(const bf16*)(w + WS_Z) + Z_GT, ZP, (bf16*)(w + WS_MERGED), 1024};
            pg8::gemm_phase<pg8::EpiMerge, pg8::StaticOrder, true, true>(lds, g, S, E, wave0);
            SEAM(pb + PH_MERGE);
        }
        if (IN(pb + PH_WOUT)) {
            KP q = load_params(); unsigned char* w = q->ws;
            pg8::Gemm g{(const bf16*)(w + WS_MERGED), (const bf16*)(w + WS_WOUT) + (size_t)l * 1024 * 1024, NTOK, 1024, 1024}; pg8::StaticOrder S; S.init(NTOK, 1024, G, bx);
            pg8::EpiF32 E{(float*)(w + WS_MIX), 1024};
            pg8::gemm_phase<pg8::EpiF32, pg8::StaticOrder, true, true>(lds, g, S, E, wave0);
            SEAM(pb + PH_WOUT);
        }
        if (IN(pb + PH_LN1)) { PH_IDS KP q = load_params(); const float* xin = (l == 0) ? q->x : (const float*)(q->ws + WS_XCUR); ln1_phase(q, l, xin, lds, G, tid, wave, lane); SEAM(pb + PH_LN1); }
        if (IN(pb + PH_SLOT)) { PH_IDS KP q = load_params(); slot_phase(q, lds, G, tid, wave, lane); SEAM(pb + PH_SLOT); }
        if (IN(pb + PH_GU)) {
            KP q = load_params(); unsigned char* w = q->ws;
            pg8::Gemm g{(const bf16*)(w + WS_X1B), (const bf16*)(w + WS_WGU + (size_t)l * 32 * 2048 * 1024), MAXSLOT, 32 * 2048, 1024};
            pg8::moe_build_list((LAS int*)(lds + pg8::STAGE_BYTES), (const int*)(w + WS_BLK), 8, G, bx, wave0 * 64 + lane_id()); pg8::MoeOrderG S{(const LAS int*)(lds + pg8::STAGE_BYTES), (const int*)(w + WS_SLOTTOK)};
            pg8::EpiSwiGLU E{(bf16*)(w + WS_ACT), (const float*)(w + WS_BGU) + (size_t)l * 32 * 2048, 8};
            pg8::gemm_phase<pg8::EpiSwiGLU, pg8::MoeOrderG, true, true, true, W8_E8M0>(lds, g, S, E, wave0);
            SEAM(pb + PH_GU);
        }
        if (IN(pb + PH_DOWN)) {
            KP q = load_params(); unsigned char* w = q->ws;
            pg8::Gemm g{(const bf16*)(w + WS_ACT), (const bf16*)(w + WS_WDN + (size_t)l * 32 * 1024 * 1024), MAXSLOT, 32 * 1024, 1024};
            pg8::moe_build_list((LAS int*)(lds + pg8::STAGE_BYTES), (const int*)(w + WS_BLK), 4, G, bx, wave0 * 64 + lane_id()); pg8::MoeOrder S{(const LAS int*)(lds + pg8::STAGE_BYTES), nullptr};
            pg8::EpiDown E{(bf16*)(w + WS_Y), q->b_down + (size_t)l * 32 * 1024, (const float*)(w + WS_GSLOT), 4};
            pg8::gemm_phase<pg8::EpiDown, pg8::MoeOrder, true, true, true, W8_E8M0>(lds, g, S, E, wave0);
            SEAM(pb + PH_DOWN);
        }
        if (IN(pb + PH_COMB)) { PH_IDS KP q = load_params(); float* xout = (l == DEPTH - 1) ? q->out : (float*)(q->ws + WS_XCUR); comb_phase(q, l, xout, G, wave, lane); SEAM(pb + PH_COMB); }
    }
#undef IN
#undef SEAM
}

#ifndef DBG
#define DBG 0
#endif
#if DBG
constexpr int CW_DBG = 64;
__device__ __forceinline__ unsigned hsh(unsigned a) { a ^= a >> 16; a *= 0x7feb352du; a ^= a >> 15; a *= 0x846ca68bu; a ^= a >> 16; return a; }
__device__ __forceinline__ void dbg_fail(Params& p, int id) { atomicMin((int*)(p.ws + WS_CTL) + CW_DBG, id); }
__device__ __forceinline__ bool bad(float a, float ref, float rel, float abs_) { return !(fabsf(a - ref) <= rel * fabsf(ref) + abs_); }
__device__ __forceinline__ float dotx(const float* xr, const float* W, int ld, int col, int K) { float s = 0.f; for (int k = 0; k < K; ++k) s += xr[k] * W[(size_t)k * ld + col]; return s; }

__global__ void __launch_bounds__(64) chk(Params p, int l, int which) {
    __shared__ float Ssh[64 * 65];
    unsigned char* ws = p.ws; const int gt_ = blockIdx.x * 64 + threadIdx.x; const unsigned h0 = hsh(gt_ * 2654435761u + which * 97u + 12345u), h1 = hsh(h0 + 0x9e3779b9u), h2 = hsh(h1 + 77u);
    const float* xin = (l == 0) ? p.x : (const float*)(ws + WS_XCUR);
    const bf16* Z = (const bf16*)(ws + WS_Z);
    const int id = (l * 20 + which) * 4;
    const float* win = p.w_in + (size_t)l * 1024 * D_IN;
    if (which == 1) {
        const int t = h0 % NTOK, n = h1 % D_IN; const int sc = zcol_src(n); const float scale = (n < 512 || (n >= Z_FQ && n < Z_FK)) ? QSCALE : 1.f;
        const float ref = dotx(xin + (size_t)t * DM, win, D_IN, sc, 1024) * scale;
        if (bad(bf2f(Z[(size_t)t * ZP + n]), ref, 0.03f, 0.03f)) dbg_fail(p, id);
    } else if (which == 2) {
        const int t = h0 % NTOK, pos = t & (SEQ - 1), b = t >> 13; const float* xr = xin + (size_t)t * DM;
        { const int hh = h1 % 21, i = h2 & 31; const int col = hh < 8 ? Z_AQ + hh * 64 : hh < 16 ? Z_AK + (hh - 8) * 64 : hh < 20 ? Z_IQ + (hh - 16) * 64 : Z_IK;
          const float sc = hh < 8 ? QSCALE : 1.f; const float t1 = dotx(xr, win, D_IN, zcol_src(col + i), 1024) * sc, t2 = dotx(xr, win, D_IN, zcol_src(col + i + 32), 1024) * sc;
          const float inv = powf(10000.f, -(float)i / 32.f); const float ang = (float)pos * inv; const double rev = (double)ang * 0.15915494309189535; const float fr = (float)(rev - __builtin_rint(rev));
          const float c = __builtin_amdgcn_cosf(fr), s = __builtin_amdgcn_sinf(fr);
          if (bad(bf2f(Z[(size_t)t * ZP + col + i]), t1 * c - t2 * s, 0.03f, 0.03f) || bad(bf2f(Z[(size_t)t * ZP + col + i + 32]), t2 * c + t1 * s, 0.03f, 0.03f)) dbg_fail(p, id); }
        { const int c = h2 % 1024; const float a0 = dotx(xr, win, D_IN, 5452 + c, 1024), a1 = dotx(xr, win, D_IN, 5452 + 1024 + c, 1024), a2 = dotx(xr, win, D_IN, 5452 + 2048 + c, 1024);
          const float g0 = sigmoidf_(a0), g1 = sigmoidf_(a1), g2 = sigmoidf_(a2);
          if (bad(bf2f(Z[(size_t)t * ZP + Z_GT + c]), g0 / g1, 0.05f, 0.01f) || bad(bf2f(Z[(size_t)t * ZP + Z_GT + 1024 + c]), g1 / g2, 0.05f, 0.01f) || bad(bf2f(Z[(size_t)t * ZP + Z_GT + 2048 + c]), g2, 0.05f, 0.01f)) dbg_fail(p, id + 1); }
        { const int hh = h1 & 7; const float v = dotx(xr, win, D_IN, 3396 + hh, 1024) + p.b_fox[l * 8 + hh]; const float ls = -log1pf(expf(-v)) * LOG2E;
          if (bad(((const float*)(ws + WS_LFT))[(size_t)(b * 8 + hh) * SEQ + pos], ls, 0.05f, 0.003f)) dbg_fail(p, id + 2); }
    } else if (which == 3) {
        { const int bh = h0 & 31, t = h1 % SEQ; const float* lf = (const float*)(ws + WS_LFT) + (size_t)bh * SEQ; float s = 0.f; for (int i = 0; i <= t; ++i) s += lf[i];
          if (bad(((const float*)(ws + WS_CT))[(size_t)bh * SEQ + t], s, 1e-3f, 1e-2f)) dbg_fail(p, id); }
        if (gt_ < 192) { const int b = h1 & 3, q = (gt_ < 32) ? (int)(h2 % 512) : (int)(h2 % SEQ); const int nadm = ((q >> 6) + 1) * 64; const u64* mw = (const u64*)(ws + WS_MASKW) + (size_t)(b * SEQ + q) * 128;
          int pc = 0; bool oob = false; for (int w = 0; w < 128; ++w) { const u64 m = mw[w]; pc += __popcll(m); if (w * 64 >= nadm && m) oob = true; }
          if (pc != (nadm < 256 ? nadm : 256) || oob) dbg_fail(p, id + 1);
          const bf16* qr = Z + (size_t)(b * SEQ + q) * ZP; float minsel = 3e38f, maxun = -3e38f;
          for (int s = 0; s < nadm; ++s) { const bf16* kr = Z + (size_t)(b * SEQ + s) * ZP + Z_IK; float sc = 0.f;
              for (int hd = 0; hd < 4; ++hd) { float d = 0.f; for (int k = 0; k < 64; ++k) d += bf2f(qr[Z_IQ + hd * 64 + k]) * bf2f(kr[k]); sc += bf2f(qr[Z_IW + hd]) * 0.0625f * fmaxf(d, 0.f); }
              if ((mw[s >> 6] >> (s & 63)) & 1ull) minsel = fminf(minsel, sc); else maxun = fmaxf(maxun, sc); }
          if (nadm > 256 && !(maxun <= minsel + 0.02f * fabsf(minsel) + 2e-3f)) dbg_fail(p, id + 2); }
    } else if (which == 4) {
        if (gt_ == 0 && l == 0) { const bf16* ob = (const bf16*)(ws + WS_OBUF) + 512;
            const float a0 = bf2f(ob[0]), a1 = bf2f(ob[1]), a3 = bf2f(ob[3]), b0 = bf2f(ob[8]), b1 = bf2f(ob[9]), b3 = bf2f(ob[11]), m0 = bf2f(ob[4]), m1 = bf2f(ob[12]);
            auto tr = [](float v) { return v == 0.f ? 0.f : v == 1.f ? 1.f : 2.f; };
            ((float*)(ws + WS_CTL))[CW_DBG + 2] = 10.f * (tr(a0) + 3.f * tr(b0) + 9.f * tr(a1) + 27.f * tr(b1));
            ((float*)(ws + WS_CTL))[CW_DBG + 3] = sqrtf(10.f * (tr(a3) + 3.f * tr(b3) + 9.f * (m0 == m1 ? 1.f : 0.f) + 27.f * (m0 > -1e20f ? 1.f : 0.f))); }
        const int mode = gt_ & 1, b = h0 & 3, h = (h0 >> 2) & 7, q = (gt_ < 64) ? (int)(h1 % 300) : (int)(h1 % SEQ), d = h2 & 63;
        const int QC = mode == 0 ? Z_FQ : Z_AQ, KC = mode == 0 ? Z_FK : Z_AK, VC = mode == 0 ? Z_FV : Z_AV, OC = mode == 0 ? 512 : 0;
        const bf16* qr = Z + (size_t)(b * SEQ + q) * ZP + QC + h * 64; const float* c = (const float*)(ws + WS_CT) + (size_t)(b * 8 + h) * SEQ; const u64* mw = (const u64*)(ws + WS_MASKW) + (size_t)(b * SEQ + q) * 128;
        const int ns = mode == 0 ? q + 1 : ((q >> 6) + 1) * 64; float mx = -3e38f, mx2 = -3e38f; float ref = 0.f, ref2 = 0.f;
        for (int pass = 0; pass < 2; ++pass) { float den = 0.f, num = 0.f, den2 = 0.f, num2 = 0.f;
            for (int s = 0; s < ns; ++s) { if (mode == 1 && !((mw[s >> 6] >> (s & 63)) & 1ull)) continue;
                const bf16* kr = Z + (size_t)(b * SEQ + s) * ZP + KC + h * 64; float lg = 0.f; for (int k = 0; k < 64; ++k) lg += bf2f(qr[k]) * bf2f(kr[k]);
                const float lg2 = lg; if (mode == 0) lg += c[q] - c[s];
                if (pass == 0) { mx = fmaxf(mx, lg); mx2 = fmaxf(mx2, lg2); } else { const float vv = bf2f(Z[(size_t)(b * SEQ + s) * ZP + VC + h * 64 + d]); const float pp = exp2f(lg - mx), pq = exp2f(lg2 - mx2); den += pp; num += pp * vv; den2 += pq; num2 += pq * vv; } }
            if (pass == 1) { ref = num / den; ref2 = num2 / den2; } }
        const float got = bf2f(((const bf16*)(ws + WS_OBUF))[(size_t)(b * SEQ + q) * OP + OC + h * 64 + d]);
        if (bad(got, ref, 0.04f, 0.03f)) { dbg_fail(p, id + mode);
            int m = 0; if (mode == 0 && q == 0) m |= 1; if (mode == 0 && q < 32) m |= 2; if (mode == 1 && q < 64) m |= 4; if (mode == 1 && q >= 64) m |= 8; atomicOr((int*)(p.ws + WS_CTL) + CW_DBG + 1, m); }
    } else if (which == 7) {
        const int b = blockIdx.x & 3, h = (blockIdx.x >> 2) & 7, e = threadIdx.x;
        for (int d = 0; d < 64; ++d) Ssh[d * 65 + e] = 0.f;
        const float lbv_e = 0.f; (void)lbv_e;
        for (int t = 0; t < 200; ++t) { const bf16* zr = Z + (size_t)(b * SEQ + t) * ZP + h * 64; float o = 0.f; const float ve = bf2f(zr[Z_CI + e]);
            for (int d = 0; d < 64; ++d) { const int dd = h * 64 + d; const float lb = (l == 0) ? 0.f : sigmoidf_(p.lb_logits[512 + dd] - p.lb_logits[dd]);
                const float sg = sigmoidf_(bf2f(zr[Z_CF + d])); const float f = lb + (1.f - lb) * sg, kk = (1.f - lb) * (1.f - sg);
                const float S = f * Ssh[d * 65 + e] + kk * ve; Ssh[d * 65 + e] = S; o += bf2f(zr[Z_CQ + d]) * S; }
            const float ss = wave_sum(o * o); const float ref = o * (1.f / sqrtf(ss * (1.f / 64.f) + RMS_EPS)) * p.norm_g[l * 512 + h * 64 + e] * sigmoidf_(bf2f(zr[Z_CG + e]));
            if (bad(bf2f(((const bf16*)(ws + WS_OBUF))[(size_t)(b * SEQ + t) * OP + 1024 + h * 64 + e]), ref, 0.06f, 0.05f)) { const int n = atomicAdd((int*)(p.ws + WS_CTL) + CW_DBG + 4 + (t >= 64 ? 1 : 0), 1); if (n >= 40) dbg_fail(p, id + (t >= 64 ? 1 : 0)); } }
    } else if (which == 8) {
        const int t = h0 % NTOK, c = h1 % 1024; const bf16* zr = Z + (size_t)t * ZP + Z_GT; const float g2 = bf2f(zr[2048 + c]), g1 = bf2f(zr[1024 + c]) * g2, g0 = bf2f(zr[c]) * g1;
        const bf16* ob = (const bf16*)(ws + WS_OBUF) + (size_t)t * OP; float sa = 0.f, sb = 0.f, sc = 0.f;
        for (int k = 0; k < 512; ++k) { sa += bf2f(ob[k]) * p.w_pa[((size_t)l * 512 + k) * 1024 + c]; sb += bf2f(ob[512 + k]) * p.w_pb[((size_t)l * 512 + k) * 1024 + c]; sc += bf2f(ob[1024 + k]) * p.w_pc[((size_t)l * 512 + k) * 1024 + c]; }
        if (bad(bf2f(((const bf16*)(ws + WS_MERGED))[(size_t)t * 1024 + c]), g0 * sa + g1 * sb + g2 * sc, 0.04f, 0.01f)) dbg_fail(p, id);
    } else if (which == 9) {
        const int t = h0 % NTOK, c = h1 % 1024; const bf16* mr = (const bf16*)(ws + WS_MERGED) + (size_t)t * 1024; float s = 0.f;
        for (int k = 0; k < 1024; ++k) s += bf2f(mr[k]) * p.w_out[((size_t)l * 1024 + k) * 1024 + c];
        if (bad(((const float*)(ws + WS_MIX))[(size_t)t * 1024 + c], s, 0.03f, 0.005f)) dbg_fail(p, id);
    } else if (which == 10) {
        const int t = h0 % NTOK, c = h1 % 1024; const float* xr = xin + (size_t)t * DM; const float* mr = (const float*)(ws + WS_MIX) + (size_t)t * DM; const float* x1 = (const float*)(ws + WS_X1) + (size_t)t * DM;
        float mean = 0.f; for (int k = 0; k < 1024; ++k) mean += ALPHA * xr[k] + mr[k]; mean *= (1.f / 1024.f);
        float var = 0.f; for (int k = 0; k < 1024; ++k) { const float dlt = ALPHA * xr[k] + mr[k] - mean; var += dlt * dlt; } var *= (1.f / 1024.f);
        const float ref = (ALPHA * xr[c] + mr[c] - mean) / sqrtf(var + LN_EPS) * p.ln1_g[l * 1024 + c] + p.ln1_b[l * 1024 + c];
        if (bad(x1[c], ref, 1e-3f, 1e-3f) || bad(bf2f(((const bf16*)(ws + WS_X1B))[(size_t)t * DM + c]), ref, 0.01f, 0.01f)) dbg_fail(p, id);
        float tv0 = -3e38f, tv1 = -3e38f, tv2 = -3e38f, tv3 = -3e38f; int ti0 = -1, ti1 = -1, ti2 = -1, ti3 = -1;
        for (int e = 0; e < 32; ++e) { float lg = p.b_router[l * 32 + e]; for (int k = 0; k < 1024; ++k) lg += x1[k] * p.w_router[((size_t)l * 1024 + k) * 32 + e];
            if (lg > tv0) { tv3 = tv2; ti3 = ti2; tv2 = tv1; ti2 = ti1; tv1 = tv0; ti1 = ti0; tv0 = lg; ti0 = e; } else if (lg > tv1) { tv3 = tv2; ti3 = ti2; tv2 = tv1; ti2 = ti1; tv1 = lg; ti1 = e; }
            else if (lg > tv2) { tv3 = tv2; ti3 = ti2; tv2 = lg; ti2 = e; } else if (lg > tv3) { tv3 = lg; ti3 = e; } }
        const int* tke = (const int*)(ws + WS_TKE) + t * 4; const float* tkg = (const float*)(ws + WS_TKG) + t * 4;
        const float den = 1.f + expf(tv1 - tv0) + expf(tv2 - tv0) + expf(tv3 - tv0);
        if (tv2 - tv3 > 1e-3f && tv1 - tv2 > 1e-3f && tv0 - tv1 > 1e-3f) { if (tke[0] != ti0 || tke[1] != ti1 || tke[2] != ti2 || tke[3] != ti3) dbg_fail(p, id + 1);
            if (bad(tkg[0], 1.f / den, 1e-2f, 1e-3f) || bad(tkg[3], expf(tv3 - tv0) / den, 1e-2f, 1e-3f)) dbg_fail(p, id + 2); }
    } else if (which == 11) {
        const int t = h0 % NTOK, k = h1 & 3, c = h2 % 1024; const int slot = ((const int*)(ws + WS_TOKSLOT))[t * 4 + k], e = ((const int*)(ws + WS_TKE))[t * 4 + k]; const int* blk = (const int*)(ws + WS_BLK);
        if (slot < 0 || slot >= blk[0] * 256 || blk[0] > MAXBLK) { dbg_fail(p, id); return; }
        if (blk[16 + (slot >> 8)] != e) dbg_fail(p, id + 1);
        if (((const float*)(ws + WS_GSLOT))[slot] != ((const float*)(ws + WS_TKG))[t * 4 + k]) dbg_fail(p, id + 2);
        if (((const bf16*)(ws + WS_XG))[(size_t)slot * DM + c] != ((const bf16*)(ws + WS_X1B))[(size_t)t * DM + c]) dbg_fail(p, id + 3);
    } else if (which == 12) {
        const int t = h0 % NTOK, k = h1 & 3, j = h2 % 1024; const int slot = ((const int*)(ws + WS_TOKSLOT))[t * 4 + k], e = ((const int*)(ws + WS_TKE))[t * 4 + k];
        const bf16* xr = (const bf16*)(ws + WS_XG) + (size_t)slot * DM; const float* W = p.w_gu + (size_t)(l * 32 + e) * 1024 * 2048; float g = p.b_gu[(size_t)(l * 32 + e) * 2048 + j], u = p.b_gu[(size_t)(l * 32 + e) * 2048 + 1024 + j];
        for (int kk = 0; kk < 1024; ++kk) { const float xv = bf2f(xr[kk]); g += xv * W[(size_t)kk * 2048 + j]; u += xv * W[(size_t)kk * 2048 + 1024 + j]; }
        g = fminf(g, 7.f); u = fminf(fmaxf(u, -7.f), 7.f); const float ref = g * sigmoidf_(1.702f * g) * (u + 1.f);
        if (bad(bf2f(((const bf16*)(ws + WS_ACT))[(size_t)slot * 1024 + j]), ref, 0.04f, 0.02f)) dbg_fail(p, id);
    } else if (which == 13) {
        const int t = h0 % NTOK, k = h1 & 3, n = h2 % 1024; const int slot = ((const int*)(ws + WS_TOKSLOT))[t * 4 + k], e = ((const int*)(ws + WS_TKE))[t * 4 + k];
        const bf16* ar = (const bf16*)(ws + WS_ACT) + (size_t)slot * 1024; const float* W = p.w_down + (size_t)(l * 32 + e) * 1024 * 1024; float s = p.b_down[(size_t)(l * 32 + e) * 1024 + n];
        for (int kk = 0; kk < 1024; ++kk) s += bf2f(ar[kk]) * W[(size_t)kk * 1024 + n];
        if (bad(bf2f(((const bf16*)(ws + WS_Y))[(size_t)slot * 1024 + n]), s * ((const float*)(ws + WS_GSLOT))[slot], 0.04f, 0.005f)) dbg_fail(p, id);
    } else if (which == 14) {
        const int t = h0 % NTOK, c = h1 % 1024; const float* x1 = (const float*)(ws + WS_X1) + (size_t)t * DM; const bf16* y = (const bf16*)(ws + WS_Y); const int* ts = (const int*)(ws + WS_TOKSLOT) + t * 4;
        const float* xo = ((l == DEPTH - 1) ? p.out : (float*)(ws + WS_XCUR)) + (size_t)t * DM;
        float mean = 0.f; for (int k = 0; k < 1024; ++k) { float v = ALPHA * x1[k]; for (int j = 0; j < 4; ++j) v += bf2f(y[(size_t)ts[j] * 1024 + k]); mean += v; } mean *= (1.f / 1024.f);
        float var = 0.f, vc = 0.f; for (int k = 0; k < 1024; ++k) { float v = ALPHA * x1[k]; for (int j = 0; j < 4; ++j) v += bf2f(y[(size_t)ts[j] * 1024 + k]); var += (v - mean) * (v - mean); if (k == c) vc = v; } var *= (1.f / 1024.f);
        if (bad(xo[c], (vc - mean) / sqrtf(var + LN_EPS) * p.ln2_g[l * 1024 + c] + p.ln2_b[l * 1024 + c], 2e-3f, 2e-3f)) dbg_fail(p, id);
    }
}
__global__ void dbg_init(Params p) { if (threadIdx.x == 0 && blockIdx.x == 0) { ((int*)(p.ws + WS_CTL))[CW_DBG] = 0x7fffffff; ((int*)(p.ws + WS_CTL))[CW_DBG + 1] = 0; ((int*)(p.ws + WS_CTL))[CW_DBG + 4] = 0; ((int*)(p.ws + WS_CTL))[CW_DBG + 5] = 0; } }
__global__ void dbg_fill(Params p, int n) {
    const int code = ((const int*)(p.ws + WS_CTL))[CW_DBG]; if (code == 0x7fffffff) return;
    const int sub = code & 3, lw = code >> 2, l = lw / 20, which = lw % 20; const int k = l * 16 + which + 32 * sub;
    const float c = sqrtf(exp2f((float)k));
    const int msk = ((const int*)(p.ws + WS_CTL))[CW_DBG + 1];
    for (int i = blockIdx.x * blockDim.x + threadIdx.x; i < n; i += gridDim.x * blockDim.x) p.out[i] = (i == 0) ? 16.f * (float)(1 + msk) : c;
}
#endif

extern "C" void kernel_launch(void* const* d_in, const int* in_sizes, int n_in, void* d_out, int out_size, void* d_ws, size_t ws_size, hipStream_t stream) {
    static int grid = 0;
    if (grid == 0) {
        if (n_in != 19 || ws_size < WS_END) { fprintf(stderr, "kernel_launch: need 19 inputs and >= %zu bytes of workspace; got %d, %zu\n", (size_t)WS_END, n_in, ws_size); grid = -1; return; }
        int dev = 0, cus = 0, per_cu = 0;
        if (hipGetDevice(&dev) != hipSuccess || hipDeviceGetAttribute(&cus, hipDeviceAttributeMultiprocessorCount, dev) != hipSuccess) { grid = -1; return; }
        if (hipFuncSetAttribute((const void*)fwd, hipFuncAttributeMaxDynamicSharedMemorySize, LDS_BYTES) != hipSuccess) { fprintf(stderr, "kernel_launch: hipFuncSetAttribute failed\n"); grid = -1; return; }
        if (hipOccupancyMaxActiveBlocksPerMultiprocessor(&per_cu, (const void*)fwd, NTHR, LDS_BYTES) != hipSuccess || per_cu < 1) fprintf(stderr, "kernel_launch: occupancy query reports %d\n", per_cu);
        (void)hipGetLastError();
        grid = cus;
    }
    if (grid < 0) return;
    (void)hipMemsetAsync((char*)d_ws + WS_CTL, 0, CTL_ZERO_BYTES, stream);
    Params p{};
    const float** f = (const float**)&p;
    for (int i = 0; i < 19; ++i) f[i] = (const float*)d_in[i];
    p.out = (float*)d_out; p.ws = (unsigned char*)d_ws;
#if ONE_LAUNCH
    p.ph_lo = 0; p.ph_hi = NPHASES; p.use_bar = 1; p.pad = 0;
    hipLaunchKernelGGL(fwd, dim3(grid), dim3(NTHR), LDS_BYTES, stream, p);
#else
#if DBG
    hipLaunchKernelGGL(dbg_init, dim3(1), dim3(64), 0, stream, p);
#endif
    for (int ph = 0; ph < NPHASES; ++ph) { p.ph_lo = ph; p.ph_hi = ph + 1; p.use_bar = 0; p.pad = 0;
        hipLaunchKernelGGL(fwd, dim3(grid), dim3(NTHR), LDS_BYTES, stream, p);
#if DBG
        if (ph >= 1) { const int l = (ph - 1) / NPH_LAYER, k = (ph - 1) % NPH_LAYER; static const int wmap[NPH_LAYER] = {1, 2, 3, 4, 0, 0, 7, 8, 9, 10, 11, 12, 13, 14}; const int w = wmap[k];
            if (w) { const int nb = (w == 7) ? 32 : (w == 3) ? 4 : (w == 4) ? 2 : 16; hipLaunchKernelGGL(chk, dim3(nb), dim3(64), 0, stream, p, l, w); } }
#endif
    }
#if DBG
    hipLaunchKernelGGL(dbg_fill, dim3(1024), dim3(256), 0, stream, p, out_size);
#endif
#endif
}
```

```cpp
#include <hip/hip_runtime.h>
#include <cstdio>
#include <cstdint>

#define GAS __attribute__((address_space(1)))
#define LAS __attribute__((address_space(3)))
typedef unsigned short bf16;
typedef short bf16x8 __attribute__((ext_vector_type(8)));
typedef short s16x4 __attribute__((ext_vector_type(4)));
typedef float f32x2 __attribute__((ext_vector_type(2)));
typedef float f32x4 __attribute__((ext_vector_type(4)));
typedef float f32x16 __attribute__((ext_vector_type(16)));
typedef unsigned u32x2 __attribute__((ext_vector_type(2)));
typedef unsigned u32x4 __attribute__((ext_vector_type(4)));
typedef unsigned long long u64;

__device__ __forceinline__ unsigned f2bf(float f) { unsigned u = __builtin_bit_cast(unsigned, f); return (u + 0x7fffu + ((u >> 16) & 1u)) >> 16; }
__device__ __forceinline__ unsigned pk2(float lo, float hi) { return f2bf(lo) | (f2bf(hi) << 16); }
__device__ __forceinline__ float bf2f(unsigned b) { return __builtin_bit_cast(float, b << 16); }
__device__ __forceinline__ float bflo(unsigned w) { return __builtin_bit_cast(float, w << 16); }
__device__ __forceinline__ float bfhi(unsigned w) { return __builtin_bit_cast(float, w & 0xffff0000u); }
__device__ __forceinline__ float sigmoidf_(float x) { return 1.0f / (1.0f + __expf(-x)); }

namespace pg8 {
#define PG8_LAS __attribute__((address_space(3)))
typedef unsigned short bf16_t;
typedef short bf16x8 __attribute__((ext_vector_type(8)));
typedef float f32x4 __attribute__((ext_vector_type(4)));
typedef unsigned u32x4 __attribute__((ext_vector_type(4)));
constexpr int BM = 256, BK = 64, HALF = 128, HTB = HALF * BK * 2  , STAGE_BYTES = 8 * HTB, NXCD = 8, WGM = 8;

__host__ __device__ __forceinline__ int lds_byte(int r, int c) { const int st = (r >> 4) * 2 + (c >> 5), rr = r & 15, cc = c & 31, ob = rr * 64 + cc * 2; return st * 1024 + (ob ^ (((ob >> 9) & 1) << 5)); }
__host__ __device__ __forceinline__ void stage_rc(int b, int& R, int& C) { const int st = b / 1024, sb = b % 1024, swz = sb ^ (((sb >> 9) & 1) << 5); R = (st >> 1) * 16 + swz / 64; C = (st & 1) * 32 + (swz % 64) / 2; }
__host__ __device__ __forceinline__ int perm32(int rho) { const int n = rho >> 4, i = rho & 15; return 8 * (i >> 2) + 4 * n + (i & 3); }

struct Unit { int pm, pn; };
struct Gemm { const bf16_t* A; const bf16_t* Bt; int M, N, K; };

struct StaticOrder {
    static constexpr bool GATHER = false; const int* tok = nullptr;
    int nM, nN, nwg, G, c;
    __host__ __device__ void init(int M, int N, int G_, int c_) { nM = M / BM; nN = N / BM; nwg = nM * nN; G = G_; c = c_; }
    __host__ __device__ bool next(int i, Unit& u) const {
        const long L = (long)i * G + c; if (L >= nwg) return false;
        int wgid = (int)L; { const int q = nwg / NXCD, r = nwg % NXCD, xcd = wgid % NXCD, off = wgid / NXCD; wgid = (xcd < r ? xcd * (q + 1) : r * (q + 1) + (xcd - r) * q) + off; }
        const int nig = WGM * nN, gid = wgid / nig, fm = gid * WGM, gsz = (nM - fm) < WGM ? (nM - fm) : WGM;
        u.pm = fm + ((wgid % nig) % gsz); u.pn = (wgid % nig) / gsz; return true;
    }
    __device__ __forceinline__ void a_ready(const Unit&) const {}
    __device__ __forceinline__ void done(const Unit&) const {}
};
template <bool GATHER_> struct MoeOrderT {
    static constexpr bool GATHER = GATHER_;
    const PG8_LAS int* list; const int* tok;
    __device__ bool next(int i, Unit& u) const {
        if (i >= __builtin_amdgcn_readfirstlane(list[0])) return false;
        u.pm = __builtin_amdgcn_readfirstlane(list[2 + 2 * i]); u.pn = __builtin_amdgcn_readfirstlane(list[3 + 2 * i]); return true;
    }
    __device__ __forceinline__ void a_ready(const Unit&) const {}
    __device__ __forceinline__ void done(const Unit&) const {}
};
typedef MoeOrderT<false> MoeOrder; typedef MoeOrderT<true> MoeOrderG;
__device__ __forceinline__ void moe_build_list(PG8_LAS int* list, const int* blk, int nN, int G, int c, int tid) {
    if (tid == 0) { const int* bst = blk + 16 + 544 + 16; int n = 0;
        if (G % 8 == 0) { const int W = G / 8, j = c / 8, x = c % 8;
            for (int i = 0; i < 64; ++i) { const int uu = i * W + j; const int bi = uu / nN, pl = uu - bi * nN; int rem = bi; bool ok = false;
                for (int k = 0; k < 4 && !ok; ++k) { const int e = x + 8 * k; const int b0 = bst[e], b1 = bst[e + 1]; if (rem < b1 - b0) { list[2 + 2 * n] = b0 + rem; list[3 + 2 * n] = e * nN + pl; ++n; ok = true; } else rem -= b1 - b0; }
                if (!ok) break; }
        } else { const int nb = bst[32];
            for (int i = 0; i < 64; ++i) { const int uu = i * G + c; const int bi = uu / nN, pl = uu - bi * nN; if (bi >= nb) break; int e = 0; for (int k = 1; k < 32; ++k) if (bi >= bst[k]) e = k; list[2 + 2 * n] = bi; list[3 + 2 * n] = e * nN + pl; ++n; } }
        list[0] = n; }
    asm volatile("s_waitcnt lgkmcnt(0)\n\ts_barrier" ::: "memory");
}

__device__ __forceinline__ unsigned cvt_pk_bf16(float lo, float hi) { unsigned r; asm volatile("v_cvt_pk_bf16_f32 %0, %1, %2" : "=v"(r) : "v"(lo), "v"(hi)); return r; }

struct EpiZ {
    static constexpr bool PERM = true, AFTER_DRAIN = false, MIDK = false;
    bf16_t* O; int ldc; const float* trig; bf16_t* IKC;
    __device__ __forceinline__ void operator()(const f32x4 (&acc)[2][2][4][2], const Unit& u, int wr, int wc, int fr, int fq) const {
        asm volatile("" : "+v"(fr), "+v"(fq));
        const int row0 = u.pm * BM + wr * 64 + fr; const int col0 = u.pn * BM + wc * 32 + 8 * fq;
        const bool rot_all = (u.pn < 4) || (u.pn == 32); const bool rot_b0 = rot_all || (u.pn == 33 && wc < 2);
        const int i0 = (wc & 1) * 16 + 4 * fq;
#pragma unroll
        for (int ai = 0; ai < 2; ++ai)
#pragma unroll
            for (int m = 0; m < 4; ++m) { const int row = row0 + ai * HALF + m * 16; bf16_t* rowp = O + (size_t)row * ldc + col0;
                f32x4 ca = {1.f, 0.f, 1.f, 0.f}, cb = {1.f, 0.f, 1.f, 0.f};
                if (rot_b0) { const float* tp = trig + ((size_t)(row & 8191) * 32 + i0) * 2; ca = *(const f32x4*)tp; cb = *(const f32x4*)(tp + 4); }
#pragma unroll
                for (int bj = 0; bj < 2; ++bj) { f32x4 v0 = acc[ai][bj][m][0], v1 = acc[ai][bj][m][1];
                    if (bj == 0 ? rot_b0 : rot_all) {
                        const f32x4 r0 = {v0[0] * ca[0] - v0[1] * ca[1], v0[1] * ca[0] + v0[0] * ca[1], v0[2] * ca[2] - v0[3] * ca[3], v0[3] * ca[2] + v0[2] * ca[3]};
                        const f32x4 r1 = {v1[0] * cb[0] - v1[1] * cb[1], v1[1] * cb[0] + v1[0] * cb[1], v1[2] * cb[2] - v1[3] * cb[3], v1[3] * cb[2] + v1[2] * cb[3]};
                        v0 = r0; v1 = r1; }
                    u32x4 w; w.x = cvt_pk_bf16(v0[0], v0[1]); w.y = cvt_pk_bf16(v0[2], v0[3]); w.z = cvt_pk_bf16(v1[0], v1[1]); w.w = cvt_pk_bf16(v1[2], v1[3]);
                    *(u32x4*)(rowp + bj * HALF) = w;
                    if (bj == 0 && u.pn == 33 && wc < 2) *(u32x4*)(IKC + (size_t)row * 64 + wc * 32 + 8 * fq) = w; } }
    }
};
struct EpiF32 {
    static constexpr bool PERM = true, AFTER_DRAIN = false, MIDK = false;
    float* O; int ldc;
    __device__ __forceinline__ void operator()(const f32x4 (&acc)[2][2][4][2], const Unit& u, int wr, int wc, int fr, int fq) const {
        asm volatile("" : "+v"(fr), "+v"(fq));
        const int row0 = u.pm * BM + wr * 64 + fr; const int col0 = u.pn * BM + wc * 32 + 8 * fq;
#pragma unroll
        for (int ai = 0; ai < 2; ++ai)
#pragma unroll
            for (int m = 0; m < 4; ++m) { float* rowp = O + (size_t)(row0 + ai * HALF + m * 16) * ldc + col0;
#pragma unroll
                for (int bj = 0; bj < 2; ++bj) { *(f32x4*)(rowp + bj * HALF) = acc[ai][bj][m][0]; *(f32x4*)(rowp + bj * HALF + 4) = acc[ai][bj][m][1]; } }
    }
};
struct EpiMerge {
    static constexpr bool PERM = true, AFTER_DRAIN = false, MIDK = true;
    const bf16_t* Gz; int gp; bf16_t* O; int ldc;
    __device__ __forceinline__ void scale(f32x4 (&acc)[2][2][4][2], const Unit& u, int idx, int wr, int wc, int fr, int fq) const {
        asm volatile("" : "+v"(fr), "+v"(fq));
        const int row0 = u.pm * BM + wr * 64 + fr; const int col0 = u.pn * BM + wc * 32 + 8 * fq;
        const int pa = (idx == 2) ? 2048 : (idx == 1) ? 2048 : 1024, pb = (idx == 1) ? 1024 : 0;
#pragma unroll
        for (int ai = 0; ai < 2; ++ai)
#pragma unroll
            for (int m = 0; m < 4; ++m) { const bf16_t* rowp = Gz + (size_t)(row0 + ai * HALF + m * 16) * gp + col0;
#pragma unroll
                for (int bj = 0; bj < 2; ++bj) { const u32x4 wa = *(const u32x4*)(rowp + pa + bj * HALF); u32x4 wb = wa; if (idx != 2) wb = *(const u32x4*)(rowp + pb + bj * HALF);
                    float s[8];
#pragma unroll
                    for (int i = 0; i < 4; ++i) { const float ea0 = __expf(-bflo(wa[i])), ea1 = __expf(-bfhi(wa[i]));
                        if (idx == 2) { s[2 * i] = __builtin_amdgcn_rcpf(1.f + ea0); s[2 * i + 1] = __builtin_amdgcn_rcpf(1.f + ea1); }
                        else { const float eb0 = __expf(-bflo(wb[i])), eb1 = __expf(-bfhi(wb[i])); s[2 * i] = (1.f + ea0) * __builtin_amdgcn_rcpf(1.f + eb0); s[2 * i + 1] = (1.f + ea1) * __builtin_amdgcn_rcpf(1.f + eb1); } }
                    acc[ai][bj][m][0] = acc[ai][bj][m][0] * (f32x4){s[0], s[1], s[2], s[3]}; acc[ai][bj][m][1] = acc[ai][bj][m][1] * (f32x4){s[4], s[5], s[6], s[7]}; }
                asm volatile("" ::: "memory"); }
    }
    __device__ __forceinline__ void mid(f32x4 (&acc)[2][2][4][2], const Unit& u, int idx, int wr, int wc, int fr, int fq) const { scale(acc, u, idx, wr, wc, fr, fq); }
    __device__ __forceinline__ void operator()(f32x4 (&acc)[2][2][4][2], const Unit& u, int wr, int wc, int fr, int fq) const {
        scale(acc, u, 2, wr, wc, fr, fq);
        asm volatile("" : "+v"(fr), "+v"(fq));
        const int row0 = u.pm * BM + wr * 64 + fr; const int col0 = u.pn * BM + wc * 32 + 8 * fq;
#pragma unroll
        for (int ai = 0; ai < 2; ++ai)
#pragma unroll
            for (int m = 0; m < 4; ++m) { bf16_t* rowp = O + (size_t)(row0 + ai * HALF + m * 16) * ldc + col0;
#pragma unroll
                for (int bj = 0; bj < 2; ++bj) { const f32x4 v0 = acc[ai][bj][m][0], v1 = acc[ai][bj][m][1];
                    u32x4 w; w.x = cvt_pk_bf16(v0[0], v0[1]); w.y = cvt_pk_bf16(v0[2], v0[3]); w.z = cvt_pk_bf16(v1[0], v1[1]); w.w = cvt_pk_bf16(v1[2], v1[3]);
                    *(u32x4*)(rowp + bj * HALF) = w; } }
    }
};
struct EpiSwiGLU {
    static constexpr bool PERM = true, AFTER_DRAIN = false, MIDK = false;
    bf16_t* O; const float* bias; int nN;
    __device__ __forceinline__ void operator()(const f32x4 (&acc)[2][2][4][2], const Unit& u, int wr, int wc, int fr, int fq) const {
        const int e = u.pn / nN, pl = u.pn - e * nN;
        asm volatile("" : "+v"(fr), "+v"(fq));
        const int row0 = u.pm * BM + wr * 64 + fr; const int colt = pl * BM + wc * 32 + 8 * fq;
        const float* bp = bias + (size_t)e * 2048 + colt;
        f32x4 bv[2][2];
#pragma unroll
        for (int bj = 0; bj < 2; ++bj) { bv[bj][0] = *(const f32x4*)(bp + bj * HALF); bv[bj][1] = *(const f32x4*)(bp + bj * HALF + 4); }
#pragma unroll
        for (int ai = 0; ai < 2; ++ai)
#pragma unroll
            for (int m = 0; m < 4; ++m) { unsigned char* rowp = (unsigned char*)O + (size_t)(row0 + ai * HALF + m * 16) * 1024 + (colt >> 1);
#pragma unroll
                for (int bj = 0; bj < 2; ++bj) { const f32x4 v0 = acc[ai][bj][m][0] + bv[bj][0], v1 = acc[ai][bj][m][1] + bv[bj][1];
                    float a[4];
                    const float gt[4] = {v0[0], v0[2], v1[0], v1[2]}, up[4] = {v0[1], v0[3], v1[1], v1[3]};
#pragma unroll
                    for (int i = 0; i < 4; ++i) { const float g = fminf(gt[i], 7.0f); const float uu = fminf(fmaxf(up[i], -7.0f), 7.0f);
                        a[i] = g * (1.0f / (1.0f + __expf(-1.702f * g))) * (uu + 1.0f); }
                    int w8 = __builtin_amdgcn_cvt_pk_fp8_f32(a[0], a[1], 0, false); w8 = __builtin_amdgcn_cvt_pk_fp8_f32(a[2], a[3], w8, true);
                    *(unsigned*)(rowp + bj * (HALF / 2)) = (unsigned)w8; } }
    }
};
struct EpiDown {
    static constexpr bool PERM = true, AFTER_DRAIN = false, MIDK = false;
    bf16_t* O; const float* bias; const float* gate; int nN;
    __device__ __forceinline__ void operator()(const f32x4 (&acc)[2][2][4][2], const Unit& u, int wr, int wc, int fr, int fq) const {
        const int e = u.pn / nN, pl = u.pn - e * nN;
        asm volatile("" : "+v"(fr), "+v"(fq));
        const int row0 = u.pm * BM + wr * 64 + fr; const int colt = pl * BM + wc * 32 + 8 * fq;
        const float* bp = bias + (size_t)e * 1024 + colt;
        f32x4 bv[2][2];
#pragma unroll
        for (int bj = 0; bj < 2; ++bj) { bv[bj][0] = *(const f32x4*)(bp + bj * HALF); bv[bj][1] = *(const f32x4*)(bp + bj * HALF + 4); }
#pragma unroll
        for (int ai = 0; ai < 2; ++ai)
#pragma unroll
            for (int m = 0; m < 4; ++m) { const int row = row0 + ai * HALF + m * 16; const float gs = gate[row]; bf16_t* rowp = O + (size_t)row * 1024 + colt;
#pragma unroll
                for (int bj = 0; bj < 2; ++bj) { const f32x4 v0 = (acc[ai][bj][m][0] + bv[bj][0]) * gs, v1 = (acc[ai][bj][m][1] + bv[bj][1]) * gs;
                    u32x4 w; w.x = cvt_pk_bf16(v0[0], v0[1]); w.y = cvt_pk_bf16(v0[2], v0[3]); w.z = cvt_pk_bf16(v1[0], v1[1]); w.w = cvt_pk_bf16(v1[2], v1[3]);
                    *(u32x4*)(rowp + bj * HALF) = w; } }
    }
};

template <class Epi, class Sched, bool ALIGN_EPI = false, bool SP2 = false, bool FP8 = false, int SCALE_B = 127>
__device__ __forceinline__ void gemm_phase(PG8_LAS unsigned char* lds, const Gemm g, const Sched& S, const Epi& E, int wv) {
    int tid_l = (int)__builtin_amdgcn_mbcnt_hi(~0u, __builtin_amdgcn_mbcnt_lo(~0u, 0u)); asm volatile("" : "+v"(tid_l)); tid_l += wv * 64;
    const int tid = tid_l, wid = __builtin_amdgcn_readfirstlane(tid >> 6), lane = tid & 63, wr = wid >> 2, wc = wid & 3, fr = lane & 15, fq = lane >> 4;
    const int K = g.K; const int KB = FP8 ? K : 2 * K;
    const int nt = KB / (2 * BK);
    unsigned voffA[2], voffB[2];
#pragma unroll
    for (int i = 0; i < 2; ++i) { int R, C; stage_rc(tid * 16 + i * 8192, R, C); const int Rb = Epi::PERM ? ((R & ~31) + perm32(R & 31)) : R;
        voffA[i] = (unsigned)(R * KB + 2 * C); voffB[i] = (unsigned)(Rb * KB + 2 * C); }
    unsigned voGc[2][2]; PG8_LAS unsigned* voGn_l = (PG8_LAS unsigned*)(lds + STAGE_BYTES + 1024) + tid;
#define PG8_GOFF(dst, pmv) do { if constexpr (Sched::GATHER) { _Pragma("unroll") for (int _h = 0; _h < 2; ++_h) _Pragma("unroll") for (int _i = 0; _i < 2; ++_i) { \
        const unsigned _R = voffA[_i] / (unsigned)KB, _cb = voffA[_i] % (unsigned)KB; dst[_h][_i] = (unsigned)S.tok[(pmv) * BM + _h * HALF + (int)_R] * (unsigned)KB + _cb; } } } while (0)
    const size_t kstep = (size_t)(BK * 2);
    const size_t hstep = (size_t)HALF * KB;
    const size_t tstep = 2 * hstep;
    const unsigned ldsw = (unsigned)wid * 1024u;
    const int aoff = lds_byte(wr * 64 + fr, FP8 ? fq * 16 : fq * 8), boff = lds_byte(wc * 32 + fr, FP8 ? fq * 16 : fq * 8);
    const int aoff1 = FP8 ? lds_byte(wr * 64 + fr, fq * 16 + 8) - aoff : 1024, boff1 = FP8 ? lds_byte(wc * 32 + fr, fq * 16 + 8) - boff : 1024;
#define PG8_SA(b, h) (((b) * 2 + (h)) * HTB)
#define PG8_SB(b, h) ((4 + (b) * 2 + (h)) * HTB)
#define PG8_STAGE(bufoff, gbase, voff) do { _Pragma("unroll") for (int _i = 0; _i < 2; ++_i) \
        __builtin_amdgcn_global_load_lds((const unsigned*)((const char*)(gbase) + (voff)[_i]), (PG8_LAS unsigned*)(lds + (bufoff) + ldsw + _i * 8192), 16, 0, 0); } while (0)
#define PG8_STAGE_A(bufoff, base, h, nx) do { if constexpr (Sched::GATHER) { unsigned _vo[2] = {voGc[h][0], voGc[h][1]}; if (nx) { _vo[0] = voGn_l[((h) * 2 + 0) * 512]; _vo[1] = voGn_l[((h) * 2 + 1) * 512]; } PG8_STAGE(bufoff, base, _vo); } else { PG8_STAGE(bufoff, (base) + (h) * hstep, voffA); } } while (0)
#define PG8_LD8(dst8, n_, base_, off_, off1_) do { _Pragma("unroll") for (int q_ = 0; q_ < n_; ++q_) { const v4i_ lo_ = *(const PG8_LAS v4i_*)(lds + (base_) + (off_) + q_ * 2048), hi_ = *(const PG8_LAS v4i_*)(lds + (base_) + (off_) + q_ * 2048 + (off1_)); \
        dst8[q_] = __builtin_shufflevector(lo_, hi_, 0, 1, 2, 3, 4, 5, 6, 7); } } while (0)
#define PG8_LDA(dst, b, h) do { if constexpr (FP8) { PG8_LD8(dst##8, 4, PG8_SA(b, h), aoff, aoff1); } else { _Pragma("unroll") for (int m = 0; m < 4; ++m) _Pragma("unroll") for (int k = 0; k < 2; ++k) dst[m][k] = *(const PG8_LAS bf16x8*)(lds + PG8_SA(b, h) + aoff + m * 2048 + k * aoff1); } } while (0)
#define PG8_LDB(dst, b, h) do { if constexpr (FP8) { PG8_LD8(dst##8, 2, PG8_SB(b, h), boff, boff1); } else { _Pragma("unroll") for (int n = 0; n < 2; ++n) _Pragma("unroll") for (int k = 0; k < 2; ++k) dst[n][k] = *(const PG8_LAS bf16x8*)(lds + PG8_SB(b, h) + boff + n * 2048 + k * boff1); } } while (0)
#define PG8_MMA(ai, bj, At, Bt) do { if constexpr (FP8) __builtin_amdgcn_sched_barrier(0); __builtin_amdgcn_s_setprio(1); _Pragma("unroll") for (int m = 0; m < 4; ++m) _Pragma("unroll") for (int n = 0; n < 2; ++n) { \
        if constexpr (FP8) { asm volatile("v_mfma_scale_f32_16x16x128_f8f6f4 %0, %1, %2, %0, %3, %4 op_sel_hi:[0,0,0]" : "+v"(acc[ai][bj][m][n]) : "v"(Bt##8[n]), "v"(At##8[m]), "v"(sclB), "v"(sclA)); } \
        else { _Pragma("unroll") for (int k = 0; k < 2; ++k) acc[ai][bj][m][n] = __builtin_amdgcn_mfma_f32_16x16x32_bf16(Bt[n][k], At[m][k], acc[ai][bj][m][n], 0, 0, 0); } } \
        __builtin_amdgcn_s_setprio(0); if constexpr (FP8) __builtin_amdgcn_sched_barrier(0); } while (0)
#define PG8_WAIT_V(n) asm volatile("s_waitcnt vmcnt(" #n ")" ::: "memory")
#define PG8_WAIT_L(n) asm volatile("s_waitcnt lgkmcnt(" #n ")" ::: "memory")
#define PG8_BAR __builtin_amdgcn_s_barrier()
#define PG8_SCHED __builtin_amdgcn_sched_barrier(0)
    Unit cur, nxt; int ui = 0;
    if (!S.next(0, cur)) return;
    f32x4 acc[2][2][4][2];
#pragma unroll
    for (int a = 0; a < 2; ++a)
#pragma unroll
        for (int b = 0; b < 2; ++b)
#pragma unroll
            for (int m = 0; m < 4; ++m)
#pragma unroll
                for (int n = 0; n < 2; ++n) acc[a][b][m][n] = (f32x4){0.f, 0.f, 0.f, 0.f};
    bf16x8 At[4][2], B0[2][2], B1[2][2];
    typedef int v8i_ __attribute__((ext_vector_type(8))); typedef int v4i_ __attribute__((ext_vector_type(4)));
    int sclB = SCALE_B * 0x01010101, sclA = 0x7f7f7f7f; asm volatile("" : "+v"(sclB), "+v"(sclA));
    v8i_ At8[4], B08[2], B18[2];
    const char* cA = (const char*)g.A + (Sched::GATHER ? (size_t)0 : (size_t)cur.pm * tstep); const char* cB = (const char*)g.Bt + (size_t)cur.pn * tstep;
    PG8_GOFF(voGc, cur.pm);
    S.a_ready(cur);
    if constexpr (SP2) {
        PG8_STAGE(PG8_SB(0, 0), cB, voffB); PG8_STAGE(PG8_SB(0, 1), cB + hstep, voffB); PG8_STAGE_A(PG8_SA(0, 0), cA, 0, false); PG8_STAGE_A(PG8_SA(0, 1), cA, 1, false);
        if (wr == 1) PG8_BAR;
        PG8_WAIT_V(2); PG8_BAR;
        PG8_STAGE(PG8_SB(1, 0), cB + kstep, voffB); PG8_STAGE_A(PG8_SA(1, 0), cA + kstep, 0, false); PG8_STAGE(PG8_SB(1, 1), cB + hstep + kstep, voffB);
        PG8_WAIT_V(6); PG8_BAR;
    } else {
        PG8_STAGE(PG8_SB(0, 0), cB, voffB); PG8_STAGE_A(PG8_SA(0, 0), cA, 0, false); PG8_STAGE(PG8_SB(0, 1), cB + hstep, voffB); PG8_STAGE_A(PG8_SA(0, 1), cA, 1, false);
        if (wr == 1) PG8_BAR;
        PG8_WAIT_V(4); PG8_BAR;
        PG8_STAGE(PG8_SB(1, 0), cB + kstep, voffB); PG8_STAGE_A(PG8_SA(1, 0), cA + kstep, 0, false); PG8_STAGE(PG8_SB(1, 1), cB + hstep + kstep, voffB);
        PG8_WAIT_V(6); PG8_BAR;
    }
    for (;;) {
        const bool has_next = S.next(ui + 1, nxt);
        const char* nA = has_next ? (const char*)g.A + (Sched::GATHER ? (size_t)0 : (size_t)nxt.pm * tstep) : cA;
        if constexpr (Sched::GATHER) { unsigned _vn[2][2]; if (has_next) { PG8_GOFF(_vn, nxt.pm); } else { _Pragma("unroll") for (int _h = 0; _h < 2; ++_h) _Pragma("unroll") for (int _i = 0; _i < 2; ++_i) _vn[_h][_i] = voGc[_h][_i]; }
            _Pragma("unroll") for (int _h = 0; _h < 2; ++_h) _Pragma("unroll") for (int _i = 0; _i < 2; ++_i) voGn_l[(_h * 2 + _i) * 512] = _vn[_h][_i]; } const char* nB = has_next ? (const char*)g.Bt + (size_t)nxt.pn * tstep : cB;
        for (int t = 0; t < nt; t += 2) {
            const bool last = (t == nt - 2);
            const char* a1 = cA + (size_t)(t + 1) * kstep;
            const char* a2 = last ? nA : cA + (size_t)(t + 2) * kstep; const char* b2 = last ? nB : cB + (size_t)(t + 2) * kstep;
            const char* a3 = a2 + kstep; const char* b3 = b2 + kstep;
            if (last && has_next) S.a_ready(nxt);
            if constexpr (SP2) {
            PG8_LDB(B0, 0, 0); PG8_LDB(B1, 0, 1); PG8_SCHED; PG8_LDA(At, 0, 0); PG8_STAGE_A(PG8_SA(1, 1), a1, 1, false);
            PG8_WAIT_V(8); PG8_WAIT_L(0); PG8_BAR; PG8_MMA(0, 0, At, B0); PG8_MMA(0, 1, At, B1); PG8_BAR; PG8_SCHED;
            PG8_LDA(At, 0, 1); PG8_STAGE(PG8_SB(0, 0), b2, voffB); PG8_STAGE(PG8_SB(0, 1), b2 + hstep, voffB); PG8_STAGE_A(PG8_SA(0, 0), a2, 0, last);
            PG8_WAIT_V(8); PG8_WAIT_L(0); PG8_BAR; PG8_MMA(1, 0, At, B0); PG8_MMA(1, 1, At, B1); PG8_BAR; PG8_SCHED;
            PG8_LDB(B0, 1, 0); PG8_LDB(B1, 1, 1); PG8_SCHED; PG8_LDA(At, 1, 0); PG8_STAGE_A(PG8_SA(0, 1), a2, 1, last);
            PG8_WAIT_V(8); PG8_WAIT_L(0); PG8_BAR; PG8_MMA(0, 0, At, B0); PG8_MMA(0, 1, At, B1); PG8_BAR; PG8_SCHED;
            PG8_LDA(At, 1, 1); PG8_STAGE(PG8_SB(1, 0), b3, voffB); PG8_STAGE(PG8_SB(1, 1), b3 + hstep, voffB); PG8_STAGE_A(PG8_SA(1, 0), a3, 0, last);
            PG8_WAIT_V(8); PG8_WAIT_L(0); PG8_BAR; PG8_MMA(1, 0, At, B0); PG8_MMA(1, 1, At, B1); PG8_BAR; PG8_SCHED;
            } else {
            PG8_LDB(B0, 0, 0); PG8_SCHED; PG8_LDA(At, 0, 0); PG8_STAGE_A(PG8_SA(1, 1), a1, 1, false);
            PG8_WAIT_L(8); PG8_BAR; PG8_WAIT_L(0); PG8_MMA(0, 0, At, B0); PG8_BAR; PG8_SCHED;
            PG8_LDB(B1, 0, 1); PG8_STAGE(PG8_SB(0, 0), b2, voffB);
            PG8_BAR; PG8_WAIT_L(0); PG8_MMA(0, 1, At, B1); PG8_BAR;
            PG8_LDA(At, 0, 1); PG8_STAGE_A(PG8_SA(0, 0), a2, 0, last);
            PG8_BAR; PG8_WAIT_L(0); PG8_MMA(1, 0, At, B0); PG8_BAR; PG8_SCHED;
            PG8_STAGE(PG8_SB(0, 1), b2 + hstep, voffB);
            PG8_WAIT_V(6); PG8_BAR; PG8_MMA(1, 1, At, B1); PG8_BAR;
            PG8_LDB(B0, 1, 0); PG8_SCHED; PG8_LDA(At, 1, 0); PG8_STAGE_A(PG8_SA(0, 1), a2, 1, last);
            PG8_WAIT_L(8); PG8_BAR; PG8_WAIT_L(0); PG8_MMA(0, 0, At, B0); PG8_BAR; PG8_SCHED;
            PG8_LDB(B1, 1, 1); PG8_STAGE(PG8_SB(1, 0), b3, voffB);
            PG8_BAR; PG8_WAIT_L(0); PG8_MMA(0, 1, At, B1); PG8_BAR;
            PG8_LDA(At, 1, 1); PG8_STAGE_A(PG8_SA(1, 0), a3, 0, last);
            PG8_BAR; PG8_WAIT_L(0); PG8_MMA(1, 0, At, B0); PG8_BAR; PG8_SCHED;
            PG8_STAGE(PG8_SB(1, 1), b3 + hstep, voffB);
            PG8_WAIT_V(6); PG8_BAR; PG8_MMA(1, 1, At, B1); PG8_BAR;
            }
            if constexpr (Epi::MIDK) { if (((t + 2) & 7) == 0 && t + 2 < nt) E.mid(acc, cur, ((t + 2) >> 3) - 1, wr, wc, fr, fq); }
        }
        if constexpr (FP8) asm volatile("s_nop 15\n\ts_nop 15" ::: "memory");
        if constexpr (ALIGN_EPI) { if (wr == 0) PG8_BAR; }
        if constexpr (!Epi::AFTER_DRAIN) { E(acc, cur, wr, wc, fr, fq); S.done(cur); }
        if (!has_next) break;
#pragma unroll
        for (int a = 0; a < 2; ++a)
#pragma unroll
            for (int b = 0; b < 2; ++b)
#pragma unroll
                for (int m = 0; m < 4; ++m)
#pragma unroll
                    for (int n = 0; n < 2; ++n) acc[a][b][m][n] = (f32x4){0.f, 0.f, 0.f, 0.f};
        cur = nxt; cA = nA; cB = nB; ++ui;
        if constexpr (Sched::GATHER) { _Pragma("unroll") for (int _h = 0; _h < 2; ++_h) _Pragma("unroll") for (int _i = 0; _i < 2; ++_i) voGc[_h][_i] = voGn_l[(_h * 2 + _i) * 512]; }
        if constexpr (ALIGN_EPI) { if (wr == 1) PG8_BAR; }
    }
    PG8_WAIT_V(0);
    if constexpr (!ALIGN_EPI) { if (wr == 0) PG8_BAR; }
    PG8_BAR;
#undef PG8_SA
#undef PG8_SB
#undef PG8_STAGE
#undef PG8_STAGE_A
#undef PG8_GOFF
#undef PG8_LDA
#undef PG8_LD8
#undef PG8_LDB
#undef PG8_MMA
#undef PG8_WAIT_V
#undef PG8_WAIT_L
#undef PG8_BAR
#undef PG8_SCHED
}
}
constexpr int BATCH = 4, SEQ = 8192, DM = 1024, NTOK = BATCH * SEQ, DEPTH = 2, NEXP = 32;
constexpr int D_IN = 8524, ZP = 8704;
constexpr int Z_AQ = 0, Z_AK = 512, Z_AV = 1024, Z_FQ = 1536, Z_FK = 2048, Z_FV = 2560, Z_CQ = 3072, Z_CF = 3584, Z_CI = 4096, Z_CG = 4608, Z_GT = 5120, Z_IQ = 8192, Z_IK = 8448, Z_IW = 8512, Z_FF = 8516;
constexpr int OP = 1536;
constexpr int MAXBLK = 544, MAXSLOT = MAXBLK * 256;
constexpr int BST_OFF = 16 + MAXBLK + 16;
constexpr float LOG2E = 1.4426950408889634f;
constexpr float QSCALE = 0.125f * LOG2E;
constexpr float ALPHA = 1.4142135623730951f;
constexpr float LN_EPS = 1e-5f, RMS_EPS = 1e-6f;
constexpr int NWAVES = 8, NTHR = 512;
constexpr float W8_SCALE = 64.0f; constexpr int W8_E8M0 = 127 - 6;
constexpr int NPH_LAYER = 14, NPHASES = 1 + DEPTH * NPH_LAYER;
enum { PH_INPROJ = 0, PH_PREP, PH_IDX, PH_ATTN, PH_H1, PH_H2, PH_H3, PH_MERGE, PH_WOUT, PH_LN1, PH_SLOT, PH_GU, PH_DOWN, PH_COMB };

__host__ __device__ __forceinline__ int zcol_src(int n) {
    if (n < 1024 || (n >= 8192 && n < 8512)) { const int p = n & 63; n = (n & ~63) + ((p & 1) ? 32 + (p >> 1) : (p >> 1)); }
    if (n < 1536) return n;
    if (n < 3072) return 1860 + (n - 1536);
    if (n < 5120) return 3404 + (n - 3072);
    if (n < 8192) return 5452 + (n - 5120);
    if (n < 8448) return 1536 + (n - 8192);
    if (n < 8512) return 1792 + (n - 8448);
    if (n < 8516) return 1856 + (n - 8512);
    if (n < 8524) return 3396 + (n - 8516);
    return -1;
}

constexpr size_t MiB = 1u << 20;
constexpr size_t WS_CTL = 0, CTL_ZERO_BYTES = 1 * MiB;
constexpr size_t WS_TRIG = 1 * MiB;
constexpr size_t WS_LFT = 3 * MiB;
constexpr size_t WS_CT = 4 * MiB;
constexpr size_t WS_DG = 5 * MiB, WS_D2G = 6 * MiB;
constexpr size_t WS_WGCNT = 7 * MiB;
constexpr size_t WS_BLK = 7 * MiB + 64 * 1024;
constexpr size_t WS_BGU = 7 * MiB + 128 * 1024;
constexpr size_t WS_TKE = 8 * MiB, WS_TKG = 8 * MiB + 512 * 1024, WS_TOKSLOT = 9 * MiB, WS_GSLOT = 9 * MiB + 512 * 1024;
constexpr size_t WS_SLOTTOK = 10 * MiB + 512 * 1024;
constexpr size_t WS_WRF = 11 * MiB;
constexpr size_t WS_WIN = 12 * MiB;
constexpr size_t WS_WP = 46 * MiB;
constexpr size_t WS_WOUT = 52 * MiB;
constexpr size_t WS_WGU = 56 * MiB;
constexpr size_t WS_WDN = 312 * MiB;
constexpr size_t WS_Z = 440 * MiB;
constexpr size_t WS_XG = WS_Z, WS_ACT = WS_Z + 272 * MiB;
constexpr size_t WS_OBUF = 984 * MiB;
constexpr size_t WS_MERGED = 1080 * MiB;
constexpr size_t WS_MIX = 1144 * MiB;
constexpr size_t WS_Y = WS_OBUF;
constexpr size_t WS_X1 = 1272 * MiB;
constexpr size_t WS_X1B = 1400 * MiB;
constexpr size_t WS_XCUR = 1464 * MiB;
constexpr size_t WS_XB = 1592 * MiB;
constexpr size_t WS_MASKW = 1656 * MiB;
constexpr size_t WS_UG = 1688 * MiB;
constexpr size_t WS_SST = 1752 * MiB;
constexpr size_t WS_SB = 7 * MiB + 768 * 1024;
constexpr size_t WS_KA = 1784 * MiB;
constexpr size_t WS_IKC = 184 * MiB;
constexpr size_t WS_END = 1792 * MiB;
static_assert(WS_Y + (size_t)MAXSLOT * 1024 * 2 <= WS_X1 && WS_ACT + (size_t)MAXSLOT * 1024 * 2 <= WS_OBUF, "ws map");
constexpr int CW_TMO = 0;
constexpr int CW_BAR = 4096;
constexpr int CW_SB = 512;

constexpr int SCR_BYTES = 153600;
constexpr int MISC_OFF = SCR_BYTES;
constexpr int LDS_BYTES = SCR_BYTES + 256;

#define RLX_AGENT __ATOMIC_RELAXED, __HIP_MEMORY_SCOPE_AGENT
#define LDS_WAIT() asm volatile("s_waitcnt lgkmcnt(0)" ::: "memory")
#define VM_WAIT() asm volatile("s_waitcnt vmcnt(0)" ::: "memory")
#define WG_BAR() asm volatile("s_waitcnt vmcnt(0) lgkmcnt(0)\n\ts_barrier" ::: "memory")
#define WG_BAR_LDS() asm volatile("s_waitcnt lgkmcnt(0)\n\ts_barrier" ::: "memory")

#define XB_TMO      128
#define XB_XCNT(j)  (256  + 64 * (j))
#define XB_XSUB(j)  (1280 + 64 * (j))
#define XB_XGEN(j)  (2304 + 64 * (j))
#define XB_TOP      3328
#define XB_TOPGEN   3392
#define XCD_BAR_WORDS 3456
#define XB_SPIN_CAP (1u << 18)

__device__ __forceinline__ unsigned xb_ld(unsigned* p)              { return __hip_atomic_load(p, __ATOMIC_RELAXED, __HIP_MEMORY_SCOPE_AGENT); }
__device__ __forceinline__ unsigned xb_add(unsigned* p, unsigned v) { return __hip_atomic_fetch_add(p, v, __ATOMIC_RELAXED, __HIP_MEMORY_SCOPE_AGENT); }
__device__ __forceinline__ unsigned xb_xcc_id() { return (unsigned)__builtin_amdgcn_s_getreg((3 << 11) | 20) & 0xFu; }
#define XB_SPIN(cond, bar) do { unsigned _sp = 0; while (cond) { __builtin_amdgcn_s_sleep(1); \
    if ((++_sp & 255u) == 0u) { if (xb_ld(&(bar)[XB_TMO])) break; if (_sp > XB_SPIN_CAP) { atomicAdd(&(bar)[XB_TMO], 1u); break; } } } } while (0)

struct XcdBarrier {
    unsigned* bar; unsigned x;
    volatile LAS unsigned* st;
};

__device__ __forceinline__ XcdBarrier xcd_barrier_post(unsigned* bar, volatile LAS unsigned* st) {
    XcdBarrier b; b.bar = bar; b.x = xb_xcc_id(); b.st = st;
    if (threadIdx.x == 0) (void)xb_add(&bar[XB_XCNT(b.x)], 1u);
    return b;
}
__device__ __forceinline__ void xcd_barrier_complete(unsigned* bar, unsigned x, unsigned& nloc, unsigned& nx) {
    const unsigned G = gridDim.x * gridDim.y * gridDim.z;
    unsigned sum, cnt, mine, sp = 0u;
    for (;;) {
        sum = 0u; cnt = 0u; mine = 0u;
#pragma unroll
        for (unsigned j = 0; j < 16; ++j) { const unsigned c = xb_ld(&bar[XB_XCNT(j)]); sum += c; cnt += (c > 0u) ? 1u : 0u; mine = (j == x) ? c : mine; }
        if (sum == G) break;
        __builtin_amdgcn_s_sleep(1);
        if ((++sp & 255u) == 0u) { if (xb_ld(&bar[XB_TMO])) break; if (sp > XB_SPIN_CAP) { atomicAdd(&bar[XB_TMO], 1u); break; } }
    }
    nloc = mine > 0u ? mine : 1u; nx = cnt > 0u ? cnt : 1u;
}

__device__ __forceinline__ void xcd_barrier(const XcdBarrier& b) {
    asm volatile("s_waitcnt vmcnt(0)" ::: "memory");
    __syncthreads();
    if (threadIdx.x == 0) {
        unsigned* bar = b.bar;
        __builtin_amdgcn_s_waitcnt(0);
        unsigned nloc = b.st[0], nx = b.st[1];
        if (nloc == 0u) { xcd_barrier_complete(bar, b.x, nloc, nx); b.st[0] = nloc; b.st[1] = nx; }
        const unsigned old = xb_add(&bar[XB_XSUB(b.x)], 1u);
        const unsigned gen = old / nloc;
        if (old + 1u == (gen + 1u) * nloc) {
            __builtin_amdgcn_fence(__ATOMIC_RELEASE, "agent");
            asm volatile("s_waitcnt vmcnt(0)" ::: "memory");
            const unsigned og = xb_add(&bar[XB_TOP], 1u);
            const unsigned tg = og / nx;
            if (og + 1u == (tg + 1u) * nx) xb_add(&bar[XB_TOPGEN], 1u);
            else XB_SPIN(xb_ld(&bar[XB_TOPGEN]) == tg, bar);
            __builtin_amdgcn_fence(__ATOMIC_ACQUIRE, "agent");
            xb_add(&bar[XB_XGEN(b.x)], 1u);
            asm volatile("s_waitcnt vmcnt(0)" ::: "memory");
        } else {
            XB_SPIN(xb_ld(&bar[XB_XGEN(b.x)]) == gen, bar);
            __builtin_amdgcn_fence(__ATOMIC_ACQUIRE, "agent");
            asm volatile("s_waitcnt vmcnt(0)" ::: "memory");
        }
    }
    __syncthreads();
}
__device__ __forceinline__ int lane_id() { int l = (int)__builtin_amdgcn_mbcnt_hi(~0u, __builtin_amdgcn_mbcnt_lo(~0u, 0u)); asm volatile("" : "+v"(l)); return l; }
__device__ __forceinline__ float wave_sum(float v) {
#pragma unroll
    for (int o = 1; o < 64; o <<= 1) v += __shfl_xor(v, o);
    return v;
}
__device__ __forceinline__ int crow(int r, int hi) { return (r & 3) + 8 * (r >> 2) + 4 * hi; }
__device__ __forceinline__ void glds16(const void* gsrc, unsigned lds_dst) { unsigned keep;
    asm volatile("s_mov_b32 %0, m0\n\ts_mov_b32 m0, %2\n\ts_nop 0\n\tglobal_load_lds_dwordx4 %1, off\n\ts_mov_b32 m0, %0" : "=&s"(keep) : "v"(gsrc), "s"(lds_dst) : "memory"); }
__device__ __forceinline__ void glds4(const void* gsrc, unsigned lds_dst) { unsigned keep;
    asm volatile("s_mov_b32 %0, m0\n\ts_mov_b32 m0, %2\n\ts_nop 0\n\tglobal_load_lds_dword %1, off\n\ts_mov_b32 m0, %0" : "=&s"(keep) : "v"(gsrc), "s"(lds_dst) : "memory"); }
typedef __bf16 bf16x2_t __attribute__((ext_vector_type(2)));
__device__ __forceinline__ unsigned cvtpk(float lo, float hi) { const f32x2 v = {lo, hi}; const bf16x2_t b = __builtin_convertvector(v, bf16x2_t); return __builtin_bit_cast(unsigned, b); }
typedef short v4i16_t __attribute__((ext_vector_type(4)));
__device__ __forceinline__ s16x4 vtr(const LAS char* p) { return __builtin_bit_cast(s16x4, __builtin_amdgcn_ds_read_tr16_b64_v4i16((LAS v4i16_t*)p)); }
__device__ __forceinline__ void plswap(float& a, float& b) { asm volatile("s_nop 1\n\tv_permlane32_swap_b32 %0, %1\n\ts_nop 1" : "+v"(a), "+v"(b)); }
__device__ __forceinline__ float swapmax(float m) { float a = m, b = m; plswap(a, b); return fmaxf(a, b); }
__device__ __forceinline__ float swapsum(float m) { float a = m, b = m; plswap(a, b); return a + b; }
#define MFMA32(a, b, c) __builtin_amdgcn_mfma_f32_32x32x16_bf16((a), (b), (c), 0, 0, 0)

struct Params {
    const float* x; const float* w_in; const float* b_fox; const float* lb_logits; const float* norm_g; const float* w_pa; const float* w_pb; const float* w_pc; const float* w_out;
    const float* ln1_g; const float* ln1_b; const float* w_router; const float* b_router; const float* w_gu; const float* b_gu; const float* w_down; const float* b_down; const float* ln2_g; const float* ln2_b;
    float* out; unsigned char* ws; int ph_lo, ph_hi, use_bar, pad;
};

typedef const __attribute__((address_space(4))) Params* KP;
__device__ __forceinline__ KP load_params() { KP kp = (KP)__builtin_amdgcn_kernarg_segment_ptr(); asm volatile("" : "+s"(kp)); return kp; }

template <class F> __device__ __forceinline__ void cvt_tile(const float* W, size_t ldsrc, int k0, bf16* WT, size_t ldw, int kd0, int n0, const F& f, LAS float* scr, int lane) {
    const int c = lane & 31; int sc; float scale; f(n0 + c, sc, scale);
#pragma unroll 8
    for (int i = 0; i < 32; ++i) { const int kk = 2 * i + (lane >> 5); scr[kk * 33 + c] = sc >= 0 ? W[(size_t)(k0 + kk) * ldsrc + sc] * scale : 0.f; }
    LDS_WAIT(); asm volatile("" ::: "memory");
    const int ch = lane & 7;
#pragma unroll
    for (int j = 0; j < 4; ++j) { const int n = (lane >> 3) + 8 * j; const LAS float* s = scr + (8 * ch) * 33 + n;
        u32x4 o; o.x = pk2(s[0 * 33], s[1 * 33]); o.y = pk2(s[2 * 33], s[3 * 33]); o.z = pk2(s[4 * 33], s[5 * 33]); o.w = pk2(s[6 * 33], s[7 * 33]);
        *(u32x4*)(WT + (size_t)(n0 + n) * ldw + kd0 + 8 * ch) = o; }
    LDS_WAIT(); asm volatile("" ::: "memory");
}
template <class F> __device__ __forceinline__ void cvt_tile8(const float* W, size_t ldsrc, int k0, unsigned char* WT, size_t ldw, int n0, const F& f, float wscale, LAS float* scr, int lane) {
    const int c = lane & 31; int sc; float scale; f(n0 + c, sc, scale); scale *= wscale;
#pragma unroll 8
    for (int i = 0; i < 32; ++i) { const int kk = 2 * i + (lane >> 5); scr[kk * 33 + c] = sc >= 0 ? W[(size_t)(k0 + kk) * ldsrc + sc] * scale : 0.f; }
    LDS_WAIT(); asm volatile("" ::: "memory");
    const int ch = lane & 7;
#pragma unroll
    for (int j = 0; j < 4; ++j) { const int n = (lane >> 3) + 8 * j; const LAS float* s = scr + (8 * ch) * 33 + n;
        int w0 = __builtin_amdgcn_cvt_pk_fp8_f32(s[0 * 33], s[1 * 33], 0, false); w0 = __builtin_amdgcn_cvt_pk_fp8_f32(s[2 * 33], s[3 * 33], w0, true);
        int w1 = __builtin_amdgcn_cvt_pk_fp8_f32(s[4 * 33], s[5 * 33], 0, false); w1 = __builtin_amdgcn_cvt_pk_fp8_f32(s[6 * 33], s[7 * 33], w1, true);
        *(u32x2*)(WT + (size_t)(n0 + n) * ldw + k0 + 8 * ch) = (u32x2){(unsigned)w0, (unsigned)w1}; }
    LDS_WAIT(); asm volatile("" ::: "memory");
}
struct MapIn { __device__ __forceinline__ void operator()(int n, int& sc, float& s) const { sc = zcol_src(n); s = (n < 512 || (n >= Z_FQ && n < Z_FK)) ? QSCALE : 1.0f; } };
struct MapGu { __device__ __forceinline__ void operator()(int n, int& sc, float& s) const { sc = (n & 1) ? 1024 + (n >> 1) : (n >> 1); s = 1.0f; } };
struct MapId { __device__ __forceinline__ void operator()(int n, int& sc, float& s) const { sc = n; s = 1.0f; } };

__device__ __forceinline__ void p0_prologue(KP p, LAS unsigned char* lds, int gw, int NGW, int wave, int lane) {
    LAS float* scr = (LAS float*)(lds + wave * 16384);
    unsigned char* ws = p->ws;
    constexpr int I_IN = 16 * 272, I_GU = 32 * 16 * 64, I_DN = 32 * 16 * 32, I_P = 3 * 8 * 32, I_OUT = 16 * 32, I_LAYER = I_IN + I_GU + I_DN + I_P + I_OUT;
    for (int it = gw; it < DEPTH * I_LAYER; it += NGW) {
        const int l = it / I_LAYER; int r = it - l * I_LAYER;
        if (r < I_IN) { const int kb = r / 272, nb = r % 272;
            cvt_tile(p->w_in + (size_t)l * 1024 * D_IN, D_IN, 64 * kb, (bf16*)(ws + WS_WIN) + (size_t)l * ZP * 1024, 1024, 64 * kb, 32 * nb, MapIn{}, scr, lane); continue; } r -= I_IN;
        if (r < I_GU) { const int e = r >> 10, r2 = r & 1023, kb = r2 >> 6, nb = r2 & 63;
            cvt_tile8(p->w_gu + (size_t)(l * 32 + e) * 1024 * 2048, 2048, 64 * kb, (unsigned char*)(ws + WS_WGU) + (size_t)(l * 32 + e) * 2048 * 1024, 1024, 32 * nb, MapGu{}, W8_SCALE, scr, lane); continue; } r -= I_GU;
        if (r < I_DN) { const int e = r >> 9, r2 = r & 511, kb = r2 >> 5, nb = r2 & 31;
            cvt_tile8(p->w_down + (size_t)(l * 32 + e) * 1024 * 1024, 1024, 64 * kb, (unsigned char*)(ws + WS_WDN) + (size_t)(l * 32 + e) * 1024 * 1024, 1024, 32 * nb, MapId{}, W8_SCALE, scr, lane); continue; } r -= I_DN;
        if (r < I_P) { const int br = r >> 8, r2 = r & 255, kb = r2 >> 5, nb = r2 & 31; const float* W = (br == 0 ? p->w_pa : br == 1 ? p->w_pb : p->w_pc) + (size_t)l * 512 * 1024;
            cvt_tile(W, 1024, 64 * kb, (bf16*)(ws + WS_WP) + (size_t)l * 1024 * 1536, 1536, br * 512 + 64 * kb, 32 * nb, MapId{}, scr, lane); continue; } r -= I_P;
        { const int kb = r >> 5, nb = r & 31;
            cvt_tile(p->w_out + (size_t)l * 1024 * 1024, 1024, 64 * kb, (bf16*)(ws + WS_WOUT) + (size_t)l * 1024 * 1024, 1024, 64 * kb, 32 * nb, MapId{}, scr, lane); }
    }
    { float* bg = (float*)(ws + WS_BGU);
      for (int i = gw * 64 + lane; i < DEPTH * 32 * 2048; i += NGW * 64) { const int n = i & 2047, le = i >> 11; bg[i] = p->b_gu[(size_t)le * 2048 + ((n & 1) ? 1024 + (n >> 1) : (n >> 1))]; } }
    { bf16* wf = (bf16*)(ws + WS_WRF);
      for (int i = gw * 64 + lane; i < DEPTH * 32 * 2 * 64 * 8; i += NGW * 64) { const int ii = i & 7, ln = (i >> 3) & 63, nt = (i >> 9) & 1, s = (i >> 10) & 31, l = i >> 15;
          const int k = 32 * s + 8 * (ln >> 4) + ii, e = 16 * nt + (ln & 15); const float w = p->w_router[((size_t)l * 1024 + k) * 32 + e];
          const unsigned hb = f2bf(w); const float lo = w - bf2f(hb);
          const size_t base = ((((size_t)l * 32 + s) * 2 + nt) * 2) * 512 + ln * 8 + ii; wf[base] = (bf16)hb; wf[base + 512] = (bf16)f2bf(lo); } }
    { f32x2* tg = (f32x2*)(ws + WS_TRIG);
      for (int i = gw * 64 + lane; i < SEQ * 32; i += NGW * 64) { const int pos = i >> 5, k = i & 31;
          const float inv = exp2f(-(float)k * (13.287712379549449f / 32.0f)); const float ang = (float)pos * inv;
          const double rev = (double)ang * 0.15915494309189535; const float fr = (float)(rev - __builtin_rint(rev));
          tg[i] = (f32x2){__builtin_amdgcn_cosf(fr), __builtin_amdgcn_sinf(fr)}; } }
    { bf16* xb = (bf16*)(ws + WS_XB);
      for (int m = gw; m < NTOK; m += NGW) { const f32x4* xr = (const f32x4*)(p->x + (size_t)m * DM) + lane; u32x2* o = (u32x2*)(xb + (size_t)m * DM) + lane;
#pragma unroll
          for (int j = 0; j < 4; ++j) { const f32x4 v = xr[64 * j]; o[64 * j] = (u32x2){pk2(v.x, v.y), pk2(v.z, v.w)}; } } }
}

__device__ __forceinline__ void prep_phase(KP p, int l, int gw, int NGW, int lane) {
    unsigned char* ws = p->ws; bf16* Z = (bf16*)(ws + WS_Z); const f32x2* tg = (const f32x2*)(ws + WS_TRIG); float* lfT = (float*)(ws + WS_LFT);
    const float bf_l = (lane < 8) ? p->b_fox[l * 8 + lane] : 0.f;
    for (int m = gw; m < NTOK; m += NGW) {
        bf16* zr = Z + (size_t)m * ZP; const int pos = m & (SEQ - 1), b = m >> 13;
        const f32x2 cs = tg[pos * 32 + (lane & 31)];
        unsigned short ta[11], tb[11];
#pragma unroll
        for (int it = 0; it < 11; ++it) { const int hh = 2 * it + (lane >> 5); const int hc = hh < 21 ? hh : 20;
            const int col = hc < 8 ? Z_AQ + hc * 64 : hc < 16 ? Z_AK + (hc - 8) * 64 : hc < 20 ? Z_IQ + (hc - 16) * 64 : Z_IK;
            const bf16* q = zr + col + (lane & 31); ta[it] = q[0]; tb[it] = q[32]; }
#pragma unroll
        for (int it = 0; it < 11; ++it) { const int hh = 2 * it + (lane >> 5);
            if (hh < 21) { const int col = hh < 8 ? Z_AQ + hh * 64 : hh < 16 ? Z_AK + (hh - 8) * 64 : hh < 20 ? Z_IQ + (hh - 16) * 64 : Z_IK;
                bf16* q = zr + col + (lane & 31); const float t1 = bf2f(ta[it]), t2 = bf2f(tb[it]);
                q[0] = (bf16)f2bf(t1 * cs.x - t2 * cs.y); q[32] = (bf16)f2bf(t2 * cs.x + t1 * cs.y); } }
#pragma unroll
        for (int j = 0; j < 2; ++j) { bf16* g0p = zr + Z_GT + lane * 8 + j * 512; const u32x4 a = *(const u32x4*)g0p, bb = *(const u32x4*)(g0p + 1024), cc = *(const u32x4*)(g0p + 2048);
            u32x4 o0, o1, o2;
#pragma unroll
            for (int i = 0; i < 4; ++i) {
                const float e0l = __expf(-bflo(a[i])), e0h = __expf(-bfhi(a[i])), e1l = __expf(-bflo(bb[i])), e1h = __expf(-bfhi(bb[i])), e2l = __expf(-bflo(cc[i])), e2h = __expf(-bfhi(cc[i]));
                o0[i] = pk2((1.f + e1l) / (1.f + e0l), (1.f + e1h) / (1.f + e0h));
                o1[i] = pk2((1.f + e2l) / (1.f + e1l), (1.f + e2h) / (1.f + e1h));
                o2[i] = pk2(1.f / (1.f + e2l), 1.f / (1.f + e2h)); }
            *(u32x4*)g0p = o0; *(u32x4*)(g0p + 1024) = o1; *(u32x4*)(g0p + 2048) = o2; }
        if (lane < 8) { const float v = bf2f(zr[Z_FF + lane]) + bf_l; const float ls = fminf(v, 0.f) - __logf(1.0f + __expf(-fabsf(v))); lfT[(size_t)(b * 8 + lane) * SEQ + pos] = ls * LOG2E; }
    }
}

constexpr int IX_CAP = 1024, IX_STRIDE = IX_CAP + 1  , IX_TRIG = 768, IX_CAND = 0, IX_BM = 0  , IX_HIST = 32 * IX_STRIDE * 4, IX_CNT = IX_HIST + 8 * 1024, IX_TAU = IX_CNT + 128, IX_FLAG = IX_TAU + 128, IX_END = IX_FLAG + 64;
static_assert(IX_END <= SCR_BYTES, "indexer LDS");

__device__ __forceinline__ int wave_incl_sum(int v) {
    v += __builtin_amdgcn_update_dpp(0, v, 0x111, 0xf, 0xf, false);
    v += __builtin_amdgcn_update_dpp(0, v, 0x112, 0xf, 0xf, false);
    v += __builtin_amdgcn_update_dpp(0, v, 0x114, 0xf, 0xf, false);
    v += __builtin_amdgcn_update_dpp(0, v, 0x118, 0xf, 0xf, false);
    v += __builtin_amdgcn_update_dpp(0, v, 0x142, 0xa, 0xf, false);
    v += __builtin_amdgcn_update_dpp(0, v, 0x143, 0xc, 0xf, false);
    return v;
}
__device__ __forceinline__ unsigned wave_or63(unsigned v) {
    v |= (unsigned)__builtin_amdgcn_update_dpp(0, (int)v, 0x111, 0xf, 0xf, false);
    v |= (unsigned)__builtin_amdgcn_update_dpp(0, (int)v, 0x112, 0xf, 0xf, false);
    v |= (unsigned)__builtin_amdgcn_update_dpp(0, (int)v, 0x114, 0xf, 0xf, false);
    v |= (unsigned)__builtin_amdgcn_update_dpp(0, (int)v, 0x118, 0xf, 0xf, false);
    v |= (unsigned)__builtin_amdgcn_update_dpp(0, (int)v, 0x142, 0xa, 0xf, false);
    v |= (unsigned)__builtin_amdgcn_update_dpp(0, (int)v, 0x143, 0xc, 0xf, false);
    return v;
}
__device__ __forceinline__ int count_ge8(const unsigned (&x)[16], int k0, unsigned t) {
    u64 m0, m1, m2, m3, m4, m5, m6, m7;
    asm("v_cmp_ge_u32_e64 %0, %8, %16\n\tv_cmp_ge_u32_e64 %1, %9, %16\n\tv_cmp_ge_u32_e64 %2, %10, %16\n\tv_cmp_ge_u32_e64 %3, %11, %16\n\t"
        "v_cmp_ge_u32_e64 %4, %12, %16\n\tv_cmp_ge_u32_e64 %5, %13, %16\n\tv_cmp_ge_u32_e64 %6, %14, %16\n\tv_cmp_ge_u32_e64 %7, %15, %16"
        : "=&s"(m0), "=&s"(m1), "=&s"(m2), "=&s"(m3), "=&s"(m4), "=&s"(m5), "=&s"(m6), "=&s"(m7)
        : "v"(x[k0]), "v"(x[k0 + 1]), "v"(x[k0 + 2]), "v"(x[k0 + 3]), "v"(x[k0 + 4]), "v"(x[k0 + 5]), "v"(x[k0 + 6]), "v"(x[k0 + 7]), "v"(t));
    return (int)(__popcll(m0) + __popcll(m1) + __popcll(m2) + __popcll(m3) + __popcll(m4) + __popcll(m5) + __popcll(m6) + __popcll(m7));
}
template <bool EXACT>
__device__ __forceinline__ unsigned wave_search256(const unsigned (&x)[16]) {
    const unsigned xr = (unsigned)__builtin_amdgcn_readfirstlane((int)x[0]); unsigned df = 0u;
#pragma unroll
    for (int k = 0; k < 16; ++k) df |= (x[k] != 0u) ? (x[k] ^ xr) : 0u;
    df = (unsigned)__builtin_amdgcn_readlane((int)wave_or63(df), 63);
    const int hb = 31 - (int)__builtin_clz(df | 1u);
    unsigned prefix = xr & ~((2u << hb) - 1u);
#pragma unroll 1
    for (int bit = hb; bit >= 0; --bit) { const unsigned trial = prefix | (1u << bit); const int c = count_ge8(x, 0, trial) + count_ge8(x, 8, trial);
        if (c >= 256) { prefix = trial; if (EXACT ? (c == 256) : (c <= 384)) break; } }
    return prefix;
}
__device__ __forceinline__ unsigned wave_compact(LAS unsigned* cand, int n, int lane, int& kept) {
    unsigned x[16];
#pragma unroll
    for (int k = 0; k < 16; ++k) { const int i = lane + 64 * k; x[k] = (i < n) ? cand[i] : 0u; }
    const unsigned prefix = wave_search256<false>(x);
    int base = 0;
#pragma unroll
    for (int k = 0; k < 16; ++k) { const bool keep = x[k] >= prefix; const u64 mk = __ballot(keep);
        if (keep) cand[__builtin_amdgcn_mbcnt_hi((unsigned)(mk >> 32), __builtin_amdgcn_mbcnt_lo((unsigned)mk, (unsigned)base))] = x[k]; base += __popcll(mk); }
    kept = base;
    return prefix;
}

__device__ __forceinline__ void idx_phase(KP p, int l, LAS unsigned char* lds, int vcu, int G, int tid, int wave, int lane) {
    unsigned char* ws = p->ws; const bf16* Z = (const bf16*)(ws + WS_Z);
    { unsigned* sbr = (unsigned*)(ws + WS_CTL) + CW_SB + l * 64; LAS float* wt = (LAS float*)lds;
      for (int task = blockIdx.x; task < 256; task += G) { const int bh = task >> 3, part = task & 7; float qm = 0.f, km = 0.f;
          const bf16* zr = Z + (size_t)((bh >> 3) * SEQ + part * 1024 + tid * 2) * ZP + (bh & 7) * 64;
#pragma unroll
          for (int i = 0; i < 2; ++i) { float qs = 0.f, ks = 0.f;
#pragma unroll
              for (int c8 = 0; c8 < 8; ++c8) { const u32x4 a = *(const u32x4*)(zr + (size_t)i * ZP + Z_FQ + c8 * 8), kq = *(const u32x4*)(zr + (size_t)i * ZP + Z_FK + c8 * 8);
#pragma unroll
                  for (int w4 = 0; w4 < 4; ++w4) { qs += bflo(a[w4]) * bflo(a[w4]) + bfhi(a[w4]) * bfhi(a[w4]); ks += bflo(kq[w4]) * bflo(kq[w4]) + bfhi(kq[w4]) * bfhi(kq[w4]); } }
              qm = fmaxf(qm, qs); km = fmaxf(km, ks); }
#pragma unroll
          for (int o = 1; o < 64; o <<= 1) { qm = fmaxf(qm, __shfl_xor(qm, o)); km = fmaxf(km, __shfl_xor(km, o)); }
          if (lane == 0) { __hip_atomic_fetch_max(sbr + 2 * bh, __builtin_bit_cast(unsigned, qm), __ATOMIC_RELAXED, __HIP_MEMORY_SCOPE_AGENT); __hip_atomic_fetch_max(sbr + 2 * bh + 1, __builtin_bit_cast(unsigned, km), __ATOMIC_RELAXED, __HIP_MEMORY_SCOPE_AGENT); } }
      (void)wt; }
    for (int bh = blockIdx.x; bh < 32; bh += G) {
        float* dst = (float*)(ws + WS_CT) + (size_t)bh * SEQ;
        LAS float* wt = (LAS float*)lds;
        const float bfx = p->b_fox[l * 8 + (bh & 7)]; const bf16* zf = Z + (size_t)((bh >> 3) * SEQ + tid * 16) * ZP + Z_FF + (bh & 7);
        f32x4 v[4]; float run = 0.f;
#pragma unroll
        for (int j = 0; j < 4; ++j) {
#pragma unroll
            for (int i = 0; i < 4; ++i) { const float t = bf2f(zf[(size_t)(4 * j + i) * ZP]) + bfx; v[j][i] = (fminf(t, 0.f) - __logf(1.0f + __expf(-fabsf(t)))) * LOG2E; }
            v[j].x += run; v[j].y += v[j].x; v[j].z += v[j].y; v[j].w += v[j].z; run = v[j].w; }
        float inc = run;
#pragma unroll
        for (int o = 1; o < 64; o <<= 1) { const float t = __shfl_up(inc, o); if (lane >= o) inc += t; }
        if (lane == 63) wt[wave] = inc;
        WG_BAR();
        float off = inc - run;
        for (int w = 0; w < wave; ++w) off += wt[w];
        { u32x4* ka = (u32x4*)((bf16*)(ws + WS_KA) + ((size_t)bh * SEQ + tid * 16) * 16);
#pragma unroll
          for (int j = 0; j < 4; ++j) { const f32x4 c4 = v[j] + off; *(f32x4*)(dst + tid * 16 + 4 * j) = c4;
#pragma unroll
              for (int i = 0; i < 4; ++i) { const float c = c4[i]; const unsigned h1 = f2bf(c); const float r1 = c - bf2f(h1); const unsigned h2 = f2bf(r1); const unsigned h3 = f2bf(r1 - bf2f(h2));
                  unsigned z0 = 0u; asm volatile("" : "+v"(z0));
                  ka[(4 * j + i) * 2] = (u32x4){h1 | (h2 << 16), h3 | 0x3f800000u, z0, z0}; ka[(4 * j + i) * 2 + 1] = (u32x4){z0, z0, z0, z0}; } } }
        WG_BAR();
    }
    LAS unsigned* cand = (LAS unsigned*)(lds + IX_CAND); LAS unsigned* BM = (LAS unsigned*)(lds + IX_BM);
    LAS unsigned* cnt = (LAS unsigned*)(lds + IX_CNT); LAS unsigned* tau = (LAS unsigned*)(lds + IX_TAU); LAS unsigned* hist = (LAS unsigned*)(lds + IX_HIST); LAS unsigned* flg = (LAS unsigned*)(lds + IX_FLAG);
    u64* MW = (u64*)(ws + WS_MASKW);
    const int r32 = lane & 31, hi = lane >> 5;
    for (int U = vcu; U < 1024; U += G) {
        const int v = U & 255, i4 = U >> 8; const int b = v & 3, a = v >> 2;
        const int hc = (i4 == 0) ? a : (i4 == 1) ? 255 - a : (i4 == 2) ? 64 + a : 191 - a;
        const int qbase = b * SEQ + hc * 32; const int nadm = ((hc >> 1) + 1) * 64;
        if (nadm <= 256) {
            const int nw = nadm >> 6;
            for (int i = tid; i < 32 * 128; i += NTHR) { const int q = i >> 7, w = i & 127; unsigned on = (w < nw) ? 0xffffffffu : 0u; asm volatile("" : "+v"(on));
                MW[(size_t)(qbase + q) * 128 + w] = (u64)on | ((u64)on << 32); }
            continue;
        }
        const bf16* qrow = Z + (size_t)(qbase + r32) * ZP;
        bf16x8 iqf[4][4];
#pragma unroll
        for (int hd = 0; hd < 4; ++hd)
#pragma unroll
            for (int j = 0; j < 4; ++j) iqf[hd][j] = *(const bf16x8*)(qrow + Z_IQ + hd * 64 + j * 16 + hi * 8);
        float wq[4];
#pragma unroll
        for (int hd = 0; hd < 4; ++hd) wq[hd] = bf2f(qrow[Z_IW + hd]) * (0.5f * 0.125f);
        if (tid < 32) { cnt[tid] = 0u; tau[tid] = 0u; } if (tid < 3) flg[tid] = 0u;
        const int ntiles = nadm >> 5, nrounds = (ntiles + 7) >> 3;
        const bf16* kbase = (const bf16*)(ws + WS_IKC) + (size_t)(b * SEQ) * 64 + hi * 8;
        bf16x8 kf[4], kn[4];
#pragma unroll
        for (int j = 0; j < 4; ++j) kn[j] = *(const bf16x8*)(kbase + (size_t)((wave < ntiles ? wave : 0) * 32 + r32) * 64 + j * 16);
        WG_BAR();
        for (int rd = 0; rd < nrounds; ++rd) {
            const int tile = rd * 8 + wave;
#pragma unroll
            for (int j = 0; j < 4; ++j) kf[j] = kn[j];
            { const int tn = (tile + 8 < ntiles) ? tile + 8 : tile;
#pragma unroll
              for (int j = 0; j < 4; ++j) kn[j] = *(const bf16x8*)(kbase + (size_t)((tn < ntiles ? tn : 0) * 32 + r32) * 64 + j * 16); }
            if (tile < ntiles) {
                f32x16 sc = {};
#pragma unroll
                for (int hd = 0; hd < 4; ++hd) { f32x16 pp = {};
#pragma unroll
                    for (int j = 0; j < 4; ++j) pp = MFMA32(kf[j], iqf[hd][j], pp);
#pragma unroll
                    for (int r = 0; r < 16; ++r) { const float pv = pp[r]; const int pb = __builtin_bit_cast(int, pv); const int pr = pb > 0 ? pb : 0;
                        sc[r] = __builtin_fmaf(wq[hd], __builtin_bit_cast(float, pr), sc[r]); } }
                const unsigned tq = tau[r32];
                typedef unsigned u32x16_t __attribute__((ext_vector_type(16))); u32x16_t comp; unsigned npass = 0u;
#pragma unroll
                for (int r = 0; r < 16; ++r) { const int key = tile * 32 + crow(r, hi);
                    unsigned u = __builtin_bit_cast(unsigned, sc[r] + 0.0f); u ^= (u >> 31) ? 0xffffffffu : 0x80000000u;
                    comp[r] = (u & 0xffffe000u) | (unsigned)(8191 - key); npass += (comp[r] > tq) ? 1u : 0u; }
                unsigned pos = 0u;
                if (npass) pos = __hip_atomic_fetch_add(cnt + r32, npass, __ATOMIC_RELAXED, __HIP_MEMORY_SCOPE_WORKGROUP);
                LAS unsigned* cq_ = cand + r32 * IX_STRIDE;
#pragma unroll
                for (int r = 0; r < 16; ++r) if (comp[r] > tq) { cq_[pos] = comp[r]; ++pos; }
                if (npass && pos > (unsigned)IX_TRIG) flg[rd % 3] = 1u;
            }
            WG_BAR_LDS();
            const bool need_any = flg[rd % 3] != 0u;
            if (tid == 0) flg[(rd + 2) % 3] = 0u;
            if (need_any) {
#pragma unroll 1
                for (int i = 0; i < 4; ++i) { const int qq = wave * 4 + i; const int n = __builtin_amdgcn_readfirstlane((int)cnt[qq]);
                    if (n > 256) { int kept; const unsigned th = wave_compact(cand + qq * IX_STRIDE, n, lane, kept); if (lane == 0) { cnt[qq] = (unsigned)kept; tau[qq] = th ? th - 1u : 0u; } } }
                WG_BAR_LDS();
            }
        }
#pragma unroll 1
        for (int i = 0; i < 4; ++i) { const int qq = wave * 4 + i; const int n = __builtin_amdgcn_readfirstlane((int)cnt[qq]);
            LAS unsigned* cq = cand + qq * IX_STRIDE; unsigned x[16];
#pragma unroll
            for (int k = 0; k < 16; ++k) { const int ii = lane + 64 * k; x[k] = (ii < n) ? cq[ii] : 0u; }
            unsigned th = 1u; if (n > 256) th = wave_search256<true>(x);
            asm volatile("" ::: "memory");
#pragma unroll
            for (int k = 0; k < 4; ++k) { unsigned z0 = 0u; asm volatile("" : "+v"(z0)); cq[lane + 64 * k] = z0; }
#pragma unroll
            for (int k = 0; k < 16; ++k) if (x[k] >= th) { const int key = 8191 - (int)(x[k] & 8191u);
                (void)__hip_atomic_fetch_or(cq + (key >> 5), 1u << (key & 31), __ATOMIC_RELAXED, __HIP_MEMORY_SCOPE_WORKGROUP); }
            LDS_WAIT(); asm volatile("" ::: "memory");
            const unsigned w0 = cq[4 * lane], w1 = cq[4 * lane + 1], w2 = cq[4 * lane + 2], w3 = cq[4 * lane + 3];
            *(u32x4*)(MW + (size_t)(qbase + qq) * 128 + 2 * lane) = (u32x4){w0, w1, w2, w3};
            asm volatile("" ::: "memory"); }
        WG_BAR();
    }
}

constexpr int AT_K = 0, AT_V = 2 * 8192, AT_WS = 4 * 8192, AT_OST = AT_WS + 4096, AT_MW = AT_OST + 8 * 4096, AT_KA = AT_MW + 2 * 8 * 512, AT_END = AT_KA + 2 * 2048;
static_assert(AT_END <= SCR_BYTES, "attention LDS");
#ifndef DBG_ATT_L
#define DBG_ATT_L 0
#endif

template <int MODE>
__device__ __forceinline__ void attn_unit(int b, int h, int qb, const bf16* Z, bf16* Ob, const float* cT, const u64* MW, const void* KA, const void* SBp, LAS char* shm, int wv) {
    int tid_l = lane_id() + wv * 64;
    const int tid = tid_l, lane = tid & 63, r32 = lane & 31, hi = lane >> 5; const int wid = __builtin_amdgcn_readfirstlane(tid >> 6);
    constexpr int QC = MODE == 0 ? Z_FQ : Z_AQ, KC = MODE == 0 ? Z_FK : Z_AK, VC = MODE == 0 ? Z_FV : Z_AV, OC = MODE == 0 ? 512 : 0;
    const long rowbase = (long)b * SEQ; const int q0 = qb * 512;
    const bf16* Qw = Z + (rowbase + q0 + wid * 64) * ZP + QC + h * 64;
    const bf16* Kh = Z + rowbase * ZP + KC + h * 64; const bf16* Vh = Z + rowbase * ZP + VC + h * 64;
    const unsigned lds0 = (unsigned)(uintptr_t)shm;
    LAS float* wsf = (LAS float*)(shm + AT_WS) + wid * 128;
    const int NT = 8 * (qb + 1); const int tlast = 8 * qb + wid;
    const bf16* ksrc = Kh + (long)lane * ZP + wid * 8;
    const bf16* vsrc = Vh + (long)(16 * (wid & 3) + (lane >> 2)) * ZP + (wid >> 2) * 32 + (lane & 3) * 8;
    const unsigned kdst = lds0 + AT_K + wid * 1024, vdst = lds0 + AT_V + wid * 1024, mdst = lds0 + AT_MW + wid * 512;
    const unsigned kadst = lds0 + AT_KA + (wid & 1) * 1024;
#define DMA_KA(t, sl) do { if (MODE == 0 && wid < 2) { const int ln_ = lane_id();     \
        glds16((const bf16*)KA + ((size_t)(b * 8 + h) * SEQ + (t) * 64 + 32 * wid + (ln_ >> 1)) * 16 + (ln_ & 1) * 8, (unsigned)__builtin_amdgcn_readfirstlane(kadst + (sl) * 2048)); } } while (0)
#define DMA_K(t, slotb) glds16(ksrc + (long)(t) * 64 * ZP, (unsigned)__builtin_amdgcn_readfirstlane(kdst + (slotb)))
#define DMA_V(t, slotb) glds16(vsrc + (long)(t) * 64 * ZP, (unsigned)__builtin_amdgcn_readfirstlane(vdst + (slotb)))
#define DMA_M(t, sl) do { const int ln_ = lane_id(); const unsigned* msrcA = (const unsigned*)(MW + (size_t)(rowbase + q0 + wid * 64 + (ln_ & 31)) * 128) + (ln_ >> 5);     \
        glds4(msrcA + 2 * (t), (unsigned)__builtin_amdgcn_readfirstlane(mdst + (sl) * 4096)); glds4(msrcA + 32 * 256 + 2 * (t), (unsigned)__builtin_amdgcn_readfirstlane(mdst + (sl) * 4096 + 256)); } while (0)
    int t_start = 0, t_first = 0;
    if (MODE == 0) { const float* cg = cT + (size_t)(b * 8 + h) * SEQ; const float th = 2.0f * (sqrtf(((const float*)SBp)[2 * (b * 8 + h)]) * sqrtf(((const float*)SBp)[2 * (b * 8 + h) + 1]) * 1.01f + 1.0f) + 40.0f; const int ln_ = lane_id();
        const float c0 = cg[q0], cw = cg[q0 + wid * 64];
        const float ca = (ln_ < NT) ? cg[64 * ln_ + 63] : -3e38f, cb = (ln_ + 64 < NT) ? cg[64 * (ln_ + 64) + 63] : -3e38f;
        { const u64 m0 = __ballot(ca <= c0 + th), m1 = __ballot(cb <= c0 + th); t_start = m0 ? (int)__builtin_ctzll(m0) : 64 + (int)__builtin_ctzll(m1 | (1ull << 63)); }
        { const u64 m0 = __ballot(ca <= cw + th), m1 = __ballot(cb <= cw + th); t_first = m0 ? (int)__builtin_ctzll(m0) : 64 + (int)__builtin_ctzll(m1 | (1ull << 63)); }
        if (t_start > 8 * qb) t_start = 8 * qb; if (t_first > tlast) t_first = tlast; }
    DMA_K(t_start, 0); DMA_V(t_start, 0); if (MODE == 1) DMA_M(0, 0); DMA_KA(t_start, 0);
    bf16x8 qA[4], qB[4];
#pragma unroll
    for (int d0 = 0; d0 < 4; ++d0) { qA[d0] = *(const bf16x8*)(Qw + (long)r32 * ZP + d0 * 16 + hi * 8); qB[d0] = *(const bf16x8*)(Qw + (long)(32 + r32) * ZP + d0 * 16 + hi * 8); }
    float mA = 0.f, mB = 0.f, lA = 0.f, lB = 0.f;
    const unsigned qa0 = (MODE == 0 && hi == 0) ? 0xbf80bf80u : 0u; const unsigned qa1c = (MODE == 0 && hi == 0) ? 0xbf80u : 0u;
    u32x4 qaA = {qa0, qa1c, 0u, 0u}, qaB = {qa0, qa1c, 0u, 0u};
    f32x16 oA[2], oB[2]; oA[0] = f32x16{}; oA[1] = f32x16{}; oB[0] = f32x16{}; oB[1] = f32x16{};
    const int qrelA = wid * 64 + r32;
    const LAS char* kp0 = shm + AT_K + hi * 1024 + r32 * 16;
    const LAS char* vp0 = shm + AT_V + ((lane >> 4) & 1) * 32 + (lane & 3) * 8 + (4 * hi + ((lane & 15) >> 2)) * 64;
    const LAS unsigned* mwp = (const LAS unsigned*)(shm + AT_MW + wid * 512);
    const LAS char* kap0 = shm + AT_KA + r32 * 32 + hi * 16;
    int slot = 0;
#define SOFTMAX(P0, P1, MH, LR, OO, QA, QREL, WSOFF, MWOFF, PW) do { \
        if (MODE == 0) { \
            if (t == tlast) { _Pragma("unroll") for (int r = 0; r < 16; ++r) { const int kv = crow(r, hi); if (kv > (QREL) - wid * 64) P0[r] = -INFINITY; if (kv + 32 > (QREL) - wid * 64) P1[r] = -INFINITY; } } \
        } else { const unsigned mlo = mwp[slot * 1024 + (MWOFF) + r32] >> (4 * hi), mhi = mwp[slot * 1024 + (MWOFF) + 32 + r32] >> (4 * hi);     \
            _Pragma("unroll") for (int r = 0; r < 16; ++r) { const int bitp = crow(r, 0); const float p0_ = P0[r], p1_ = P1[r];     \
                const unsigned s0_ = (unsigned)__builtin_amdgcn_sbfe((int)mlo, bitp, 1), s1_ = (unsigned)__builtin_amdgcn_sbfe((int)mhi, bitp, 1);                       \
                P0[r] = __builtin_bit_cast(float, (__builtin_bit_cast(unsigned, p0_) & s0_) | (0xff800000u & ~s0_)); P1[r] = __builtin_bit_cast(float, (__builtin_bit_cast(unsigned, p1_) & s1_) | (0xff800000u & ~s1_)); } } \
        float rm = __builtin_fmaxf(__builtin_fmaxf(P0[0], P0[1]), P1[0]), rm2 = __builtin_fmaxf(__builtin_fmaxf(P0[2], P0[3]), P1[1]); rm = __builtin_fmaxf(__builtin_fmaxf(rm, P1[2]), P1[3]); \
        _Pragma("unroll") for (int r = 4; r < 16; r += 4) { rm = __builtin_fmaxf(__builtin_fmaxf(rm, P0[r]), P0[r + 1]); rm2 = __builtin_fmaxf(__builtin_fmaxf(rm2, P0[r + 2]), P0[r + 3]); rm = __builtin_fmaxf(__builtin_fmaxf(rm, P1[r]), P1[r + 1]); rm2 = __builtin_fmaxf(__builtin_fmaxf(rm2, P1[r + 2]), P1[r + 3]); } \
        rm = __builtin_fmaxf(rm, rm2); \
        rm = swapmax(rm);                            \
        if (__any(rm > 8.0f)) { const bool big_ = __builtin_fabsf(MH) + __builtin_fabsf(rm > 0.f ? rm : 0.f) > 1800.0f;     \
            const float dl = rm > 0.f ? (big_ ? 64.0f * __builtin_ceilf((MH + rm) * (1.0f / 64.0f)) - MH : 8.0f * __builtin_ceilf(rm * 0.125f)) : 0.f; const float f = __builtin_amdgcn_exp2f(-dl); LR *= f; MH += dl; \
            QA[1] = (QA[1] & 0xffffu) | ((hi == 0) ? (f2bf(-MH) << 16) : 0u); \
            _Pragma("unroll") for (int r = 0; r < 16; ++r) { P0[r] -= dl; P1[r] -= dl; } \
            if (hi == 0) wsf[(WSOFF) + r32] = f; \
            LDS_WAIT(); \
            _Pragma("unroll") for (int j = 0; j < 4; ++j) { const f32x4 ff = *(const LAS f32x4*)(wsf + (WSOFF) + 8 * j + 4 * hi); \
                _Pragma("unroll") for (int i = 0; i < 4; ++i) { OO[0][4 * j + i] *= ff[i]; OO[1][4 * j + i] *= ff[i]; } } } \
        float sacc = 0.f; \
        _Pragma("unroll") for (int r = 0; r < 16; ++r) { P0[r] = __builtin_amdgcn_exp2f(P0[r]); P1[r] = __builtin_amdgcn_exp2f(P1[r]); sacc += P0[r] + P1[r]; } \
        LR += sacc; \
        _Pragma("unroll") for (int i = 0; i < 4; ++i) { PW[0][i] = cvtpk(P0[2 * i], P0[2 * i + 1]); PW[1][i] = cvtpk(P0[8 + 2 * i], P0[8 + 2 * i + 1]); PW[2][i] = cvtpk(P1[2 * i], P1[2 * i + 1]); PW[3][i] = cvtpk(P1[8 + 2 * i], P1[8 + 2 * i + 1]); } \
    } while (0)
#define PVMM(OO, PW) do { const LAS char* vp = vp0 + slot * 8192; \
        _Pragma("unroll") for (int d0 = 0; d0 < 2; ++d0) { s16x4 lo_[4], hh_[4]; \
            _Pragma("unroll") for (int ks = 0; ks < 4; ++ks) { lo_[ks] = vtr(vp + d0 * 4096 + ks * 1024); hh_[ks] = vtr(vp + d0 * 4096 + ks * 1024 + 512); } \
            _Pragma("unroll") for (int ks = 0; ks < 4; ++ks) { const bf16x8 vf = {lo_[ks][0], lo_[ks][1], lo_[ks][2], lo_[ks][3], hh_[ks][0], hh_[ks][1], hh_[ks][2], hh_[ks][3]}; \
                OO[d0] = MFMA32(__builtin_bit_cast(bf16x8, PW[ks]), vf, OO[d0]); } } } while (0)
    for (int t = t_start; t < NT; ++t) {
        asm volatile("s_waitcnt vmcnt(0) lgkmcnt(0)\n\ts_barrier" ::: "memory");
        if (t + 1 < NT) { DMA_K(t + 1, (slot ^ 1) * 8192); DMA_V(t + 1, (slot ^ 1) * 8192); if (MODE == 1) DMA_M(t + 1, slot ^ 1); DMA_KA(t + 1, slot ^ 1); }
        if (t <= tlast && t >= t_first) {
            f32x16 a0 = {}, a1 = {}, b0 = {}, b1 = {};
            { const LAS char* kb = kp0 + slot * 8192;
#pragma unroll
              for (int d0 = 0; d0 < 4; ++d0) { const bf16x8 k0 = *(const LAS bf16x8*)(kb + d0 * 2048), k1 = *(const LAS bf16x8*)(kb + d0 * 2048 + 512);
                  a0 = MFMA32(k0, qA[d0], a0); a1 = MFMA32(k1, qA[d0], a1); b0 = MFMA32(k0, qB[d0], b0); b1 = MFMA32(k1, qB[d0], b1); }
              bf16x8 x0, x1;
              if (MODE == 0) { x0 = *(const LAS bf16x8*)(kap0 + slot * 2048); x1 = *(const LAS bf16x8*)(kap0 + slot * 2048 + 1024); }
              else { const u32x4 cw = {0u, (hi == 0) ? 0x3f800000u : 0u, 0u, 0u}; x0 = __builtin_bit_cast(bf16x8, cw); x1 = x0; }
              a0 = MFMA32(x0, __builtin_bit_cast(bf16x8, qaA), a0); a1 = MFMA32(x1, __builtin_bit_cast(bf16x8, qaA), a1); b0 = MFMA32(x0, __builtin_bit_cast(bf16x8, qaB), b0); b1 = MFMA32(x1, __builtin_bit_cast(bf16x8, qaB), b1); }
            u32x4 pwA[4], pwB[4];
            SOFTMAX(a0, a1, mA, lA, oA, qaA, qrelA, 0, 0, pwA);
            PVMM(oA, pwA);
            SOFTMAX(b0, b1, mB, lB, oB, qaB, qrelA + 32, 32, 64, pwB);
            PVMM(oB, pwB);
        }
        slot ^= 1;
    }
#define EPILOG(OO, LR, WSOFF, ROWOFF) do { float l_ = swapsum(LR); if (hi == 0) wsf[64 + (WSOFF) + r32] = l_; LDS_WAIT(); float rli[16]; \
        _Pragma("unroll") for (int r = 0; r < 16; ++r) rli[r] = __builtin_amdgcn_rcpf(wsf[64 + (WSOFF) + crow(r, hi)]); \
        bf16* Ow = Ob + (rowbase + q0 + wid * 64 + (ROWOFF)) * OP + OC + h * 64; LAS bf16* stg = (LAS bf16*)(shm + AT_OST) + wid * 2048; \
        _Pragma("unroll") for (int r = 0; r < 16; ++r) { const int orow = crow(r, hi); _Pragma("unroll") for (int d0 = 0; d0 < 2; ++d0) stg[orow * 64 + d0 * 32 + r32] = (bf16)f2bf(OO[d0][r] * rli[r]); } \
        LDS_WAIT(); \
        _Pragma("unroll") for (int i = 0; i < 4; ++i) { const int row = i * 8 + (lane >> 3), ch = lane & 7; const u32x4 v = *(const LAS u32x4*)(stg + row * 64 + ch * 8); *(u32x4*)(Ow + (long)row * OP + ch * 8) = v; } \
        LDS_WAIT(); } while (0)
    EPILOG(oA, lA, 0, 0);
    EPILOG(oB, lB, 32, 32);
    asm volatile("s_waitcnt lgkmcnt(0)\n\ts_barrier" ::: "memory");
#undef DMA_K
#undef DMA_V
#undef DMA_M
#undef DMA_KA
#undef SOFTMAX
#undef PVMM
#undef EPILOG
}

__device__ __forceinline__ void attn_phase(KP p, int l, LAS unsigned char* lds, int vcu, int G, int wv) {
    unsigned char* ws = p->ws; const bf16* Z = (const bf16*)(ws + WS_Z); bf16* Ob = (bf16*)(ws + WS_OBUF); const float* cT = (const float*)(ws + WS_CT); const u64* MW = (const u64*)(ws + WS_MASKW);
    for (int U = vcu; U < 1024; U += G) {
        const int v = U & 255, i4 = U >> 8; const int mode = i4 & 1, k = i4 >> 1; const int bh = v >> 3, s = v & 7;
        const int qb = (k == 0) ? s : 15 - s;
        if (mode == 0) attn_unit<0>(bh >> 3, bh & 7, qb, Z, Ob, cT, MW, (const void*)(ws + WS_KA), (const void*)((const unsigned*)(ws + WS_CTL) + CW_SB + l * 64), (LAS char*)lds, wv);
        else attn_unit<1>(bh >> 3, bh & 7, qb, Z, Ob, cT, MW, (const void*)(ws + WS_KA), (const void*)((const unsigned*)(ws + WS_CTL) + CW_SB + l * 64), (LAS char*)lds, wv);
    }
}

constexpr int HG_LF = 0, HG_KK = 16640, HG_SEG = 33280, HG_P = 35328, HG_R = HG_P + 9216, HG_RT = HG_R + 9216, HG_VT = HG_RT + 9216, HG_ST = HG_VT + 9216, HG_CG = HG_ST + 9216, HG_END = HG_CG + 9216;
static_assert(HG_END <= SCR_BYTES, "hgrn LDS");
constexpr int HP = 72;

__device__ __forceinline__ void hgrn_front(KP p, int l, const unsigned short (&zf)[8], int h, int d, int seg, LAS float* SEG, float (&kk)[8], float (&bb)[8], float& bm, float& bl) {
    const int dd = h * 64 + d; const float lb = (l == 0) ? 0.f : sigmoidf_(p->lb_logits[512 + dd] - p->lb_logits[dd]);
    float run = 0.f;
#pragma unroll
    for (int i = 0; i < 8; ++i) { const float sg = sigmoidf_(bf2f(zf[i])); const float f = lb + (1.f - lb) * sg; kk[i] = (1.f - lb) * (1.f - sg); run += __logf(f); bb[i] = run; }
    SEG[seg * 64 + d] = run;
    WG_BAR_LDS();
    float pre = 0.f, m4 = 0.f, all = 0.f;
#pragma unroll
    for (int s2 = 0; s2 < 8; ++s2) { const float sv = SEG[s2 * 64 + d]; if (s2 < seg) pre += sv; if (s2 < 4) m4 += sv; all += sv; }
#pragma unroll
    for (int i = 0; i < 8; ++i) bb[i] += pre;
    bm = m4; bl = all;
}

#define H_ROWP(U_) (Z + (size_t)((((U_) >> 7) >> 3) * SEQ + ((U_) & 127) * 64 + 8 * seg) * ZP + (((U_) >> 7) & 7) * 64 + d)
__device__ __forceinline__ void h1_phase(KP p, int l, LAS unsigned char* lds, int vcu, int G, int tid, int wave, int lane) {
    unsigned char* ws = p->ws; const bf16* Z = (const bf16*)(ws + WS_Z); float* Ug = (float*)(ws + WS_UG); float* Dg = (float*)(ws + WS_DG); float* D2g = (float*)(ws + WS_D2G);
    LAS float* SEG = (LAS float*)(lds + HG_SEG); LAS bf16* RT = (LAS bf16*)(lds + HG_RT); LAS bf16* VT = (LAS bf16*)(lds + HG_VT);
    const int r32 = lane & 31, hi = lane >> 5; const int d = tid & 63, seg = tid >> 6;
    for (int U = vcu; U < 4096; U += G) {
        const int bh = U >> 7, h = bh & 7; const bf16* rp = H_ROWP(U);
        unsigned short zf[8], vv[8];
#pragma unroll
        for (int i = 0; i < 8; ++i) { zf[i] = rp[(size_t)i * ZP + Z_CF]; vv[i] = rp[(size_t)i * ZP + Z_CI]; }
        float kk[8], bb[8], bm, bl; hgrn_front(p, l, zf, h, d, seg, SEG, kk, bb, bm, bl);
        { unsigned rw[4], vw[4];
#pragma unroll
          for (int i = 0; i < 4; ++i) { rw[i] = pk2(kk[2 * i] * __expf(fminf(bm - bb[2 * i], 80.f)), kk[2 * i + 1] * __expf(fminf(bm - bb[2 * i + 1], 80.f))); vw[i] = (unsigned)vv[2 * i] | ((unsigned)vv[2 * i + 1] << 16); }
          *(LAS u32x4*)(RT + d * HP + 8 * seg) = (u32x4){rw[0], rw[1], rw[2], rw[3]}; *(LAS u32x4*)(VT + d * HP + 8 * seg) = (u32x4){vw[0], vw[1], vw[2], vw[3]}; }
        if (seg == 7) { Dg[(size_t)U * 64 + d] = __expf(bl); D2g[(size_t)U * 64 + d] = __expf(bl - bm); }
        WG_BAR_LDS();
        if (wave < 4) { const int ib = wave >> 1, jb = wave & 1; f32x16 acc = {};
#pragma unroll
            for (int ks = 0; ks < 4; ++ks) { const bf16x8 a = *(const LAS bf16x8*)(RT + (32 * ib + r32) * HP + 16 * ks + 8 * hi), bq = *(const LAS bf16x8*)(VT + (32 * jb + r32) * HP + 16 * ks + 8 * hi);
                acc = MFMA32(a, bq, acc); }
            float* up = Ug + ((size_t)U * 64 + 32 * jb + r32) * 64 + 32 * ib + 4 * hi;
#pragma unroll
            for (int rr = 0; rr < 4; ++rr) *(f32x4*)(up + 8 * rr) = (f32x4){acc[4 * rr], acc[4 * rr + 1], acc[4 * rr + 2], acc[4 * rr + 3]}; }
        WG_BAR_LDS();
    }
}

__device__ __forceinline__ void h2_phase(KP p, int G, int tid) {
    unsigned char* ws = p->ws; const float* Ug = (const float*)(ws + WS_UG); const float* Dg = (const float*)(ws + WS_DG); const float* D2g = (const float*)(ws + WS_D2G); bf16* Sst = (bf16*)(ws + WS_SST);
    for (int gid = blockIdx.x * NTHR + tid; gid < 32 * 4096; gid += G * NTHR) {
        const int bh = gid >> 12, ed = gid & 4095, d = ed & 63; float S = 0.f;
        const float* up = Ug + (size_t)bh * 128 * 4096 + ed; const float* dp = Dg + (size_t)bh * 128 * 64 + d; const float* d2p = D2g + (size_t)bh * 128 * 64 + d; bf16* sp = Sst + (size_t)bh * 128 * 4096 + ed;
        for (int c0 = 0; c0 < 128; c0 += 8) { float u[8], dd[8], d2[8];
#pragma unroll
            for (int i = 0; i < 8; ++i) { u[i] = up[(size_t)(c0 + i) * 4096]; dd[i] = dp[(c0 + i) * 64]; d2[i] = d2p[(c0 + i) * 64]; }
#pragma unroll
            for (int i = 0; i < 8; ++i) { sp[(size_t)(c0 + i) * 4096] = (bf16)f2bf(S); S = dd[i] * S + d2[i] * u[i]; } }
    }
}

__device__ __forceinline__ void h3_phase(KP p, int l, LAS unsigned char* lds, int vcu, int G, int tid, int wave, int lane) {
    unsigned char* ws = p->ws; const bf16* Z = (const bf16*)(ws + WS_Z); const bf16* Sst = (const bf16*)(ws + WS_SST); bf16* Ob = (bf16*)(ws + WS_OBUF);
    LAS float* SEG = (LAS float*)(lds + HG_SEG);
    LAS bf16* Pt = (LAS bf16*)(lds + HG_P); LAS bf16* Rt = (LAS bf16*)(lds + HG_R); LAS bf16* VT = (LAS bf16*)(lds + HG_VT); LAS bf16* ST = (LAS bf16*)(lds + HG_ST); LAS bf16* CG = (LAS bf16*)(lds + HG_CG);
    const int r32 = lane & 31, hi = lane >> 5; const int d = tid & 63, seg = tid >> 6;
    const float* gn = p->norm_g + l * 512;
    for (int U = vcu; U < 4096; U += G) {
        const int bh = U >> 7, c = U & 127, b = bh >> 3, h = bh & 7; const int t0 = b * SEQ + c * 64; const bf16* rp = H_ROWP(U);
        unsigned short zf[8], qv[8], vv[8], gg[8], sv[8];
#pragma unroll
        for (int i = 0; i < 8; ++i) { zf[i] = rp[(size_t)i * ZP + Z_CF]; qv[i] = rp[(size_t)i * ZP + Z_CQ]; vv[i] = rp[(size_t)i * ZP + Z_CI]; gg[i] = rp[(size_t)i * ZP + Z_CG]; sv[i] = Sst[(size_t)U * 4096 + (8 * seg + i) * 64 + d]; }
        float kk[8], bb[8], bm, bl; hgrn_front(p, l, zf, h, d, seg, SEG, kk, bb, bm, bl); (void)bl;
        { const float ebm = __expf(bm); unsigned vw[4];
#pragma unroll
          for (int i = 0; i < 8; ++i) { const int t = 8 * seg + i;
              Pt[t * HP + d] = (bf16)f2bf(bf2f(qv[i]) * __expf(fminf(bb[i] - bm, 80.f))); Rt[t * HP + d] = (bf16)f2bf(kk[i] * __expf(fminf(bm - bb[i], 80.f)));
              ST[t * HP + d] = (bf16)f2bf(bf2f(sv[i]) * ebm); CG[t * HP + d] = (bf16)gg[i]; }
#pragma unroll
          for (int i = 0; i < 4; ++i) vw[i] = (unsigned)vv[2 * i] | ((unsigned)vv[2 * i + 1] << 16);
          *(LAS u32x4*)(VT + d * HP + 8 * seg) = (u32x4){vw[0], vw[1], vw[2], vw[3]}; }
        WG_BAR_LDS();
        if (wave < 2) { const int ib = wave;
            u32x4 pw[2][2];
#pragma unroll
            for (int k = 0; k < 2; ++k) { f32x16 a = {};
                if (k <= ib) {
#pragma unroll
                    for (int js = 0; js < 4; ++js) { const bf16x8 ra = *(const LAS bf16x8*)(Rt + (32 * k + r32) * HP + 16 * js + 8 * hi), pb = *(const LAS bf16x8*)(Pt + (32 * ib + r32) * HP + 16 * js + 8 * hi);
                        a = MFMA32(ra, pb, a); }
                    if (k == ib) {
#pragma unroll
                        for (int r = 0; r < 16; ++r) if (crow(r, hi) > r32) a[r] = 0.f;
                    }
                }
#pragma unroll
                for (int i = 0; i < 4; ++i) { pw[k][0][i] = cvtpk(a[2 * i], a[2 * i + 1]); pw[k][1][i] = cvtpk(a[8 + 2 * i], a[8 + 2 * i + 1]); } }
            f32x16 oacc[2]; float ss = 0.f;
#pragma unroll
            for (int j = 0; j < 2; ++j) { f32x16 oa = {};
#pragma unroll
                for (int k = 0; k < 2; ++k) { if (k <= ib) {
#pragma unroll
                    for (int st = 0; st < 2; ++st) { const LAS bf16* vp = VT + (32 * j + r32) * HP + 32 * k + 16 * st + 4 * hi;
                        const s16x4 v0 = *(const LAS s16x4*)vp, v1 = *(const LAS s16x4*)(vp + 8);
                        const bf16x8 vf = {v0[0], v0[1], v0[2], v0[3], v1[0], v1[1], v1[2], v1[3]};
                        oa = MFMA32(vf, __builtin_bit_cast(bf16x8, pw[k][st]), oa); } } }
#pragma unroll
                for (int js = 0; js < 4; ++js) { const bf16x8 sa = *(const LAS bf16x8*)(ST + (32 * j + r32) * HP + 16 * js + 8 * hi), pb = *(const LAS bf16x8*)(Pt + (32 * ib + r32) * HP + 16 * js + 8 * hi);
                    oa = MFMA32(sa, pb, oa); }
#pragma unroll
                for (int r = 0; r < 16; ++r) ss += oa[r] * oa[r];
                oacc[j] = oa; }
            ss = swapsum(ss);
            const float rstd = 1.0f / sqrtf(ss * (1.0f / 64.0f) + RMS_EPS);
            bf16* orow = Ob + (size_t)(t0 + 32 * ib + r32) * OP + 1024 + h * 64;
#pragma unroll
            for (int j = 0; j < 2; ++j)
#pragma unroll
                for (int rr = 0; rr < 4; ++rr) { const int e0 = 32 * j + 8 * rr + 4 * hi; const f32x4 g4 = *(const f32x4*)(gn + h * 64 + e0);
                    const u32x2 cw = *(const LAS u32x2*)(CG + (32 * ib + r32) * HP + e0);
                    const float o0 = oacc[j][4 * rr] * rstd * g4[0] * sigmoidf_(bflo(cw.x)), o1 = oacc[j][4 * rr + 1] * rstd * g4[1] * sigmoidf_(bfhi(cw.x));
                    const float o2 = oacc[j][4 * rr + 2] * rstd * g4[2] * sigmoidf_(bflo(cw.y)), o3 = oacc[j][4 * rr + 3] * rstd * g4[3] * sigmoidf_(bfhi(cw.y));
                    *(u32x2*)(orow + e0) = (u32x2){cvtpk(o0, o1), cvtpk(o2, o3)}; }
        }
        WG_BAR_LDS();
    }
}

#undef H_ROWP
constexpr int RT_LG = 0, RT_HIST = 8 * 2048, RT_END = RT_HIST + 1024;
static_assert(RT_END <= SCR_BYTES, "router LDS");
typedef short bf16x8_t __attribute__((ext_vector_type(8)));
__device__ __forceinline__ void split_hi_lo(const f32x4 a, const f32x4 b, bf16x8_t& hi, bf16x8_t& lo) {
    const float v[8] = {a.x, a.y, a.z, a.w, b.x, b.y, b.z, b.w}; unsigned h[8], l[8];
#pragma unroll
    for (int i = 0; i < 8; ++i) { h[i] = f2bf(v[i]); l[i] = f2bf(v[i] - bf2f(h[i])); }
    const u32x4 hw = {h[0] | (h[1] << 16), h[2] | (h[3] << 16), h[4] | (h[5] << 16), h[6] | (h[7] << 16)}, lw = {l[0] | (l[1] << 16), l[2] | (l[3] << 16), l[4] | (l[5] << 16), l[6] | (l[7] << 16)};
    hi = __builtin_bit_cast(bf16x8_t, hw); lo = __builtin_bit_cast(bf16x8_t, lw);
}
__device__ __forceinline__ void ln1_phase(KP p, int l, const float* xin, LAS unsigned char* lds, int G, int tid, int wave, int lane) {
    unsigned char* ws = p->ws; const float* mix = (const float*)(ws + WS_MIX); float* x1 = (float*)(ws + WS_X1); bf16* x1b = (bf16*)(ws + WS_X1B);
    int* tke = (int*)(ws + WS_TKE); float* tkg = (float*)(ws + WS_TKG); int* wgcnt = (int*)(ws + WS_WGCNT);
    LAS float* LG = (LAS float*)(lds + RT_LG) + wave * 512; LAS unsigned* hist = (LAS unsigned*)(lds + RT_HIST);
    if (tid < 32) hist[tid] = 0u;
    WG_BAR();
    const float* lg = p->ln1_g + l * 1024; const float* lb = p->ln1_b + l * 1024;
    f32x4 gv[4], bv[4];
#pragma unroll
    for (int j = 0; j < 4; ++j) { gv[j] = *(const f32x4*)(lg + 4 * lane + 256 * j); bv[j] = *(const f32x4*)(lb + 4 * lane + 256 * j); }
    const int m0 = blockIdx.x * NWAVES + wave, mstride = G * NWAVES;
    for (int mb = m0; mb < NTOK; mb += 16 * mstride) {
        f32x4 xa[4], xm[4];
        { const f32x4* xr = (const f32x4*)(xin + (size_t)mb * DM) + lane; const f32x4* mr = (const f32x4*)(mix + (size_t)mb * DM) + lane;
#pragma unroll
          for (int j = 0; j < 4; ++j) { xa[j] = xr[64 * j]; xm[j] = mr[64 * j]; } }
#pragma unroll 1
        for (int i = 0; i < 16; ++i) { const int m = mb + i * mstride; if (m >= NTOK) break;
            f32x4 v[4]; float s = 0.f;
#pragma unroll
            for (int j = 0; j < 4; ++j) { v[j] = xa[j] * ALPHA + xm[j]; s += (v[j].x + v[j].y) + (v[j].z + v[j].w); }
            { const int mn = (m + mstride < NTOK) ? m + mstride : m;
              const f32x4* xr = (const f32x4*)(xin + (size_t)mn * DM) + lane; const f32x4* mr = (const f32x4*)(mix + (size_t)mn * DM) + lane;
#pragma unroll
              for (int j = 0; j < 4; ++j) { xa[j] = xr[64 * j]; xm[j] = mr[64 * j]; } }
            const float mean = wave_sum(s) * (1.f / DM); float s2 = 0.f;
#pragma unroll
            for (int j = 0; j < 4; ++j) { v[j] = v[j] - mean; s2 += (v[j].x * v[j].x + v[j].y * v[j].y) + (v[j].z * v[j].z + v[j].w * v[j].w); }
            const float rstd = 1.f / sqrtf(wave_sum(s2) * (1.f / DM) + LN_EPS);
            f32x4* o4 = (f32x4*)(x1 + (size_t)m * DM) + lane; unsigned* o1 = (unsigned*)((unsigned char*)x1b + (size_t)m * DM) + lane;
#pragma unroll
            for (int j = 0; j < 4; ++j) { v[j] = v[j] * rstd * gv[j] + bv[j]; o4[64 * j] = v[j]; int w8 = __builtin_amdgcn_cvt_pk_fp8_f32(v[j].x, v[j].y, 0, false); w8 = __builtin_amdgcn_cvt_pk_fp8_f32(v[j].z, v[j].w, w8, true); o1[64 * j] = (unsigned)w8; } }
        asm volatile("s_waitcnt vmcnt(0)" ::: "memory"); __builtin_amdgcn_fence(__ATOMIC_ACQUIRE, "agent"); asm volatile("s_waitcnt vmcnt(0)" ::: "memory");
        { const int ti = lane & 15, kg = lane >> 4; int mt = mb + ti * mstride; if (mt >= NTOK) mt = mb;
          const float* xr = x1 + (size_t)mt * DM + 8 * kg; const bf16* wf = (const bf16*)(ws + WS_WRF) + (size_t)l * 32 * 2 * 2 * 512 + lane * 8;
          f32x4 acc0 = {0.f, 0.f, 0.f, 0.f}, acc1 = {0.f, 0.f, 0.f, 0.f};
#pragma unroll 4
          for (int s = 0; s < 32; ++s) { const f32x4 a0 = *(const f32x4*)(xr + 32 * s), a1 = *(const f32x4*)(xr + 32 * s + 4); bf16x8_t ah, al; split_hi_lo(a0, a1, ah, al);
              const bf16x8_t w0h = *(const bf16x8_t*)(wf + (size_t)(s * 4 + 0) * 512), w0l = *(const bf16x8_t*)(wf + (size_t)(s * 4 + 1) * 512), w1h = *(const bf16x8_t*)(wf + (size_t)(s * 4 + 2) * 512), w1l = *(const bf16x8_t*)(wf + (size_t)(s * 4 + 3) * 512);
              acc0 = __builtin_amdgcn_mfma_f32_16x16x32_bf16(ah, w0h, acc0, 0, 0, 0); acc0 = __builtin_amdgcn_mfma_f32_16x16x32_bf16(al, w0h, acc0, 0, 0, 0); acc0 = __builtin_amdgcn_mfma_f32_16x16x32_bf16(ah, w0l, acc0, 0, 0, 0);
              acc1 = __builtin_amdgcn_mfma_f32_16x16x32_bf16(ah, w1h, acc1, 0, 0, 0); acc1 = __builtin_amdgcn_mfma_f32_16x16x32_bf16(al, w1h, acc1, 0, 0, 0); acc1 = __builtin_amdgcn_mfma_f32_16x16x32_bf16(ah, w1l, acc1, 0, 0, 0); }
#pragma unroll
          for (int r = 0; r < 4; ++r) { LG[(4 * kg + r) * 32 + ti] = acc0[r]; LG[(4 * kg + r) * 32 + 16 + ti] = acc1[r]; } }
        LDS_WAIT();
        if (lane < 16) { const int m = mb + lane * mstride;
            if (m < NTOK) { float tv0 = -3e38f, tv1 = -3e38f, tv2 = -3e38f, tv3 = -3e38f; int ti0 = 0, ti1 = 0, ti2 = 0, ti3 = 0;
#pragma unroll
                for (int e4 = 0; e4 < 8; ++e4) { const f32x4 lv = *(const LAS f32x4*)(LG + lane * 32 + 4 * e4); const f32x4 bb = *(const f32x4*)(p->b_router + l * 32 + 4 * e4);
#pragma unroll
                    for (int i = 0; i < 4; ++i) { const float g = lv[i] + bb[i]; const int e = 4 * e4 + i;
                        if (g > tv0) { tv3 = tv2; ti3 = ti2; tv2 = tv1; ti2 = ti1; tv1 = tv0; ti1 = ti0; tv0 = g; ti0 = e; }
                        else if (g > tv1) { tv3 = tv2; ti3 = ti2; tv2 = tv1; ti2 = ti1; tv1 = g; ti1 = e; }
                        else if (g > tv2) { tv3 = tv2; ti3 = ti2; tv2 = g; ti2 = e; }
                        else if (g > tv3) { tv3 = g; ti3 = e; } } }
                const float e1 = __expf(tv1 - tv0), e2 = __expf(tv2 - tv0), e3 = __expf(tv3 - tv0); const float inv = 1.f / (1.f + e1 + e2 + e3);
                *(int4*)(tke + m * 4) = make_int4(ti0, ti1, ti2, ti3); *(f32x4*)(tkg + m * 4) = (f32x4){inv, e1 * inv, e2 * inv, e3 * inv};
                __hip_atomic_fetch_add(hist + ti0, 1u, __ATOMIC_RELAXED, __HIP_MEMORY_SCOPE_WORKGROUP); __hip_atomic_fetch_add(hist + ti1, 1u, __ATOMIC_RELAXED, __HIP_MEMORY_SCOPE_WORKGROUP);
                __hip_atomic_fetch_add(hist + ti2, 1u, __ATOMIC_RELAXED, __HIP_MEMORY_SCOPE_WORKGROUP); __hip_atomic_fetch_add(hist + ti3, 1u, __ATOMIC_RELAXED, __HIP_MEMORY_SCOPE_WORKGROUP); } }
        LDS_WAIT();
    }
    WG_BAR();
    if (tid < 32) wgcnt[blockIdx.x * 32 + tid] = (int)hist[tid];
}

__device__ __forceinline__ void slot_phase(KP p, LAS unsigned char* lds, int G, int tid, int wave, int lane) {
    unsigned char* ws = p->ws; const int* wgcnt = (const int*)(ws + WS_WGCNT); int* blk = (int*)(ws + WS_BLK);
    const int* tke = (const int*)(ws + WS_TKE); const float* tkg = (const float*)(ws + WS_TKG); int* tokslot = (int*)(ws + WS_TOKSLOT); float* gslot = (float*)(ws + WS_GSLOT);
    LAS unsigned* tot = (LAS unsigned*)lds; LAS unsigned* mine = tot + 32; LAS unsigned* cur = tot + 64;
    if (tid < 96) tot[tid] = 0u;
    WG_BAR();
    { const int e = tid & 31, part = tid >> 5; unsigned sa = 0u, sb = 0u;
      for (int w = part; w < G; w += 16) { const unsigned c = (unsigned)wgcnt[w * 32 + e]; sa += c; if (w < (int)blockIdx.x) sb += c; }
      __hip_atomic_fetch_add(tot + e, sa, __ATOMIC_RELAXED, __HIP_MEMORY_SCOPE_WORKGROUP); __hip_atomic_fetch_add(mine + e, sb, __ATOMIC_RELAXED, __HIP_MEMORY_SCOPE_WORKGROUP); }
    WG_BAR();
    if (tid == 0) { unsigned off = 0u;
#pragma unroll 1
        for (int e = 0; e < 32; ++e) { const unsigned padded = (tot[e] + 255u) & ~255u; cur[e] = off + mine[e];
            if (blockIdx.x == 0) { blk[BST_OFF + e] = (int)(off >> 8);
#pragma unroll 1
                for (unsigned bb = off >> 8; bb < ((off + padded) >> 8); ++bb) blk[16 + bb] = e; }
            off += padded; }
        if (blockIdx.x == 0) { blk[0] = (int)(off >> 8); blk[BST_OFF + 32] = (int)(off >> 8); } }
    WG_BAR();
    int* slottok = (int*)(ws + WS_SLOTTOK);
    if (blockIdx.x == 0 && tid < 32) { const unsigned ps = cur[tid], n = tot[tid];
        int zero_ = 0; asm volatile("" : "+v"(zero_));
#pragma unroll 1
        for (unsigned s = ps + n; s < ps + ((n + 255u) & ~255u); ++s) slottok[s] = zero_; }
    WG_BAR();
    for (int m = blockIdx.x * NWAVES + wave; m < NTOK; m += G * NWAVES) {
        if (lane < 4) { const int e = tke[m * 4 + lane]; const int slot = (int)__hip_atomic_fetch_add(cur + e, 1u, __ATOMIC_RELAXED, __HIP_MEMORY_SCOPE_WORKGROUP); tokslot[m * 4 + lane] = slot; gslot[slot] = tkg[m * 4 + lane]; slottok[slot] = m; }
    }
}

__device__ __forceinline__ void comb_phase(KP p, int l, float* xout, int G, int wave, int lane) {
    unsigned char* ws = p->ws; const float* x1 = (const float*)(ws + WS_X1); const bf16* y = (const bf16*)(ws + WS_Y); const int* tokslot = (const int*)(ws + WS_TOKSLOT); bf16* xb = (bf16*)(ws + WS_XB);
    const float* lg = p->ln2_g + l * 1024; const float* lb = p->ln2_b + l * 1024;
    f32x4 gv[4], bv[4];
#pragma unroll
    for (int j = 0; j < 4; ++j) { gv[j] = *(const f32x4*)(lg + 4 * lane + 256 * j); bv[j] = *(const f32x4*)(lb + 4 * lane + 256 * j); }
    for (int m = blockIdx.x * NWAVES + wave; m < NTOK; m += G * NWAVES) {
        const f32x4* xr = (const f32x4*)(x1 + (size_t)m * DM) + lane;
        f32x4 v[4];
#pragma unroll
        for (int j = 0; j < 4; ++j) v[j] = xr[64 * j] * ALPHA;
#pragma unroll
        for (int k = 0; k < 4; ++k) { const int sk = __builtin_amdgcn_readfirstlane(tokslot[m * 4 + k]); const u32x2* yr = (const u32x2*)(y + (size_t)sk * DM) + lane;
#pragma unroll
            for (int j = 0; j < 4; ++j) { const u32x2 w = yr[64 * j]; v[j].x += bflo(w.x); v[j].y += bfhi(w.x); v[j].z += bflo(w.y); v[j].w += bfhi(w.y); } }
        float s = 0.f;
#pragma unroll
        for (int j = 0; j < 4; ++j) s += (v[j].x + v[j].y) + (v[j].z + v[j].w);
        const float mean = wave_sum(s) * (1.f / DM); float s2 = 0.f;
#pragma unroll
        for (int j = 0; j < 4; ++j) { v[j] = v[j] - mean; s2 += (v[j].x * v[j].x + v[j].y * v[j].y) + (v[j].z * v[j].z + v[j].w * v[j].w); }
        const float rstd = 1.f / sqrtf(wave_sum(s2) * (1.f / DM) + LN_EPS);
        f32x4* o4 = (f32x4*)(xout + (size_t)m * DM) + lane; u32x2* o2 = (u32x2*)(xb + (size_t)m * DM) + lane;
#pragma unroll
        for (int j = 0; j < 4; ++j) { v[j] = v[j] * rstd * gv[j] + bv[j]; o4[64 * j] = v[j]; o2[64 * j] = (u32x2){pk2(v[j].x, v[j].y), pk2(v[j].z, v[j].w)}; }
    }
}

#ifndef ONE_LAUNCH
#define ONE_LAUNCH 1
#endif
__global__ void __launch_bounds__(NTHR, 2) fwd(Params p) {
    extern __shared__ __attribute__((aligned(16))) unsigned char lds_raw[];
    LAS unsigned char* lds = (LAS unsigned char*)lds_raw;
    volatile LAS unsigned* MISC = (volatile LAS unsigned*)(lds + MISC_OFF);
    const int tid = threadIdx.x, lane = tid & 63, wave = __builtin_amdgcn_readfirstlane(tid >> 6); const int wave0 = wave;
    const int G = gridDim.x; const int bx = blockIdx.x; const int vcu = (G % 8 == 0) ? (bx % 8) * (G / 8) + bx / 8 : bx;
    if (tid < 64) MISC[tid] = 0u;
    __syncthreads();
    if (p.use_bar) (void)xcd_barrier_post((unsigned*)(p.ws + WS_CTL) + CW_BAR, MISC + 8);
    const int lo = p.ph_lo, hi = p.ph_hi;
#ifndef PHSEL
#define PHSEL(k) true
#endif
#define IN(k) (PHSEL(k) && lo <= (k) && (k) < hi)
#define SEAM(k) do { if (lo <= (k) && (k) + 1 < hi) { KP qb_ = load_params(); XcdBarrier b_; b_.bar = (unsigned*)(qb_->ws + WS_CTL) + CW_BAR; b_.x = xb_xcc_id(); b_.st = MISC + 8; xcd_barrier(b_); } } while (0)
    const int gw0 = vcu * NWAVES + wave, NGW = G * NWAVES;
#define PH_IDS const int lane = lane_id(), wave = wave0, tid = wave0 * 64 + lane, gw = vcu * NWAVES + wave; (void)lane; (void)gw; (void)gw0;

    if (IN(0)) { PH_IDS KP q = load_params(); p0_prologue(q, lds, gw, NGW, wave, lane); SEAM(0); }

    for (int l = 0; l < DEPTH; ++l) {
        const int pb = 1 + l * NPH_LAYER;

        if (IN(pb + PH_INPROJ)) {
            KP q = load_params(); unsigned char* w = q->ws;
            pg8::Gemm g{(const bf16*)(w + WS_XB), (const bf16*)(w + WS_WIN) + (size_t)l * ZP * 1024, NTOK, ZP, 1024}; pg8::StaticOrder S; S.init(NTOK, ZP, G, bx);
            pg8::EpiZ E{(bf16*)(w + WS_Z), ZP, (const float*)(w + WS_TRIG), (bf16*)(w + WS_IKC)};
            pg8::gemm_phase<pg8::EpiZ, pg8::StaticOrder, true, true>(lds, g, S, E, wave0);
            SEAM(pb + PH_INPROJ);
        }
        if (IN(pb + PH_IDX)) { PH_IDS KP q = load_params(); idx_phase(q, l, lds, vcu, G, tid, wave, lane); SEAM(pb + PH_IDX); }
        if (IN(pb + PH_ATTN)) { PH_IDS KP q = load_params(); attn_phase(q, l, lds, vcu, G, wave0); SEAM(pb + PH_ATTN); }
        if (IN(pb + PH_H1)) { PH_IDS KP q = load_params(); h1_phase(q, l, lds, vcu, G, tid, wave, lane); SEAM(pb + PH_H1); }
        if (IN(pb + PH_H2)) { PH_IDS KP q = load_params(); h2_phase(q, G, tid); SEAM(pb + PH_H2); }
        if (IN(pb + PH_H3)) { PH_IDS KP q = load_params(); h3_phase(q, l, lds, vcu, G, tid, wave, lane); SEAM(pb + PH_H3); }
        if (IN(pb + PH_MERGE)) {
            KP q = load_params(); unsigned char* w = q->ws;
            pg8::Gemm g{(const bf16*)(w + WS_OBUF), (const bf16*)(w + WS_WP) + (size_t)l * 1024 * 1536, NTOK, 1024, 1536}; pg8::StaticOrder S; S.init(NTOK, 1024, G, bx);
            pg8::EpiMerge E{(const bf16*)(w + WS_Z) + Z_GT, ZP, (bf16*)(w + WS_MERGED), 1024};
            pg8::gemm_phase<pg8::EpiMerge, pg8::StaticOrder, true, true>(lds, g, S, E, wave0);
            SEAM(pb + PH_MERGE);
        }
        if (IN(pb + PH_WOUT)) {
            KP q = load_params(); unsigned char* w = q->ws;
            pg8::Gemm g{(const bf16*)(w + WS_MERGED), (const bf16*)(w + WS_WOUT) + (size_t)l * 1024 * 1024, NTOK, 1024, 1024}; pg8::StaticOrder S; S.init(NTOK, 1024, G, bx);
            pg8::EpiF32 E{(float*)(w + WS_MIX), 1024};
            pg8::gemm_phase<pg8::EpiF32, pg8::StaticOrder, true, true>(lds, g, S, E, wave0);
            SEAM(pb + PH_WOUT);
        }
        if (IN(pb + PH_LN1)) { PH_IDS KP q = load_params(); const float* xin = (l == 0) ? q->x : (const float*)(q->ws + WS_XCUR); ln1_phase(q, l, xin, lds, G, tid, wave, lane); SEAM(pb + PH_LN1); }
        if (IN(pb + PH_SLOT)) { PH_IDS KP q = load_params(); slot_phase(q, lds, G, tid, wave, lane); SEAM(pb + PH_SLOT); }
        if (IN(pb + PH_GU)) {
            KP q = load_params(); unsigned char* w = q->ws;
            pg8::Gemm g{(const bf16*)(w + WS_X1B), (const bf16*)(w + WS_WGU + (size_t)l * 32 * 2048 * 1024), MAXSLOT, 32 * 2048, 1024};
            pg8::moe_build_list((LAS int*)(lds + pg8::STAGE_BYTES), (const int*)(w + WS_BLK), 8, G, bx, wave0 * 64 + lane_id()); pg8::MoeOrderG S{(const LAS int*)(lds + pg8::STAGE_BYTES), (const int*)(w + WS_SLOTTOK)};
            pg8::EpiSwiGLU E{(bf16*)(w + WS_ACT), (const float*)(w + WS_BGU) + (size_t)l * 32 * 2048, 8};
            pg8::gemm_phase<pg8::EpiSwiGLU, pg8::MoeOrderG, true, true, true, W8_E8M0>(lds, g, S, E, wave0);
            SEAM(pb + PH_GU);
        }
        if (IN(pb + PH_DOWN)) {
            KP q = load_params(); unsigned char* w = q->ws;
            pg8::Gemm g{(const bf16*)(w + WS_ACT), (const bf16*)(w + WS_WDN + (size_t)l * 32 * 1024 * 1024), MAXSLOT, 32 * 1024, 1024};
            pg8::moe_build_list((LAS int*)(lds + pg8::STAGE_BYTES), (const int*)(w + WS_BLK), 4, G, bx, wave0 * 64 + lane_id()); pg8::MoeOrder S{(const LAS int*)(lds + pg8::STAGE_BYTES), nullptr};
            pg8::EpiDown E{(bf16*)(w + WS_Y), q->b_down + (size_t)l * 32 * 1024, (const float*)(w + WS_GSLOT), 4};
            pg8::gemm_phase<pg8::EpiDown, pg8::MoeOrder, true, true, true, W8_E8M0>(lds, g, S, E, wave0);
            SEAM(pb + PH_DOWN);
        }
        if (IN(pb + PH_COMB)) { PH_IDS KP q = load_params(); float* xout = (l == DEPTH - 1) ? q->out : (float*)(q->ws + WS_XCUR); comb_phase(q, l, xout, G, wave, lane); SEAM(pb + PH_COMB); }
    }
#undef IN
#undef SEAM
}

#ifndef DBG
#define DBG 0
#endif
#if DBG
constexpr int CW_DBG = 64;
__device__ __forceinline__ unsigned hsh(unsigned a) { a ^= a >> 16; a *= 0x7feb352du; a ^= a >> 15; a *= 0x846ca68bu; a ^= a >> 16; return a; }
__device__ __forceinline__ void dbg_fail(Params& p, int id) { atomicMin((int*)(p.ws + WS_CTL) + CW_DBG, id); }
__device__ __forceinline__ bool bad(float a, float ref, float rel, float abs_) { return !(fabsf(a - ref) <= rel * fabsf(ref) + abs_); }
__device__ __forceinline__ float dotx(const float* xr, const float* W, int ld, int col, int K) { float s = 0.f; for (int k = 0; k < K; ++k) s += xr[k] * W[(size_t)k * ld + col]; return s; }

__global__ void __launch_bounds__(64) chk(Params p, int l, int which) {
    __shared__ float Ssh[64 * 65];
    unsigned char* ws = p.ws; const int gt_ = blockIdx.x * 64 + threadIdx.x; const unsigned h0 = hsh(gt_ * 2654435761u + which * 97u + 12345u), h1 = hsh(h0 + 0x9e3779b9u), h2 = hsh(h1 + 77u);
    const float* xin = (l == 0) ? p.x : (const float*)(ws + WS_XCUR);
    const bf16* Z = (const bf16*)(ws + WS_Z);
    const int id = (l * 20 + which) * 4;
    const float* win = p.w_in + (size_t)l * 1024 * D_IN;
    if (which == 1) {
        const int t = h0 % NTOK, n = h1 % D_IN; const int sc = zcol_src(n); const float scale = (n < 512 || (n >= Z_FQ && n < Z_FK)) ? QSCALE : 1.f;
        const float ref = dotx(xin + (size_t)t * DM, win, D_IN, sc, 1024) * scale;
        if (bad(bf2f(Z[(size_t)t * ZP + n]), ref, 0.03f, 0.03f)) dbg_fail(p, id);
    } else if (which == 2) {
        const int t = h0 % NTOK, pos = t & (SEQ - 1), b = t >> 13; const float* xr = xin + (size_t)t * DM;
        { const int hh = h1 % 21, i = h2 & 31; const int col = hh < 8 ? Z_AQ + hh * 64 : hh < 16 ? Z_AK + (hh - 8) * 64 : hh < 20 ? Z_IQ + (hh - 16) * 64 : Z_IK;
          const float sc = hh < 8 ? QSCALE : 1.f; const float t1 = dotx(xr, win, D_IN, zcol_src(col + i), 1024) * sc, t2 = dotx(xr, win, D_IN, zcol_src(col + i + 32), 1024) * sc;
          const float inv = powf(10000.f, -(float)i / 32.f); const float ang = (float)pos * inv; const double rev = (double)ang * 0.15915494309189535; const float fr = (float)(rev - __builtin_rint(rev));
          const float c = __builtin_amdgcn_cosf(fr), s = __builtin_amdgcn_sinf(fr);
          if (bad(bf2f(Z[(size_t)t * ZP + col + i]), t1 * c - t2 * s, 0.03f, 0.03f) || bad(bf2f(Z[(size_t)t * ZP + col + i + 32]), t2 * c + t1 * s, 0.03f, 0.03f)) dbg_fail(p, id); }
        { const int c = h2 % 1024; const float a0 = dotx(xr, win, D_IN, 5452 + c, 1024), a1 = dotx(xr, win, D_IN, 5452 + 1024 + c, 1024), a2 = dotx(xr, win, D_IN, 5452 + 2048 + c, 1024);
          const float g0 = sigmoidf_(a0), g1 = sigmoidf_(a1), g2 = sigmoidf_(a2);
          if (bad(bf2f(Z[(size_t)t * ZP + Z_GT + c]), g0 / g1, 0.05f, 0.01f) || bad(bf2f(Z[(size_t)t * ZP + Z_GT + 1024 + c]), g1 / g2, 0.05f, 0.01f) || bad(bf2f(Z[(size_t)t * ZP + Z_GT + 2048 + c]), g2, 0.05f, 0.01f)) dbg_fail(p, id + 1); }
        { const int hh = h1 & 7; const float v = dotx(xr, win, D_IN, 3396 + hh, 1024) + p.b_fox[l * 8 + hh]; const float ls = -log1pf(expf(-v)) * LOG2E;
          if (bad(((const float*)(ws + WS_LFT))[(size_t)(b * 8 + hh) * SEQ + pos], ls, 0.05f, 0.003f)) dbg_fail(p, id + 2); }
    } else if (which == 3) {
        { const int bh = h0 & 31, t = h1 % SEQ; const float* lf = (const float*)(ws + WS_LFT) + (size_t)bh * SEQ; float s = 0.f; for (int i = 0; i <= t; ++i) s += lf[i];
          if (bad(((const float*)(ws + WS_CT))[(size_t)bh * SEQ + t], s, 1e-3f, 1e-2f)) dbg_fail(p, id); }
        if (gt_ < 192) { const int b = h1 & 3, q = (gt_ < 32) ? (int)(h2 % 512) : (int)(h2 % SEQ); const int nadm = ((q >> 6) + 1) * 64; const u64* mw = (const u64*)(ws + WS_MASKW) + (size_t)(b * SEQ + q) * 128;
          int pc = 0; bool oob = false; for (int w = 0; w < 128; ++w) { const u64 m = mw[w]; pc += __popcll(m); if (w * 64 >= nadm && m) oob = true; }
          if (pc != (nadm < 256 ? nadm : 256) || oob) dbg_fail(p, id + 1);
          const bf16* qr = Z + (size_t)(b * SEQ + q) * ZP; float minsel = 3e38f, maxun = -3e38f;
          for (int s = 0; s < nadm; ++s) { const bf16* kr = Z + (size_t)(b * SEQ + s) * ZP + Z_IK; float sc = 0.f;
              for (int hd = 0; hd < 4; ++hd) { float d = 0.f; for (int k = 0; k < 64; ++k) d += bf2f(qr[Z_IQ + hd * 64 + k]) * bf2f(kr[k]); sc += bf2f(qr[Z_IW + hd]) * 0.0625f * fmaxf(d, 0.f); }
              if ((mw[s >> 6] >> (s & 63)) & 1ull) minsel = fminf(minsel, sc); else maxun = fmaxf(maxun, sc); }
          if (nadm > 256 && !(maxun <= minsel + 0.02f * fabsf(minsel) + 2e-3f)) dbg_fail(p, id + 2); }
    } else if (which == 4) {
        if (gt_ == 0 && l == 0) { const bf16* ob = (const bf16*)(ws + WS_OBUF) + 512;
            const float a0 = bf2f(ob[0]), a1 = bf2f(ob[1]), a3 = bf2f(ob[3]), b0 = bf2f(ob[8]), b1 = bf2f(ob[9]), b3 = bf2f(ob[11]), m0 = bf2f(ob[4]), m1 = bf2f(ob[12]);
            auto tr = [](float v) { return v == 0.f ? 0.f : v == 1.f ? 1.f : 2.f; };
            ((float*)(ws + WS_CTL))[CW_DBG + 2] = 10.f * (tr(a0) + 3.f * tr(b0) + 9.f * tr(a1) + 27.f * tr(b1));
            ((float*)(ws + WS_CTL))[CW_DBG + 3] = sqrtf(10.f * (tr(a3) + 3.f * tr(b3) + 9.f * (m0 == m1 ? 1.f : 0.f) + 27.f * (m0 > -1e20f ? 1.f : 0.f))); }
        const int mode = gt_ & 1, b = h0 & 3, h = (h0 >> 2) & 7, q = (gt_ < 64) ? (int)(h1 % 300) : (int)(h1 % SEQ), d = h2 & 63;
        const int QC = mode == 0 ? Z_FQ : Z_AQ, KC = mode == 0 ? Z_FK : Z_AK, VC = mode == 0 ? Z_FV : Z_AV, OC = mode == 0 ? 512 : 0;
        const bf16* qr = Z + (size_t)(b * SEQ + q) * ZP + QC + h * 64; const float* c = (const float*)(ws + WS_CT) + (size_t)(b * 8 + h) * SEQ; const u64* mw = (const u64*)(ws + WS_MASKW) + (size_t)(b * SEQ + q) * 128;
        const int ns = mode == 0 ? q + 1 : ((q >> 6) + 1) * 64; float mx = -3e38f, mx2 = -3e38f; float ref = 0.f, ref2 = 0.f;
        for (int pass = 0; pass < 2; ++pass) { float den = 0.f, num = 0.f, den2 = 0.f, num2 = 0.f;
            for (int s = 0; s < ns; ++s) { if (mode == 1 && !((mw[s >> 6] >> (s & 63)) & 1ull)) continue;
                const bf16* kr = Z + (size_t)(b * SEQ + s) * ZP + KC + h * 64; float lg = 0.f; for (int k = 0; k < 64; ++k) lg += bf2f(qr[k]) * bf2f(kr[k]);
                const float lg2 = lg; if (mode == 0) lg += c[q] - c[s];
                if (pass == 0) { mx = fmaxf(mx, lg); mx2 = fmaxf(mx2, lg2); } else { const float vv = bf2f(Z[(size_t)(b * SEQ + s) * ZP + VC + h * 64 + d]); const float pp = exp2f(lg - mx), pq = exp2f(lg2 - mx2); den += pp; num += pp * vv; den2 += pq; num2 += pq * vv; } }
            if (pass == 1) { ref = num / den; ref2 = num2 / den2; } }
        const float got = bf2f(((const bf16*)(ws + WS_OBUF))[(size_t)(b * SEQ + q) * OP + OC + h * 64 + d]);
        if (bad(got, ref, 0.04f, 0.03f)) { dbg_fail(p, id + mode);
            int m = 0; if (mode == 0 && q == 0) m |= 1; if (mode == 0 && q < 32) m |= 2; if (mode == 1 && q < 64) m |= 4; if (mode == 1 && q >= 64) m |= 8; atomicOr((int*)(p.ws + WS_CTL) + CW_DBG + 1, m); }
    } else if (which == 7) {
        const int b = blockIdx.x & 3, h = (blockIdx.x >> 2) & 7, e = threadIdx.x;
        for (int d = 0; d < 64; ++d) Ssh[d * 65 + e] = 0.f;
        const float lbv_e = 0.f; (void)lbv_e;
        for (int t = 0; t < 200; ++t) { const bf16* zr = Z + (size_t)(b * SEQ + t) * ZP + h * 64; float o = 0.f; const float ve = bf2f(zr[Z_CI + e]);
            for (int d = 0; d < 64; ++d) { const int dd = h * 64 + d; const float lb = (l == 0) ? 0.f : sigmoidf_(p.lb_logits[512 + dd] - p.lb_logits[dd]);
                const float sg = sigmoidf_(bf2f(zr[Z_CF + d])); const float f = lb + (1.f - lb) * sg, kk = (1.f - lb) * (1.f - sg);
                const float S = f * Ssh[d * 65 + e] + kk * ve; Ssh[d * 65 + e] = S; o += bf2f(zr[Z_CQ + d]) * S; }
            const float ss = wave_sum(o * o); const float ref = o * (1.f / sqrtf(ss * (1.f / 64.f) + RMS_EPS)) * p.norm_g[l * 512 + h * 64 + e] * sigmoidf_(bf2f(zr[Z_CG + e]));
            if (bad(bf2f(((const bf16*)(ws + WS_OBUF))[(size_t)(b * SEQ + t) * OP + 1024 + h * 64 + e]), ref, 0.06f, 0.05f)) { const int n = atomicAdd((int*)(p.ws + WS_CTL) + CW_DBG + 4 + (t >= 64 ? 1 : 0), 1); if (n >= 40) dbg_fail(p, id + (t >= 64 ? 1 : 0)); } }
    } else if (which == 8) {
        const int t = h0 % NTOK, c = h1 % 1024; const bf16* zr = Z + (size_t)t * ZP + Z_GT; const float g2 = bf2f(zr[2048 + c]), g1 = bf2f(zr[1024 + c]) * g2, g0 = bf2f(zr[c]) * g1;
        const bf16* ob = (const bf16*)(ws + WS_OBUF) + (size_t)t * OP; float sa = 0.f, sb = 0.f, sc = 0.f;
        for (int k = 0; k < 512; ++k) { sa += bf2f(ob[k]) * p.w_pa[((size_t)l * 512 + k) * 1024 + c]; sb += bf2f(ob[512 + k]) * p.w_pb[((size_t)l * 512 + k) * 1024 + c]; sc += bf2f(ob[1024 + k]) * p.w_pc[((size_t)l * 512 + k) * 1024 + c]; }
        if (bad(bf2f(((const bf16*)(ws + WS_MERGED))[(size_t)t * 1024 + c]), g0 * sa + g1 * sb + g2 * sc, 0.04f, 0.01f)) dbg_fail(p, id);
    } else if (which == 9) {
        const int t = h0 % NTOK, c = h1 % 1024; const bf16* mr = (const bf16*)(ws + WS_MERGED) + (size_t)t * 1024; float s = 0.f;
        for (int k = 0; k < 1024; ++k) s += bf2f(mr[k]) * p.w_out[((size_t)l * 1024 + k) * 1024 + c];
        if (bad(((const float*)(ws + WS_MIX))[(size_t)t * 1024 + c], s, 0.03f, 0.005f)) dbg_fail(p, id);
    } else if (which == 10) {
        const int t = h0 % NTOK, c = h1 % 1024; const float* xr = xin + (size_t)t * DM; const float* mr = (const float*)(ws + WS_MIX) + (size_t)t * DM; const float* x1 = (const float*)(ws + WS_X1) + (size_t)t * DM;
        float mean = 0.f; for (int k = 0; k < 1024; ++k) mean += ALPHA * xr[k] + mr[k]; mean *= (1.f / 1024.f);
        float var = 0.f; for (int k = 0; k < 1024; ++k) { const float dlt = ALPHA * xr[k] + mr[k] - mean; var += dlt * dlt; } var *= (1.f / 1024.f);
        const float ref = (ALPHA * xr[c] + mr[c] - mean) / sqrtf(var + LN_EPS) * p.ln1_g[l * 1024 + c] + p.ln1_b[l * 1024 + c];
        if (bad(x1[c], ref, 1e-3f, 1e-3f) || bad(bf2f(((const bf16*)(ws + WS_X1B))[(size_t)t * DM + c]), ref, 0.01f, 0.01f)) dbg_fail(p, id);
        float tv0 = -3e38f, tv1 = -3e38f, tv2 = -3e38f, tv3 = -3e38f; int ti0 = -1, ti1 = -1, ti2 = -1, ti3 = -1;
        for (int e = 0; e < 32; ++e) { float lg = p.b_router[l * 32 + e]; for (int k = 0; k < 1024; ++k) lg += x1[k] * p.w_router[((size_t)l * 1024 + k) * 32 + e];
            if (lg > tv0) { tv3 = tv2; ti3 = ti2; tv2 = tv1; ti2 = ti1; tv1 = tv0; ti1 = ti0; tv0 = lg; ti0 = e; } else if (lg > tv1) { tv3 = tv2; ti3 = ti2; tv2 = tv1; ti2 = ti1; tv1 = lg; ti1 = e; }
            else if (lg > tv2) { tv3 = tv2; ti3 = ti2; tv2 = lg; ti2 = e; } else if (lg > tv3) { tv3 = lg; ti3 = e; } }
        const int* tke = (const int*)(ws + WS_TKE) + t * 4; const float* tkg = (const float*)(ws + WS_TKG) + t * 4;
        const float den = 1.f + expf(tv1 - tv0) + expf(tv2 - tv0) + expf(tv3 - tv0);
        if (tv2 - tv3 > 1e-3f && tv1 - tv2 > 1e-3f && tv0 - tv1 > 1e-3f) { if (tke[0] != ti0 || tke[1] != ti1 || tke[2] != ti2 || tke[3] != ti3) dbg_fail(p, id + 1);
            if (bad(tkg[0], 1.f / den, 1e-2f, 1e-3f) || bad(tkg[3], expf(tv3 - tv0) / den, 1e-2f, 1e-3f)) dbg_fail(p, id + 2); }
    } else if (which == 11) {
        const int t = h0 % NTOK, k = h1 & 3, c = h2 % 1024; const int slot = ((const int*)(ws + WS_TOKSLOT))[t * 4 + k], e = ((const int*)(ws + WS_TKE))[t * 4 + k]; const int* blk = (const int*)(ws + WS_BLK);
        if (slot < 0 || slot >= blk[0] * 256 || blk[0] > MAXBLK) { dbg_fail(p, id); return; }
        if (blk[16 + (slot >> 8)] != e) dbg_fail(p, id + 1);
        if (((const float*)(ws + WS_GSLOT))[slot] != ((const float*)(ws + WS_TKG))[t * 4 + k]) dbg_fail(p, id + 2);
        if (((const bf16*)(ws + WS_XG))[(size_t)slot * DM + c] != ((const bf16*)(ws + WS_X1B))[(size_t)t * DM + c]) dbg_fail(p, id + 3);
    } else if (which == 12) {
        const int t = h0 % NTOK, k = h1 & 3, j = h2 % 1024; const int slot = ((const int*)(ws + WS_TOKSLOT))[t * 4 + k], e = ((const int*)(ws + WS_TKE))[t * 4 + k];
        const bf16* xr = (const bf16*)(ws + WS_XG) + (size_t)slot * DM; const float* W = p.w_gu + (size_t)(l * 32 + e) * 1024 * 2048; float g = p.b_gu[(size_t)(l * 32 + e) * 2048 + j], u = p.b_gu[(size_t)(l * 32 + e) * 2048 + 1024 + j];
        for (int kk = 0; kk < 1024; ++kk) { const float xv = bf2f(xr[kk]); g += xv * W[(size_t)kk * 2048 + j]; u += xv * W[(size_t)kk * 2048 + 1024 + j]; }
        g = fminf(g, 7.f); u = fminf(fmaxf(u, -7.f), 7.f); const float ref = g * sigmoidf_(1.702f * g) * (u + 1.f);
        if (bad(bf2f(((const bf16*)(ws + WS_ACT))[(size_t)slot * 1024 + j]), ref, 0.04f, 0.02f)) dbg_fail(p, id);
    } else if (which == 13) {
        const int t = h0 % NTOK, k = h1 & 3, n = h2 % 1024; const int slot = ((const int*)(ws + WS_TOKSLOT))[t * 4 + k], e = ((const int*)(ws + WS_TKE))[t * 4 + k];
        const bf16* ar = (const bf16*)(ws + WS_ACT) + (size_t)slot * 1024; const float* W = p.w_down + (size_t)(l * 32 + e) * 1024 * 1024; float s = p.b_down[(size_t)(l * 32 + e) * 1024 + n];
        for (int kk = 0; kk < 1024; ++kk) s += bf2f(ar[kk]) * W[(size_t)kk * 1024 + n];
        if (bad(bf2f(((const bf16*)(ws + WS_Y))[(size_t)slot * 1024 + n]), s * ((const float*)(ws + WS_GSLOT))[slot], 0.04f, 0.005f)) dbg_fail(p, id);
    } else if (which == 14) {
        const int t = h0 % NTOK, c = h1 % 1024; const float* x1 = (const float*)(ws + WS_X1) + (size_t)t * DM; const bf16* y = (const bf16*)(ws + WS_Y); const int* ts = (const int*)(ws + WS_TOKSLOT) + t * 4;
        const float* xo = ((l == DEPTH - 1) ? p.out : (float*)(ws + WS_XCUR)) + (size_t)t * DM;
        float mean = 0.f; for (int k = 0; k < 1024; ++k) { float v = ALPHA * x1[k]; for (int j = 0; j < 4; ++j) v += bf2f(y[(size_t)ts[j] * 1024 + k]); mean += v; } mean *= (1.f / 1024.f);
        float var = 0.f, vc = 0.f; for (int k = 0; k < 1024; ++k) { float v = ALPHA * x1[k]; for (int j = 0; j < 4; ++j) v += bf2f(y[(size_t)ts[j] * 1024 + k]); var += (v - mean) * (v - mean); if (k == c) vc = v; } var *= (1.f / 1024.f);
        if (bad(xo[c], (vc - mean) / sqrtf(var + LN_EPS) * p.ln2_g[l * 1024 + c] + p.ln2_b[l * 1024 + c], 2e-3f, 2e-3f)) dbg_fail(p, id);
    }
}
__global__ void dbg_init(Params p) { if (threadIdx.x == 0 && blockIdx.x == 0) { ((int*)(p.ws + WS_CTL))[CW_DBG] = 0x7fffffff; ((int*)(p.ws + WS_CTL))[CW_DBG + 1] = 0; ((int*)(p.ws + WS_CTL))[CW_DBG + 4] = 0; ((int*)(p.ws + WS_CTL))[CW_DBG + 5] = 0; } }
__global__ void dbg_fill(Params p, int n) {
    const int code = ((const int*)(p.ws + WS_CTL))[CW_DBG]; if (code == 0x7fffffff) return;
    const int sub = code & 3, lw = code >> 2, l = lw / 20, which = lw % 20; const int k = l * 16 + which + 32 * sub;
    const float c = sqrtf(exp2f((float)k));
    const int msk = ((const int*)(p.ws + WS_CTL))[CW_DBG + 1];
    for (int i = blockIdx.x * blockDim.x + threadIdx.x; i < n; i += gridDim.x * blockDim.x) p.out[i] = (i == 0) ? 16.f * (float)(1 + msk) : c;
}
#endif

extern "C" void kernel_launch(void* const* d_in, const int* in_sizes, int n_in, void* d_out, int out_size, void* d_ws, size_t ws_size, hipStream_t stream) {
    static int grid = 0;
    if (grid == 0) {
        if (n_in != 19 || ws_size < WS_END) { fprintf(stderr, "kernel_launch: need 19 inputs and >= %zu bytes of workspace; got %d, %zu\n", (size_t)WS_END, n_in, ws_size); grid = -1; return; }
        int dev = 0, cus = 0, per_cu = 0;
        if (hipGetDevice(&dev) != hipSuccess || hipDeviceGetAttribute(&cus, hipDeviceAttributeMultiprocessorCount, dev) != hipSuccess) { grid = -1; return; }
        if (hipFuncSetAttribute((const void*)fwd, hipFuncAttributeMaxDynamicSharedMemorySize, LDS_BYTES) != hipSuccess) { fprintf(stderr, "kernel_launch: hipFuncSetAttribute failed\n"); grid = -1; return; }
        if (hipOccupancyMaxActiveBlocksPerMultiprocessor(&per_cu, (const void*)fwd, NTHR, LDS_BYTES) != hipSuccess || per_cu < 1) fprintf(stderr, "kernel_launch: occupancy query reports %d\n", per_cu);
        (void)hipGetLastError();
        grid = cus;
    }
    if (grid < 0) return;
    (void)hipMemsetAsync((char*)d_ws + WS_CTL, 0, CTL_ZERO_BYTES, stream);
    Params p{};
    const float** f = (const float**)&p;
    for (int i = 0; i < 19; ++i) f[i] = (const float*)d_in[i];
    p.out = (float*)d_out; p.ws = (unsigned char*)d_ws;
#if ONE_LAUNCH
    p.ph_lo = 0; p.ph_hi = NPHASES; p.use_bar = 1; p.pad = 0;
    hipLaunchKernelGGL(fwd, dim3(grid), dim3(NTHR), LDS_BYTES, stream, p);
#else
#if DBG
    hipLaunchKernelGGL(dbg_init, dim3(1), dim3(64), 0, stream, p);
#endif
    for (int ph = 0; ph < NPHASES; ++ph) { p.ph_lo = ph; p.ph_hi = ph + 1; p.use_bar = 0; p.pad = 0;
        hipLaunchKernelGGL(fwd, dim3(grid), dim3(NTHR), LDS_BYTES, stream, p);
#if DBG
        if (ph >= 1) { const int l = (ph - 1) / NPH_LAYER, k = (ph - 1) % NPH_LAYER; static const int wmap[NPH_LAYER] = {1, 2, 3, 4, 0, 0, 7, 8, 9, 10, 11, 12, 13, 14}; const int w = wmap[k];
            if (w) { const int nb = (w == 7) ? 32 : (w == 3) ? 4 : (w == 4) ? 2 : 16; hipLaunchKernelGGL(chk, dim3(nb), dim3(64), 0, stream, p, l, w); } }
#endif
    }
#if DBG
    hipLaunchKernelGGL(dbg_fill, dim3(1024), dim3(256), 0, stream, p, out_size);
#endif
#endif
}
```

```cpp
#include <hip/hip_runtime.h>
#include <cstdio>
#include <cstdint>

#define GAS __attribute__((address_space(1)))
#define LAS __attribute__((address_space(3)))
typedef unsigned short bf16;
typedef short bf16x8 __attribute__((ext_vector_type(8)));
typedef short s16x4 __attribute__((ext_vector_type(4)));
typedef float f32x2 __attribute__((ext_vector_type(2)));
typedef float f32x4 __attribute__((ext_vector_type(4)));
typedef float f32x16 __attribute__((ext_vector_type(16)));
typedef unsigned u32x2 __attribute__((ext_vector_type(2)));
typedef unsigned u32x4 __attribute__((ext_vector_type(4)));
typedef unsigned long long u64;

__device__ __forceinline__ unsigned f2bf(float f) { unsigned u = __builtin_bit_cast(unsigned, f); return (u + 0x7fffu + ((u >> 16) & 1u)) >> 16; }
__device__ __forceinline__ unsigned pk2(float lo, float hi) { return f2bf(lo) | (f2bf(hi) << 16); }
__device__ __forceinline__ float bf2f(unsigned b) { return __builtin_bit_cast(float, b << 16); }
__device__ __forceinline__ float bflo(unsigned w) { return __builtin_bit_cast(float, w << 16); }
__device__ __forceinline__ float bfhi(unsigned w) { return __builtin_bit_cast(float, w & 0xffff0000u); }
__device__ __forceinline__ float sigmoidf_(float x) { return 1.0f / (1.0f + __expf(-x)); }

namespace pg8 {
#define PG8_LAS __attribute__((address_space(3)))
typedef unsigned short bf16_t;
typedef short bf16x8 __attribute__((ext_vector_type(8)));
typedef float f32x4 __attribute__((ext_vector_type(4)));
typedef unsigned u32x4 __attribute__((ext_vector_type(4)));
constexpr int BM = 256, BK = 64, HALF = 128, HTB = HALF * BK * 2  , STAGE_BYTES = 8 * HTB, NXCD = 8, WGM = 8;

__host__ __device__ __forceinline__ int lds_byte(int r, int c) { const int st = (r >> 4) * 2 + (c >> 5), rr = r & 15, cc = c & 31, ob = rr * 64 + cc * 2; return st * 1024 + (ob ^ (((ob >> 9) & 1) << 5)); }
__host__ __device__ __forceinline__ void stage_rc(int b, int& R, int& C) { const int st = b / 1024, sb = b % 1024, swz = sb ^ (((sb >> 9) & 1) << 5); R = (st >> 1) * 16 + swz / 64; C = (st & 1) * 32 + (swz % 64) / 2; }
__host__ __device__ __forceinline__ int perm32(int rho) { const int n = rho >> 4, i = rho & 15; return 8 * (i >> 2) + 4 * n + (i & 3); }

struct Unit { int pm, pn; };
struct Gemm { const bf16_t* A; const bf16_t* Bt; int M, N, K; };

struct StaticOrder {
    static constexpr bool GATHER = false; const int* tok = nullptr;
    int nM, nN, nwg, G, c;
    __host__ __device__ void init(int M, int N, int G_, int c_) { nM = M / BM; nN = N / BM; nwg = nM * nN; G = G_; c = c_; }
    __host__ __device__ bool next(int i, Unit& u) const {
        const long L = (long)i * G + c; if (L >= nwg) return false;
        int wgid = (int)L; { const int q = nwg / NXCD, r = nwg % NXCD, xcd = wgid % NXCD, off = wgid / NXCD; wgid = (xcd < r ? xcd * (q + 1) : r * (q + 1) + (xcd - r) * q) + off; }
        const int nig = WGM * nN, gid = wgid / nig, fm = gid * WGM, gsz = (nM - fm) < WGM ? (nM - fm) : WGM;
        u.pm = fm + ((wgid % nig) % gsz); u.pn = (wgid % nig) / gsz; return true;
    }
    __device__ __forceinline__ void a_ready(const Unit&) const {}
    __device__ __forceinline__ void done(const Unit&) const {}
};
template <bool GATHER_> struct MoeOrderT {
    static constexpr bool GATHER = GATHER_;
    const PG8_LAS int* list; const int* tok;
    __device__ bool next(int i, Unit& u) const {
        if (i >= __builtin_amdgcn_readfirstlane(list[0])) return false;
        u.pm = __builtin_amdgcn_readfirstlane(list[2 + 2 * i]); u.pn = __builtin_amdgcn_readfirstlane(list[3 + 2 * i]); return true;
    }
    __device__ __forceinline__ void a_ready(const Unit&) const {}
    __device__ __forceinline__ void done(const Unit&) const {}
};
typedef MoeOrderT<false> MoeOrder; typedef MoeOrderT<true> MoeOrderG;
__device__ __forceinline__ void moe_build_list(PG8_LAS int* list, const int* blk, int nN, int G, int c, int tid) {
    if (tid == 0) { const int* bst = blk + 16 + 544 + 16; int n = 0;
        if (G % 8 == 0) { const int W = G / 8, j = c / 8, x = c % 8;
            for (int i = 0; i < 64; ++i) { const int uu = i * W + j; const int bi = uu / nN, pl = uu - bi * nN; int rem = bi; bool ok = false;
                for (int k = 0; k < 4 && !ok; ++k) { const int e = x + 8 * k; const int b0 = bst[e], b1 = bst[e + 1]; if (rem < b1 - b0) { list[2 + 2 * n] = b0 + rem; list[3 + 2 * n] = e * nN + pl; ++n; ok = true; } else rem -= b1 - b0; }
                if (!ok) break; }
        } else { const int nb = bst[32];
            for (int i = 0; i < 64; ++i) { const int uu = i * G + c; const int bi = uu / nN, pl = uu - bi * nN; if (bi >= nb) break; int e = 0; for (int k = 1; k < 32; ++k) if (bi >= bst[k]) e = k; list[2 + 2 * n] = bi; list[3 + 2 * n] = e * nN + pl; ++n; } }
        list[0] = n; }
    asm volatile("s_waitcnt lgkmcnt(0)\n\ts_barrier" ::: "memory");
}

__device__ __forceinline__ unsigned cvt_pk_bf16(float lo, float hi) { unsigned r; asm volatile("v_cvt_pk_bf16_f32 %0, %1, %2" : "=v"(r) : "v"(lo), "v"(hi)); return r; }

struct EpiZ {
    static constexpr bool PERM = true, AFTER_DRAIN = false, MIDK = false;
    bf16_t* O; int ldc; const float* trig; bf16_t* IKC;
    __device__ __forceinline__ void operator()(const f32x4 (&acc)[2][2][4][2], const Unit& u, int wr, int wc, int fr, int fq) const {
        asm volatile("" : "+v"(fr), "+v"(fq));
        const int row0 = u.pm * BM + wr * 64 + fr; const int col0 = u.pn * BM + wc * 32 + 8 * fq;
        const bool rot_all = (u.pn < 4) || (u.pn == 32); const bool rot_b0 = rot_all || (u.pn == 33 && wc < 2);
        const int i0 = (wc & 1) * 16 + 4 * fq;
#pragma unroll
        for (int ai = 0; ai < 2; ++ai)
#pragma unroll
            for (int m = 0; m < 4; ++m) { const int row = row0 + ai * HALF + m * 16; bf16_t* rowp = O + (size_t)row * ldc + col0;
                f32x4 ca = {1.f, 0.f, 1.f, 0.f}, cb = {1.f, 0.f, 1.f, 0.f};
                if (rot_b0) { const float* tp = trig + ((size_t)(row & 8191) * 32 + i0) * 2; ca = *(const f32x4*)tp; cb = *(const f32x4*)(tp + 4); }
#pragma unroll
                for (int bj = 0; bj < 2; ++bj) { f32x4 v0 = acc[ai][bj][m][0], v1 = acc[ai][bj][m][1];
                    if (bj == 0 ? rot_b0 : rot_all) {
                        const f32x4 r0 = {v0[0] * ca[0] - v0[1] * ca[1], v0[1] * ca[0] + v0[0] * ca[1], v0[2] * ca[2] - v0[3] * ca[3], v0[3] * ca[2] + v0[2] * ca[3]};
                        const f32x4 r1 = {v1[0] * cb[0] - v1[1] * cb[1], v1[1] * cb[0] + v1[0] * cb[1], v1[2] * cb[2] - v1[3] * cb[3], v1[3] * cb[2] + v1[2] * cb[3]};
                        v0 = r0; v1 = r1; }
                    u32x4 w; w.x = cvt_pk_bf16(v0[0], v0[1]); w.y = cvt_pk_bf16(v0[2], v0[3]); w.z = cvt_pk_bf16(v1[0], v1[1]); w.w = cvt_pk_bf16(v1[2], v1[3]);
                    *(u32x4*)(rowp + bj * HALF) = w;
                    if (bj == 0 && u.pn == 33 && wc < 2) *(u32x4*)(IKC + (size_t)row * 64 + wc * 32 + 8 * fq) = w; } }
    }
};
struct EpiF32 {
    static constexpr bool PERM = true, AFTER_DRAIN = false, MIDK = false;
    float* O; int ldc;
    __device__ __forceinline__ void operator()(const f32x4 (&acc)[2][2][4][2], const Unit& u, int wr, int wc, int fr, int fq) const {
        asm volatile("" : "+v"(fr), "+v"(fq));
        const int row0 = u.pm * BM + wr * 64 + fr; const int col0 = u.pn * BM + wc * 32 + 8 * fq;
#pragma unroll
        for (int ai = 0; ai < 2; ++ai)
#pragma unroll
            for (int m = 0; m < 4; ++m) { float* rowp = O + (size_t)(row0 + ai * HALF + m * 16) * ldc + col0;
#pragma unroll
                for (int bj = 0; bj < 2; ++bj) { *(f32x4*)(rowp + bj * HALF) = acc[ai][bj][m][0]; *(f32x4*)(rowp + bj * HALF + 4) = acc[ai][bj][m][1]; } }
    }
};
struct EpiBf16 {
    static constexpr bool PERM = true, AFTER_DRAIN = false, MIDK = false;
    bf16_t* O; int ldc;
    __device__ __forceinline__ void operator()(const f32x4 (&acc)[2][2][4][2], const Unit& u, int wr, int wc, int fr, int fq) const {
        asm volatile("" : "+v"(fr), "+v"(fq));
        const int row0 = u.pm * BM + wr * 64 + fr; const int col0 = u.pn * BM + wc * 32 + 8 * fq;
#pragma unroll
        for (int ai = 0; ai < 2; ++ai)
#pragma unroll
            for (int m = 0; m < 4; ++m) { bf16_t* rowp = O + (size_t)(row0 + ai * HALF + m * 16) * ldc + col0;
#pragma unroll
                for (int bj = 0; bj < 2; ++bj) { const f32x4 v0 = acc[ai][bj][m][0], v1 = acc[ai][bj][m][1];
                    u32x4 w; w.x = cvt_pk_bf16(v0[0], v0[1]); w.y = cvt_pk_bf16(v0[2], v0[3]); w.z = cvt_pk_bf16(v1[0], v1[1]); w.w = cvt_pk_bf16(v1[2], v1[3]);
                    *(u32x4*)(rowp + bj * HALF) = w; } }
    }
};
struct EpiMerge {
    static constexpr bool PERM = true, AFTER_DRAIN = false, MIDK = true;
    const bf16_t* Gz; int gp; bf16_t* O; int ldc;
    __device__ __forceinline__ void scale(f32x4 (&acc)[2][2][4][2], const Unit& u, int idx, int wr, int wc, int fr, int fq) const {
        asm volatile("" : "+v"(fr), "+v"(fq));
        const int row0 = u.pm * BM + wr * 64 + fr; const int col0 = u.pn * BM + wc * 32 + 8 * fq;
        const int pa = (idx == 2) ? 2048 : (idx == 1) ? 2048 : 1024, pb = (idx == 1) ? 1024 : 0;
        u32x4 wa[2], wb[2], na[2], nb[2];
#define MG_LOAD(IT, WA, WB) do { const bf16_t* rowp_ = Gz + (size_t)(row0 + ((IT) >> 2) * HALF + ((IT) & 3) * 16) * gp + col0; \
            _Pragma("unroll") for (int bj = 0; bj < 2; ++bj) { WA[bj] = *(const u32x4*)(rowp_ + pa + bj * HALF); if (idx != 2) WB[bj] = *(const u32x4*)(rowp_ + pb + bj * HALF); else WB[bj] = WA[bj]; } } while (0)
        MG_LOAD(0, wa, wb);
#pragma unroll
        for (int it = 0; it < 8; ++it) { const int ai = it >> 2, m = it & 3;
            if (it + 1 < 8) MG_LOAD(it + 1, na, nb);
            asm volatile("" ::: "memory");
#pragma unroll
            for (int bj = 0; bj < 2; ++bj) { float s[8];
#pragma unroll
                for (int i = 0; i < 4; ++i) { const float ea0 = __expf(-bflo(wa[bj][i])), ea1 = __expf(-bfhi(wa[bj][i]));
                    if (idx == 2) { s[2 * i] = __builtin_amdgcn_rcpf(1.f + ea0); s[2 * i + 1] = __builtin_amdgcn_rcpf(1.f + ea1); }
                    else { const float eb0 = __expf(-bflo(wb[bj][i])), eb1 = __expf(-bfhi(wb[bj][i])); s[2 * i] = (1.f + ea0) * __builtin_amdgcn_rcpf(1.f + eb0); s[2 * i + 1] = (1.f + ea1) * __builtin_amdgcn_rcpf(1.f + eb1); } }
                acc[ai][bj][m][0] = acc[ai][bj][m][0] * (f32x4){s[0], s[1], s[2], s[3]}; acc[ai][bj][m][1] = acc[ai][bj][m][1] * (f32x4){s[4], s[5], s[6], s[7]}; }
#pragma unroll
            for (int bj = 0; bj < 2; ++bj) { wa[bj] = na[bj]; wb[bj] = nb[bj]; } }
#undef MG_LOAD
    }
    __device__ __forceinline__ void mid(f32x4 (&acc)[2][2][4][2], const Unit& u, int idx, int wr, int wc, int fr, int fq) const { scale(acc, u, idx, wr, wc, fr, fq); }
    __device__ __forceinline__ void operator()(f32x4 (&acc)[2][2][4][2], const Unit& u, int wr, int wc, int fr, int fq) const {
        scale(acc, u, 2, wr, wc, fr, fq);
        asm volatile("" : "+v"(fr), "+v"(fq));
        const int row0 = u.pm * BM + wr * 64 + fr; const int col0 = u.pn * BM + wc * 32 + 8 * fq;
#pragma unroll
        for (int ai = 0; ai < 2; ++ai)
#pragma unroll
            for (int m = 0; m < 4; ++m) { bf16_t* rowp = O + (size_t)(row0 + ai * HALF + m * 16) * ldc + col0;
#pragma unroll
                for (int bj = 0; bj < 2; ++bj) { const f32x4 v0 = acc[ai][bj][m][0], v1 = acc[ai][bj][m][1];
                    u32x4 w; w.x = cvt_pk_bf16(v0[0], v0[1]); w.y = cvt_pk_bf16(v0[2], v0[3]); w.z = cvt_pk_bf16(v1[0], v1[1]); w.w = cvt_pk_bf16(v1[2], v1[3]);
                    *(u32x4*)(rowp + bj * HALF) = w; } }
    }
};
struct EpiSwiGLU {
    static constexpr bool PERM = true, AFTER_DRAIN = false, MIDK = false;
    bf16_t* O; const float* bias; int nN;
    __device__ __forceinline__ void operator()(const f32x4 (&acc)[2][2][4][2], const Unit& u, int wr, int wc, int fr, int fq) const {
        const int e = u.pn / nN, pl = u.pn - e * nN;
        asm volatile("" : "+v"(fr), "+v"(fq));
        const int row0 = u.pm * BM + wr * 64 + fr; const int colt = pl * BM + wc * 32 + 8 * fq;
        const float* bp = bias + (size_t)e * 2048 + colt;
        f32x4 bv[2][2];
#pragma unroll
        for (int bj = 0; bj < 2; ++bj) { bv[bj][0] = *(const f32x4*)(bp + bj * HALF); bv[bj][1] = *(const f32x4*)(bp + bj * HALF + 4); }
#pragma unroll
        for (int ai = 0; ai < 2; ++ai)
#pragma unroll
            for (int m = 0; m < 4; ++m) { unsigned char* rowp = (unsigned char*)O + (size_t)(row0 + ai * HALF + m * 16) * 1024 + (colt >> 1);
#pragma unroll
                for (int bj = 0; bj < 2; ++bj) { const f32x4 v0 = acc[ai][bj][m][0] + bv[bj][0], v1 = acc[ai][bj][m][1] + bv[bj][1];
                    float a[4];
                    const float gt[4] = {v0[0], v0[2], v1[0], v1[2]}, up[4] = {v0[1], v0[3], v1[1], v1[3]};
#pragma unroll
                    for (int i = 0; i < 4; ++i) { const float g = fminf(gt[i], 7.0f); const float uu = fminf(fmaxf(up[i], -7.0f), 7.0f);
                        a[i] = g * (1.0f / (1.0f + __expf(-1.702f * g))) * (uu + 1.0f); }
                    int w8 = __builtin_amdgcn_cvt_pk_fp8_f32(a[0], a[1], 0, false); w8 = __builtin_amdgcn_cvt_pk_fp8_f32(a[2], a[3], w8, true);
                    *(unsigned*)(rowp + bj * (HALF / 2)) = (unsigned)w8; } }
    }
};
struct EpiDown {
    static constexpr bool PERM = true, AFTER_DRAIN = false, MIDK = false;
    bf16_t* O; const float* bias; const float* gate; int nN;
    __device__ __forceinline__ void operator()(const f32x4 (&acc)[2][2][4][2], const Unit& u, int wr, int wc, int fr, int fq) const {
        const int e = u.pn / nN, pl = u.pn - e * nN;
        asm volatile("" : "+v"(fr), "+v"(fq));
        const int row0 = u.pm * BM + wr * 64 + fr; const int colt = pl * BM + wc * 32 + 8 * fq;
        const float* bp = bias + (size_t)e * 1024 + colt;
        f32x4 bv[2][2];
#pragma unroll
        for (int bj = 0; bj < 2; ++bj) { bv[bj][0] = *(const f32x4*)(bp + bj * HALF); bv[bj][1] = *(const f32x4*)(bp + bj * HALF + 4); }
#pragma unroll
        for (int ai = 0; ai < 2; ++ai)
#pragma unroll
            for (int m = 0; m < 4; ++m) { const int row = row0 + ai * HALF + m * 16; const float gs = gate[row]; bf16_t* rowp = O + (size_t)row * 1024 + colt;
#pragma unroll
                for (int bj = 0; bj < 2; ++bj) { const f32x4 v0 = (acc[ai][bj][m][0] + bv[bj][0]) * gs, v1 = (acc[ai][bj][m][1] + bv[bj][1]) * gs;
                    u32x4 w; w.x = cvt_pk_bf16(v0[0], v0[1]); w.y = cvt_pk_bf16(v0[2], v0[3]); w.z = cvt_pk_bf16(v1[0], v1[1]); w.w = cvt_pk_bf16(v1[2], v1[3]);
                    *(u32x4*)(rowp + bj * HALF) = w; } }
    }
};

template <class Epi, class Sched, bool ALIGN_EPI = false, bool SP2 = false, bool FP8 = false, int SCALE_B = 127>
__device__ __forceinline__ void gemm_phase(PG8_LAS unsigned char* lds, const Gemm g, const Sched& S, const Epi& E, int wv) {
    int tid_l = (int)__builtin_amdgcn_mbcnt_hi(~0u, __builtin_amdgcn_mbcnt_lo(~0u, 0u)); asm volatile("" : "+v"(tid_l)); tid_l += wv * 64;
    const int tid = tid_l, wid = __builtin_amdgcn_readfirstlane(tid >> 6), lane = tid & 63, wr = wid >> 2, wc = wid & 3, fr = lane & 15, fq = lane >> 4;
    const int K = g.K; const int KB = FP8 ? K : 2 * K;
    const int nt = KB / (2 * BK);
    unsigned voffA[2], voffB[2];
#pragma unroll
    for (int i = 0; i < 2; ++i) { int R, C; stage_rc(tid * 16 + i * 8192, R, C); const int Rb = Epi::PERM ? ((R & ~31) + perm32(R & 31)) : R;
        voffA[i] = (unsigned)(R * KB + 2 * C); voffB[i] = (unsigned)(Rb * KB + 2 * C); }
    unsigned voGc[2][2]; PG8_LAS unsigned* voGn_l = (PG8_LAS unsigned*)(lds + STAGE_BYTES + 1024) + tid;
#define PG8_GOFF(dst, pmv) do { if constexpr (Sched::GATHER) { _Pragma("unroll") for (int _h = 0; _h < 2; ++_h) _Pragma("unroll") for (int _i = 0; _i < 2; ++_i) { \
        const unsigned _R = voffA[_i] / (unsigned)KB, _cb = voffA[_i] % (unsigned)KB; dst[_h][_i] = (unsigned)S.tok[(pmv) * BM + _h * HALF + (int)_R] * (unsigned)KB + _cb; } } } while (0)
    const size_t kstep = (size_t)(BK * 2);
    const size_t hstep = (size_t)HALF * KB;
    const size_t tstep = 2 * hstep;
    const unsigned ldsw = (unsigned)wid * 1024u;
    const int aoff = lds_byte(wr * 64 + fr, FP8 ? fq * 16 : fq * 8), boff = lds_byte(wc * 32 + fr, FP8 ? fq * 16 : fq * 8);
    const int aoff1 = FP8 ? lds_byte(wr * 64 + fr, fq * 16 + 8) - aoff : 1024, boff1 = FP8 ? lds_byte(wc * 32 + fr, fq * 16 + 8) - boff : 1024;
#define PG8_SA(b, h) (((b) * 2 + (h)) * HTB)
#define PG8_SB(b, h) ((4 + (b) * 2 + (h)) * HTB)
#define PG8_STAGE(bufoff, gbase, voff) do { _Pragma("unroll") for (int _i = 0; _i < 2; ++_i) \
        __builtin_amdgcn_global_load_lds((const unsigned*)((const char*)(gbase) + (voff)[_i]), (PG8_LAS unsigned*)(lds + (bufoff) + ldsw + _i * 8192), 16, 0, 0); } while (0)
#define PG8_STAGE_A(bufoff, base, h, nx) do { if constexpr (Sched::GATHER) { unsigned _vo[2] = {voGc[h][0], voGc[h][1]}; if (nx) { _vo[0] = voGn_l[((h) * 2 + 0) * 512]; _vo[1] = voGn_l[((h) * 2 + 1) * 512]; } PG8_STAGE(bufoff, base, _vo); } else { PG8_STAGE(bufoff, (base) + (h) * hstep, voffA); } } while (0)
#define PG8_LD8(dst8, n_, base_, off_, off1_) do { _Pragma("unroll") for (int q_ = 0; q_ < n_; ++q_) { const v4i_ lo_ = *(const PG8_LAS v4i_*)(lds + (base_) + (off_) + q_ * 2048), hi_ = *(const PG8_LAS v4i_*)(lds + (base_) + (off_) + q_ * 2048 + (off1_)); \
        dst8[q_] = __builtin_shufflevector(lo_, hi_, 0, 1, 2, 3, 4, 5, 6, 7); } } while (0)
#define PG8_LDA(dst, b, h) do { if constexpr (FP8) { PG8_LD8(dst##8, 4, PG8_SA(b, h), aoff, aoff1); } else { _Pragma("unroll") for (int m = 0; m < 4; ++m) _Pragma("unroll") for (int k = 0; k < 2; ++k) dst[m][k] = *(const PG8_LAS bf16x8*)(lds + PG8_SA(b, h) + aoff + m * 2048 + k * aoff1); } } while (0)
#define PG8_LDB(dst, b, h) do { if constexpr (FP8) { PG8_LD8(dst##8, 2, PG8_SB(b, h), boff, boff1); } else { _Pragma("unroll") for (int n = 0; n < 2; ++n) _Pragma("unroll") for (int k = 0; k < 2; ++k) dst[n][k] = *(const PG8_LAS bf16x8*)(lds + PG8_SB(b, h) + boff + n * 2048 + k * boff1); } } while (0)
#define PG8_MMA(ai, bj, At, Bt) do { if constexpr (FP8) __builtin_amdgcn_sched_barrier(0); __builtin_amdgcn_s_setprio(1); _Pragma("unroll") for (int m = 0; m < 4; ++m) _Pragma("unroll") for (int n = 0; n < 2; ++n) { \
        if constexpr (FP8) { asm volatile("v_mfma_scale_f32_16x16x128_f8f6f4 %0, %1, %2, %0, %3, %4 op_sel_hi:[0,0,0]" : "+v"(acc[ai][bj][m][n]) : "v"(Bt##8[n]), "v"(At##8[m]), "v"(sclB), "v"(sclA)); } \
        else { _Pragma("unroll") for (int k = 0; k < 2; ++k) acc[ai][bj][m][n] = __builtin_amdgcn_mfma_f32_16x16x32_bf16(Bt[n][k], At[m][k], acc[ai][bj][m][n], 0, 0, 0); } } \
        __builtin_amdgcn_s_setprio(0); if constexpr (FP8) __builtin_amdgcn_sched_barrier(0); } while (0)
#define PG8_WAIT_V(n) asm volatile("s_waitcnt vmcnt(" #n ")" ::: "memory")
#define PG8_WAIT_L(n) asm volatile("s_waitcnt lgkmcnt(" #n ")" ::: "memory")
#define PG8_BAR __builtin_amdgcn_s_barrier()
#define PG8_SCHED __builtin_amdgcn_sched_barrier(0)
    Unit cur, nxt; int ui = 0;
    if (!S.next(0, cur)) return;
    f32x4 acc[2][2][4][2];
#pragma unroll
    for (int a = 0; a < 2; ++a)
#pragma unroll
        for (int b = 0; b < 2; ++b)
#pragma unroll
            for (int m = 0; m < 4; ++m)
#pragma unroll
                for (int n = 0; n < 2; ++n) acc[a][b][m][n] = (f32x4){0.f, 0.f, 0.f, 0.f};
    bf16x8 At[4][2], B0[2][2], B1[2][2];
    typedef int v8i_ __attribute__((ext_vector_type(8))); typedef int v4i_ __attribute__((ext_vector_type(4)));
    int sclB = SCALE_B * 0x01010101, sclA = 0x7f7f7f7f; asm volatile("" : "+v"(sclB), "+v"(sclA));
    v8i_ At8[4], B08[2], B18[2];
    const char* cA = (const char*)g.A + (Sched::GATHER ? (size_t)0 : (size_t)cur.pm * tstep); const char* cB = (const char*)g.Bt + (size_t)cur.pn * tstep;
    PG8_GOFF(voGc, cur.pm);
    S.a_ready(cur);
    if constexpr (SP2) {
        PG8_STAGE(PG8_SB(0, 0), cB, voffB); PG8_STAGE(PG8_SB(0, 1), cB + hstep, voffB); PG8_STAGE_A(PG8_SA(0, 0), cA, 0, false); PG8_STAGE_A(PG8_SA(0, 1), cA, 1, false);
        if (wr == 1) PG8_BAR;
        PG8_WAIT_V(2); PG8_BAR;
        PG8_STAGE(PG8_SB(1, 0), cB + kstep, voffB); PG8_STAGE_A(PG8_SA(1, 0), cA + kstep, 0, false); PG8_STAGE(PG8_SB(1, 1), cB + hstep + kstep, voffB);
        PG8_WAIT_V(6); PG8_BAR;
    } else {
        PG8_STAGE(PG8_SB(0, 0), cB, voffB); PG8_STAGE_A(PG8_SA(0, 0), cA, 0, false); PG8_STAGE(PG8_SB(0, 1), cB + hstep, voffB); PG8_STAGE_A(PG8_SA(0, 1), cA, 1, false);
        if (wr == 1) PG8_BAR;
        PG8_WAIT_V(4); PG8_BAR;
        PG8_STAGE(PG8_SB(1, 0), cB + kstep, voffB); PG8_STAGE_A(PG8_SA(1, 0), cA + kstep, 0, false); PG8_STAGE(PG8_SB(1, 1), cB + hstep + kstep, voffB);
        PG8_WAIT_V(6); PG8_BAR;
    }
    for (;;) {
        const bool has_next = S.next(ui + 1, nxt);
        const char* nA = has_next ? (const char*)g.A + (Sched::GATHER ? (size_t)0 : (size_t)nxt.pm * tstep) : cA;
        if constexpr (Sched::GATHER) { unsigned _vn[2][2]; if (has_next) { PG8_GOFF(_vn, nxt.pm); } else { _Pragma("unroll") for (int _h = 0; _h < 2; ++_h) _Pragma("unroll") for (int _i = 0; _i < 2; ++_i) _vn[_h][_i] = voGc[_h][_i]; }
            _Pragma("unroll") for (int _h = 0; _h < 2; ++_h) _Pragma("unroll") for (int _i = 0; _i < 2; ++_i) voGn_l[(_h * 2 + _i) * 512] = _vn[_h][_i]; } const char* nB = has_next ? (const char*)g.Bt + (size_t)nxt.pn * tstep : cB;
        for (int t = 0; t < nt; t += 2) {
            const bool last = (t == nt - 2);
            const char* a1 = cA + (size_t)(t + 1) * kstep;
            const char* a2 = last ? nA : cA + (size_t)(t + 2) * kstep; const char* b2 = last ? nB : cB + (size_t)(t + 2) * kstep;
            const char* a3 = a2 + kstep; const char* b3 = b2 + kstep;
            if (last && has_next) S.a_ready(nxt);
            if constexpr (SP2) {
            PG8_LDB(B0, 0, 0); PG8_LDB(B1, 0, 1); PG8_SCHED; PG8_LDA(At, 0, 0); PG8_STAGE_A(PG8_SA(1, 1), a1, 1, false);
            PG8_WAIT_V(8); PG8_WAIT_L(0); PG8_BAR; PG8_MMA(0, 0, At, B0); PG8_MMA(0, 1, At, B1); PG8_BAR; PG8_SCHED;
            PG8_LDA(At, 0, 1); PG8_STAGE(PG8_SB(0, 0), b2, voffB); PG8_STAGE(PG8_SB(0, 1), b2 + hstep, voffB); PG8_STAGE_A(PG8_SA(0, 0), a2, 0, last);
            PG8_WAIT_V(8); PG8_WAIT_L(0); PG8_BAR; PG8_MMA(1, 0, At, B0); PG8_MMA(1, 1, At, B1); PG8_BAR; PG8_SCHED;
            PG8_LDB(B0, 1, 0); PG8_LDB(B1, 1, 1); PG8_SCHED; PG8_LDA(At, 1, 0); PG8_STAGE_A(PG8_SA(0, 1), a2, 1, last);
            PG8_WAIT_V(8); PG8_WAIT_L(0); PG8_BAR; PG8_MMA(0, 0, At, B0); PG8_MMA(0, 1, At, B1); PG8_BAR; PG8_SCHED;
            PG8_LDA(At, 1, 1); PG8_STAGE(PG8_SB(1, 0), b3, voffB); PG8_STAGE(PG8_SB(1, 1), b3 + hstep, voffB); PG8_STAGE_A(PG8_SA(1, 0), a3, 0, last);
            PG8_WAIT_V(8); PG8_WAIT_L(0); PG8_BAR; PG8_MMA(1, 0, At, B0); PG8_MMA(1, 1, At, B1); PG8_BAR; PG8_SCHED;
            } else {
            PG8_LDB(B0, 0, 0); PG8_SCHED; PG8_LDA(At, 0, 0); PG8_STAGE_A(PG8_SA(1, 1), a1, 1, false);
            PG8_WAIT_L(8); PG8_BAR; PG8_WAIT_L(0); PG8_MMA(0, 0, At, B0); PG8_BAR; PG8_SCHED;
            PG8_LDB(B1, 0, 1); PG8_STAGE(PG8_SB(0, 0), b2, voffB);
            PG8_BAR; PG8_WAIT_L(0); PG8_MMA(0, 1, At, B1); PG8_BAR;
            PG8_LDA(At, 0, 1); PG8_STAGE_A(PG8_SA(0, 0), a2, 0, last);
            PG8_BAR; PG8_WAIT_L(0); PG8_MMA(1, 0, At, B0); PG8_BAR; PG8_SCHED;
            PG8_STAGE(PG8_SB(0, 1), b2 + hstep, voffB);
            PG8_WAIT_V(6); PG8_BAR; PG8_MMA(1, 1, At, B1); PG8_BAR;
            PG8_LDB(B0, 1, 0); PG8_SCHED; PG8_LDA(At, 1, 0); PG8_STAGE_A(PG8_SA(0, 1), a2, 1, last);
            PG8_WAIT_L(8); PG8_BAR; PG8_WAIT_L(0); PG8_MMA(0, 0, At, B0); PG8_BAR; PG8_SCHED;
            PG8_LDB(B1, 1, 1); PG8_STAGE(PG8_SB(1, 0), b3, voffB);
            PG8_BAR; PG8_WAIT_L(0); PG8_MMA(0, 1, At, B1); PG8_BAR;
            PG8_LDA(At, 1, 1); PG8_STAGE_A(PG8_SA(1, 0), a3, 0, last);
            PG8_BAR; PG8_WAIT_L(0); PG8_MMA(1, 0, At, B0); PG8_BAR; PG8_SCHED;
            PG8_STAGE(PG8_SB(1, 1), b3 + hstep, voffB);
            PG8_WAIT_V(6); PG8_BAR; PG8_MMA(1, 1, At, B1); PG8_BAR;
            }
            if constexpr (Epi::MIDK) { if (((t + 2) & 7) == 0 && t + 2 < nt) E.mid(acc, cur, ((t + 2) >> 3) - 1, wr, wc, fr, fq); }
        }
        if constexpr (FP8) asm volatile("s_nop 15\n\ts_nop 15" ::: "memory");
        if constexpr (ALIGN_EPI) { if (wr == 0) PG8_BAR; }
        if constexpr (!Epi::AFTER_DRAIN) { E(acc, cur, wr, wc, fr, fq); S.done(cur); }
        if (!has_next) break;
#pragma unroll
        for (int a = 0; a < 2; ++a)
#pragma unroll
            for (int b = 0; b < 2; ++b)
#pragma unroll
                for (int m = 0; m < 4; ++m)
#pragma unroll
                    for (int n = 0; n < 2; ++n) acc[a][b][m][n] = (f32x4){0.f, 0.f, 0.f, 0.f};
        cur = nxt; cA = nA; cB = nB; ++ui;
        if constexpr (Sched::GATHER) { _Pragma("unroll") for (int _h = 0; _h < 2; ++_h) _Pragma("unroll") for (int _i = 0; _i < 2; ++_i) voGc[_h][_i] = voGn_l[(_h * 2 + _i) * 512]; }
        if constexpr (ALIGN_EPI) { if (wr == 1) PG8_BAR; }
    }
    PG8_WAIT_V(0);
    if constexpr (!ALIGN_EPI) { if (wr == 0) PG8_BAR; }
    PG8_BAR;
#undef PG8_SA
#undef PG8_SB
#undef PG8_STAGE
#undef PG8_STAGE_A
#undef PG8_GOFF
#undef PG8_LDA
#undef PG8_LD8
#undef PG8_LDB
#undef PG8_MMA
#undef PG8_WAIT_V
#undef PG8_WAIT_L
#undef PG8_BAR
#undef PG8_SCHED
}
}
constexpr int BATCH = 4, SEQ = 8192, DM = 1024, NTOK = BATCH * SEQ, DEPTH = 2, NEXP = 32;
constexpr int D_IN = 8524, ZP = 8704;
constexpr int Z_AQ = 0, Z_AK = 512, Z_AV = 1024, Z_FQ = 1536, Z_FK = 2048, Z_FV = 2560, Z_CQ = 3072, Z_CF = 3584, Z_CI = 4096, Z_CG = 4608, Z_GT = 5120, Z_IQ = 8192, Z_IK = 8448, Z_IW = 8512, Z_FF = 8516;
constexpr int OP = 1536;
constexpr int MAXBLK = 544, MAXSLOT = MAXBLK * 256;
constexpr int BST_OFF = 16 + MAXBLK + 16;
constexpr float LOG2E = 1.4426950408889634f;
constexpr float QSCALE = 0.125f * LOG2E;
constexpr float ALPHA = 1.4142135623730951f;
constexpr float LN_EPS = 1e-5f, RMS_EPS = 1e-6f;
constexpr int NWAVES = 8, NTHR = 512;
constexpr float W8_SCALE = 64.0f; constexpr int W8_E8M0 = 127 - 6;
constexpr int NPH_LAYER = 14, NPHASES = 1 + DEPTH * NPH_LAYER;
enum { PH_INPROJ = 0, PH_PREP, PH_IDX, PH_ATTN, PH_H1, PH_H2, PH_H3, PH_MERGE, PH_WOUT, PH_LN1, PH_SLOT, PH_GU, PH_DOWN, PH_COMB };

__host__ __device__ __forceinline__ int zcol_src(int n) {
    if (n < 1024 || (n >= 8192 && n < 8512)) { const int p = n & 63; n = (n & ~63) + ((p & 1) ? 32 + (p >> 1) : (p >> 1)); }
    if (n < 1536) return n;
    if (n < 3072) return 1860 + (n - 1536);
    if (n < 5120) return 3404 + (n - 3072);
    if (n < 8192) return 5452 + (n - 5120);
    if (n < 8448) return 1536 + (n - 8192);
    if (n < 8512) return 1792 + (n - 8448);
    if (n < 8516) return 1856 + (n - 8512);
    if (n < 8524) return 3396 + (n - 8516);
    return -1;
}

constexpr size_t MiB = 1u << 20;
constexpr size_t WS_CTL = 0, CTL_ZERO_BYTES = 1 * MiB;
constexpr size_t WS_TRIG = 1 * MiB;
constexpr size_t WS_LFT = 3 * MiB;
constexpr size_t WS_CT = 4 * MiB;
constexpr size_t WS_DG = 5 * MiB, WS_D2G = 6 * MiB;
constexpr size_t WS_WGCNT = 7 * MiB;
constexpr size_t WS_BLK = 7 * MiB + 64 * 1024;
constexpr size_t WS_BGU = 7 * MiB + 128 * 1024;
constexpr size_t WS_TKE = 8 * MiB, WS_TKG = 8 * MiB + 512 * 1024, WS_TOKSLOT = 9 * MiB, WS_GSLOT = 9 * MiB + 512 * 1024;
constexpr size_t WS_SLOTTOK = 10 * MiB + 512 * 1024;
constexpr size_t WS_WRF = 11 * MiB;
constexpr size_t WS_WIN = 12 * MiB;
constexpr size_t WS_WP = 46 * MiB;
constexpr size_t WS_WOUT = 52 * MiB;
constexpr size_t WS_WGU = 56 * MiB;
constexpr size_t WS_WDN = 312 * MiB;
constexpr size_t WS_Z = 440 * MiB;
constexpr size_t WS_XG = WS_Z, WS_ACT = WS_Z + 272 * MiB;
constexpr size_t WS_OBUF = 984 * MiB;
constexpr size_t WS_MERGED = 1080 * MiB;
constexpr size_t WS_MIX = 1144 * MiB;
constexpr size_t WS_Y = WS_OBUF;
constexpr size_t WS_X1 = 1272 * MiB;
constexpr size_t WS_X1B = 1400 * MiB;
constexpr size_t WS_XCUR = 1464 * MiB;
constexpr size_t WS_XB = 1592 * MiB;
constexpr size_t WS_MASKW = 1656 * MiB;
constexpr size_t WS_UG = 1688 * MiB;
constexpr size_t WS_SST = 1752 * MiB;
constexpr size_t WS_SB = 7 * MiB + 768 * 1024;
constexpr size_t WS_KA = 1784 * MiB;
constexpr size_t WS_IKC = 184 * MiB;
constexpr size_t WS_END = 1792 * MiB;
static_assert(WS_Y + (size_t)MAXSLOT * 1024 * 2 <= WS_X1 && WS_ACT + (size_t)MAXSLOT * 1024 * 2 <= WS_OBUF, "ws map");
constexpr int CW_TMO = 0;
constexpr int CW_BAR = 4096;
constexpr int CW_SB = 512;

constexpr int SCR_BYTES = 153600;
constexpr int MISC_OFF = SCR_BYTES;
constexpr int LDS_BYTES = SCR_BYTES + 256;

#define RLX_AGENT __ATOMIC_RELAXED, __HIP_MEMORY_SCOPE_AGENT
#define LDS_WAIT() asm volatile("s_waitcnt lgkmcnt(0)" ::: "memory")
#define VM_WAIT() asm volatile("s_waitcnt vmcnt(0)" ::: "memory")
#define WG_BAR() asm volatile("s_waitcnt vmcnt(0) lgkmcnt(0)\n\ts_barrier" ::: "memory")
#define WG_BAR_LDS() asm volatile("s_waitcnt lgkmcnt(0)\n\ts_barrier" ::: "memory")

#define XB_TMO      128
#define XB_XCNT(j)  (256  + 64 * (j))
#define XB_XSUB(j)  (1280 + 64 * (j))
#define XB_XGEN(j)  (2304 + 64 * (j))
#define XB_TOP      3328
#define XB_TOPGEN   3392
#define XCD_BAR_WORDS 3456
#define XB_SPIN_CAP (1u << 18)

__device__ __forceinline__ unsigned xb_ld(unsigned* p)              { return __hip_atomic_load(p, __ATOMIC_RELAXED, __HIP_MEMORY_SCOPE_AGENT); }
__device__ __forceinline__ unsigned xb_add(unsigned* p, unsigned v) { return __hip_atomic_fetch_add(p, v, __ATOMIC_RELAXED, __HIP_MEMORY_SCOPE_AGENT); }
__device__ __forceinline__ unsigned xb_xcc_id() { return (unsigned)__builtin_amdgcn_s_getreg((3 << 11) | 20) & 0xFu; }
#define XB_SPIN(cond, bar) do { unsigned _sp = 0; while (cond) { __builtin_amdgcn_s_sleep(1); \
    if ((++_sp & 255u) == 0u) { if (xb_ld(&(bar)[XB_TMO])) break; if (_sp > XB_SPIN_CAP) { atomicAdd(&(bar)[XB_TMO], 1u); break; } } } } while (0)

struct XcdBarrier {
    unsigned* bar; unsigned x;
    volatile LAS unsigned* st;
};

__device__ __forceinline__ XcdBarrier xcd_barrier_post(unsigned* bar, volatile LAS unsigned* st) {
    XcdBarrier b; b.bar = bar; b.x = xb_xcc_id(); b.st = st;
    if (threadIdx.x == 0) (void)xb_add(&bar[XB_XCNT(b.x)], 1u);
    return b;
}
__device__ __forceinline__ void xcd_barrier_complete(unsigned* bar, unsigned x, unsigned& nloc, unsigned& nx) {
    const unsigned G = gridDim.x * gridDim.y * gridDim.z;
    unsigned sum, cnt, mine, sp = 0u;
    for (;;) {
        sum = 0u; cnt = 0u; mine = 0u;
#pragma unroll
        for (unsigned j = 0; j < 16; ++j) { const unsigned c = xb_ld(&bar[XB_XCNT(j)]); sum += c; cnt += (c > 0u) ? 1u : 0u; mine = (j == x) ? c : mine; }
        if (sum == G) break;
        __builtin_amdgcn_s_sleep(1);
        if ((++sp & 255u) == 0u) { if (xb_ld(&bar[XB_TMO])) break; if (sp > XB_SPIN_CAP) { atomicAdd(&bar[XB_TMO], 1u); break; } }
    }
    nloc = mine > 0u ? mine : 1u; nx = cnt > 0u ? cnt : 1u;
}

__device__ __forceinline__ void xcd_barrier(const XcdBarrier& b) {
    asm volatile("s_waitcnt vmcnt(0)" ::: "memory");
    __syncthreads();
    if (threadIdx.x == 0) {
        unsigned* bar = b.bar;
        __builtin_amdgcn_s_waitcnt(0);
        unsigned nloc = b.st[0], nx = b.st[1];
        if (nloc == 0u) { xcd_barrier_complete(bar, b.x, nloc, nx); b.st[0] = nloc; b.st[1] = nx; }
        const unsigned old = xb_add(&bar[XB_XSUB(b.x)], 1u);
        const unsigned gen = old / nloc;
        if (old + 1u == (gen + 1u) * nloc) {
            __builtin_amdgcn_fence(__ATOMIC_RELEASE, "agent");
            asm volatile("s_waitcnt vmcnt(0)" ::: "memory");
            const unsigned og = xb_add(&bar[XB_TOP], 1u);
            const unsigned tg = og / nx;
            if (og + 1u == (tg + 1u) * nx) xb_add(&bar[XB_TOPGEN], 1u);
            else XB_SPIN(xb_ld(&bar[XB_TOPGEN]) == tg, bar);
            __builtin_amdgcn_fence(__ATOMIC_ACQUIRE, "agent");
            xb_add(&bar[XB_XGEN(b.x)], 1u);
            asm volatile("s_waitcnt vmcnt(0)" ::: "memory");
        } else {
            XB_SPIN(xb_ld(&bar[XB_XGEN(b.x)]) == gen, bar);
            __builtin_amdgcn_fence(__ATOMIC_ACQUIRE, "agent");
            asm volatile("s_waitcnt vmcnt(0)" ::: "memory");
        }
    }
    __syncthreads();
}
__device__ __forceinline__ int lane_id() { int l = (int)__builtin_amdgcn_mbcnt_hi(~0u, __builtin_amdgcn_mbcnt_lo(~0u, 0u)); asm volatile("" : "+v"(l)); return l; }
__device__ __forceinline__ float wave_sum(float v) {
#pragma unroll
    for (int o = 1; o < 64; o <<= 1) v += __shfl_xor(v, o);
    return v;
}
__device__ __forceinline__ int crow(int r, int hi) { return (r & 3) + 8 * (r >> 2) + 4 * hi; }
__device__ __forceinline__ void glds16(const void* gsrc, unsigned lds_dst) { unsigned keep;
    asm volatile("s_mov_b32 %0, m0\n\ts_mov_b32 m0, %2\n\ts_nop 0\n\tglobal_load_lds_dwordx4 %1, off\n\ts_mov_b32 m0, %0" : "=&s"(keep) : "v"(gsrc), "s"(lds_dst) : "memory"); }
__device__ __forceinline__ void glds4(const void* gsrc, unsigned lds_dst) { unsigned keep;
    asm volatile("s_mov_b32 %0, m0\n\ts_mov_b32 m0, %2\n\ts_nop 0\n\tglobal_load_lds_dword %1, off\n\ts_mov_b32 m0, %0" : "=&s"(keep) : "v"(gsrc), "s"(lds_dst) : "memory"); }
typedef __bf16 bf16x2_t __attribute__((ext_vector_type(2)));
__device__ __forceinline__ unsigned cvtpk(float lo, float hi) { const f32x2 v = {lo, hi}; const bf16x2_t b = __builtin_convertvector(v, bf16x2_t); return __builtin_bit_cast(unsigned, b); }
typedef short v4i16_t __attribute__((ext_vector_type(4)));
__device__ __forceinline__ s16x4 vtr(const LAS char* p) { return __builtin_bit_cast(s16x4, __builtin_amdgcn_ds_read_tr16_b64_v4i16((LAS v4i16_t*)p)); }
__device__ __forceinline__ void plswap(float& a, float& b) { asm volatile("s_nop 1\n\tv_permlane32_swap_b32 %0, %1\n\ts_nop 1" : "+v"(a), "+v"(b)); }
__device__ __forceinline__ float swapmax(float m) { float a = m, b = m; plswap(a, b); return fmaxf(a, b); }
__device__ __forceinline__ float swapsum(float m) { float a = m, b = m; plswap(a, b); return a + b; }
#define MFMA32(a, b, c) __builtin_amdgcn_mfma_f32_32x32x16_bf16((a), (b), (c), 0, 0, 0)

struct Params {
    const float* x; const float* w_in; const float* b_fox; const float* lb_logits; const float* norm_g; const float* w_pa; const float* w_pb; const float* w_pc; const float* w_out;
    const float* ln1_g; const float* ln1_b; const float* w_router; const float* b_router; const float* w_gu; const float* b_gu; const float* w_down; const float* b_down; const float* ln2_g; const float* ln2_b;
    float* out; unsigned char* ws; int ph_lo, ph_hi, use_bar, pad;
};

typedef const __attribute__((address_space(4))) Params* KP;
__device__ __forceinline__ KP load_params() { KP kp = (KP)__builtin_amdgcn_kernarg_segment_ptr(); asm volatile("" : "+s"(kp)); return kp; }

template <class F> __device__ __forceinline__ void cvt_tile(const float* W, size_t ldsrc, int k0, bf16* WT, size_t ldw, int kd0, int n0, const F& f, LAS float* scr, int lane) {
    const int c = lane & 31; int sc; float scale; f(n0 + c, sc, scale);
#pragma unroll 8
    for (int i = 0; i < 32; ++i) { const int kk = 2 * i + (lane >> 5); scr[kk * 33 + c] = sc >= 0 ? W[(size_t)(k0 + kk) * ldsrc + sc] * scale : 0.f; }
    LDS_WAIT(); asm volatile("" ::: "memory");
    const int ch = lane & 7;
#pragma unroll
    for (int j = 0; j < 4; ++j) { const int n = (lane >> 3) + 8 * j; const LAS float* s = scr + (8 * ch) * 33 + n;
        u32x4 o; o.x = pk2(s[0 * 33], s[1 * 33]); o.y = pk2(s[2 * 33], s[3 * 33]); o.z = pk2(s[4 * 33], s[5 * 33]); o.w = pk2(s[6 * 33], s[7 * 33]);
        *(u32x4*)(WT + (size_t)(n0 + n) * ldw + kd0 + 8 * ch) = o; }
    LDS_WAIT(); asm volatile("" ::: "memory");
}
template <class F> __device__ __forceinline__ void cvt_tile8(const float* W, size_t ldsrc, int k0, unsigned char* WT, size_t ldw, int n0, const F& f, float wscale, LAS float* scr, int lane) {
    const int c = lane & 31; int sc; float scale; f(n0 + c, sc, scale); scale *= wscale;
#pragma unroll 8
    for (int i = 0; i < 32; ++i) { const int kk = 2 * i + (lane >> 5); scr[kk * 33 + c] = sc >= 0 ? W[(size_t)(k0 + kk) * ldsrc + sc] * scale : 0.f; }
    LDS_WAIT(); asm volatile("" ::: "memory");
    const int ch = lane & 7;
#pragma unroll
    for (int j = 0; j < 4; ++j) { const int n = (lane >> 3) + 8 * j; const LAS float* s = scr + (8 * ch) * 33 + n;
        int w0 = __builtin_amdgcn_cvt_pk_fp8_f32(s[0 * 33], s[1 * 33], 0, false); w0 = __builtin_amdgcn_cvt_pk_fp8_f32(s[2 * 33], s[3 * 33], w0, true);
        int w1 = __builtin_amdgcn_cvt_pk_fp8_f32(s[4 * 33], s[5 * 33], 0, false); w1 = __builtin_amdgcn_cvt_pk_fp8_f32(s[6 * 33], s[7 * 33], w1, true);
        *(u32x2*)(WT + (size_t)(n0 + n) * ldw + k0 + 8 * ch) = (u32x2){(unsigned)w0, (unsigned)w1}; }
    LDS_WAIT(); asm volatile("" ::: "memory");
}
struct MapIn { __device__ __forceinline__ void operator()(int n, int& sc, float& s) const { sc = zcol_src(n); s = (n < 512 || (n >= Z_FQ && n < Z_FK)) ? QSCALE : 1.0f; } };
struct MapGu { __device__ __forceinline__ void operator()(int n, int& sc, float& s) const { sc = (n & 1) ? 1024 + (n >> 1) : (n >> 1); s = 1.0f; } };
struct MapId { __device__ __forceinline__ void operator()(int n, int& sc, float& s) const { sc = n; s = 1.0f; } };

__device__ __forceinline__ void p0_prologue(KP p, LAS unsigned char* lds, int gw, int NGW, int wave, int lane) {
    LAS float* scr = (LAS float*)(lds + wave * 16384);
    unsigned char* ws = p->ws;
    constexpr int I_IN = 16 * 272, I_GU = 32 * 16 * 64, I_DN = 32 * 16 * 32, I_P = 3 * 8 * 32, I_OUT = 16 * 32, I_LAYER = I_IN + I_GU + I_DN + I_P + I_OUT;
    for (int it = gw; it < DEPTH * I_LAYER; it += NGW) {
        const int l = it / I_LAYER; int r = it - l * I_LAYER;
        if (r < I_IN) { const int kb = r / 272, nb = r % 272;
            cvt_tile(p->w_in + (size_t)l * 1024 * D_IN, D_IN, 64 * kb, (bf16*)(ws + WS_WIN) + (size_t)l * ZP * 1024, 1024, 64 * kb, 32 * nb, MapIn{}, scr, lane); continue; } r -= I_IN;
        if (r < I_GU) { const int e = r >> 10, r2 = r & 1023, kb = r2 >> 6, nb = r2 & 63;
            cvt_tile8(p->w_gu + (size_t)(l * 32 + e) * 1024 * 2048, 2048, 64 * kb, (unsigned char*)(ws + WS_WGU) + (size_t)(l * 32 + e) * 2048 * 1024, 1024, 32 * nb, MapGu{}, W8_SCALE, scr, lane); continue; } r -= I_GU;
        if (r < I_DN) { const int e = r >> 9, r2 = r & 511, kb = r2 >> 5, nb = r2 & 31;
            cvt_tile8(p->w_down + (size_t)(l * 32 + e) * 1024 * 1024, 1024, 64 * kb, (unsigned char*)(ws + WS_WDN) + (size_t)(l * 32 + e) * 1024 * 1024, 1024, 32 * nb, MapId{}, W8_SCALE, scr, lane); continue; } r -= I_DN;
        if (r < I_P) { const int br = r >> 8, r2 = r & 255, kb = r2 >> 5, nb = r2 & 31; const float* W = (br == 0 ? p->w_pa : br == 1 ? p->w_pb : p->w_pc) + (size_t)l * 512 * 1024;
            cvt_tile(W, 1024, 64 * kb, (bf16*)(ws + WS_WP) + (size_t)l * 1024 * 1536, 1536, br * 512 + 64 * kb, 32 * nb, MapId{}, scr, lane); continue; } r -= I_P;
        { const int kb = r >> 5, nb = r & 31;
            cvt_tile(p->w_out + (size_t)l * 1024 * 1024, 1024, 64 * kb, (bf16*)(ws + WS_WOUT) + (size_t)l * 1024 * 1024, 1024, 64 * kb, 32 * nb, MapId{}, scr, lane); }
    }
    { float* bg = (float*)(ws + WS_BGU);
      for (int i = gw * 64 + lane; i < DEPTH * 32 * 2048; i += NGW * 64) { const int n = i & 2047, le = i >> 11; bg[i] = p->b_gu[(size_t)le * 2048 + ((n & 1) ? 1024 + (n >> 1) : (n >> 1))]; } }
    { bf16* wf = (bf16*)(ws + WS_WRF);
      for (int i = gw * 64 + lane; i < DEPTH * 32 * 2 * 64 * 8; i += NGW * 64) { const int ii = i & 7, ln = (i >> 3) & 63, nt = (i >> 9) & 1, s = (i >> 10) & 31, l = i >> 15;
          const int k = 32 * s + 8 * (ln >> 4) + ii, e = 16 * nt + (ln & 15); const float w = p->w_router[((size_t)l * 1024 + k) * 32 + e];
          const unsigned hb = f2bf(w); const float lo = w - bf2f(hb);
          const size_t base = ((((size_t)l * 32 + s) * 2 + nt) * 2) * 512 + ln * 8 + ii; wf[base] = (bf16)hb; wf[base + 512] = (bf16)f2bf(lo); } }
    { f32x2* tg = (f32x2*)(ws + WS_TRIG);
      for (int i = gw * 64 + lane; i < SEQ * 32; i += NGW * 64) { const int pos = i >> 5, k = i & 31;
          const float inv = exp2f(-(float)k * (13.287712379549449f / 32.0f)); const float ang = (float)pos * inv;
          const double rev = (double)ang * 0.15915494309189535; const float fr = (float)(rev - __builtin_rint(rev));
          tg[i] = (f32x2){__builtin_amdgcn_cosf(fr), __builtin_amdgcn_sinf(fr)}; } }
    { bf16* xb = (bf16*)(ws + WS_XB);
      for (int m = gw; m < NTOK; m += NGW) { const f32x4* xr = (const f32x4*)(p->x + (size_t)m * DM) + lane; u32x2* o = (u32x2*)(xb + (size_t)m * DM) + lane;
#pragma unroll
          for (int j = 0; j < 4; ++j) { const f32x4 v = xr[64 * j]; o[64 * j] = (u32x2){pk2(v.x, v.y), pk2(v.z, v.w)}; } } }
}

__device__ __forceinline__ void prep_phase(KP p, int l, int gw, int NGW, int lane) {
    unsigned char* ws = p->ws; bf16* Z = (bf16*)(ws + WS_Z); const f32x2* tg = (const f32x2*)(ws + WS_TRIG); float* lfT = (float*)(ws + WS_LFT);
    const float bf_l = (lane < 8) ? p->b_fox[l * 8 + lane] : 0.f;
    for (int m = gw; m < NTOK; m += NGW) {
        bf16* zr = Z + (size_t)m * ZP; const int pos = m & (SEQ - 1), b = m >> 13;
        const f32x2 cs = tg[pos * 32 + (lane & 31)];
        unsigned short ta[11], tb[11];
#pragma unroll
        for (int it = 0; it < 11; ++it) { const int hh = 2 * it + (lane >> 5); const int hc = hh < 21 ? hh : 20;
            const int col = hc < 8 ? Z_AQ + hc * 64 : hc < 16 ? Z_AK + (hc - 8) * 64 : hc < 20 ? Z_IQ + (hc - 16) * 64 : Z_IK;
            const bf16* q = zr + col + (lane & 31); ta[it] = q[0]; tb[it] = q[32]; }
#pragma unroll
        for (int it = 0; it < 11; ++it) { const int hh = 2 * it + (lane >> 5);
            if (hh < 21) { const int col = hh < 8 ? Z_AQ + hh * 64 : hh < 16 ? Z_AK + (hh - 8) * 64 : hh < 20 ? Z_IQ + (hh - 16) * 64 : Z_IK;
                bf16* q = zr + col + (lane & 31); const float t1 = bf2f(ta[it]), t2 = bf2f(tb[it]);
                q[0] = (bf16)f2bf(t1 * cs.x - t2 * cs.y); q[32] = (bf16)f2bf(t2 * cs.x + t1 * cs.y); } }
#pragma unroll
        for (int j = 0; j < 2; ++j) { bf16* g0p = zr + Z_GT + lane * 8 + j * 512; const u32x4 a = *(const u32x4*)g0p, bb = *(const u32x4*)(g0p + 1024), cc = *(const u32x4*)(g0p + 2048);
            u32x4 o0, o1, o2;
#pragma unroll
            for (int i = 0; i < 4; ++i) {
                const float e0l = __expf(-bflo(a[i])), e0h = __expf(-bfhi(a[i])), e1l = __expf(-bflo(bb[i])), e1h = __expf(-bfhi(bb[i])), e2l = __expf(-bflo(cc[i])), e2h = __expf(-bfhi(cc[i]));
                o0[i] = pk2((1.f + e1l) / (1.f + e0l), (1.f + e1h) / (1.f + e0h));
                o1[i] = pk2((1.f + e2l) / (1.f + e1l), (1.f + e2h) / (1.f + e1h));
                o2[i] = pk2(1.f / (1.f + e2l), 1.f / (1.f + e2h)); }
            *(u32x4*)g0p = o0; *(u32x4*)(g0p + 1024) = o1; *(u32x4*)(g0p + 2048) = o2; }
        if (lane < 8) { const float v = bf2f(zr[Z_FF + lane]) + bf_l; const float ls = fminf(v, 0.f) - __logf(1.0f + __expf(-fabsf(v))); lfT[(size_t)(b * 8 + lane) * SEQ + pos] = ls * LOG2E; }
    }
}

constexpr int IX_CAP = 1024, IX_STRIDE = IX_CAP + 1  , IX_TRIG = 768, IX_CAND = 0, IX_BM = 0  , IX_HIST = 32 * IX_STRIDE * 4, IX_CNT = IX_HIST + 8 * 1024, IX_TAU = IX_CNT + 128, IX_FLAG = IX_TAU + 128, IX_END = IX_FLAG + 64;
static_assert(IX_END <= SCR_BYTES, "indexer LDS");

__device__ __forceinline__ int wave_incl_sum(int v) {
    v += __builtin_amdgcn_update_dpp(0, v, 0x111, 0xf, 0xf, false);
    v += __builtin_amdgcn_update_dpp(0, v, 0x112, 0xf, 0xf, false);
    v += __builtin_amdgcn_update_dpp(0, v, 0x114, 0xf, 0xf, false);
    v += __builtin_amdgcn_update_dpp(0, v, 0x118, 0xf, 0xf, false);
    v += __builtin_amdgcn_update_dpp(0, v, 0x142, 0xa, 0xf, false);
    v += __builtin_amdgcn_update_dpp(0, v, 0x143, 0xc, 0xf, false);
    return v;
}
__device__ __forceinline__ unsigned wave_or63(unsigned v) {
    v |= (unsigned)__builtin_amdgcn_update_dpp(0, (int)v, 0x111, 0xf, 0xf, false);
    v |= (unsigned)__builtin_amdgcn_update_dpp(0, (int)v, 0x112, 0xf, 0xf, false);
    v |= (unsigned)__builtin_amdgcn_update_dpp(0, (int)v, 0x114, 0xf, 0xf, false);
    v |= (unsigned)__builtin_amdgcn_update_dpp(0, (int)v, 0x118, 0xf, 0xf, false);
    v |= (unsigned)__builtin_amdgcn_update_dpp(0, (int)v, 0x142, 0xa, 0xf, false);
    v |= (unsigned)__builtin_amdgcn_update_dpp(0, (int)v, 0x143, 0xc, 0xf, false);
    return v;
}
__device__ __forceinline__ int count_ge8(const unsigned (&x)[16], int k0, unsigned t) {
    u64 m0, m1, m2, m3, m4, m5, m6, m7;
    asm("v_cmp_ge_u32_e64 %0, %8, %16\n\tv_cmp_ge_u32_e64 %1, %9, %16\n\tv_cmp_ge_u32_e64 %2, %10, %16\n\tv_cmp_ge_u32_e64 %3, %11, %16\n\t"
        "v_cmp_ge_u32_e64 %4, %12, %16\n\tv_cmp_ge_u32_e64 %5, %13, %16\n\tv_cmp_ge_u32_e64 %6, %14, %16\n\tv_cmp_ge_u32_e64 %7, %15, %16"
        : "=&s"(m0), "=&s"(m1), "=&s"(m2), "=&s"(m3), "=&s"(m4), "=&s"(m5), "=&s"(m6), "=&s"(m7)
        : "v"(x[k0]), "v"(x[k0 + 1]), "v"(x[k0 + 2]), "v"(x[k0 + 3]), "v"(x[k0 + 4]), "v"(x[k0 + 5]), "v"(x[k0 + 6]), "v"(x[k0 + 7]), "v"(t));
    return (int)(__popcll(m0) + __popcll(m1) + __popcll(m2) + __popcll(m3) + __popcll(m4) + __popcll(m5) + __popcll(m6) + __popcll(m7));
}
template <bool EXACT>
__device__ __forceinline__ unsigned wave_search256(const unsigned (&x)[16]) {
    const unsigned xr = (unsigned)__builtin_amdgcn_readfirstlane((int)x[0]); unsigned df = 0u;
#pragma unroll
    for (int k = 0; k < 16; ++k) df |= (x[k] != 0u) ? (x[k] ^ xr) : 0u;
    df = (unsigned)__builtin_amdgcn_readlane((int)wave_or63(df), 63);
    const int hb = 31 - (int)__builtin_clz(df | 1u);
    unsigned prefix = xr & ~((2u << hb) - 1u);
#pragma unroll 1
    for (int bit = hb; bit >= 0; --bit) { const unsigned trial = prefix | (1u << bit); const int c = count_ge8(x, 0, trial) + count_ge8(x, 8, trial);
        if (c >= 256) { prefix = trial; if (EXACT ? (c == 256) : (c <= 384)) break; } }
    return prefix;
}
__device__ __forceinline__ unsigned wave_compact(LAS unsigned* cand, int n, int lane, int& kept) {
    unsigned x[16];
#pragma unroll
    for (int k = 0; k < 16; ++k) { const int i = lane + 64 * k; x[k] = (i < n) ? cand[i] : 0u; }
    const unsigned prefix = wave_search256<false>(x);
    int base = 0;
#pragma unroll
    for (int k = 0; k < 16; ++k) { const bool keep = x[k] >= prefix; const u64 mk = __ballot(keep);
        if (keep) cand[__builtin_amdgcn_mbcnt_hi((unsigned)(mk >> 32), __builtin_amdgcn_mbcnt_lo((unsigned)mk, (unsigned)base))] = x[k]; base += __popcll(mk); }
    kept = base;
    return prefix;
}

__device__ __forceinline__ void idx_phase(KP p, int l, LAS unsigned char* lds, int vcu, int G, int tid, int wave, int lane) {
    unsigned char* ws = p->ws; const bf16* Z = (const bf16*)(ws + WS_Z);
    { unsigned* sbr = (unsigned*)(ws + WS_CTL) + CW_SB + l * 64; LAS float* wt = (LAS float*)lds;
      for (int task = blockIdx.x; task < 256; task += G) { const int bh = task >> 3, part = task & 7; float qm = 0.f, km = 0.f;
          const bf16* zr = Z + (size_t)((bh >> 3) * SEQ + part * 1024 + tid * 2) * ZP + (bh & 7) * 64;
#pragma unroll
          for (int i = 0; i < 2; ++i) { float qs = 0.f, ks = 0.f;
#pragma unroll
              for (int c8 = 0; c8 < 8; ++c8) { const u32x4 a = *(const u32x4*)(zr + (size_t)i * ZP + Z_FQ + c8 * 8), kq = *(const u32x4*)(zr + (size_t)i * ZP + Z_FK + c8 * 8);
#pragma unroll
                  for (int w4 = 0; w4 < 4; ++w4) { qs += bflo(a[w4]) * bflo(a[w4]) + bfhi(a[w4]) * bfhi(a[w4]); ks += bflo(kq[w4]) * bflo(kq[w4]) + bfhi(kq[w4]) * bfhi(kq[w4]); } }
              qm = fmaxf(qm, qs); km = fmaxf(km, ks); }
#pragma unroll
          for (int o = 1; o < 64; o <<= 1) { qm = fmaxf(qm, __shfl_xor(qm, o)); km = fmaxf(km, __shfl_xor(km, o)); }
          if (lane == 0) { __hip_atomic_fetch_max(sbr + 2 * bh, __builtin_bit_cast(unsigned, qm), __ATOMIC_RELAXED, __HIP_MEMORY_SCOPE_AGENT); __hip_atomic_fetch_max(sbr + 2 * bh + 1, __builtin_bit_cast(unsigned, km), __ATOMIC_RELAXED, __HIP_MEMORY_SCOPE_AGENT); } }
      (void)wt; }
    for (int bh = blockIdx.x; bh < 32; bh += G) {
        float* dst = (float*)(ws + WS_CT) + (size_t)bh * SEQ;
        LAS float* wt = (LAS float*)lds;
        const float bfx = p->b_fox[l * 8 + (bh & 7)]; const bf16* zf = Z + (size_t)((bh >> 3) * SEQ + tid * 16) * ZP + Z_FF + (bh & 7);
        f32x4 v[4]; float run = 0.f;
#pragma unroll
        for (int j = 0; j < 4; ++j) {
#pragma unroll
            for (int i = 0; i < 4; ++i) { const float t = bf2f(zf[(size_t)(4 * j + i) * ZP]) + bfx; v[j][i] = (fminf(t, 0.f) - __logf(1.0f + __expf(-fabsf(t)))) * LOG2E; }
            v[j].x += run; v[j].y += v[j].x; v[j].z += v[j].y; v[j].w += v[j].z; run = v[j].w; }
        float inc = run;
#pragma unroll
        for (int o = 1; o < 64; o <<= 1) { const float t = __shfl_up(inc, o); if (lane >= o) inc += t; }
        if (lane == 63) wt[wave] = inc;
        WG_BAR();
        float off = inc - run;
        for (int w = 0; w < wave; ++w) off += wt[w];
        { u32x4* ka = (u32x4*)((bf16*)(ws + WS_KA) + ((size_t)bh * SEQ + tid * 16) * 16);
#pragma unroll
          for (int j = 0; j < 4; ++j) { const f32x4 c4 = v[j] + off; *(f32x4*)(dst + tid * 16 + 4 * j) = c4;
#pragma unroll
              for (int i = 0; i < 4; ++i) { const float c = c4[i]; const unsigned h1 = f2bf(c); const float r1 = c - bf2f(h1); const unsigned h2 = f2bf(r1); const unsigned h3 = f2bf(r1 - bf2f(h2));
                  unsigned z0 = 0u; asm volatile("" : "+v"(z0));
                  ka[(4 * j + i) * 2] = (u32x4){h1 | (h2 << 16), h3 | 0x3f800000u, z0, z0}; ka[(4 * j + i) * 2 + 1] = (u32x4){z0, z0, z0, z0}; } } }
        WG_BAR();
    }
    LAS unsigned* cand = (LAS unsigned*)(lds + IX_CAND); LAS unsigned* BM = (LAS unsigned*)(lds + IX_BM);
    LAS unsigned* cnt = (LAS unsigned*)(lds + IX_CNT); LAS unsigned* tau = (LAS unsigned*)(lds + IX_TAU); LAS unsigned* hist = (LAS unsigned*)(lds + IX_HIST); LAS unsigned* flg = (LAS unsigned*)(lds + IX_FLAG);
    u64* MW = (u64*)(ws + WS_MASKW);
    const int r32 = lane & 31, hi = lane >> 5;
    for (int U = vcu; U < 1024; U += G) {
        const int v = U & 255, i4 = U >> 8; const int b = v & 3, a = v >> 2;
        const int hc = (i4 == 0) ? a : (i4 == 1) ? 255 - a : (i4 == 2) ? 64 + a : 191 - a;
        const int qbase = b * SEQ + hc * 32; const int nadm = ((hc >> 1) + 1) * 64;
        if (nadm <= 256) {
            const int nw = nadm >> 6;
            for (int i = tid; i < 32 * 128; i += NTHR) { const int q = i >> 7, w = i & 127; unsigned on = (w < nw) ? 0xffffffffu : 0u; asm volatile("" : "+v"(on));
                MW[(size_t)(qbase + q) * 128 + w] = (u64)on | ((u64)on << 32); }
            continue;
        }
        const bf16* qrow = Z + (size_t)(qbase + r32) * ZP;
        bf16x8 iqf[4][4];
#pragma unroll
        for (int hd = 0; hd < 4; ++hd)
#pragma unroll
            for (int j = 0; j < 4; ++j) iqf[hd][j] = *(const bf16x8*)(qrow + Z_IQ + hd * 64 + j * 16 + hi * 8);
        float wq[4];
#pragma unroll
        for (int hd = 0; hd < 4; ++hd) wq[hd] = bf2f(qrow[Z_IW + hd]) * (0.5f * 0.125f);
        if (tid < 32) { cnt[tid] = 0u; tau[tid] = 0u; } if (tid < 3) flg[tid] = 0u;
        const int ntiles = nadm >> 5, nrounds = (ntiles + 7) >> 3;
        const bf16* kbase = (const bf16*)(ws + WS_IKC) + (size_t)(b * SEQ) * 64 + hi * 8;
        bf16x8 kf[4], kn[4];
#pragma unroll
        for (int j = 0; j < 4; ++j) kn[j] = *(const bf16x8*)(kbase + (size_t)((wave < ntiles ? wave : 0) * 32 + r32) * 64 + j * 16);
        WG_BAR();
        for (int rd = 0; rd < nrounds; ++rd) {
            const int tile = rd * 8 + wave;
#pragma unroll
            for (int j = 0; j < 4; ++j) kf[j] = kn[j];
            { const int tn = (tile + 8 < ntiles) ? tile + 8 : tile;
#pragma unroll
              for (int j = 0; j < 4; ++j) kn[j] = *(const bf16x8*)(kbase + (size_t)((tn < ntiles ? tn : 0) * 32 + r32) * 64 + j * 16); }
            if (tile < ntiles) {
                f32x16 sc = {};
#pragma unroll
                for (int hd = 0; hd < 4; ++hd) { f32x16 pp = {};
#pragma unroll
                    for (int j = 0; j < 4; ++j) pp = MFMA32(kf[j], iqf[hd][j], pp);
#pragma unroll
                    for (int r = 0; r < 16; ++r) { const float pv = pp[r]; const int pb = __builtin_bit_cast(int, pv); const int pr = pb > 0 ? pb : 0;
                        sc[r] = __builtin_fmaf(wq[hd], __builtin_bit_cast(float, pr), sc[r]); } }
                const unsigned tq = tau[r32];
                typedef unsigned u32x16_t __attribute__((ext_vector_type(16))); u32x16_t comp; unsigned npass = 0u;
#pragma unroll
                for (int r = 0; r < 16; ++r) { const int key = tile * 32 + crow(r, hi);
                    unsigned u = __builtin_bit_cast(unsigned, sc[r] + 0.0f); u ^= (u >> 31) ? 0xffffffffu : 0x80000000u;
                    comp[r] = (u & 0xffffe000u) | (unsigned)(8191 - key); npass += (comp[r] > tq) ? 1u : 0u; }
                unsigned pos = 0u;
                if (npass) pos = __hip_atomic_fetch_add(cnt + r32, npass, __ATOMIC_RELAXED, __HIP_MEMORY_SCOPE_WORKGROUP);
                LAS unsigned* cq_ = cand + r32 * IX_STRIDE;
#pragma unroll
                for (int r = 0; r < 16; ++r) if (comp[r] > tq) { cq_[pos] = comp[r]; ++pos; }
                if (npass && pos > (unsigned)IX_TRIG) flg[rd % 3] = 1u;
            }
            WG_BAR_LDS();
            const bool need_any = flg[rd % 3] != 0u;
            if (tid == 0) flg[(rd + 2) % 3] = 0u;
            if (need_any) {
#pragma unroll 1
                for (int i = 0; i < 4; ++i) { const int qq = wave * 4 + i; const int n = __builtin_amdgcn_readfirstlane((int)cnt[qq]);
                    if (n > 256) { int kept; const unsigned th = wave_compact(cand + qq * IX_STRIDE, n, lane, kept); if (lane == 0) { cnt[qq] = (unsigned)kept; tau[qq] = th ? th - 1u : 0u; } } }
                WG_BAR_LDS();
            }
        }
#pragma unroll 1
        for (int i = 0; i < 4; ++i) { const int qq = wave * 4 + i; const int n = __builtin_amdgcn_readfirstlane((int)cnt[qq]);
            LAS unsigned* cq = cand + qq * IX_STRIDE; unsigned x[16];
#pragma unroll
            for (int k = 0; k < 16; ++k) { const int ii = lane + 64 * k; x[k] = (ii < n) ? cq[ii] : 0u; }
            unsigned th = 1u; if (n > 256) th = wave_search256<true>(x);
            asm volatile("" ::: "memory");
#pragma unroll
            for (int k = 0; k < 4; ++k) { unsigned z0 = 0u; asm volatile("" : "+v"(z0)); cq[lane + 64 * k] = z0; }
#pragma unroll
            for (int k = 0; k < 16; ++k) if (x[k] >= th) { const int key = 8191 - (int)(x[k] & 8191u);
                (void)__hip_atomic_fetch_or(cq + (key >> 5), 1u << (key & 31), __ATOMIC_RELAXED, __HIP_MEMORY_SCOPE_WORKGROUP); }
            LDS_WAIT(); asm volatile("" ::: "memory");
            const unsigned w0 = cq[4 * lane], w1 = cq[4 * lane + 1], w2 = cq[4 * lane + 2], w3 = cq[4 * lane + 3];
            *(u32x4*)(MW + (size_t)(qbase + qq) * 128 + 2 * lane) = (u32x4){w0, w1, w2, w3};
            asm volatile("" ::: "memory"); }
        WG_BAR();
    }
}

constexpr int AT_K = 0, AT_V = 2 * 8192, AT_WS = 4 * 8192, AT_OST = AT_WS + 4096, AT_MW = AT_OST + 8 * 4096, AT_KA = AT_MW + 2 * 8 * 512, AT_END = AT_KA + 2 * 2048;
static_assert(AT_END <= SCR_BYTES, "attention LDS");
#ifndef DBG_ATT_L
#define DBG_ATT_L 0
#endif

template <int MODE>
__device__ __forceinline__ void attn_unit(int b, int h, int qb, const bf16* Z, bf16* Ob, const float* cT, const u64* MW, const void* KA, const void* SBp, LAS char* shm, int wv) {
    int tid_l = lane_id() + wv * 64;
    const int tid = tid_l, lane = tid & 63, r32 = lane & 31, hi = lane >> 5; const int wid = __builtin_amdgcn_readfirstlane(tid >> 6);
    constexpr int QC = MODE == 0 ? Z_FQ : Z_AQ, KC = MODE == 0 ? Z_FK : Z_AK, VC = MODE == 0 ? Z_FV : Z_AV, OC = MODE == 0 ? 512 : 0;
    const long rowbase = (long)b * SEQ; const int q0 = qb * 512;
    const bf16* Qw = Z + (rowbase + q0 + wid * 64) * ZP + QC + h * 64;
    const bf16* Kh = Z + rowbase * ZP + KC + h * 64; const bf16* Vh = Z + rowbase * ZP + VC + h * 64;
    const unsigned lds0 = (unsigned)(uintptr_t)shm;
    LAS float* wsf = (LAS float*)(shm + AT_WS) + wid * 128;
    const int NT = 8 * (qb + 1); const int tlast = 8 * qb + wid;
    const bf16* ksrc = Kh + (long)lane * ZP + wid * 8;
    const bf16* vsrc = Vh + (long)(16 * (wid & 3) + (lane >> 2)) * ZP + (wid >> 2) * 32 + (lane & 3) * 8;
    const unsigned kdst = lds0 + AT_K + wid * 1024, vdst = lds0 + AT_V + wid * 1024, mdst = lds0 + AT_MW + wid * 512;
    const unsigned kadst = lds0 + AT_KA + (wid & 1) * 1024;
#define DMA_KA(t, sl) do { if (MODE == 0 && wid < 2) { const int ln_ = lane_id();     \
        glds16((const bf16*)KA + ((size_t)(b * 8 + h) * SEQ + (t) * 64 + 32 * wid + (ln_ >> 1)) * 16 + (ln_ & 1) * 8, (unsigned)__builtin_amdgcn_readfirstlane(kadst + (sl) * 2048)); } } while (0)
#define DMA_K(t, slotb) glds16(ksrc + (long)(t) * 64 * ZP, (unsigned)__builtin_amdgcn_readfirstlane(kdst + (slotb)))
#define DMA_V(t, slotb) glds16(vsrc + (long)(t) * 64 * ZP, (unsigned)__builtin_amdgcn_readfirstlane(vdst + (slotb)))
#define DMA_M(t, sl) do { const int ln_ = lane_id(); const unsigned* msrcA = (const unsigned*)(MW + (size_t)(rowbase + q0 + wid * 64 + (ln_ & 31)) * 128) + (ln_ >> 5);     \
        glds4(msrcA + 2 * (t), (unsigned)__builtin_amdgcn_readfirstlane(mdst + (sl) * 4096)); glds4(msrcA + 32 * 256 + 2 * (t), (unsigned)__builtin_amdgcn_readfirstlane(mdst + (sl) * 4096 + 256)); } while (0)
    int t_start = 0, t_first = 0;
    if (MODE == 0) { const float* cg = cT + (size_t)(b * 8 + h) * SEQ; const float th = 2.0f * (sqrtf(((const float*)SBp)[2 * (b * 8 + h)]) * sqrtf(((const float*)SBp)[2 * (b * 8 + h) + 1]) * 1.01f + 1.0f) + 40.0f; const int ln_ = lane_id();
        const float c0 = cg[q0], cw = cg[q0 + wid * 64];
        const float ca = (ln_ < NT) ? cg[64 * ln_ + 63] : -3e38f, cb = (ln_ + 64 < NT) ? cg[64 * (ln_ + 64) + 63] : -3e38f;
        { const u64 m0 = __ballot(ca <= c0 + th), m1 = __ballot(cb <= c0 + th); t_start = m0 ? (int)__builtin_ctzll(m0) : 64 + (int)__builtin_ctzll(m1 | (1ull << 63)); }
        { const u64 m0 = __ballot(ca <= cw + th), m1 = __ballot(cb <= cw + th); t_first = m0 ? (int)__builtin_ctzll(m0) : 64 + (int)__builtin_ctzll(m1 | (1ull << 63)); }
        if (t_start > 8 * qb) t_start = 8 * qb; if (t_first > tlast) t_first = tlast; }
    DMA_K(t_start, 0); DMA_V(t_start, 0); if (MODE == 1) DMA_M(0, 0); DMA_KA(t_start, 0);
    bf16x8 qA[4], qB[4];
#pragma unroll
    for (int d0 = 0; d0 < 4; ++d0) { qA[d0] = *(const bf16x8*)(Qw + (long)r32 * ZP + d0 * 16 + hi * 8); qB[d0] = *(const bf16x8*)(Qw + (long)(32 + r32) * ZP + d0 * 16 + hi * 8); }
    float mA = 0.f, mB = 0.f, lA = 0.f, lB = 0.f;
    const unsigned qa0 = (MODE == 0 && hi == 0) ? 0xbf80bf80u : 0u; const unsigned qa1c = (MODE == 0 && hi == 0) ? 0xbf80u : 0u;
    u32x4 qaA = {qa0, qa1c, 0u, 0u}, qaB = {qa0, qa1c, 0u, 0u};
    f32x16 oA[2], oB[2]; oA[0] = f32x16{}; oA[1] = f32x16{}; oB[0] = f32x16{}; oB[1] = f32x16{};
    const int qrelA = wid * 64 + r32;
    const LAS char* kp0 = shm + AT_K + hi * 1024 + r32 * 16;
    const LAS char* vp0 = shm + AT_V + ((lane >> 4) & 1) * 32 + (lane & 3) * 8 + (4 * hi + ((lane & 15) >> 2)) * 64;
    const LAS unsigned* mwp = (const LAS unsigned*)(shm + AT_MW + wid * 512);
    const LAS char* kap0 = shm + AT_KA + r32 * 32 + hi * 16;
    int slot = 0;
#define SOFTMAX(P0, P1, MH, LR, OO, QA, QREL, WSOFF, MWOFF, PW) do { \
        if (MODE == 0) { \
            if (t == tlast) { _Pragma("unroll") for (int r = 0; r < 16; ++r) { const int kv = crow(r, hi); if (kv > (QREL) - wid * 64) P0[r] = -INFINITY; if (kv + 32 > (QREL) - wid * 64) P1[r] = -INFINITY; } } \
        } else { const unsigned mlo = mwp[slot * 1024 + (MWOFF) + r32] >> (4 * hi), mhi = mwp[slot * 1024 + (MWOFF) + 32 + r32] >> (4 * hi);     \
            _Pragma("unroll") for (int r = 0; r < 16; ++r) { const int bitp = crow(r, 0); const float p0_ = P0[r], p1_ = P1[r];     \
                const unsigned s0_ = (unsigned)__builtin_amdgcn_sbfe((int)mlo, bitp, 1), s1_ = (unsigned)__builtin_amdgcn_sbfe((int)mhi, bitp, 1);                       \
                P0[r] = __builtin_bit_cast(float, (__builtin_bit_cast(unsigned, p0_) & s0_) | (0xff800000u & ~s0_)); P1[r] = __builtin_bit_cast(float, (__builtin_bit_cast(unsigned, p1_) & s1_) | (0xff800000u & ~s1_)); } } \
        float rm = __builtin_fmaxf(__builtin_fmaxf(P0[0], P0[1]), P1[0]), rm2 = __builtin_fmaxf(__builtin_fmaxf(P0[2], P0[3]), P1[1]); rm = __builtin_fmaxf(__builtin_fmaxf(rm, P1[2]), P1[3]); \
        _Pragma("unroll") for (int r = 4; r < 16; r += 4) { rm = __builtin_fmaxf(__builtin_fmaxf(rm, P0[r]), P0[r + 1]); rm2 = __builtin_fmaxf(__builtin_fmaxf(rm2, P0[r + 2]), P0[r + 3]); rm = __builtin_fmaxf(__builtin_fmaxf(rm, P1[r]), P1[r + 1]); rm2 = __builtin_fmaxf(__builtin_fmaxf(rm2, P1[r + 2]), P1[r + 3]); } \
        rm = __builtin_fmaxf(rm, rm2); \
        rm = swapmax(rm);                            \
        if (__any(rm > 8.0f)) { const bool big_ = __builtin_fabsf(MH) + __builtin_fabsf(rm > 0.f ? rm : 0.f) > 1800.0f;     \
            const float dl = rm > 0.f ? (big_ ? 64.0f * __builtin_ceilf((MH + rm) * (1.0f / 64.0f)) - MH : 8.0f * __builtin_ceilf(rm * 0.125f)) : 0.f; const float f = __builtin_amdgcn_exp2f(-dl); LR *= f; MH += dl; \
            QA[1] = (QA[1] & 0xffffu) | ((hi == 0) ? (f2bf(-MH) << 16) : 0u); \
            _Pragma("unroll") for (int r = 0; r < 16; ++r) { P0[r] -= dl; P1[r] -= dl; } \
            if (hi == 0) wsf[(WSOFF) + r32] = f; \
            LDS_WAIT(); \
            _Pragma("unroll") for (int j = 0; j < 4; ++j) { const f32x4 ff = *(const LAS f32x4*)(wsf + (WSOFF) + 8 * j + 4 * hi); \
                _Pragma("unroll") for (int i = 0; i < 4; ++i) { OO[0][4 * j + i] *= ff[i]; OO[1][4 * j + i] *= ff[i]; } } } \
        float sacc = 0.f; \
        _Pragma("unroll") for (int r = 0; r < 16; ++r) { P0[r] = __builtin_amdgcn_exp2f(P0[r]); P1[r] = __builtin_amdgcn_exp2f(P1[r]); sacc += P0[r] + P1[r]; } \
        LR += sacc; \
        _Pragma("unroll") for (int i = 0; i < 4; ++i) { PW[0][i] = cvtpk(P0[2 * i], P0[2 * i + 1]); PW[1][i] = cvtpk(P0[8 + 2 * i], P0[8 + 2 * i + 1]); PW[2][i] = cvtpk(P1[2 * i], P1[2 * i + 1]); PW[3][i] = cvtpk(P1[8 + 2 * i], P1[8 + 2 * i + 1]); } \
    } while (0)
#define PVMM(OO, PW) do { const LAS char* vp = vp0 + slot * 8192; \
        _Pragma("unroll") for (int d0 = 0; d0 < 2; ++d0) { s16x4 lo_[4], hh_[4]; \
            _Pragma("unroll") for (int ks = 0; ks < 4; ++ks) { lo_[ks] = vtr(vp + d0 * 4096 + ks * 1024); hh_[ks] = vtr(vp + d0 * 4096 + ks * 1024 + 512); } \
            _Pragma("unroll") for (int ks = 0; ks < 4; ++ks) { const bf16x8 vf = {lo_[ks][0], lo_[ks][1], lo_[ks][2], lo_[ks][3], hh_[ks][0], hh_[ks][1], hh_[ks][2], hh_[ks][3]}; \
                OO[d0] = MFMA32(__builtin_bit_cast(bf16x8, PW[ks]), vf, OO[d0]); } } } while (0)
    for (int t = t_start; t < NT; ++t) {
        asm volatile("s_waitcnt vmcnt(0) lgkmcnt(0)\n\ts_barrier" ::: "memory");
        if (t + 1 < NT) { DMA_K(t + 1, (slot ^ 1) * 8192); DMA_V(t + 1, (slot ^ 1) * 8192); if (MODE == 1) DMA_M(t + 1, slot ^ 1); DMA_KA(t + 1, slot ^ 1); }
        if (t <= tlast && t >= t_first) {
            f32x16 a0 = {}, a1 = {}, b0 = {}, b1 = {};
            { const LAS char* kb = kp0 + slot * 8192;
#pragma unroll
              for (int d0 = 0; d0 < 4; ++d0) { const bf16x8 k0 = *(const LAS bf16x8*)(kb + d0 * 2048), k1 = *(const LAS bf16x8*)(kb + d0 * 2048 + 512);
                  a0 = MFMA32(k0, qA[d0], a0); a1 = MFMA32(k1, qA[d0], a1); b0 = MFMA32(k0, qB[d0], b0); b1 = MFMA32(k1, qB[d0], b1); }
              bf16x8 x0, x1;
              if (MODE == 0) { x0 = *(const LAS bf16x8*)(kap0 + slot * 2048); x1 = *(const LAS bf16x8*)(kap0 + slot * 2048 + 1024); }
              else { const u32x4 cw = {0u, (hi == 0) ? 0x3f800000u : 0u, 0u, 0u}; x0 = __builtin_bit_cast(bf16x8, cw); x1 = x0; }
              a0 = MFMA32(x0, __builtin_bit_cast(bf16x8, qaA), a0); a1 = MFMA32(x1, __builtin_bit_cast(bf16x8, qaA), a1); b0 = MFMA32(x0, __builtin_bit_cast(bf16x8, qaB), b0); b1 = MFMA32(x1, __builtin_bit_cast(bf16x8, qaB), b1); }
            u32x4 pwA[4], pwB[4];
            SOFTMAX(a0, a1, mA, lA, oA, qaA, qrelA, 0, 0, pwA);
            PVMM(oA, pwA);
            SOFTMAX(b0, b1, mB, lB, oB, qaB, qrelA + 32, 32, 64, pwB);
            PVMM(oB, pwB);
        }
        slot ^= 1;
    }
#define EPILOG(OO, LR, WSOFF, ROWOFF) do { float l_ = swapsum(LR); if (hi == 0) wsf[64 + (WSOFF) + r32] = l_; LDS_WAIT(); float rli[16]; \
        _Pragma("unroll") for (int r = 0; r < 16; ++r) rli[r] = __builtin_amdgcn_rcpf(wsf[64 + (WSOFF) + crow(r, hi)]); \
        bf16* Ow = Ob + (rowbase + q0 + wid * 64 + (ROWOFF)) * OP + OC + h * 64; LAS bf16* stg = (LAS bf16*)(shm + AT_OST) + wid * 2048; \
        _Pragma("unroll") for (int r = 0; r < 16; ++r) { const int orow = crow(r, hi); _Pragma("unroll") for (int d0 = 0; d0 < 2; ++d0) stg[orow * 64 + d0 * 32 + r32] = (bf16)f2bf(OO[d0][r] * rli[r]); } \
        LDS_WAIT(); \
        _Pragma("unroll") for (int i = 0; i < 4; ++i) { const int row = i * 8 + (lane >> 3), ch = lane & 7; const u32x4 v = *(const LAS u32x4*)(stg + row * 64 + ch * 8); *(u32x4*)(Ow + (long)row * OP + ch * 8) = v; } \
        LDS_WAIT(); } while (0)
    EPILOG(oA, lA, 0, 0);
    EPILOG(oB, lB, 32, 32);
    asm volatile("s_waitcnt lgkmcnt(0)\n\ts_barrier" ::: "memory");
#undef DMA_K
#undef DMA_V
#undef DMA_M
#undef DMA_KA
#undef SOFTMAX
#undef PVMM
#undef EPILOG
}

__device__ __forceinline__ void attn_phase(KP p, int l, LAS unsigned char* lds, int vcu, int G, int wv) {
    unsigned char* ws = p->ws; const bf16* Z = (const bf16*)(ws + WS_Z); bf16* Ob = (bf16*)(ws + WS_OBUF); const float* cT = (const float*)(ws + WS_CT); const u64* MW = (const u64*)(ws + WS_MASKW);
    for (int U = vcu; U < 1024; U += G) {
        const int v = U & 255, i4 = U >> 8; const int mode = i4 & 1, k = i4 >> 1; const int bh = v >> 3, s = v & 7;
        const int qb = (k == 0) ? s : 15 - s;
        if (mode == 0) attn_unit<0>(bh >> 3, bh & 7, qb, Z, Ob, cT, MW, (const void*)(ws + WS_KA), (const void*)((const unsigned*)(ws + WS_CTL) + CW_SB + l * 64), (LAS char*)lds, wv);
        else attn_unit<1>(bh >> 3, bh & 7, qb, Z, Ob, cT, MW, (const void*)(ws + WS_KA), (const void*)((const unsigned*)(ws + WS_CTL) + CW_SB + l * 64), (LAS char*)lds, wv);
    }
}

constexpr int HG_LF = 0, HG_KK = 16640, HG_SEG = 33280, HG_P = 35328, HG_R = HG_P + 9216, HG_RT = HG_R + 9216, HG_VT = HG_RT + 9216, HG_ST = HG_VT + 9216, HG_CG = HG_ST + 9216, HG_END = HG_CG + 9216;
static_assert(HG_END <= SCR_BYTES, "hgrn LDS");
constexpr int HP = 72;

__device__ __forceinline__ void hgrn_front(KP p, int l, const unsigned short (&zf)[8], int h, int d, int seg, LAS float* SEG, float (&kk)[8], float (&bb)[8], float& bm, float& bl) {
    const int dd = h * 64 + d; const float lb = (l == 0) ? 0.f : sigmoidf_(p->lb_logits[512 + dd] - p->lb_logits[dd]);
    float run = 0.f;
#pragma unroll
    for (int i = 0; i < 8; ++i) { const float sg = sigmoidf_(bf2f(zf[i])); const float f = lb + (1.f - lb) * sg; kk[i] = (1.f - lb) * (1.f - sg); run += __logf(f); bb[i] = run; }
    SEG[seg * 64 + d] = run;
    WG_BAR_LDS();
    float pre = 0.f, m4 = 0.f, all = 0.f;
#pragma unroll
    for (int s2 = 0; s2 < 8; ++s2) { const float sv = SEG[s2 * 64 + d]; if (s2 < seg) pre += sv; if (s2 < 4) m4 += sv; all += sv; }
#pragma unroll
    for (int i = 0; i < 8; ++i) bb[i] += pre;
    bm = m4; bl = all;
}

#define H_ROWP(U_) (Z + (size_t)((((U_) >> 7) >> 3) * SEQ + ((U_) & 127) * 64 + 8 * seg) * ZP + (((U_) >> 7) & 7) * 64 + d)
__device__ __forceinline__ void h1_phase(KP p, int l, LAS unsigned char* lds, int vcu, int G, int tid, int wave, int lane) {
    unsigned char* ws = p->ws; const bf16* Z = (const bf16*)(ws + WS_Z); float* Ug = (float*)(ws + WS_UG); float* Dg = (float*)(ws + WS_DG); float* D2g = (float*)(ws + WS_D2G);
    LAS float* SEG = (LAS float*)(lds + HG_SEG); LAS bf16* RT = (LAS bf16*)(lds + HG_RT); LAS bf16* VT = (LAS bf16*)(lds + HG_VT);
    const int r32 = lane & 31, hi = lane >> 5; const int d = tid & 63, seg = tid >> 6;
    for (int U = vcu; U < 4096; U += G) {
        const int bh = U >> 7, h = bh & 7; const bf16* rp = H_ROWP(U);
        unsigned short zf[8], vv[8];
#pragma unroll
        for (int i = 0; i < 8; ++i) { zf[i] = rp[(size_t)i * ZP + Z_CF]; vv[i] = rp[(size_t)i * ZP + Z_CI]; }
        float kk[8], bb[8], bm, bl; hgrn_front(p, l, zf, h, d, seg, SEG, kk, bb, bm, bl);
        { unsigned rw[4], vw[4];
#pragma unroll
          for (int i = 0; i < 4; ++i) { rw[i] = pk2(kk[2 * i] * __expf(fminf(bm - bb[2 * i], 80.f)), kk[2 * i + 1] * __expf(fminf(bm - bb[2 * i + 1], 80.f))); vw[i] = (unsigned)vv[2 * i] | ((unsigned)vv[2 * i + 1] << 16); }
          *(LAS u32x4*)(RT + d * HP + 8 * seg) = (u32x4){rw[0], rw[1], rw[2], rw[3]}; *(LAS u32x4*)(VT + d * HP + 8 * seg) = (u32x4){vw[0], vw[1], vw[2], vw[3]}; }
        if (seg == 7) { Dg[(size_t)U * 64 + d] = __expf(bl); D2g[(size_t)U * 64 + d] = __expf(bl - bm); }
        WG_BAR_LDS();
        if (wave < 4) { const int ib = wave >> 1, jb = wave & 1; f32x16 acc = {};
#pragma unroll
            for (int ks = 0; ks < 4; ++ks) { const bf16x8 a = *(const LAS bf16x8*)(RT + (32 * ib + r32) * HP + 16 * ks + 8 * hi), bq = *(const LAS bf16x8*)(VT + (32 * jb + r32) * HP + 16 * ks + 8 * hi);
                acc = MFMA32(a, bq, acc); }
            float* up = Ug + ((size_t)U * 64 + 32 * jb + r32) * 64 + 32 * ib + 4 * hi;
#pragma unroll
            for (int rr = 0; rr < 4; ++rr) *(f32x4*)(up + 8 * rr) = (f32x4){acc[4 * rr], acc[4 * rr + 1], acc[4 * rr + 2], acc[4 * rr + 3]}; }
        WG_BAR_LDS();
    }
}

__device__ __forceinline__ void h2_phase(KP p, int G, int tid) {
    unsigned char* ws = p->ws; const float* Ug = (const float*)(ws + WS_UG); const float* Dg = (const float*)(ws + WS_DG); const float* D2g = (const float*)(ws + WS_D2G); bf16* Sst = (bf16*)(ws + WS_SST);
    for (int gid = blockIdx.x * NTHR + tid; gid < 32 * 4096; gid += G * NTHR) {
        const int bh = gid >> 12, ed = gid & 4095, d = ed & 63; float S = 0.f;
        const float* up = Ug + (size_t)bh * 128 * 4096 + ed; const float* dp = Dg + (size_t)bh * 128 * 64 + d; const float* d2p = D2g + (size_t)bh * 128 * 64 + d; bf16* sp = Sst + (size_t)bh * 128 * 4096 + ed;
        for (int c0 = 0; c0 < 128; c0 += 8) { float u[8], dd[8], d2[8];
#pragma unroll
            for (int i = 0; i < 8; ++i) { u[i] = up[(size_t)(c0 + i) * 4096]; dd[i] = dp[(c0 + i) * 64]; d2[i] = d2p[(c0 + i) * 64]; }
#pragma unroll
            for (int i = 0; i < 8; ++i) { sp[(size_t)(c0 + i) * 4096] = (bf16)f2bf(S); S = dd[i] * S + d2[i] * u[i]; } }
    }
}

__device__ __forceinline__ void h3_phase(KP p, int l, LAS unsigned char* lds, int vcu, int G, int tid, int wave, int lane) {
    unsigned char* ws = p->ws; const bf16* Z = (const bf16*)(ws + WS_Z); const bf16* Sst = (const bf16*)(ws + WS_SST); bf16* Ob = (bf16*)(ws + WS_OBUF);
    LAS float* SEG = (LAS float*)(lds + HG_SEG);
    LAS bf16* Pt = (LAS bf16*)(lds + HG_P); LAS bf16* Rt = (LAS bf16*)(lds + HG_R); LAS bf16* VT = (LAS bf16*)(lds + HG_VT); LAS bf16* ST = (LAS bf16*)(lds + HG_ST); LAS bf16* CG = (LAS bf16*)(lds + HG_CG);
    const int r32 = lane & 31, hi = lane >> 5; const int d = tid & 63, seg = tid >> 6;
    const float* gn = p->norm_g + l * 512;
    for (int U = vcu; U < 4096; U += G) {
        const int bh = U >> 7, c = U & 127, b = bh >> 3, h = bh & 7; const int t0 = b * SEQ + c * 64; const bf16* rp = H_ROWP(U);
        unsigned short zf[8], qv[8], vv[8], gg[8], sv[8];
#pragma unroll
        for (int i = 0; i < 8; ++i) { zf[i] = rp[(size_t)i * ZP + Z_CF]; qv[i] = rp[(size_t)i * ZP + Z_CQ]; vv[i] = rp[(size_t)i * ZP + Z_CI]; gg[i] = rp[(size_t)i * ZP + Z_CG]; sv[i] = Sst[(size_t)U * 4096 + (8 * seg + i) * 64 + d]; }
        float kk[8], bb[8], bm, bl; hgrn_front(p, l, zf, h, d, seg, SEG, kk, bb, bm, bl); (void)bl;
        { const float ebm = __expf(bm); unsigned vw[4];
#pragma unroll
          for (int i = 0; i < 8; ++i) { const int t = 8 * seg + i;
              Pt[t * HP + d] = (bf16)f2bf(bf2f(qv[i]) * __expf(fminf(bb[i] - bm, 80.f))); Rt[t * HP + d] = (bf16)f2bf(kk[i] * __expf(fminf(bm - bb[i], 80.f)));
              ST[t * HP + d] = (bf16)f2bf(bf2f(sv[i]) * ebm); CG[t * HP + d] = (bf16)gg[i]; }
#pragma unroll
          for (int i = 0; i < 4; ++i) vw[i] = (unsigned)vv[2 * i] | ((unsigned)vv[2 * i + 1] << 16);
          *(LAS u32x4*)(VT + d * HP + 8 * seg) = (u32x4){vw[0], vw[1], vw[2], vw[3]}; }
        WG_BAR_LDS();
        if (wave < 2) { const int ib = wave;
            u32x4 pw[2][2];
#pragma unroll
            for (int k = 0; k < 2; ++k) { f32x16 a = {};
                if (k <= ib) {
#pragma unroll
                    for (int js = 0; js < 4; ++js) { const bf16x8 ra = *(const LAS bf16x8*)(Rt + (32 * k + r32) * HP + 16 * js + 8 * hi), pb = *(const LAS bf16x8*)(Pt + (32 * ib + r32) * HP + 16 * js + 8 * hi);
                        a = MFMA32(ra, pb, a); }
                    if (k == ib) {
#pragma unroll
                        for (int r = 0; r < 16; ++r) if (crow(r, hi) > r32) a[r] = 0.f;
                    }
                }
#pragma unroll
                for (int i = 0; i < 4; ++i) { pw[k][0][i] = cvtpk(a[2 * i], a[2 * i + 1]); pw[k][1][i] = cvtpk(a[8 + 2 * i], a[8 + 2 * i + 1]); } }
            f32x16 oacc[2]; float ss = 0.f;
#pragma unroll
            for (int j = 0; j < 2; ++j) { f32x16 oa = {};
#pragma unroll
                for (int k = 0; k < 2; ++k) { if (k <= ib) {
#pragma unroll
                    for (int st = 0; st < 2; ++st) { const LAS bf16* vp = VT + (32 * j + r32) * HP + 32 * k + 16 * st + 4 * hi;
                        const s16x4 v0 = *(const LAS s16x4*)vp, v1 = *(const LAS s16x4*)(vp + 8);
                        const bf16x8 vf = {v0[0], v0[1], v0[2], v0[3], v1[0], v1[1], v1[2], v1[3]};
                        oa = MFMA32(vf, __builtin_bit_cast(bf16x8, pw[k][st]), oa); } } }
#pragma unroll
                for (int js = 0; js < 4; ++js) { const bf16x8 sa = *(const LAS bf16x8*)(ST + (32 * j + r32) * HP + 16 * js + 8 * hi), pb = *(const LAS bf16x8*)(Pt + (32 * ib + r32) * HP + 16 * js + 8 * hi);
                    oa = MFMA32(sa, pb, oa); }
#pragma unroll
                for (int r = 0; r < 16; ++r) ss += oa[r] * oa[r];
                oacc[j] = oa; }
            ss = swapsum(ss);
            const float rstd = 1.0f / sqrtf(ss * (1.0f / 64.0f) + RMS_EPS);
            bf16* orow = Ob + (size_t)(t0 + 32 * ib + r32) * OP + 1024 + h * 64;
#pragma unroll
            for (int j = 0; j < 2; ++j)
#pragma unroll
                for (int rr = 0; rr < 4; ++rr) { const int e0 = 32 * j + 8 * rr + 4 * hi; const f32x4 g4 = *(const f32x4*)(gn + h * 64 + e0);
                    const u32x2 cw = *(const LAS u32x2*)(CG + (32 * ib + r32) * HP + e0);
                    const float o0 = oacc[j][4 * rr] * rstd * g4[0] * sigmoidf_(bflo(cw.x)), o1 = oacc[j][4 * rr + 1] * rstd * g4[1] * sigmoidf_(bfhi(cw.x));
                    const float o2 = oacc[j][4 * rr + 2] * rstd * g4[2] * sigmoidf_(bflo(cw.y)), o3 = oacc[j][4 * rr + 3] * rstd * g4[3] * sigmoidf_(bfhi(cw.y));
                    *(u32x2*)(orow + e0) = (u32x2){cvtpk(o0, o1), cvtpk(o2, o3)}; }
        }
        WG_BAR_LDS();
    }
}

#undef H_ROWP
constexpr int RT_LG = 0, RT_HIST = 8 * 2048, RT_END = RT_HIST + 1024;
static_assert(RT_END <= SCR_BYTES, "router LDS");
typedef short bf16x8_t __attribute__((ext_vector_type(8)));
__device__ __forceinline__ void split_hi_lo(const f32x4 a, const f32x4 b, bf16x8_t& hi, bf16x8_t& lo) {
    const float v[8] = {a.x, a.y, a.z, a.w, b.x, b.y, b.z, b.w}; unsigned h[8], l[8];
#pragma unroll
    for (int i = 0; i < 8; ++i) { h[i] = f2bf(v[i]); l[i] = f2bf(v[i] - bf2f(h[i])); }
    const u32x4 hw = {h[0] | (h[1] << 16), h[2] | (h[3] << 16), h[4] | (h[5] << 16), h[6] | (h[7] << 16)}, lw = {l[0] | (l[1] << 16), l[2] | (l[3] << 16), l[4] | (l[5] << 16), l[6] | (l[7] << 16)};
    hi = __builtin_bit_cast(bf16x8_t, hw); lo = __builtin_bit_cast(bf16x8_t, lw);
}
__device__ __forceinline__ void ln1_phase(KP p, int l, const float* xin, LAS unsigned char* lds, int G, int tid, int wave, int lane) {
    unsigned char* ws = p->ws; const bf16* mix = (const bf16*)(ws + WS_MIX); float* x1 = (float*)(ws + WS_X1); bf16* x1b = (bf16*)(ws + WS_X1B);
    int* tke = (int*)(ws + WS_TKE); float* tkg = (float*)(ws + WS_TKG); int* wgcnt = (int*)(ws + WS_WGCNT);
    LAS float* LG = (LAS float*)(lds + RT_LG) + wave * 512; LAS unsigned* hist = (LAS unsigned*)(lds + RT_HIST);
    if (tid < 32) hist[tid] = 0u;
    WG_BAR();
    const float* lg = p->ln1_g + l * 1024; const float* lb = p->ln1_b + l * 1024;
    f32x4 gv[4], bv[4];
#pragma unroll
    for (int j = 0; j < 4; ++j) { gv[j] = *(const f32x4*)(lg + 4 * lane + 256 * j); bv[j] = *(const f32x4*)(lb + 4 * lane + 256 * j); }
    const int m0 = blockIdx.x * NWAVES + wave, mstride = G * NWAVES;
    for (int mb = m0; mb < NTOK; mb += 16 * mstride) {
        f32x4 xa[4], xm[4];
#define LOAD_XIN(mm) do { if (l == 0) { const f32x4* xr = (const f32x4*)(xin + (size_t)(mm) * DM) + lane; _Pragma("unroll") for (int j = 0; j < 4; ++j) xa[j] = xr[64 * j]; } \
            else { const u32x2* xr = (const u32x2*)((const bf16*)(ws + WS_XB) + (size_t)(mm) * DM) + lane; _Pragma("unroll") for (int j = 0; j < 4; ++j) { const u32x2 w = xr[64 * j]; xa[j] = (f32x4){bflo(w.x), bfhi(w.x), bflo(w.y), bfhi(w.y)}; } } } while (0)
        { LOAD_XIN(mb); const u32x2* mr = (const u32x2*)(mix + (size_t)mb * DM) + lane;
#pragma unroll
          for (int j = 0; j < 4; ++j) { const u32x2 w = mr[64 * j]; xm[j] = (f32x4){bflo(w.x), bfhi(w.x), bflo(w.y), bfhi(w.y)}; } }
#pragma unroll 1
        for (int i = 0; i < 16; ++i) { const int m = mb + i * mstride; if (m >= NTOK) break;
            f32x4 v[4]; float s = 0.f;
#pragma unroll
            for (int j = 0; j < 4; ++j) { v[j] = xa[j] * ALPHA + xm[j]; s += (v[j].x + v[j].y) + (v[j].z + v[j].w); }
            { const int mn = (m + mstride < NTOK) ? m + mstride : m;
              LOAD_XIN(mn); const u32x2* mr = (const u32x2*)(mix + (size_t)mn * DM) + lane;
#pragma unroll
              for (int j = 0; j < 4; ++j) { const u32x2 w = mr[64 * j]; xm[j] = (f32x4){bflo(w.x), bfhi(w.x), bflo(w.y), bfhi(w.y)}; } }
            const float mean = wave_sum(s) * (1.f / DM); float s2 = 0.f;
#pragma unroll
            for (int j = 0; j < 4; ++j) { v[j] = v[j] - mean; s2 += (v[j].x * v[j].x + v[j].y * v[j].y) + (v[j].z * v[j].z + v[j].w * v[j].w); }
            const float rstd = 1.f / sqrtf(wave_sum(s2) * (1.f / DM) + LN_EPS);
            f32x4* o4 = (f32x4*)(x1 + (size_t)m * DM) + lane; unsigned* o1 = (unsigned*)((unsigned char*)x1b + (size_t)m * DM) + lane;
#pragma unroll
            for (int j = 0; j < 4; ++j) { v[j] = v[j] * rstd * gv[j] + bv[j]; o4[64 * j] = v[j]; int w8 = __builtin_amdgcn_cvt_pk_fp8_f32(v[j].x, v[j].y, 0, false); w8 = __builtin_amdgcn_cvt_pk_fp8_f32(v[j].z, v[j].w, w8, true); o1[64 * j] = (unsigned)w8; } }
        asm volatile("s_waitcnt vmcnt(0)" ::: "memory"); __builtin_amdgcn_fence(__ATOMIC_ACQUIRE, "agent"); asm volatile("s_waitcnt vmcnt(0)" ::: "memory");
        { const int ti = lane & 15, kg = lane >> 4; int mt = mb + ti * mstride; if (mt >= NTOK) mt = mb;
          const float* xr = x1 + (size_t)mt * DM + 8 * kg; const bf16* wf = (const bf16*)(ws + WS_WRF) + (size_t)l * 32 * 2 * 2 * 512 + lane * 8;
          f32x4 acc0 = {0.f, 0.f, 0.f, 0.f}, acc1 = {0.f, 0.f, 0.f, 0.f};
#pragma unroll 4
          for (int s = 0; s < 32; ++s) { const f32x4 a0 = *(const f32x4*)(xr + 32 * s), a1 = *(const f32x4*)(xr + 32 * s + 4); bf16x8_t ah, al; split_hi_lo(a0, a1, ah, al);
              const bf16x8_t w0h = *(const bf16x8_t*)(wf + (size_t)(s * 4 + 0) * 512), w0l = *(const bf16x8_t*)(wf + (size_t)(s * 4 + 1) * 512), w1h = *(const bf16x8_t*)(wf + (size_t)(s * 4 + 2) * 512), w1l = *(const bf16x8_t*)(wf + (size_t)(s * 4 + 3) * 512);
              acc0 = __builtin_amdgcn_mfma_f32_16x16x32_bf16(ah, w0h, acc0, 0, 0, 0); acc0 = __builtin_amdgcn_mfma_f32_16x16x32_bf16(al, w0h, acc0, 0, 0, 0); acc0 = __builtin_amdgcn_mfma_f32_16x16x32_bf16(ah, w0l, acc0, 0, 0, 0);
              acc1 = __builtin_amdgcn_mfma_f32_16x16x32_bf16(ah, w1h, acc1, 0, 0, 0); acc1 = __builtin_amdgcn_mfma_f32_16x16x32_bf16(al, w1h, acc1, 0, 0, 0); acc1 = __builtin_amdgcn_mfma_f32_16x16x32_bf16(ah, w1l, acc1, 0, 0, 0); }
#pragma unroll
          for (int r = 0; r < 4; ++r) { LG[(4 * kg + r) * 32 + ti] = acc0[r]; LG[(4 * kg + r) * 32 + 16 + ti] = acc1[r]; } }
        LDS_WAIT();
        if (lane < 16) { const int m = mb + lane * mstride;
            if (m < NTOK) { float tv0 = -3e38f, tv1 = -3e38f, tv2 = -3e38f, tv3 = -3e38f; int ti0 = 0, ti1 = 0, ti2 = 0, ti3 = 0;
#pragma unroll
                for (int e4 = 0; e4 < 8; ++e4) { const f32x4 lv = *(const LAS f32x4*)(LG + lane * 32 + 4 * e4); const f32x4 bb = *(const f32x4*)(p->b_router + l * 32 + 4 * e4);
#pragma unroll
                    for (int i = 0; i < 4; ++i) { const float g = lv[i] + bb[i]; const int e = 4 * e4 + i;
                        if (g > tv0) { tv3 = tv2; ti3 = ti2; tv2 = tv1; ti2 = ti1; tv1 = tv0; ti1 = ti0; tv0 = g; ti0 = e; }
                        else if (g > tv1) { tv3 = tv2; ti3 = ti2; tv2 = tv1; ti2 = ti1; tv1 = g; ti1 = e; }
                        else if (g > tv2) { tv3 = tv2; ti3 = ti2; tv2 = g; ti2 = e; }
                        else if (g > tv3) { tv3 = g; ti3 = e; } } }
                const float e1 = __expf(tv1 - tv0), e2 = __expf(tv2 - tv0), e3 = __expf(tv3 - tv0); const float inv = 1.f / (1.f + e1 + e2 + e3);
                *(int4*)(tke + m * 4) = make_int4(ti0, ti1, ti2, ti3); *(f32x4*)(tkg + m * 4) = (f32x4){inv, e1 * inv, e2 * inv, e3 * inv};
                __hip_atomic_fetch_add(hist + ti0, 1u, __ATOMIC_RELAXED, __HIP_MEMORY_SCOPE_WORKGROUP); __hip_atomic_fetch_add(hist + ti1, 1u, __ATOMIC_RELAXED, __HIP_MEMORY_SCOPE_WORKGROUP);
                __hip_atomic_fetch_add(hist + ti2, 1u, __ATOMIC_RELAXED, __HIP_MEMORY_SCOPE_WORKGROUP); __hip_atomic_fetch_add(hist + ti3, 1u, __ATOMIC_RELAXED, __HIP_MEMORY_SCOPE_WORKGROUP); } }
        LDS_WAIT();
    }
    WG_BAR();
    if (tid < 32) wgcnt[blockIdx.x * 32 + tid] = (int)hist[tid];
}

__device__ __forceinline__ void slot_phase(KP p, LAS unsigned char* lds, int G, int tid, int wave, int lane) {
    unsigned char* ws = p->ws; const int* wgcnt = (const int*)(ws + WS_WGCNT); int* blk = (int*)(ws + WS_BLK);
    const int* tke = (const int*)(ws + WS_TKE); const float* tkg = (const float*)(ws + WS_TKG); int* tokslot = (int*)(ws + WS_TOKSLOT); float* gslot = (float*)(ws + WS_GSLOT);
    LAS unsigned* tot = (LAS unsigned*)lds; LAS unsigned* mine = tot + 32; LAS unsigned* cur = tot + 64;
    if (tid < 96) tot[tid] = 0u;
    WG_BAR();
    { const int e = tid & 31, part = tid >> 5; unsigned sa = 0u, sb = 0u;
      for (int w = part; w < G; w += 16) { const unsigned c = (unsigned)wgcnt[w * 32 + e]; sa += c; if (w < (int)blockIdx.x) sb += c; }
      __hip_atomic_fetch_add(tot + e, sa, __ATOMIC_RELAXED, __HIP_MEMORY_SCOPE_WORKGROUP); __hip_atomic_fetch_add(mine + e, sb, __ATOMIC_RELAXED, __HIP_MEMORY_SCOPE_WORKGROUP); }
    WG_BAR();
    if (tid == 0) { unsigned off = 0u;
#pragma unroll 1
        for (int e = 0; e < 32; ++e) { const unsigned padded = (tot[e] + 255u) & ~255u; cur[e] = off + mine[e];
            if (blockIdx.x == 0) { blk[BST_OFF + e] = (int)(off >> 8);
#pragma unroll 1
                for (unsigned bb = off >> 8; bb < ((off + padded) >> 8); ++bb) blk[16 + bb] = e; }
            off += padded; }
        if (blockIdx.x == 0) { blk[0] = (int)(off >> 8); blk[BST_OFF + 32] = (int)(off >> 8); } }
    WG_BAR();
    int* slottok = (int*)(ws + WS_SLOTTOK);
    if (blockIdx.x == 0 && tid < 32) { const unsigned ps = cur[tid], n = tot[tid];
        int zero_ = 0; asm volatile("" : "+v"(zero_));
#pragma unroll 1
        for (unsigned s = ps + n; s < ps + ((n + 255u) & ~255u); ++s) slottok[s] = zero_; }
    WG_BAR();
    for (int m = blockIdx.x * NWAVES + wave; m < NTOK; m += G * NWAVES) {
        if (lane < 4) { const int e = tke[m * 4 + lane]; const int slot = (int)__hip_atomic_fetch_add(cur + e, 1u, __ATOMIC_RELAXED, __HIP_MEMORY_SCOPE_WORKGROUP); tokslot[m * 4 + lane] = slot; gslot[slot] = tkg[m * 4 + lane]; slottok[slot] = m; }
    }
}

__device__ __forceinline__ void comb_phase(KP p, int l, float* xout, int G, int wave, int lane) {
    unsigned char* ws = p->ws; const float* x1 = (const float*)(ws + WS_X1); const bf16* y = (const bf16*)(ws + WS_Y); const int* tokslot = (const int*)(ws + WS_TOKSLOT); bf16* xb = (bf16*)(ws + WS_XB);
    const float* lg = p->ln2_g + l * 1024; const float* lb = p->ln2_b + l * 1024;
    f32x4 gv[4], bv[4];
#pragma unroll
    for (int j = 0; j < 4; ++j) { gv[j] = *(const f32x4*)(lg + 4 * lane + 256 * j); bv[j] = *(const f32x4*)(lb + 4 * lane + 256 * j); }
    for (int m = blockIdx.x * NWAVES + wave; m < NTOK; m += G * NWAVES) {
        const f32x4* xr = (const f32x4*)(x1 + (size_t)m * DM) + lane;
        f32x4 v[4];
#pragma unroll
        for (int j = 0; j < 4; ++j) v[j] = xr[64 * j] * ALPHA;
#pragma unroll
        for (int k = 0; k < 4; ++k) { const int sk = __builtin_amdgcn_readfirstlane(tokslot[m * 4 + k]); const u32x2* yr = (const u32x2*)(y + (size_t)sk * DM) + lane;
#pragma unroll
            for (int j = 0; j < 4; ++j) { const u32x2 w = yr[64 * j]; v[j].x += bflo(w.x); v[j].y += bfhi(w.x); v[j].z += bflo(w.y); v[j].w += bfhi(w.y); } }
        float s = 0.f;
#pragma unroll
        for (int j = 0; j < 4; ++j) s += (v[j].x + v[j].y) + (v[j].z + v[j].w);
        const float mean = wave_sum(s) * (1.f / DM); float s2 = 0.f;
#pragma unroll
        for (int j = 0; j < 4; ++j) { v[j] = v[j] - mean; s2 += (v[j].x * v[j].x + v[j].y * v[j].y) + (v[j].z * v[j].z + v[j].w * v[j].w); }
        const float rstd = 1.f / sqrtf(wave_sum(s2) * (1.f / DM) + LN_EPS);
        f32x4* o4 = (f32x4*)(xout + (size_t)m * DM) + lane; u32x2* o2 = (u32x2*)(xb + (size_t)m * DM) + lane;
#pragma unroll
        for (int j = 0; j < 4; ++j) { v[j] = v[j] * rstd * gv[j] + bv[j]; if (l == DEPTH - 1) o4[64 * j] = v[j]; else o2[64 * j] = (u32x2){pk2(v[j].x, v[j].y), pk2(v[j].z, v[j].w)}; }
    }
}

#ifndef ONE_LAUNCH
#define ONE_LAUNCH 1
#endif
__global__ void __launch_bounds__(NTHR, 2) fwd(Params p) {
    extern __shared__ __attribute__((aligned(16))) unsigned char lds_raw[];
    LAS unsigned char* lds = (LAS unsigned char*)lds_raw;
    volatile LAS unsigned* MISC = (volatile LAS unsigned*)(lds + MISC_OFF);
    const int tid = threadIdx.x, lane = tid & 63, wave = __builtin_amdgcn_readfirstlane(tid >> 6); const int wave0 = wave;
    const int G = gridDim.x; const int bx = blockIdx.x; const int vcu = (G % 8 == 0) ? (bx % 8) * (G / 8) + bx / 8 : bx;
    if (tid < 64) MISC[tid] = 0u;
    __syncthreads();
    if (p.use_bar) (void)xcd_barrier_post((unsigned*)(p.ws + WS_CTL) + CW_BAR, MISC + 8);
    const int lo = p.ph_lo, hi = p.ph_hi;
#ifndef PHSEL
#define PHSEL(k) true
#endif
#define IN(k) (PHSEL(k) && lo <= (k) && (k) < hi)
#define SEAM(k) do { if (lo <= (k) && (k) + 1 < hi) { KP qb_ = load_params(); XcdBarrier b_; b_.bar = (unsigned*)(qb_->ws + WS_CTL) + CW_BAR; b_.x = xb_xcc_id(); b_.st = MISC + 8; xcd_barrier(b_); } } while (0)
    const int gw0 = vcu * NWAVES + wave, NGW = G * NWAVES;
#define PH_IDS const int lane = lane_id(), wave = wave0, tid = wave0 * 64 + lane, gw = vcu * NWAVES + wave; (void)lane; (void)gw; (void)gw0;

    if (IN(0)) { PH_IDS KP q = load_params(); p0_prologue(q, lds, gw, NGW, wave, lane); SEAM(0); }

    for (int l = 0; l < DEPTH; ++l) {
        const int pb = 1 + l * NPH_LAYER;

        if (IN(pb + PH_INPROJ)) {
            KP q = load_params(); unsigned char* w = q->ws;
            pg8::Gemm g{(const bf16*)(w + WS_XB), (const bf16*)(w + WS_WIN) + (size_t)l * ZP * 1024, NTOK, ZP, 1024}; pg8::StaticOrder S; S.init(NTOK, ZP, G, bx);
            pg8::EpiZ E{(bf16*)(w + WS_Z), ZP, (const float*)(w + WS_TRIG), (bf16*)(w + WS_IKC)};
            pg8::gemm_phase<pg8::EpiZ, pg8::StaticOrder, true, true>(lds, g, S, E, wave0);
            SEAM(pb + PH_INPROJ);
        }
        if (IN(pb + PH_IDX)) { PH_IDS KP q = load_params(); idx_phase(q, l, lds, vcu, G, tid, wave, lane); SEAM(pb + PH_IDX); }
        if (IN(pb + PH_ATTN)) { PH_IDS KP q = load_params(); attn_phase(q, l, lds, vcu, G, wave0); SEAM(pb + PH_ATTN); }
        if (IN(pb + PH_H1)) { PH_IDS KP q = load_params(); h1_phase(q, l, lds, vcu, G, tid, wave, lane); SEAM(pb + PH_H1); }
        if (IN(pb + PH_H2)) { PH_IDS KP q = load_params(); h2_phase(q, G, tid); SEAM(pb + PH_H2); }
        if (IN(pb + PH_H3)) { PH_IDS KP q = load_params(); h3_phase(q, l, lds, vcu, G, tid, wave, lane); SEAM(pb + PH_H3); }
        if (IN(pb + PH_MERGE)) {
            KP q = load_params(); unsigned char* w = q->ws;
            pg8::Gemm g{(const bf16*)(w + WS_OBUF), (const bf16*)(w + WS_WP) + (size_t)l * 1024 * 1536, NTOK, 1024, 1536}; pg8::StaticOrder S; S.init(NTOK, 1024, G, bx);
            pg8::EpiMerge E{(const bf16*)(w + WS_Z) + Z_GT, ZP, (bf16*)(w + WS_MERGED), 1024};
            pg8::gemm_phase<pg8::EpiMerge, pg8::StaticOrder, true, true>(lds, g, S, E, wave0);
            SEAM(pb + PH_MERGE);
        }
        if (IN(pb + PH_WOUT)) {
            KP q = load_params(); unsigned char* w = q->ws;
            pg8::Gemm g{(const bf16*)(w + WS_MERGED), (const bf16*)(w + WS_WOUT) + (size_t)l * 1024 * 1024, NTOK, 1024, 1024}; pg8::StaticOrder S; S.init(NTOK, 1024, G, bx);
            pg8::EpiBf16 E{(bf16*)(w + WS_MIX), 1024};
            pg8::gemm_phase<pg8::EpiBf16, pg8::StaticOrder, true, true>(lds, g, S, E, wave0);
            SEAM(pb + PH_WOUT);
        }
        if (IN(pb + PH_LN1)) { PH_IDS KP q = load_params(); const float* xin = (l == 0) ? q->x : (const float*)(q->ws + WS_XCUR); ln1_phase(q, l, xin, lds, G, tid, wave, lane); SEAM(pb + PH_LN1); }
        if (IN(pb + PH_SLOT)) { PH_IDS KP q = load_params(); slot_phase(q, lds, G, tid, wave, lane); SEAM(pb + PH_SLOT); }
        if (IN(pb + PH_GU)) {
            KP q = load_params(); unsigned char* w = q->ws;
            pg8::Gemm g{(const bf16*)(w + WS_X1B), (const bf16*)(w + WS_WGU + (size_t)l * 32 * 2048 * 1024), MAXSLOT, 32 * 2048, 1024};
            pg8::moe_build_list((LAS int*)(lds + pg8::STAGE_BYTES), (const int*)(w + WS_BLK), 8, G, bx, wave0 * 64 + lane_id()); pg8::MoeOrderG S{(const LAS int*)(lds + pg8::STAGE_BYTES), (const int*)(w + WS_SLOTTOK)};
            pg8::EpiSwiGLU E{(bf16*)(w + WS_ACT), (const float*)(w + WS_BGU) + (size_t)l * 32 * 2048, 8};
            pg8::gemm_phase<pg8::EpiSwiGLU, pg8::MoeOrderG, true, true, true, W8_E8M0>(lds, g, S, E, wave0);
            SEAM(pb + PH_GU);
        }
        if (IN(pb + PH_DOWN)) {
            KP q = load_params(); unsigned char* w = q->ws;
            pg8::Gemm g{(const bf16*)(w + WS_ACT), (const bf16*)(w + WS_WDN + (size_t)l * 32 * 1024 * 1024), MAXSLOT, 32 * 1024, 1024};
            pg8::moe_build_list((LAS int*)(lds + pg8::STAGE_BYTES), (const int*)(w + WS_BLK), 4, G, bx, wave0 * 64 + lane_id()); pg8::MoeOrder S{(const LAS int*)(lds + pg8::STAGE_BYTES), nullptr};
            pg8::EpiDown E{(bf16*)(w + WS_Y), q->b_down + (size_t)l * 32 * 1024, (const float*)(w + WS_GSLOT), 4};
            pg8::gemm_phase<pg8::EpiDown, pg8::MoeOrder, true, true, true, W8_E8M0>(lds, g, S, E, wave0);
            SEAM(pb + PH_DOWN);
        }
        if (IN(pb + PH_COMB)) { PH_IDS KP q = load_params(); float* xout = (l == DEPTH - 1) ? q->out : (float*)(q->ws + WS_XCUR); comb_phase(q, l, xout, G, wave, lane); SEAM(pb + PH_COMB); }
    }
#undef IN
#undef SEAM
}

#ifndef DBG
#define DBG 0
#endif
#if DBG
constexpr int CW_DBG = 64;
__device__ __forceinline__ unsigned hsh(unsigned a) { a ^= a >> 16; a *= 0x7feb352du; a ^= a >> 15; a *= 0x846ca68bu; a ^= a >> 16; return a; }
__device__ __forceinline__ void dbg_fail(Params& p, int id) { atomicMin((int*)(p.ws + WS_CTL) + CW_DBG, id); }
__device__ __forceinline__ bool bad(float a, float ref, float rel, float abs_) { return !(fabsf(a - ref) <= rel * fabsf(ref) + abs_); }
__device__ __forceinline__ float dotx(const float* xr, const float* W, int ld, int col, int K) { float s = 0.f; for (int k = 0; k < K; ++k) s += xr[k] * W[(size_t)k * ld + col]; return s; }

__global__ void __launch_bounds__(64) chk(Params p, int l, int which) {
    __shared__ float Ssh[64 * 65];
    unsigned char* ws = p.ws; const int gt_ = blockIdx.x * 64 + threadIdx.x; const unsigned h0 = hsh(gt_ * 2654435761u + which * 97u + 12345u), h1 = hsh(h0 + 0x9e3779b9u), h2 = hsh(h1 + 77u);
    const float* xin = (l == 0) ? p.x : (const float*)(ws + WS_XCUR);
    const bf16* Z = (const bf16*)(ws + WS_Z);
    const int id = (l * 20 + which) * 4;
    const float* win = p.w_in + (size_t)l * 1024 * D_IN;
    if (which == 1) {
        const int t = h0 % NTOK, n = h1 % D_IN; const int sc = zcol_src(n); const float scale = (n < 512 || (n >= Z_FQ && n < Z_FK)) ? QSCALE : 1.f;
        const float ref = dotx(xin + (size_t)t * DM, win, D_IN, sc, 1024) * scale;
        if (bad(bf2f(Z[(size_t)t * ZP + n]), ref, 0.03f, 0.03f)) dbg_fail(p, id);
    } else if (which == 2) {
        const int t = h0 % NTOK, pos = t & (SEQ - 1), b = t >> 13; const float* xr = xin + (size_t)t * DM;
        { const int hh = h1 % 21, i = h2 & 31; const int col = hh < 8 ? Z_AQ + hh * 64 : hh < 16 ? Z_AK + (hh - 8) * 64 : hh < 20 ? Z_IQ + (hh - 16) * 64 : Z_IK;
          const float sc = hh < 8 ? QSCALE : 1.f; const float t1 = dotx(xr, win, D_IN, zcol_src(col + i), 1024) * sc, t2 = dotx(xr, win, D_IN, zcol_src(col + i + 32), 1024) * sc;
          const float inv = powf(10000.f, -(float)i / 32.f); const float ang = (float)pos * inv; const double rev = (double)ang * 0.15915494309189535; const float fr = (float)(rev - __builtin_rint(rev));
          const float c = __builtin_amdgcn_cosf(fr), s = __builtin_amdgcn_sinf(fr);
          if (bad(bf2f(Z[(size_t)t * ZP + col + i]), t1 * c - t2 * s, 0.03f, 0.03f) || bad(bf2f(Z[(size_t)t * ZP + col + i + 32]), t2 * c + t1 * s, 0.03f, 0.03f)) dbg_fail(p, id); }
        { const int c = h2 % 1024; const float a0 = dotx(xr, win, D_IN, 5452 + c, 1024), a1 = dotx(xr, win, D_IN, 5452 + 1024 + c, 1024), a2 = dotx(xr, win, D_IN, 5452 + 2048 + c, 1024);
          const float g0 = sigmoidf_(a0), g1 = sigmoidf_(a1), g2 = sigmoidf_(a2);
          if (bad(bf2f(Z[(size_t)t * ZP + Z_GT + c]), g0 / g1, 0.05f, 0.01f) || bad(bf2f(Z[(size_t)t * ZP + Z_GT + 1024 + c]), g1 / g2, 0.05f, 0.01f) || bad(bf2f(Z[(size_t)t * ZP + Z_GT + 2048 + c]), g2, 0.05f, 0.01f)) dbg_fail(p, id + 1); }
        { const int hh = h1 & 7; const float v = dotx(xr, win, D_IN, 3396 + hh, 1024) + p.b_fox[l * 8 + hh]; const float ls = -log1pf(expf(-v)) * LOG2E;
          if (bad(((const float*)(ws + WS_LFT))[(size_t)(b * 8 + hh) * SEQ + pos], ls, 0.05f, 0.003f)) dbg_fail(p, id + 2); }
    } else if (which == 3) {
        { const int bh = h0 & 31, t = h1 % SEQ; const float* lf = (const float*)(ws + WS_LFT) + (size_t)bh * SEQ; float s = 0.f; for (int i = 0; i <= t; ++i) s += lf[i];
          if (bad(((const float*)(ws + WS_CT))[(size_t)bh * SEQ + t], s, 1e-3f, 1e-2f)) dbg_fail(p, id); }
        if (gt_ < 192) { const int b = h1 & 3, q = (gt_ < 32) ? (int)(h2 % 512) : (int)(h2 % SEQ); const int nadm = ((q >> 6) + 1) * 64; const u64* mw = (const u64*)(ws + WS_MASKW) + (size_t)(b * SEQ + q) * 128;
          int pc = 0; bool oob = false; for (int w = 0; w < 128; ++w) { const u64 m = mw[w]; pc += __popcll(m); if (w * 64 >= nadm && m) oob = true; }
          if (pc != (nadm < 256 ? nadm : 256) || oob) dbg_fail(p, id + 1);
          const bf16* qr = Z + (size_t)(b * SEQ + q) * ZP; float minsel = 3e38f, maxun = -3e38f;
          for (int s = 0; s < nadm; ++s) { const bf16* kr = Z + (size_t)(b * SEQ + s) * ZP + Z_IK; float sc = 0.f;
              for (int hd = 0; hd < 4; ++hd) { float d = 0.f; for (int k = 0; k < 64; ++k) d += bf2f(qr[Z_IQ + hd * 64 + k]) * bf2f(kr[k]); sc += bf2f(qr[Z_IW + hd]) * 0.0625f * fmaxf(d, 0.f); }
              if ((mw[s >> 6] >> (s & 63)) & 1ull) minsel = fminf(minsel, sc); else maxun = fmaxf(maxun, sc); }
          if (nadm > 256 && !(maxun <= minsel + 0.02f * fabsf(minsel) + 2e-3f)) dbg_fail(p, id + 2); }
    } else if (which == 4) {
        if (gt_ == 0 && l == 0) { const bf16* ob = (const bf16*)(ws + WS_OBUF) + 512;
            const float a0 = bf2f(ob[0]), a1 = bf2f(ob[1]), a3 = bf2f(ob[3]), b0 = bf2f(ob[8]), b1 = bf2f(ob[9]), b3 = bf2f(ob[11]), m0 = bf2f(ob[4]), m1 = bf2f(ob[12]);
            auto tr = [](float v) { return v == 0.f ? 0.f : v == 1.f ? 1.f : 2.f; };
            ((float*)(ws + WS_CTL))[CW_DBG + 2] = 10.f * (tr(a0) + 3.f * tr(b0) + 9.f * tr(a1) + 27.f * tr(b1));
            ((float*)(ws + WS_CTL))[CW_DBG + 3] = sqrtf(10.f * (tr(a3) + 3.f * tr(b3) + 9.f * (m0 == m1 ? 1.f : 0.f) + 27.f * (m0 > -1e20f ? 1.f : 0.f))); }
        const int mode = gt_ & 1, b = h0 & 3, h = (h0 >> 2) & 7, q = (gt_ < 64) ? (int)(h1 % 300) : (int)(h1 % SEQ), d = h2 & 63;
        const int QC = mode == 0 ? Z_FQ : Z_AQ, KC = mode == 0 ? Z_FK : Z_AK, VC = mode == 0 ? Z_FV : Z_AV, OC = mode == 0 ? 512 : 0;
        const bf16* qr = Z + (size_t)(b * SEQ + q) * ZP + QC + h * 64; const float* c = (const float*)(ws + WS_CT) + (size_t)(b * 8 + h) * SEQ; const u64* mw = (const u64*)(ws + WS_MASKW) + (size_t)(b * SEQ + q) * 128;
        const int ns = mode == 0 ? q + 1 : ((q >> 6) + 1) * 64; float mx = -3e38f, mx2 = -3e38f; float ref = 0.f, ref2 = 0.f;
        for (int pass = 0; pass < 2; ++pass) { float den = 0.f, num = 0.f, den2 = 0.f, num2 = 0.f;
            for (int s = 0; s < ns; ++s) { if (mode == 1 && !((mw[s >> 6] >> (s & 63)) & 1ull)) continue;
                const bf16* kr = Z + (size_t)(b * SEQ + s) * ZP + KC + h * 64; float lg = 0.f; for (int k = 0; k < 64; ++k) lg += bf2f(qr[k]) * bf2f(kr[k]);
                const float lg2 = lg; if (mode == 0) lg += c[q] - c[s];
                if (pass == 0) { mx = fmaxf(mx, lg); mx2 = fmaxf(mx2, lg2); } else { const float vv = bf2f(Z[(size_t)(b * SEQ + s) * ZP + VC + h * 64 + d]); const float pp = exp2f(lg - mx), pq = exp2f(lg2 - mx2); den += pp; num += pp * vv; den2 += pq; num2 += pq * vv; } }
            if (pass == 1) { ref = num / den; ref2 = num2 / den2; } }
        const float got = bf2f(((const bf16*)(ws + WS_OBUF))[(size_t)(b * SEQ + q) * OP + OC + h * 64 + d]);
        if (bad(got, ref, 0.04f, 0.03f)) { dbg_fail(p, id + mode);
            int m = 0; if (mode == 0 && q == 0) m |= 1; if (mode == 0 && q < 32) m |= 2; if (mode == 1 && q < 64) m |= 4; if (mode == 1 && q >= 64) m |= 8; atomicOr((int*)(p.ws + WS_CTL) + CW_DBG + 1, m); }
    } else if (which == 7) {
        const int b = blockIdx.x & 3, h = (blockIdx.x >> 2) & 7, e = threadIdx.x;
        for (int d = 0; d < 64; ++d) Ssh[d * 65 + e] = 0.f;
        const float lbv_e = 0.f; (void)lbv_e;
        for (int t = 0; t < 200; ++t) { const bf16* zr = Z + (size_t)(b * SEQ + t) * ZP + h * 64; float o = 0.f; const float ve = bf2f(zr[Z_CI + e]);
            for (int d = 0; d < 64; ++d) { const int dd = h * 64 + d; const float lb = (l == 0) ? 0.f : sigmoidf_(p.lb_logits[512 + dd] - p.lb_logits[dd]);
                const float sg = sigmoidf_(bf2f(zr[Z_CF + d])); const float f = lb + (1.f - lb) * sg, kk = (1.f - lb) * (1.f - sg);
                const float S = f * Ssh[d * 65 + e] + kk * ve; Ssh[d * 65 + e] = S; o += bf2f(zr[Z_CQ + d]) * S; }
            const float ss = wave_sum(o * o); const float ref = o * (1.f / sqrtf(ss * (1.f / 64.f) + RMS_EPS)) * p.norm_g[l * 512 + h * 64 + e] * sigmoidf_(bf2f(zr[Z_CG + e]));
            if (bad(bf2f(((const bf16*)(ws + WS_OBUF))[(size_t)(b * SEQ + t) * OP + 1024 + h * 64 + e]), ref, 0.06f, 0.05f)) { const int n = atomicAdd((int*)(p.ws + WS_CTL) + CW_DBG + 4 + (t >= 64 ? 1 : 0), 1); if (n >= 40) dbg_fail(p, id + (t >= 64 ? 1 : 0)); } }
    } else if (which == 8) {
        const int t = h0 % NTOK, c = h1 % 1024; const bf16* zr = Z + (size_t)t * ZP + Z_GT; const float g2 = bf2f(zr[2048 + c]), g1 = bf2f(zr[1024 + c]) * g2, g0 = bf2f(zr[c]) * g1;
        const bf16* ob = (const bf16*)(ws + WS_OBUF) + (size_t)t * OP; float sa = 0.f, sb = 0.f, sc = 0.f;
        for (int k = 0; k < 512; ++k) { sa += bf2f(ob[k]) * p.w_pa[((size_t)l * 512 + k) * 1024 + c]; sb += bf2f(ob[512 + k]) * p.w_pb[((size_t)l * 512 + k) * 1024 + c]; sc += bf2f(ob[1024 + k]) * p.w_pc[((size_t)l * 512 + k) * 1024 + c]; }
        if (bad(bf2f(((const bf16*)(ws + WS_MERGED))[(size_t)t * 1024 + c]), g0 * sa + g1 * sb + g2 * sc, 0.04f, 0.01f)) dbg_fail(p, id);
    } else if (which == 9) {
        const int t = h0 % NTOK, c = h1 % 1024; const bf16* mr = (const bf16*)(ws + WS_MERGED) + (size_t)t * 1024; float s = 0.f;
        for (int k = 0; k < 1024; ++k) s += bf2f(mr[k]) * p.w_out[((size_t)l * 1024 + k) * 1024 + c];
        if (bad(((const float*)(ws + WS_MIX))[(size_t)t * 1024 + c], s, 0.03f, 0.005f)) dbg_fail(p, id);
    } else if (which == 10) {
        const int t = h0 % NTOK, c = h1 % 1024; const float* xr = xin + (size_t)t * DM; const float* mr = (const float*)(ws + WS_MIX) + (size_t)t * DM; const float* x1 = (const float*)(ws + WS_X1) + (size_t)t * DM;
        float mean = 0.f; for (int k = 0; k < 1024; ++k) mean += ALPHA * xr[k] + mr[k]; mean *= (1.f / 1024.f);
        float var = 0.f; for (int k = 0; k < 1024; ++k) { const float dlt = ALPHA * xr[k] + mr[k] - mean; var += dlt * dlt; } var *= (1.f / 1024.f);
        const float ref = (ALPHA * xr[c] + mr[c] - mean) / sqrtf(var + LN_EPS) * p.ln1_g[l * 1024 + c] + p.ln1_b[l * 1024 + c];
        if (bad(x1[c], ref, 1e-3f, 1e-3f) || bad(bf2f(((const bf16*)(ws + WS_X1B))[(size_t)t * DM + c]), ref, 0.01f, 0.01f)) dbg_fail(p, id);
        float tv0 = -3e38f, tv1 = -3e38f, tv2 = -3e38f, tv3 = -3e38f; int ti0 = -1, ti1 = -1, ti2 = -1, ti3 = -1;
        for (int e = 0; e < 32; ++e) { float lg = p.b_router[l * 32 + e]; for (int k = 0; k < 1024; ++k) lg += x1[k] * p.w_router[((size_t)l * 1024 + k) * 32 + e];
            if (lg > tv0) { tv3 = tv2; ti3 = ti2; tv2 = tv1; ti2 = ti1; tv1 = tv0; ti1 = ti0; tv0 = lg; ti0 = e; } else if (lg > tv1) { tv3 = tv2; ti3 = ti2; tv2 = tv1; ti2 = ti1; tv1 = lg; ti1 = e; }
            else if (lg > tv2) { tv3 = tv2; ti3 = ti2; tv2 = lg; ti2 = e; } else if (lg > tv3) { tv3 = lg; ti3 = e; } }
        const int* tke = (const int*)(ws + WS_TKE) + t * 4; const float* tkg = (const float*)(ws + WS_TKG) + t * 4;
        const float den = 1.f + expf(tv1 - tv0) + expf(tv2 - tv0) + expf(tv3 - tv0);
        if (tv2 - tv3 > 1e-3f && tv1 - tv2 > 1e-3f && tv0 - tv1 > 1e-3f) { if (tke[0] != ti0 || tke[1] != ti1 || tke[2] != ti2 || tke[3] != ti3) dbg_fail(p, id + 1);
            if (bad(tkg[0], 1.f / den, 1e-2f, 1e-3f) || bad(tkg[3], expf(tv3 - tv0) / den, 1e-2f, 1e-3f)) dbg_fail(p, id + 2); }
    } else if (which == 11) {
        const int t = h0 % NTOK, k = h1 & 3, c = h2 % 1024; const int slot = ((const int*)(ws + WS_TOKSLOT))[t * 4 + k], e = ((const int*)(ws + WS_TKE))[t * 4 + k]; const int* blk = (const int*)(ws + WS_BLK);
        if (slot < 0 || slot >= blk[0] * 256 || blk[0] > MAXBLK) { dbg_fail(p, id); return; }
        if (blk[16 + (slot >> 8)] != e) dbg_fail(p, id + 1);
        if (((const float*)(ws + WS_GSLOT))[slot] != ((const float*)(ws + WS_TKG))[t * 4 + k]) dbg_fail(p, id + 2);
        if (((const bf16*)(ws + WS_XG))[(size_t)slot * DM + c] != ((const bf16*)(ws + WS_X1B))[(size_t)t * DM + c]) dbg_fail(p, id + 3);
    } else if (which == 12) {
        const int t = h0 % NTOK, k = h1 & 3, j = h2 % 1024; const int slot = ((const int*)(ws + WS_TOKSLOT))[t * 4 + k], e = ((const int*)(ws + WS_TKE))[t * 4 + k];
        const bf16* xr = (const bf16*)(ws + WS_XG) + (size_t)slot * DM; const float* W = p.w_gu + (size_t)(l * 32 + e) * 1024 * 2048; float g = p.b_gu[(size_t)(l * 32 + e) * 2048 + j], u = p.b_gu[(size_t)(l * 32 + e) * 2048 + 1024 + j];
        for (int kk = 0; kk < 1024; ++kk) { const float xv = bf2f(xr[kk]); g += xv * W[(size_t)kk * 2048 + j]; u += xv * W[(size_t)kk * 2048 + 1024 + j]; }
        g = fminf(g, 7.f); u = fminf(fmaxf(u, -7.f), 7.f); const float ref = g * sigmoidf_(1.702f * g) * (u + 1.f);
        if (bad(bf2f(((const bf16*)(ws + WS_ACT))[(size_t)slot * 1024 + j]), ref, 0.04f, 0.02f)) dbg_fail(p, id);
    } else if (which == 13) {
        const int t = h0 % NTOK, k = h1 & 3, n = h2 % 1024; const int slot = ((const int*)(ws + WS_TOKSLOT))[t * 4 + k], e = ((const int*)(ws + WS_TKE))[t * 4 + k];
        const bf16* ar = (const bf16*)(ws + WS_ACT) + (size_t)slot * 1024; const float* W = p.w_down + (size_t)(l * 32 + e) * 1024 * 1024; float s = p.b_down[(size_t)(l * 32 + e) * 1024 + n];
        for (int kk = 0; kk < 1024; ++kk) s += bf2f(ar[kk]) * W[(size_t)kk * 1024 + n];
        if (bad(bf2f(((const bf16*)(ws + WS_Y))[(size_t)slot * 1024 + n]), s * ((const float*)(ws + WS_GSLOT))[slot], 0.04f, 0.005f)) dbg_fail(p, id);
    } else if (which == 14) {
        const int t = h0 % NTOK, c = h1 % 1024; const float* x1 = (const float*)(ws + WS_X1) + (size_t)t * DM; const bf16* y = (const bf16*)(ws + WS_Y); const int* ts = (const int*)(ws + WS_TOKSLOT) + t * 4;
        const float* xo = ((l == DEPTH - 1) ? p.out : (float*)(ws + WS_XCUR)) + (size_t)t * DM;
        float mean = 0.f; for (int k = 0; k < 1024; ++k) { float v = ALPHA * x1[k]; for (int j = 0; j < 4; ++j) v += bf2f(y[(size_t)ts[j] * 1024 + k]); mean += v; } mean *= (1.f / 1024.f);
        float var = 0.f, vc = 0.f; for (int k = 0; k < 1024; ++k) { float v = ALPHA * x1[k]; for (int j = 0; j < 4; ++j) v += bf2f(y[(size_t)ts[j] * 1024 + k]); var += (v - mean) * (v - mean); if (k == c) vc = v; } var *= (1.f / 1024.f);
        if (bad(xo[c], (vc - mean) / sqrtf(var + LN_EPS) * p.ln2_g[l * 1024 + c] + p.ln2_b[l * 1024 + c], 2e-3f, 2e-3f)) dbg_fail(p, id);
    }
}
__global__ void dbg_init(Params p) { if (threadIdx.x == 0 && blockIdx.x == 0) { ((int*)(p.ws + WS_CTL))[CW_DBG] = 0x7fffffff; ((int*)(p.ws + WS_CTL))[CW_DBG + 1] = 0; ((int*)(p.ws + WS_CTL))[CW_DBG + 4] = 0; ((int*)(p.ws + WS_CTL))[CW_DBG + 5] = 0; } }
__global__ void dbg_fill(Params p, int n) {
    const int code = ((const int*)(p.ws + WS_CTL))[CW_DBG]; if (code == 0x7fffffff) return;
    const int sub = code & 3, lw = code >> 2, l = lw / 20, which = lw % 20; const int k = l * 16 + which + 32 * sub;
    const float c = sqrtf(exp2f((float)k));
    const int msk = ((const int*)(p.ws + WS_CTL))[CW_DBG + 1];
    for (int i = blockIdx.x * blockDim.x + threadIdx.x; i < n; i += gridDim.x * blockDim.x) p.out[i] = (i == 0) ? 16.f * (float)(1 + msk) : c;
}
#endif

extern "C" void kernel_launch(void* const* d_in, const int* in_sizes, int n_in, void* d_out, int out_size, void* d_ws, size_t ws_size, hipStream_t stream) {
    static int grid = 0;
    if (grid == 0) {
        if (n_in != 19 || ws_size < WS_END) { fprintf(stderr, "kernel_launch: need 19 inputs and >= %zu bytes of workspace; got %d, %zu\n", (size_t)WS_END, n_in, ws_size); grid = -1; return; }
        int dev = 0, cus = 0, per_cu = 0;
        if (hipGetDevice(&dev) != hipSuccess || hipDeviceGetAttribute(&cus, hipDeviceAttributeMultiprocessorCount, dev) != hipSuccess) { grid = -1; return; }
        if (hipFuncSetAttribute((const void*)fwd, hipFuncAttributeMaxDynamicSharedMemorySize, LDS_BYTES) != hipSuccess) { fprintf(stderr, "kernel_launch: hipFuncSetAttribute failed\n"); grid = -1; return; }
        if (hipOccupancyMaxActiveBlocksPerMultiprocessor(&per_cu, (const void*)fwd, NTHR, LDS_BYTES) != hipSuccess || per_cu < 1) fprintf(stderr, "kernel_launch: occupancy query reports %d\n", per_cu);
        (void)hipGetLastError();
        grid = cus;
    }
    if (grid < 0) return;
    (void)hipMemsetAsync((char*)d_ws + WS_CTL, 0, CTL_ZERO_BYTES, stream);
    Params p{};
    const float** f = (const float**)&p;
    for (int i = 0; i < 19; ++i) f[i] = (const float*)d_in[i];
    p.out = (float*)d_out; p.ws = (unsigned char*)d_ws;
#if ONE_LAUNCH
    p.ph_lo = 0; p.ph_hi = NPHASES; p.use_bar = 1; p.pad = 0;
    hipLaunchKernelGGL(fwd, dim3(grid), dim3(NTHR), LDS_BYTES, stream, p);
#else
#if DBG
    hipLaunchKernelGGL(dbg_init, dim3(1), dim3(64), 0, stream, p);
#endif
    for (int ph = 0; ph < NPHASES; ++ph) { p.ph_lo = ph; p.ph_hi = ph + 1; p.use_bar = 0; p.pad = 0;
        hipLaunchKernelGGL(fwd, dim3(grid), dim3(NTHR), LDS_BYTES, stream, p);
#if DBG
        if (ph >= 1) { const int l = (ph - 1) / NPH_LAYER, k = (ph - 1) % NPH_LAYER; static const int wmap[NPH_LAYER] = {1, 2, 3, 4, 0, 0, 7, 8, 9, 10, 11, 12, 13, 14}; const int w = wmap[k];
            if (w) { const int nb = (w == 7) ? 32 : (w == 3) ? 4 : (w == 4) ? 2 : 16; hipLaunchKernelGGL(chk, dim3(nb), dim3(64), 0, stream, p, l, w); } }
#endif
    }
#if DBG
    hipLaunchKernelGGL(dbg_fill, dim3(1024), dim3(256), 0, stream, p, out_size);
#endif
#endif
}
```

```cpp
#include <hip/hip_runtime.h>
#include <cstdio>
#include <cstdint>

#define GAS __attribute__((address_space(1)))
#define LAS __attribute__((address_space(3)))
typedef unsigned short bf16;
typedef short bf16x8 __attribute__((ext_vector_type(8)));
typedef short s16x4 __attribute__((ext_vector_type(4)));
typedef float f32x2 __attribute__((ext_vector_type(2)));
typedef float f32x4 __attribute__((ext_vector_type(4)));
typedef float f32x16 __attribute__((ext_vector_type(16)));
typedef unsigned u32x2 __attribute__((ext_vector_type(2)));
typedef unsigned u32x4 __attribute__((ext_vector_type(4)));
typedef unsigned long long u64;

__device__ __forceinline__ unsigned f2bf(float f) { unsigned u = __builtin_bit_cast(unsigned, f); return (u + 0x7fffu + ((u >> 16) & 1u)) >> 16; }
__device__ __forceinline__ unsigned pk2(float lo, float hi) { return f2bf(lo) | (f2bf(hi) << 16); }
__device__ __forceinline__ float bf2f(unsigned b) { return __builtin_bit_cast(float, b << 16); }
__device__ __forceinline__ float bflo(unsigned w) { return __builtin_bit_cast(float, w << 16); }
__device__ __forceinline__ float bfhi(unsigned w) { return __builtin_bit_cast(float, w & 0xffff0000u); }
__device__ __forceinline__ float sigmoidf_(float x) { return 1.0f / (1.0f + __expf(-x)); }

namespace pg8 {
#define PG8_LAS __attribute__((address_space(3)))
typedef unsigned short bf16_t;
typedef short bf16x8 __attribute__((ext_vector_type(8)));
typedef float f32x4 __attribute__((ext_vector_type(4)));
typedef unsigned u32x4 __attribute__((ext_vector_type(4)));
constexpr int BM = 256, BK = 64, HALF = 128, HTB = HALF * BK * 2  , STAGE_BYTES = 8 * HTB, NXCD = 8, WGM = 8;

__host__ __device__ __forceinline__ int lds_byte(int r, int c) { const int st = (r >> 4) * 2 + (c >> 5), rr = r & 15, cc = c & 31, ob = rr * 64 + cc * 2; return st * 1024 + (ob ^ (((ob >> 9) & 1) << 5)); }
__host__ __device__ __forceinline__ void stage_rc(int b, int& R, int& C) { const int st = b / 1024, sb = b % 1024, swz = sb ^ (((sb >> 9) & 1) << 5); R = (st >> 1) * 16 + swz / 64; C = (st & 1) * 32 + (swz % 64) / 2; }
__host__ __device__ __forceinline__ int perm32(int rho) { const int n = rho >> 4, i = rho & 15; return 8 * (i >> 2) + 4 * n + (i & 3); }

struct Unit { int pm, pn; };
struct Gemm { const bf16_t* A; const bf16_t* Bt; int M, N, K; };

struct StaticOrder {
    static constexpr bool GATHER = false; const int* tok = nullptr;
    int nM, nN, nwg, G, c;
    __host__ __device__ void init(int M, int N, int G_, int c_) { nM = M / BM; nN = N / BM; nwg = nM * nN; G = G_; c = c_; }
    __host__ __device__ bool next(int i, Unit& u) const {
        const long L = (long)i * G + c; if (L >= nwg) return false;
        int wgid = (int)L; { const int q = nwg / NXCD, r = nwg % NXCD, xcd = wgid % NXCD, off = wgid / NXCD; wgid = (xcd < r ? xcd * (q + 1) : r * (q + 1) + (xcd - r) * q) + off; }
        const int nig = WGM * nN, gid = wgid / nig, fm = gid * WGM, gsz = (nM - fm) < WGM ? (nM - fm) : WGM;
        u.pm = fm + ((wgid % nig) % gsz); u.pn = (wgid % nig) / gsz; return true;
    }
    __device__ __forceinline__ void a_ready(const Unit&) const {}
    __device__ __forceinline__ void done(const Unit&) const {}
};
template <bool GATHER_> struct MoeOrderT {
    static constexpr bool GATHER = GATHER_;
    const PG8_LAS int* list; const int* tok;
    __device__ bool next(int i, Unit& u) const {
        if (i >= __builtin_amdgcn_readfirstlane(list[0])) return false;
        u.pm = __builtin_amdgcn_readfirstlane(list[2 + 2 * i]); u.pn = __builtin_amdgcn_readfirstlane(list[3 + 2 * i]); return true;
    }
    __device__ __forceinline__ void a_ready(const Unit&) const {}
    __device__ __forceinline__ void done(const Unit&) const {}
};
typedef MoeOrderT<false> MoeOrder; typedef MoeOrderT<true> MoeOrderG;
__device__ __forceinline__ void moe_build_list(PG8_LAS int* list, const int* blk, int nN, int G, int c, int tid) {
    if (tid == 0) { const int* bst = blk + 16 + 544 + 16; int n = 0;
        if (G % 8 == 0) { const int W = G / 8, j = c / 8, x = c % 8;
            for (int i = 0; i < 64; ++i) { const int uu = i * W + j; const int bi = uu / nN, pl = uu - bi * nN; int rem = bi; bool ok = false;
                for (int k = 0; k < 4 && !ok; ++k) { const int e = x + 8 * k; const int b0 = bst[e], b1 = bst[e + 1]; if (rem < b1 - b0) { list[2 + 2 * n] = b0 + rem; list[3 + 2 * n] = e * nN + pl; ++n; ok = true; } else rem -= b1 - b0; }
                if (!ok) break; }
        } else { const int nb = bst[32];
            for (int i = 0; i < 64; ++i) { const int uu = i * G + c; const int bi = uu / nN, pl = uu - bi * nN; if (bi >= nb) break; int e = 0; for (int k = 1; k < 32; ++k) if (bi >= bst[k]) e = k; list[2 + 2 * n] = bi; list[3 + 2 * n] = e * nN + pl; ++n; } }
        list[0] = n; }
    asm volatile("s_waitcnt lgkmcnt(0)\n\ts_barrier" ::: "memory");
}

__device__ __forceinline__ unsigned cvt_pk_bf16(float lo, float hi) { unsigned r; asm volatile("v_cvt_pk_bf16_f32 %0, %1, %2" : "=v"(r) : "v"(lo), "v"(hi)); return r; }

struct EpiZ {
    static constexpr bool PERM = true, AFTER_DRAIN = false, MIDK = false;
    bf16_t* O; int ldc; const float* trig; bf16_t* IKC;
    __device__ __forceinline__ void operator()(const f32x4 (&acc)[2][2][4][2], const Unit& u, int wr, int wc, int fr, int fq) const {
        asm volatile("" : "+v"(fr), "+v"(fq));
        const int row0 = u.pm * BM + wr * 64 + fr; const int col0 = u.pn * BM + wc * 32 + 8 * fq;
        const bool rot_all = (u.pn < 4) || (u.pn == 32); const bool rot_b0 = rot_all || (u.pn == 33 && wc < 2);
        const int i0 = (wc & 1) * 16 + 4 * fq;
#pragma unroll
        for (int ai = 0; ai < 2; ++ai)
#pragma unroll
            for (int m = 0; m < 4; ++m) { const int row = row0 + ai * HALF + m * 16; bf16_t* rowp = O + (size_t)row * ldc + col0;
                f32x4 ca = {1.f, 0.f, 1.f, 0.f}, cb = {1.f, 0.f, 1.f, 0.f};
                if (rot_b0) { const float* tp = trig + ((size_t)(row & 8191) * 32 + i0) * 2; ca = *(const f32x4*)tp; cb = *(const f32x4*)(tp + 4); }
#pragma unroll
                for (int bj = 0; bj < 2; ++bj) { f32x4 v0 = acc[ai][bj][m][0], v1 = acc[ai][bj][m][1];
                    if (bj == 0 ? rot_b0 : rot_all) {
                        const f32x4 r0 = {v0[0] * ca[0] - v0[1] * ca[1], v0[1] * ca[0] + v0[0] * ca[1], v0[2] * ca[2] - v0[3] * ca[3], v0[3] * ca[2] + v0[2] * ca[3]};
                        const f32x4 r1 = {v1[0] * cb[0] - v1[1] * cb[1], v1[1] * cb[0] + v1[0] * cb[1], v1[2] * cb[2] - v1[3] * cb[3], v1[3] * cb[2] + v1[2] * cb[3]};
                        v0 = r0; v1 = r1; }
                    u32x4 w; w.x = cvt_pk_bf16(v0[0], v0[1]); w.y = cvt_pk_bf16(v0[2], v0[3]); w.z = cvt_pk_bf16(v1[0], v1[1]); w.w = cvt_pk_bf16(v1[2], v1[3]);
                    *(u32x4*)(rowp + bj * HALF) = w;
                    if (bj == 0 && u.pn == 33 && wc < 2) *(u32x4*)(IKC + (size_t)row * 64 + wc * 32 + 8 * fq) = w; } }
    }
};
struct EpiF32 {
    static constexpr bool PERM = true, AFTER_DRAIN = false, MIDK = false;
    float* O; int ldc;
    __device__ __forceinline__ void operator()(const f32x4 (&acc)[2][2][4][2], const Unit& u, int wr, int wc, int fr, int fq) const {
        asm volatile("" : "+v"(fr), "+v"(fq));
        const int row0 = u.pm * BM + wr * 64 + fr; const int col0 = u.pn * BM + wc * 32 + 8 * fq;
#pragma unroll
        for (int ai = 0; ai < 2; ++ai)
#pragma unroll
            for (int m = 0; m < 4; ++m) { float* rowp = O + (size_t)(row0 + ai * HALF + m * 16) * ldc + col0;
#pragma unroll
                for (int bj = 0; bj < 2; ++bj) { *(f32x4*)(rowp + bj * HALF) = acc[ai][bj][m][0]; *(f32x4*)(rowp + bj * HALF + 4) = acc[ai][bj][m][1]; } }
    }
};
struct EpiBf16 {
    static constexpr bool PERM = true, AFTER_DRAIN = false, MIDK = false;
    bf16_t* O; int ldc;
    __device__ __forceinline__ void operator()(const f32x4 (&acc)[2][2][4][2], const Unit& u, int wr, int wc, int fr, int fq) const {
        asm volatile("" : "+v"(fr), "+v"(fq));
        const int row0 = u.pm * BM + wr * 64 + fr; const int col0 = u.pn * BM + wc * 32 + 8 * fq;
#pragma unroll
        for (int ai = 0; ai < 2; ++ai)
#pragma unroll
            for (int m = 0; m < 4; ++m) { bf16_t* rowp = O + (size_t)(row0 + ai * HALF + m * 16) * ldc + col0;
#pragma unroll
                for (int bj = 0; bj < 2; ++bj) { const f32x4 v0 = acc[ai][bj][m][0], v1 = acc[ai][bj][m][1];
                    u32x4 w; w.x = cvt_pk_bf16(v0[0], v0[1]); w.y = cvt_pk_bf16(v0[2], v0[3]); w.z = cvt_pk_bf16(v1[0], v1[1]); w.w = cvt_pk_bf16(v1[2], v1[3]);
                    *(u32x4*)(rowp + bj * HALF) = w; } }
    }
};
struct EpiMerge {
    static constexpr bool PERM = true, AFTER_DRAIN = false, MIDK = true;
    const bf16_t* Gz; int gp; bf16_t* O; int ldc;
    __device__ __forceinline__ void scale(f32x4 (&acc)[2][2][4][2], const Unit& u, int idx, int wr, int wc, int fr, int fq) const {
        asm volatile("" : "+v"(fr), "+v"(fq));
        const int row0 = u.pm * BM + wr * 64 + fr; const int col0 = u.pn * BM + wc * 32 + 8 * fq;
        const int pa = (idx == 2) ? 2048 : (idx == 1) ? 2048 : 1024, pb = (idx == 1) ? 1024 : 0;
        u32x4 wa[2], wb[2], na[2], nb[2];
#define MG_LOAD(IT, WA, WB) do { const bf16_t* rowp_ = Gz + (size_t)(row0 + ((IT) >> 2) * HALF + ((IT) & 3) * 16) * gp + col0; \
            _Pragma("unroll") for (int bj = 0; bj < 2; ++bj) { WA[bj] = *(const u32x4*)(rowp_ + pa + bj * HALF); if (idx != 2) WB[bj] = *(const u32x4*)(rowp_ + pb + bj * HALF); else WB[bj] = WA[bj]; } } while (0)
        MG_LOAD(0, wa, wb);
#pragma unroll
        for (int it = 0; it < 8; ++it) { const int ai = it >> 2, m = it & 3;
            if (it + 1 < 8) MG_LOAD(it + 1, na, nb);
            asm volatile("" ::: "memory");
#pragma unroll
            for (int bj = 0; bj < 2; ++bj) { float s[8];
#pragma unroll
                for (int i = 0; i < 4; ++i) { const float ea0 = __expf(-bflo(wa[bj][i])), ea1 = __expf(-bfhi(wa[bj][i]));
                    if (idx == 2) { s[2 * i] = __builtin_amdgcn_rcpf(1.f + ea0); s[2 * i + 1] = __builtin_amdgcn_rcpf(1.f + ea1); }
                    else { const float eb0 = __expf(-bflo(wb[bj][i])), eb1 = __expf(-bfhi(wb[bj][i])); s[2 * i] = (1.f + ea0) * __builtin_amdgcn_rcpf(1.f + eb0); s[2 * i + 1] = (1.f + ea1) * __builtin_amdgcn_rcpf(1.f + eb1); } }
                acc[ai][bj][m][0] = acc[ai][bj][m][0] * (f32x4){s[0], s[1], s[2], s[3]}; acc[ai][bj][m][1] = acc[ai][bj][m][1] * (f32x4){s[4], s[5], s[6], s[7]}; }
#pragma unroll
            for (int bj = 0; bj < 2; ++bj) { wa[bj] = na[bj]; wb[bj] = nb[bj]; } }
#undef MG_LOAD
    }
    __device__ __forceinline__ void mid(f32x4 (&acc)[2][2][4][2], const Unit& u, int idx, int wr, int wc, int fr, int fq) const { scale(acc, u, idx, wr, wc, fr, fq); }
    __device__ __forceinline__ void operator()(f32x4 (&acc)[2][2][4][2], const Unit& u, int wr, int wc, int fr, int fq) const {
        scale(acc, u, 2, wr, wc, fr, fq);
        asm volatile("" : "+v"(fr), "+v"(fq));
        const int row0 = u.pm * BM + wr * 64 + fr; const int col0 = u.pn * BM + wc * 32 + 8 * fq;
#pragma unroll
        for (int ai = 0; ai < 2; ++ai)
#pragma unroll
            for (int m = 0; m < 4; ++m) { bf16_t* rowp = O + (size_t)(row0 + ai * HALF + m * 16) * ldc + col0;
#pragma unroll
                for (int bj = 0; bj < 2; ++bj) { const f32x4 v0 = acc[ai][bj][m][0], v1 = acc[ai][bj][m][1];
                    u32x4 w; w.x = cvt_pk_bf16(v0[0], v0[1]); w.y = cvt_pk_bf16(v0[2], v0[3]); w.z = cvt_pk_bf16(v1[0], v1[1]); w.w = cvt_pk_bf16(v1[2], v1[3]);
                    *(u32x4*)(rowp + bj * HALF) = w; } }
    }
};
struct EpiSwiGLU {
    static constexpr bool PERM = true, AFTER_DRAIN = false, MIDK = false;
    bf16_t* O; const float* bias; int nN;
    __device__ __forceinline__ void operator()(const f32x4 (&acc)[2][2][4][2], const Unit& u, int wr, int wc, int fr, int fq) const {
        const int e = u.pn / nN, pl = u.pn - e * nN;
        asm volatile("" : "+v"(fr), "+v"(fq));
        const int row0 = u.pm * BM + wr * 64 + fr; const int colt = pl * BM + wc * 32 + 8 * fq;
        const float* bp = bias + (size_t)e * 2048 + colt;
        f32x4 bv[2][2];
#pragma unroll
        for (int bj = 0; bj < 2; ++bj) { bv[bj][0] = *(const f32x4*)(bp + bj * HALF); bv[bj][1] = *(const f32x4*)(bp + bj * HALF + 4); }
#pragma unroll
        for (int ai = 0; ai < 2; ++ai)
#pragma unroll
            for (int m = 0; m < 4; ++m) { unsigned char* rowp = (unsigned char*)O + (size_t)(row0 + ai * HALF + m * 16) * 1024 + (colt >> 1);
#pragma unroll
                for (int bj = 0; bj < 2; ++bj) { const f32x4 v0 = acc[ai][bj][m][0] + bv[bj][0], v1 = acc[ai][bj][m][1] + bv[bj][1];
                    float a[4];
                    const float gt[4] = {v0[0], v0[2], v1[0], v1[2]}, up[4] = {v0[1], v0[3], v1[1], v1[3]};
#pragma unroll
                    for (int i = 0; i < 4; ++i) { const float g = fminf(gt[i], 7.0f); const float uu = fminf(fmaxf(up[i], -7.0f), 7.0f);
                        a[i] = g * (1.0f / (1.0f + __expf(-1.702f * g))) * (uu + 1.0f); }
                    int w8 = __builtin_amdgcn_cvt_pk_fp8_f32(a[0], a[1], 0, false); w8 = __builtin_amdgcn_cvt_pk_fp8_f32(a[2], a[3], w8, true);
                    *(unsigned*)(rowp + bj * (HALF / 2)) = (unsigned)w8; } }
    }
};
struct EpiDown {
    static constexpr bool PERM = true, AFTER_DRAIN = false, MIDK = false;
    bf16_t* O; const float* bias; const float* gate; int nN;
    __device__ __forceinline__ void operator()(const f32x4 (&acc)[2][2][4][2], const Unit& u, int wr, int wc, int fr, int fq) const {
        const int e = u.pn / nN, pl = u.pn - e * nN;
        asm volatile("" : "+v"(fr), "+v"(fq));
        const int row0 = u.pm * BM + wr * 64 + fr; const int colt = pl * BM + wc * 32 + 8 * fq;
        const float* bp = bias + (size_t)e * 1024 + colt;
        f32x4 bv[2][2];
#pragma unroll
        for (int bj = 0; bj < 2; ++bj) { bv[bj][0] = *(const f32x4*)(bp + bj * HALF); bv[bj][1] = *(const f32x4*)(bp + bj * HALF + 4); }
#pragma unroll
        for (int ai = 0; ai < 2; ++ai)
#pragma unroll
            for (int m = 0; m < 4; ++m) { const int row = row0 + ai * HALF + m * 16; const float gs = gate[row]; bf16_t* rowp = O + (size_t)row * 1024 + colt;
#pragma unroll
                for (int bj = 0; bj < 2; ++bj) { const f32x4 v0 = (acc[ai][bj][m][0] + bv[bj][0]) * gs, v1 = (acc[ai][bj][m][1] + bv[bj][1]) * gs;
                    u32x4 w; w.x = cvt_pk_bf16(v0[0], v0[1]); w.y = cvt_pk_bf16(v0[2], v0[3]); w.z = cvt_pk_bf16(v1[0], v1[1]); w.w = cvt_pk_bf16(v1[2], v1[3]);
                    *(u32x4*)(rowp + bj * HALF) = w; } }
    }
};

template <class Epi, class Sched, bool ALIGN_EPI = false, bool SP2 = false, bool FP8 = false, int SCALE_B = 127>
__device__ __forceinline__ void gemm_phase(PG8_LAS unsigned char* lds, const Gemm g, const Sched& S, const Epi& E, int wv) {
    int tid_l = (int)__builtin_amdgcn_mbcnt_hi(~0u, __builtin_amdgcn_mbcnt_lo(~0u, 0u)); asm volatile("" : "+v"(tid_l)); tid_l += wv * 64;
    const int tid = tid_l, wid = __builtin_amdgcn_readfirstlane(tid >> 6), lane = tid & 63, wr = wid >> 2, wc = wid & 3, fr = lane & 15, fq = lane >> 4;
    const int K = g.K; const int KB = FP8 ? K : 2 * K;
    const int nt = KB / (2 * BK);
    unsigned voffA[2], voffB[2];
#pragma unroll
    for (int i = 0; i < 2; ++i) { int R, C; stage_rc(tid * 16 + i * 8192, R, C); const int Rb = Epi::PERM ? ((R & ~31) + perm32(R & 31)) : R;
        voffA[i] = (unsigned)(R * KB + 2 * C); voffB[i] = (unsigned)(Rb * KB + 2 * C); }
    unsigned voGc[2][2]; PG8_LAS unsigned* voGn_l = (PG8_LAS unsigned*)(lds + STAGE_BYTES + 1024) + tid;
#define PG8_GOFF(dst, pmv) do { if constexpr (Sched::GATHER) { _Pragma("unroll") for (int _h = 0; _h < 2; ++_h) _Pragma("unroll") for (int _i = 0; _i < 2; ++_i) { \
        const unsigned _R = voffA[_i] / (unsigned)KB, _cb = voffA[_i] % (unsigned)KB; dst[_h][_i] = (unsigned)S.tok[(pmv) * BM + _h * HALF + (int)_R] * (unsigned)KB + _cb; } } } while (0)
    const size_t kstep = (size_t)(BK * 2);
    const size_t hstep = (size_t)HALF * KB;
    const size_t tstep = 2 * hstep;
    const unsigned ldsw = (unsigned)wid * 1024u;
    const int aoff = lds_byte(wr * 64 + fr, FP8 ? fq * 16 : fq * 8), boff = lds_byte(wc * 32 + fr, FP8 ? fq * 16 : fq * 8);
    const int aoff1 = FP8 ? lds_byte(wr * 64 + fr, fq * 16 + 8) - aoff : 1024, boff1 = FP8 ? lds_byte(wc * 32 + fr, fq * 16 + 8) - boff : 1024;
#define PG8_SA(b, h) (((b) * 2 + (h)) * HTB)
#define PG8_SB(b, h) ((4 + (b) * 2 + (h)) * HTB)
#define PG8_STAGE(bufoff, gbase, voff) do { _Pragma("unroll") for (int _i = 0; _i < 2; ++_i) \
        __builtin_amdgcn_global_load_lds((const unsigned*)((const char*)(gbase) + (voff)[_i]), (PG8_LAS unsigned*)(lds + (bufoff) + ldsw + _i * 8192), 16, 0, 0); } while (0)
#define PG8_STAGE_A(bufoff, base, h, nx) do { if constexpr (Sched::GATHER) { unsigned _vo[2] = {voGc[h][0], voGc[h][1]}; if (nx) { _vo[0] = voGn_l[((h) * 2 + 0) * 512]; _vo[1] = voGn_l[((h) * 2 + 1) * 512]; } PG8_STAGE(bufoff, base, _vo); } else { PG8_STAGE(bufoff, (base) + (h) * hstep, voffA); } } while (0)
#define PG8_LD8(dst8, n_, base_, off_, off1_) do { _Pragma("unroll") for (int q_ = 0; q_ < n_; ++q_) { const v4i_ lo_ = *(const PG8_LAS v4i_*)(lds + (base_) + (off_) + q_ * 2048), hi_ = *(const PG8_LAS v4i_*)(lds + (base_) + (off_) + q_ * 2048 + (off1_)); \
        dst8[q_] = __builtin_shufflevector(lo_, hi_, 0, 1, 2, 3, 4, 5, 6, 7); } } while (0)
#define PG8_LDA(dst, b, h) do { if constexpr (FP8) { PG8_LD8(dst##8, 4, PG8_SA(b, h), aoff, aoff1); } else { _Pragma("unroll") for (int m = 0; m < 4; ++m) _Pragma("unroll") for (int k = 0; k < 2; ++k) dst[m][k] = *(const PG8_LAS bf16x8*)(lds + PG8_SA(b, h) + aoff + m * 2048 + k * aoff1); } } while (0)
#define PG8_LDB(dst, b, h) do { if constexpr (FP8) { PG8_LD8(dst##8, 2, PG8_SB(b, h), boff, boff1); } else { _Pragma("unroll") for (int n = 0; n < 2; ++n) _Pragma("unroll") for (int k = 0; k < 2; ++k) dst[n][k] = *(const PG8_LAS bf16x8*)(lds + PG8_SB(b, h) + boff + n * 2048 + k * boff1); } } while (0)
#define PG8_MMA(ai, bj, At, Bt) do { if constexpr (FP8) __builtin_amdgcn_sched_barrier(0); __builtin_amdgcn_s_setprio(1); _Pragma("unroll") for (int m = 0; m < 4; ++m) _Pragma("unroll") for (int n = 0; n < 2; ++n) { \
        if constexpr (FP8) { asm volatile("v_mfma_scale_f32_16x16x128_f8f6f4 %0, %1, %2, %0, %3, %4 op_sel_hi:[0,0,0]" : "+v"(acc[ai][bj][m][n]) : "v"(Bt##8[n]), "v"(At##8[m]), "v"(sclB), "v"(sclA)); } \
        else { _Pragma("unroll") for (int k = 0; k < 2; ++k) acc[ai][bj][m][n] = __builtin_amdgcn_mfma_f32_16x16x32_bf16(Bt[n][k], At[m][k], acc[ai][bj][m][n], 0, 0, 0); } } \
        __builtin_amdgcn_s_setprio(0); if constexpr (FP8) __builtin_amdgcn_sched_barrier(0); } while (0)
#define PG8_WAIT_V(n) asm volatile("s_waitcnt vmcnt(" #n ")" ::: "memory")
#define PG8_WAIT_L(n) asm volatile("s_waitcnt lgkmcnt(" #n ")" ::: "memory")
#define PG8_BAR __builtin_amdgcn_s_barrier()
#define PG8_SCHED __builtin_amdgcn_sched_barrier(0)
    Unit cur, nxt; int ui = 0;
    if (!S.next(0, cur)) return;
    f32x4 acc[2][2][4][2];
#pragma unroll
    for (int a = 0; a < 2; ++a)
#pragma unroll
        for (int b = 0; b < 2; ++b)
#pragma unroll
            for (int m = 0; m < 4; ++m)
#pragma unroll
                for (int n = 0; n < 2; ++n) acc[a][b][m][n] = (f32x4){0.f, 0.f, 0.f, 0.f};
    bf16x8 At[4][2], B0[2][2], B1[2][2];
    typedef int v8i_ __attribute__((ext_vector_type(8))); typedef int v4i_ __attribute__((ext_vector_type(4)));
    int sclB = SCALE_B * 0x01010101, sclA = 0x7f7f7f7f; asm volatile("" : "+v"(sclB), "+v"(sclA));
    v8i_ At8[4], B08[2], B18[2];
    const char* cA = (const char*)g.A + (Sched::GATHER ? (size_t)0 : (size_t)cur.pm * tstep); const char* cB = (const char*)g.Bt + (size_t)cur.pn * tstep;
    PG8_GOFF(voGc, cur.pm);
    S.a_ready(cur);
    if constexpr (SP2) {
        PG8_STAGE(PG8_SB(0, 0), cB, voffB); PG8_STAGE(PG8_SB(0, 1), cB + hstep, voffB); PG8_STAGE_A(PG8_SA(0, 0), cA, 0, false); PG8_STAGE_A(PG8_SA(0, 1), cA, 1, false);
        if (wr == 1) PG8_BAR;
        PG8_WAIT_V(2); PG8_BAR;
        PG8_STAGE(PG8_SB(1, 0), cB + kstep, voffB); PG8_STAGE_A(PG8_SA(1, 0), cA + kstep, 0, false); PG8_STAGE(PG8_SB(1, 1), cB + hstep + kstep, voffB);
        PG8_WAIT_V(6); PG8_BAR;
    } else {
        PG8_STAGE(PG8_SB(0, 0), cB, voffB); PG8_STAGE_A(PG8_SA(0, 0), cA, 0, false); PG8_STAGE(PG8_SB(0, 1), cB + hstep, voffB); PG8_STAGE_A(PG8_SA(0, 1), cA, 1, false);
        if (wr == 1) PG8_BAR;
        PG8_WAIT_V(4); PG8_BAR;
        PG8_STAGE(PG8_SB(1, 0), cB + kstep, voffB); PG8_STAGE_A(PG8_SA(1, 0), cA + kstep, 0, false); PG8_STAGE(PG8_SB(1, 1), cB + hstep + kstep, voffB);
        PG8_WAIT_V(6); PG8_BAR;
    }
    for (;;) {
        const bool has_next = S.next(ui + 1, nxt);
        const char* nA = has_next ? (const char*)g.A + (Sched::GATHER ? (size_t)0 : (size_t)nxt.pm * tstep) : cA;
        if constexpr (Sched::GATHER) { unsigned _vn[2][2]; if (has_next) { PG8_GOFF(_vn, nxt.pm); } else { _Pragma("unroll") for (int _h = 0; _h < 2; ++_h) _Pragma("unroll") for (int _i = 0; _i < 2; ++_i) _vn[_h][_i] = voGc[_h][_i]; }
            _Pragma("unroll") for (int _h = 0; _h < 2; ++_h) _Pragma("unroll") for (int _i = 0; _i < 2; ++_i) voGn_l[(_h * 2 + _i) * 512] = _vn[_h][_i]; } const char* nB = has_next ? (const char*)g.Bt + (size_t)nxt.pn * tstep : cB;
        for (int t = 0; t < nt; t += 2) {
            const bool last = (t == nt - 2);
            const char* a1 = cA + (size_t)(t + 1) * kstep;
            const char* a2 = last ? nA : cA + (size_t)(t + 2) * kstep; const char* b2 = last ? nB : cB + (size_t)(t + 2) * kstep;
            const char* a3 = a2 + kstep; const char* b3 = b2 + kstep;
            if (last && has_next) S.a_ready(nxt);
            if constexpr (SP2) {
            PG8_LDB(B0, 0, 0); PG8_LDB(B1, 0, 1); PG8_SCHED; PG8_LDA(At, 0, 0); PG8_STAGE_A(PG8_SA(1, 1), a1, 1, false);
            PG8_WAIT_V(8); PG8_WAIT_L(0); PG8_BAR; PG8_MMA(0, 0, At, B0); PG8_MMA(0, 1, At, B1); PG8_BAR; PG8_SCHED;
            PG8_LDA(At, 0, 1); PG8_STAGE(PG8_SB(0, 0), b2, voffB); PG8_STAGE(PG8_SB(0, 1), b2 + hstep, voffB); PG8_STAGE_A(PG8_SA(0, 0), a2, 0, last);
            PG8_WAIT_V(8); PG8_WAIT_L(0); PG8_BAR; PG8_MMA(1, 0, At, B0); PG8_MMA(1, 1, At, B1); PG8_BAR; PG8_SCHED;
            PG8_LDB(B0, 1, 0); PG8_LDB(B1, 1, 1); PG8_SCHED; PG8_LDA(At, 1, 0); PG8_STAGE_A(PG8_SA(0, 1), a2, 1, last);
            PG8_WAIT_V(8); PG8_WAIT_L(0); PG8_BAR; PG8_MMA(0, 0, At, B0); PG8_MMA(0, 1, At, B1); PG8_BAR; PG8_SCHED;
            PG8_LDA(At, 1, 1); PG8_STAGE(PG8_SB(1, 0), b3, voffB); PG8_STAGE(PG8_SB(1, 1), b3 + hstep, voffB); PG8_STAGE_A(PG8_SA(1, 0), a3, 0, last);
            PG8_WAIT_V(8); PG8_WAIT_L(0); PG8_BAR; PG8_MMA(1, 0, At, B0); PG8_MMA(1, 1, At, B1); PG8_BAR; PG8_SCHED;
            } else {
            PG8_LDB(B0, 0, 0); PG8_SCHED; PG8_LDA(At, 0, 0); PG8_STAGE_A(PG8_SA(1, 1), a1, 1, false);
            PG8_WAIT_L(8); PG8_BAR; PG8_WAIT_L(0); PG8_MMA(0, 0, At, B0); PG8_BAR; PG8_SCHED;
            PG8_LDB(B1, 0, 1); PG8_STAGE(PG8_SB(0, 0), b2, voffB);
            PG8_BAR; PG8_WAIT_L(0); PG8_MMA(0, 1, At, B1); PG8_BAR;
            PG8_LDA(At, 0, 1); PG8_STAGE_A(PG8_SA(0, 0), a2, 0, last);
            PG8_BAR; PG8_WAIT_L(0); PG8_MMA(1, 0, At, B0); PG8_BAR; PG8_SCHED;
            PG8_STAGE(PG8_SB(0, 1), b2 + hstep, voffB);
            PG8_WAIT_V(6); PG8_BAR; PG8_MMA(1, 1, At, B1); PG8_BAR;
            PG8_LDB(B0, 1, 0); PG8_SCHED; PG8_LDA(At, 1, 0); PG8_STAGE_A(PG8_SA(0, 1), a2, 1, last);
            PG8_WAIT_L(8); PG8_BAR; PG8_WAIT_L(0); PG8_MMA(0, 0, At, B0); PG8_BAR; PG8_SCHED;
            PG8_LDB(B1, 1, 1); PG8_STAGE(PG8_SB(1, 0), b3, voffB);
            PG8_BAR; PG8_WAIT_L(0); PG8_MMA(0, 1, At, B1); PG8_BAR;
            PG8_LDA(At, 1, 1); PG8_STAGE_A(PG8_SA(1, 0), a3, 0, last);
            PG8_BAR; PG8_WAIT_L(0); PG8_MMA(1, 0, At, B0); PG8_BAR; PG8_SCHED;
            PG8_STAGE(PG8_SB(1, 1), b3 + hstep, voffB);
            PG8_WAIT_V(6); PG8_BAR; PG8_MMA(1, 1, At, B1); PG8_BAR;
            }
            if constexpr (Epi::MIDK) { if (((t + 2) & 7) == 0 && t + 2 < nt) E.mid(acc, cur, ((t + 2) >> 3) - 1, wr, wc, fr, fq); }
        }
        if constexpr (FP8) asm volatile("s_nop 15\n\ts_nop 15" ::: "memory");
        if constexpr (ALIGN_EPI) { if (wr == 0) PG8_BAR; }
        if constexpr (!Epi::AFTER_DRAIN) { E(acc, cur, wr, wc, fr, fq); S.done(cur); }
        if (!has_next) break;
#pragma unroll
        for (int a = 0; a < 2; ++a)
#pragma unroll
            for (int b = 0; b < 2; ++b)
#pragma unroll
                for (int m = 0; m < 4; ++m)
#pragma unroll
                    for (int n = 0; n < 2; ++n) acc[a][b][m][n] = (f32x4){0.f, 0.f, 0.f, 0.f};
        cur = nxt; cA = nA; cB = nB; ++ui;
        if constexpr (Sched::GATHER) { _Pragma("unroll") for (int _h = 0; _h < 2; ++_h) _Pragma("unroll") for (int _i = 0; _i < 2; ++_i) voGc[_h][_i] = voGn_l[(_h * 2 + _i) * 512]; }
        if constexpr (ALIGN_EPI) { if (wr == 1) PG8_BAR; }
    }
    PG8_WAIT_V(0);
    if constexpr (!ALIGN_EPI) { if (wr == 0) PG8_BAR; }
    PG8_BAR;
#undef PG8_SA
#undef PG8_SB
#undef PG8_STAGE
#undef PG8_STAGE_A
#undef PG8_GOFF
#undef PG8_LDA
#undef PG8_LD8
#undef PG8_LDB
#undef PG8_MMA
#undef PG8_WAIT_V
#undef PG8_WAIT_L
#undef PG8_BAR
#undef PG8_SCHED
}
}
constexpr int BATCH = 4, SEQ = 8192, DM = 1024, NTOK = BATCH * SEQ, DEPTH = 2, NEXP = 32;
constexpr int D_IN = 8524, ZP = 8704;
constexpr int Z_AQ = 0, Z_AK = 512, Z_AV = 1024, Z_FQ = 1536, Z_FK = 2048, Z_FV = 2560, Z_CQ = 3072, Z_CF = 3584, Z_CI = 4096, Z_CG = 4608, Z_GT = 5120, Z_IQ = 8192, Z_IK = 8448, Z_IW = 8512, Z_FF = 8516;
constexpr int OP = 1536;
constexpr int MAXBLK = 544, MAXSLOT = MAXBLK * 256;
constexpr int BST_OFF = 16 + MAXBLK + 16;
constexpr float LOG2E = 1.4426950408889634f;
constexpr float QSCALE = 0.125f * LOG2E;
constexpr float ALPHA = 1.4142135623730951f;
constexpr float LN_EPS = 1e-5f, RMS_EPS = 1e-6f;
constexpr int NWAVES = 8, NTHR = 512;
constexpr float W8_SCALE = 64.0f; constexpr int W8_E8M0 = 127 - 6;
constexpr int NPH_LAYER = 14, NPHASES = 1 + DEPTH * NPH_LAYER;
enum { PH_INPROJ = 0, PH_PREP, PH_IDX, PH_ATTN, PH_H1, PH_H2, PH_H3, PH_MERGE, PH_WOUT, PH_LN1, PH_SLOT, PH_GU, PH_DOWN, PH_COMB };

__host__ __device__ __forceinline__ int zcol_src(int n) {
    if (n < 1024 || (n >= 8192 && n < 8512)) { const int p = n & 63; n = (n & ~63) + ((p & 1) ? 32 + (p >> 1) : (p >> 1)); }
    if (n < 1536) return n;
    if (n < 3072) return 1860 + (n - 1536);
    if (n < 5120) return 3404 + (n - 3072);
    if (n < 8192) return 5452 + (n - 5120);
    if (n < 8448) return 1536 + (n - 8192);
    if (n < 8512) return 1792 + (n - 8448);
    if (n < 8516) return 1856 + (n - 8512);
    if (n < 8524) return 3396 + (n - 8516);
    return -1;
}

constexpr size_t MiB = 1u << 20;
constexpr size_t WS_CTL = 0, CTL_ZERO_BYTES = 1 * MiB;
constexpr size_t WS_TRIG = 1 * MiB;
constexpr size_t WS_LFT = 3 * MiB;
constexpr size_t WS_CT = 4 * MiB;
constexpr size_t WS_DG = 5 * MiB, WS_D2G = 6 * MiB;
constexpr size_t WS_WGCNT = 7 * MiB;
constexpr size_t WS_BLK = 7 * MiB + 64 * 1024;
constexpr size_t WS_BGU = 7 * MiB + 128 * 1024;
constexpr size_t WS_TKE = 8 * MiB, WS_TKG = 8 * MiB + 512 * 1024, WS_TOKSLOT = 9 * MiB, WS_GSLOT = 9 * MiB + 512 * 1024;
constexpr size_t WS_SLOTTOK = 10 * MiB + 512 * 1024;
constexpr size_t WS_WRF = 11 * MiB;
constexpr size_t WS_WIN = 12 * MiB;
constexpr size_t WS_WP = 46 * MiB;
constexpr size_t WS_WOUT = 52 * MiB;
constexpr size_t WS_WGU = 56 * MiB;
constexpr size_t WS_WDN = 312 * MiB;
constexpr size_t WS_Z = 440 * MiB;
constexpr size_t WS_XG = WS_Z, WS_ACT = WS_Z + 272 * MiB;
constexpr size_t WS_OBUF = 984 * MiB;
constexpr size_t WS_MERGED = 1080 * MiB;
constexpr size_t WS_MIX = 1144 * MiB;
constexpr size_t WS_Y = WS_OBUF;
constexpr size_t WS_X1 = 1272 * MiB;
constexpr size_t WS_X1B = 1400 * MiB;
constexpr size_t WS_XCUR = 1464 * MiB;
constexpr size_t WS_XB = 1592 * MiB;
constexpr size_t WS_MASKW = 1656 * MiB;
constexpr size_t WS_UG = 1688 * MiB;
constexpr size_t WS_SST = 1752 * MiB;
constexpr size_t WS_SB = 7 * MiB + 768 * 1024;
constexpr size_t WS_KA = 1784 * MiB;
constexpr size_t WS_XB8 = 192 * MiB;
constexpr size_t WS_IKC = 184 * MiB;
constexpr size_t WS_END = 1792 * MiB;
static_assert(WS_Y + (size_t)MAXSLOT * 1024 * 2 <= WS_X1 && WS_ACT + (size_t)MAXSLOT * 1024 * 2 <= WS_OBUF, "ws map");
constexpr int CW_TMO = 0;
constexpr int CW_BAR = 4096;
constexpr int CW_SB = 512;

constexpr int SCR_BYTES = 153600;
constexpr int MISC_OFF = SCR_BYTES;
constexpr int LDS_BYTES = SCR_BYTES + 256;

#define RLX_AGENT __ATOMIC_RELAXED, __HIP_MEMORY_SCOPE_AGENT
#define LDS_WAIT() asm volatile("s_waitcnt lgkmcnt(0)" ::: "memory")
#define VM_WAIT() asm volatile("s_waitcnt vmcnt(0)" ::: "memory")
#define WG_BAR() asm volatile("s_waitcnt vmcnt(0) lgkmcnt(0)\n\ts_barrier" ::: "memory")
#define WG_BAR_LDS() asm volatile("s_waitcnt lgkmcnt(0)\n\ts_barrier" ::: "memory")

#define XB_TMO      128
#define XB_XCNT(j)  (256  + 64 * (j))
#define XB_XSUB(j)  (1280 + 64 * (j))
#define XB_XGEN(j)  (2304 + 64 * (j))
#define XB_TOP      3328
#define XB_TOPGEN   3392
#define XCD_BAR_WORDS 3456
#define XB_SPIN_CAP (1u << 18)

__device__ __forceinline__ unsigned xb_ld(unsigned* p)              { return __hip_atomic_load(p, __ATOMIC_RELAXED, __HIP_MEMORY_SCOPE_AGENT); }
__device__ __forceinline__ unsigned xb_add(unsigned* p, unsigned v) { return __hip_atomic_fetch_add(p, v, __ATOMIC_RELAXED, __HIP_MEMORY_SCOPE_AGENT); }
__device__ __forceinline__ unsigned xb_xcc_id() { return (unsigned)__builtin_amdgcn_s_getreg((3 << 11) | 20) & 0xFu; }
#define XB_SPIN(cond, bar) do { unsigned _sp = 0; while (cond) { __builtin_amdgcn_s_sleep(1); \
    if ((++_sp & 255u) == 0u) { if (xb_ld(&(bar)[XB_TMO])) break; if (_sp > XB_SPIN_CAP) { atomicAdd(&(bar)[XB_TMO], 1u); break; } } } } while (0)

struct XcdBarrier {
    unsigned* bar; unsigned x;
    volatile LAS unsigned* st;
};

__device__ __forceinline__ XcdBarrier xcd_barrier_post(unsigned* bar, volatile LAS unsigned* st) {
    XcdBarrier b; b.bar = bar; b.x = xb_xcc_id(); b.st = st;
    if (threadIdx.x == 0) (void)xb_add(&bar[XB_XCNT(b.x)], 1u);
    return b;
}
__device__ __forceinline__ void xcd_barrier_complete(unsigned* bar, unsigned x, unsigned& nloc, unsigned& nx) {
    const unsigned G = gridDim.x * gridDim.y * gridDim.z;
    unsigned sum, cnt, mine, sp = 0u;
    for (;;) {
        sum = 0u; cnt = 0u; mine = 0u;
#pragma unroll
        for (unsigned j = 0; j < 16; ++j) { const unsigned c = xb_ld(&bar[XB_XCNT(j)]); sum += c; cnt += (c > 0u) ? 1u : 0u; mine = (j == x) ? c : mine; }
        if (sum == G) break;
        __builtin_amdgcn_s_sleep(1);
        if ((++sp & 255u) == 0u) { if (xb_ld(&bar[XB_TMO])) break; if (sp > XB_SPIN_CAP) { atomicAdd(&bar[XB_TMO], 1u); break; } }
    }
    nloc = mine > 0u ? mine : 1u; nx = cnt > 0u ? cnt : 1u;
}

__device__ __forceinline__ void xcd_barrier(const XcdBarrier& b) {
    asm volatile("s_waitcnt vmcnt(0)" ::: "memory");
    __syncthreads();
    if (threadIdx.x == 0) {
        unsigned* bar = b.bar;
        __builtin_amdgcn_s_waitcnt(0);
        unsigned nloc = b.st[0], nx = b.st[1];
        if (nloc == 0u) { xcd_barrier_complete(bar, b.x, nloc, nx); b.st[0] = nloc; b.st[1] = nx; }
        const unsigned old = xb_add(&bar[XB_XSUB(b.x)], 1u);
        const unsigned gen = old / nloc;
        if (old + 1u == (gen + 1u) * nloc) {
            __builtin_amdgcn_fence(__ATOMIC_RELEASE, "agent");
            asm volatile("s_waitcnt vmcnt(0)" ::: "memory");
            const unsigned og = xb_add(&bar[XB_TOP], 1u);
            const unsigned tg = og / nx;
            if (og + 1u == (tg + 1u) * nx) xb_add(&bar[XB_TOPGEN], 1u);
            else XB_SPIN(xb_ld(&bar[XB_TOPGEN]) == tg, bar);
            __builtin_amdgcn_fence(__ATOMIC_ACQUIRE, "agent");
            xb_add(&bar[XB_XGEN(b.x)], 1u);
            asm volatile("s_waitcnt vmcnt(0)" ::: "memory");
        } else {
            XB_SPIN(xb_ld(&bar[XB_XGEN(b.x)]) == gen, bar);
            __builtin_amdgcn_fence(__ATOMIC_ACQUIRE, "agent");
            asm volatile("s_waitcnt vmcnt(0)" ::: "memory");
        }
    }
    __syncthreads();
}
__device__ __forceinline__ int lane_id() { int l = (int)__builtin_amdgcn_mbcnt_hi(~0u, __builtin_amdgcn_mbcnt_lo(~0u, 0u)); asm volatile("" : "+v"(l)); return l; }
__device__ __forceinline__ float wave_sum(float v) {
#pragma unroll
    for (int o = 1; o < 64; o <<= 1) v += __shfl_xor(v, o);
    return v;
}
__device__ __forceinline__ int crow(int r, int hi) { return (r & 3) + 8 * (r >> 2) + 4 * hi; }
__device__ __forceinline__ void glds16(const void* gsrc, unsigned lds_dst) { unsigned keep;
    asm volatile("s_mov_b32 %0, m0\n\ts_mov_b32 m0, %2\n\ts_nop 0\n\tglobal_load_lds_dwordx4 %1, off\n\ts_mov_b32 m0, %0" : "=&s"(keep) : "v"(gsrc), "s"(lds_dst) : "memory"); }
__device__ __forceinline__ void glds4(const void* gsrc, unsigned lds_dst) { unsigned keep;
    asm volatile("s_mov_b32 %0, m0\n\ts_mov_b32 m0, %2\n\ts_nop 0\n\tglobal_load_lds_dword %1, off\n\ts_mov_b32 m0, %0" : "=&s"(keep) : "v"(gsrc), "s"(lds_dst) : "memory"); }
typedef __bf16 bf16x2_t __attribute__((ext_vector_type(2)));
__device__ __forceinline__ unsigned cvtpk(float lo, float hi) { const f32x2 v = {lo, hi}; const bf16x2_t b = __builtin_convertvector(v, bf16x2_t); return __builtin_bit_cast(unsigned, b); }
typedef short v4i16_t __attribute__((ext_vector_type(4)));
__device__ __forceinline__ s16x4 vtr(const LAS char* p) { return __builtin_bit_cast(s16x4, __builtin_amdgcn_ds_read_tr16_b64_v4i16((LAS v4i16_t*)p)); }
__device__ __forceinline__ void plswap(float& a, float& b) { asm volatile("s_nop 1\n\tv_permlane32_swap_b32 %0, %1\n\ts_nop 1" : "+v"(a), "+v"(b)); }
__device__ __forceinline__ float swapmax(float m) { float a = m, b = m; plswap(a, b); return fmaxf(a, b); }
__device__ __forceinline__ float swapsum(float m) { float a = m, b = m; plswap(a, b); return a + b; }
#define MFMA32(a, b, c) __builtin_amdgcn_mfma_f32_32x32x16_bf16((a), (b), (c), 0, 0, 0)

struct Params {
    const float* x; const float* w_in; const float* b_fox; const float* lb_logits; const float* norm_g; const float* w_pa; const float* w_pb; const float* w_pc; const float* w_out;
    const float* ln1_g; const float* ln1_b; const float* w_router; const float* b_router; const float* w_gu; const float* b_gu; const float* w_down; const float* b_down; const float* ln2_g; const float* ln2_b;
    float* out; unsigned char* ws; int ph_lo, ph_hi, use_bar, pad;
};

typedef const __attribute__((address_space(4))) Params* KP;
__device__ __forceinline__ KP load_params() { KP kp = (KP)__builtin_amdgcn_kernarg_segment_ptr(); asm volatile("" : "+s"(kp)); return kp; }

template <class F> __device__ __forceinline__ void cvt_tile(const float* W, size_t ldsrc, int k0, bf16* WT, size_t ldw, int kd0, int n0, const F& f, LAS float* scr, int lane) {
    const int c = lane & 31; int sc; float scale; f(n0 + c, sc, scale);
#pragma unroll 8
    for (int i = 0; i < 32; ++i) { const int kk = 2 * i + (lane >> 5); scr[kk * 33 + c] = sc >= 0 ? W[(size_t)(k0 + kk) * ldsrc + sc] * scale : 0.f; }
    LDS_WAIT(); asm volatile("" ::: "memory");
    const int ch = lane & 7;
#pragma unroll
    for (int j = 0; j < 4; ++j) { const int n = (lane >> 3) + 8 * j; const LAS float* s = scr + (8 * ch) * 33 + n;
        u32x4 o; o.x = pk2(s[0 * 33], s[1 * 33]); o.y = pk2(s[2 * 33], s[3 * 33]); o.z = pk2(s[4 * 33], s[5 * 33]); o.w = pk2(s[6 * 33], s[7 * 33]);
        *(u32x4*)(WT + (size_t)(n0 + n) * ldw + kd0 + 8 * ch) = o; }
    LDS_WAIT(); asm volatile("" ::: "memory");
}
template <class F> __device__ __forceinline__ void cvt_tile8(const float* W, size_t ldsrc, int k0, unsigned char* WT, size_t ldw, int n0, const F& f, float wscale, LAS float* scr, int lane) {
    const int c = lane & 31; int sc; float scale; f(n0 + c, sc, scale); scale *= wscale;
#pragma unroll 8
    for (int i = 0; i < 32; ++i) { const int kk = 2 * i + (lane >> 5); scr[kk * 33 + c] = sc >= 0 ? W[(size_t)(k0 + kk) * ldsrc + sc] * scale : 0.f; }
    LDS_WAIT(); asm volatile("" ::: "memory");
    const int ch = lane & 7;
#pragma unroll
    for (int j = 0; j < 4; ++j) { const int n = (lane >> 3) + 8 * j; const LAS float* s = scr + (8 * ch) * 33 + n;
        int w0 = __builtin_amdgcn_cvt_pk_fp8_f32(s[0 * 33], s[1 * 33], 0, false); w0 = __builtin_amdgcn_cvt_pk_fp8_f32(s[2 * 33], s[3 * 33], w0, true);
        int w1 = __builtin_amdgcn_cvt_pk_fp8_f32(s[4 * 33], s[5 * 33], 0, false); w1 = __builtin_amdgcn_cvt_pk_fp8_f32(s[6 * 33], s[7 * 33], w1, true);
        *(u32x2*)(WT + (size_t)(n0 + n) * ldw + k0 + 8 * ch) = (u32x2){(unsigned)w0, (unsigned)w1}; }
    LDS_WAIT(); asm volatile("" ::: "memory");
}
struct MapIn { __device__ __forceinline__ void operator()(int n, int& sc, float& s) const { sc = zcol_src(n); s = (n < 512 || (n >= Z_FQ && n < Z_FK)) ? QSCALE : 1.0f; } };
struct MapGu { __device__ __forceinline__ void operator()(int n, int& sc, float& s) const { sc = (n & 1) ? 1024 + (n >> 1) : (n >> 1); s = 1.0f; } };
struct MapId { __device__ __forceinline__ void operator()(int n, int& sc, float& s) const { sc = n; s = 1.0f; } };

__device__ __forceinline__ void p0_prologue(KP p, LAS unsigned char* lds, int gw, int NGW, int wave, int lane) {
    LAS float* scr = (LAS float*)(lds + wave * 16384);
    unsigned char* ws = p->ws;
    constexpr int I_IN = 16 * 272, I_GU = 32 * 16 * 64, I_DN = 32 * 16 * 32, I_P = 3 * 8 * 32, I_OUT = 16 * 32, I_LAYER = I_IN + I_GU + I_DN + I_P + I_OUT;
    for (int it = gw; it < DEPTH * I_LAYER; it += NGW) {
        const int l = it / I_LAYER; int r = it - l * I_LAYER;
        if (r < I_IN) { const int kb = r / 272, nb = r % 272;
            cvt_tile8(p->w_in + (size_t)l * 1024 * D_IN, D_IN, 64 * kb, (unsigned char*)(ws + WS_WIN) + (size_t)l * ZP * 1024, 1024, 32 * nb, MapIn{}, W8_SCALE, scr, lane); continue; } r -= I_IN;
        if (r < I_GU) { const int e = r >> 10, r2 = r & 1023, kb = r2 >> 6, nb = r2 & 63;
            cvt_tile8(p->w_gu + (size_t)(l * 32 + e) * 1024 * 2048, 2048, 64 * kb, (unsigned char*)(ws + WS_WGU) + (size_t)(l * 32 + e) * 2048 * 1024, 1024, 32 * nb, MapGu{}, W8_SCALE, scr, lane); continue; } r -= I_GU;
        if (r < I_DN) { const int e = r >> 9, r2 = r & 511, kb = r2 >> 5, nb = r2 & 31;
            cvt_tile8(p->w_down + (size_t)(l * 32 + e) * 1024 * 1024, 1024, 64 * kb, (unsigned char*)(ws + WS_WDN) + (size_t)(l * 32 + e) * 1024 * 1024, 1024, 32 * nb, MapId{}, W8_SCALE, scr, lane); continue; } r -= I_DN;
        if (r < I_P) { const int br = r >> 8, r2 = r & 255, kb = r2 >> 5, nb = r2 & 31; const float* W = (br == 0 ? p->w_pa : br == 1 ? p->w_pb : p->w_pc) + (size_t)l * 512 * 1024;
            cvt_tile(W, 1024, 64 * kb, (bf16*)(ws + WS_WP) + (size_t)l * 1024 * 1536, 1536, br * 512 + 64 * kb, 32 * nb, MapId{}, scr, lane); continue; } r -= I_P;
        { const int kb = r >> 5, nb = r & 31;
            cvt_tile(p->w_out + (size_t)l * 1024 * 1024, 1024, 64 * kb, (bf16*)(ws + WS_WOUT) + (size_t)l * 1024 * 1024, 1024, 64 * kb, 32 * nb, MapId{}, scr, lane); }
    }
    { float* bg = (float*)(ws + WS_BGU);
      for (int i = gw * 64 + lane; i < DEPTH * 32 * 2048; i += NGW * 64) { const int n = i & 2047, le = i >> 11; bg[i] = p->b_gu[(size_t)le * 2048 + ((n & 1) ? 1024 + (n >> 1) : (n >> 1))]; } }
    { bf16* wf = (bf16*)(ws + WS_WRF);
      for (int i = gw * 64 + lane; i < DEPTH * 32 * 2 * 64 * 8; i += NGW * 64) { const int ii = i & 7, ln = (i >> 3) & 63, nt = (i >> 9) & 1, s = (i >> 10) & 31, l = i >> 15;
          const int k = 32 * s + 8 * (ln >> 4) + ii, e = 16 * nt + (ln & 15); const float w = p->w_router[((size_t)l * 1024 + k) * 32 + e];
          const unsigned hb = f2bf(w); const float lo = w - bf2f(hb);
          const size_t base = ((((size_t)l * 32 + s) * 2 + nt) * 2) * 512 + ln * 8 + ii; wf[base] = (bf16)hb; wf[base + 512] = (bf16)f2bf(lo); } }
    { f32x2* tg = (f32x2*)(ws + WS_TRIG);
      for (int i = gw * 64 + lane; i < SEQ * 32; i += NGW * 64) { const int pos = i >> 5, k = i & 31;
          const float inv = exp2f(-(float)k * (13.287712379549449f / 32.0f)); const float ang = (float)pos * inv;
          const double rev = (double)ang * 0.15915494309189535; const float fr = (float)(rev - __builtin_rint(rev));
          tg[i] = (f32x2){__builtin_amdgcn_cosf(fr), __builtin_amdgcn_sinf(fr)}; } }
    { bf16* xb = (bf16*)(ws + WS_XB);
      for (int m = gw; m < NTOK; m += NGW) { const f32x4* xr = (const f32x4*)(p->x + (size_t)m * DM) + lane; u32x2* o = (u32x2*)(xb + (size_t)m * DM) + lane;
#pragma unroll
          for (int j = 0; j < 4; ++j) { const f32x4 v = xr[64 * j]; o[64 * j] = (u32x2){pk2(v.x, v.y), pk2(v.z, v.w)};
              int w8 = __builtin_amdgcn_cvt_pk_fp8_f32(v.x, v.y, 0, false); w8 = __builtin_amdgcn_cvt_pk_fp8_f32(v.z, v.w, w8, true); ((unsigned*)(ws + WS_XB8 + (size_t)m * DM))[lane + 64 * j] = (unsigned)w8; } } }
}

__device__ __forceinline__ void prep_phase(KP p, int l, int gw, int NGW, int lane) {
    unsigned char* ws = p->ws; bf16* Z = (bf16*)(ws + WS_Z); const f32x2* tg = (const f32x2*)(ws + WS_TRIG); float* lfT = (float*)(ws + WS_LFT);
    const float bf_l = (lane < 8) ? p->b_fox[l * 8 + lane] : 0.f;
    for (int m = gw; m < NTOK; m += NGW) {
        bf16* zr = Z + (size_t)m * ZP; const int pos = m & (SEQ - 1), b = m >> 13;
        const f32x2 cs = tg[pos * 32 + (lane & 31)];
        unsigned short ta[11], tb[11];
#pragma unroll
        for (int it = 0; it < 11; ++it) { const int hh = 2 * it + (lane >> 5); const int hc = hh < 21 ? hh : 20;
            const int col = hc < 8 ? Z_AQ + hc * 64 : hc < 16 ? Z_AK + (hc - 8) * 64 : hc < 20 ? Z_IQ + (hc - 16) * 64 : Z_IK;
            const bf16* q = zr + col + (lane & 31); ta[it] = q[0]; tb[it] = q[32]; }
#pragma unroll
        for (int it = 0; it < 11; ++it) { const int hh = 2 * it + (lane >> 5);
            if (hh < 21) { const int col = hh < 8 ? Z_AQ + hh * 64 : hh < 16 ? Z_AK + (hh - 8) * 64 : hh < 20 ? Z_IQ + (hh - 16) * 64 : Z_IK;
                bf16* q = zr + col + (lane & 31); const float t1 = bf2f(ta[it]), t2 = bf2f(tb[it]);
                q[0] = (bf16)f2bf(t1 * cs.x - t2 * cs.y); q[32] = (bf16)f2bf(t2 * cs.x + t1 * cs.y); } }
#pragma unroll
        for (int j = 0; j < 2; ++j) { bf16* g0p = zr + Z_GT + lane * 8 + j * 512; const u32x4 a = *(const u32x4*)g0p, bb = *(const u32x4*)(g0p + 1024), cc = *(const u32x4*)(g0p + 2048);
            u32x4 o0, o1, o2;
#pragma unroll
            for (int i = 0; i < 4; ++i) {
                const float e0l = __expf(-bflo(a[i])), e0h = __expf(-bfhi(a[i])), e1l = __expf(-bflo(bb[i])), e1h = __expf(-bfhi(bb[i])), e2l = __expf(-bflo(cc[i])), e2h = __expf(-bfhi(cc[i]));
                o0[i] = pk2((1.f + e1l) / (1.f + e0l), (1.f + e1h) / (1.f + e0h));
                o1[i] = pk2((1.f + e2l) / (1.f + e1l), (1.f + e2h) / (1.f + e1h));
                o2[i] = pk2(1.f / (1.f + e2l), 1.f / (1.f + e2h)); }
            *(u32x4*)g0p = o0; *(u32x4*)(g0p + 1024) = o1; *(u32x4*)(g0p + 2048) = o2; }
        if (lane < 8) { const float v = bf2f(zr[Z_FF + lane]) + bf_l; const float ls = fminf(v, 0.f) - __logf(1.0f + __expf(-fabsf(v))); lfT[(size_t)(b * 8 + lane) * SEQ + pos] = ls * LOG2E; }
    }
}

constexpr int IX_CAP = 1024, IX_STRIDE = IX_CAP + 1  , IX_TRIG = 768, IX_CAND = 0, IX_BM = 0  , IX_HIST = 32 * IX_STRIDE * 4, IX_CNT = IX_HIST + 8 * 1024, IX_TAU = IX_CNT + 128, IX_FLAG = IX_TAU + 128, IX_END = IX_FLAG + 64;
static_assert(IX_END <= SCR_BYTES, "indexer LDS");

__device__ __forceinline__ int wave_incl_sum(int v) {
    v += __builtin_amdgcn_update_dpp(0, v, 0x111, 0xf, 0xf, false);
    v += __builtin_amdgcn_update_dpp(0, v, 0x112, 0xf, 0xf, false);
    v += __builtin_amdgcn_update_dpp(0, v, 0x114, 0xf, 0xf, false);
    v += __builtin_amdgcn_update_dpp(0, v, 0x118, 0xf, 0xf, false);
    v += __builtin_amdgcn_update_dpp(0, v, 0x142, 0xa, 0xf, false);
    v += __builtin_amdgcn_update_dpp(0, v, 0x143, 0xc, 0xf, false);
    return v;
}
__device__ __forceinline__ unsigned wave_or63(unsigned v) {
    v |= (unsigned)__builtin_amdgcn_update_dpp(0, (int)v, 0x111, 0xf, 0xf, false);
    v |= (unsigned)__builtin_amdgcn_update_dpp(0, (int)v, 0x112, 0xf, 0xf, false);
    v |= (unsigned)__builtin_amdgcn_update_dpp(0, (int)v, 0x114, 0xf, 0xf, false);
    v |= (unsigned)__builtin_amdgcn_update_dpp(0, (int)v, 0x118, 0xf, 0xf, false);
    v |= (unsigned)__builtin_amdgcn_update_dpp(0, (int)v, 0x142, 0xa, 0xf, false);
    v |= (unsigned)__builtin_amdgcn_update_dpp(0, (int)v, 0x143, 0xc, 0xf, false);
    return v;
}
__device__ __forceinline__ int count_ge8(const unsigned (&x)[16], int k0, unsigned t) {
    u64 m0, m1, m2, m3, m4, m5, m6, m7;
    asm("v_cmp_ge_u32_e64 %0, %8, %16\n\tv_cmp_ge_u32_e64 %1, %9, %16\n\tv_cmp_ge_u32_e64 %2, %10, %16\n\tv_cmp_ge_u32_e64 %3, %11, %16\n\t"
        "v_cmp_ge_u32_e64 %4, %12, %16\n\tv_cmp_ge_u32_e64 %5, %13, %16\n\tv_cmp_ge_u32_e64 %6, %14, %16\n\tv_cmp_ge_u32_e64 %7, %15, %16"
        : "=&s"(m0), "=&s"(m1), "=&s"(m2), "=&s"(m3), "=&s"(m4), "=&s"(m5), "=&s"(m6), "=&s"(m7)
        : "v"(x[k0]), "v"(x[k0 + 1]), "v"(x[k0 + 2]), "v"(x[k0 + 3]), "v"(x[k0 + 4]), "v"(x[k0 + 5]), "v"(x[k0 + 6]), "v"(x[k0 + 7]), "v"(t));
    return (int)(__popcll(m0) + __popcll(m1) + __popcll(m2) + __popcll(m3) + __popcll(m4) + __popcll(m5) + __popcll(m6) + __popcll(m7));
}
template <bool EXACT>
__device__ __forceinline__ unsigned wave_search256(const unsigned (&x)[16]) {
    const unsigned xr = (unsigned)__builtin_amdgcn_readfirstlane((int)x[0]); unsigned df = 0u;
#pragma unroll
    for (int k = 0; k < 16; ++k) df |= (x[k] != 0u) ? (x[k] ^ xr) : 0u;
    df = (unsigned)__builtin_amdgcn_readlane((int)wave_or63(df), 63);
    const int hb = 31 - (int)__builtin_clz(df | 1u);
    unsigned prefix = xr & ~((2u << hb) - 1u);
#pragma unroll 1
    for (int bit = hb; bit >= 0; --bit) { const unsigned trial = prefix | (1u << bit); const int c = count_ge8(x, 0, trial) + count_ge8(x, 8, trial);
        if (c >= 256) { prefix = trial; if (EXACT ? (c == 256) : (c <= 384)) break; } }
    return prefix;
}
__device__ __forceinline__ unsigned wave_compact(LAS unsigned* cand, int n, int lane, int& kept) {
    unsigned x[16];
#pragma unroll
    for (int k = 0; k < 16; ++k) { const int i = lane + 64 * k; x[k] = (i < n) ? cand[i] : 0u; }
    const unsigned prefix = wave_search256<false>(x);
    int base = 0;
#pragma unroll
    for (int k = 0; k < 16; ++k) { const bool keep = x[k] >= prefix; const u64 mk = __ballot(keep);
        if (keep) cand[__builtin_amdgcn_mbcnt_hi((unsigned)(mk >> 32), __builtin_amdgcn_mbcnt_lo((unsigned)mk, (unsigned)base))] = x[k]; base += __popcll(mk); }
    kept = base;
    return prefix;
}

__device__ __forceinline__ void idx_phase(KP p, int l, LAS unsigned char* lds, int vcu, int G, int tid, int wave, int lane) {
    unsigned char* ws = p->ws; const bf16* Z = (const bf16*)(ws + WS_Z);
    { unsigned* sbr = (unsigned*)(ws + WS_CTL) + CW_SB + l * 64; LAS float* wt = (LAS float*)lds;
      for (int task = blockIdx.x; task < 256; task += G) { const int bh = task >> 3, part = task & 7; float qm = 0.f, km = 0.f;
          const bf16* zr = Z + (size_t)((bh >> 3) * SEQ + part * 1024 + tid * 2) * ZP + (bh & 7) * 64;
#pragma unroll
          for (int i = 0; i < 2; ++i) { float qs = 0.f, ks = 0.f;
#pragma unroll
              for (int c8 = 0; c8 < 8; ++c8) { const u32x4 a = *(const u32x4*)(zr + (size_t)i * ZP + Z_FQ + c8 * 8), kq = *(const u32x4*)(zr + (size_t)i * ZP + Z_FK + c8 * 8);
#pragma unroll
                  for (int w4 = 0; w4 < 4; ++w4) { qs += bflo(a[w4]) * bflo(a[w4]) + bfhi(a[w4]) * bfhi(a[w4]); ks += bflo(kq[w4]) * bflo(kq[w4]) + bfhi(kq[w4]) * bfhi(kq[w4]); } }
              qm = fmaxf(qm, qs); km = fmaxf(km, ks); }
#pragma unroll
          for (int o = 1; o < 64; o <<= 1) { qm = fmaxf(qm, __shfl_xor(qm, o)); km = fmaxf(km, __shfl_xor(km, o)); }
          if (lane == 0) { __hip_atomic_fetch_max(sbr + 2 * bh, __builtin_bit_cast(unsigned, qm), __ATOMIC_RELAXED, __HIP_MEMORY_SCOPE_AGENT); __hip_atomic_fetch_max(sbr + 2 * bh + 1, __builtin_bit_cast(unsigned, km), __ATOMIC_RELAXED, __HIP_MEMORY_SCOPE_AGENT); } }
      (void)wt; }
    for (int bh = blockIdx.x; bh < 32; bh += G) {
        float* dst = (float*)(ws + WS_CT) + (size_t)bh * SEQ;
        LAS float* wt = (LAS float*)lds;
        const float bfx = p->b_fox[l * 8 + (bh & 7)]; const bf16* zf = Z + (size_t)((bh >> 3) * SEQ + tid * 16) * ZP + Z_FF + (bh & 7);
        f32x4 v[4]; float run = 0.f;
#pragma unroll
        for (int j = 0; j < 4; ++j) {
#pragma unroll
            for (int i = 0; i < 4; ++i) { const float t = bf2f(zf[(size_t)(4 * j + i) * ZP]) + bfx; v[j][i] = (fminf(t, 0.f) - __logf(1.0f + __expf(-fabsf(t)))) * LOG2E; }
            v[j].x += run; v[j].y += v[j].x; v[j].z += v[j].y; v[j].w += v[j].z; run = v[j].w; }
        float inc = run;
#pragma unroll
        for (int o = 1; o < 64; o <<= 1) { const float t = __shfl_up(inc, o); if (lane >= o) inc += t; }
        if (lane == 63) wt[wave] = inc;
        WG_BAR();
        float off = inc - run;
        for (int w = 0; w < wave; ++w) off += wt[w];
        { u32x4* ka = (u32x4*)((bf16*)(ws + WS_KA) + ((size_t)bh * SEQ + tid * 16) * 16);
#pragma unroll
          for (int j = 0; j < 4; ++j) { const f32x4 c4 = v[j] + off; *(f32x4*)(dst + tid * 16 + 4 * j) = c4;
#pragma unroll
              for (int i = 0; i < 4; ++i) { const float c = c4[i]; const unsigned h1 = f2bf(c); const float r1 = c - bf2f(h1); const unsigned h2 = f2bf(r1); const unsigned h3 = f2bf(r1 - bf2f(h2));
                  unsigned z0 = 0u; asm volatile("" : "+v"(z0));
                  ka[(4 * j + i) * 2] = (u32x4){h1 | (h2 << 16), h3 | 0x3f800000u, z0, z0}; ka[(4 * j + i) * 2 + 1] = (u32x4){z0, z0, z0, z0}; } } }
        WG_BAR();
    }
    LAS unsigned* cand = (LAS unsigned*)(lds + IX_CAND); LAS unsigned* BM = (LAS unsigned*)(lds + IX_BM);
    LAS unsigned* cnt = (LAS unsigned*)(lds + IX_CNT); LAS unsigned* tau = (LAS unsigned*)(lds + IX_TAU); LAS unsigned* hist = (LAS unsigned*)(lds + IX_HIST); LAS unsigned* flg = (LAS unsigned*)(lds + IX_FLAG);
    u64* MW = (u64*)(ws + WS_MASKW);
    const int r32 = lane & 31, hi = lane >> 5;
    for (int U = vcu; U < 1024; U += G) {
        const int v = U & 255, i4 = U >> 8; const int b = v & 3, a = v >> 2;
        const int hc = (i4 == 0) ? a : (i4 == 1) ? 255 - a : (i4 == 2) ? 64 + a : 191 - a;
        const int qbase = b * SEQ + hc * 32; const int nadm = ((hc >> 1) + 1) * 64;
        if (nadm <= 256) {
            const int nw = nadm >> 6;
            for (int i = tid; i < 32 * 128; i += NTHR) { const int q = i >> 7, w = i & 127; unsigned on = (w < nw) ? 0xffffffffu : 0u; asm volatile("" : "+v"(on));
                MW[(size_t)(qbase + q) * 128 + w] = (u64)on | ((u64)on << 32); }
            continue;
        }
        const bf16* qrow = Z + (size_t)(qbase + r32) * ZP;
        bf16x8 iqf[4][4];
#pragma unroll
        for (int hd = 0; hd < 4; ++hd)
#pragma unroll
            for (int j = 0; j < 4; ++j) iqf[hd][j] = *(const bf16x8*)(qrow + Z_IQ + hd * 64 + j * 16 + hi * 8);
        float wq[4];
#pragma unroll
        for (int hd = 0; hd < 4; ++hd) wq[hd] = bf2f(qrow[Z_IW + hd]) * (0.5f * 0.125f);
        if (tid < 32) { cnt[tid] = 0u; tau[tid] = 0u; } if (tid < 3) flg[tid] = 0u;
        const int ntiles = nadm >> 5, nrounds = (ntiles + 7) >> 3;
        const bf16* kbase = (const bf16*)(ws + WS_IKC) + (size_t)(b * SEQ) * 64 + hi * 8;
        bf16x8 kf[4], kn[4];
#pragma unroll
        for (int j = 0; j < 4; ++j) kn[j] = *(const bf16x8*)(kbase + (size_t)((wave < ntiles ? wave : 0) * 32 + r32) * 64 + j * 16);
        WG_BAR();
        for (int rd = 0; rd < nrounds; ++rd) {
            const int tile = rd * 8 + wave;
#pragma unroll
            for (int j = 0; j < 4; ++j) kf[j] = kn[j];
            { const int tn = (tile + 8 < ntiles) ? tile + 8 : tile;
#pragma unroll
              for (int j = 0; j < 4; ++j) kn[j] = *(const bf16x8*)(kbase + (size_t)((tn < ntiles ? tn : 0) * 32 + r32) * 64 + j * 16); }
            if (tile < ntiles) {
                f32x16 sc = {};
#pragma unroll
                for (int hd = 0; hd < 4; ++hd) { f32x16 pp = {};
#pragma unroll
                    for (int j = 0; j < 4; ++j) pp = MFMA32(kf[j], iqf[hd][j], pp);
#pragma unroll
                    for (int r = 0; r < 16; ++r) { const float pv = pp[r]; const int pb = __builtin_bit_cast(int, pv); const int pr = pb > 0 ? pb : 0;
                        sc[r] = __builtin_fmaf(wq[hd], __builtin_bit_cast(float, pr), sc[r]); } }
                const unsigned tq = tau[r32];
                typedef unsigned u32x16_t __attribute__((ext_vector_type(16))); u32x16_t comp; unsigned npass = 0u;
#pragma unroll
                for (int r = 0; r < 16; ++r) { const int key = tile * 32 + crow(r, hi);
                    unsigned u = __builtin_bit_cast(unsigned, sc[r] + 0.0f); u ^= (u >> 31) ? 0xffffffffu : 0x80000000u;
                    comp[r] = (u & 0xffffe000u) | (unsigned)(8191 - key); npass += (comp[r] > tq) ? 1u : 0u; }
                unsigned pos = 0u;
                if (npass) pos = __hip_atomic_fetch_add(cnt + r32, npass, __ATOMIC_RELAXED, __HIP_MEMORY_SCOPE_WORKGROUP);
                LAS unsigned* cq_ = cand + r32 * IX_STRIDE;
#pragma unroll
                for (int r = 0; r < 16; ++r) if (comp[r] > tq) { cq_[pos] = comp[r]; ++pos; }
                if (npass && pos > (unsigned)IX_TRIG) flg[rd % 3] = 1u;
            }
            WG_BAR_LDS();
            const bool need_any = flg[rd % 3] != 0u;
            if (tid == 0) flg[(rd + 2) % 3] = 0u;
            if (need_any) {
#pragma unroll 1
                for (int i = 0; i < 4; ++i) { const int qq = wave * 4 + i; const int n = __builtin_amdgcn_readfirstlane((int)cnt[qq]);
                    if (n > 256) { int kept; const unsigned th = wave_compact(cand + qq * IX_STRIDE, n, lane, kept); if (lane == 0) { cnt[qq] = (unsigned)kept; tau[qq] = th ? th - 1u : 0u; } } }
                WG_BAR_LDS();
            }
        }
#pragma unroll 1
        for (int i = 0; i < 4; ++i) { const int qq = wave * 4 + i; const int n = __builtin_amdgcn_readfirstlane((int)cnt[qq]);
            LAS unsigned* cq = cand + qq * IX_STRIDE; unsigned x[16];
#pragma unroll
            for (int k = 0; k < 16; ++k) { const int ii = lane + 64 * k; x[k] = (ii < n) ? cq[ii] : 0u; }
            unsigned th = 1u; if (n > 256) th = wave_search256<true>(x);
            asm volatile("" ::: "memory");
#pragma unroll
            for (int k = 0; k < 4; ++k) { unsigned z0 = 0u; asm volatile("" : "+v"(z0)); cq[lane + 64 * k] = z0; }
#pragma unroll
            for (int k = 0; k < 16; ++k) if (x[k] >= th) { const int key = 8191 - (int)(x[k] & 8191u);
                (void)__hip_atomic_fetch_or(cq + (key >> 5), 1u << (key & 31), __ATOMIC_RELAXED, __HIP_MEMORY_SCOPE_WORKGROUP); }
            LDS_WAIT(); asm volatile("" ::: "memory");
            const unsigned w0 = cq[4 * lane], w1 = cq[4 * lane + 1], w2 = cq[4 * lane + 2], w3 = cq[4 * lane + 3];
            *(u32x4*)(MW + (size_t)(qbase + qq) * 128 + 2 * lane) = (u32x4){w0, w1, w2, w3};
            asm volatile("" ::: "memory"); }
        WG_BAR();
    }
}

constexpr int AT_K = 0, AT_V = 2 * 8192, AT_WS = 4 * 8192, AT_OST = AT_WS + 4096, AT_MW = AT_OST + 8 * 4096, AT_KA = AT_MW + 2 * 8 * 512, AT_END = AT_KA + 2 * 2048;
static_assert(AT_END <= SCR_BYTES, "attention LDS");
#ifndef DBG_ATT_L
#define DBG_ATT_L 0
#endif

template <int MODE>
__device__ __forceinline__ void attn_unit(int b, int h, int qb, const bf16* Z, bf16* Ob, const float* cT, const u64* MW, const void* KA, const void* SBp, LAS char* shm, int wv) {
    int tid_l = lane_id() + wv * 64;
    const int tid = tid_l, lane = tid & 63, r32 = lane & 31, hi = lane >> 5; const int wid = __builtin_amdgcn_readfirstlane(tid >> 6);
    constexpr int QC = MODE == 0 ? Z_FQ : Z_AQ, KC = MODE == 0 ? Z_FK : Z_AK, VC = MODE == 0 ? Z_FV : Z_AV, OC = MODE == 0 ? 512 : 0;
    const long rowbase = (long)b * SEQ; const int q0 = qb * 512;
    const bf16* Qw = Z + (rowbase + q0 + wid * 64) * ZP + QC + h * 64;
    const bf16* Kh = Z + rowbase * ZP + KC + h * 64; const bf16* Vh = Z + rowbase * ZP + VC + h * 64;
    const unsigned lds0 = (unsigned)(uintptr_t)shm;
    LAS float* wsf = (LAS float*)(shm + AT_WS) + wid * 128;
    const int NT = 8 * (qb + 1); const int tlast = 8 * qb + wid;
    const bf16* ksrc = Kh + (long)lane * ZP + wid * 8;
    const bf16* vsrc = Vh + (long)(16 * (wid & 3) + (lane >> 2)) * ZP + (wid >> 2) * 32 + (lane & 3) * 8;
    const unsigned kdst = lds0 + AT_K + wid * 1024, vdst = lds0 + AT_V + wid * 1024, mdst = lds0 + AT_MW + wid * 512;
    const unsigned kadst = lds0 + AT_KA + (wid & 1) * 1024;
#define DMA_KA(t, sl) do { if (MODE == 0 && wid < 2) { const int ln_ = lane_id();     \
        glds16((const bf16*)KA + ((size_t)(b * 8 + h) * SEQ + (t) * 64 + 32 * wid + (ln_ >> 1)) * 16 + (ln_ & 1) * 8, (unsigned)__builtin_amdgcn_readfirstlane(kadst + (sl) * 2048)); } } while (0)
#define DMA_K(t, slotb) glds16(ksrc + (long)(t) * 64 * ZP, (unsigned)__builtin_amdgcn_readfirstlane(kdst + (slotb)))
#define DMA_V(t, slotb) glds16(vsrc + (long)(t) * 64 * ZP, (unsigned)__builtin_amdgcn_readfirstlane(vdst + (slotb)))
#define DMA_M(t, sl) do { const int ln_ = lane_id(); const unsigned* msrcA = (const unsigned*)(MW + (size_t)(rowbase + q0 + wid * 64 + (ln_ & 31)) * 128) + (ln_ >> 5);     \
        glds4(msrcA + 2 * (t), (unsigned)__builtin_amdgcn_readfirstlane(mdst + (sl) * 4096)); glds4(msrcA + 32 * 256 + 2 * (t), (unsigned)__builtin_amdgcn_readfirstlane(mdst + (sl) * 4096 + 256)); } while (0)
    int t_start = 0, t_first = 0;
    if (MODE == 0) { const float* cg = cT + (size_t)(b * 8 + h) * SEQ; const float th = 2.0f * (sqrtf(((const float*)SBp)[2 * (b * 8 + h)]) * sqrtf(((const float*)SBp)[2 * (b * 8 + h) + 1]) * 1.01f + 1.0f) + 40.0f; const int ln_ = lane_id();
        const float c0 = cg[q0], cw = cg[q0 + wid * 64];
        const float ca = (ln_ < NT) ? cg[64 * ln_ + 63] : -3e38f, cb = (ln_ + 64 < NT) ? cg[64 * (ln_ + 64) + 63] : -3e38f;
        { const u64 m0 = __ballot(ca <= c0 + th), m1 = __ballot(cb <= c0 + th); t_start = m0 ? (int)__builtin_ctzll(m0) : 64 + (int)__builtin_ctzll(m1 | (1ull << 63)); }
        { const u64 m0 = __ballot(ca <= cw + th), m1 = __ballot(cb <= cw + th); t_first = m0 ? (int)__builtin_ctzll(m0) : 64 + (int)__builtin_ctzll(m1 | (1ull << 63)); }
        if (t_start > 8 * qb) t_start = 8 * qb; if (t_first > tlast) t_first = tlast; }
    DMA_K(t_start, 0); DMA_V(t_start, 0); if (MODE == 1) DMA_M(0, 0); DMA_KA(t_start, 0);
    bf16x8 qA[4], qB[4];
#pragma unroll
    for (int d0 = 0; d0 < 4; ++d0) { qA[d0] = *(const bf16x8*)(Qw + (long)r32 * ZP + d0 * 16 + hi * 8); qB[d0] = *(const bf16x8*)(Qw + (long)(32 + r32) * ZP + d0 * 16 + hi * 8); }
    float mA = 0.f, mB = 0.f, lA = 0.f, lB = 0.f;
    const unsigned qa0 = (MODE == 0 && hi == 0) ? 0xbf80bf80u : 0u; const unsigned qa1c = (MODE == 0 && hi == 0) ? 0xbf80u : 0u;
    u32x4 qaA = {qa0, qa1c, 0u, 0u}, qaB = {qa0, qa1c, 0u, 0u};
    f32x16 oA[2], oB[2]; oA[0] = f32x16{}; oA[1] = f32x16{}; oB[0] = f32x16{}; oB[1] = f32x16{};
    const int qrelA = wid * 64 + r32;
    const LAS char* kp0 = shm + AT_K + hi * 1024 + r32 * 16;
    const LAS char* vp0 = shm + AT_V + ((lane >> 4) & 1) * 32 + (lane & 3) * 8 + (4 * hi + ((lane & 15) >> 2)) * 64;
    const LAS unsigned* mwp = (const LAS unsigned*)(shm + AT_MW + wid * 512);
    const LAS char* kap0 = shm + AT_KA + r32 * 32 + hi * 16;
    int slot = 0;
#define SOFTMAX(P0, P1, MH, LR, OO, QA, QREL, WSOFF, MWOFF, PW) do { \
        if (MODE == 0) { \
            if (t == tlast) { _Pragma("unroll") for (int r = 0; r < 16; ++r) { const int kv = crow(r, hi); if (kv > (QREL) - wid * 64) P0[r] = -INFINITY; if (kv + 32 > (QREL) - wid * 64) P1[r] = -INFINITY; } } \
        } else { const unsigned mlo = mwp[slot * 1024 + (MWOFF) + r32] >> (4 * hi), mhi = mwp[slot * 1024 + (MWOFF) + 32 + r32] >> (4 * hi);     \
            _Pragma("unroll") for (int r = 0; r < 16; ++r) { const int bitp = crow(r, 0); const float p0_ = P0[r], p1_ = P1[r];     \
                const unsigned s0_ = (unsigned)__builtin_amdgcn_sbfe((int)mlo, bitp, 1), s1_ = (unsigned)__builtin_amdgcn_sbfe((int)mhi, bitp, 1);                       \
                P0[r] = __builtin_bit_cast(float, (__builtin_bit_cast(unsigned, p0_) & s0_) | (0xff800000u & ~s0_)); P1[r] = __builtin_bit_cast(float, (__builtin_bit_cast(unsigned, p1_) & s1_) | (0xff800000u & ~s1_)); } } \
        float rm = __builtin_fmaxf(__builtin_fmaxf(P0[0], P0[1]), P1[0]), rm2 = __builtin_fmaxf(__builtin_fmaxf(P0[2], P0[3]), P1[1]); rm = __builtin_fmaxf(__builtin_fmaxf(rm, P1[2]), P1[3]); \
        _Pragma("unroll") for (int r = 4; r < 16; r += 4) { rm = __builtin_fmaxf(__builtin_fmaxf(rm, P0[r]), P0[r + 1]); rm2 = __builtin_fmaxf(__builtin_fmaxf(rm2, P0[r + 2]), P0[r + 3]); rm = __builtin_fmaxf(__builtin_fmaxf(rm, P1[r]), P1[r + 1]); rm2 = __builtin_fmaxf(__builtin_fmaxf(rm2, P1[r + 2]), P1[r + 3]); } \
        rm = __builtin_fmaxf(rm, rm2); \
        rm = swapmax(rm);                            \
        if (__any(rm > 8.0f)) { const bool big_ = __builtin_fabsf(MH) + __builtin_fabsf(rm > 0.f ? rm : 0.f) > 1800.0f;     \
            const float dl = rm > 0.f ? (big_ ? 64.0f * __builtin_ceilf((MH + rm) * (1.0f / 64.0f)) - MH : 8.0f * __builtin_ceilf(rm * 0.125f)) : 0.f; const float f = __builtin_amdgcn_exp2f(-dl); LR *= f; MH += dl; \
            QA[1] = (QA[1] & 0xffffu) | ((hi == 0) ? (f2bf(-MH) << 16) : 0u); \
            _Pragma("unroll") for (int r = 0; r < 16; ++r) { P0[r] -= dl; P1[r] -= dl; } \
            if (hi == 0) wsf[(WSOFF) + r32] = f; \
            LDS_WAIT(); \
            _Pragma("unroll") for (int j = 0; j < 4; ++j) { const f32x4 ff = *(const LAS f32x4*)(wsf + (WSOFF) + 8 * j + 4 * hi); \
                _Pragma("unroll") for (int i = 0; i < 4; ++i) { OO[0][4 * j + i] *= ff[i]; OO[1][4 * j + i] *= ff[i]; } } } \
        float sacc = 0.f; \
        _Pragma("unroll") for (int r = 0; r < 16; ++r) { P0[r] = __builtin_amdgcn_exp2f(P0[r]); P1[r] = __builtin_amdgcn_exp2f(P1[r]); sacc += P0[r] + P1[r]; } \
        LR += sacc; \
        _Pragma("unroll") for (int i = 0; i < 4; ++i) { PW[0][i] = cvtpk(P0[2 * i], P0[2 * i + 1]); PW[1][i] = cvtpk(P0[8 + 2 * i], P0[8 + 2 * i + 1]); PW[2][i] = cvtpk(P1[2 * i], P1[2 * i + 1]); PW[3][i] = cvtpk(P1[8 + 2 * i], P1[8 + 2 * i + 1]); } \
    } while (0)
#define PVMM(OO, PW) do { const LAS char* vp = vp0 + slot * 8192; \
        _Pragma("unroll") for (int d0 = 0; d0 < 2; ++d0) { s16x4 lo_[4], hh_[4]; \
            _Pragma("unroll") for (int ks = 0; ks < 4; ++ks) { lo_[ks] = vtr(vp + d0 * 4096 + ks * 1024); hh_[ks] = vtr(vp + d0 * 4096 + ks * 1024 + 512); } \
            _Pragma("unroll") for (int ks = 0; ks < 4; ++ks) { const bf16x8 vf = {lo_[ks][0], lo_[ks][1], lo_[ks][2], lo_[ks][3], hh_[ks][0], hh_[ks][1], hh_[ks][2], hh_[ks][3]}; \
                OO[d0] = MFMA32(__builtin_bit_cast(bf16x8, PW[ks]), vf, OO[d0]); } } } while (0)
    for (int t = t_start; t < NT; ++t) {
        asm volatile("s_waitcnt vmcnt(0) lgkmcnt(0)\n\ts_barrier" ::: "memory");
        if (t + 1 < NT) { DMA_K(t + 1, (slot ^ 1) * 8192); DMA_V(t + 1, (slot ^ 1) * 8192); if (MODE == 1) DMA_M(t + 1, slot ^ 1); DMA_KA(t + 1, slot ^ 1); }
        if (t <= tlast && t >= t_first) {
            f32x16 a0 = {}, a1 = {}, b0 = {}, b1 = {};
            { const LAS char* kb = kp0 + slot * 8192;
#pragma unroll
              for (int d0 = 0; d0 < 4; ++d0) { const bf16x8 k0 = *(const LAS bf16x8*)(kb + d0 * 2048), k1 = *(const LAS bf16x8*)(kb + d0 * 2048 + 512);
                  a0 = MFMA32(k0, qA[d0], a0); a1 = MFMA32(k1, qA[d0], a1); b0 = MFMA32(k0, qB[d0], b0); b1 = MFMA32(k1, qB[d0], b1); }
              bf16x8 x0, x1;
              if (MODE == 0) { x0 = *(const LAS bf16x8*)(kap0 + slot * 2048); x1 = *(const LAS bf16x8*)(kap0 + slot * 2048 + 1024); }
              else { const u32x4 cw = {0u, (hi == 0) ? 0x3f800000u : 0u, 0u, 0u}; x0 = __builtin_bit_cast(bf16x8, cw); x1 = x0; }
              a0 = MFMA32(x0, __builtin_bit_cast(bf16x8, qaA), a0); a1 = MFMA32(x1, __builtin_bit_cast(bf16x8, qaA), a1); b0 = MFMA32(x0, __builtin_bit_cast(bf16x8, qaB), b0); b1 = MFMA32(x1, __builtin_bit_cast(bf16x8, qaB), b1); }
            u32x4 pwA[4], pwB[4];
            SOFTMAX(a0, a1, mA, lA, oA, qaA, qrelA, 0, 0, pwA);
            PVMM(oA, pwA);
            SOFTMAX(b0, b1, mB, lB, oB, qaB, qrelA + 32, 32, 64, pwB);
            PVMM(oB, pwB);
        }
        slot ^= 1;
    }
#define EPILOG(OO, LR, WSOFF, ROWOFF) do { float l_ = swapsum(LR); if (hi == 0) wsf[64 + (WSOFF) + r32] = l_; LDS_WAIT(); float rli[16]; \
        _Pragma("unroll") for (int r = 0; r < 16; ++r) rli[r] = __builtin_amdgcn_rcpf(wsf[64 + (WSOFF) + crow(r, hi)]); \
        bf16* Ow = Ob + (rowbase + q0 + wid * 64 + (ROWOFF)) * OP + OC + h * 64; LAS bf16* stg = (LAS bf16*)(shm + AT_OST) + wid * 2048; \
        _Pragma("unroll") for (int r = 0; r < 16; ++r) { const int orow = crow(r, hi); _Pragma("unroll") for (int d0 = 0; d0 < 2; ++d0) stg[orow * 64 + d0 * 32 + r32] = (bf16)f2bf(OO[d0][r] * rli[r]); } \
        LDS_WAIT(); \
        _Pragma("unroll") for (int i = 0; i < 4; ++i) { const int row = i * 8 + (lane >> 3), ch = lane & 7; const u32x4 v = *(const LAS u32x4*)(stg + row * 64 + ch * 8); *(u32x4*)(Ow + (long)row * OP + ch * 8) = v; } \
        LDS_WAIT(); } while (0)
    EPILOG(oA, lA, 0, 0);
    EPILOG(oB, lB, 32, 32);
    asm volatile("s_waitcnt lgkmcnt(0)\n\ts_barrier" ::: "memory");
#undef DMA_K
#undef DMA_V
#undef DMA_M
#undef DMA_KA
#undef SOFTMAX
#undef PVMM
#undef EPILOG
}

__device__ __forceinline__ void attn_phase(KP p, int l, LAS unsigned char* lds, int vcu, int G, int wv) {
    unsigned char* ws = p->ws; const bf16* Z = (const bf16*)(ws + WS_Z); bf16* Ob = (bf16*)(ws + WS_OBUF); const float* cT = (const float*)(ws + WS_CT); const u64* MW = (const u64*)(ws + WS_MASKW);
    for (int U = vcu; U < 1024; U += G) {
        const int v = U & 255, i4 = U >> 8; const int mode = i4 & 1, k = i4 >> 1; const int bh = v >> 3, s = v & 7;
        const int qb = (k == 0) ? s : 15 - s;
        if (mode == 0) attn_unit<0>(bh >> 3, bh & 7, qb, Z, Ob, cT, MW, (const void*)(ws + WS_KA), (const void*)((const unsigned*)(ws + WS_CTL) + CW_SB + l * 64), (LAS char*)lds, wv);
        else attn_unit<1>(bh >> 3, bh & 7, qb, Z, Ob, cT, MW, (const void*)(ws + WS_KA), (const void*)((const unsigned*)(ws + WS_CTL) + CW_SB + l * 64), (LAS char*)lds, wv);
    }
}

constexpr int HG_LF = 0, HG_KK = 16640, HG_SEG = 33280, HG_P = 35328, HG_R = HG_P + 9216, HG_RT = HG_R + 9216, HG_VT = HG_RT + 9216, HG_ST = HG_VT + 9216, HG_CG = HG_ST + 9216, HG_END = HG_CG + 9216;
static_assert(HG_END <= SCR_BYTES, "hgrn LDS");
constexpr int HP = 72;

__device__ __forceinline__ void hgrn_front(KP p, int l, const unsigned short (&zf)[8], int h, int d, int seg, LAS float* SEG, float (&kk)[8], float (&bb)[8], float& bm, float& bl) {
    const int dd = h * 64 + d; const float lb = (l == 0) ? 0.f : sigmoidf_(p->lb_logits[512 + dd] - p->lb_logits[dd]);
    float run = 0.f;
#pragma unroll
    for (int i = 0; i < 8; ++i) { const float sg = sigmoidf_(bf2f(zf[i])); const float f = lb + (1.f - lb) * sg; kk[i] = (1.f - lb) * (1.f - sg); run += __logf(f); bb[i] = run; }
    SEG[seg * 64 + d] = run;
    WG_BAR_LDS();
    float pre = 0.f, m4 = 0.f, all = 0.f;
#pragma unroll
    for (int s2 = 0; s2 < 8; ++s2) { const float sv = SEG[s2 * 64 + d]; if (s2 < seg) pre += sv; if (s2 < 4) m4 += sv; all += sv; }
#pragma unroll
    for (int i = 0; i < 8; ++i) bb[i] += pre;
    bm = m4; bl = all;
}

#define H_ROWP(U_) (Z + (size_t)((((U_) >> 7) >> 3) * SEQ + ((U_) & 127) * 64 + 8 * seg) * ZP + (((U_) >> 7) & 7) * 64 + d)
__device__ __forceinline__ void h1_phase(KP p, int l, LAS unsigned char* lds, int vcu, int G, int tid, int wave, int lane) {
    unsigned char* ws = p->ws; const bf16* Z = (const bf16*)(ws + WS_Z); float* Ug = (float*)(ws + WS_UG); float* Dg = (float*)(ws + WS_DG); float* D2g = (float*)(ws + WS_D2G);
    LAS float* SEG = (LAS float*)(lds + HG_SEG); LAS bf16* RT = (LAS bf16*)(lds + HG_RT); LAS bf16* VT = (LAS bf16*)(lds + HG_VT);
    const int r32 = lane & 31, hi = lane >> 5; const int d = tid & 63, seg = tid >> 6;
    for (int U = vcu; U < 4096; U += G) {
        const int bh = U >> 7, h = bh & 7; const bf16* rp = H_ROWP(U);
        unsigned short zf[8], vv[8];
#pragma unroll
        for (int i = 0; i < 8; ++i) { zf[i] = rp[(size_t)i * ZP + Z_CF]; vv[i] = rp[(size_t)i * ZP + Z_CI]; }
        float kk[8], bb[8], bm, bl; hgrn_front(p, l, zf, h, d, seg, SEG, kk, bb, bm, bl);
        { unsigned rw[4], vw[4];
#pragma unroll
          for (int i = 0; i < 4; ++i) { rw[i] = pk2(kk[2 * i] * __expf(fminf(bm - bb[2 * i], 80.f)), kk[2 * i + 1] * __expf(fminf(bm - bb[2 * i + 1], 80.f))); vw[i] = (unsigned)vv[2 * i] | ((unsigned)vv[2 * i + 1] << 16); }
          *(LAS u32x4*)(RT + d * HP + 8 * seg) = (u32x4){rw[0], rw[1], rw[2], rw[3]}; *(LAS u32x4*)(VT + d * HP + 8 * seg) = (u32x4){vw[0], vw[1], vw[2], vw[3]}; }
        if (seg == 7) { Dg[(size_t)U * 64 + d] = __expf(bl); D2g[(size_t)U * 64 + d] = __expf(bl - bm); }
        WG_BAR_LDS();
        if (wave < 4) { const int ib = wave >> 1, jb = wave & 1; f32x16 acc = {};
#pragma unroll
            for (int ks = 0; ks < 4; ++ks) { const bf16x8 a = *(const LAS bf16x8*)(RT + (32 * ib + r32) * HP + 16 * ks + 8 * hi), bq = *(const LAS bf16x8*)(VT + (32 * jb + r32) * HP + 16 * ks + 8 * hi);
                acc = MFMA32(a, bq, acc); }
            float* up = Ug + ((size_t)U * 64 + 32 * jb + r32) * 64 + 32 * ib + 4 * hi;
#pragma unroll
            for (int rr = 0; rr < 4; ++rr) *(f32x4*)(up + 8 * rr) = (f32x4){acc[4 * rr], acc[4 * rr + 1], acc[4 * rr + 2], acc[4 * rr + 3]}; }
        WG_BAR_LDS();
    }
}

__device__ __forceinline__ void h2_phase(KP p, int G, int tid) {
    unsigned char* ws = p->ws; const float* Ug = (const float*)(ws + WS_UG); const float* Dg = (const float*)(ws + WS_DG); const float* D2g = (const float*)(ws + WS_D2G); bf16* Sst = (bf16*)(ws + WS_SST);
    for (int gid = blockIdx.x * NTHR + tid; gid < 32 * 4096; gid += G * NTHR) {
        const int bh = gid >> 12, ed = gid & 4095, d = ed & 63; float S = 0.f;
        const float* up = Ug + (size_t)bh * 128 * 4096 + ed; const float* dp = Dg + (size_t)bh * 128 * 64 + d; const float* d2p = D2g + (size_t)bh * 128 * 64 + d; bf16* sp = Sst + (size_t)bh * 128 * 4096 + ed;
        for (int c0 = 0; c0 < 128; c0 += 8) { float u[8], dd[8], d2[8];
#pragma unroll
            for (int i = 0; i < 8; ++i) { u[i] = up[(size_t)(c0 + i) * 4096]; dd[i] = dp[(c0 + i) * 64]; d2[i] = d2p[(c0 + i) * 64]; }
#pragma unroll
            for (int i = 0; i < 8; ++i) { sp[(size_t)(c0 + i) * 4096] = (bf16)f2bf(S); S = dd[i] * S + d2[i] * u[i]; } }
    }
}

__device__ __forceinline__ void h3_phase(KP p, int l, LAS unsigned char* lds, int vcu, int G, int tid, int wave, int lane) {
    unsigned char* ws = p->ws; const bf16* Z = (const bf16*)(ws + WS_Z); const bf16* Sst = (const bf16*)(ws + WS_SST); bf16* Ob = (bf16*)(ws + WS_OBUF);
    LAS float* SEG = (LAS float*)(lds + HG_SEG);
    LAS bf16* Pt = (LAS bf16*)(lds + HG_P); LAS bf16* Rt = (LAS bf16*)(lds + HG_R); LAS bf16* VT = (LAS bf16*)(lds + HG_VT); LAS bf16* ST = (LAS bf16*)(lds + HG_ST); LAS bf16* CG = (LAS bf16*)(lds + HG_CG);
    const int r32 = lane & 31, hi = lane >> 5; const int d = tid & 63, seg = tid >> 6;
    const float* gn = p->norm_g + l * 512;
    for (int U = vcu; U < 4096; U += G) {
        const int bh = U >> 7, c = U & 127, b = bh >> 3, h = bh & 7; const int t0 = b * SEQ + c * 64; const bf16* rp = H_ROWP(U);
        unsigned short zf[8], qv[8], vv[8], gg[8], sv[8];
#pragma unroll
        for (int i = 0; i < 8; ++i) { zf[i] = rp[(size_t)i * ZP + Z_CF]; qv[i] = rp[(size_t)i * ZP + Z_CQ]; vv[i] = rp[(size_t)i * ZP + Z_CI]; gg[i] = rp[(size_t)i * ZP + Z_CG]; sv[i] = Sst[(size_t)U * 4096 + (8 * seg + i) * 64 + d]; }
        float kk[8], bb[8], bm, bl; hgrn_front(p, l, zf, h, d, seg, SEG, kk, bb, bm, bl); (void)bl;
        { const float ebm = __expf(bm); unsigned vw[4];
#pragma unroll
          for (int i = 0; i < 8; ++i) { const int t = 8 * seg + i;
              Pt[t * HP + d] = (bf16)f2bf(bf2f(qv[i]) * __expf(fminf(bb[i] - bm, 80.f))); Rt[t * HP + d] = (bf16)f2bf(kk[i] * __expf(fminf(bm - bb[i], 80.f)));
              ST[t * HP + d] = (bf16)f2bf(bf2f(sv[i]) * ebm); CG[t * HP + d] = (bf16)gg[i]; }
#pragma unroll
          for (int i = 0; i < 4; ++i) vw[i] = (unsigned)vv[2 * i] | ((unsigned)vv[2 * i + 1] << 16);
          *(LAS u32x4*)(VT + d * HP + 8 * seg) = (u32x4){vw[0], vw[1], vw[2], vw[3]}; }
        WG_BAR_LDS();
        if (wave < 2) { const int ib = wave;
            u32x4 pw[2][2];
#pragma unroll
            for (int k = 0; k < 2; ++k) { f32x16 a = {};
                if (k <= ib) {
#pragma unroll
                    for (int js = 0; js < 4; ++js) { const bf16x8 ra = *(const LAS bf16x8*)(Rt + (32 * k + r32) * HP + 16 * js + 8 * hi), pb = *(const LAS bf16x8*)(Pt + (32 * ib + r32) * HP + 16 * js + 8 * hi);
                        a = MFMA32(ra, pb, a); }
                    if (k == ib) {
#pragma unroll
                        for (int r = 0; r < 16; ++r) if (crow(r, hi) > r32) a[r] = 0.f;
                    }
                }
#pragma unroll
                for (int i = 0; i < 4; ++i) { pw[k][0][i] = cvtpk(a[2 * i], a[2 * i + 1]); pw[k][1][i] = cvtpk(a[8 + 2 * i], a[8 + 2 * i + 1]); } }
            f32x16 oacc[2]; float ss = 0.f;
#pragma unroll
            for (int j = 0; j < 2; ++j) { f32x16 oa = {};
#pragma unroll
                for (int k = 0; k < 2; ++k) { if (k <= ib) {
#pragma unroll
                    for (int st = 0; st < 2; ++st) { const LAS bf16* vp = VT + (32 * j + r32) * HP + 32 * k + 16 * st + 4 * hi;
                        const s16x4 v0 = *(const LAS s16x4*)vp, v1 = *(const LAS s16x4*)(vp + 8);
                        const bf16x8 vf = {v0[0], v0[1], v0[2], v0[3], v1[0], v1[1], v1[2], v1[3]};
                        oa = MFMA32(vf, __builtin_bit_cast(bf16x8, pw[k][st]), oa); } } }
#pragma unroll
                for (int js = 0; js < 4; ++js) { const bf16x8 sa = *(const LAS bf16x8*)(ST + (32 * j + r32) * HP + 16 * js + 8 * hi), pb = *(const LAS bf16x8*)(Pt + (32 * ib + r32) * HP + 16 * js + 8 * hi);
                    oa = MFMA32(sa, pb, oa); }
#pragma unroll
                for (int r = 0; r < 16; ++r) ss += oa[r] * oa[r];
                oacc[j] = oa; }
            ss = swapsum(ss);
            const float rstd = 1.0f / sqrtf(ss * (1.0f / 64.0f) + RMS_EPS);
            bf16* orow = Ob + (size_t)(t0 + 32 * ib + r32) * OP + 1024 + h * 64;
#pragma unroll
            for (int j = 0; j < 2; ++j)
#pragma unroll
                for (int rr = 0; rr < 4; ++rr) { const int e0 = 32 * j + 8 * rr + 4 * hi; const f32x4 g4 = *(const f32x4*)(gn + h * 64 + e0);
                    const u32x2 cw = *(const LAS u32x2*)(CG + (32 * ib + r32) * HP + e0);
                    const float o0 = oacc[j][4 * rr] * rstd * g4[0] * sigmoidf_(bflo(cw.x)), o1 = oacc[j][4 * rr + 1] * rstd * g4[1] * sigmoidf_(bfhi(cw.x));
                    const float o2 = oacc[j][4 * rr + 2] * rstd * g4[2] * sigmoidf_(bflo(cw.y)), o3 = oacc[j][4 * rr + 3] * rstd * g4[3] * sigmoidf_(bfhi(cw.y));
                    *(u32x2*)(orow + e0) = (u32x2){cvtpk(o0, o1), cvtpk(o2, o3)}; }
        }
        WG_BAR_LDS();
    }
}

#undef H_ROWP
constexpr int RT_LG = 0, RT_HIST = 8 * 2048, RT_END = RT_HIST + 1024;
static_assert(RT_END <= SCR_BYTES, "router LDS");
typedef short bf16x8_t __attribute__((ext_vector_type(8)));
__device__ __forceinline__ void split_hi_lo(const f32x4 a, const f32x4 b, bf16x8_t& hi, bf16x8_t& lo) {
    const float v[8] = {a.x, a.y, a.z, a.w, b.x, b.y, b.z, b.w}; unsigned h[8], l[8];
#pragma unroll
    for (int i = 0; i < 8; ++i) { h[i] = f2bf(v[i]); l[i] = f2bf(v[i] - bf2f(h[i])); }
    const u32x4 hw = {h[0] | (h[1] << 16), h[2] | (h[3] << 16), h[4] | (h[5] << 16), h[6] | (h[7] << 16)}, lw = {l[0] | (l[1] << 16), l[2] | (l[3] << 16), l[4] | (l[5] << 16), l[6] | (l[7] << 16)};
    hi = __builtin_bit_cast(bf16x8_t, hw); lo = __builtin_bit_cast(bf16x8_t, lw);
}
__device__ __forceinline__ void ln1_phase(KP p, int l, const float* xin, LAS unsigned char* lds, int G, int tid, int wave, int lane) {
    unsigned char* ws = p->ws; const bf16* mix = (const bf16*)(ws + WS_MIX); float* x1 = (float*)(ws + WS_X1); bf16* x1b = (bf16*)(ws + WS_X1B);
    int* tke = (int*)(ws + WS_TKE); float* tkg = (float*)(ws + WS_TKG); int* wgcnt = (int*)(ws + WS_WGCNT);
    LAS float* LG = (LAS float*)(lds + RT_LG) + wave * 512; LAS unsigned* hist = (LAS unsigned*)(lds + RT_HIST);
    if (tid < 32) hist[tid] = 0u;
    WG_BAR();
    const float* lg = p->ln1_g + l * 1024; const float* lb = p->ln1_b + l * 1024;
    f32x4 gv[4], bv[4];
#pragma unroll
    for (int j = 0; j < 4; ++j) { gv[j] = *(const f32x4*)(lg + 4 * lane + 256 * j); bv[j] = *(const f32x4*)(lb + 4 * lane + 256 * j); }
    const int m0 = blockIdx.x * NWAVES + wave, mstride = G * NWAVES;
    for (int mb = m0; mb < NTOK; mb += 16 * mstride) {
        f32x4 xa[4], xm[4];
#define LOAD_XIN(mm) do { if (l == 0) { const f32x4* xr = (const f32x4*)(xin + (size_t)(mm) * DM) + lane; _Pragma("unroll") for (int j = 0; j < 4; ++j) xa[j] = xr[64 * j]; } \
            else { const u32x2* xr = (const u32x2*)((const bf16*)(ws + WS_XB) + (size_t)(mm) * DM) + lane; _Pragma("unroll") for (int j = 0; j < 4; ++j) { const u32x2 w = xr[64 * j]; xa[j] = (f32x4){bflo(w.x), bfhi(w.x), bflo(w.y), bfhi(w.y)}; } } } while (0)
        { LOAD_XIN(mb); const u32x2* mr = (const u32x2*)(mix + (size_t)mb * DM) + lane;
#pragma unroll
          for (int j = 0; j < 4; ++j) { const u32x2 w = mr[64 * j]; xm[j] = (f32x4){bflo(w.x), bfhi(w.x), bflo(w.y), bfhi(w.y)}; } }
#pragma unroll 1
        for (int i = 0; i < 16; ++i) { const int m = mb + i * mstride; if (m >= NTOK) break;
            f32x4 v[4]; float s = 0.f;
#pragma unroll
            for (int j = 0; j < 4; ++j) { v[j] = xa[j] * ALPHA + xm[j]; s += (v[j].x + v[j].y) + (v[j].z + v[j].w); }
            { const int mn = (m + mstride < NTOK) ? m + mstride : m;
              LOAD_XIN(mn); const u32x2* mr = (const u32x2*)(mix + (size_t)mn * DM) + lane;
#pragma unroll
              for (int j = 0; j < 4; ++j) { const u32x2 w = mr[64 * j]; xm[j] = (f32x4){bflo(w.x), bfhi(w.x), bflo(w.y), bfhi(w.y)}; } }
            const float mean = wave_sum(s) * (1.f / DM); float s2 = 0.f;
#pragma unroll
            for (int j = 0; j < 4; ++j) { v[j] = v[j] - mean; s2 += (v[j].x * v[j].x + v[j].y * v[j].y) + (v[j].z * v[j].z + v[j].w * v[j].w); }
            const float rstd = 1.f / sqrtf(wave_sum(s2) * (1.f / DM) + LN_EPS);
            f32x4* o4 = (f32x4*)(x1 + (size_t)m * DM) + lane; unsigned* o1 = (unsigned*)((unsigned char*)x1b + (size_t)m * DM) + lane;
#pragma unroll
            for (int j = 0; j < 4; ++j) { v[j] = v[j] * rstd * gv[j] + bv[j]; o4[64 * j] = v[j]; int w8 = __builtin_amdgcn_cvt_pk_fp8_f32(v[j].x, v[j].y, 0, false); w8 = __builtin_amdgcn_cvt_pk_fp8_f32(v[j].z, v[j].w, w8, true); o1[64 * j] = (unsigned)w8; } }
        asm volatile("s_waitcnt vmcnt(0)" ::: "memory"); __builtin_amdgcn_fence(__ATOMIC_ACQUIRE, "agent"); asm volatile("s_waitcnt vmcnt(0)" ::: "memory");
        { const int ti = lane & 15, kg = lane >> 4; int mt = mb + ti * mstride; if (mt >= NTOK) mt = mb;
          const float* xr = x1 + (size_t)mt * DM + 8 * kg; const bf16* wf = (const bf16*)(ws + WS_WRF) + (size_t)l * 32 * 2 * 2 * 512 + lane * 8;
          f32x4 acc0 = {0.f, 0.f, 0.f, 0.f}, acc1 = {0.f, 0.f, 0.f, 0.f};
#pragma unroll 4
          for (int s = 0; s < 32; ++s) { const f32x4 a0 = *(const f32x4*)(xr + 32 * s), a1 = *(const f32x4*)(xr + 32 * s + 4); bf16x8_t ah, al; split_hi_lo(a0, a1, ah, al);
              const bf16x8_t w0h = *(const bf16x8_t*)(wf + (size_t)(s * 4 + 0) * 512), w0l = *(const bf16x8_t*)(wf + (size_t)(s * 4 + 1) * 512), w1h = *(const bf16x8_t*)(wf + (size_t)(s * 4 + 2) * 512), w1l = *(const bf16x8_t*)(wf + (size_t)(s * 4 + 3) * 512);
              acc0 = __builtin_amdgcn_mfma_f32_16x16x32_bf16(ah, w0h, acc0, 0, 0, 0); acc0 = __builtin_amdgcn_mfma_f32_16x16x32_bf16(al, w0h, acc0, 0, 0, 0); acc0 = __builtin_amdgcn_mfma_f32_16x16x32_bf16(ah, w0l, acc0, 0, 0, 0);
              acc1 = __builtin_amdgcn_mfma_f32_16x16x32_bf16(ah, w1h, acc1, 0, 0, 0); acc1 = __builtin_amdgcn_mfma_f32_16x16x32_bf16(al, w1h, acc1, 0, 0, 0); acc1 = __builtin_amdgcn_mfma_f32_16x16x32_bf16(ah, w1l, acc1, 0, 0, 0); }
#pragma unroll
          for (int r = 0; r < 4; ++r) { LG[(4 * kg + r) * 32 + ti] = acc0[r]; LG[(4 * kg + r) * 32 + 16 + ti] = acc1[r]; } }
        LDS_WAIT();
        if (lane < 16) { const int m = mb + lane * mstride;
            if (m < NTOK) { float tv0 = -3e38f, tv1 = -3e38f, tv2 = -3e38f, tv3 = -3e38f; int ti0 = 0, ti1 = 0, ti2 = 0, ti3 = 0;
#pragma unroll
                for (int e4 = 0; e4 < 8; ++e4) { const f32x4 lv = *(const LAS f32x4*)(LG + lane * 32 + 4 * e4); const f32x4 bb = *(const f32x4*)(p->b_router + l * 32 + 4 * e4);
#pragma unroll
                    for (int i = 0; i < 4; ++i) { const float g = lv[i] + bb[i]; const int e = 4 * e4 + i;
                        if (g > tv0) { tv3 = tv2; ti3 = ti2; tv2 = tv1; ti2 = ti1; tv1 = tv0; ti1 = ti0; tv0 = g; ti0 = e; }
                        else if (g > tv1) { tv3 = tv2; ti3 = ti2; tv2 = tv1; ti2 = ti1; tv1 = g; ti1 = e; }
                        else if (g > tv2) { tv3 = tv2; ti3 = ti2; tv2 = g; ti2 = e; }
                        else if (g > tv3) { tv3 = g; ti3 = e; } } }
                const float e1 = __expf(tv1 - tv0), e2 = __expf(tv2 - tv0), e3 = __expf(tv3 - tv0); const float inv = 1.f / (1.f + e1 + e2 + e3);
                *(int4*)(tke + m * 4) = make_int4(ti0, ti1, ti2, ti3); *(f32x4*)(tkg + m * 4) = (f32x4){inv, e1 * inv, e2 * inv, e3 * inv};
                __hip_atomic_fetch_add(hist + ti0, 1u, __ATOMIC_RELAXED, __HIP_MEMORY_SCOPE_WORKGROUP); __hip_atomic_fetch_add(hist + ti1, 1u, __ATOMIC_RELAXED, __HIP_MEMORY_SCOPE_WORKGROUP);
                __hip_atomic_fetch_add(hist + ti2, 1u, __ATOMIC_RELAXED, __HIP_MEMORY_SCOPE_WORKGROUP); __hip_atomic_fetch_add(hist + ti3, 1u, __ATOMIC_RELAXED, __HIP_MEMORY_SCOPE_WORKGROUP); } }
        LDS_WAIT();
    }
    WG_BAR();
    if (tid < 32) wgcnt[blockIdx.x * 32 + tid] = (int)hist[tid];
}

__device__ __forceinline__ void slot_phase(KP p, LAS unsigned char* lds, int G, int tid, int wave, int lane) {
    unsigned char* ws = p->ws; const int* wgcnt = (const int*)(ws + WS_WGCNT); int* blk = (int*)(ws + WS_BLK);
    const int* tke = (const int*)(ws + WS_TKE); const float* tkg = (const float*)(ws + WS_TKG); int* tokslot = (int*)(ws + WS_TOKSLOT); float* gslot = (float*)(ws + WS_GSLOT);
    LAS unsigned* tot = (LAS unsigned*)lds; LAS unsigned* mine = tot + 32; LAS unsigned* cur = tot + 64;
    if (tid < 96) tot[tid] = 0u;
    WG_BAR();
    { const int e = tid & 31, part = tid >> 5; unsigned sa = 0u, sb = 0u;
      for (int w = part; w < G; w += 16) { const unsigned c = (unsigned)wgcnt[w * 32 + e]; sa += c; if (w < (int)blockIdx.x) sb += c; }
      __hip_atomic_fetch_add(tot + e, sa, __ATOMIC_RELAXED, __HIP_MEMORY_SCOPE_WORKGROUP); __hip_atomic_fetch_add(mine + e, sb, __ATOMIC_RELAXED, __HIP_MEMORY_SCOPE_WORKGROUP); }
    WG_BAR();
    if (tid == 0) { unsigned off = 0u;
#pragma unroll 1
        for (int e = 0; e < 32; ++e) { const unsigned padded = (tot[e] + 255u) & ~255u; cur[e] = off + mine[e];
            if (blockIdx.x == 0) { blk[BST_OFF + e] = (int)(off >> 8);
#pragma unroll 1
                for (unsigned bb = off >> 8; bb < ((off + padded) >> 8); ++bb) blk[16 + bb] = e; }
            off += padded; }
        if (blockIdx.x == 0) { blk[0] = (int)(off >> 8); blk[BST_OFF + 32] = (int)(off >> 8); } }
    WG_BAR();
    int* slottok = (int*)(ws + WS_SLOTTOK);
    if (blockIdx.x == 0 && tid < 32) { const unsigned ps = cur[tid], n = tot[tid];
        int zero_ = 0; asm volatile("" : "+v"(zero_));
#pragma unroll 1
        for (unsigned s = ps + n; s < ps + ((n + 255u) & ~255u); ++s) slottok[s] = zero_; }
    WG_BAR();
    for (int m = blockIdx.x * NWAVES + wave; m < NTOK; m += G * NWAVES) {
        if (lane < 4) { const int e = tke[m * 4 + lane]; const int slot = (int)__hip_atomic_fetch_add(cur + e, 1u, __ATOMIC_RELAXED, __HIP_MEMORY_SCOPE_WORKGROUP); tokslot[m * 4 + lane] = slot; gslot[slot] = tkg[m * 4 + lane]; slottok[slot] = m; }
    }
}

__device__ __forceinline__ void comb_phase(KP p, int l, float* xout, int G, int wave, int lane) {
    unsigned char* ws = p->ws; const float* x1 = (const float*)(ws + WS_X1); const bf16* y = (const bf16*)(ws + WS_Y); const int* tokslot = (const int*)(ws + WS_TOKSLOT); bf16* xb = (bf16*)(ws + WS_XB);
    const float* lg = p->ln2_g + l * 1024; const float* lb = p->ln2_b + l * 1024;
    f32x4 gv[4], bv[4];
#pragma unroll
    for (int j = 0; j < 4; ++j) { gv[j] = *(const f32x4*)(lg + 4 * lane + 256 * j); bv[j] = *(const f32x4*)(lb + 4 * lane + 256 * j); }
    for (int m = blockIdx.x * NWAVES + wave; m < NTOK; m += G * NWAVES) {
        const f32x4* xr = (const f32x4*)(x1 + (size_t)m * DM) + lane;
        f32x4 v[4];
#pragma unroll
        for (int j = 0; j < 4; ++j) v[j] = xr[64 * j] * ALPHA;
#pragma unroll
        for (int k = 0; k < 4; ++k) { const int sk = __builtin_amdgcn_readfirstlane(tokslot[m * 4 + k]); const u32x2* yr = (const u32x2*)(y + (size_t)sk * DM) + lane;
#pragma unroll
            for (int j = 0; j < 4; ++j) { const u32x2 w = yr[64 * j]; v[j].x += bflo(w.x); v[j].y += bfhi(w.x); v[j].z += bflo(w.y); v[j].w += bfhi(w.y); } }
        float s = 0.f;
#pragma unroll
        for (int j = 0; j < 4; ++j) s += (v[j].x + v[j].y) + (v[j].z + v[j].w);
        const float mean = wave_sum(s) * (1.f / DM); float s2 = 0.f;
#pragma unroll
        for (int j = 0; j < 4; ++j) { v[j] = v[j] - mean; s2 += (v[j].x * v[j].x + v[j].y * v[j].y) + (v[j].z * v[j].z + v[j].w * v[j].w); }
        const float rstd = 1.f / sqrtf(wave_sum(s2) * (1.f / DM) + LN_EPS);
        f32x4* o4 = (f32x4*)(xout + (size_t)m * DM) + lane; u32x2* o2 = (u32x2*)(xb + (size_t)m * DM) + lane;
#pragma unroll
        for (int j = 0; j < 4; ++j) { v[j] = v[j] * rstd * gv[j] + bv[j]; if (l == DEPTH - 1) o4[64 * j] = v[j]; else { o2[64 * j] = (u32x2){pk2(v[j].x, v[j].y), pk2(v[j].z, v[j].w)};
            int w8 = __builtin_amdgcn_cvt_pk_fp8_f32(v[j].x, v[j].y, 0, false); w8 = __builtin_amdgcn_cvt_pk_fp8_f32(v[j].z, v[j].w, w8, true); ((unsigned*)(ws + WS_XB8 + (size_t)m * DM))[lane + 64 * j] = (unsigned)w8; } }
    }
}

#ifndef ONE_LAUNCH
#define ONE_LAUNCH 1
#endif
__global__ void __launch_bounds__(NTHR, 2) fwd(Params p) {
    extern __shared__ __attribute__((aligned(16))) unsigned char lds_raw[];
    LAS unsigned char* lds = (LAS unsigned char*)lds_raw;
    volatile LAS unsigned* MISC = (volatile LAS unsigned*)(lds + MISC_OFF);
    const int tid = threadIdx.x, lane = tid & 63, wave = __builtin_amdgcn_readfirstlane(tid >> 6); const int wave0 = wave;
    const int G = gridDim.x; const int bx = blockIdx.x; const int vcu = (G % 8 == 0) ? (bx % 8) * (G / 8) + bx / 8 : bx;
    if (tid < 64) MISC[tid] = 0u;
    __syncthreads();
    if (p.use_bar) (void)xcd_barrier_post((unsigned*)(p.ws + WS_CTL) + CW_BAR, MISC + 8);
    const int lo = p.ph_lo, hi = p.ph_hi;
#ifndef PHSEL
#define PHSEL(k) true
#endif
#define IN(k) (PHSEL(k) && lo <= (k) && (k) < hi)
#define SEAM(k) do { if (lo <= (k) && (k) + 1 < hi) { KP qb_ = load_params(); XcdBarrier b_; b_.bar = (unsigned*)(qb_->ws + WS_CTL) + CW_BAR; b_.x = xb_xcc_id(); b_.st = MISC + 8; xcd_barrier(b_); } } while (0)
    const int gw0 = vcu * NWAVES + wave, NGW = G * NWAVES;
#define PH_IDS const int lane = lane_id(), wave = wave0, tid = wave0 * 64 + lane, gw = vcu * NWAVES + wave; (void)lane; (void)gw; (void)gw0;

    if (IN(0)) { PH_IDS KP q = load_params(); p0_prologue(q, lds, gw, NGW, wave, lane); SEAM(0); }

    for (int l = 0; l < DEPTH; ++l) {
        const int pb = 1 + l * NPH_LAYER;

        if (IN(pb + PH_INPROJ)) {
            KP q = load_params(); unsigned char* w = q->ws;
            pg8::Gemm g{(const bf16*)(w + WS_XB8), (const bf16*)(w + WS_WIN + (size_t)l * ZP * 1024), NTOK, ZP, 1024}; pg8::StaticOrder S; S.init(NTOK, ZP, G, bx);
            pg8::EpiZ E{(bf16*)(w + WS_Z), ZP, (const float*)(w + WS_TRIG), (bf16*)(w + WS_IKC)};
            pg8::gemm_phase<pg8::EpiZ, pg8::StaticOrder, true, true, true, W8_E8M0>(lds, g, S, E, wave0);
            SEAM(pb + PH_INPROJ);
        }
        if (IN(pb + PH_IDX)) { PH_IDS KP q = load_params(); idx_phase(q, l, lds, vcu, G, tid, wave, lane); SEAM(pb + PH_IDX); }
        if (IN(pb + PH_ATTN)) { PH_IDS KP q = load_params(); attn_phase(q, l, lds, vcu, G, wave0); SEAM(pb + PH_ATTN); }
        if (IN(pb + PH_H1)) { PH_IDS KP q = load_params(); h1_phase(q, l, lds, vcu, G, tid, wave, lane); SEAM(pb + PH_H1); }
        if (IN(pb + PH_H2)) { PH_IDS KP q = load_params(); h2_phase(q, G, tid); SEAM(pb + PH_H2); }
        if (IN(pb + PH_H3)) { PH_IDS KP q = load_params(); h3_phase(q, l, lds, vcu, G, tid, wave, lane); SEAM(pb + PH_H3); }
        if (IN(pb + PH_MERGE)) {
            KP q = load_params(); unsigned char* w = q->ws;
            pg8::Gemm g{(const bf16*)(w + WS_OBUF), (const bf16*)(w + WS_WP) + (size_t)l * 1024 * 1536, NTOK, 1024, 1536}; pg8::StaticOrder S; S.init(NTOK, 1024, G, bx);
            pg8::EpiMerge E{(const bf16*)(w + WS_Z) + Z_GT, ZP, (bf16*)(w + WS_MERGED), 1024};
            pg8::gemm_phase<pg8::EpiMerge, pg8::StaticOrder, true, true>(lds, g, S, E, wave0);
            SEAM(pb + PH_MERGE);
        }
        if (IN(pb + PH_WOUT)) {
            KP q = load_params(); unsigned char* w = q->ws;
            pg8::Gemm g{(const bf16*)(w + WS_MERGED), (const bf16*)(w + WS_WOUT) + (size_t)l * 1024 * 1024, NTOK, 1024, 1024}; pg8::StaticOrder S; S.init(NTOK, 1024, G, bx);
            pg8::EpiBf16 E{(bf16*)(w + WS_MIX), 1024};
            pg8::gemm_phase<pg8::EpiBf16, pg8::StaticOrder, true, true>(lds, g, S, E, wave0);
            SEAM(pb + PH_WOUT);
        }
        if (IN(pb + PH_LN1)) { PH_IDS KP q = load_params(); const float* xin = (l == 0) ? q->x : (const float*)(q->ws + WS_XCUR); ln1_phase(q, l, xin, lds, G, tid, wave, lane); SEAM(pb + PH_LN1); }
        if (IN(pb + PH_SLOT)) { PH_IDS KP q = load_params(); slot_phase(q, lds, G, tid, wave, lane); SEAM(pb + PH_SLOT); }
        if (IN(pb + PH_GU)) {
            KP q = load_params(); unsigned char* w = q->ws;
            pg8::Gemm g{(const bf16*)(w + WS_X1B), (const bf16*)(w + WS_WGU + (size_t)l * 32 * 2048 * 1024), MAXSLOT, 32 * 2048, 1024};
            pg8::moe_build_list((LAS int*)(lds + pg8::STAGE_BYTES), (const int*)(w + WS_BLK), 8, G, bx, wave0 * 64 + lane_id()); pg8::MoeOrderG S{(const LAS int*)(lds + pg8::STAGE_BYTES), (const int*)(w + WS_SLOTTOK)};
            pg8::EpiSwiGLU E{(bf16*)(w + WS_ACT), (const float*)(w + WS_BGU) + (size_t)l * 32 * 2048, 8};
            pg8::gemm_phase<pg8::EpiSwiGLU, pg8::MoeOrderG, true, true, true, W8_E8M0>(lds, g, S, E, wave0);
            SEAM(pb + PH_GU);
        }
        if (IN(pb + PH_DOWN)) {
            KP q = load_params(); unsigned char* w = q->ws;
            pg8::Gemm g{(const bf16*)(w + WS_ACT), (const bf16*)(w + WS_WDN + (size_t)l * 32 * 1024 * 1024), MAXSLOT, 32 * 1024, 1024};
            pg8::moe_build_list((LAS int*)(lds + pg8::STAGE_BYTES), (const int*)(w + WS_BLK), 4, G, bx, wave0 * 64 + lane_id()); pg8::MoeOrder S{(const LAS int*)(lds + pg8::STAGE_BYTES), nullptr};
            pg8::EpiDown E{(bf16*)(w + WS_Y), q->b_down + (size_t)l * 32 * 1024, (const float*)(w + WS_GSLOT), 4};
            pg8::gemm_phase<pg8::EpiDown, pg8::MoeOrder, true, true, true, W8_E8M0>(lds, g, S, E, wave0);
            SEAM(pb + PH_DOWN);
        }
        if (IN(pb + PH_COMB)) { PH_IDS KP q = load_params(); float* xout = (l == DEPTH - 1) ? q->out : (float*)(q->ws + WS_XCUR); comb_phase(q, l, xout, G, wave, lane); SEAM(pb + PH_COMB); }
    }
#undef IN
#undef SEAM
}

#ifndef DBG
#define DBG 0
#endif
#if DBG
constexpr int CW_DBG = 64;
__device__ __forceinline__ unsigned hsh(unsigned a) { a ^= a >> 16; a *= 0x7feb352du; a ^= a >> 15; a *= 0x846ca68bu; a ^= a >> 16; return a; }
__device__ __forceinline__ void dbg_fail(Params& p, int id) { atomicMin((int*)(p.ws + WS_CTL) + CW_DBG, id); }
__device__ __forceinline__ bool bad(float a, float ref, float rel, float abs_) { return !(fabsf(a - ref) <= rel * fabsf(ref) + abs_); }
__device__ __forceinline__ float dotx(const float* xr, const float* W, int ld, int col, int K) { float s = 0.f; for (int k = 0; k < K; ++k) s += xr[k] * W[(size_t)k * ld + col]; return s; }

__global__ void __launch_bounds__(64) chk(Params p, int l, int which) {
    __shared__ float Ssh[64 * 65];
    unsigned char* ws = p.ws; const int gt_ = blockIdx.x * 64 + threadIdx.x; const unsigned h0 = hsh(gt_ * 2654435761u + which * 97u + 12345u), h1 = hsh(h0 + 0x9e3779b9u), h2 = hsh(h1 + 77u);
    const float* xin = (l == 0) ? p.x : (const float*)(ws + WS_XCUR);
    const bf16* Z = (const bf16*)(ws + WS_Z);
    const int id = (l * 20 + which) * 4;
    const float* win = p.w_in + (size_t)l * 1024 * D_IN;
    if (which == 1) {
        const int t = h0 % NTOK, n = h1 % D_IN; const int sc = zcol_src(n); const float scale = (n < 512 || (n >= Z_FQ && n < Z_FK)) ? QSCALE : 1.f;
        const float ref = dotx(xin + (size_t)t * DM, win, D_IN, sc, 1024) * scale;
        if (bad(bf2f(Z[(size_t)t * ZP + n]), ref, 0.03f, 0.03f)) dbg_fail(p, id);
    } else if (which == 2) {
        const int t = h0 % NTOK, pos = t & (SEQ - 1), b = t >> 13; const float* xr = xin + (size_t)t * DM;
        { const int hh = h1 % 21, i = h2 & 31; const int col = hh < 8 ? Z_AQ + hh * 64 : hh < 16 ? Z_AK + (hh - 8) * 64 : hh < 20 ? Z_IQ + (hh - 16) * 64 : Z_IK;
          const float sc = hh < 8 ? QSCALE : 1.f; const float t1 = dotx(xr, win, D_IN, zcol_src(col + i), 1024) * sc, t2 = dotx(xr, win, D_IN, zcol_src(col + i + 32), 1024) * sc;
          const float inv = powf(10000.f, -(float)i / 32.f); const float ang = (float)pos * inv; const double rev = (double)ang * 0.15915494309189535; const float fr = (float)(rev - __builtin_rint(rev));
          const float c = __builtin_amdgcn_cosf(fr), s = __builtin_amdgcn_sinf(fr);
          if (bad(bf2f(Z[(size_t)t * ZP + col + i]), t1 * c - t2 * s, 0.03f, 0.03f) || bad(bf2f(Z[(size_t)t * ZP + col + i + 32]), t2 * c + t1 * s, 0.03f, 0.03f)) dbg_fail(p, id); }
        { const int c = h2 % 1024; const float a0 = dotx(xr, win, D_IN, 5452 + c, 1024), a1 = dotx(xr, win, D_IN, 5452 + 1024 + c, 1024), a2 = dotx(xr, win, D_IN, 5452 + 2048 + c, 1024);
          const float g0 = sigmoidf_(a0), g1 = sigmoidf_(a1), g2 = sigmoidf_(a2);
          if (bad(bf2f(Z[(size_t)t * ZP + Z_GT + c]), g0 / g1, 0.05f, 0.01f) || bad(bf2f(Z[(size_t)t * ZP + Z_GT + 1024 + c]), g1 / g2, 0.05f, 0.01f) || bad(bf2f(Z[(size_t)t * ZP + Z_GT + 2048 + c]), g2, 0.05f, 0.01f)) dbg_fail(p, id + 1); }
        { const int hh = h1 & 7; const float v = dotx(xr, win, D_IN, 3396 + hh, 1024) + p.b_fox[l * 8 + hh]; const float ls = -log1pf(expf(-v)) * LOG2E;
          if (bad(((const float*)(ws + WS_LFT))[(size_t)(b * 8 + hh) * SEQ + pos], ls, 0.05f, 0.003f)) dbg_fail(p, id + 2); }
    } else if (which == 3) {
        { const int bh = h0 & 31, t = h1 % SEQ; const float* lf = (const float*)(ws + WS_LFT) + (size_t)bh * SEQ; float s = 0.f; for (int i = 0; i <= t; ++i) s += lf[i];
          if (bad(((const float*)(ws + WS_CT))[(size_t)bh * SEQ + t], s, 1e-3f, 1e-2f)) dbg_fail(p, id); }
        if (gt_ < 192) { const int b = h1 & 3, q = (gt_ < 32) ? (int)(h2 % 512) : (int)(h2 % SEQ); const int nadm = ((q >> 6) + 1) * 64; const u64* mw = (const u64*)(ws + WS_MASKW) + (size_t)(b * SEQ + q) * 128;
          int pc = 0; bool oob = false; for (int w = 0; w < 128; ++w) { const u64 m = mw[w]; pc += __popcll(m); if (w * 64 >= nadm && m) oob = true; }
          if (pc != (nadm < 256 ? nadm : 256) || oob) dbg_fail(p, id + 1);
          const bf16* qr = Z + (size_t)(b * SEQ + q) * ZP; float minsel = 3e38f, maxun = -3e38f;
          for (int s = 0; s < nadm; ++s) { const bf16* kr = Z + (size_t)(b * SEQ + s) * ZP + Z_IK; float sc = 0.f;
              for (int hd = 0; hd < 4; ++hd) { float d = 0.f; for (int k = 0; k < 64; ++k) d += bf2f(qr[Z_IQ + hd * 64 + k]) * bf2f(kr[k]); sc += bf2f(qr[Z_IW + hd]) * 0.0625f * fmaxf(d, 0.f); }
              if ((mw[s >> 6] >> (s & 63)) & 1ull) minsel = fminf(minsel, sc); else maxun = fmaxf(maxun, sc); }
          if (nadm > 256 && !(maxun <= minsel + 0.02f * fabsf(minsel) + 2e-3f)) dbg_fail(p, id + 2); }
    } else if (which == 4) {
        if (gt_ == 0 && l == 0) { const bf16* ob = (const bf16*)(ws + WS_OBUF) + 512;
            const float a0 = bf2f(ob[0]), a1 = bf2f(ob[1]), a3 = bf2f(ob[3]), b0 = bf2f(ob[8]), b1 = bf2f(ob[9]), b3 = bf2f(ob[11]), m0 = bf2f(ob[4]), m1 = bf2f(ob[12]);
            auto tr = [](float v) { return v == 0.f ? 0.f : v == 1.f ? 1.f : 2.f; };
            ((float*)(ws + WS_CTL))[CW_DBG + 2] = 10.f * (tr(a0) + 3.f * tr(b0) + 9.f * tr(a1) + 27.f * tr(b1));
            ((float*)(ws + WS_CTL))[CW_DBG + 3] = sqrtf(10.f * (tr(a3) + 3.f * tr(b3) + 9.f * (m0 == m1 ? 1.f : 0.f) + 27.f * (m0 > -1e20f ? 1.f : 0.f))); }
        const int mode = gt_ & 1, b = h0 & 3, h = (h0 >> 2) & 7, q = (gt_ < 64) ? (int)(h1 % 300) : (int)(h1 % SEQ), d = h2 & 63;
        const int QC = mode == 0 ? Z_FQ : Z_AQ, KC = mode == 0 ? Z_FK : Z_AK, VC = mode == 0 ? Z_FV : Z_AV, OC = mode == 0 ? 512 : 0;
        const bf16* qr = Z + (size_t)(b * SEQ + q) * ZP + QC + h * 64; const float* c = (const float*)(ws + WS_CT) + (size_t)(b * 8 + h) * SEQ; const u64* mw = (const u64*)(ws + WS_MASKW) + (size_t)(b * SEQ + q) * 128;
        const int ns = mode == 0 ? q + 1 : ((q >> 6) + 1) * 64; float mx = -3e38f, mx2 = -3e38f; float ref = 0.f, ref2 = 0.f;
        for (int pass = 0; pass < 2; ++pass) { float den = 0.f, num = 0.f, den2 = 0.f, num2 = 0.f;
            for (int s = 0; s < ns; ++s) { if (mode == 1 && !((mw[s >> 6] >> (s & 63)) & 1ull)) continue;
                const bf16* kr = Z + (size_t)(b * SEQ + s) * ZP + KC + h * 64; float lg = 0.f; for (int k = 0; k < 64; ++k) lg += bf2f(qr[k]) * bf2f(kr[k]);
                const float lg2 = lg; if (mode == 0) lg += c[q] - c[s];
                if (pass == 0) { mx = fmaxf(mx, lg); mx2 = fmaxf(mx2, lg2); } else { const float vv = bf2f(Z[(size_t)(b * SEQ + s) * ZP + VC + h * 64 + d]); const float pp = exp2f(lg - mx), pq = exp2f(lg2 - mx2); den += pp; num += pp * vv; den2 += pq; num2 += pq * vv; } }
            if (pass == 1) { ref = num / den; ref2 = num2 / den2; } }
        const float got = bf2f(((const bf16*)(ws + WS_OBUF))[(size_t)(b * SEQ + q) * OP + OC + h * 64 + d]);
        if (bad(got, ref, 0.04f, 0.03f)) { dbg_fail(p, id + mode);
            int m = 0; if (mode == 0 && q == 0) m |= 1; if (mode == 0 && q < 32) m |= 2; if (mode == 1 && q < 64) m |= 4; if (mode == 1 && q >= 64) m |= 8; atomicOr((int*)(p.ws + WS_CTL) + CW_DBG + 1, m); }
    } else if (which == 7) {
        const int b = blockIdx.x & 3, h = (blockIdx.x >> 2) & 7, e = threadIdx.x;
        for (int d = 0; d < 64; ++d) Ssh[d * 65 + e] = 0.f;
        const float lbv_e = 0.f; (void)lbv_e;
        for (int t = 0; t < 200; ++t) { const bf16* zr = Z + (size_t)(b * SEQ + t) * ZP + h * 64; float o = 0.f; const float ve = bf2f(zr[Z_CI + e]);
            for (int d = 0; d < 64; ++d) { const int dd = h * 64 + d; const float lb = (l == 0) ? 0.f : sigmoidf_(p.lb_logits[512 + dd] - p.lb_logits[dd]);
                const float sg = sigmoidf_(bf2f(zr[Z_CF + d])); const float f = lb + (1.f - lb) * sg, kk = (1.f - lb) * (1.f - sg);
                const float S = f * Ssh[d * 65 + e] + kk * ve; Ssh[d * 65 + e] = S; o += bf2f(zr[Z_CQ + d]) * S; }
            const float ss = wave_sum(o * o); const float ref = o * (1.f / sqrtf(ss * (1.f / 64.f) + RMS_EPS)) * p.norm_g[l * 512 + h * 64 + e] * sigmoidf_(bf2f(zr[Z_CG + e]));
            if (bad(bf2f(((const bf16*)(ws + WS_OBUF))[(size_t)(b * SEQ + t) * OP + 1024 + h * 64 + e]), ref, 0.06f, 0.05f)) { const int n = atomicAdd((int*)(p.ws + WS_CTL) + CW_DBG + 4 + (t >= 64 ? 1 : 0), 1); if (n >= 40) dbg_fail(p, id + (t >= 64 ? 1 : 0)); } }
    } else if (which == 8) {
        const int t = h0 % NTOK, c = h1 % 1024; const bf16* zr = Z + (size_t)t * ZP + Z_GT; const float g2 = bf2f(zr[2048 + c]), g1 = bf2f(zr[1024 + c]) * g2, g0 = bf2f(zr[c]) * g1;
        const bf16* ob = (const bf16*)(ws + WS_OBUF) + (size_t)t * OP; float sa = 0.f, sb = 0.f, sc = 0.f;
        for (int k = 0; k < 512; ++k) { sa += bf2f(ob[k]) * p.w_pa[((size_t)l * 512 + k) * 1024 + c]; sb += bf2f(ob[512 + k]) * p.w_pb[((size_t)l * 512 + k) * 1024 + c]; sc += bf2f(ob[1024 + k]) * p.w_pc[((size_t)l * 512 + k) * 1024 + c]; }
        if (bad(bf2f(((const bf16*)(ws + WS_MERGED))[(size_t)t * 1024 + c]), g0 * sa + g1 * sb + g2 * sc, 0.04f, 0.01f)) dbg_fail(p, id);
    } else if (which == 9) {
        const int t = h0 % NTOK, c = h1 % 1024; const bf16* mr = (const bf16*)(ws + WS_MERGED) + (size_t)t * 1024; float s = 0.f;
        for (int k = 0; k < 1024; ++k) s += bf2f(mr[k]) * p.w_out[((size_t)l * 1024 + k) * 1024 + c];
        if (bad(((const float*)(ws + WS_MIX))[(size_t)t * 1024 + c], s, 0.03f, 0.005f)) dbg_fail(p, id);
    } else if (which == 10) {
        const int t = h0 % NTOK, c = h1 % 1024; const float* xr = xin + (size_t)t * DM; const float* mr = (const float*)(ws + WS_MIX) + (size_t)t * DM; const float* x1 = (const float*)(ws + WS_X1) + (size_t)t * DM;
        float mean = 0.f; for (int k = 0; k < 1024; ++k) mean += ALPHA * xr[k] + mr[k]; mean *= (1.f / 1024.f);
        float var = 0.f; for (int k = 0; k < 1024; ++k) { const float dlt = ALPHA * xr[k] + mr[k] - mean; var += dlt * dlt; } var *= (1.f / 1024.f);
        const float ref = (ALPHA * xr[c] + mr[c] - mean) / sqrtf(var + LN_EPS) * p.ln1_g[l * 1024 + c] + p.ln1_b[l * 1024 + c];
        if (bad(x1[c], ref, 1e-3f, 1e-3f) || bad(bf2f(((const bf16*)(ws + WS_X1B))[(size_t)t * DM + c]), ref, 0.01f, 0.01f)) dbg_fail(p, id);
        float tv0 = -3e38f, tv1 = -3e38f, tv2 = -3e38f, tv3 = -3e38f; int ti0 = -1, ti1 = -1, ti2 = -1, ti3 = -1;
        for (int e = 0; e < 32; ++e) { float lg = p.b_router[l * 32 + e]; for (int k = 0; k < 1024; ++k) lg += x1[k] * p.w_router[((size_t)l * 1024 + k) * 32 + e];
            if (lg > tv0) { tv3 = tv2; ti3 = ti2; tv2 = tv1; ti2 = ti1; tv1 = tv0; ti1 = ti0; tv0 = lg; ti0 = e; } else if (lg > tv1) { tv3 = tv2; ti3 = ti2; tv2 = tv1; ti2 = ti1; tv1 = lg; ti1 = e; }
            else if (lg > tv2) { tv3 = tv2; ti3 = ti2; tv2 = lg; ti2 = e; } else if (lg > tv3) { tv3 = lg; ti3 = e; } }
        const int* tke = (const int*)(ws + WS_TKE) + t * 4; const float* tkg = (const float*)(ws + WS_TKG) + t * 4;
        const float den = 1.f + expf(tv1 - tv0) + expf(tv2 - tv0) + expf(tv3 - tv0);
        if (tv2 - tv3 > 1e-3f && tv1 - tv2 > 1e-3f && tv0 - tv1 > 1e-3f) { if (tke[0] != ti0 || tke[1] != ti1 || tke[2] != ti2 || tke[3] != ti3) dbg_fail(p, id + 1);
            if (bad(tkg[0], 1.f / den, 1e-2f, 1e-3f) || bad(tkg[3], expf(tv3 - tv0) / den, 1e-2f, 1e-3f)) dbg_fail(p, id + 2); }
    } else if (which == 11) {
        const int t = h0 % NTOK, k = h1 & 3, c = h2 % 1024; const int slot = ((const int*)(ws + WS_TOKSLOT))[t * 4 + k], e = ((const int*)(ws + WS_TKE))[t * 4 + k]; const int* blk = (const int*)(ws + WS_BLK);
        if (slot < 0 || slot >= blk[0] * 256 || blk[0] > MAXBLK) { dbg_fail(p, id); return; }
        if (blk[16 + (slot >> 8)] != e) dbg_fail(p, id + 1);
        if (((const float*)(ws + WS_GSLOT))[slot] != ((const float*)(ws + WS_TKG))[t * 4 + k]) dbg_fail(p, id + 2);
        if (((const bf16*)(ws + WS_XG))[(size_t)slot * DM + c] != ((const bf16*)(ws + WS_X1B))[(size_t)t * DM + c]) dbg_fail(p, id + 3);
    } else if (which == 12) {
        const int t = h0 % NTOK, k = h1 & 3, j = h2 % 1024; const int slot = ((const int*)(ws + WS_TOKSLOT))[t * 4 + k], e = ((const int*)(ws + WS_TKE))[t * 4 + k];
        const bf16* xr = (const bf16*)(ws + WS_XG) + (size_t)slot * DM; const float* W = p.w_gu + (size_t)(l * 32 + e) * 1024 * 2048; float g = p.b_gu[(size_t)(l * 32 + e) * 2048 + j], u = p.b_gu[(size_t)(l * 32 + e) * 2048 + 1024 + j];
        for (int kk = 0; kk < 1024; ++kk) { const float xv = bf2f(xr[kk]); g += xv * W[(size_t)kk * 2048 + j]; u += xv * W[(size_t)kk * 2048 + 1024 + j]; }
        g = fminf(g, 7.f); u = fminf(fmaxf(u, -7.f), 7.f); const float ref = g * sigmoidf_(1.702f * g) * (u + 1.f);
        if (bad(bf2f(((const bf16*)(ws + WS_ACT))[(size_t)slot * 1024 + j]), ref, 0.04f, 0.02f)) dbg_fail(p, id);
    } else if (which == 13) {
        const int t = h0 % NTOK, k = h1 & 3, n = h2 % 1024; const int slot = ((const int*)(ws + WS_TOKSLOT))[t * 4 + k], e = ((const int*)(ws + WS_TKE))[t * 4 + k];
        const bf16* ar = (const bf16*)(ws + WS_ACT) + (size_t)slot * 1024; const float* W = p.w_down + (size_t)(l * 32 + e) * 1024 * 1024; float s = p.b_down[(size_t)(l * 32 + e) * 1024 + n];
        for (int kk = 0; kk < 1024; ++kk) s += bf2f(ar[kk]) * W[(size_t)kk * 1024 + n];
        if (bad(bf2f(((const bf16*)(ws + WS_Y))[(size_t)slot * 1024 + n]), s * ((const float*)(ws + WS_GSLOT))[slot], 0.04f, 0.005f)) dbg_fail(p, id);
    } else if (which == 14) {
        const int t = h0 % NTOK, c = h1 % 1024; const float* x1 = (const float*)(ws + WS_X1) + (size_t)t * DM; const bf16* y = (const bf16*)(ws + WS_Y); const int* ts = (const int*)(ws + WS_TOKSLOT) + t * 4;
        const float* xo = ((l == DEPTH - 1) ? p.out : (float*)(ws + WS_XCUR)) + (size_t)t * DM;
        float mean = 0.f; for (int k = 0; k < 1024; ++k) { float v = ALPHA * x1[k]; for (int j = 0; j < 4; ++j) v += bf2f(y[(size_t)ts[j] * 1024 + k]); mean += v; } mean *= (1.f / 1024.f);
        float var = 0.f, vc = 0.f; for (int k = 0; k < 1024; ++k) { float v = ALPHA * x1[k]; for (int j = 0; j < 4; ++j) v += bf2f(y[(size_t)ts[j] * 1024 + k]); var += (v - mean) * (v - mean); if (k == c) vc = v; } var *= (1.f / 1024.f);
        if (bad(xo[c], (vc - mean) / sqrtf(var + LN_EPS) * p.ln2_g[l * 1024 + c] + p.ln2_b[l * 1024 + c], 2e-3f, 2e-3f)) dbg_fail(p, id);
    }
}
__global__ void dbg_init(Params p) { if (threadIdx.x == 0 && blockIdx.x == 0) { ((int*)(p.ws + WS_CTL))[CW_DBG] = 0x7fffffff; ((int*)(p.ws + WS_CTL))[CW_DBG + 1] = 0; ((int*)(p.ws + WS_CTL))[CW_DBG + 4] = 0; ((int*)(p.ws + WS_CTL))[CW_DBG + 5] = 0; } }
__global__ void dbg_fill(Params p, int n) {
    const int code = ((const int*)(p.ws + WS_CTL))[CW_DBG]; if (code == 0x7fffffff) return;
    const int sub = code & 3, lw = code >> 2, l = lw / 20, which = lw % 20; const int k = l * 16 + which + 32 * sub;
    const float c = sqrtf(exp2f((float)k));
    const int msk = ((const int*)(p.ws + WS_CTL))[CW_DBG + 1];
    for (int i = blockIdx.x * blockDim.x + threadIdx.x; i < n; i += gridDim.x * blockDim.x) p.out[i] = (i == 0) ? 16.f * (float)(1 + msk) : c;
}
#endif

extern "C" void kernel_launch(void* const* d_in, const int* in_sizes, int n_in, void* d_out, int out_size, void* d_ws, size_t ws_size, hipStream_t stream) {
    static int grid = 0;
    if (grid == 0) {
        if (n_in != 19 || ws_size < WS_END) { fprintf(stderr, "kernel_launch: need 19 inputs and >= %zu bytes of workspace; got %d, %zu\n", (size_t)WS_END, n_in, ws_size); grid = -1; return; }
        int dev = 0, cus = 0, per_cu = 0;
        if (hipGetDevice(&dev) != hipSuccess || hipDeviceGetAttribute(&cus, hipDeviceAttributeMultiprocessorCount, dev) != hipSuccess) { grid = -1; return; }
        if (hipFuncSetAttribute((const void*)fwd, hipFuncAttributeMaxDynamicSharedMemorySize, LDS_BYTES) != hipSuccess) { fprintf(stderr, "kernel_launch: hipFuncSetAttribute failed\n"); grid = -1; return; }
        if (hipOccupancyMaxActiveBlocksPerMultiprocessor(&per_cu, (const void*)fwd, NTHR, LDS_BYTES) != hipSuccess || per_cu < 1) fprintf(stderr, "kernel_launch: occupancy query reports %d\n", per_cu);
        (void)hipGetLastError();
        grid = cus;
    }
    if (grid < 0) return;
    (void)hipMemsetAsync((char*)d_ws + WS_CTL, 0, CTL_ZERO_BYTES, stream);
    Params p{};
    const float** f = (const float**)&p;
    for (int i = 0; i < 19; ++i) f[i] = (const float*)d_in[i];
    p.out = (float*)d_out; p.ws = (unsigned char*)d_ws;
#if ONE_LAUNCH
    p.ph_lo = 0; p.ph_hi = NPHASES; p.use_bar = 1; p.pad = 0;
    hipLaunchKernelGGL(fwd, dim3(grid), dim3(NTHR), LDS_BYTES, stream, p);
#else
#if DBG
    hipLaunchKernelGGL(dbg_init, dim3(1), dim3(64), 0, stream, p);
#endif
    for (int ph = 0; ph < NPHASES; ++ph) { p.ph_lo = ph; p.ph_hi = ph + 1; p.use_bar = 0; p.pad = 0;
        hipLaunchKernelGGL(fwd, dim3(grid), dim3(NTHR), LDS_BYTES, stream, p);
#if DBG
        if (ph >= 1) { const int l = (ph - 1) / NPH_LAYER, k = (ph - 1) % NPH_LAYER; static const int wmap[NPH_LAYER] = {1, 2, 3, 4, 0, 0, 7, 8, 9, 10, 11, 12, 13, 14}; const int w = wmap[k];
            if (w) { const int nb = (w == 7) ? 32 : (w == 3) ? 4 : (w == 4) ? 2 : 16; hipLaunchKernelGGL(chk, dim3(nb), dim3(64), 0, stream, p, l, w); } }
#endif
    }
#if DBG
    hipLaunchKernelGGL(dbg_fill, dim3(1024), dim3(256), 0, stream, p, out_size);
#endif
#endif
}
```

```cpp
#include <hip/hip_runtime.h>
#include <cstdio>
#include <cstdint>

#define GAS __attribute__((address_space(1)))
#define LAS __attribute__((address_space(3)))
typedef unsigned short bf16;
typedef short bf16x8 __attribute__((ext_vector_type(8)));
typedef short s16x4 __attribute__((ext_vector_type(4)));
typedef float f32x2 __attribute__((ext_vector_type(2)));
typedef float f32x4 __attribute__((ext_vector_type(4)));
typedef float f32x16 __attribute__((ext_vector_type(16)));
typedef unsigned u32x2 __attribute__((ext_vector_type(2)));
typedef unsigned u32x4 __attribute__((ext_vector_type(4)));
typedef unsigned long long u64;

__device__ __forceinline__ unsigned f2bf(float f) { unsigned u = __builtin_bit_cast(unsigned, f); return (u + 0x7fffu + ((u >> 16) & 1u)) >> 16; }
__device__ __forceinline__ unsigned pk2(float lo, float hi) { return f2bf(lo) | (f2bf(hi) << 16); }
__device__ __forceinline__ float bf2f(unsigned b) { return __builtin_bit_cast(float, b << 16); }
__device__ __forceinline__ float bflo(unsigned w) { return __builtin_bit_cast(float, w << 16); }
__device__ __forceinline__ float bfhi(unsigned w) { return __builtin_bit_cast(float, w & 0xffff0000u); }
__device__ __forceinline__ float sigmoidf_(float x) { return __builtin_amdgcn_rcpf(1.0f + __expf(-x)); }

namespace pg8 {
#define PG8_LAS __attribute__((address_space(3)))
typedef unsigned short bf16_t;
typedef short bf16x8 __attribute__((ext_vector_type(8)));
typedef float f32x4 __attribute__((ext_vector_type(4)));
typedef unsigned u32x4 __attribute__((ext_vector_type(4)));
constexpr int BM = 256, BK = 64, HALF = 128, HTB = HALF * BK * 2  , STAGE_BYTES = 8 * HTB, NXCD = 8, WGM = 8;

__host__ __device__ __forceinline__ int lds_byte(int r, int c) { const int st = (r >> 4) * 2 + (c >> 5), rr = r & 15, cc = c & 31, ob = rr * 64 + cc * 2; return st * 1024 + (ob ^ (((ob >> 9) & 1) << 5)); }
__host__ __device__ __forceinline__ void stage_rc(int b, int& R, int& C) { const int st = b / 1024, sb = b % 1024, swz = sb ^ (((sb >> 9) & 1) << 5); R = (st >> 1) * 16 + swz / 64; C = (st & 1) * 32 + (swz % 64) / 2; }
__host__ __device__ __forceinline__ int perm32(int rho) { const int n = rho >> 4, i = rho & 15; return 8 * (i >> 2) + 4 * n + (i & 3); }

struct Unit { int pm, pn; };
struct Gemm { const bf16_t* A; const bf16_t* Bt; int M, N, K; };

struct StaticOrder {
    static constexpr bool GATHER = false; const int* tok = nullptr;
    int nM, nN, nwg, G, c;
    __host__ __device__ void init(int M, int N, int G_, int c_) { nM = M / BM; nN = N / BM; nwg = nM * nN; G = G_; c = c_; }
    __host__ __device__ bool next(int i, Unit& u) const {
        const long L = (long)i * G + c; if (L >= nwg) return false;
        int wgid = (int)L; { const int q = nwg / NXCD, r = nwg % NXCD, xcd = wgid % NXCD, off = wgid / NXCD; wgid = (xcd < r ? xcd * (q + 1) : r * (q + 1) + (xcd - r) * q) + off; }
        const int nig = WGM * nN, gid = wgid / nig, fm = gid * WGM, gsz = (nM - fm) < WGM ? (nM - fm) : WGM;
        u.pm = fm + ((wgid % nig) % gsz); u.pn = (wgid % nig) / gsz; return true;
    }
    __device__ __forceinline__ void a_ready(const Unit&) const {}
    __device__ __forceinline__ void done(const Unit&) const {}
};
template <bool GATHER_> struct MoeOrderT {
    static constexpr bool GATHER = GATHER_;
    const PG8_LAS int* list; const int* tok;
    __device__ bool next(int i, Unit& u) const {
        if (i >= __builtin_amdgcn_readfirstlane(list[0])) return false;
        u.pm = __builtin_amdgcn_readfirstlane(list[2 + 2 * i]); u.pn = __builtin_amdgcn_readfirstlane(list[3 + 2 * i]); return true;
    }
    __device__ __forceinline__ void a_ready(const Unit&) const {}
    __device__ __forceinline__ void done(const Unit&) const {}
};
typedef MoeOrderT<false> MoeOrder; typedef MoeOrderT<true> MoeOrderG;
__device__ __forceinline__ void moe_build_list(PG8_LAS int* list, const int* blk, int nN, int G, int c, int tid) {
    if (tid == 0) { const int* bst = blk + 16 + 544 + 16; int n = 0;
        if (G % 8 == 0) { const int W = G / 8, j = c / 8, x = c % 8;
            for (int i = 0; i < 64; ++i) { const int uu = i * W + j; const int bi = uu / nN, pl = uu - bi * nN; int rem = bi; bool ok = false;
                for (int k = 0; k < 4 && !ok; ++k) { const int e = x + 8 * k; const int b0 = bst[e], b1 = bst[e + 1]; if (rem < b1 - b0) { list[2 + 2 * n] = b0 + rem; list[3 + 2 * n] = e * nN + pl; ++n; ok = true; } else rem -= b1 - b0; }
                if (!ok) break; }
        } else { const int nb = bst[32];
            for (int i = 0; i < 64; ++i) { const int uu = i * G + c; const int bi = uu / nN, pl = uu - bi * nN; if (bi >= nb) break; int e = 0; for (int k = 1; k < 32; ++k) if (bi >= bst[k]) e = k; list[2 + 2 * n] = bi; list[3 + 2 * n] = e * nN + pl; ++n; } }
        list[0] = n; }
    asm volatile("s_waitcnt lgkmcnt(0)\n\ts_barrier" ::: "memory");
}

__device__ __forceinline__ unsigned cvt_pk_bf16(float lo, float hi) { unsigned r; asm volatile("v_cvt_pk_bf16_f32 %0, %1, %2" : "=v"(r) : "v"(lo), "v"(hi)); return r; }

struct EpiZ {
    static constexpr bool PERM = true, AFTER_DRAIN = false, MIDK = false;
    bf16_t* O; int ldc; const float* trig; bf16_t* IKC;
    __device__ __forceinline__ void operator()(const f32x4 (&acc)[2][2][4][2], const Unit& u, int wr, int wc, int fr, int fq) const {
        asm volatile("" : "+v"(fr), "+v"(fq));
        const int row0 = u.pm * BM + wr * 64 + fr; const int col0 = u.pn * BM + wc * 32 + 8 * fq;
        const bool rot_all = (u.pn < 4) || (u.pn == 32); const bool rot_b0 = rot_all || (u.pn == 33 && wc < 2);
        const int i0 = (wc & 1) * 16 + 4 * fq;
#pragma unroll
        for (int ai = 0; ai < 2; ++ai)
#pragma unroll
            for (int m = 0; m < 4; ++m) { const int row = row0 + ai * HALF + m * 16; bf16_t* rowp = O + (size_t)row * ldc + col0;
                f32x4 ca = {1.f, 0.f, 1.f, 0.f}, cb = {1.f, 0.f, 1.f, 0.f};
                if (rot_b0) { const float* tp = trig + ((size_t)(row & 8191) * 32 + i0) * 2; ca = *(const f32x4*)tp; cb = *(const f32x4*)(tp + 4); }
#pragma unroll
                for (int bj = 0; bj < 2; ++bj) { f32x4 v0 = acc[ai][bj][m][0], v1 = acc[ai][bj][m][1];
                    if (bj == 0 ? rot_b0 : rot_all) {
                        const f32x4 r0 = {v0[0] * ca[0] - v0[1] * ca[1], v0[1] * ca[0] + v0[0] * ca[1], v0[2] * ca[2] - v0[3] * ca[3], v0[3] * ca[2] + v0[2] * ca[3]};
                        const f32x4 r1 = {v1[0] * cb[0] - v1[1] * cb[1], v1[1] * cb[0] + v1[0] * cb[1], v1[2] * cb[2] - v1[3] * cb[3], v1[3] * cb[2] + v1[2] * cb[3]};
                        v0 = r0; v1 = r1; }
                    u32x4 w; w.x = cvt_pk_bf16(v0[0], v0[1]); w.y = cvt_pk_bf16(v0[2], v0[3]); w.z = cvt_pk_bf16(v1[0], v1[1]); w.w = cvt_pk_bf16(v1[2], v1[3]);
                    *(u32x4*)(rowp + bj * HALF) = w;
                    if (bj == 0 && u.pn == 33 && wc < 2) *(u32x4*)(IKC + (size_t)row * 64 + wc * 32 + 8 * fq) = w; } }
    }
};
struct EpiF32 {
    static constexpr bool PERM = true, AFTER_DRAIN = false, MIDK = false;
    float* O; int ldc;
    __device__ __forceinline__ void operator()(const f32x4 (&acc)[2][2][4][2], const Unit& u, int wr, int wc, int fr, int fq) const {
        asm volatile("" : "+v"(fr), "+v"(fq));
        const int row0 = u.pm * BM + wr * 64 + fr; const int col0 = u.pn * BM + wc * 32 + 8 * fq;
#pragma unroll
        for (int ai = 0; ai < 2; ++ai)
#pragma unroll
            for (int m = 0; m < 4; ++m) { float* rowp = O + (size_t)(row0 + ai * HALF + m * 16) * ldc + col0;
#pragma unroll
                for (int bj = 0; bj < 2; ++bj) { *(f32x4*)(rowp + bj * HALF) = acc[ai][bj][m][0]; *(f32x4*)(rowp + bj * HALF + 4) = acc[ai][bj][m][1]; } }
    }
};
struct EpiBf16 {
    static constexpr bool PERM = true, AFTER_DRAIN = false, MIDK = false;
    bf16_t* O; int ldc;
    __device__ __forceinline__ void operator()(const f32x4 (&acc)[2][2][4][2], const Unit& u, int wr, int wc, int fr, int fq) const {
        asm volatile("" : "+v"(fr), "+v"(fq));
        const int row0 = u.pm * BM + wr * 64 + fr; const int col0 = u.pn * BM + wc * 32 + 8 * fq;
#pragma unroll
        for (int ai = 0; ai < 2; ++ai)
#pragma unroll
            for (int m = 0; m < 4; ++m) { bf16_t* rowp = O + (size_t)(row0 + ai * HALF + m * 16) * ldc + col0;
#pragma unroll
                for (int bj = 0; bj < 2; ++bj) { const f32x4 v0 = acc[ai][bj][m][0], v1 = acc[ai][bj][m][1];
                    u32x4 w; w.x = cvt_pk_bf16(v0[0], v0[1]); w.y = cvt_pk_bf16(v0[2], v0[3]); w.z = cvt_pk_bf16(v1[0], v1[1]); w.w = cvt_pk_bf16(v1[2], v1[3]);
                    *(u32x4*)(rowp + bj * HALF) = w; } }
    }
};
struct EpiMerge {
    static constexpr bool PERM = true, AFTER_DRAIN = false, MIDK = true;
    const bf16_t* Gz; int gp; bf16_t* O; int ldc;
    __device__ __forceinline__ void scale(f32x4 (&acc)[2][2][4][2], const Unit& u, int idx, int wr, int wc, int fr, int fq) const {
        asm volatile("" : "+v"(fr), "+v"(fq));
        const int row0 = u.pm * BM + wr * 64 + fr; const int col0 = u.pn * BM + wc * 32 + 8 * fq;
        const int pa = (idx == 2) ? 2048 : (idx == 1) ? 2048 : 1024, pb = (idx == 1) ? 1024 : 0;
        u32x4 wa[2], wb[2], na[2], nb[2];
#define MG_LOAD(IT, WA, WB) do { const bf16_t* rowp_ = Gz + (size_t)(row0 + ((IT) >> 2) * HALF + ((IT) & 3) * 16) * gp + col0; \
            _Pragma("unroll") for (int bj = 0; bj < 2; ++bj) { WA[bj] = *(const u32x4*)(rowp_ + pa + bj * HALF); if (idx != 2) WB[bj] = *(const u32x4*)(rowp_ + pb + bj * HALF); else WB[bj] = WA[bj]; } } while (0)
        MG_LOAD(0, wa, wb);
#pragma unroll
        for (int it = 0; it < 8; ++it) { const int ai = it >> 2, m = it & 3;
            if (it + 1 < 8) MG_LOAD(it + 1, na, nb);
            asm volatile("" ::: "memory");
#pragma unroll
            for (int bj = 0; bj < 2; ++bj) { float s[8];
#pragma unroll
                for (int i = 0; i < 4; ++i) { const float ea0 = __expf(-bflo(wa[bj][i])), ea1 = __expf(-bfhi(wa[bj][i]));
                    if (idx == 2) { s[2 * i] = __builtin_amdgcn_rcpf(1.f + ea0); s[2 * i + 1] = __builtin_amdgcn_rcpf(1.f + ea1); }
                    else { const float eb0 = __expf(-bflo(wb[bj][i])), eb1 = __expf(-bfhi(wb[bj][i])); s[2 * i] = (1.f + ea0) * __builtin_amdgcn_rcpf(1.f + eb0); s[2 * i + 1] = (1.f + ea1) * __builtin_amdgcn_rcpf(1.f + eb1); } }
                acc[ai][bj][m][0] = acc[ai][bj][m][0] * (f32x4){s[0], s[1], s[2], s[3]}; acc[ai][bj][m][1] = acc[ai][bj][m][1] * (f32x4){s[4], s[5], s[6], s[7]}; }
#pragma unroll
            for (int bj = 0; bj < 2; ++bj) { wa[bj] = na[bj]; wb[bj] = nb[bj]; } }
#undef MG_LOAD
    }
    __device__ __forceinline__ void mid(f32x4 (&acc)[2][2][4][2], const Unit& u, int idx, int wr, int wc, int fr, int fq) const { scale(acc, u, idx, wr, wc, fr, fq); }
    __device__ __forceinline__ void operator()(f32x4 (&acc)[2][2][4][2], const Unit& u, int wr, int wc, int fr, int fq) const {
        scale(acc, u, 2, wr, wc, fr, fq);
        asm volatile("" : "+v"(fr), "+v"(fq));
        const int row0 = u.pm * BM + wr * 64 + fr; const int col0 = u.pn * BM + wc * 32 + 8 * fq;
#pragma unroll
        for (int ai = 0; ai < 2; ++ai)
#pragma unroll
            for (int m = 0; m < 4; ++m) { bf16_t* rowp = O + (size_t)(row0 + ai * HALF + m * 16) * ldc + col0;
#pragma unroll
                for (int bj = 0; bj < 2; ++bj) { const f32x4 v0 = acc[ai][bj][m][0], v1 = acc[ai][bj][m][1];
                    u32x4 w; w.x = cvt_pk_bf16(v0[0], v0[1]); w.y = cvt_pk_bf16(v0[2], v0[3]); w.z = cvt_pk_bf16(v1[0], v1[1]); w.w = cvt_pk_bf16(v1[2], v1[3]);
                    *(u32x4*)(rowp + bj * HALF) = w; } }
    }
};
struct EpiSwiGLU {
    static constexpr bool PERM = true, AFTER_DRAIN = false, MIDK = false;
    bf16_t* O; const float* bias; int nN;
    __device__ __forceinline__ void operator()(const f32x4 (&acc)[2][2][4][2], const Unit& u, int wr, int wc, int fr, int fq) const {
        const int e = u.pn / nN, pl = u.pn - e * nN;
        asm volatile("" : "+v"(fr), "+v"(fq));
        const int row0 = u.pm * BM + wr * 64 + fr; const int colt = pl * BM + wc * 32 + 8 * fq;
        const float* bp = bias + (size_t)e * 2048 + colt;
        f32x4 bv[2][2];
#pragma unroll
        for (int bj = 0; bj < 2; ++bj) { bv[bj][0] = *(const f32x4*)(bp + bj * HALF); bv[bj][1] = *(const f32x4*)(bp + bj * HALF + 4); }
#pragma unroll
        for (int ai = 0; ai < 2; ++ai)
#pragma unroll
            for (int m = 0; m < 4; ++m) { unsigned char* rowp = (unsigned char*)O + (size_t)(row0 + ai * HALF + m * 16) * 1024 + (colt >> 1);
#pragma unroll
                for (int bj = 0; bj < 2; ++bj) { const f32x4 v0 = acc[ai][bj][m][0] + bv[bj][0], v1 = acc[ai][bj][m][1] + bv[bj][1];
                    float a[4];
                    const float gt[4] = {v0[0], v0[2], v1[0], v1[2]}, up[4] = {v0[1], v0[3], v1[1], v1[3]};
#pragma unroll
                    for (int i = 0; i < 4; ++i) { const float g = fminf(gt[i], 7.0f); const float uu = fminf(fmaxf(up[i], -7.0f), 7.0f);
                        a[i] = g * __builtin_amdgcn_rcpf(1.0f + __expf(-1.702f * g)) * (uu + 1.0f); }
                    int w8 = __builtin_amdgcn_cvt_pk_fp8_f32(a[0], a[1], 0, false); w8 = __builtin_amdgcn_cvt_pk_fp8_f32(a[2], a[3], w8, true);
                    *(unsigned*)(rowp + bj * (HALF / 2)) = (unsigned)w8; } }
    }
};
struct EpiDown {
    static constexpr bool PERM = true, AFTER_DRAIN = false, MIDK = false;
    bf16_t* O; const float* bias; const float* gate; int nN;
    __device__ __forceinline__ void operator()(const f32x4 (&acc)[2][2][4][2], const Unit& u, int wr, int wc, int fr, int fq) const {
        const int e = u.pn / nN, pl = u.pn - e * nN;
        asm volatile("" : "+v"(fr), "+v"(fq));
        const int row0 = u.pm * BM + wr * 64 + fr; const int colt = pl * BM + wc * 32 + 8 * fq;
        const float* bp = bias + (size_t)e * 1024 + colt;
        f32x4 bv[2][2];
#pragma unroll
        for (int bj = 0; bj < 2; ++bj) { bv[bj][0] = *(const f32x4*)(bp + bj * HALF); bv[bj][1] = *(const f32x4*)(bp + bj * HALF + 4); }
#pragma unroll
        for (int ai = 0; ai < 2; ++ai)
#pragma unroll
            for (int m = 0; m < 4; ++m) { const int row = row0 + ai * HALF + m * 16; const float gs = gate[row]; bf16_t* rowp = O + (size_t)row * 1024 + colt;
#pragma unroll
                for (int bj = 0; bj < 2; ++bj) { const f32x4 v0 = (acc[ai][bj][m][0] + bv[bj][0]) * gs, v1 = (acc[ai][bj][m][1] + bv[bj][1]) * gs;
                    u32x4 w; w.x = cvt_pk_bf16(v0[0], v0[1]); w.y = cvt_pk_bf16(v0[2], v0[3]); w.z = cvt_pk_bf16(v1[0], v1[1]); w.w = cvt_pk_bf16(v1[2], v1[3]);
                    *(u32x4*)(rowp + bj * HALF) = w; } }
    }
};

template <class Epi, class Sched, bool ALIGN_EPI = false, bool SP2 = false, bool FP8 = false, int SCALE_B = 127>
__device__ __forceinline__ void gemm_phase(PG8_LAS unsigned char* lds, const Gemm g, const Sched& S, const Epi& E, int wv) {
    int tid_l = (int)__builtin_amdgcn_mbcnt_hi(~0u, __builtin_amdgcn_mbcnt_lo(~0u, 0u)); asm volatile("" : "+v"(tid_l)); tid_l += wv * 64;
    const int tid = tid_l, wid = __builtin_amdgcn_readfirstlane(tid >> 6), lane = tid & 63, wr = wid >> 2, wc = wid & 3, fr = lane & 15, fq = lane >> 4;
    const int K = g.K; const int KB = FP8 ? K : 2 * K;
    const int nt = KB / (2 * BK);
    unsigned voffA[2], voffB[2];
#pragma unroll
    for (int i = 0; i < 2; ++i) { int R, C; stage_rc(tid * 16 + i * 8192, R, C); const int Rb = Epi::PERM ? ((R & ~31) + perm32(R & 31)) : R;
        voffA[i] = (unsigned)(R * KB + 2 * C); voffB[i] = (unsigned)(Rb * KB + 2 * C); }
    unsigned voGc[2][2]; PG8_LAS unsigned* voGn_l = (PG8_LAS unsigned*)(lds + STAGE_BYTES + 1024) + tid;
#define PG8_GOFF(dst, pmv) do { if constexpr (Sched::GATHER) { _Pragma("unroll") for (int _h = 0; _h < 2; ++_h) _Pragma("unroll") for (int _i = 0; _i < 2; ++_i) { \
        const unsigned _R = voffA[_i] / (unsigned)KB, _cb = voffA[_i] % (unsigned)KB; dst[_h][_i] = (unsigned)S.tok[(pmv) * BM + _h * HALF + (int)_R] * (unsigned)KB + _cb; } } } while (0)
    const size_t kstep = (size_t)(BK * 2);
    const size_t hstep = (size_t)HALF * KB;
    const size_t tstep = 2 * hstep;
    const unsigned ldsw = (unsigned)wid * 1024u;
    const int aoff = lds_byte(wr * 64 + fr, FP8 ? fq * 16 : fq * 8), boff = lds_byte(wc * 32 + fr, FP8 ? fq * 16 : fq * 8);
    const int aoff1 = FP8 ? lds_byte(wr * 64 + fr, fq * 16 + 8) - aoff : 1024, boff1 = FP8 ? lds_byte(wc * 32 + fr, fq * 16 + 8) - boff : 1024;
#define PG8_SA(b, h) (((b) * 2 + (h)) * HTB)
#define PG8_SB(b, h) ((4 + (b) * 2 + (h)) * HTB)
#define PG8_STAGE(bufoff, gbase, voff) do { _Pragma("unroll") for (int _i = 0; _i < 2; ++_i) \
        __builtin_amdgcn_global_load_lds((const unsigned*)((const char*)(gbase) + (voff)[_i]), (PG8_LAS unsigned*)(lds + (bufoff) + ldsw + _i * 8192), 16, 0, 0); } while (0)
#define PG8_STAGE_A(bufoff, base, h, nx) do { if constexpr (Sched::GATHER) { unsigned _vo[2] = {voGc[h][0], voGc[h][1]}; if (nx) { _vo[0] = voGn_l[((h) * 2 + 0) * 512]; _vo[1] = voGn_l[((h) * 2 + 1) * 512]; } PG8_STAGE(bufoff, base, _vo); } else { PG8_STAGE(bufoff, (base) + (h) * hstep, voffA); } } while (0)
#define PG8_LD8(dst8, n_, base_, off_, off1_) do { _Pragma("unroll") for (int q_ = 0; q_ < n_; ++q_) { const v4i_ lo_ = *(const PG8_LAS v4i_*)(lds + (base_) + (off_) + q_ * 2048), hi_ = *(const PG8_LAS v4i_*)(lds + (base_) + (off_) + q_ * 2048 + (off1_)); \
        dst8[q_] = __builtin_shufflevector(lo_, hi_, 0, 1, 2, 3, 4, 5, 6, 7); } } while (0)
#define PG8_LDA(dst, b, h) do { if constexpr (FP8) { PG8_LD8(dst##8, 4, PG8_SA(b, h), aoff, aoff1); } else { _Pragma("unroll") for (int m = 0; m < 4; ++m) _Pragma("unroll") for (int k = 0; k < 2; ++k) dst[m][k] = *(const PG8_LAS bf16x8*)(lds + PG8_SA(b, h) + aoff + m * 2048 + k * aoff1); } } while (0)
#define PG8_LDB(dst, b, h) do { if constexpr (FP8) { PG8_LD8(dst##8, 2, PG8_SB(b, h), boff, boff1); } else { _Pragma("unroll") for (int n = 0; n < 2; ++n) _Pragma("unroll") for (int k = 0; k < 2; ++k) dst[n][k] = *(const PG8_LAS bf16x8*)(lds + PG8_SB(b, h) + boff + n * 2048 + k * boff1); } } while (0)
#define PG8_MMA(ai, bj, At, Bt) do { if constexpr (FP8) __builtin_amdgcn_sched_barrier(0); __builtin_amdgcn_s_setprio(1); _Pragma("unroll") for (int m = 0; m < 4; ++m) _Pragma("unroll") for (int n = 0; n < 2; ++n) { \
        if constexpr (FP8) { asm volatile("v_mfma_scale_f32_16x16x128_f8f6f4 %0, %1, %2, %0, %3, %4 op_sel_hi:[0,0,0]" : "+v"(acc[ai][bj][m][n]) : "v"(Bt##8[n]), "v"(At##8[m]), "v"(sclB), "v"(sclA)); } \
        else { _Pragma("unroll") for (int k = 0; k < 2; ++k) acc[ai][bj][m][n] = __builtin_amdgcn_mfma_f32_16x16x32_bf16(Bt[n][k], At[m][k], acc[ai][bj][m][n], 0, 0, 0); } } \
        __builtin_amdgcn_s_setprio(0); if constexpr (FP8) __builtin_amdgcn_sched_barrier(0); } while (0)
#define PG8_WAIT_V(n) asm volatile("s_waitcnt vmcnt(" #n ")" ::: "memory")
#define PG8_WAIT_L(n) asm volatile("s_waitcnt lgkmcnt(" #n ")" ::: "memory")
#define PG8_BAR __builtin_amdgcn_s_barrier()
#define PG8_SCHED __builtin_amdgcn_sched_barrier(0)
    Unit cur, nxt; int ui = 0;
    if (!S.next(0, cur)) return;
    f32x4 acc[2][2][4][2];
#pragma unroll
    for (int a = 0; a < 2; ++a)
#pragma unroll
        for (int b = 0; b < 2; ++b)
#pragma unroll
            for (int m = 0; m < 4; ++m)
#pragma unroll
                for (int n = 0; n < 2; ++n) acc[a][b][m][n] = (f32x4){0.f, 0.f, 0.f, 0.f};
    bf16x8 At[4][2], B0[2][2], B1[2][2];
    typedef int v8i_ __attribute__((ext_vector_type(8))); typedef int v4i_ __attribute__((ext_vector_type(4)));
    int sclB = SCALE_B * 0x01010101, sclA = 0x7f7f7f7f; asm volatile("" : "+v"(sclB), "+v"(sclA));
    v8i_ At8[4], B08[2], B18[2];
    const char* cA = (const char*)g.A + (Sched::GATHER ? (size_t)0 : (size_t)cur.pm * tstep); const char* cB = (const char*)g.Bt + (size_t)cur.pn * tstep;
    PG8_GOFF(voGc, cur.pm);
    S.a_ready(cur);
    if constexpr (SP2) {
        PG8_STAGE(PG8_SB(0, 0), cB, voffB); PG8_STAGE(PG8_SB(0, 1), cB + hstep, voffB); PG8_STAGE_A(PG8_SA(0, 0), cA, 0, false); PG8_STAGE_A(PG8_SA(0, 1), cA, 1, false);
        if (wr == 1) PG8_BAR;
        PG8_WAIT_V(2); PG8_BAR;
        PG8_STAGE(PG8_SB(1, 0), cB + kstep, voffB); PG8_STAGE_A(PG8_SA(1, 0), cA + kstep, 0, false); PG8_STAGE(PG8_SB(1, 1), cB + hstep + kstep, voffB);
        PG8_WAIT_V(6); PG8_BAR;
    } else {
        PG8_STAGE(PG8_SB(0, 0), cB, voffB); PG8_STAGE_A(PG8_SA(0, 0), cA, 0, false); PG8_STAGE(PG8_SB(0, 1), cB + hstep, voffB); PG8_STAGE_A(PG8_SA(0, 1), cA, 1, false);
        if (wr == 1) PG8_BAR;
        PG8_WAIT_V(4); PG8_BAR;
        PG8_STAGE(PG8_SB(1, 0), cB + kstep, voffB); PG8_STAGE_A(PG8_SA(1, 0), cA + kstep, 0, false); PG8_STAGE(PG8_SB(1, 1), cB + hstep + kstep, voffB);
        PG8_WAIT_V(6); PG8_BAR;
    }
    for (;;) {
        const bool has_next = S.next(ui + 1, nxt);
        const char* nA = has_next ? (const char*)g.A + (Sched::GATHER ? (size_t)0 : (size_t)nxt.pm * tstep) : cA;
        if constexpr (Sched::GATHER) { unsigned _vn[2][2]; if (has_next) { PG8_GOFF(_vn, nxt.pm); } else { _Pragma("unroll") for (int _h = 0; _h < 2; ++_h) _Pragma("unroll") for (int _i = 0; _i < 2; ++_i) _vn[_h][_i] = voGc[_h][_i]; }
            _Pragma("unroll") for (int _h = 0; _h < 2; ++_h) _Pragma("unroll") for (int _i = 0; _i < 2; ++_i) voGn_l[(_h * 2 + _i) * 512] = _vn[_h][_i]; } const char* nB = has_next ? (const char*)g.Bt + (size_t)nxt.pn * tstep : cB;
        for (int t = 0; t < nt; t += 2) {
            const bool last = (t == nt - 2);
            const char* a1 = cA + (size_t)(t + 1) * kstep;
            const char* a2 = last ? nA : cA + (size_t)(t + 2) * kstep; const char* b2 = last ? nB : cB + (size_t)(t + 2) * kstep;
            const char* a3 = a2 + kstep; const char* b3 = b2 + kstep;
            if (last && has_next) S.a_ready(nxt);
            if constexpr (SP2) {
            PG8_LDB(B0, 0, 0); PG8_LDB(B1, 0, 1); PG8_SCHED; PG8_LDA(At, 0, 0); PG8_STAGE_A(PG8_SA(1, 1), a1, 1, false);
            PG8_WAIT_V(8); PG8_WAIT_L(0); PG8_BAR; PG8_MMA(0, 0, At, B0); PG8_MMA(0, 1, At, B1); PG8_BAR; PG8_SCHED;
            PG8_LDA(At, 0, 1); PG8_STAGE(PG8_SB(0, 0), b2, voffB); PG8_STAGE(PG8_SB(0, 1), b2 + hstep, voffB); PG8_STAGE_A(PG8_SA(0, 0), a2, 0, last);
            PG8_WAIT_V(8); PG8_WAIT_L(0); PG8_BAR; PG8_MMA(1, 0, At, B0); PG8_MMA(1, 1, At, B1); PG8_BAR; PG8_SCHED;
            PG8_LDB(B0, 1, 0); PG8_LDB(B1, 1, 1); PG8_SCHED; PG8_LDA(At, 1, 0); PG8_STAGE_A(PG8_SA(0, 1), a2, 1, last);
            PG8_WAIT_V(8); PG8_WAIT_L(0); PG8_BAR; PG8_MMA(0, 0, At, B0); PG8_MMA(0, 1, At, B1); PG8_BAR; PG8_SCHED;
            PG8_LDA(At, 1, 1); PG8_STAGE(PG8_SB(1, 0), b3, voffB); PG8_STAGE(PG8_SB(1, 1), b3 + hstep, voffB); PG8_STAGE_A(PG8_SA(1, 0), a3, 0, last);
            PG8_WAIT_V(8); PG8_WAIT_L(0); PG8_BAR; PG8_MMA(1, 0, At, B0); PG8_MMA(1, 1, At, B1); PG8_BAR; PG8_SCHED;
            } else {
            PG8_LDB(B0, 0, 0); PG8_SCHED; PG8_LDA(At, 0, 0); PG8_STAGE_A(PG8_SA(1, 1), a1, 1, false);
            PG8_WAIT_L(8); PG8_BAR; PG8_WAIT_L(0); PG8_MMA(0, 0, At, B0); PG8_BAR; PG8_SCHED;
            PG8_LDB(B1, 0, 1); PG8_STAGE(PG8_SB(0, 0), b2, voffB);
            PG8_BAR; PG8_WAIT_L(0); PG8_MMA(0, 1, At, B1); PG8_BAR;
            PG8_LDA(At, 0, 1); PG8_STAGE_A(PG8_SA(0, 0), a2, 0, last);
            PG8_BAR; PG8_WAIT_L(0); PG8_MMA(1, 0, At, B0); PG8_BAR; PG8_SCHED;
            PG8_STAGE(PG8_SB(0, 1), b2 + hstep, voffB);
            PG8_WAIT_V(6); PG8_BAR; PG8_MMA(1, 1, At, B1); PG8_BAR;
            PG8_LDB(B0, 1, 0); PG8_SCHED; PG8_LDA(At, 1, 0); PG8_STAGE_A(PG8_SA(0, 1), a2, 1, last);
            PG8_WAIT_L(8); PG8_BAR; PG8_WAIT_L(0); PG8_MMA(0, 0, At, B0); PG8_BAR; PG8_SCHED;
            PG8_LDB(B1, 1, 1); PG8_STAGE(PG8_SB(1, 0), b3, voffB);
            PG8_BAR; PG8_WAIT_L(0); PG8_MMA(0, 1, At, B1); PG8_BAR;
            PG8_LDA(At, 1, 1); PG8_STAGE_A(PG8_SA(1, 0), a3, 0, last);
            PG8_BAR; PG8_WAIT_L(0); PG8_MMA(1, 0, At, B0); PG8_BAR; PG8_SCHED;
            PG8_STAGE(PG8_SB(1, 1), b3 + hstep, voffB);
            PG8_WAIT_V(6); PG8_BAR; PG8_MMA(1, 1, At, B1); PG8_BAR;
            }
            if constexpr (Epi::MIDK) { if (((t + 2) & 7) == 0 && t + 2 < nt) E.mid(acc, cur, ((t + 2) >> 3) - 1, wr, wc, fr, fq); }
        }
        if constexpr (FP8) asm volatile("s_nop 15\n\ts_nop 15" ::: "memory");
        if constexpr (ALIGN_EPI) { if (wr == 0) PG8_BAR; }
        if constexpr (!Epi::AFTER_DRAIN) { E(acc, cur, wr, wc, fr, fq); S.done(cur); }
        if (!has_next) break;
#pragma unroll
        for (int a = 0; a < 2; ++a)
#pragma unroll
            for (int b = 0; b < 2; ++b)
#pragma unroll
                for (int m = 0; m < 4; ++m)
#pragma unroll
                    for (int n = 0; n < 2; ++n) acc[a][b][m][n] = (f32x4){0.f, 0.f, 0.f, 0.f};
        cur = nxt; cA = nA; cB = nB; ++ui;
        if constexpr (Sched::GATHER) { _Pragma("unroll") for (int _h = 0; _h < 2; ++_h) _Pragma("unroll") for (int _i = 0; _i < 2; ++_i) voGc[_h][_i] = voGn_l[(_h * 2 + _i) * 512]; }
        if constexpr (ALIGN_EPI) { if (wr == 1) PG8_BAR; }
    }
    PG8_WAIT_V(0);
    if constexpr (!ALIGN_EPI) { if (wr == 0) PG8_BAR; }
    PG8_BAR;
#undef PG8_SA
#undef PG8_SB
#undef PG8_STAGE
#undef PG8_STAGE_A
#undef PG8_GOFF
#undef PG8_LDA
#undef PG8_LD8
#undef PG8_LDB
#undef PG8_MMA
#undef PG8_WAIT_V
#undef PG8_WAIT_L
#undef PG8_BAR
#undef PG8_SCHED
}
}
constexpr int BATCH = 4, SEQ = 8192, DM = 1024, NTOK = BATCH * SEQ, DEPTH = 2, NEXP = 32;
constexpr int D_IN = 8524, ZP = 8704;
constexpr int Z_AQ = 0, Z_AK = 512, Z_AV = 1024, Z_FQ = 1536, Z_FK = 2048, Z_FV = 2560, Z_CQ = 3072, Z_CF = 3584, Z_CI = 4096, Z_CG = 4608, Z_GT = 5120, Z_IQ = 8192, Z_IK = 8448, Z_IW = 8512, Z_FF = 8516;
constexpr int OP = 1536;
constexpr int MAXBLK = 544, MAXSLOT = MAXBLK * 256;
constexpr int BST_OFF = 16 + MAXBLK + 16;
constexpr float LOG2E = 1.4426950408889634f;
constexpr float QSCALE = 0.125f * LOG2E;
constexpr float ALPHA = 1.4142135623730951f;
constexpr float LN_EPS = 1e-5f, RMS_EPS = 1e-6f;
constexpr int NWAVES = 8, NTHR = 512;
constexpr float W8_SCALE = 64.0f; constexpr int W8_E8M0 = 127 - 6;
constexpr int NPH_LAYER = 14, NPHASES = 1 + DEPTH * NPH_LAYER;
enum { PH_INPROJ = 0, PH_PREP, PH_IDX, PH_ATTN, PH_H1, PH_H2, PH_H3, PH_MERGE, PH_WOUT, PH_LN1, PH_SLOT, PH_GU, PH_DOWN, PH_COMB };

__host__ __device__ __forceinline__ int zcol_src(int n) {
    if (n < 1024 || (n >= 8192 && n < 8512)) { const int p = n & 63; n = (n & ~63) + ((p & 1) ? 32 + (p >> 1) : (p >> 1)); }
    if (n < 1536) return n;
    if (n < 3072) return 1860 + (n - 1536);
    if (n < 5120) return 3404 + (n - 3072);
    if (n < 8192) return 5452 + (n - 5120);
    if (n < 8448) return 1536 + (n - 8192);
    if (n < 8512) return 1792 + (n - 8448);
    if (n < 8516) return 1856 + (n - 8512);
    if (n < 8524) return 3396 + (n - 8516);
    return -1;
}

constexpr size_t MiB = 1u << 20;
constexpr size_t WS_CTL = 0, CTL_ZERO_BYTES = 1 * MiB;
constexpr size_t WS_TRIG = 1 * MiB;
constexpr size_t WS_LFT = 3 * MiB;
constexpr size_t WS_CT = 4 * MiB;
constexpr size_t WS_DG = 5 * MiB, WS_D2G = 6 * MiB;
constexpr size_t WS_WGCNT = 7 * MiB;
constexpr size_t WS_BLK = 7 * MiB + 64 * 1024;
constexpr size_t WS_BGU = 7 * MiB + 128 * 1024;
constexpr size_t WS_TKE = 8 * MiB, WS_TKG = 8 * MiB + 512 * 1024, WS_TOKSLOT = 9 * MiB, WS_GSLOT = 9 * MiB + 512 * 1024;
constexpr size_t WS_SLOTTOK = 10 * MiB + 512 * 1024;
constexpr size_t WS_WRF = 11 * MiB;
constexpr size_t WS_WIN = 12 * MiB;
constexpr size_t WS_WP = 46 * MiB;
constexpr size_t WS_WOUT = 52 * MiB;
constexpr size_t WS_WGU = 56 * MiB;
constexpr size_t WS_WDN = 312 * MiB;
constexpr size_t WS_Z = 440 * MiB;
constexpr size_t WS_XG = WS_Z, WS_ACT = WS_Z + 272 * MiB;
constexpr size_t WS_OBUF = 984 * MiB;
constexpr size_t WS_MERGED = 1080 * MiB;
constexpr size_t WS_MIX = 1144 * MiB;
constexpr size_t WS_Y = WS_OBUF;
constexpr size_t WS_X1 = 1272 * MiB;
constexpr size_t WS_X1B = 1400 * MiB;
constexpr size_t WS_XCUR = 1464 * MiB;
constexpr size_t WS_XB = 1592 * MiB;
constexpr size_t WS_MASKW = 1656 * MiB;
constexpr size_t WS_UG = 1688 * MiB;
constexpr size_t WS_SST = 1752 * MiB;
constexpr size_t WS_SB = 7 * MiB + 768 * 1024;
constexpr size_t WS_KA = 1784 * MiB;
constexpr size_t WS_XB8 = 192 * MiB;
constexpr size_t WS_IKC = 184 * MiB;
constexpr size_t WS_END = 1792 * MiB;
static_assert(WS_Y + (size_t)MAXSLOT * 1024 * 2 <= WS_X1 && WS_ACT + (size_t)MAXSLOT * 1024 * 2 <= WS_OBUF, "ws map");
constexpr int CW_TMO = 0;
constexpr int CW_BAR = 4096;
constexpr int CW_SB = 512;

constexpr int SCR_BYTES = 153600;
constexpr int MISC_OFF = SCR_BYTES;
constexpr int LDS_BYTES = SCR_BYTES + 256;

#define RLX_AGENT __ATOMIC_RELAXED, __HIP_MEMORY_SCOPE_AGENT
#define LDS_WAIT() asm volatile("s_waitcnt lgkmcnt(0)" ::: "memory")
#define VM_WAIT() asm volatile("s_waitcnt vmcnt(0)" ::: "memory")
#define WG_BAR() asm volatile("s_waitcnt vmcnt(0) lgkmcnt(0)\n\ts_barrier" ::: "memory")
#define WG_BAR_LDS() asm volatile("s_waitcnt lgkmcnt(0)\n\ts_barrier" ::: "memory")

#define XB_TMO      128
#define XB_XCNT(j)  (256  + 64 * (j))
#define XB_XSUB(j)  (1280 + 64 * (j))
#define XB_XGEN(j)  (2304 + 64 * (j))
#define XB_TOP      3328
#define XB_TOPGEN   3392
#define XCD_BAR_WORDS 3456
#define XB_SPIN_CAP (1u << 18)

__device__ __forceinline__ unsigned xb_ld(unsigned* p)              { return __hip_atomic_load(p, __ATOMIC_RELAXED, __HIP_MEMORY_SCOPE_AGENT); }
__device__ __forceinline__ unsigned xb_add(unsigned* p, unsigned v) { return __hip_atomic_fetch_add(p, v, __ATOMIC_RELAXED, __HIP_MEMORY_SCOPE_AGENT); }
__device__ __forceinline__ unsigned xb_xcc_id() { return (unsigned)__builtin_amdgcn_s_getreg((3 << 11) | 20) & 0xFu; }
#define XB_SPIN(cond, bar) do { unsigned _sp = 0; while (cond) { __builtin_amdgcn_s_sleep(1); \
    if ((++_sp & 255u) == 0u) { if (xb_ld(&(bar)[XB_TMO])) break; if (_sp > XB_SPIN_CAP) { atomicAdd(&(bar)[XB_TMO], 1u); break; } } } } while (0)

struct XcdBarrier {
    unsigned* bar; unsigned x;
    volatile LAS unsigned* st;
};

__device__ __forceinline__ XcdBarrier xcd_barrier_post(unsigned* bar, volatile LAS unsigned* st) {
    XcdBarrier b; b.bar = bar; b.x = xb_xcc_id(); b.st = st;
    if (threadIdx.x == 0) (void)xb_add(&bar[XB_XCNT(b.x)], 1u);
    return b;
}
__device__ __forceinline__ void xcd_barrier_complete(unsigned* bar, unsigned x, unsigned& nloc, unsigned& nx) {
    const unsigned G = gridDim.x * gridDim.y * gridDim.z;
    unsigned sum, cnt, mine, sp = 0u;
    for (;;) {
        sum = 0u; cnt = 0u; mine = 0u;
#pragma unroll
        for (unsigned j = 0; j < 16; ++j) { const unsigned c = xb_ld(&bar[XB_XCNT(j)]); sum += c; cnt += (c > 0u) ? 1u : 0u; mine = (j == x) ? c : mine; }
        if (sum == G) break;
        __builtin_amdgcn_s_sleep(1);
        if ((++sp & 255u) == 0u) { if (xb_ld(&bar[XB_TMO])) break; if (sp > XB_SPIN_CAP) { atomicAdd(&bar[XB_TMO], 1u); break; } }
    }
    nloc = mine > 0u ? mine : 1u; nx = cnt > 0u ? cnt : 1u;
}

__device__ __forceinline__ void xcd_barrier(const XcdBarrier& b) {
    asm volatile("s_waitcnt vmcnt(0)" ::: "memory");
    __syncthreads();
    if (threadIdx.x == 0) {
        unsigned* bar = b.bar;
        __builtin_amdgcn_s_waitcnt(0);
        unsigned nloc = b.st[0], nx = b.st[1];
        if (nloc == 0u) { xcd_barrier_complete(bar, b.x, nloc, nx); b.st[0] = nloc; b.st[1] = nx; }
        const unsigned old = xb_add(&bar[XB_XSUB(b.x)], 1u);
        const unsigned gen = old / nloc;
        if (old + 1u == (gen + 1u) * nloc) {
            __builtin_amdgcn_fence(__ATOMIC_RELEASE, "agent");
            asm volatile("s_waitcnt vmcnt(0)" ::: "memory");
            const unsigned og = xb_add(&bar[XB_TOP], 1u);
            const unsigned tg = og / nx;
            if (og + 1u == (tg + 1u) * nx) xb_add(&bar[XB_TOPGEN], 1u);
            else XB_SPIN(xb_ld(&bar[XB_TOPGEN]) == tg, bar);
            __builtin_amdgcn_fence(__ATOMIC_ACQUIRE, "agent");
            xb_add(&bar[XB_XGEN(b.x)], 1u);
            asm volatile("s_waitcnt vmcnt(0)" ::: "memory");
        } else {
            XB_SPIN(xb_ld(&bar[XB_XGEN(b.x)]) == gen, bar);
            __builtin_amdgcn_fence(__ATOMIC_ACQUIRE, "agent");
            asm volatile("s_waitcnt vmcnt(0)" ::: "memory");
        }
    }
    __syncthreads();
}
__device__ __forceinline__ int lane_id() { int l = (int)__builtin_amdgcn_mbcnt_hi(~0u, __builtin_amdgcn_mbcnt_lo(~0u, 0u)); asm volatile("" : "+v"(l)); return l; }
__device__ __forceinline__ float wave_sum(float v) {
#pragma unroll
    for (int o = 1; o < 64; o <<= 1) v += __shfl_xor(v, o);
    return v;
}
__device__ __forceinline__ int crow(int r, int hi) { return (r & 3) + 8 * (r >> 2) + 4 * hi; }
__device__ __forceinline__ void glds16(const void* gsrc, unsigned lds_dst) { unsigned keep;
    asm volatile("s_mov_b32 %0, m0\n\ts_mov_b32 m0, %2\n\ts_nop 0\n\tglobal_load_lds_dwordx4 %1, off\n\ts_mov_b32 m0, %0" : "=&s"(keep) : "v"(gsrc), "s"(lds_dst) : "memory"); }
__device__ __forceinline__ void glds4(const void* gsrc, unsigned lds_dst) { unsigned keep;
    asm volatile("s_mov_b32 %0, m0\n\ts_mov_b32 m0, %2\n\ts_nop 0\n\tglobal_load_lds_dword %1, off\n\ts_mov_b32 m0, %0" : "=&s"(keep) : "v"(gsrc), "s"(lds_dst) : "memory"); }
typedef __bf16 bf16x2_t __attribute__((ext_vector_type(2)));
__device__ __forceinline__ unsigned cvtpk(float lo, float hi) { const f32x2 v = {lo, hi}; const bf16x2_t b = __builtin_convertvector(v, bf16x2_t); return __builtin_bit_cast(unsigned, b); }
typedef short v4i16_t __attribute__((ext_vector_type(4)));
__device__ __forceinline__ s16x4 vtr(const LAS char* p) { return __builtin_bit_cast(s16x4, __builtin_amdgcn_ds_read_tr16_b64_v4i16((LAS v4i16_t*)p)); }
__device__ __forceinline__ void plswap(float& a, float& b) { asm volatile("s_nop 1\n\tv_permlane32_swap_b32 %0, %1\n\ts_nop 1" : "+v"(a), "+v"(b)); }
__device__ __forceinline__ float swapmax(float m) { float a = m, b = m; plswap(a, b); return fmaxf(a, b); }
__device__ __forceinline__ float swapsum(float m) { float a = m, b = m; plswap(a, b); return a + b; }
#define MFMA32(a, b, c) __builtin_amdgcn_mfma_f32_32x32x16_bf16((a), (b), (c), 0, 0, 0)

struct Params {
    const float* x; const float* w_in; const float* b_fox; const float* lb_logits; const float* norm_g; const float* w_pa; const float* w_pb; const float* w_pc; const float* w_out;
    const float* ln1_g; const float* ln1_b; const float* w_router; const float* b_router; const float* w_gu; const float* b_gu; const float* w_down; const float* b_down; const float* ln2_g; const float* ln2_b;
    float* out; unsigned char* ws; int ph_lo, ph_hi, use_bar, pad;
};

typedef const __attribute__((address_space(4))) Params* KP;
__device__ __forceinline__ KP load_params() { KP kp = (KP)__builtin_amdgcn_kernarg_segment_ptr(); asm volatile("" : "+s"(kp)); return kp; }

template <class F> __device__ __forceinline__ void cvt_tile(const float* W, size_t ldsrc, int k0, bf16* WT, size_t ldw, int kd0, int n0, const F& f, LAS float* scr, int lane) {
    const int c = lane & 31; int sc; float scale; f(n0 + c, sc, scale);
#pragma unroll 8
    for (int i = 0; i < 32; ++i) { const int kk = 2 * i + (lane >> 5); scr[kk * 33 + c] = sc >= 0 ? W[(size_t)(k0 + kk) * ldsrc + sc] * scale : 0.f; }
    LDS_WAIT(); asm volatile("" ::: "memory");
    const int ch = lane & 7;
#pragma unroll
    for (int j = 0; j < 4; ++j) { const int n = (lane >> 3) + 8 * j; const LAS float* s = scr + (8 * ch) * 33 + n;
        u32x4 o; o.x = pk2(s[0 * 33], s[1 * 33]); o.y = pk2(s[2 * 33], s[3 * 33]); o.z = pk2(s[4 * 33], s[5 * 33]); o.w = pk2(s[6 * 33], s[7 * 33]);
        *(u32x4*)(WT + (size_t)(n0 + n) * ldw + kd0 + 8 * ch) = o; }
    LDS_WAIT(); asm volatile("" ::: "memory");
}
template <class F> __device__ __forceinline__ void cvt_tile8(const float* W, size_t ldsrc, int k0, unsigned char* WT, size_t ldw, int n0, const F& f, float wscale, LAS float* scr, int lane) {
    const int c = lane & 31; int sc; float scale; f(n0 + c, sc, scale); scale *= wscale;
#pragma unroll 8
    for (int i = 0; i < 32; ++i) { const int kk = 2 * i + (lane >> 5); scr[kk * 33 + c] = sc >= 0 ? W[(size_t)(k0 + kk) * ldsrc + sc] * scale : 0.f; }
    LDS_WAIT(); asm volatile("" ::: "memory");
    const int ch = lane & 7;
#pragma unroll
    for (int j = 0; j < 4; ++j) { const int n = (lane >> 3) + 8 * j; const LAS float* s = scr + (8 * ch) * 33 + n;
        int w0 = __builtin_amdgcn_cvt_pk_fp8_f32(s[0 * 33], s[1 * 33], 0, false); w0 = __builtin_amdgcn_cvt_pk_fp8_f32(s[2 * 33], s[3 * 33], w0, true);
        int w1 = __builtin_amdgcn_cvt_pk_fp8_f32(s[4 * 33], s[5 * 33], 0, false); w1 = __builtin_amdgcn_cvt_pk_fp8_f32(s[6 * 33], s[7 * 33], w1, true);
        *(u32x2*)(WT + (size_t)(n0 + n) * ldw + k0 + 8 * ch) = (u32x2){(unsigned)w0, (unsigned)w1}; }
    LDS_WAIT(); asm volatile("" ::: "memory");
}
struct MapIn { __device__ __forceinline__ void operator()(int n, int& sc, float& s) const { sc = zcol_src(n); s = (n < 512 || (n >= Z_FQ && n < Z_FK)) ? QSCALE : 1.0f; } };
struct MapGu { __device__ __forceinline__ void operator()(int n, int& sc, float& s) const { sc = (n & 1) ? 1024 + (n >> 1) : (n >> 1); s = 1.0f; } };
struct MapId { __device__ __forceinline__ void operator()(int n, int& sc, float& s) const { sc = n; s = 1.0f; } };

__device__ __forceinline__ void p0_prologue(KP p, LAS unsigned char* lds, int gw, int NGW, int wave, int lane) {
    LAS float* scr = (LAS float*)(lds + wave * 16384);
    unsigned char* ws = p->ws;
    constexpr int I_IN = 16 * 272, I_GU = 32 * 16 * 64, I_DN = 32 * 16 * 32, I_P = 3 * 8 * 32, I_OUT = 16 * 32, I_LAYER = I_IN + I_GU + I_DN + I_P + I_OUT;
    for (int it = gw; it < DEPTH * I_LAYER; it += NGW) {
        const int l = it / I_LAYER; int r = it - l * I_LAYER;
        if (r < I_IN) { const int kb = r / 272, nb = r % 272;
            cvt_tile8(p->w_in + (size_t)l * 1024 * D_IN, D_IN, 64 * kb, (unsigned char*)(ws + WS_WIN) + (size_t)l * ZP * 1024, 1024, 32 * nb, MapIn{}, W8_SCALE, scr, lane); continue; } r -= I_IN;
        if (r < I_GU) { const int e = r >> 10, r2 = r & 1023, kb = r2 >> 6, nb = r2 & 63;
            cvt_tile8(p->w_gu + (size_t)(l * 32 + e) * 1024 * 2048, 2048, 64 * kb, (unsigned char*)(ws + WS_WGU) + (size_t)(l * 32 + e) * 2048 * 1024, 1024, 32 * nb, MapGu{}, W8_SCALE, scr, lane); continue; } r -= I_GU;
        if (r < I_DN) { const int e = r >> 9, r2 = r & 511, kb = r2 >> 5, nb = r2 & 31;
            cvt_tile8(p->w_down + (size_t)(l * 32 + e) * 1024 * 1024, 1024, 64 * kb, (unsigned char*)(ws + WS_WDN) + (size_t)(l * 32 + e) * 1024 * 1024, 1024, 32 * nb, MapId{}, W8_SCALE, scr, lane); continue; } r -= I_DN;
        if (r < I_P) { const int br = r >> 8, r2 = r & 255, kb = r2 >> 5, nb = r2 & 31; const float* W = (br == 0 ? p->w_pa : br == 1 ? p->w_pb : p->w_pc) + (size_t)l * 512 * 1024;
            cvt_tile(W, 1024, 64 * kb, (bf16*)(ws + WS_WP) + (size_t)l * 1024 * 1536, 1536, br * 512 + 64 * kb, 32 * nb, MapId{}, scr, lane); continue; } r -= I_P;
        { const int kb = r >> 5, nb = r & 31;
            cvt_tile(p->w_out + (size_t)l * 1024 * 1024, 1024, 64 * kb, (bf16*)(ws + WS_WOUT) + (size_t)l * 1024 * 1024, 1024, 64 * kb, 32 * nb, MapId{}, scr, lane); }
    }
    { float* bg = (float*)(ws + WS_BGU);
      for (int i = gw * 64 + lane; i < DEPTH * 32 * 2048; i += NGW * 64) { const int n = i & 2047, le = i >> 11; bg[i] = p->b_gu[(size_t)le * 2048 + ((n & 1) ? 1024 + (n >> 1) : (n >> 1))]; } }
    { bf16* wf = (bf16*)(ws + WS_WRF);
      for (int i = gw * 64 + lane; i < DEPTH * 32 * 2 * 64 * 8; i += NGW * 64) { const int ii = i & 7, ln = (i >> 3) & 63, nt = (i >> 9) & 1, s = (i >> 10) & 31, l = i >> 15;
          const int k = 32 * s + 8 * (ln >> 4) + ii, e = 16 * nt + (ln & 15); const float w = p->w_router[((size_t)l * 1024 + k) * 32 + e];
          const unsigned hb = f2bf(w); const float lo = w - bf2f(hb);
          const size_t base = ((((size_t)l * 32 + s) * 2 + nt) * 2) * 512 + ln * 8 + ii; wf[base] = (bf16)hb; wf[base + 512] = (bf16)f2bf(lo); } }
    { f32x2* tg = (f32x2*)(ws + WS_TRIG);
      for (int i = gw * 64 + lane; i < SEQ * 32; i += NGW * 64) { const int pos = i >> 5, k = i & 31;
          const float inv = exp2f(-(float)k * (13.287712379549449f / 32.0f)); const float ang = (float)pos * inv;
          const double rev = (double)ang * 0.15915494309189535; const float fr = (float)(rev - __builtin_rint(rev));
          tg[i] = (f32x2){__builtin_amdgcn_cosf(fr), __builtin_amdgcn_sinf(fr)}; } }
    { bf16* xb = (bf16*)(ws + WS_XB);
      for (int m = gw; m < NTOK; m += NGW) { const f32x4* xr = (const f32x4*)(p->x + (size_t)m * DM) + lane; u32x2* o = (u32x2*)(xb + (size_t)m * DM) + lane;
#pragma unroll
          for (int j = 0; j < 4; ++j) { const f32x4 v = xr[64 * j]; o[64 * j] = (u32x2){pk2(v.x, v.y), pk2(v.z, v.w)};
              int w8 = __builtin_amdgcn_cvt_pk_fp8_f32(v.x, v.y, 0, false); w8 = __builtin_amdgcn_cvt_pk_fp8_f32(v.z, v.w, w8, true); ((unsigned*)(ws + WS_XB8 + (size_t)m * DM))[lane + 64 * j] = (unsigned)w8; } } }
}

__device__ __forceinline__ void prep_phase(KP p, int l, int gw, int NGW, int lane) {
    unsigned char* ws = p->ws; bf16* Z = (bf16*)(ws + WS_Z); const f32x2* tg = (const f32x2*)(ws + WS_TRIG); float* lfT = (float*)(ws + WS_LFT);
    const float bf_l = (lane < 8) ? p->b_fox[l * 8 + lane] : 0.f;
    for (int m = gw; m < NTOK; m += NGW) {
        bf16* zr = Z + (size_t)m * ZP; const int pos = m & (SEQ - 1), b = m >> 13;
        const f32x2 cs = tg[pos * 32 + (lane & 31)];
        unsigned short ta[11], tb[11];
#pragma unroll
        for (int it = 0; it < 11; ++it) { const int hh = 2 * it + (lane >> 5); const int hc = hh < 21 ? hh : 20;
            const int col = hc < 8 ? Z_AQ + hc * 64 : hc < 16 ? Z_AK + (hc - 8) * 64 : hc < 20 ? Z_IQ + (hc - 16) * 64 : Z_IK;
            const bf16* q = zr + col + (lane & 31); ta[it] = q[0]; tb[it] = q[32]; }
#pragma unroll
        for (int it = 0; it < 11; ++it) { const int hh = 2 * it + (lane >> 5);
            if (hh < 21) { const int col = hh < 8 ? Z_AQ + hh * 64 : hh < 16 ? Z_AK + (hh - 8) * 64 : hh < 20 ? Z_IQ + (hh - 16) * 64 : Z_IK;
                bf16* q = zr + col + (lane & 31); const float t1 = bf2f(ta[it]), t2 = bf2f(tb[it]);
                q[0] = (bf16)f2bf(t1 * cs.x - t2 * cs.y); q[32] = (bf16)f2bf(t2 * cs.x + t1 * cs.y); } }
#pragma unroll
        for (int j = 0; j < 2; ++j) { bf16* g0p = zr + Z_GT + lane * 8 + j * 512; const u32x4 a = *(const u32x4*)g0p, bb = *(const u32x4*)(g0p + 1024), cc = *(const u32x4*)(g0p + 2048);
            u32x4 o0, o1, o2;
#pragma unroll
            for (int i = 0; i < 4; ++i) {
                const float e0l = __expf(-bflo(a[i])), e0h = __expf(-bfhi(a[i])), e1l = __expf(-bflo(bb[i])), e1h = __expf(-bfhi(bb[i])), e2l = __expf(-bflo(cc[i])), e2h = __expf(-bfhi(cc[i]));
                o0[i] = pk2((1.f + e1l) / (1.f + e0l), (1.f + e1h) / (1.f + e0h));
                o1[i] = pk2((1.f + e2l) / (1.f + e1l), (1.f + e2h) / (1.f + e1h));
                o2[i] = pk2(1.f / (1.f + e2l), 1.f / (1.f + e2h)); }
            *(u32x4*)g0p = o0; *(u32x4*)(g0p + 1024) = o1; *(u32x4*)(g0p + 2048) = o2; }
        if (lane < 8) { const float v = bf2f(zr[Z_FF + lane]) + bf_l; const float ls = fminf(v, 0.f) - __logf(1.0f + __expf(-fabsf(v))); lfT[(size_t)(b * 8 + lane) * SEQ + pos] = ls * LOG2E; }
    }
}

constexpr int IX_CAP = 1024, IX_STRIDE = IX_CAP + 1  , IX_TRIG = 768, IX_CAND = 0, IX_BM = 0  , IX_HIST = 32 * IX_STRIDE * 4, IX_CNT = IX_HIST + 8 * 1024, IX_TAU = IX_CNT + 128, IX_FLAG = IX_TAU + 128, IX_END = IX_FLAG + 64;
static_assert(IX_END <= SCR_BYTES, "indexer LDS");

__device__ __forceinline__ int wave_incl_sum(int v) {
    v += __builtin_amdgcn_update_dpp(0, v, 0x111, 0xf, 0xf, false);
    v += __builtin_amdgcn_update_dpp(0, v, 0x112, 0xf, 0xf, false);
    v += __builtin_amdgcn_update_dpp(0, v, 0x114, 0xf, 0xf, false);
    v += __builtin_amdgcn_update_dpp(0, v, 0x118, 0xf, 0xf, false);
    v += __builtin_amdgcn_update_dpp(0, v, 0x142, 0xa, 0xf, false);
    v += __builtin_amdgcn_update_dpp(0, v, 0x143, 0xc, 0xf, false);
    return v;
}
__device__ __forceinline__ unsigned wave_or63(unsigned v) {
    v |= (unsigned)__builtin_amdgcn_update_dpp(0, (int)v, 0x111, 0xf, 0xf, false);
    v |= (unsigned)__builtin_amdgcn_update_dpp(0, (int)v, 0x112, 0xf, 0xf, false);
    v |= (unsigned)__builtin_amdgcn_update_dpp(0, (int)v, 0x114, 0xf, 0xf, false);
    v |= (unsigned)__builtin_amdgcn_update_dpp(0, (int)v, 0x118, 0xf, 0xf, false);
    v |= (unsigned)__builtin_amdgcn_update_dpp(0, (int)v, 0x142, 0xa, 0xf, false);
    v |= (unsigned)__builtin_amdgcn_update_dpp(0, (int)v, 0x143, 0xc, 0xf, false);
    return v;
}
__device__ __forceinline__ int count_ge8(const unsigned (&x)[16], int k0, unsigned t) {
    u64 m0, m1, m2, m3, m4, m5, m6, m7;
    asm("v_cmp_ge_u32_e64 %0, %8, %16\n\tv_cmp_ge_u32_e64 %1, %9, %16\n\tv_cmp_ge_u32_e64 %2, %10, %16\n\tv_cmp_ge_u32_e64 %3, %11, %16\n\t"
        "v_cmp_ge_u32_e64 %4, %12, %16\n\tv_cmp_ge_u32_e64 %5, %13, %16\n\tv_cmp_ge_u32_e64 %6, %14, %16\n\tv_cmp_ge_u32_e64 %7, %15, %16"
        : "=&s"(m0), "=&s"(m1), "=&s"(m2), "=&s"(m3), "=&s"(m4), "=&s"(m5), "=&s"(m6), "=&s"(m7)
        : "v"(x[k0]), "v"(x[k0 + 1]), "v"(x[k0 + 2]), "v"(x[k0 + 3]), "v"(x[k0 + 4]), "v"(x[k0 + 5]), "v"(x[k0 + 6]), "v"(x[k0 + 7]), "v"(t));
    return (int)(__popcll(m0) + __popcll(m1) + __popcll(m2) + __popcll(m3) + __popcll(m4) + __popcll(m5) + __popcll(m6) + __popcll(m7));
}
template <bool EXACT>
__device__ __forceinline__ unsigned wave_search256(const unsigned (&x)[16]) {
    const unsigned xr = (unsigned)__builtin_amdgcn_readfirstlane((int)x[0]); unsigned df = 0u;
#pragma unroll
    for (int k = 0; k < 16; ++k) df |= (x[k] != 0u) ? (x[k] ^ xr) : 0u;
    df = (unsigned)__builtin_amdgcn_readlane((int)wave_or63(df), 63);
    const int hb = 31 - (int)__builtin_clz(df | 1u);
    unsigned prefix = xr & ~((2u << hb) - 1u);
#pragma unroll 1
    for (int bit = hb; bit >= 0; --bit) { const unsigned trial = prefix | (1u << bit); const int c = count_ge8(x, 0, trial) + count_ge8(x, 8, trial);
        if (c >= 256) { prefix = trial; if (EXACT ? (c == 256) : (c <= 384)) break; } }
    return prefix;
}
__device__ __forceinline__ unsigned wave_compact(LAS unsigned* cand, int n, int lane, int& kept) {
    unsigned x[16];
#pragma unroll
    for (int k = 0; k < 16; ++k) { const int i = lane + 64 * k; x[k] = (i < n) ? cand[i] : 0u; }
    const unsigned prefix = wave_search256<false>(x);
    int base = 0;
#pragma unroll
    for (int k = 0; k < 16; ++k) { const bool keep = x[k] >= prefix; const u64 mk = __ballot(keep);
        if (keep) cand[__builtin_amdgcn_mbcnt_hi((unsigned)(mk >> 32), __builtin_amdgcn_mbcnt_lo((unsigned)mk, (unsigned)base))] = x[k]; base += __popcll(mk); }
    kept = base;
    return prefix;
}

__device__ __forceinline__ void idx_phase(KP p, int l, LAS unsigned char* lds, int vcu, int G, int tid, int wave, int lane) {
    unsigned char* ws = p->ws; const bf16* Z = (const bf16*)(ws + WS_Z);
    { unsigned* sbr = (unsigned*)(ws + WS_CTL) + CW_SB + l * 64; LAS float* wt = (LAS float*)lds;
      for (int task = blockIdx.x; task < 256; task += G) { const int bh = task >> 3, part = task & 7; float qm = 0.f, km = 0.f;
          const bf16* zr = Z + (size_t)((bh >> 3) * SEQ + part * 1024 + tid * 2) * ZP + (bh & 7) * 64;
#pragma unroll
          for (int i = 0; i < 2; ++i) { float qs = 0.f, ks = 0.f;
#pragma unroll
              for (int c8 = 0; c8 < 8; ++c8) { const u32x4 a = *(const u32x4*)(zr + (size_t)i * ZP + Z_FQ + c8 * 8), kq = *(const u32x4*)(zr + (size_t)i * ZP + Z_FK + c8 * 8);
#pragma unroll
                  for (int w4 = 0; w4 < 4; ++w4) { qs += bflo(a[w4]) * bflo(a[w4]) + bfhi(a[w4]) * bfhi(a[w4]); ks += bflo(kq[w4]) * bflo(kq[w4]) + bfhi(kq[w4]) * bfhi(kq[w4]); } }
              qm = fmaxf(qm, qs); km = fmaxf(km, ks); }
#pragma unroll
          for (int o = 1; o < 64; o <<= 1) { qm = fmaxf(qm, __shfl_xor(qm, o)); km = fmaxf(km, __shfl_xor(km, o)); }
          if (lane == 0) { __hip_atomic_fetch_max(sbr + 2 * bh, __builtin_bit_cast(unsigned, qm), __ATOMIC_RELAXED, __HIP_MEMORY_SCOPE_AGENT); __hip_atomic_fetch_max(sbr + 2 * bh + 1, __builtin_bit_cast(unsigned, km), __ATOMIC_RELAXED, __HIP_MEMORY_SCOPE_AGENT); } }
      (void)wt; }
    for (int bh = blockIdx.x; bh < 32; bh += G) {
        float* dst = (float*)(ws + WS_CT) + (size_t)bh * SEQ;
        LAS float* wt = (LAS float*)lds;
        const float bfx = p->b_fox[l * 8 + (bh & 7)]; const bf16* zf = Z + (size_t)((bh >> 3) * SEQ + tid * 16) * ZP + Z_FF + (bh & 7);
        f32x4 v[4]; float run = 0.f;
#pragma unroll
        for (int j = 0; j < 4; ++j) {
#pragma unroll
            for (int i = 0; i < 4; ++i) { const float t = bf2f(zf[(size_t)(4 * j + i) * ZP]) + bfx; v[j][i] = (fminf(t, 0.f) - __logf(1.0f + __expf(-fabsf(t)))) * LOG2E; }
            v[j].x += run; v[j].y += v[j].x; v[j].z += v[j].y; v[j].w += v[j].z; run = v[j].w; }
        float inc = run;
#pragma unroll
        for (int o = 1; o < 64; o <<= 1) { const float t = __shfl_up(inc, o); if (lane >= o) inc += t; }
        if (lane == 63) wt[wave] = inc;
        WG_BAR();
        float off = inc - run;
        for (int w = 0; w < wave; ++w) off += wt[w];
        { u32x4* ka = (u32x4*)((bf16*)(ws + WS_KA) + ((size_t)bh * SEQ + tid * 16) * 16);
#pragma unroll
          for (int j = 0; j < 4; ++j) { const f32x4 c4 = v[j] + off; *(f32x4*)(dst + tid * 16 + 4 * j) = c4;
#pragma unroll
              for (int i = 0; i < 4; ++i) { const float c = c4[i]; const unsigned h1 = f2bf(c); const float r1 = c - bf2f(h1); const unsigned h2 = f2bf(r1); const unsigned h3 = f2bf(r1 - bf2f(h2));
                  unsigned z0 = 0u; asm volatile("" : "+v"(z0));
                  ka[(4 * j + i) * 2] = (u32x4){h1 | (h2 << 16), h3 | 0x3f800000u, z0, z0}; ka[(4 * j + i) * 2 + 1] = (u32x4){z0, z0, z0, z0}; } } }
        WG_BAR();
    }
    LAS unsigned* cand = (LAS unsigned*)(lds + IX_CAND); LAS unsigned* BM = (LAS unsigned*)(lds + IX_BM);
    LAS unsigned* cnt = (LAS unsigned*)(lds + IX_CNT); LAS unsigned* tau = (LAS unsigned*)(lds + IX_TAU); LAS unsigned* hist = (LAS unsigned*)(lds + IX_HIST); LAS unsigned* flg = (LAS unsigned*)(lds + IX_FLAG);
    u64* MW = (u64*)(ws + WS_MASKW);
    const int r32 = lane & 31, hi = lane >> 5;
    for (int U = vcu; U < 1024; U += G) {
        const int v = U & 255, i4 = U >> 8; const int b = v & 3, a = v >> 2;
        const int hc = (i4 == 0) ? a : (i4 == 1) ? 255 - a : (i4 == 2) ? 64 + a : 191 - a;
        const int qbase = b * SEQ + hc * 32; const int nadm = ((hc >> 1) + 1) * 64;
        if (nadm <= 256) {
            const int nw = nadm >> 6;
            for (int i = tid; i < 32 * 128; i += NTHR) { const int q = i >> 7, w = i & 127; unsigned on = (w < nw) ? 0xffffffffu : 0u; asm volatile("" : "+v"(on));
                MW[(size_t)(qbase + q) * 128 + w] = (u64)on | ((u64)on << 32); }
            continue;
        }
        const bf16* qrow = Z + (size_t)(qbase + r32) * ZP;
        bf16x8 iqf[4][4];
#pragma unroll
        for (int hd = 0; hd < 4; ++hd)
#pragma unroll
            for (int j = 0; j < 4; ++j) iqf[hd][j] = *(const bf16x8*)(qrow + Z_IQ + hd * 64 + j * 16 + hi * 8);
        float wq[4];
#pragma unroll
        for (int hd = 0; hd < 4; ++hd) wq[hd] = bf2f(qrow[Z_IW + hd]) * (0.5f * 0.125f);
        if (tid < 32) { cnt[tid] = 0u; tau[tid] = 0u; } if (tid < 3) flg[tid] = 0u;
        const int ntiles = nadm >> 5, nrounds = (ntiles + 7) >> 3;
        const bf16* kbase = (const bf16*)(ws + WS_IKC) + (size_t)(b * SEQ) * 64 + hi * 8;
        bf16x8 kf[4], kn[4];
#pragma unroll
        for (int j = 0; j < 4; ++j) kn[j] = *(const bf16x8*)(kbase + (size_t)((wave < ntiles ? wave : 0) * 32 + r32) * 64 + j * 16);
        WG_BAR();
        for (int rd = 0; rd < nrounds; ++rd) {
            const int tile = rd * 8 + wave;
#pragma unroll
            for (int j = 0; j < 4; ++j) kf[j] = kn[j];
            { const int tn = (tile + 8 < ntiles) ? tile + 8 : tile;
#pragma unroll
              for (int j = 0; j < 4; ++j) kn[j] = *(const bf16x8*)(kbase + (size_t)((tn < ntiles ? tn : 0) * 32 + r32) * 64 + j * 16); }
            if (tile < ntiles) {
                f32x16 sc = {};
#pragma unroll
                for (int hd = 0; hd < 4; ++hd) { f32x16 pp = {};
#pragma unroll
                    for (int j = 0; j < 4; ++j) pp = MFMA32(kf[j], iqf[hd][j], pp);
#pragma unroll
                    for (int r = 0; r < 16; ++r) { const float pv = pp[r]; const int pb = __builtin_bit_cast(int, pv); const int pr = pb > 0 ? pb : 0;
                        sc[r] = __builtin_fmaf(wq[hd], __builtin_bit_cast(float, pr), sc[r]); } }
                const unsigned tq = tau[r32];
                typedef unsigned u32x16_t __attribute__((ext_vector_type(16))); u32x16_t comp; unsigned npass = 0u;
#pragma unroll
                for (int r = 0; r < 16; ++r) { const int key = tile * 32 + crow(r, hi);
                    unsigned u = __builtin_bit_cast(unsigned, sc[r] + 0.0f); u ^= (u >> 31) ? 0xffffffffu : 0x80000000u;
                    comp[r] = (u & 0xffffe000u) | (unsigned)(8191 - key); npass += (comp[r] > tq) ? 1u : 0u; }
                unsigned pos = 0u;
                if (npass) pos = __hip_atomic_fetch_add(cnt + r32, npass, __ATOMIC_RELAXED, __HIP_MEMORY_SCOPE_WORKGROUP);
                LAS unsigned* cq_ = cand + r32 * IX_STRIDE;
#pragma unroll
                for (int r = 0; r < 16; ++r) if (comp[r] > tq) { cq_[pos] = comp[r]; ++pos; }
                if (npass && pos > (unsigned)IX_TRIG) flg[rd % 3] = 1u;
            }
            WG_BAR_LDS();
            const bool need_any = flg[rd % 3] != 0u;
            if (tid == 0) flg[(rd + 2) % 3] = 0u;
            if (need_any) {
#pragma unroll 1
                for (int i = 0; i < 4; ++i) { const int qq = wave * 4 + i; const int n = __builtin_amdgcn_readfirstlane((int)cnt[qq]);
                    if (n > 256) { int kept; const unsigned th = wave_compact(cand + qq * IX_STRIDE, n, lane, kept); if (lane == 0) { cnt[qq] = (unsigned)kept; tau[qq] = th ? th - 1u : 0u; } } }
                WG_BAR_LDS();
            }
        }
#pragma unroll 1
        for (int i = 0; i < 4; ++i) { const int qq = wave * 4 + i; const int n = __builtin_amdgcn_readfirstlane((int)cnt[qq]);
            LAS unsigned* cq = cand + qq * IX_STRIDE; unsigned x[16];
#pragma unroll
            for (int k = 0; k < 16; ++k) { const int ii = lane + 64 * k; x[k] = (ii < n) ? cq[ii] : 0u; }
            unsigned th = 1u; if (n > 256) th = wave_search256<true>(x);
            asm volatile("" ::: "memory");
#pragma unroll
            for (int k = 0; k < 4; ++k) { unsigned z0 = 0u; asm volatile("" : "+v"(z0)); cq[lane + 64 * k] = z0; }
#pragma unroll
            for (int k = 0; k < 16; ++k) if (x[k] >= th) { const int key = 8191 - (int)(x[k] & 8191u);
                (void)__hip_atomic_fetch_or(cq + (key >> 5), 1u << (key & 31), __ATOMIC_RELAXED, __HIP_MEMORY_SCOPE_WORKGROUP); }
            LDS_WAIT(); asm volatile("" ::: "memory");
            const unsigned w0 = cq[4 * lane], w1 = cq[4 * lane + 1], w2 = cq[4 * lane + 2], w3 = cq[4 * lane + 3];
            *(u32x4*)(MW + (size_t)(qbase + qq) * 128 + 2 * lane) = (u32x4){w0, w1, w2, w3};
            asm volatile("" ::: "memory"); }
        WG_BAR();
    }
}

constexpr int AT_K = 0, AT_V = 2 * 8192, AT_WS = 4 * 8192, AT_OST = AT_WS + 4096, AT_MW = AT_OST + 8 * 4096, AT_KA = AT_MW + 2 * 8 * 512, AT_END = AT_KA + 2 * 2048;
static_assert(AT_END <= SCR_BYTES, "attention LDS");
#ifndef DBG_ATT_L
#define DBG_ATT_L 0
#endif

template <int MODE>
__device__ __forceinline__ void attn_unit(int b, int h, int qb, const bf16* Z, bf16* Ob, const float* cT, const u64* MW, const void* KA, const void* SBp, LAS char* shm, int wv) {
    int tid_l = lane_id() + wv * 64;
    const int tid = tid_l, lane = tid & 63, r32 = lane & 31, hi = lane >> 5; const int wid = __builtin_amdgcn_readfirstlane(tid >> 6);
    constexpr int QC = MODE == 0 ? Z_FQ : Z_AQ, KC = MODE == 0 ? Z_FK : Z_AK, VC = MODE == 0 ? Z_FV : Z_AV, OC = MODE == 0 ? 512 : 0;
    const long rowbase = (long)b * SEQ; const int q0 = qb * 512;
    const bf16* Qw = Z + (rowbase + q0 + wid * 64) * ZP + QC + h * 64;
    const bf16* Kh = Z + rowbase * ZP + KC + h * 64; const bf16* Vh = Z + rowbase * ZP + VC + h * 64;
    const unsigned lds0 = (unsigned)(uintptr_t)shm;
    LAS float* wsf = (LAS float*)(shm + AT_WS) + wid * 128;
    const int NT = 8 * (qb + 1); const int tlast = 8 * qb + wid;
    const bf16* ksrc = Kh + (long)lane * ZP + wid * 8;
    const bf16* vsrc = Vh + (long)(16 * (wid & 3) + (lane >> 2)) * ZP + (wid >> 2) * 32 + (lane & 3) * 8;
    const unsigned kdst = lds0 + AT_K + wid * 1024, vdst = lds0 + AT_V + wid * 1024, mdst = lds0 + AT_MW + wid * 512;
    const unsigned kadst = lds0 + AT_KA + (wid & 1) * 1024;
#define DMA_KA(t, sl) do { if (MODE == 0 && wid < 2) { const int ln_ = lane_id();     \
        glds16((const bf16*)KA + ((size_t)(b * 8 + h) * SEQ + (t) * 64 + 32 * wid + (ln_ >> 1)) * 16 + (ln_ & 1) * 8, (unsigned)__builtin_amdgcn_readfirstlane(kadst + (sl) * 2048)); } } while (0)
#define DMA_K(t, slotb) glds16(ksrc + (long)(t) * 64 * ZP, (unsigned)__builtin_amdgcn_readfirstlane(kdst + (slotb)))
#define DMA_V(t, slotb) glds16(vsrc + (long)(t) * 64 * ZP, (unsigned)__builtin_amdgcn_readfirstlane(vdst + (slotb)))
#define DMA_M(t, sl) do { const int ln_ = lane_id(); const unsigned* msrcA = (const unsigned*)(MW + (size_t)(rowbase + q0 + wid * 64 + (ln_ & 31)) * 128) + (ln_ >> 5);     \
        glds4(msrcA + 2 * (t), (unsigned)__builtin_amdgcn_readfirstlane(mdst + (sl) * 4096)); glds4(msrcA + 32 * 256 + 2 * (t), (unsigned)__builtin_amdgcn_readfirstlane(mdst + (sl) * 4096 + 256)); } while (0)
    int t_start = 0, t_first = 0;
    if (MODE == 0) { const float* cg = cT + (size_t)(b * 8 + h) * SEQ; const float th = 2.0f * (sqrtf(((const float*)SBp)[2 * (b * 8 + h)]) * sqrtf(((const float*)SBp)[2 * (b * 8 + h) + 1]) * 1.01f + 1.0f) + 40.0f; const int ln_ = lane_id();
        const float c0 = cg[q0], cw = cg[q0 + wid * 64];
        const float ca = (ln_ < NT) ? cg[64 * ln_ + 63] : -3e38f, cb = (ln_ + 64 < NT) ? cg[64 * (ln_ + 64) + 63] : -3e38f;
        { const u64 m0 = __ballot(ca <= c0 + th), m1 = __ballot(cb <= c0 + th); t_start = m0 ? (int)__builtin_ctzll(m0) : 64 + (int)__builtin_ctzll(m1 | (1ull << 63)); }
        { const u64 m0 = __ballot(ca <= cw + th), m1 = __ballot(cb <= cw + th); t_first = m0 ? (int)__builtin_ctzll(m0) : 64 + (int)__builtin_ctzll(m1 | (1ull << 63)); }
        if (t_start > 8 * qb) t_start = 8 * qb; if (t_first > tlast) t_first = tlast; }
    DMA_K(t_start, 0); DMA_V(t_start, 0); if (MODE == 1) DMA_M(0, 0); DMA_KA(t_start, 0);
    bf16x8 qA[4], qB[4];
#pragma unroll
    for (int d0 = 0; d0 < 4; ++d0) { qA[d0] = *(const bf16x8*)(Qw + (long)r32 * ZP + d0 * 16 + hi * 8); qB[d0] = *(const bf16x8*)(Qw + (long)(32 + r32) * ZP + d0 * 16 + hi * 8); }
    float mA = 0.f, mB = 0.f, lA = 0.f, lB = 0.f;
    const unsigned qa0 = (MODE == 0 && hi == 0) ? 0xbf80bf80u : 0u; const unsigned qa1c = (MODE == 0 && hi == 0) ? 0xbf80u : 0u;
    u32x4 qaA = {qa0, qa1c, 0u, 0u}, qaB = {qa0, qa1c, 0u, 0u};
    f32x16 oA[2], oB[2]; oA[0] = f32x16{}; oA[1] = f32x16{}; oB[0] = f32x16{}; oB[1] = f32x16{};
    const int qrelA = wid * 64 + r32;
    const LAS char* kp0 = shm + AT_K + hi * 1024 + r32 * 16;
    const LAS char* vp0 = shm + AT_V + ((lane >> 4) & 1) * 32 + (lane & 3) * 8 + (4 * hi + ((lane & 15) >> 2)) * 64;
    const LAS unsigned* mwp = (const LAS unsigned*)(shm + AT_MW + wid * 512);
    const LAS char* kap0 = shm + AT_KA + r32 * 32 + hi * 16;
    int slot = 0;
#define SOFTMAX(P0, P1, MH, LR, OO, QA, QREL, WSOFF, MWOFF, PW) do { \
        if (MODE == 0) { \
            if (t == tlast) { _Pragma("unroll") for (int r = 0; r < 16; ++r) { const int kv = crow(r, hi); if (kv > (QREL) - wid * 64) P0[r] = -INFINITY; if (kv + 32 > (QREL) - wid * 64) P1[r] = -INFINITY; } } \
        } else { const unsigned mlo = mwp[slot * 1024 + (MWOFF) + r32] >> (4 * hi), mhi = mwp[slot * 1024 + (MWOFF) + 32 + r32] >> (4 * hi);     \
            _Pragma("unroll") for (int r = 0; r < 16; ++r) { const int bitp = crow(r, 0); const float p0_ = P0[r], p1_ = P1[r];     \
                const unsigned s0_ = (unsigned)__builtin_amdgcn_sbfe((int)mlo, bitp, 1), s1_ = (unsigned)__builtin_amdgcn_sbfe((int)mhi, bitp, 1);                       \
                P0[r] = __builtin_bit_cast(float, (__builtin_bit_cast(unsigned, p0_) & s0_) | (0xff800000u & ~s0_)); P1[r] = __builtin_bit_cast(float, (__builtin_bit_cast(unsigned, p1_) & s1_) | (0xff800000u & ~s1_)); } } \
        float rm = __builtin_fmaxf(__builtin_fmaxf(P0[0], P0[1]), P1[0]), rm2 = __builtin_fmaxf(__builtin_fmaxf(P0[2], P0[3]), P1[1]); rm = __builtin_fmaxf(__builtin_fmaxf(rm, P1[2]), P1[3]); \
        _Pragma("unroll") for (int r = 4; r < 16; r += 4) { rm = __builtin_fmaxf(__builtin_fmaxf(rm, P0[r]), P0[r + 1]); rm2 = __builtin_fmaxf(__builtin_fmaxf(rm2, P0[r + 2]), P0[r + 3]); rm = __builtin_fmaxf(__builtin_fmaxf(rm, P1[r]), P1[r + 1]); rm2 = __builtin_fmaxf(__builtin_fmaxf(rm2, P1[r + 2]), P1[r + 3]); } \
        rm = __builtin_fmaxf(rm, rm2); \
        rm = swapmax(rm);                            \
        if (__any(rm > 8.0f)) { const bool big_ = __builtin_fabsf(MH) + __builtin_fabsf(rm > 0.f ? rm : 0.f) > 1800.0f;     \
            const float dl = rm > 0.f ? (big_ ? 64.0f * __builtin_ceilf((MH + rm) * (1.0f / 64.0f)) - MH : 8.0f * __builtin_ceilf(rm * 0.125f)) : 0.f; const float f = __builtin_amdgcn_exp2f(-dl); LR *= f; MH += dl; \
            QA[1] = (QA[1] & 0xffffu) | ((hi == 0) ? (f2bf(-MH) << 16) : 0u); \
            _Pragma("unroll") for (int r = 0; r < 16; ++r) { P0[r] -= dl; P1[r] -= dl; } \
            if (hi == 0) wsf[(WSOFF) + r32] = f; \
            LDS_WAIT(); \
            _Pragma("unroll") for (int j = 0; j < 4; ++j) { const f32x4 ff = *(const LAS f32x4*)(wsf + (WSOFF) + 8 * j + 4 * hi); \
                _Pragma("unroll") for (int i = 0; i < 4; ++i) { OO[0][4 * j + i] *= ff[i]; OO[1][4 * j + i] *= ff[i]; } } } \
        float sacc = 0.f; \
        _Pragma("unroll") for (int r = 0; r < 16; ++r) { P0[r] = __builtin_amdgcn_exp2f(P0[r]); P1[r] = __builtin_amdgcn_exp2f(P1[r]); sacc += P0[r] + P1[r]; } \
        LR += sacc; \
        _Pragma("unroll") for (int i = 0; i < 4; ++i) { PW[0][i] = cvtpk(P0[2 * i], P0[2 * i + 1]); PW[1][i] = cvtpk(P0[8 + 2 * i], P0[8 + 2 * i + 1]); PW[2][i] = cvtpk(P1[2 * i], P1[2 * i + 1]); PW[3][i] = cvtpk(P1[8 + 2 * i], P1[8 + 2 * i + 1]); } \
    } while (0)
#define PVMM(OO, PW) do { const LAS char* vp = vp0 + slot * 8192; \
        _Pragma("unroll") for (int d0 = 0; d0 < 2; ++d0) { s16x4 lo_[4], hh_[4]; \
            _Pragma("unroll") for (int ks = 0; ks < 4; ++ks) { lo_[ks] = vtr(vp + d0 * 4096 + ks * 1024); hh_[ks] = vtr(vp + d0 * 4096 + ks * 1024 + 512); } \
            _Pragma("unroll") for (int ks = 0; ks < 4; ++ks) { const bf16x8 vf = {lo_[ks][0], lo_[ks][1], lo_[ks][2], lo_[ks][3], hh_[ks][0], hh_[ks][1], hh_[ks][2], hh_[ks][3]}; \
                OO[d0] = MFMA32(__builtin_bit_cast(bf16x8, PW[ks]), vf, OO[d0]); } } } while (0)
    for (int t = t_start; t < NT; ++t) {
        asm volatile("s_waitcnt vmcnt(0) lgkmcnt(0)\n\ts_barrier" ::: "memory");
        if (t + 1 < NT) { DMA_K(t + 1, (slot ^ 1) * 8192); DMA_V(t + 1, (slot ^ 1) * 8192); if (MODE == 1) DMA_M(t + 1, slot ^ 1); DMA_KA(t + 1, slot ^ 1); }
        if (t <= tlast && t >= t_first) {
            f32x16 a0 = {}, a1 = {}, b0 = {}, b1 = {};
            { const LAS char* kb = kp0 + slot * 8192;
#pragma unroll
              for (int d0 = 0; d0 < 4; ++d0) { const bf16x8 k0 = *(const LAS bf16x8*)(kb + d0 * 2048), k1 = *(const LAS bf16x8*)(kb + d0 * 2048 + 512);
                  a0 = MFMA32(k0, qA[d0], a0); a1 = MFMA32(k1, qA[d0], a1); b0 = MFMA32(k0, qB[d0], b0); b1 = MFMA32(k1, qB[d0], b1); }
              bf16x8 x0, x1;
              if (MODE == 0) { x0 = *(const LAS bf16x8*)(kap0 + slot * 2048); x1 = *(const LAS bf16x8*)(kap0 + slot * 2048 + 1024); }
              else { const u32x4 cw = {0u, (hi == 0) ? 0x3f800000u : 0u, 0u, 0u}; x0 = __builtin_bit_cast(bf16x8, cw); x1 = x0; }
              a0 = MFMA32(x0, __builtin_bit_cast(bf16x8, qaA), a0); a1 = MFMA32(x1, __builtin_bit_cast(bf16x8, qaA), a1); b0 = MFMA32(x0, __builtin_bit_cast(bf16x8, qaB), b0); b1 = MFMA32(x1, __builtin_bit_cast(bf16x8, qaB), b1); }
            u32x4 pwA[4], pwB[4];
            SOFTMAX(a0, a1, mA, lA, oA, qaA, qrelA, 0, 0, pwA);
            PVMM(oA, pwA);
            SOFTMAX(b0, b1, mB, lB, oB, qaB, qrelA + 32, 32, 64, pwB);
            PVMM(oB, pwB);
        }
        slot ^= 1;
    }
#define EPILOG(OO, LR, WSOFF, ROWOFF) do { float l_ = swapsum(LR); if (hi == 0) wsf[64 + (WSOFF) + r32] = l_; LDS_WAIT(); float rli[16]; \
        _Pragma("unroll") for (int r = 0; r < 16; ++r) rli[r] = __builtin_amdgcn_rcpf(wsf[64 + (WSOFF) + crow(r, hi)]); \
        bf16* Ow = Ob + (rowbase + q0 + wid * 64 + (ROWOFF)) * OP + OC + h * 64; LAS bf16* stg = (LAS bf16*)(shm + AT_OST) + wid * 2048; \
        _Pragma("unroll") for (int r = 0; r < 16; ++r) { const int orow = crow(r, hi); _Pragma("unroll") for (int d0 = 0; d0 < 2; ++d0) stg[orow * 64 + d0 * 32 + r32] = (bf16)f2bf(OO[d0][r] * rli[r]); } \
        LDS_WAIT(); \
        _Pragma("unroll") for (int i = 0; i < 4; ++i) { const int row = i * 8 + (lane >> 3), ch = lane & 7; const u32x4 v = *(const LAS u32x4*)(stg + row * 64 + ch * 8); *(u32x4*)(Ow + (long)row * OP + ch * 8) = v; } \
        LDS_WAIT(); } while (0)
    EPILOG(oA, lA, 0, 0);
    EPILOG(oB, lB, 32, 32);
    asm volatile("s_waitcnt lgkmcnt(0)\n\ts_barrier" ::: "memory");
#undef DMA_K
#undef DMA_V
#undef DMA_M
#undef DMA_KA
#undef SOFTMAX
#undef PVMM
#undef EPILOG
}

__device__ __forceinline__ void attn_phase(KP p, int l, LAS unsigned char* lds, int vcu, int G, int wv) {
    unsigned char* ws = p->ws; const bf16* Z = (const bf16*)(ws + WS_Z); bf16* Ob = (bf16*)(ws + WS_OBUF); const float* cT = (const float*)(ws + WS_CT); const u64* MW = (const u64*)(ws + WS_MASKW);
    for (int U = vcu; U < 1024; U += G) {
        const int v = U & 255, i4 = U >> 8; const int mode = i4 & 1, k = i4 >> 1; const int bh = v >> 3, s = v & 7;
        const int qb = (k == 0) ? s : 15 - s;
        if (mode == 0) attn_unit<0>(bh >> 3, bh & 7, qb, Z, Ob, cT, MW, (const void*)(ws + WS_KA), (const void*)((const unsigned*)(ws + WS_CTL) + CW_SB + l * 64), (LAS char*)lds, wv);
        else attn_unit<1>(bh >> 3, bh & 7, qb, Z, Ob, cT, MW, (const void*)(ws + WS_KA), (const void*)((const unsigned*)(ws + WS_CTL) + CW_SB + l * 64), (LAS char*)lds, wv);
    }
}

constexpr int HG_LF = 0, HG_KK = 16640, HG_SEG = 33280, HG_P = 35328, HG_R = HG_P + 9216, HG_RT = HG_R + 9216, HG_VT = HG_RT + 9216, HG_ST = HG_VT + 9216, HG_CG = HG_ST + 9216, HG_END = HG_CG + 9216;
static_assert(HG_END <= SCR_BYTES, "hgrn LDS");
constexpr int HP = 72;

__device__ __forceinline__ void hgrn_front(KP p, int l, const unsigned short (&zf)[8], int h, int d, int seg, LAS float* SEG, float (&kk)[8], float (&bb)[8], float& bm, float& bl) {
    const int dd = h * 64 + d; const float lb = (l == 0) ? 0.f : sigmoidf_(p->lb_logits[512 + dd] - p->lb_logits[dd]);
    float run = 0.f;
#pragma unroll
    for (int i = 0; i < 8; ++i) { const float sg = sigmoidf_(bf2f(zf[i])); const float f = lb + (1.f - lb) * sg; kk[i] = (1.f - lb) * (1.f - sg); run += __logf(f); bb[i] = run; }
    SEG[seg * 64 + d] = run;
    WG_BAR_LDS();
    float pre = 0.f, m4 = 0.f, all = 0.f;
#pragma unroll
    for (int s2 = 0; s2 < 8; ++s2) { const float sv = SEG[s2 * 64 + d]; if (s2 < seg) pre += sv; if (s2 < 4) m4 += sv; all += sv; }
#pragma unroll
    for (int i = 0; i < 8; ++i) bb[i] += pre;
    bm = m4; bl = all;
}

#define H_ROWP(U_) (Z + (size_t)((((U_) >> 7) >> 3) * SEQ + ((U_) & 127) * 64 + 8 * seg) * ZP + (((U_) >> 7) & 7) * 64 + d)
__device__ __forceinline__ void h1_phase(KP p, int l, LAS unsigned char* lds, int vcu, int G, int tid, int wave, int lane) {
    unsigned char* ws = p->ws; const bf16* Z = (const bf16*)(ws + WS_Z); float* Ug = (float*)(ws + WS_UG); float* Dg = (float*)(ws + WS_DG); float* D2g = (float*)(ws + WS_D2G);
    LAS float* SEG = (LAS float*)(lds + HG_SEG); LAS bf16* RT = (LAS bf16*)(lds + HG_RT); LAS bf16* VT = (LAS bf16*)(lds + HG_VT);
    const int r32 = lane & 31, hi = lane >> 5; const int d = tid & 63, seg = tid >> 6;
    for (int U = vcu; U < 4096; U += G) {
        const int bh = U >> 7, h = bh & 7; const bf16* rp = H_ROWP(U);
        unsigned short zf[8], vv[8];
#pragma unroll
        for (int i = 0; i < 8; ++i) { zf[i] = rp[(size_t)i * ZP + Z_CF]; vv[i] = rp[(size_t)i * ZP + Z_CI]; }
        float kk[8], bb[8], bm, bl; hgrn_front(p, l, zf, h, d, seg, SEG, kk, bb, bm, bl);
        { unsigned rw[4], vw[4];
#pragma unroll
          for (int i = 0; i < 4; ++i) { rw[i] = pk2(kk[2 * i] * __expf(fminf(bm - bb[2 * i], 80.f)), kk[2 * i + 1] * __expf(fminf(bm - bb[2 * i + 1], 80.f))); vw[i] = (unsigned)vv[2 * i] | ((unsigned)vv[2 * i + 1] << 16); }
          *(LAS u32x4*)(RT + d * HP + 8 * seg) = (u32x4){rw[0], rw[1], rw[2], rw[3]}; *(LAS u32x4*)(VT + d * HP + 8 * seg) = (u32x4){vw[0], vw[1], vw[2], vw[3]}; }
        if (seg == 7) { Dg[(size_t)U * 64 + d] = __expf(bl); D2g[(size_t)U * 64 + d] = __expf(bl - bm); }
        WG_BAR_LDS();
        if (wave < 4) { const int ib = wave >> 1, jb = wave & 1; f32x16 acc = {};
#pragma unroll
            for (int ks = 0; ks < 4; ++ks) { const bf16x8 a = *(const LAS bf16x8*)(RT + (32 * ib + r32) * HP + 16 * ks + 8 * hi), bq = *(const LAS bf16x8*)(VT + (32 * jb + r32) * HP + 16 * ks + 8 * hi);
                acc = MFMA32(a, bq, acc); }
            float* up = Ug + ((size_t)U * 64 + 32 * jb + r32) * 64 + 32 * ib + 4 * hi;
#pragma unroll
            for (int rr = 0; rr < 4; ++rr) *(f32x4*)(up + 8 * rr) = (f32x4){acc[4 * rr], acc[4 * rr + 1], acc[4 * rr + 2], acc[4 * rr + 3]}; }
        WG_BAR_LDS();
    }
}

__device__ __forceinline__ void h2_phase(KP p, int G, int tid) {
    unsigned char* ws = p->ws; const float* Ug = (const float*)(ws + WS_UG); const float* Dg = (const float*)(ws + WS_DG); const float* D2g = (const float*)(ws + WS_D2G); bf16* Sst = (bf16*)(ws + WS_SST);
    for (int gid = blockIdx.x * NTHR + tid; gid < 32 * 4096; gid += G * NTHR) {
        const int bh = gid >> 12, ed = gid & 4095, d = ed & 63; float S = 0.f;
        const float* up = Ug + (size_t)bh * 128 * 4096 + ed; const float* dp = Dg + (size_t)bh * 128 * 64 + d; const float* d2p = D2g + (size_t)bh * 128 * 64 + d; bf16* sp = Sst + (size_t)bh * 128 * 4096 + ed;
        for (int c0 = 0; c0 < 128; c0 += 8) { float u[8], dd[8], d2[8];
#pragma unroll
            for (int i = 0; i < 8; ++i) { u[i] = up[(size_t)(c0 + i) * 4096]; dd[i] = dp[(c0 + i) * 64]; d2[i] = d2p[(c0 + i) * 64]; }
#pragma unroll
            for (int i = 0; i < 8; ++i) { sp[(size_t)(c0 + i) * 4096] = (bf16)f2bf(S); S = dd[i] * S + d2[i] * u[i]; } }
    }
}

__device__ __forceinline__ void h3_phase(KP p, int l, LAS unsigned char* lds, int vcu, int G, int tid, int wave, int lane) {
    unsigned char* ws = p->ws; const bf16* Z = (const bf16*)(ws + WS_Z); const bf16* Sst = (const bf16*)(ws + WS_SST); bf16* Ob = (bf16*)(ws + WS_OBUF);
    LAS float* SEG = (LAS float*)(lds + HG_SEG);
    LAS bf16* Pt = (LAS bf16*)(lds + HG_P); LAS bf16* Rt = (LAS bf16*)(lds + HG_R); LAS bf16* VT = (LAS bf16*)(lds + HG_VT); LAS bf16* ST = (LAS bf16*)(lds + HG_ST); LAS bf16* CG = (LAS bf16*)(lds + HG_CG);
    const int r32 = lane & 31, hi = lane >> 5; const int d = tid & 63, seg = tid >> 6;
    const float* gn = p->norm_g + l * 512;
    for (int U = vcu; U < 4096; U += G) {
        const int bh = U >> 7, c = U & 127, b = bh >> 3, h = bh & 7; const int t0 = b * SEQ + c * 64; const bf16* rp = H_ROWP(U);
        unsigned short zf[8], qv[8], vv[8], gg[8], sv[8];
#pragma unroll
        for (int i = 0; i < 8; ++i) { zf[i] = rp[(size_t)i * ZP + Z_CF]; qv[i] = rp[(size_t)i * ZP + Z_CQ]; vv[i] = rp[(size_t)i * ZP + Z_CI]; gg[i] = rp[(size_t)i * ZP + Z_CG]; sv[i] = Sst[(size_t)U * 4096 + (8 * seg + i) * 64 + d]; }
        float kk[8], bb[8], bm, bl; hgrn_front(p, l, zf, h, d, seg, SEG, kk, bb, bm, bl); (void)bl;
        { const float ebm = __expf(bm); unsigned vw[4];
#pragma unroll
          for (int i = 0; i < 8; ++i) { const int t = 8 * seg + i;
              Pt[t * HP + d] = (bf16)f2bf(bf2f(qv[i]) * __expf(fminf(bb[i] - bm, 80.f))); Rt[t * HP + d] = (bf16)f2bf(kk[i] * __expf(fminf(bm - bb[i], 80.f)));
              ST[t * HP + d] = (bf16)f2bf(bf2f(sv[i]) * ebm); CG[t * HP + d] = (bf16)gg[i]; }
#pragma unroll
          for (int i = 0; i < 4; ++i) vw[i] = (unsigned)vv[2 * i] | ((unsigned)vv[2 * i + 1] << 16);
          *(LAS u32x4*)(VT + d * HP + 8 * seg) = (u32x4){vw[0], vw[1], vw[2], vw[3]}; }
        WG_BAR_LDS();
        if (wave < 2) { const int ib = wave;
            u32x4 pw[2][2];
#pragma unroll
            for (int k = 0; k < 2; ++k) { f32x16 a = {};
                if (k <= ib) {
#pragma unroll
                    for (int js = 0; js < 4; ++js) { const bf16x8 ra = *(const LAS bf16x8*)(Rt + (32 * k + r32) * HP + 16 * js + 8 * hi), pb = *(const LAS bf16x8*)(Pt + (32 * ib + r32) * HP + 16 * js + 8 * hi);
                        a = MFMA32(ra, pb, a); }
                    if (k == ib) {
#pragma unroll
                        for (int r = 0; r < 16; ++r) if (crow(r, hi) > r32) a[r] = 0.f;
                    }
                }
#pragma unroll
                for (int i = 0; i < 4; ++i) { pw[k][0][i] = cvtpk(a[2 * i], a[2 * i + 1]); pw[k][1][i] = cvtpk(a[8 + 2 * i], a[8 + 2 * i + 1]); } }
            f32x16 oacc[2]; float ss = 0.f;
#pragma unroll
            for (int j = 0; j < 2; ++j) { f32x16 oa = {};
#pragma unroll
                for (int k = 0; k < 2; ++k) { if (k <= ib) {
#pragma unroll
                    for (int st = 0; st < 2; ++st) { const LAS bf16* vp = VT + (32 * j + r32) * HP + 32 * k + 16 * st + 4 * hi;
                        const s16x4 v0 = *(const LAS s16x4*)vp, v1 = *(const LAS s16x4*)(vp + 8);
                        const bf16x8 vf = {v0[0], v0[1], v0[2], v0[3], v1[0], v1[1], v1[2], v1[3]};
                        oa = MFMA32(vf, __builtin_bit_cast(bf16x8, pw[k][st]), oa); } } }
#pragma unroll
                for (int js = 0; js < 4; ++js) { const bf16x8 sa = *(const LAS bf16x8*)(ST + (32 * j + r32) * HP + 16 * js + 8 * hi), pb = *(const LAS bf16x8*)(Pt + (32 * ib + r32) * HP + 16 * js + 8 * hi);
                    oa = MFMA32(sa, pb, oa); }
#pragma unroll
                for (int r = 0; r < 16; ++r) ss += oa[r] * oa[r];
                oacc[j] = oa; }
            ss = swapsum(ss);
            const float rstd = 1.0f / sqrtf(ss * (1.0f / 64.0f) + RMS_EPS);
            bf16* orow = Ob + (size_t)(t0 + 32 * ib + r32) * OP + 1024 + h * 64;
#pragma unroll
            for (int j = 0; j < 2; ++j)
#pragma unroll
                for (int rr = 0; rr < 4; ++rr) { const int e0 = 32 * j + 8 * rr + 4 * hi; const f32x4 g4 = *(const f32x4*)(gn + h * 64 + e0);
                    const u32x2 cw = *(const LAS u32x2*)(CG + (32 * ib + r32) * HP + e0);
                    const float o0 = oacc[j][4 * rr] * rstd * g4[0] * sigmoidf_(bflo(cw.x)), o1 = oacc[j][4 * rr + 1] * rstd * g4[1] * sigmoidf_(bfhi(cw.x));
                    const float o2 = oacc[j][4 * rr + 2] * rstd * g4[2] * sigmoidf_(bflo(cw.y)), o3 = oacc[j][4 * rr + 3] * rstd * g4[3] * sigmoidf_(bfhi(cw.y));
                    *(u32x2*)(orow + e0) = (u32x2){cvtpk(o0, o1), cvtpk(o2, o3)}; }
        }
        WG_BAR_LDS();
    }
}

#undef H_ROWP
constexpr int RT_LG = 0, RT_HIST = 8 * 2048, RT_END = RT_HIST + 1024;
static_assert(RT_END <= SCR_BYTES, "router LDS");
typedef short bf16x8_t __attribute__((ext_vector_type(8)));
__device__ __forceinline__ void split_hi_lo(const f32x4 a, const f32x4 b, bf16x8_t& hi, bf16x8_t& lo) {
    const float v[8] = {a.x, a.y, a.z, a.w, b.x, b.y, b.z, b.w}; unsigned h[8], l[8];
#pragma unroll
    for (int i = 0; i < 8; ++i) { h[i] = f2bf(v[i]); l[i] = f2bf(v[i] - bf2f(h[i])); }
    const u32x4 hw = {h[0] | (h[1] << 16), h[2] | (h[3] << 16), h[4] | (h[5] << 16), h[6] | (h[7] << 16)}, lw = {l[0] | (l[1] << 16), l[2] | (l[3] << 16), l[4] | (l[5] << 16), l[6] | (l[7] << 16)};
    hi = __builtin_bit_cast(bf16x8_t, hw); lo = __builtin_bit_cast(bf16x8_t, lw);
}
__device__ __forceinline__ void ln1_phase(KP p, int l, const float* xin, LAS unsigned char* lds, int G, int tid, int wave, int lane) {
    unsigned char* ws = p->ws; const bf16* mix = (const bf16*)(ws + WS_MIX); float* x1 = (float*)(ws + WS_X1); bf16* x1b = (bf16*)(ws + WS_X1B);
    int* tke = (int*)(ws + WS_TKE); float* tkg = (float*)(ws + WS_TKG); int* wgcnt = (int*)(ws + WS_WGCNT);
    LAS float* LG = (LAS float*)(lds + RT_LG) + wave * 512; LAS unsigned* hist = (LAS unsigned*)(lds + RT_HIST);
    if (tid < 32) hist[tid] = 0u;
    WG_BAR();
    const float* lg = p->ln1_g + l * 1024; const float* lb = p->ln1_b + l * 1024;
    f32x4 gv[4], bv[4];
#pragma unroll
    for (int j = 0; j < 4; ++j) { gv[j] = *(const f32x4*)(lg + 4 * lane + 256 * j); bv[j] = *(const f32x4*)(lb + 4 * lane + 256 * j); }
    const int m0 = blockIdx.x * NWAVES + wave, mstride = G * NWAVES;
    for (int mb = m0; mb < NTOK; mb += 16 * mstride) {
        f32x4 xa[4], xm[4];
#define LOAD_XIN(mm) do { if (l == 0) { const f32x4* xr = (const f32x4*)(xin + (size_t)(mm) * DM) + lane; _Pragma("unroll") for (int j = 0; j < 4; ++j) xa[j] = xr[64 * j]; } \
            else { const u32x2* xr = (const u32x2*)((const bf16*)(ws + WS_XB) + (size_t)(mm) * DM) + lane; _Pragma("unroll") for (int j = 0; j < 4; ++j) { const u32x2 w = xr[64 * j]; xa[j] = (f32x4){bflo(w.x), bfhi(w.x), bflo(w.y), bfhi(w.y)}; } } } while (0)
        { LOAD_XIN(mb); const u32x2* mr = (const u32x2*)(mix + (size_t)mb * DM) + lane;
#pragma unroll
          for (int j = 0; j < 4; ++j) { const u32x2 w = mr[64 * j]; xm[j] = (f32x4){bflo(w.x), bfhi(w.x), bflo(w.y), bfhi(w.y)}; } }
#pragma unroll 1
        for (int i = 0; i < 16; ++i) { const int m = mb + i * mstride; if (m >= NTOK) break;
            f32x4 v[4]; float s = 0.f;
#pragma unroll
            for (int j = 0; j < 4; ++j) { v[j] = xa[j] * ALPHA + xm[j]; s += (v[j].x + v[j].y) + (v[j].z + v[j].w); }
            { const int mn = (m + mstride < NTOK) ? m + mstride : m;
              LOAD_XIN(mn); const u32x2* mr = (const u32x2*)(mix + (size_t)mn * DM) + lane;
#pragma unroll
              for (int j = 0; j < 4; ++j) { const u32x2 w = mr[64 * j]; xm[j] = (f32x4){bflo(w.x), bfhi(w.x), bflo(w.y), bfhi(w.y)}; } }
            const float mean = wave_sum(s) * (1.f / DM); float s2 = 0.f;
#pragma unroll
            for (int j = 0; j < 4; ++j) { v[j] = v[j] - mean; s2 += (v[j].x * v[j].x + v[j].y * v[j].y) + (v[j].z * v[j].z + v[j].w * v[j].w); }
            const float rstd = 1.f / sqrtf(wave_sum(s2) * (1.f / DM) + LN_EPS);
            f32x4* o4 = (f32x4*)(x1 + (size_t)m * DM) + lane; unsigned* o1 = (unsigned*)((unsigned char*)x1b + (size_t)m * DM) + lane;
#pragma unroll
            for (int j = 0; j < 4; ++j) { v[j] = v[j] * rstd * gv[j] + bv[j]; o4[64 * j] = v[j]; int w8 = __builtin_amdgcn_cvt_pk_fp8_f32(v[j].x, v[j].y, 0, false); w8 = __builtin_amdgcn_cvt_pk_fp8_f32(v[j].z, v[j].w, w8, true); o1[64 * j] = (unsigned)w8; } }
        asm volatile("s_waitcnt vmcnt(0)" ::: "memory"); __builtin_amdgcn_fence(__ATOMIC_ACQUIRE, "agent"); asm volatile("s_waitcnt vmcnt(0)" ::: "memory");
        { const int ti = lane & 15, kg = lane >> 4; int mt = mb + ti * mstride; if (mt >= NTOK) mt = mb;
          const float* xr = x1 + (size_t)mt * DM + 8 * kg; const bf16* wf = (const bf16*)(ws + WS_WRF) + (size_t)l * 32 * 2 * 2 * 512 + lane * 8;
          f32x4 acc0 = {0.f, 0.f, 0.f, 0.f}, acc1 = {0.f, 0.f, 0.f, 0.f};
#pragma unroll 4
          for (int s = 0; s < 32; ++s) { const f32x4 a0 = *(const f32x4*)(xr + 32 * s), a1 = *(const f32x4*)(xr + 32 * s + 4); bf16x8_t ah, al; split_hi_lo(a0, a1, ah, al);
              const bf16x8_t w0h = *(const bf16x8_t*)(wf + (size_t)(s * 4 + 0) * 512), w0l = *(const bf16x8_t*)(wf + (size_t)(s * 4 + 1) * 512), w1h = *(const bf16x8_t*)(wf + (size_t)(s * 4 + 2) * 512), w1l = *(const bf16x8_t*)(wf + (size_t)(s * 4 + 3) * 512);
              acc0 = __builtin_amdgcn_mfma_f32_16x16x32_bf16(ah, w0h, acc0, 0, 0, 0); acc0 = __builtin_amdgcn_mfma_f32_16x16x32_bf16(al, w0h, acc0, 0, 0, 0); acc0 = __builtin_amdgcn_mfma_f32_16x16x32_bf16(ah, w0l, acc0, 0, 0, 0);
              acc1 = __builtin_amdgcn_mfma_f32_16x16x32_bf16(ah, w1h, acc1, 0, 0, 0); acc1 = __builtin_amdgcn_mfma_f32_16x16x32_bf16(al, w1h, acc1, 0, 0, 0); acc1 = __builtin_amdgcn_mfma_f32_16x16x32_bf16(ah, w1l, acc1, 0, 0, 0); }
#pragma unroll
          for (int r = 0; r < 4; ++r) { LG[(4 * kg + r) * 32 + ti] = acc0[r]; LG[(4 * kg + r) * 32 + 16 + ti] = acc1[r]; } }
        LDS_WAIT();
        if (lane < 16) { const int m = mb + lane * mstride;
            if (m < NTOK) { float tv0 = -3e38f, tv1 = -3e38f, tv2 = -3e38f, tv3 = -3e38f; int ti0 = 0, ti1 = 0, ti2 = 0, ti3 = 0;
#pragma unroll
                for (int e4 = 0; e4 < 8; ++e4) { const f32x4 lv = *(const LAS f32x4*)(LG + lane * 32 + 4 * e4); const f32x4 bb = *(const f32x4*)(p->b_router + l * 32 + 4 * e4);
#pragma unroll
                    for (int i = 0; i < 4; ++i) { const float g = lv[i] + bb[i]; const int e = 4 * e4 + i;
                        if (g > tv0) { tv3 = tv2; ti3 = ti2; tv2 = tv1; ti2 = ti1; tv1 = tv0; ti1 = ti0; tv0 = g; ti0 = e; }
                        else if (g > tv1) { tv3 = tv2; ti3 = ti2; tv2 = tv1; ti2 = ti1; tv1 = g; ti1 = e; }
                        else if (g > tv2) { tv3 = tv2; ti3 = ti2; tv2 = g; ti2 = e; }
                        else if (g > tv3) { tv3 = g; ti3 = e; } } }
                const float e1 = __expf(tv1 - tv0), e2 = __expf(tv2 - tv0), e3 = __expf(tv3 - tv0); const float inv = 1.f / (1.f + e1 + e2 + e3);
                *(int4*)(tke + m * 4) = make_int4(ti0, ti1, ti2, ti3); *(f32x4*)(tkg + m * 4) = (f32x4){inv, e1 * inv, e2 * inv, e3 * inv};
                __hip_atomic_fetch_add(hist + ti0, 1u, __ATOMIC_RELAXED, __HIP_MEMORY_SCOPE_WORKGROUP); __hip_atomic_fetch_add(hist + ti1, 1u, __ATOMIC_RELAXED, __HIP_MEMORY_SCOPE_WORKGROUP);
                __hip_atomic_fetch_add(hist + ti2, 1u, __ATOMIC_RELAXED, __HIP_MEMORY_SCOPE_WORKGROUP); __hip_atomic_fetch_add(hist + ti3, 1u, __ATOMIC_RELAXED, __HIP_MEMORY_SCOPE_WORKGROUP); } }
        LDS_WAIT();
    }
    WG_BAR();
    if (tid < 32) wgcnt[blockIdx.x * 32 + tid] = (int)hist[tid];
}

__device__ __forceinline__ void slot_phase(KP p, LAS unsigned char* lds, int G, int tid, int wave, int lane) {
    unsigned char* ws = p->ws; const int* wgcnt = (const int*)(ws + WS_WGCNT); int* blk = (int*)(ws + WS_BLK);
    const int* tke = (const int*)(ws + WS_TKE); const float* tkg = (const float*)(ws + WS_TKG); int* tokslot = (int*)(ws + WS_TOKSLOT); float* gslot = (float*)(ws + WS_GSLOT);
    LAS unsigned* tot = (LAS unsigned*)lds; LAS unsigned* mine = tot + 32; LAS unsigned* cur = tot + 64;
    if (tid < 96) tot[tid] = 0u;
    WG_BAR();
    { const int e = tid & 31, part = tid >> 5; unsigned sa = 0u, sb = 0u;
      for (int w = part; w < G; w += 16) { const unsigned c = (unsigned)wgcnt[w * 32 + e]; sa += c; if (w < (int)blockIdx.x) sb += c; }
      __hip_atomic_fetch_add(tot + e, sa, __ATOMIC_RELAXED, __HIP_MEMORY_SCOPE_WORKGROUP); __hip_atomic_fetch_add(mine + e, sb, __ATOMIC_RELAXED, __HIP_MEMORY_SCOPE_WORKGROUP); }
    WG_BAR();
    if (tid == 0) { unsigned off = 0u;
#pragma unroll 1
        for (int e = 0; e < 32; ++e) { const unsigned padded = (tot[e] + 255u) & ~255u; cur[e] = off + mine[e];
            if (blockIdx.x == 0) { blk[BST_OFF + e] = (int)(off >> 8);
#pragma unroll 1
                for (unsigned bb = off >> 8; bb < ((off + padded) >> 8); ++bb) blk[16 + bb] = e; }
            off += padded; }
        if (blockIdx.x == 0) { blk[0] = (int)(off >> 8); blk[BST_OFF + 32] = (int)(off >> 8); } }
    WG_BAR();
    int* slottok = (int*)(ws + WS_SLOTTOK);
    if (blockIdx.x == 0 && tid < 32) { const unsigned ps = cur[tid], n = tot[tid];
        int zero_ = 0; asm volatile("" : "+v"(zero_));
#pragma unroll 1
        for (unsigned s = ps + n; s < ps + ((n + 255u) & ~255u); ++s) slottok[s] = zero_; }
    WG_BAR();
    for (int m = blockIdx.x * NWAVES + wave; m < NTOK; m += G * NWAVES) {
        if (lane < 4) { const int e = tke[m * 4 + lane]; const int slot = (int)__hip_atomic_fetch_add(cur + e, 1u, __ATOMIC_RELAXED, __HIP_MEMORY_SCOPE_WORKGROUP); tokslot[m * 4 + lane] = slot; gslot[slot] = tkg[m * 4 + lane]; slottok[slot] = m; }
    }
}

__device__ __forceinline__ void comb_phase(KP p, int l, float* xout, int G, int wave, int lane) {
    unsigned char* ws = p->ws; const float* x1 = (const float*)(ws + WS_X1); const bf16* y = (const bf16*)(ws + WS_Y); const int* tokslot = (const int*)(ws + WS_TOKSLOT); bf16* xb = (bf16*)(ws + WS_XB);
    const float* lg = p->ln2_g + l * 1024; const float* lb = p->ln2_b + l * 1024;
    f32x4 gv[4], bv[4];
#pragma unroll
    for (int j = 0; j < 4; ++j) { gv[j] = *(const f32x4*)(lg + 4 * lane + 256 * j); bv[j] = *(const f32x4*)(lb + 4 * lane + 256 * j); }
    for (int m = blockIdx.x * NWAVES + wave; m < NTOK; m += G * NWAVES) {
        const f32x4* xr = (const f32x4*)(x1 + (size_t)m * DM) + lane;
        f32x4 v[4];
#pragma unroll
        for (int j = 0; j < 4; ++j) v[j] = xr[64 * j] * ALPHA;
#pragma unroll
        for (int k = 0; k < 4; ++k) { const int sk = __builtin_amdgcn_readfirstlane(tokslot[m * 4 + k]); const u32x2* yr = (const u32x2*)(y + (size_t)sk * DM) + lane;
#pragma unroll
            for (int j = 0; j < 4; ++j) { const u32x2 w = yr[64 * j]; v[j].x += bflo(w.x); v[j].y += bfhi(w.x); v[j].z += bflo(w.y); v[j].w += bfhi(w.y); } }
        float s = 0.f;
#pragma unroll
        for (int j = 0; j < 4; ++j) s += (v[j].x + v[j].y) + (v[j].z + v[j].w);
        const float mean = wave_sum(s) * (1.f / DM); float s2 = 0.f;
#pragma unroll
        for (int j = 0; j < 4; ++j) { v[j] = v[j] - mean; s2 += (v[j].x * v[j].x + v[j].y * v[j].y) + (v[j].z * v[j].z + v[j].w * v[j].w); }
        const float rstd = 1.f / sqrtf(wave_sum(s2) * (1.f / DM) + LN_EPS);
        f32x4* o4 = (f32x4*)(xout + (size_t)m * DM) + lane; u32x2* o2 = (u32x2*)(xb + (size_t)m * DM) + lane;
#pragma unroll
        for (int j = 0; j < 4; ++j) { v[j] = v[j] * rstd * gv[j] + bv[j]; if (l == DEPTH - 1) o4[64 * j] = v[j]; else { o2[64 * j] = (u32x2){pk2(v[j].x, v[j].y), pk2(v[j].z, v[j].w)};
            int w8 = __builtin_amdgcn_cvt_pk_fp8_f32(v[j].x, v[j].y, 0, false); w8 = __builtin_amdgcn_cvt_pk_fp8_f32(v[j].z, v[j].w, w8, true); ((unsigned*)(ws + WS_XB8 + (size_t)m * DM))[lane + 64 * j] = (unsigned)w8; } }
    }
}

#ifndef ONE_LAUNCH
#define ONE_LAUNCH 1
#endif
__global__ void __launch_bounds__(NTHR, 2) fwd(Params p) {
    extern __shared__ __attribute__((aligned(16))) unsigned char lds_raw[];
    LAS unsigned char* lds = (LAS unsigned char*)lds_raw;
    volatile LAS unsigned* MISC = (volatile LAS unsigned*)(lds + MISC_OFF);
    const int tid = threadIdx.x, lane = tid & 63, wave = __builtin_amdgcn_readfirstlane(tid >> 6); const int wave0 = wave;
    const int G = gridDim.x; const int bx = blockIdx.x; const int vcu = (G % 8 == 0) ? (bx % 8) * (G / 8) + bx / 8 : bx;
    if (tid < 64) MISC[tid] = 0u;
    __syncthreads();
    if (p.use_bar) (void)xcd_barrier_post((unsigned*)(p.ws + WS_CTL) + CW_BAR, MISC + 8);
    const int lo = p.ph_lo, hi = p.ph_hi;
#ifndef PHSEL
#define PHSEL(k) true
#endif
#define IN(k) (PHSEL(k) && lo <= (k) && (k) < hi)
#define SEAM(k) do { if (lo <= (k) && (k) + 1 < hi) { KP qb_ = load_params(); XcdBarrier b_; b_.bar = (unsigned*)(qb_->ws + WS_CTL) + CW_BAR; b_.x = xb_xcc_id(); b_.st = MISC + 8; xcd_barrier(b_); } } while (0)
    const int gw0 = vcu * NWAVES + wave, NGW = G * NWAVES;
#define PH_IDS const int lane = lane_id(), wave = wave0, tid = wave0 * 64 + lane, gw = vcu * NWAVES + wave; (void)lane; (void)gw; (void)gw0;

    if (IN(0)) { PH_IDS KP q = load_params(); p0_prologue(q, lds, gw, NGW, wave, lane); SEAM(0); }

    for (int l = 0; l < DEPTH; ++l) {
        const int pb = 1 + l * NPH_LAYER;

        if (IN(pb + PH_INPROJ)) {
            KP q = load_params(); unsigned char* w = q->ws;
            pg8::Gemm g{(const bf16*)(w + WS_XB8), (const bf16*)(w + WS_WIN + (size_t)l * ZP * 1024), NTOK, ZP, 1024}; pg8::StaticOrder S; S.init(NTOK, ZP, G, bx);
            pg8::EpiZ E{(bf16*)(w + WS_Z), ZP, (const float*)(w + WS_TRIG), (bf16*)(w + WS_IKC)};
            pg8::gemm_phase<pg8::EpiZ, pg8::StaticOrder, true, true, true, W8_E8M0>(lds, g, S, E, wave0);
            SEAM(pb + PH_INPROJ);
        }
        if (IN(pb + PH_IDX)) { PH_IDS KP q = load_params(); idx_phase(q, l, lds, vcu, G, tid, wave, lane); SEAM(pb + PH_IDX); }
        if (IN(pb + PH_ATTN)) { PH_IDS KP q = load_params(); attn_phase(q, l, lds, vcu, G, wave0); SEAM(pb + PH_ATTN); }
        if (IN(pb + PH_H1)) { PH_IDS KP q = load_params(); h1_phase(q, l, lds, vcu, G, tid, wave, lane); SEAM(pb + PH_H1); }
        if (IN(pb + PH_H2)) { PH_IDS KP q = load_params(); h2_phase(q, G, tid); SEAM(pb + PH_H2); }
        if (IN(pb + PH_H3)) { PH_IDS KP q = load_params(); h3_phase(q, l, lds, vcu, G, tid, wave, lane); SEAM(pb + PH_H3); }
        if (IN(pb + PH_MERGE)) {
            KP q = load_params(); unsigned char* w = q->ws;
            pg8::Gemm g{(const bf16*)(w + WS_OBUF), (const bf16*)(w + WS_WP) + (size_t)l * 1024 * 1536, NTOK, 1024, 1536}; pg8::StaticOrder S; S.init(NTOK, 1024, G, bx);
            pg8::EpiMerge E{(const bf16*)(w + WS_Z) + Z_GT, ZP, (bf16*)(w + WS_MERGED), 1024};
            pg8::gemm_phase<pg8::EpiMerge, pg8::StaticOrder, true, true>(lds, g, S, E, wave0);
            SEAM(pb + PH_MERGE);
        }
        if (IN(pb + PH_WOUT)) {
            KP q = load_params(); unsigned char* w = q->ws;
            pg8::Gemm g{(const bf16*)(w + WS_MERGED), (const bf16*)(w + WS_WOUT) + (size_t)l * 1024 * 1024, NTOK, 1024, 1024}; pg8::StaticOrder S; S.init(NTOK, 1024, G, bx);
            pg8::EpiBf16 E{(bf16*)(w + WS_MIX), 1024};
            pg8::gemm_phase<pg8::EpiBf16, pg8::StaticOrder, true, true>(lds, g, S, E, wave0);
            SEAM(pb + PH_WOUT);
        }
        if (IN(pb + PH_LN1)) { PH_IDS KP q = load_params(); const float* xin = (l == 0) ? q->x : (const float*)(q->ws + WS_XCUR); ln1_phase(q, l, xin, lds, G, tid, wave, lane); SEAM(pb + PH_LN1); }
        if (IN(pb + PH_SLOT)) { PH_IDS KP q = load_params(); slot_phase(q, lds, G, tid, wave, lane); SEAM(pb + PH_SLOT); }
        if (IN(pb + PH_GU)) {
            KP q = load_params(); unsigned char* w = q->ws;
            pg8::Gemm g{(const bf16*)(w + WS_X1B), (const bf16*)(w + WS_WGU + (size_t)l * 32 * 2048 * 1024), MAXSLOT, 32 * 2048, 1024};
            pg8::moe_build_list((LAS int*)(lds + pg8::STAGE_BYTES), (const int*)(w + WS_BLK), 8, G, bx, wave0 * 64 + lane_id()); pg8::MoeOrderG S{(const LAS int*)(lds + pg8::STAGE_BYTES), (const int*)(w + WS_SLOTTOK)};
            pg8::EpiSwiGLU E{(bf16*)(w + WS_ACT), (const float*)(w + WS_BGU) + (size_t)l * 32 * 2048, 8};
            pg8::gemm_phase<pg8::EpiSwiGLU, pg8::MoeOrderG, true, true, true, W8_E8M0>(lds, g, S, E, wave0);
            SEAM(pb + PH_GU);
        }
        if (IN(pb + PH_DOWN)) {
            KP q = load_params(); unsigned char* w = q->ws;
            pg8::Gemm g{(const bf16*)(w + WS_ACT), (const bf16*)(w + WS_WDN + (size_t)l * 32 * 1024 * 1024), MAXSLOT, 32 * 1024, 1024};
            pg8::moe_build_list((LAS int*)(lds + pg8::STAGE_BYTES), (const int*)(w + WS_BLK), 4, G, bx, wave0 * 64 + lane_id()); pg8::MoeOrder S{(const LAS int*)(lds + pg8::STAGE_BYTES), nullptr};
            pg8::EpiDown E{(bf16*)(w + WS_Y), q->b_down + (size_t)l * 32 * 1024, (const float*)(w + WS_GSLOT), 4};
            pg8::gemm_phase<pg8::EpiDown, pg8::MoeOrder, true, true, true, W8_E8M0>(lds, g, S, E, wave0);
            SEAM(pb + PH_DOWN);
        }
        if (IN(pb + PH_COMB)) { PH_IDS KP q = load_params(); float* xout = (l == DEPTH - 1) ? q->out : (float*)(q->ws + WS_XCUR); comb_phase(q, l, xout, G, wave, lane); SEAM(pb + PH_COMB); }
    }
#undef IN
#undef SEAM
}

#ifndef DBG
#define DBG 0
#endif
#if DBG
constexpr int CW_DBG = 64;
__device__ __forceinline__ unsigned hsh(unsigned a) { a ^= a >> 16; a *= 0x7feb352du; a ^= a >> 15; a *= 0x846ca68bu; a ^= a >> 16; return a; }
__device__ __forceinline__ void dbg_fail(Params& p, int id) { atomicMin((int*)(p.ws + WS_CTL) + CW_DBG, id); }
__device__ __forceinline__ bool bad(float a, float ref, float rel, float abs_) { return !(fabsf(a - ref) <= rel * fabsf(ref) + abs_); }
__device__ __forceinline__ float dotx(const float* xr, const float* W, int ld, int col, int K) { float s = 0.f; for (int k = 0; k < K; ++k) s += xr[k] * W[(size_t)k * ld + col]; return s; }

__global__ void __launch_bounds__(64) chk(Params p, int l, int which) {
    __shared__ float Ssh[64 * 65];
    unsigned char* ws = p.ws; const int gt_ = blockIdx.x * 64 + threadIdx.x; const unsigned h0 = hsh(gt_ * 2654435761u + which * 97u + 12345u), h1 = hsh(h0 + 0x9e3779b9u), h2 = hsh(h1 + 77u);
    const float* xin = (l == 0) ? p.x : (const float*)(ws + WS_XCUR);
    const bf16* Z = (const bf16*)(ws + WS_Z);
    const int id = (l * 20 + which) * 4;
    const float* win = p.w_in + (size_t)l * 1024 * D_IN;
    if (which == 1) {
        const int t = h0 % NTOK, n = h1 % D_IN; const int sc = zcol_src(n); const float scale = (n < 512 || (n >= Z_FQ && n < Z_FK)) ? QSCALE : 1.f;
        const float ref = dotx(xin + (size_t)t * DM, win, D_IN, sc, 1024) * scale;
        if (bad(bf2f(Z[(size_t)t * ZP + n]), ref, 0.03f, 0.03f)) dbg_fail(p, id);
    } else if (which == 2) {
        const int t = h0 % NTOK, pos = t & (SEQ - 1), b = t >> 13; const float* xr = xin + (size_t)t * DM;
        { const int hh = h1 % 21, i = h2 & 31; const int col = hh < 8 ? Z_AQ + hh * 64 : hh < 16 ? Z_AK + (hh - 8) * 64 : hh < 20 ? Z_IQ + (hh - 16) * 64 : Z_IK;
          const float sc = hh < 8 ? QSCALE : 1.f; const float t1 = dotx(xr, win, D_IN, zcol_src(col + i), 1024) * sc, t2 = dotx(xr, win, D_IN, zcol_src(col + i + 32), 1024) * sc;
          const float inv = powf(10000.f, -(float)i / 32.f); const float ang = (float)pos * inv; const double rev = (double)ang * 0.15915494309189535; const float fr = (float)(rev - __builtin_rint(rev));
          const float c = __builtin_amdgcn_cosf(fr), s = __builtin_amdgcn_sinf(fr);
          if (bad(bf2f(Z[(size_t)t * ZP + col + i]), t1 * c - t2 * s, 0.03f, 0.03f) || bad(bf2f(Z[(size_t)t * ZP + col + i + 32]), t2 * c + t1 * s, 0.03f, 0.03f)) dbg_fail(p, id); }
        { const int c = h2 % 1024; const float a0 = dotx(xr, win, D_IN, 5452 + c, 1024), a1 = dotx(xr, win, D_IN, 5452 + 1024 + c, 1024), a2 = dotx(xr, win, D_IN, 5452 + 2048 + c, 1024);
          const float g0 = sigmoidf_(a0), g1 = sigmoidf_(a1), g2 = sigmoidf_(a2);
          if (bad(bf2f(Z[(size_t)t * ZP + Z_GT + c]), g0 / g1, 0.05f, 0.01f) || bad(bf2f(Z[(size_t)t * ZP + Z_GT + 1024 + c]), g1 / g2, 0.05f, 0.01f) || bad(bf2f(Z[(size_t)t * ZP + Z_GT + 2048 + c]), g2, 0.05f, 0.01f)) dbg_fail(p, id + 1); }
        { const int hh = h1 & 7; const float v = dotx(xr, win, D_IN, 3396 + hh, 1024) + p.b_fox[l * 8 + hh]; const float ls = -log1pf(expf(-v)) * LOG2E;
          if (bad(((const float*)(ws + WS_LFT))[(size_t)(b * 8 + hh) * SEQ + pos], ls, 0.05f, 0.003f)) dbg_fail(p, id + 2); }
    } else if (which == 3) {
        { const int bh = h0 & 31, t = h1 % SEQ; const float* lf = (const float*)(ws + WS_LFT) + (size_t)bh * SEQ; float s = 0.f; for (int i = 0; i <= t; ++i) s += lf[i];
          if (bad(((const float*)(ws + WS_CT))[(size_t)bh * SEQ + t], s, 1e-3f, 1e-2f)) dbg_fail(p, id); }
        if (gt_ < 192) { const int b = h1 & 3, q = (gt_ < 32) ? (int)(h2 % 512) : (int)(h2 % SEQ); const int nadm = ((q >> 6) + 1) * 64; const u64* mw = (const u64*)(ws + WS_MASKW) + (size_t)(b * SEQ + q) * 128;
          int pc = 0; bool oob = false; for (int w = 0; w < 128; ++w) { const u64 m = mw[w]; pc += __popcll(m); if (w * 64 >= nadm && m) oob = true; }
          if (pc != (nadm < 256 ? nadm : 256) || oob) dbg_fail(p, id + 1);
          const bf16* qr = Z + (size_t)(b * SEQ + q) * ZP; float minsel = 3e38f, maxun = -3e38f;
          for (int s = 0; s < nadm; ++s) { const bf16* kr = Z + (size_t)(b * SEQ + s) * ZP + Z_IK; float sc = 0.f;
              for (int hd = 0; hd < 4; ++hd) { float d = 0.f; for (int k = 0; k < 64; ++k) d += bf2f(qr[Z_IQ + hd * 64 + k]) * bf2f(kr[k]); sc += bf2f(qr[Z_IW + hd]) * 0.0625f * fmaxf(d, 0.f); }
              if ((mw[s >> 6] >> (s & 63)) & 1ull) minsel = fminf(minsel, sc); else maxun = fmaxf(maxun, sc); }
          if (nadm > 256 && !(maxun <= minsel + 0.02f * fabsf(minsel) + 2e-3f)) dbg_fail(p, id + 2); }
    } else if (which == 4) {
        if (gt_ == 0 && l == 0) { const bf16* ob = (const bf16*)(ws + WS_OBUF) + 512;
            const float a0 = bf2f(ob[0]), a1 = bf2f(ob[1]), a3 = bf2f(ob[3]), b0 = bf2f(ob[8]), b1 = bf2f(ob[9]), b3 = bf2f(ob[11]), m0 = bf2f(ob[4]), m1 = bf2f(ob[12]);
            auto tr = [](float v) { return v == 0.f ? 0.f : v == 1.f ? 1.f : 2.f; };
            ((float*)(ws + WS_CTL))[CW_DBG + 2] = 10.f * (tr(a0) + 3.f * tr(b0) + 9.f * tr(a1) + 27.f * tr(b1));
            ((float*)(ws + WS_CTL))[CW_DBG + 3] = sqrtf(10.f * (tr(a3) + 3.f * tr(b3) + 9.f * (m0 == m1 ? 1.f : 0.f) + 27.f * (m0 > -1e20f ? 1.f : 0.f))); }
        const int mode = gt_ & 1, b = h0 & 3, h = (h0 >> 2) & 7, q = (gt_ < 64) ? (int)(h1 % 300) : (int)(h1 % SEQ), d = h2 & 63;
        const int QC = mode == 0 ? Z_FQ : Z_AQ, KC = mode == 0 ? Z_FK : Z_AK, VC = mode == 0 ? Z_FV : Z_AV, OC = mode == 0 ? 512 : 0;
        const bf16* qr = Z + (size_t)(b * SEQ + q) * ZP + QC + h * 64; const float* c = (const float*)(ws + WS_CT) + (size_t)(b * 8 + h) * SEQ; const u64* mw = (const u64*)(ws + WS_MASKW) + (size_t)(b * SEQ + q) * 128;
        const int ns = mode == 0 ? q + 1 : ((q >> 6) + 1) * 64; float mx = -3e38f, mx2 = -3e38f; float ref = 0.f, ref2 = 0.f;
        for (int pass = 0; pass < 2; ++pass) { float den = 0.f, num = 0.f, den2 = 0.f, num2 = 0.f;
            for (int s = 0; s < ns; ++s) { if (mode == 1 && !((mw[s >> 6] >> (s & 63)) & 1ull)) continue;
                const bf16* kr = Z + (size_t)(b * SEQ + s) * ZP + KC + h * 64; float lg = 0.f; for (int k = 0; k < 64; ++k) lg += bf2f(qr[k]) * bf2f(kr[k]);
                const float lg2 = lg; if (mode == 0) lg += c[q] - c[s];
                if (pass == 0) { mx = fmaxf(mx, lg); mx2 = fmaxf(mx2, lg2); } else { const float vv = bf2f(Z[(size_t)(b * SEQ + s) * ZP + VC + h * 64 + d]); const float pp = exp2f(lg - mx), pq = exp2f(lg2 - mx2); den += pp; num += pp * vv; den2 += pq; num2 += pq * vv; } }
            if (pass == 1) { ref = num / den; ref2 = num2 / den2; } }
        const float got = bf2f(((const bf16*)(ws + WS_OBUF))[(size_t)(b * SEQ + q) * OP + OC + h * 64 + d]);
        if (bad(got, ref, 0.04f, 0.03f)) { dbg_fail(p, id + mode);
            int m = 0; if (mode == 0 && q == 0) m |= 1; if (mode == 0 && q < 32) m |= 2; if (mode == 1 && q < 64) m |= 4; if (mode == 1 && q >= 64) m |= 8; atomicOr((int*)(p.ws + WS_CTL) + CW_DBG + 1, m); }
    } else if (which == 7) {
        const int b = blockIdx.x & 3, h = (blockIdx.x >> 2) & 7, e = threadIdx.x;
        for (int d = 0; d < 64; ++d) Ssh[d * 65 + e] = 0.f;
        const float lbv_e = 0.f; (void)lbv_e;
        for (int t = 0; t < 200; ++t) { const bf16* zr = Z + (size_t)(b * SEQ + t) * ZP + h * 64; float o = 0.f; const float ve = bf2f(zr[Z_CI + e]);
            for (int d = 0; d < 64; ++d) { const int dd = h * 64 + d; const float lb = (l == 0) ? 0.f : sigmoidf_(p.lb_logits[512 + dd] - p.lb_logits[dd]);
                const float sg = sigmoidf_(bf2f(zr[Z_CF + d])); const float f = lb + (1.f - lb) * sg, kk = (1.f - lb) * (1.f - sg);
                const float S = f * Ssh[d * 65 + e] + kk * ve; Ssh[d * 65 + e] = S; o += bf2f(zr[Z_CQ + d]) * S; }
            const float ss = wave_sum(o * o); const float ref = o * (1.f / sqrtf(ss * (1.f / 64.f) + RMS_EPS)) * p.norm_g[l * 512 + h * 64 + e] * sigmoidf_(bf2f(zr[Z_CG + e]));
            if (bad(bf2f(((const bf16*)(ws + WS_OBUF))[(size_t)(b * SEQ + t) * OP + 1024 + h * 64 + e]), ref, 0.06f, 0.05f)) { const int n = atomicAdd((int*)(p.ws + WS_CTL) + CW_DBG + 4 + (t >= 64 ? 1 : 0), 1); if (n >= 40) dbg_fail(p, id + (t >= 64 ? 1 : 0)); } }
    } else if (which == 8) {
        const int t = h0 % NTOK, c = h1 % 1024; const bf16* zr = Z + (size_t)t * ZP + Z_GT; const float g2 = bf2f(zr[2048 + c]), g1 = bf2f(zr[1024 + c]) * g2, g0 = bf2f(zr[c]) * g1;
        const bf16* ob = (const bf16*)(ws + WS_OBUF) + (size_t)t * OP; float sa = 0.f, sb = 0.f, sc = 0.f;
        for (int k = 0; k < 512; ++k) { sa += bf2f(ob[k]) * p.w_pa[((size_t)l * 512 + k) * 1024 + c]; sb += bf2f(ob[512 + k]) * p.w_pb[((size_t)l * 512 + k) * 1024 + c]; sc += bf2f(ob[1024 + k]) * p.w_pc[((size_t)l * 512 + k) * 1024 + c]; }
        if (bad(bf2f(((const bf16*)(ws + WS_MERGED))[(size_t)t * 1024 + c]), g0 * sa + g1 * sb + g2 * sc, 0.04f, 0.01f)) dbg_fail(p, id);
    } else if (which == 9) {
        const int t = h0 % NTOK, c = h1 % 1024; const bf16* mr = (const bf16*)(ws + WS_MERGED) + (size_t)t * 1024; float s = 0.f;
        for (int k = 0; k < 1024; ++k) s += bf2f(mr[k]) * p.w_out[((size_t)l * 1024 + k) * 1024 + c];
        if (bad(((const float*)(ws + WS_MIX))[(size_t)t * 1024 + c], s, 0.03f, 0.005f)) dbg_fail(p, id);
    } else if (which == 10) {
        const int t = h0 % NTOK, c = h1 % 1024; const float* xr = xin + (size_t)t * DM; const float* mr = (const float*)(ws + WS_MIX) + (size_t)t * DM; const float* x1 = (const float*)(ws + WS_X1) + (size_t)t * DM;
        float mean = 0.f; for (int k = 0; k < 1024; ++k) mean += ALPHA * xr[k] + mr[k]; mean *= (1.f / 1024.f);
        float var = 0.f; for (int k = 0; k < 1024; ++k) { const float dlt = ALPHA * xr[k] + mr[k] - mean; var += dlt * dlt; } var *= (1.f / 1024.f);
        const float ref = (ALPHA * xr[c] + mr[c] - mean) / sqrtf(var + LN_EPS) * p.ln1_g[l * 1024 + c] + p.ln1_b[l * 1024 + c];
        if (bad(x1[c], ref, 1e-3f, 1e-3f) || bad(bf2f(((const bf16*)(ws + WS_X1B))[(size_t)t * DM + c]), ref, 0.01f, 0.01f)) dbg_fail(p, id);
        float tv0 = -3e38f, tv1 = -3e38f, tv2 = -3e38f, tv3 = -3e38f; int ti0 = -1, ti1 = -1, ti2 = -1, ti3 = -1;
        for (int e = 0; e < 32; ++e) { float lg = p.b_router[l * 32 + e]; for (int k = 0; k < 1024; ++k) lg += x1[k] * p.w_router[((size_t)l * 1024 + k) * 32 + e];
            if (lg > tv0) { tv3 = tv2; ti3 = ti2; tv2 = tv1; ti2 = ti1; tv1 = tv0; ti1 = ti0; tv0 = lg; ti0 = e; } else if (lg > tv1) { tv3 = tv2; ti3 = ti2; tv2 = tv1; ti2 = ti1; tv1 = lg; ti1 = e; }
            else if (lg > tv2) { tv3 = tv2; ti3 = ti2; tv2 = lg; ti2 = e; } else if (lg > tv3) { tv3 = lg; ti3 = e; } }
        const int* tke = (const int*)(ws + WS_TKE) + t * 4; const float* tkg = (const float*)(ws + WS_TKG) + t * 4;
        const float den = 1.f + expf(tv1 - tv0) + expf(tv2 - tv0) + expf(tv3 - tv0);
        if (tv2 - tv3 > 1e-3f && tv1 - tv2 > 1e-3f && tv0 - tv1 > 1e-3f) { if (tke[0] != ti0 || tke[1] != ti1 || tke[2] != ti2 || tke[3] != ti3) dbg_fail(p, id + 1);
            if (bad(tkg[0], 1.f / den, 1e-2f, 1e-3f) || bad(tkg[3], expf(tv3 - tv0) / den, 1e-2f, 1e-3f)) dbg_fail(p, id + 2); }
    } else if (which == 11) {
        const int t = h0 % NTOK, k = h1 & 3, c = h2 % 1024; const int slot = ((const int*)(ws + WS_TOKSLOT))[t * 4 + k], e = ((const int*)(ws + WS_TKE))[t * 4 + k]; const int* blk = (const int*)(ws + WS_BLK);
        if (slot < 0 || slot >= blk[0] * 256 || blk[0] > MAXBLK) { dbg_fail(p, id); return; }
        if (blk[16 + (slot >> 8)] != e) dbg_fail(p, id + 1);
        if (((const float*)(ws + WS_GSLOT))[slot] != ((const float*)(ws + WS_TKG))[t * 4 + k]) dbg_fail(p, id + 2);
        if (((const bf16*)(ws + WS_XG))[(size_t)slot * DM + c] != ((const bf16*)(ws + WS_X1B))[(size_t)t * DM + c]) dbg_fail(p, id + 3);
    } else if (which == 12) {
        const int t = h0 % NTOK, k = h1 & 3, j = h2 % 1024; const int slot = ((const int*)(ws + WS_TOKSLOT))[t * 4 + k], e = ((const int*)(ws + WS_TKE))[t * 4 + k];
        const bf16* xr = (const bf16*)(ws + WS_XG) + (size_t)slot * DM; const float* W = p.w_gu + (size_t)(l * 32 + e) * 1024 * 2048; float g = p.b_gu[(size_t)(l * 32 + e) * 2048 + j], u = p.b_gu[(size_t)(l * 32 + e) * 2048 + 1024 + j];
        for (int kk = 0; kk < 1024; ++kk) { const float xv = bf2f(xr[kk]); g += xv * W[(size_t)kk * 2048 + j]; u += xv * W[(size_t)kk * 2048 + 1024 + j]; }
        g = fminf(g, 7.f); u = fminf(fmaxf(u, -7.f), 7.f); const float ref = g * sigmoidf_(1.702f * g) * (u + 1.f);
        if (bad(bf2f(((const bf16*)(ws + WS_ACT))[(size_t)slot * 1024 + j]), ref, 0.04f, 0.02f)) dbg_fail(p, id);
    } else if (which == 13) {
        const int t = h0 % NTOK, k = h1 & 3, n = h2 % 1024; const int slot = ((const int*)(ws + WS_TOKSLOT))[t * 4 + k], e = ((const int*)(ws + WS_TKE))[t * 4 + k];
        const bf16* ar = (const bf16*)(ws + WS_ACT) + (size_t)slot * 1024; const float* W = p.w_down + (size_t)(l * 32 + e) * 1024 * 1024; float s = p.b_down[(size_t)(l * 32 + e) * 1024 + n];
        for (int kk = 0; kk < 1024; ++kk) s += bf2f(ar[kk]) * W[(size_t)kk * 1024 + n];
        if (bad(bf2f(((const bf16*)(ws + WS_Y))[(size_t)slot * 1024 + n]), s * ((const float*)(ws + WS_GSLOT))[slot], 0.04f, 0.005f)) dbg_fail(p, id);
    } else if (which == 14) {
        const int t = h0 % NTOK, c = h1 % 1024; const float* x1 = (const float*)(ws + WS_X1) + (size_t)t * DM; const bf16* y = (const bf16*)(ws + WS_Y); const int* ts = (const int*)(ws + WS_TOKSLOT) + t * 4;
        const float* xo = ((l == DEPTH - 1) ? p.out : (float*)(ws + WS_XCUR)) + (size_t)t * DM;
        float mean = 0.f; for (int k = 0; k < 1024; ++k) { float v = ALPHA * x1[k]; for (int j = 0; j < 4; ++j) v += bf2f(y[(size_t)ts[j] * 1024 + k]); mean += v; } mean *= (1.f / 1024.f);
        float var = 0.f, vc = 0.f; for (int k = 0; k < 1024; ++k) { float v = ALPHA * x1[k]; for (int j = 0; j < 4; ++j) v += bf2f(y[(size_t)ts[j] * 1024 + k]); var += (v - mean) * (v - mean); if (k == c) vc = v; } var *= (1.f / 1024.f);
        if (bad(xo[c], (vc - mean) / sqrtf(var + LN_EPS) * p.ln2_g[l * 1024 + c] + p.ln2_b[l * 1024 + c], 2e-3f, 2e-3f)) dbg_fail(p, id);
    }
}
__global__ void dbg_init(Params p) { if (threadIdx.x == 0 && blockIdx.x == 0) { ((int*)(p.ws + WS_CTL))[CW_DBG] = 0x7fffffff; ((int*)(p.ws + WS_CTL))[CW_DBG + 1] = 0; ((int*)(p.ws + WS_CTL))[CW_DBG + 4] = 0; ((int*)(p.ws + WS_CTL))[CW_DBG + 5] = 0; } }
__global__ void dbg_fill(Params p, int n) {
    const int code = ((const int*)(p.ws + WS_CTL))[CW_DBG]; if (code == 0x7fffffff) return;
    const int sub = code & 3, lw = code >> 2, l = lw / 20, which = lw % 20; const int k = l * 16 + which + 32 * sub;
    const float c = sqrtf(exp2f((float)k));
    const int msk = ((const int*)(p.ws + WS_CTL))[CW_DBG + 1];
    for (int i = blockIdx.x * blockDim.x + threadIdx.x; i < n; i += gridDim.x * blockDim.x) p.out[i] = (i == 0) ? 16.f * (float)(1 + msk) : c;
}
#endif

extern "C" void kernel_launch(void* const* d_in, const int* in_sizes, int n_in, void* d_out, int out_size, void* d_ws, size_t ws_size, hipStream_t stream) {
    static int grid = 0;
    if (grid == 0) {
        if (n_in != 19 || ws_size < WS_END) { fprintf(stderr, "kernel_launch: need 19 inputs and >= %zu bytes of workspace; got %d, %zu\n", (size_t)WS_END, n_in, ws_size); grid = -1; return; }
        int dev = 0, cus = 0, per_cu = 0;
        if (hipGetDevice(&dev) != hipSuccess || hipDeviceGetAttribute(&cus, hipDeviceAttributeMultiprocessorCount, dev) != hipSuccess) { grid = -1; return; }
        if (hipFuncSetAttribute((const void*)fwd, hipFuncAttributeMaxDynamicSharedMemorySize, LDS_BYTES) != hipSuccess) { fprintf(stderr, "kernel_launch: hipFuncSetAttribute failed\n"); grid = -1; return; }
        if (hipOccupancyMaxActiveBlocksPerMultiprocessor(&per_cu, (const void*)fwd, NTHR, LDS_BYTES) != hipSuccess || per_cu < 1) fprintf(stderr, "kernel_launch: occupancy query reports %d\n", per_cu);
        (void)hipGetLastError();
        grid = cus;
    }
    if (grid < 0) return;
    (void)hipMemsetAsync((char*)d_ws + WS_CTL, 0, CTL_ZERO_BYTES, stream);
    Params p{};
    const float** f = (const float**)&p;
    for (int i = 0; i < 19; ++i) f[i] = (const float*)d_in[i];
    p.out = (float*)d_out; p.ws = (unsigned char*)d_ws;
#if ONE_LAUNCH
    p.ph_lo = 0; p.ph_hi = NPHASES; p.use_bar = 1; p.pad = 0;
    hipLaunchKernelGGL(fwd, dim3(grid), dim3(NTHR), LDS_BYTES, stream, p);
#else
#if DBG
    hipLaunchKernelGGL(dbg_init, dim3(1), dim3(64), 0, stream, p);
#endif
    for (int ph = 0; ph < NPHASES; ++ph) { p.ph_lo = ph; p.ph_hi = ph + 1; p.use_bar = 0; p.pad = 0;
        hipLaunchKernelGGL(fwd, dim3(grid), dim3(NTHR), LDS_BYTES, stream, p);
#if DBG
        if (ph >= 1) { const int l = (ph - 1) / NPH_LAYER, k = (ph - 1) % NPH_LAYER; static const int wmap[NPH_LAYER] = {1, 2, 3, 4, 0, 0, 7, 8, 9, 10, 11, 12, 13, 14}; const int w = wmap[k];
            if (w) { const int nb = (w == 7) ? 32 : (w == 3) ? 4 : (w == 4) ? 2 : 16; hipLaunchKernelGGL(chk, dim3(nb), dim3(64), 0, stream, p, l, w); } }
#endif
    }
#if DBG
    hipLaunchKernelGGL(dbg_fill, dim3(1024), dim3(256), 0, stream, p, out_size);
#endif
#endif
}
```

```cpp
#include <hip/hip_runtime.h>
#include <cstdio>
#include <cstdint>

#define GAS __attribute__((address_space(1)))
#define LAS __attribute__((address_space(3)))
typedef unsigned short bf16;
typedef short bf16x8 __attribute__((ext_vector_type(8)));
typedef short s16x4 __attribute__((ext_vector_type(4)));
typedef float f32x2 __attribute__((ext_vector_type(2)));
typedef float f32x4 __attribute__((ext_vector_type(4)));
typedef float f32x16 __attribute__((ext_vector_type(16)));
typedef unsigned u32x2 __attribute__((ext_vector_type(2)));
typedef unsigned u32x4 __attribute__((ext_vector_type(4)));
typedef unsigned long long u64;

__device__ __forceinline__ unsigned f2bf(float f) { unsigned u = __builtin_bit_cast(unsigned, f); return (u + 0x7fffu + ((u >> 16) & 1u)) >> 16; }
__device__ __forceinline__ unsigned pk2(float lo, float hi) { return f2bf(lo) | (f2bf(hi) << 16); }
__device__ __forceinline__ float bf2f(unsigned b) { return __builtin_bit_cast(float, b << 16); }
__device__ __forceinline__ float bflo(unsigned w) { return __builtin_bit_cast(float, w << 16); }
__device__ __forceinline__ float bfhi(unsigned w) { return __builtin_bit_cast(float, w & 0xffff0000u); }
__device__ __forceinline__ float sigmoidf_(float x) { return __builtin_amdgcn_rcpf(1.0f + __expf(-x)); }

namespace pg8 {
#define PG8_LAS __attribute__((address_space(3)))
typedef unsigned short bf16_t;
typedef short bf16x8 __attribute__((ext_vector_type(8)));
typedef float f32x4 __attribute__((ext_vector_type(4)));
typedef unsigned u32x4 __attribute__((ext_vector_type(4)));
constexpr int BM = 256, BK = 64, HALF = 128, HTB = HALF * BK * 2  , STAGE_BYTES = 8 * HTB, NXCD = 8, WGM = 8;

__host__ __device__ __forceinline__ int lds_byte(int r, int c) { const int st = (r >> 4) * 2 + (c >> 5), rr = r & 15, cc = c & 31, ob = rr * 64 + cc * 2; return st * 1024 + (ob ^ (((ob >> 9) & 1) << 5)); }
__host__ __device__ __forceinline__ void stage_rc(int b, int& R, int& C) { const int st = b / 1024, sb = b % 1024, swz = sb ^ (((sb >> 9) & 1) << 5); R = (st >> 1) * 16 + swz / 64; C = (st & 1) * 32 + (swz % 64) / 2; }
__host__ __device__ __forceinline__ int perm32(int rho) { const int n = rho >> 4, i = rho & 15; return 8 * (i >> 2) + 4 * n + (i & 3); }

struct Unit { int pm, pn; };
struct Gemm { const bf16_t* A; const bf16_t* Bt; int M, N, K; };

struct StaticOrder {
    static constexpr bool GATHER = false; const int* tok = nullptr;
    int nM, nN, nwg, G, c;
    __host__ __device__ void init(int M, int N, int G_, int c_) { nM = M / BM; nN = N / BM; nwg = nM * nN; G = G_; c = c_; }
    __host__ __device__ bool next(int i, Unit& u) const {
        const long L = (long)i * G + c; if (L >= nwg) return false;
        int wgid = (int)L; { const int q = nwg / NXCD, r = nwg % NXCD, xcd = wgid % NXCD, off = wgid / NXCD; wgid = (xcd < r ? xcd * (q + 1) : r * (q + 1) + (xcd - r) * q) + off; }
        const int nig = WGM * nN, gid = wgid / nig, fm = gid * WGM, gsz = (nM - fm) < WGM ? (nM - fm) : WGM;
        u.pm = fm + ((wgid % nig) % gsz); u.pn = (wgid % nig) / gsz; return true;
    }
    __device__ __forceinline__ void a_ready(const Unit&) const {}
    __device__ __forceinline__ void done(const Unit&) const {}
};
template <bool GATHER_> struct MoeOrderT {
    static constexpr bool GATHER = GATHER_;
    const PG8_LAS int* list; const int* tok;
    __device__ bool next(int i, Unit& u) const {
        if (i >= __builtin_amdgcn_readfirstlane(list[0])) return false;
        u.pm = __builtin_amdgcn_readfirstlane(list[2 + 2 * i]); u.pn = __builtin_amdgcn_readfirstlane(list[3 + 2 * i]); return true;
    }
    __device__ __forceinline__ void a_ready(const Unit&) const {}
    __device__ __forceinline__ void done(const Unit&) const {}
};
typedef MoeOrderT<false> MoeOrder; typedef MoeOrderT<true> MoeOrderG;
__device__ __forceinline__ void moe_build_list(PG8_LAS int* list, const int* blk, int nN, int G, int c, int tid) {
    if (tid == 0) { const int* bst = blk + 16 + 544 + 16; int n = 0;
        if (G % 8 == 0) { const int W = G / 8, j = c / 8, x = c % 8;
            for (int i = 0; i < 64; ++i) { const int uu = i * W + j; const int bi = uu / nN, pl = uu - bi * nN; int rem = bi; bool ok = false;
                for (int k = 0; k < 4 && !ok; ++k) { const int e = x + 8 * k; const int b0 = bst[e], b1 = bst[e + 1]; if (rem < b1 - b0) { list[2 + 2 * n] = b0 + rem; list[3 + 2 * n] = e * nN + pl; ++n; ok = true; } else rem -= b1 - b0; }
                if (!ok) break; }
        } else { const int nb = bst[32];
            for (int i = 0; i < 64; ++i) { const int uu = i * G + c; const int bi = uu / nN, pl = uu - bi * nN; if (bi >= nb) break; int e = 0; for (int k = 1; k < 32; ++k) if (bi >= bst[k]) e = k; list[2 + 2 * n] = bi; list[3 + 2 * n] = e * nN + pl; ++n; } }
        list[0] = n; }
    asm volatile("s_waitcnt lgkmcnt(0)\n\ts_barrier" ::: "memory");
}

__device__ __forceinline__ unsigned cvt_pk_bf16(float lo, float hi) { unsigned r; asm volatile("v_cvt_pk_bf16_f32 %0, %1, %2" : "=v"(r) : "v"(lo), "v"(hi)); return r; }

struct EpiZ {
    static constexpr bool PERM = true, AFTER_DRAIN = false, MIDK = false;
    bf16_t* O; int ldc; const float* trig; bf16_t* IKC;
    __device__ __forceinline__ void operator()(const f32x4 (&acc)[2][2][4][2], const Unit& u, int wr, int wc, int fr, int fq) const {
        asm volatile("" : "+v"(fr), "+v"(fq));
        const int row0 = u.pm * BM + wr * 64 + fr; const int col0 = u.pn * BM + wc * 32 + 8 * fq;
        const bool rot_all = (u.pn < 4) || (u.pn == 32); const bool rot_b0 = rot_all || (u.pn == 33 && wc < 2);
        const int i0 = (wc & 1) * 16 + 4 * fq;
#pragma unroll
        for (int ai = 0; ai < 2; ++ai)
#pragma unroll
            for (int m = 0; m < 4; ++m) { const int row = row0 + ai * HALF + m * 16; bf16_t* rowp = O + (size_t)row * ldc + col0;
                f32x4 ca = {1.f, 0.f, 1.f, 0.f}, cb = {1.f, 0.f, 1.f, 0.f};
                if (rot_b0) { const float* tp = trig + ((size_t)(row & 8191) * 32 + i0) * 2; ca = *(const f32x4*)tp; cb = *(const f32x4*)(tp + 4); }
#pragma unroll
                for (int bj = 0; bj < 2; ++bj) { f32x4 v0 = acc[ai][bj][m][0], v1 = acc[ai][bj][m][1];
                    if (bj == 0 ? rot_b0 : rot_all) {
                        const f32x4 r0 = {v0[0] * ca[0] - v0[1] * ca[1], v0[1] * ca[0] + v0[0] * ca[1], v0[2] * ca[2] - v0[3] * ca[3], v0[3] * ca[2] + v0[2] * ca[3]};
                        const f32x4 r1 = {v1[0] * cb[0] - v1[1] * cb[1], v1[1] * cb[0] + v1[0] * cb[1], v1[2] * cb[2] - v1[3] * cb[3], v1[3] * cb[2] + v1[2] * cb[3]};
                        v0 = r0; v1 = r1; }
                    u32x4 w; w.x = cvt_pk_bf16(v0[0], v0[1]); w.y = cvt_pk_bf16(v0[2], v0[3]); w.z = cvt_pk_bf16(v1[0], v1[1]); w.w = cvt_pk_bf16(v1[2], v1[3]);
                    *(u32x4*)(rowp + bj * HALF) = w;
                    if (bj == 0 && u.pn == 33 && wc < 2) *(u32x4*)(IKC + (size_t)row * 64 + wc * 32 + 8 * fq) = w; } }
    }
};
struct EpiF32 {
    static constexpr bool PERM = true, AFTER_DRAIN = false, MIDK = false;
    float* O; int ldc;
    __device__ __forceinline__ void operator()(const f32x4 (&acc)[2][2][4][2], const Unit& u, int wr, int wc, int fr, int fq) const {
        asm volatile("" : "+v"(fr), "+v"(fq));
        const int row0 = u.pm * BM + wr * 64 + fr; const int col0 = u.pn * BM + wc * 32 + 8 * fq;
#pragma unroll
        for (int ai = 0; ai < 2; ++ai)
#pragma unroll
            for (int m = 0; m < 4; ++m) { float* rowp = O + (size_t)(row0 + ai * HALF + m * 16) * ldc + col0;
#pragma unroll
                for (int bj = 0; bj < 2; ++bj) { *(f32x4*)(rowp + bj * HALF) = acc[ai][bj][m][0]; *(f32x4*)(rowp + bj * HALF + 4) = acc[ai][bj][m][1]; } }
    }
};
struct EpiBf16 {
    static constexpr bool PERM = true, AFTER_DRAIN = false, MIDK = false;
    bf16_t* O; int ldc;
    __device__ __forceinline__ void operator()(const f32x4 (&acc)[2][2][4][2], const Unit& u, int wr, int wc, int fr, int fq) const {
        asm volatile("" : "+v"(fr), "+v"(fq));
        const int row0 = u.pm * BM + wr * 64 + fr; const int col0 = u.pn * BM + wc * 32 + 8 * fq;
#pragma unroll
        for (int ai = 0; ai < 2; ++ai)
#pragma unroll
            for (int m = 0; m < 4; ++m) { bf16_t* rowp = O + (size_t)(row0 + ai * HALF + m * 16) * ldc + col0;
#pragma unroll
                for (int bj = 0; bj < 2; ++bj) { const f32x4 v0 = acc[ai][bj][m][0], v1 = acc[ai][bj][m][1];
                    u32x4 w; w.x = cvt_pk_bf16(v0[0], v0[1]); w.y = cvt_pk_bf16(v0[2], v0[3]); w.z = cvt_pk_bf16(v1[0], v1[1]); w.w = cvt_pk_bf16(v1[2], v1[3]);
                    *(u32x4*)(rowp + bj * HALF) = w; } }
    }
};
struct EpiMerge {
    static constexpr bool PERM = true, AFTER_DRAIN = false, MIDK = true;
    const bf16_t* Gz; int gp; bf16_t* O; int ldc;
    __device__ __forceinline__ void scale(f32x4 (&acc)[2][2][4][2], const Unit& u, int idx, int wr, int wc, int fr, int fq) const {
        asm volatile("" : "+v"(fr), "+v"(fq));
        const int row0 = u.pm * BM + wr * 64 + fr; const int col0 = u.pn * BM + wc * 32 + 8 * fq;
        const int pa = (idx == 2) ? 2048 : (idx == 1) ? 2048 : 1024, pb = (idx == 1) ? 1024 : 0;
        u32x4 wa[2], wb[2], na[2], nb[2];
#define MG_LOAD(IT, WA, WB) do { const bf16_t* rowp_ = Gz + (size_t)(row0 + ((IT) >> 2) * HALF + ((IT) & 3) * 16) * gp + col0; \
            _Pragma("unroll") for (int bj = 0; bj < 2; ++bj) { WA[bj] = *(const u32x4*)(rowp_ + pa + bj * HALF); if (idx != 2) WB[bj] = *(const u32x4*)(rowp_ + pb + bj * HALF); else WB[bj] = WA[bj]; } } while (0)
        MG_LOAD(0, wa, wb);
#pragma unroll
        for (int it = 0; it < 8; ++it) { const int ai = it >> 2, m = it & 3;
            if (it + 1 < 8) MG_LOAD(it + 1, na, nb);
            asm volatile("" ::: "memory");
#pragma unroll
            for (int bj = 0; bj < 2; ++bj) { float s[8];
#pragma unroll
                for (int i = 0; i < 4; ++i) { const float ea0 = __expf(-bflo(wa[bj][i])), ea1 = __expf(-bfhi(wa[bj][i]));
                    if (idx == 2) { s[2 * i] = __builtin_amdgcn_rcpf(1.f + ea0); s[2 * i + 1] = __builtin_amdgcn_rcpf(1.f + ea1); }
                    else { const float eb0 = __expf(-bflo(wb[bj][i])), eb1 = __expf(-bfhi(wb[bj][i])); s[2 * i] = (1.f + ea0) * __builtin_amdgcn_rcpf(1.f + eb0); s[2 * i + 1] = (1.f + ea1) * __builtin_amdgcn_rcpf(1.f + eb1); } }
                acc[ai][bj][m][0] = acc[ai][bj][m][0] * (f32x4){s[0], s[1], s[2], s[3]}; acc[ai][bj][m][1] = acc[ai][bj][m][1] * (f32x4){s[4], s[5], s[6], s[7]}; }
#pragma unroll
            for (int bj = 0; bj < 2; ++bj) { wa[bj] = na[bj]; wb[bj] = nb[bj]; } }
#undef MG_LOAD
    }
    __device__ __forceinline__ void mid(f32x4 (&acc)[2][2][4][2], const Unit& u, int idx, int wr, int wc, int fr, int fq) const { scale(acc, u, idx, wr, wc, fr, fq); }
    __device__ __forceinline__ void operator()(f32x4 (&acc)[2][2][4][2], const Unit& u, int wr, int wc, int fr, int fq) const {
        scale(acc, u, 2, wr, wc, fr, fq);
        asm volatile("" : "+v"(fr), "+v"(fq));
        const int row0 = u.pm * BM + wr * 64 + fr; const int col0 = u.pn * BM + wc * 32 + 8 * fq;
#pragma unroll
        for (int ai = 0; ai < 2; ++ai)
#pragma unroll
            for (int m = 0; m < 4; ++m) { bf16_t* rowp = O + (size_t)(row0 + ai * HALF + m * 16) * ldc + col0;
#pragma unroll
                for (int bj = 0; bj < 2; ++bj) { const f32x4 v0 = acc[ai][bj][m][0], v1 = acc[ai][bj][m][1];
                    u32x4 w; w.x = cvt_pk_bf16(v0[0], v0[1]); w.y = cvt_pk_bf16(v0[2], v0[3]); w.z = cvt_pk_bf16(v1[0], v1[1]); w.w = cvt_pk_bf16(v1[2], v1[3]);
                    *(u32x4*)(rowp + bj * HALF) = w; } }
    }
};
struct EpiSwiGLU {
    static constexpr bool PERM = true, AFTER_DRAIN = false, MIDK = false;
    bf16_t* O; const float* bias; int nN;
    __device__ __forceinline__ void operator()(const f32x4 (&acc)[2][2][4][2], const Unit& u, int wr, int wc, int fr, int fq) const {
        const int e = u.pn / nN, pl = u.pn - e * nN;
        asm volatile("" : "+v"(fr), "+v"(fq));
        const int row0 = u.pm * BM + wr * 64 + fr; const int colt = pl * BM + wc * 32 + 8 * fq;
        const float* bp = bias + (size_t)e * 2048 + colt;
        f32x4 bv[2][2];
#pragma unroll
        for (int bj = 0; bj < 2; ++bj) { bv[bj][0] = *(const f32x4*)(bp + bj * HALF); bv[bj][1] = *(const f32x4*)(bp + bj * HALF + 4); }
#pragma unroll
        for (int ai = 0; ai < 2; ++ai)
#pragma unroll
            for (int m = 0; m < 4; ++m) { unsigned char* rowp = (unsigned char*)O + (size_t)(row0 + ai * HALF + m * 16) * 1024 + (colt >> 1);
#pragma unroll
                for (int bj = 0; bj < 2; ++bj) { const f32x4 v0 = acc[ai][bj][m][0] + bv[bj][0], v1 = acc[ai][bj][m][1] + bv[bj][1];
                    float a[4];
                    const float gt[4] = {v0[0], v0[2], v1[0], v1[2]}, up[4] = {v0[1], v0[3], v1[1], v1[3]};
#pragma unroll
                    for (int i = 0; i < 4; ++i) { const float g = fminf(gt[i], 7.0f); const float uu = fminf(fmaxf(up[i], -7.0f), 7.0f);
                        a[i] = g * __builtin_amdgcn_rcpf(1.0f + __expf(-1.702f * g)) * (uu + 1.0f); }
                    int w8 = __builtin_amdgcn_cvt_pk_fp8_f32(a[0], a[1], 0, false); w8 = __builtin_amdgcn_cvt_pk_fp8_f32(a[2], a[3], w8, true);
                    *(unsigned*)(rowp + bj * (HALF / 2)) = (unsigned)w8; } }
    }
};
struct EpiDown {
    static constexpr bool PERM = true, AFTER_DRAIN = false, MIDK = false;
    bf16_t* O; const float* bias; const float* gate; int nN;
    __device__ __forceinline__ void operator()(const f32x4 (&acc)[2][2][4][2], const Unit& u, int wr, int wc, int fr, int fq) const {
        const int e = u.pn / nN, pl = u.pn - e * nN;
        asm volatile("" : "+v"(fr), "+v"(fq));
        const int row0 = u.pm * BM + wr * 64 + fr; const int colt = pl * BM + wc * 32 + 8 * fq;
        const float* bp = bias + (size_t)e * 1024 + colt;
        f32x4 bv[2][2];
#pragma unroll
        for (int bj = 0; bj < 2; ++bj) { bv[bj][0] = *(const f32x4*)(bp + bj * HALF); bv[bj][1] = *(const f32x4*)(bp + bj * HALF + 4); }
#pragma unroll
        for (int ai = 0; ai < 2; ++ai)
#pragma unroll
            for (int m = 0; m < 4; ++m) { const int row = row0 + ai * HALF + m * 16; const float gs = gate[row]; bf16_t* rowp = O + (size_t)row * 1024 + colt;
#pragma unroll
                for (int bj = 0; bj < 2; ++bj) { const f32x4 v0 = (acc[ai][bj][m][0] + bv[bj][0]) * gs, v1 = (acc[ai][bj][m][1] + bv[bj][1]) * gs;
                    u32x4 w; w.x = cvt_pk_bf16(v0[0], v0[1]); w.y = cvt_pk_bf16(v0[2], v0[3]); w.z = cvt_pk_bf16(v1[0], v1[1]); w.w = cvt_pk_bf16(v1[2], v1[3]);
                    *(u32x4*)(rowp + bj * HALF) = w; } }
    }
};

template <class Epi, class Sched, bool ALIGN_EPI = false, bool SP2 = false, bool FP8 = false, int SCALE_B = 127>
__device__ __forceinline__ void gemm_phase(PG8_LAS unsigned char* lds, const Gemm g, const Sched& S, const Epi& E, int wv) {
    int tid_l = (int)__builtin_amdgcn_mbcnt_hi(~0u, __builtin_amdgcn_mbcnt_lo(~0u, 0u)); asm volatile("" : "+v"(tid_l)); tid_l += wv * 64;
    const int tid = tid_l, wid = __builtin_amdgcn_readfirstlane(tid >> 6), lane = tid & 63, wr = wid >> 2, wc = wid & 3, fr = lane & 15, fq = lane >> 4;
    const int K = g.K; const int KB = FP8 ? K : 2 * K;
    const int nt = KB / (2 * BK);
    unsigned voffA[2], voffB[2];
#pragma unroll
    for (int i = 0; i < 2; ++i) { int R, C; stage_rc(tid * 16 + i * 8192, R, C); const int Rb = Epi::PERM ? ((R & ~31) + perm32(R & 31)) : R;
        voffA[i] = (unsigned)(R * KB + 2 * C); voffB[i] = (unsigned)(Rb * KB + 2 * C); }
    unsigned voGc[2][2]; PG8_LAS unsigned* voGn_l = (PG8_LAS unsigned*)(lds + STAGE_BYTES + 1024) + tid;
#define PG8_GOFF(dst, pmv) do { if constexpr (Sched::GATHER) { _Pragma("unroll") for (int _h = 0; _h < 2; ++_h) _Pragma("unroll") for (int _i = 0; _i < 2; ++_i) { \
        const unsigned _R = voffA[_i] / (unsigned)KB, _cb = voffA[_i] % (unsigned)KB; dst[_h][_i] = (unsigned)S.tok[(pmv) * BM + _h * HALF + (int)_R] * (unsigned)KB + _cb; } } } while (0)
    const size_t kstep = (size_t)(BK * 2);
    const size_t hstep = (size_t)HALF * KB;
    const size_t tstep = 2 * hstep;
    const unsigned ldsw = (unsigned)wid * 1024u;
    const int aoff = lds_byte(wr * 64 + fr, FP8 ? fq * 16 : fq * 8), boff = lds_byte(wc * 32 + fr, FP8 ? fq * 16 : fq * 8);
    const int aoff1 = FP8 ? lds_byte(wr * 64 + fr, fq * 16 + 8) - aoff : 1024, boff1 = FP8 ? lds_byte(wc * 32 + fr, fq * 16 + 8) - boff : 1024;
#define PG8_SA(b, h) (((b) * 2 + (h)) * HTB)
#define PG8_SB(b, h) ((4 + (b) * 2 + (h)) * HTB)
#define PG8_STAGE(bufoff, gbase, voff) do { _Pragma("unroll") for (int _i = 0; _i < 2; ++_i) \
        __builtin_amdgcn_global_load_lds((const unsigned*)((const char*)(gbase) + (voff)[_i]), (PG8_LAS unsigned*)(lds + (bufoff) + ldsw + _i * 8192), 16, 0, 0); } while (0)
#define PG8_STAGE_A(bufoff, base, h, nx) do { if constexpr (Sched::GATHER) { unsigned _vo[2] = {voGc[h][0], voGc[h][1]}; if (nx) { _vo[0] = voGn_l[((h) * 2 + 0) * 512]; _vo[1] = voGn_l[((h) * 2 + 1) * 512]; } PG8_STAGE(bufoff, base, _vo); } else { PG8_STAGE(bufoff, (base) + (h) * hstep, voffA); } } while (0)
#define PG8_LD8(dst8, n_, base_, off_, off1_) do { _Pragma("unroll") for (int q_ = 0; q_ < n_; ++q_) { const v4i_ lo_ = *(const PG8_LAS v4i_*)(lds + (base_) + (off_) + q_ * 2048), hi_ = *(const PG8_LAS v4i_*)(lds + (base_) + (off_) + q_ * 2048 + (off1_)); \
        dst8[q_] = __builtin_shufflevector(lo_, hi_, 0, 1, 2, 3, 4, 5, 6, 7); } } while (0)
#define PG8_LDA(dst, b, h) do { if constexpr (FP8) { PG8_LD8(dst##8, 4, PG8_SA(b, h), aoff, aoff1); } else { _Pragma("unroll") for (int m = 0; m < 4; ++m) _Pragma("unroll") for (int k = 0; k < 2; ++k) dst[m][k] = *(const PG8_LAS bf16x8*)(lds + PG8_SA(b, h) + aoff + m * 2048 + k * aoff1); } } while (0)
#define PG8_LDB(dst, b, h) do { if constexpr (FP8) { PG8_LD8(dst##8, 2, PG8_SB(b, h), boff, boff1); } else { _Pragma("unroll") for (int n = 0; n < 2; ++n) _Pragma("unroll") for (int k = 0; k < 2; ++k) dst[n][k] = *(const PG8_LAS bf16x8*)(lds + PG8_SB(b, h) + boff + n * 2048 + k * boff1); } } while (0)
#define PG8_MMA(ai, bj, At, Bt) do { if constexpr (FP8) __builtin_amdgcn_sched_barrier(0); __builtin_amdgcn_s_setprio(1); _Pragma("unroll") for (int m = 0; m < 4; ++m) _Pragma("unroll") for (int n = 0; n < 2; ++n) { \
        if constexpr (FP8) { asm volatile("v_mfma_scale_f32_16x16x128_f8f6f4 %0, %1, %2, %0, %3, %4 op_sel_hi:[0,0,0]" : "+v"(acc[ai][bj][m][n]) : "v"(Bt##8[n]), "v"(At##8[m]), "v"(sclB), "v"(sclA)); } \
        else { _Pragma("unroll") for (int k = 0; k < 2; ++k) acc[ai][bj][m][n] = __builtin_amdgcn_mfma_f32_16x16x32_bf16(Bt[n][k], At[m][k], acc[ai][bj][m][n], 0, 0, 0); } } \
        __builtin_amdgcn_s_setprio(0); if constexpr (FP8) __builtin_amdgcn_sched_barrier(0); } while (0)
#define PG8_WAIT_V(n) asm volatile("s_waitcnt vmcnt(" #n ")" ::: "memory")
#define PG8_WAIT_L(n) asm volatile("s_waitcnt lgkmcnt(" #n ")" ::: "memory")
#define PG8_BAR __builtin_amdgcn_s_barrier()
#define PG8_SCHED __builtin_amdgcn_sched_barrier(0)
    Unit cur, nxt; int ui = 0;
    if (!S.next(0, cur)) return;
    f32x4 acc[2][2][4][2];
#pragma unroll
    for (int a = 0; a < 2; ++a)
#pragma unroll
        for (int b = 0; b < 2; ++b)
#pragma unroll
            for (int m = 0; m < 4; ++m)
#pragma unroll
                for (int n = 0; n < 2; ++n) acc[a][b][m][n] = (f32x4){0.f, 0.f, 0.f, 0.f};
    bf16x8 At[4][2], B0[2][2], B1[2][2];
    typedef int v8i_ __attribute__((ext_vector_type(8))); typedef int v4i_ __attribute__((ext_vector_type(4)));
    int sclB = SCALE_B * 0x01010101, sclA = 0x7f7f7f7f; asm volatile("" : "+v"(sclB), "+v"(sclA));
    v8i_ At8[4], B08[2], B18[2];
    const char* cA = (const char*)g.A + (Sched::GATHER ? (size_t)0 : (size_t)cur.pm * tstep); const char* cB = (const char*)g.Bt + (size_t)cur.pn * tstep;
    PG8_GOFF(voGc, cur.pm);
    S.a_ready(cur);
    if constexpr (SP2) {
        PG8_STAGE(PG8_SB(0, 0), cB, voffB); PG8_STAGE(PG8_SB(0, 1), cB + hstep, voffB); PG8_STAGE_A(PG8_SA(0, 0), cA, 0, false); PG8_STAGE_A(PG8_SA(0, 1), cA, 1, false);
        if (wr == 1) PG8_BAR;
        PG8_WAIT_V(2); PG8_BAR;
        PG8_STAGE(PG8_SB(1, 0), cB + kstep, voffB); PG8_STAGE_A(PG8_SA(1, 0), cA + kstep, 0, false); PG8_STAGE(PG8_SB(1, 1), cB + hstep + kstep, voffB);
        PG8_WAIT_V(6); PG8_BAR;
    } else {
        PG8_STAGE(PG8_SB(0, 0), cB, voffB); PG8_STAGE_A(PG8_SA(0, 0), cA, 0, false); PG8_STAGE(PG8_SB(0, 1), cB + hstep, voffB); PG8_STAGE_A(PG8_SA(0, 1), cA, 1, false);
        if (wr == 1) PG8_BAR;
        PG8_WAIT_V(4); PG8_BAR;
        PG8_STAGE(PG8_SB(1, 0), cB + kstep, voffB); PG8_STAGE_A(PG8_SA(1, 0), cA + kstep, 0, false); PG8_STAGE(PG8_SB(1, 1), cB + hstep + kstep, voffB);
        PG8_WAIT_V(6); PG8_BAR;
    }
    for (;;) {
        const bool has_next = S.next(ui + 1, nxt);
        const char* nA = has_next ? (const char*)g.A + (Sched::GATHER ? (size_t)0 : (size_t)nxt.pm * tstep) : cA;
        if constexpr (Sched::GATHER) { unsigned _vn[2][2]; if (has_next) { PG8_GOFF(_vn, nxt.pm); } else { _Pragma("unroll") for (int _h = 0; _h < 2; ++_h) _Pragma("unroll") for (int _i = 0; _i < 2; ++_i) _vn[_h][_i] = voGc[_h][_i]; }
            _Pragma("unroll") for (int _h = 0; _h < 2; ++_h) _Pragma("unroll") for (int _i = 0; _i < 2; ++_i) voGn_l[(_h * 2 + _i) * 512] = _vn[_h][_i]; } const char* nB = has_next ? (const char*)g.Bt + (size_t)nxt.pn * tstep : cB;
        for (int t = 0; t < nt; t += 2) {
            const bool last = (t == nt - 2);
            const char* a1 = cA + (size_t)(t + 1) * kstep;
            const char* a2 = last ? nA : cA + (size_t)(t + 2) * kstep; const char* b2 = last ? nB : cB + (size_t)(t + 2) * kstep;
            const char* a3 = a2 + kstep; const char* b3 = b2 + kstep;
            if (last && has_next) S.a_ready(nxt);
            if constexpr (SP2) {
            PG8_LDB(B0, 0, 0); PG8_LDB(B1, 0, 1); PG8_SCHED; PG8_LDA(At, 0, 0); PG8_STAGE_A(PG8_SA(1, 1), a1, 1, false);
            PG8_WAIT_V(8); PG8_WAIT_L(0); PG8_BAR; PG8_MMA(0, 0, At, B0); PG8_MMA(0, 1, At, B1); PG8_BAR; PG8_SCHED;
            PG8_LDA(At, 0, 1); PG8_STAGE(PG8_SB(0, 0), b2, voffB); PG8_STAGE(PG8_SB(0, 1), b2 + hstep, voffB); PG8_STAGE_A(PG8_SA(0, 0), a2, 0, last);
            PG8_WAIT_V(8); PG8_WAIT_L(0); PG8_BAR; PG8_MMA(1, 0, At, B0); PG8_MMA(1, 1, At, B1); PG8_BAR; PG8_SCHED;
            PG8_LDB(B0, 1, 0); PG8_LDB(B1, 1, 1); PG8_SCHED; PG8_LDA(At, 1, 0); PG8_STAGE_A(PG8_SA(0, 1), a2, 1, last);
            PG8_WAIT_V(8); PG8_WAIT_L(0); PG8_BAR; PG8_MMA(0, 0, At, B0); PG8_MMA(0, 1, At, B1); PG8_BAR; PG8_SCHED;
            PG8_LDA(At, 1, 1); PG8_STAGE(PG8_SB(1, 0), b3, voffB); PG8_STAGE(PG8_SB(1, 1), b3 + hstep, voffB); PG8_STAGE_A(PG8_SA(1, 0), a3, 0, last);
            PG8_WAIT_V(8); PG8_WAIT_L(0); PG8_BAR; PG8_MMA(1, 0, At, B0); PG8_MMA(1, 1, At, B1); PG8_BAR; PG8_SCHED;
            } else {
            PG8_LDB(B0, 0, 0); PG8_SCHED; PG8_LDA(At, 0, 0); PG8_STAGE_A(PG8_SA(1, 1), a1, 1, false);
            PG8_WAIT_L(8); PG8_BAR; PG8_WAIT_L(0); PG8_MMA(0, 0, At, B0); PG8_BAR; PG8_SCHED;
            PG8_LDB(B1, 0, 1); PG8_STAGE(PG8_SB(0, 0), b2, voffB);
            PG8_BAR; PG8_WAIT_L(0); PG8_MMA(0, 1, At, B1); PG8_BAR;
            PG8_LDA(At, 0, 1); PG8_STAGE_A(PG8_SA(0, 0), a2, 0, last);
            PG8_BAR; PG8_WAIT_L(0); PG8_MMA(1, 0, At, B0); PG8_BAR; PG8_SCHED;
            PG8_STAGE(PG8_SB(0, 1), b2 + hstep, voffB);
            PG8_WAIT_V(6); PG8_BAR; PG8_MMA(1, 1, At, B1); PG8_BAR;
            PG8_LDB(B0, 1, 0); PG8_SCHED; PG8_LDA(At, 1, 0); PG8_STAGE_A(PG8_SA(0, 1), a2, 1, last);
            PG8_WAIT_L(8); PG8_BAR; PG8_WAIT_L(0); PG8_MMA(0, 0, At, B0); PG8_BAR; PG8_SCHED;
            PG8_LDB(B1, 1, 1); PG8_STAGE(PG8_SB(1, 0), b3, voffB);
            PG8_BAR; PG8_WAIT_L(0); PG8_MMA(0, 1, At, B1); PG8_BAR;
            PG8_LDA(At, 1, 1); PG8_STAGE_A(PG8_SA(1, 0), a3, 0, last);
            PG8_BAR; PG8_WAIT_L(0); PG8_MMA(1, 0, At, B0); PG8_BAR; PG8_SCHED;
            PG8_STAGE(PG8_SB(1, 1), b3 + hstep, voffB);
            PG8_WAIT_V(6); PG8_BAR; PG8_MMA(1, 1, At, B1); PG8_BAR;
            }
            if constexpr (Epi::MIDK) { if (((t + 2) & 7) == 0 && t + 2 < nt) E.mid(acc, cur, ((t + 2) >> 3) - 1, wr, wc, fr, fq); }
        }
        if constexpr (FP8) asm volatile("s_nop 15\n\ts_nop 15" ::: "memory");
        if constexpr (ALIGN_EPI) { if (wr == 0) PG8_BAR; }
        if constexpr (!Epi::AFTER_DRAIN) { E(acc, cur, wr, wc, fr, fq); S.done(cur); }
        if (!has_next) break;
#pragma unroll
        for (int a = 0; a < 2; ++a)
#pragma unroll
            for (int b = 0; b < 2; ++b)
#pragma unroll
                for (int m = 0; m < 4; ++m)
#pragma unroll
                    for (int n = 0; n < 2; ++n) acc[a][b][m][n] = (f32x4){0.f, 0.f, 0.f, 0.f};
        cur = nxt; cA = nA; cB = nB; ++ui;
        if constexpr (Sched::GATHER) { _Pragma("unroll") for (int _h = 0; _h < 2; ++_h) _Pragma("unroll") for (int _i = 0; _i < 2; ++_i) voGc[_h][_i] = voGn_l[(_h * 2 + _i) * 512]; }
        if constexpr (ALIGN_EPI) { if (wr == 1) PG8_BAR; }
    }
    PG8_WAIT_V(0);
    if constexpr (!ALIGN_EPI) { if (wr == 0) PG8_BAR; }
    PG8_BAR;
#undef PG8_SA
#undef PG8_SB
#undef PG8_STAGE
#undef PG8_STAGE_A
#undef PG8_GOFF
#undef PG8_LDA
#undef PG8_LD8
#undef PG8_LDB
#undef PG8_MMA
#undef PG8_WAIT_V
#undef PG8_WAIT_L
#undef PG8_BAR
#undef PG8_SCHED
}
}
constexpr int BATCH = 4, SEQ = 8192, DM = 1024, NTOK = BATCH * SEQ, DEPTH = 2, NEXP = 32;
constexpr int D_IN = 8524, ZP = 8704;
constexpr int Z_AQ = 0, Z_AK = 512, Z_AV = 1024, Z_FQ = 1536, Z_FK = 2048, Z_FV = 2560, Z_CQ = 3072, Z_CF = 3584, Z_CI = 4096, Z_CG = 4608, Z_GT = 5120, Z_IQ = 8192, Z_IK = 8448, Z_IW = 8512, Z_FF = 8516;
constexpr int OP = 1536;
constexpr int MAXBLK = 544, MAXSLOT = MAXBLK * 256;
constexpr int BST_OFF = 16 + MAXBLK + 16;
constexpr float LOG2E = 1.4426950408889634f;
constexpr float QSCALE = 0.125f * LOG2E;
constexpr float ALPHA = 1.4142135623730951f;
constexpr float LN_EPS = 1e-5f, RMS_EPS = 1e-6f;
constexpr int NWAVES = 8, NTHR = 512;
constexpr float W8_SCALE = 64.0f; constexpr int W8_E8M0 = 127 - 6;
constexpr int NPH_LAYER = 14, NPHASES = 1 + DEPTH * NPH_LAYER;
enum { PH_INPROJ = 0, PH_PREP, PH_IDX, PH_ATTN, PH_H1, PH_H2, PH_H3, PH_MERGE, PH_WOUT, PH_LN1, PH_SLOT, PH_GU, PH_DOWN, PH_COMB };

__host__ __device__ __forceinline__ int zcol_src(int n) {
    if (n < 1024 || (n >= 8192 && n < 8512)) { const int p = n & 63; n = (n & ~63) + ((p & 1) ? 32 + (p >> 1) : (p >> 1)); }
    if (n < 1536) return n;
    if (n < 3072) return 1860 + (n - 1536);
    if (n < 5120) return 3404 + (n - 3072);
    if (n < 8192) return 5452 + (n - 5120);
    if (n < 8448) return 1536 + (n - 8192);
    if (n < 8512) return 1792 + (n - 8448);
    if (n < 8516) return 1856 + (n - 8512);
    if (n < 8524) return 3396 + (n - 8516);
    return -1;
}

constexpr size_t MiB = 1u << 20;
constexpr size_t WS_CTL = 0, CTL_ZERO_BYTES = 1 * MiB;
constexpr size_t WS_TRIG = 1 * MiB;
constexpr size_t WS_LFT = 3 * MiB;
constexpr size_t WS_CT = 4 * MiB;
constexpr size_t WS_DG = 5 * MiB, WS_D2G = 6 * MiB;
constexpr size_t WS_WGCNT = 7 * MiB;
constexpr size_t WS_BLK = 7 * MiB + 64 * 1024;
constexpr size_t WS_BGU = 7 * MiB + 128 * 1024;
constexpr size_t WS_TKE = 8 * MiB, WS_TKG = 8 * MiB + 512 * 1024, WS_TOKSLOT = 9 * MiB, WS_GSLOT = 9 * MiB + 512 * 1024;
constexpr size_t WS_SLOTTOK = 10 * MiB + 512 * 1024;
constexpr size_t WS_WRF = 11 * MiB;
constexpr size_t WS_WIN = 12 * MiB;
constexpr size_t WS_WP = 46 * MiB;
constexpr size_t WS_WOUT = 52 * MiB;
constexpr size_t WS_WGU = 56 * MiB;
constexpr size_t WS_WDN = 312 * MiB;
constexpr size_t WS_Z = 440 * MiB;
constexpr size_t WS_XG = WS_Z, WS_ACT = WS_Z + 272 * MiB;
constexpr size_t WS_OBUF = 984 * MiB;
constexpr size_t WS_MERGED = 1080 * MiB;
constexpr size_t WS_MIX = 1144 * MiB;
constexpr size_t WS_Y = WS_OBUF;
constexpr size_t WS_X1 = 1272 * MiB;
constexpr size_t WS_X1B = 1400 * MiB;
constexpr size_t WS_XCUR = 1464 * MiB;
constexpr size_t WS_XB = 1592 * MiB;
constexpr size_t WS_MASKW = 1656 * MiB;
constexpr size_t WS_UG = 1688 * MiB;
constexpr size_t WS_SST = 1752 * MiB;
constexpr size_t WS_SB = 7 * MiB + 768 * 1024;
constexpr size_t WS_KA = 1784 * MiB;
constexpr size_t WS_XB8 = 192 * MiB;
constexpr size_t WS_IKC = 184 * MiB;
constexpr size_t WS_END = 1792 * MiB;
static_assert(WS_Y + (size_t)MAXSLOT * 1024 * 2 <= WS_X1 && WS_ACT + (size_t)MAXSLOT * 1024 * 2 <= WS_OBUF, "ws map");
constexpr int CW_TMO = 0;
constexpr int CW_BAR = 4096;
constexpr int CW_SB = 512;

constexpr int SCR_BYTES = 153600;
constexpr int MISC_OFF = SCR_BYTES;
constexpr int LDS_BYTES = SCR_BYTES + 256;

#define RLX_AGENT __ATOMIC_RELAXED, __HIP_MEMORY_SCOPE_AGENT
#define LDS_WAIT() asm volatile("s_waitcnt lgkmcnt(0)" ::: "memory")
#define VM_WAIT() asm volatile("s_waitcnt vmcnt(0)" ::: "memory")
#define WG_BAR() asm volatile("s_waitcnt vmcnt(0) lgkmcnt(0)\n\ts_barrier" ::: "memory")
#define WG_BAR_LDS() asm volatile("s_waitcnt lgkmcnt(0)\n\ts_barrier" ::: "memory")

#define XB_TMO      128
#define XB_XCNT(j)  (256  + 64 * (j))
#define XB_XSUB(j)  (1280 + 64 * (j))
#define XB_XGEN(j)  (2304 + 64 * (j))
#define XB_TOP      3328
#define XB_TOPGEN   3392
#define XCD_BAR_WORDS 3456
#define XB_SPIN_CAP (1u << 18)

__device__ __forceinline__ unsigned xb_ld(unsigned* p)              { return __hip_atomic_load(p, __ATOMIC_RELAXED, __HIP_MEMORY_SCOPE_AGENT); }
__device__ __forceinline__ unsigned xb_add(unsigned* p, unsigned v) { return __hip_atomic_fetch_add(p, v, __ATOMIC_RELAXED, __HIP_MEMORY_SCOPE_AGENT); }
__device__ __forceinline__ unsigned xb_xcc_id() { return (unsigned)__builtin_amdgcn_s_getreg((3 << 11) | 20) & 0xFu; }
#define XB_SPIN(cond, bar) do { unsigned _sp = 0; while (cond) { __builtin_amdgcn_s_sleep(1); \
    if ((++_sp & 255u) == 0u) { if (xb_ld(&(bar)[XB_TMO])) break; if (_sp > XB_SPIN_CAP) { atomicAdd(&(bar)[XB_TMO], 1u); break; } } } } while (0)

struct XcdBarrier {
    unsigned* bar; unsigned x;
    volatile LAS unsigned* st;
};

__device__ __forceinline__ XcdBarrier xcd_barrier_post(unsigned* bar, volatile LAS unsigned* st) {
    XcdBarrier b; b.bar = bar; b.x = xb_xcc_id(); b.st = st;
    if (threadIdx.x == 0) (void)xb_add(&bar[XB_XCNT(b.x)], 1u);
    return b;
}
__device__ __forceinline__ void xcd_barrier_complete(unsigned* bar, unsigned x, unsigned& nloc, unsigned& nx) {
    const unsigned G = gridDim.x * gridDim.y * gridDim.z;
    unsigned sum, cnt, mine, sp = 0u;
    for (;;) {
        sum = 0u; cnt = 0u; mine = 0u;
#pragma unroll
        for (unsigned j = 0; j < 16; ++j) { const unsigned c = xb_ld(&bar[XB_XCNT(j)]); sum += c; cnt += (c > 0u) ? 1u : 0u; mine = (j == x) ? c : mine; }
        if (sum == G) break;
        __builtin_amdgcn_s_sleep(1);
        if ((++sp & 255u) == 0u) { if (xb_ld(&bar[XB_TMO])) break; if (sp > XB_SPIN_CAP) { atomicAdd(&bar[XB_TMO], 1u); break; } }
    }
    nloc = mine > 0u ? mine : 1u; nx = cnt > 0u ? cnt : 1u;
}

__device__ __forceinline__ void xcd_barrier(const XcdBarrier& b) {
    asm volatile("s_waitcnt vmcnt(0)" ::: "memory");
    __syncthreads();
    if (threadIdx.x == 0) {
        unsigned* bar = b.bar;
        __builtin_amdgcn_s_waitcnt(0);
        unsigned nloc = b.st[0], nx = b.st[1];
        if (nloc == 0u) { xcd_barrier_complete(bar, b.x, nloc, nx); b.st[0] = nloc; b.st[1] = nx; }
        const unsigned old = xb_add(&bar[XB_XSUB(b.x)], 1u);
        const unsigned gen = old / nloc;
        if (old + 1u == (gen + 1u) * nloc) {
            __builtin_amdgcn_fence(__ATOMIC_RELEASE, "agent");
            asm volatile("s_waitcnt vmcnt(0)" ::: "memory");
            const unsigned og = xb_add(&bar[XB_TOP], 1u);
            const unsigned tg = og / nx;
            if (og + 1u == (tg + 1u) * nx) xb_add(&bar[XB_TOPGEN], 1u);
            else XB_SPIN(xb_ld(&bar[XB_TOPGEN]) == tg, bar);
            __builtin_amdgcn_fence(__ATOMIC_ACQUIRE, "agent");
            xb_add(&bar[XB_XGEN(b.x)], 1u);
            asm volatile("s_waitcnt vmcnt(0)" ::: "memory");
        } else {
            XB_SPIN(xb_ld(&bar[XB_XGEN(b.x)]) == gen, bar);
            __builtin_amdgcn_fence(__ATOMIC_ACQUIRE, "agent");
            asm volatile("s_waitcnt vmcnt(0)" ::: "memory");
        }
    }
    __syncthreads();
}
__device__ __forceinline__ int lane_id() { int l = (int)__builtin_amdgcn_mbcnt_hi(~0u, __builtin_amdgcn_mbcnt_lo(~0u, 0u)); asm volatile("" : "+v"(l)); return l; }
__device__ __forceinline__ float wave_sum(float v) {
#pragma unroll
    for (int o = 1; o < 64; o <<= 1) v += __shfl_xor(v, o);
    return v;
}
__device__ __forceinline__ int crow(int r, int hi) { return (r & 3) + 8 * (r >> 2) + 4 * hi; }
__device__ __forceinline__ void glds16(const void* gsrc, unsigned lds_dst) { unsigned keep;
    asm volatile("s_mov_b32 %0, m0\n\ts_mov_b32 m0, %2\n\ts_nop 0\n\tglobal_load_lds_dwordx4 %1, off\n\ts_mov_b32 m0, %0" : "=&s"(keep) : "v"(gsrc), "s"(lds_dst) : "memory"); }
__device__ __forceinline__ void glds4(const void* gsrc, unsigned lds_dst) { unsigned keep;
    asm volatile("s_mov_b32 %0, m0\n\ts_mov_b32 m0, %2\n\ts_nop 0\n\tglobal_load_lds_dword %1, off\n\ts_mov_b32 m0, %0" : "=&s"(keep) : "v"(gsrc), "s"(lds_dst) : "memory"); }
typedef __bf16 bf16x2_t __attribute__((ext_vector_type(2)));
__device__ __forceinline__ unsigned cvtpk(float lo, float hi) { const f32x2 v = {lo, hi}; const bf16x2_t b = __builtin_convertvector(v, bf16x2_t); return __builtin_bit_cast(unsigned, b); }
typedef short v4i16_t __attribute__((ext_vector_type(4)));
__device__ __forceinline__ s16x4 vtr(const LAS char* p) { return __builtin_bit_cast(s16x4, __builtin_amdgcn_ds_read_tr16_b64_v4i16((LAS v4i16_t*)p)); }
__device__ __forceinline__ void plswap(float& a, float& b) { asm volatile("s_nop 1\n\tv_permlane32_swap_b32 %0, %1\n\ts_nop 1" : "+v"(a), "+v"(b)); }
__device__ __forceinline__ float swapmax(float m) { float a = m, b = m; plswap(a, b); return fmaxf(a, b); }
__device__ __forceinline__ float swapsum(float m) { float a = m, b = m; plswap(a, b); return a + b; }
#define MFMA32(a, b, c) __builtin_amdgcn_mfma_f32_32x32x16_bf16((a), (b), (c), 0, 0, 0)

struct Params {
    const float* x; const float* w_in; const float* b_fox; const float* lb_logits; const float* norm_g; const float* w_pa; const float* w_pb; const float* w_pc; const float* w_out;
    const float* ln1_g; const float* ln1_b; const float* w_router; const float* b_router; const float* w_gu; const float* b_gu; const float* w_down; const float* b_down; const float* ln2_g; const float* ln2_b;
    float* out; unsigned char* ws; int ph_lo, ph_hi, use_bar, pad;
};

typedef const __attribute__((address_space(4))) Params* KP;
__device__ __forceinline__ KP load_params() { KP kp = (KP)__builtin_amdgcn_kernarg_segment_ptr(); asm volatile("" : "+s"(kp)); return kp; }

template <class F> __device__ __forceinline__ void cvt_tile(const float* W, size_t ldsrc, int k0, bf16* WT, size_t ldw, int kd0, int n0, const F& f, LAS float* scr, int lane) {
    const int c = lane & 31; int sc; float scale; f(n0 + c, sc, scale);
#pragma unroll 8
    for (int i = 0; i < 32; ++i) { const int kk = 2 * i + (lane >> 5); scr[kk * 33 + c] = sc >= 0 ? W[(size_t)(k0 + kk) * ldsrc + sc] * scale : 0.f; }
    LDS_WAIT(); asm volatile("" ::: "memory");
    const int ch = lane & 7;
#pragma unroll
    for (int j = 0; j < 4; ++j) { const int n = (lane >> 3) + 8 * j; const LAS float* s = scr + (8 * ch) * 33 + n;
        u32x4 o; o.x = pk2(s[0 * 33], s[1 * 33]); o.y = pk2(s[2 * 33], s[3 * 33]); o.z = pk2(s[4 * 33], s[5 * 33]); o.w = pk2(s[6 * 33], s[7 * 33]);
        *(u32x4*)(WT + (size_t)(n0 + n) * ldw + kd0 + 8 * ch) = o; }
    LDS_WAIT(); asm volatile("" ::: "memory");
}
template <class F> __device__ __forceinline__ void cvt_tile8(const float* W, size_t ldsrc, int k0, unsigned char* WT, size_t ldw, int n0, const F& f, float wscale, LAS float* scr, int lane) {
    const int c = lane & 31; int sc; float scale; f(n0 + c, sc, scale); scale *= wscale;
#pragma unroll 8
    for (int i = 0; i < 32; ++i) { const int kk = 2 * i + (lane >> 5); scr[kk * 33 + c] = sc >= 0 ? W[(size_t)(k0 + kk) * ldsrc + sc] * scale : 0.f; }
    LDS_WAIT(); asm volatile("" ::: "memory");
    const int ch = lane & 7;
#pragma unroll
    for (int j = 0; j < 4; ++j) { const int n = (lane >> 3) + 8 * j; const LAS float* s = scr + (8 * ch) * 33 + n;
        int w0 = __builtin_amdgcn_cvt_pk_fp8_f32(s[0 * 33], s[1 * 33], 0, false); w0 = __builtin_amdgcn_cvt_pk_fp8_f32(s[2 * 33], s[3 * 33], w0, true);
        int w1 = __builtin_amdgcn_cvt_pk_fp8_f32(s[4 * 33], s[5 * 33], 0, false); w1 = __builtin_amdgcn_cvt_pk_fp8_f32(s[6 * 33], s[7 * 33], w1, true);
        *(u32x2*)(WT + (size_t)(n0 + n) * ldw + k0 + 8 * ch) = (u32x2){(unsigned)w0, (unsigned)w1}; }
    LDS_WAIT(); asm volatile("" ::: "memory");
}
template <class F> __device__ __forceinline__ void cvt_tile8w(const float* W, size_t ldsrc, int k0, unsigned char* WT, size_t ldw, int n0, const F& f, float wscale, LAS float* scr, int lane) {
    const int c = lane & 31; int sc; float scale; f(n0 + c, sc, scale); scale *= wscale;
#pragma unroll 16
    for (int i = 0; i < 64; ++i) { const int kk = 2 * i + (lane >> 5); scr[kk * 33 + c] = sc >= 0 ? W[(size_t)(k0 + kk) * ldsrc + sc] * scale : 0.f; }
    LDS_WAIT(); asm volatile("" ::: "memory");
    const int ch = lane & 15;
#pragma unroll
    for (int j = 0; j < 8; ++j) { const int n = (lane >> 4) + 4 * j; const LAS float* s = scr + (8 * ch) * 33 + n;
        int w0 = __builtin_amdgcn_cvt_pk_fp8_f32(s[0 * 33], s[1 * 33], 0, false); w0 = __builtin_amdgcn_cvt_pk_fp8_f32(s[2 * 33], s[3 * 33], w0, true);
        int w1 = __builtin_amdgcn_cvt_pk_fp8_f32(s[4 * 33], s[5 * 33], 0, false); w1 = __builtin_amdgcn_cvt_pk_fp8_f32(s[6 * 33], s[7 * 33], w1, true);
        *(u32x2*)(WT + (size_t)(n0 + n) * ldw + k0 + 8 * ch) = (u32x2){(unsigned)w0, (unsigned)w1}; }
    LDS_WAIT(); asm volatile("" ::: "memory");
}
struct MapIn { __device__ __forceinline__ void operator()(int n, int& sc, float& s) const { sc = zcol_src(n); s = (n < 512 || (n >= Z_FQ && n < Z_FK)) ? QSCALE : 1.0f; } };
struct MapGu { __device__ __forceinline__ void operator()(int n, int& sc, float& s) const { sc = (n & 1) ? 1024 + (n >> 1) : (n >> 1); s = 1.0f; } };
struct MapId { __device__ __forceinline__ void operator()(int n, int& sc, float& s) const { sc = n; s = 1.0f; } };

__device__ __forceinline__ void p0_prologue(KP p, LAS unsigned char* lds, int gw, int NGW, int wave, int lane) {
    LAS float* scr = (LAS float*)(lds + wave * 17408);
    unsigned char* ws = p->ws;
    constexpr int I_IN = 8 * 272, I_GU = 32 * 8 * 64, I_DN = 32 * 8 * 32, I_P = 3 * 8 * 32, I_OUT = 16 * 32, I_LAYER = I_IN + I_GU + I_DN + I_P + I_OUT;
    for (int it = gw; it < DEPTH * I_LAYER; it += NGW) {
        const int l = it / I_LAYER; int r = it - l * I_LAYER;
        if (r < I_IN) { const int kb = r / 272, nb = r % 272;
            cvt_tile8w(p->w_in + (size_t)l * 1024 * D_IN, D_IN, 128 * kb, (unsigned char*)(ws + WS_WIN) + (size_t)l * ZP * 1024, 1024, 32 * nb, MapIn{}, W8_SCALE, scr, lane); continue; } r -= I_IN;
        if (r < I_GU) { const int e = r >> 9, r2 = r & 511, kb = r2 >> 6, nb = r2 & 63;
            cvt_tile8w(p->w_gu + (size_t)(l * 32 + e) * 1024 * 2048, 2048, 128 * kb, (unsigned char*)(ws + WS_WGU) + (size_t)(l * 32 + e) * 2048 * 1024, 1024, 32 * nb, MapGu{}, W8_SCALE, scr, lane); continue; } r -= I_GU;
        if (r < I_DN) { const int e = r >> 8, r2 = r & 255, kb = r2 >> 5, nb = r2 & 31;
            cvt_tile8w(p->w_down + (size_t)(l * 32 + e) * 1024 * 1024, 1024, 128 * kb, (unsigned char*)(ws + WS_WDN) + (size_t)(l * 32 + e) * 1024 * 1024, 1024, 32 * nb, MapId{}, W8_SCALE, scr, lane); continue; } r -= I_DN;
        if (r < I_P) { const int br = r >> 8, r2 = r & 255, kb = r2 >> 5, nb = r2 & 31; const float* W = (br == 0 ? p->w_pa : br == 1 ? p->w_pb : p->w_pc) + (size_t)l * 512 * 1024;
            cvt_tile(W, 1024, 64 * kb, (bf16*)(ws + WS_WP) + (size_t)l * 1024 * 1536, 1536, br * 512 + 64 * kb, 32 * nb, MapId{}, scr, lane); continue; } r -= I_P;
        { const int kb = r >> 5, nb = r & 31;
            cvt_tile(p->w_out + (size_t)l * 1024 * 1024, 1024, 64 * kb, (bf16*)(ws + WS_WOUT) + (size_t)l * 1024 * 1024, 1024, 64 * kb, 32 * nb, MapId{}, scr, lane); }
    }
    { float* bg = (float*)(ws + WS_BGU);
      for (int i = gw * 64 + lane; i < DEPTH * 32 * 2048; i += NGW * 64) { const int n = i & 2047, le = i >> 11; bg[i] = p->b_gu[(size_t)le * 2048 + ((n & 1) ? 1024 + (n >> 1) : (n >> 1))]; } }
    { bf16* wf = (bf16*)(ws + WS_WRF);
      for (int i = gw * 64 + lane; i < DEPTH * 32 * 2 * 64 * 8; i += NGW * 64) { const int ii = i & 7, ln = (i >> 3) & 63, nt = (i >> 9) & 1, s = (i >> 10) & 31, l = i >> 15;
          const int k = 32 * s + 8 * (ln >> 4) + ii, e = 16 * nt + (ln & 15); const float w = p->w_router[((size_t)l * 1024 + k) * 32 + e];
          const unsigned hb = f2bf(w); const float lo = w - bf2f(hb);
          const size_t base = ((((size_t)l * 32 + s) * 2 + nt) * 2) * 512 + ln * 8 + ii; wf[base] = (bf16)hb; wf[base + 512] = (bf16)f2bf(lo); } }
    { f32x2* tg = (f32x2*)(ws + WS_TRIG);
      for (int i = gw * 64 + lane; i < SEQ * 32; i += NGW * 64) { const int pos = i >> 5, k = i & 31;
          const float inv = exp2f(-(float)k * (13.287712379549449f / 32.0f)); const float ang = (float)pos * inv;
          const double rev = (double)ang * 0.15915494309189535; const float fr = (float)(rev - __builtin_rint(rev));
          tg[i] = (f32x2){__builtin_amdgcn_cosf(fr), __builtin_amdgcn_sinf(fr)}; } }
    { bf16* xb = (bf16*)(ws + WS_XB);
      for (int m = gw; m < NTOK; m += NGW) { const f32x4* xr = (const f32x4*)(p->x + (size_t)m * DM) + lane; u32x2* o = (u32x2*)(xb + (size_t)m * DM) + lane;
#pragma unroll
          for (int j = 0; j < 4; ++j) { const f32x4 v = xr[64 * j]; o[64 * j] = (u32x2){pk2(v.x, v.y), pk2(v.z, v.w)};
              int w8 = __builtin_amdgcn_cvt_pk_fp8_f32(v.x, v.y, 0, false); w8 = __builtin_amdgcn_cvt_pk_fp8_f32(v.z, v.w, w8, true); ((unsigned*)(ws + WS_XB8 + (size_t)m * DM))[lane + 64 * j] = (unsigned)w8; } } }
}

__device__ __forceinline__ void prep_phase(KP p, int l, int gw, int NGW, int lane) {
    unsigned char* ws = p->ws; bf16* Z = (bf16*)(ws + WS_Z); const f32x2* tg = (const f32x2*)(ws + WS_TRIG); float* lfT = (float*)(ws + WS_LFT);
    const float bf_l = (lane < 8) ? p->b_fox[l * 8 + lane] : 0.f;
    for (int m = gw; m < NTOK; m += NGW) {
        bf16* zr = Z + (size_t)m * ZP; const int pos = m & (SEQ - 1), b = m >> 13;
        const f32x2 cs = tg[pos * 32 + (lane & 31)];
        unsigned short ta[11], tb[11];
#pragma unroll
        for (int it = 0; it < 11; ++it) { const int hh = 2 * it + (lane >> 5); const int hc = hh < 21 ? hh : 20;
            const int col = hc < 8 ? Z_AQ + hc * 64 : hc < 16 ? Z_AK + (hc - 8) * 64 : hc < 20 ? Z_IQ + (hc - 16) * 64 : Z_IK;
            const bf16* q = zr + col + (lane & 31); ta[it] = q[0]; tb[it] = q[32]; }
#pragma unroll
        for (int it = 0; it < 11; ++it) { const int hh = 2 * it + (lane >> 5);
            if (hh < 21) { const int col = hh < 8 ? Z_AQ + hh * 64 : hh < 16 ? Z_AK + (hh - 8) * 64 : hh < 20 ? Z_IQ + (hh - 16) * 64 : Z_IK;
                bf16* q = zr + col + (lane & 31); const float t1 = bf2f(ta[it]), t2 = bf2f(tb[it]);
                q[0] = (bf16)f2bf(t1 * cs.x - t2 * cs.y); q[32] = (bf16)f2bf(t2 * cs.x + t1 * cs.y); } }
#pragma unroll
        for (int j = 0; j < 2; ++j) { bf16* g0p = zr + Z_GT + lane * 8 + j * 512; const u32x4 a = *(const u32x4*)g0p, bb = *(const u32x4*)(g0p + 1024), cc = *(const u32x4*)(g0p + 2048);
            u32x4 o0, o1, o2;
#pragma unroll
            for (int i = 0; i < 4; ++i) {
                const float e0l = __expf(-bflo(a[i])), e0h = __expf(-bfhi(a[i])), e1l = __expf(-bflo(bb[i])), e1h = __expf(-bfhi(bb[i])), e2l = __expf(-bflo(cc[i])), e2h = __expf(-bfhi(cc[i]));
                o0[i] = pk2((1.f + e1l) / (1.f + e0l), (1.f + e1h) / (1.f + e0h));
                o1[i] = pk2((1.f + e2l) / (1.f + e1l), (1.f + e2h) / (1.f + e1h));
                o2[i] = pk2(1.f / (1.f + e2l), 1.f / (1.f + e2h)); }
            *(u32x4*)g0p = o0; *(u32x4*)(g0p + 1024) = o1; *(u32x4*)(g0p + 2048) = o2; }
        if (lane < 8) { const float v = bf2f(zr[Z_FF + lane]) + bf_l; const float ls = fminf(v, 0.f) - __logf(1.0f + __expf(-fabsf(v))); lfT[(size_t)(b * 8 + lane) * SEQ + pos] = ls * LOG2E; }
    }
}

constexpr int IX_CAP = 1024, IX_STRIDE = IX_CAP + 1  , IX_TRIG = 768, IX_CAND = 0, IX_BM = 0  , IX_HIST = 32 * IX_STRIDE * 4, IX_CNT = IX_HIST + 8 * 1024, IX_TAU = IX_CNT + 128, IX_FLAG = IX_TAU + 128, IX_END = IX_FLAG + 64;
static_assert(IX_END <= SCR_BYTES, "indexer LDS");

__device__ __forceinline__ int wave_incl_sum(int v) {
    v += __builtin_amdgcn_update_dpp(0, v, 0x111, 0xf, 0xf, false);
    v += __builtin_amdgcn_update_dpp(0, v, 0x112, 0xf, 0xf, false);
    v += __builtin_amdgcn_update_dpp(0, v, 0x114, 0xf, 0xf, false);
    v += __builtin_amdgcn_update_dpp(0, v, 0x118, 0xf, 0xf, false);
    v += __builtin_amdgcn_update_dpp(0, v, 0x142, 0xa, 0xf, false);
    v += __builtin_amdgcn_update_dpp(0, v, 0x143, 0xc, 0xf, false);
    return v;
}
__device__ __forceinline__ unsigned wave_or63(unsigned v) {
    v |= (unsigned)__builtin_amdgcn_update_dpp(0, (int)v, 0x111, 0xf, 0xf, false);
    v |= (unsigned)__builtin_amdgcn_update_dpp(0, (int)v, 0x112, 0xf, 0xf, false);
    v |= (unsigned)__builtin_amdgcn_update_dpp(0, (int)v, 0x114, 0xf, 0xf, false);
    v |= (unsigned)__builtin_amdgcn_update_dpp(0, (int)v, 0x118, 0xf, 0xf, false);
    v |= (unsigned)__builtin_amdgcn_update_dpp(0, (int)v, 0x142, 0xa, 0xf, false);
    v |= (unsigned)__builtin_amdgcn_update_dpp(0, (int)v, 0x143, 0xc, 0xf, false);
    return v;
}
__device__ __forceinline__ int count_ge8(const unsigned (&x)[16], int k0, unsigned t) {
    u64 m0, m1, m2, m3, m4, m5, m6, m7;
    asm("v_cmp_ge_u32_e64 %0, %8, %16\n\tv_cmp_ge_u32_e64 %1, %9, %16\n\tv_cmp_ge_u32_e64 %2, %10, %16\n\tv_cmp_ge_u32_e64 %3, %11, %16\n\t"
        "v_cmp_ge_u32_e64 %4, %12, %16\n\tv_cmp_ge_u32_e64 %5, %13, %16\n\tv_cmp_ge_u32_e64 %6, %14, %16\n\tv_cmp_ge_u32_e64 %7, %15, %16"
        : "=&s"(m0), "=&s"(m1), "=&s"(m2), "=&s"(m3), "=&s"(m4), "=&s"(m5), "=&s"(m6), "=&s"(m7)
        : "v"(x[k0]), "v"(x[k0 + 1]), "v"(x[k0 + 2]), "v"(x[k0 + 3]), "v"(x[k0 + 4]), "v"(x[k0 + 5]), "v"(x[k0 + 6]), "v"(x[k0 + 7]), "v"(t));
    return (int)(__popcll(m0) + __popcll(m1) + __popcll(m2) + __popcll(m3) + __popcll(m4) + __popcll(m5) + __popcll(m6) + __popcll(m7));
}
template <bool EXACT>
__device__ __forceinline__ unsigned wave_search256(const unsigned (&x)[16]) {
    const unsigned xr = (unsigned)__builtin_amdgcn_readfirstlane((int)x[0]); unsigned df = 0u;
#pragma unroll
    for (int k = 0; k < 16; ++k) df |= (x[k] != 0u) ? (x[k] ^ xr) : 0u;
    df = (unsigned)__builtin_amdgcn_readlane((int)wave_or63(df), 63);
    const int hb = 31 - (int)__builtin_clz(df | 1u);
    unsigned prefix = xr & ~((2u << hb) - 1u);
#pragma unroll 1
    for (int bit = hb; bit >= 0; --bit) { const unsigned trial = prefix | (1u << bit); const int c = count_ge8(x, 0, trial) + count_ge8(x, 8, trial);
        if (c >= 256) { prefix = trial; if (EXACT ? (c == 256) : (c <= 384)) break; } }
    return prefix;
}
__device__ __forceinline__ unsigned wave_compact(LAS unsigned* cand, int n, int lane, int& kept) {
    unsigned x[16];
#pragma unroll
    for (int k = 0; k < 16; ++k) { const int i = lane + 64 * k; x[k] = (i < n) ? cand[i] : 0u; }
    const unsigned prefix = wave_search256<false>(x);
    int base = 0;
#pragma unroll
    for (int k = 0; k < 16; ++k) { const bool keep = x[k] >= prefix; const u64 mk = __ballot(keep);
        if (keep) cand[__builtin_amdgcn_mbcnt_hi((unsigned)(mk >> 32), __builtin_amdgcn_mbcnt_lo((unsigned)mk, (unsigned)base))] = x[k]; base += __popcll(mk); }
    kept = base;
    return prefix;
}

__device__ __forceinline__ void idx_phase(KP p, int l, LAS unsigned char* lds, int vcu, int G, int tid, int wave, int lane) {
    unsigned char* ws = p->ws; const bf16* Z = (const bf16*)(ws + WS_Z);
    { unsigned* sbr = (unsigned*)(ws + WS_CTL) + CW_SB + l * 64; LAS float* wt = (LAS float*)lds;
      for (int task = blockIdx.x; task < 256; task += G) { const int bh = task >> 3, part = task & 7; float qm = 0.f, km = 0.f;
          const bf16* zr = Z + (size_t)((bh >> 3) * SEQ + part * 1024 + tid * 2) * ZP + (bh & 7) * 64;
#pragma unroll
          for (int i = 0; i < 2; ++i) { float qs = 0.f, ks = 0.f;
#pragma unroll
              for (int c8 = 0; c8 < 8; ++c8) { const u32x4 a = *(const u32x4*)(zr + (size_t)i * ZP + Z_FQ + c8 * 8), kq = *(const u32x4*)(zr + (size_t)i * ZP + Z_FK + c8 * 8);
#pragma unroll
                  for (int w4 = 0; w4 < 4; ++w4) { qs += bflo(a[w4]) * bflo(a[w4]) + bfhi(a[w4]) * bfhi(a[w4]); ks += bflo(kq[w4]) * bflo(kq[w4]) + bfhi(kq[w4]) * bfhi(kq[w4]); } }
              qm = fmaxf(qm, qs); km = fmaxf(km, ks); }
#pragma unroll
          for (int o = 1; o < 64; o <<= 1) { qm = fmaxf(qm, __shfl_xor(qm, o)); km = fmaxf(km, __shfl_xor(km, o)); }
          if (lane == 0) { __hip_atomic_fetch_max(sbr + 2 * bh, __builtin_bit_cast(unsigned, qm), __ATOMIC_RELAXED, __HIP_MEMORY_SCOPE_AGENT); __hip_atomic_fetch_max(sbr + 2 * bh + 1, __builtin_bit_cast(unsigned, km), __ATOMIC_RELAXED, __HIP_MEMORY_SCOPE_AGENT); } }
      (void)wt; }
    for (int bh = blockIdx.x; bh < 32; bh += G) {
        float* dst = (float*)(ws + WS_CT) + (size_t)bh * SEQ;
        LAS float* wt = (LAS float*)lds;
        const float bfx = p->b_fox[l * 8 + (bh & 7)]; const bf16* zf = Z + (size_t)((bh >> 3) * SEQ + tid * 16) * ZP + Z_FF + (bh & 7);
        f32x4 v[4]; float run = 0.f;
#pragma unroll
        for (int j = 0; j < 4; ++j) {
#pragma unroll
            for (int i = 0; i < 4; ++i) { const float t = bf2f(zf[(size_t)(4 * j + i) * ZP]) + bfx; v[j][i] = (fminf(t, 0.f) - __logf(1.0f + __expf(-fabsf(t)))) * LOG2E; }
            v[j].x += run; v[j].y += v[j].x; v[j].z += v[j].y; v[j].w += v[j].z; run = v[j].w; }
        float inc = run;
#pragma unroll
        for (int o = 1; o < 64; o <<= 1) { const float t = __shfl_up(inc, o); if (lane >= o) inc += t; }
        if (lane == 63) wt[wave] = inc;
        WG_BAR();
        float off = inc - run;
        for (int w = 0; w < wave; ++w) off += wt[w];
        { u32x4* ka = (u32x4*)((bf16*)(ws + WS_KA) + ((size_t)bh * SEQ + tid * 16) * 16);
#pragma unroll
          for (int j = 0; j < 4; ++j) { const f32x4 c4 = v[j] + off; *(f32x4*)(dst + tid * 16 + 4 * j) = c4;
#pragma unroll
              for (int i = 0; i < 4; ++i) { const float c = c4[i]; const unsigned h1 = f2bf(c); const float r1 = c - bf2f(h1); const unsigned h2 = f2bf(r1); const unsigned h3 = f2bf(r1 - bf2f(h2));
                  unsigned z0 = 0u; asm volatile("" : "+v"(z0));
                  ka[(4 * j + i) * 2] = (u32x4){h1 | (h2 << 16), h3 | 0x3f800000u, z0, z0}; ka[(4 * j + i) * 2 + 1] = (u32x4){z0, z0, z0, z0}; } } }
        WG_BAR();
    }
    LAS unsigned* cand = (LAS unsigned*)(lds + IX_CAND); LAS unsigned* BM = (LAS unsigned*)(lds + IX_BM);
    LAS unsigned* cnt = (LAS unsigned*)(lds + IX_CNT); LAS unsigned* tau = (LAS unsigned*)(lds + IX_TAU); LAS unsigned* hist = (LAS unsigned*)(lds + IX_HIST); LAS unsigned* flg = (LAS unsigned*)(lds + IX_FLAG);
    u64* MW = (u64*)(ws + WS_MASKW);
    const int r32 = lane & 31, hi = lane >> 5;
    for (int U = vcu; U < 1024; U += G) {
        const int v = U & 255, i4 = U >> 8; const int b = v & 3, a = v >> 2;
        const int hc = (i4 == 0) ? a : (i4 == 1) ? 255 - a : (i4 == 2) ? 64 + a : 191 - a;
        const int qbase = b * SEQ + hc * 32; const int nadm = ((hc >> 1) + 1) * 64;
        if (nadm <= 256) {
            const int nw = nadm >> 6;
            for (int i = tid; i < 32 * 128; i += NTHR) { const int q = i >> 7, w = i & 127; unsigned on = (w < nw) ? 0xffffffffu : 0u; asm volatile("" : "+v"(on));
                MW[(size_t)(qbase + q) * 128 + w] = (u64)on | ((u64)on << 32); }
            continue;
        }
        const bf16* qrow = Z + (size_t)(qbase + r32) * ZP;
        bf16x8 iqf[4][4];
#pragma unroll
        for (int hd = 0; hd < 4; ++hd)
#pragma unroll
            for (int j = 0; j < 4; ++j) iqf[hd][j] = *(const bf16x8*)(qrow + Z_IQ + hd * 64 + j * 16 + hi * 8);
        float wq[4];
#pragma unroll
        for (int hd = 0; hd < 4; ++hd) wq[hd] = bf2f(qrow[Z_IW + hd]) * (0.5f * 0.125f);
        if (tid < 32) { cnt[tid] = 0u; tau[tid] = 0u; } if (tid < 3) flg[tid] = 0u;
        const int ntiles = nadm >> 5, nrounds = (ntiles + 7) >> 3;
        const bf16* kbase = (const bf16*)(ws + WS_IKC) + (size_t)(b * SEQ) * 64 + hi * 8;
        bf16x8 kf[4], kn[4];
#pragma unroll
        for (int j = 0; j < 4; ++j) kn[j] = *(const bf16x8*)(kbase + (size_t)((wave < ntiles ? wave : 0) * 32 + r32) * 64 + j * 16);
        WG_BAR();
        for (int rd = 0; rd < nrounds; ++rd) {
            const int tile = rd * 8 + wave;
#pragma unroll
            for (int j = 0; j < 4; ++j) kf[j] = kn[j];
            { const int tn = (tile + 8 < ntiles) ? tile + 8 : tile;
#pragma unroll
              for (int j = 0; j < 4; ++j) kn[j] = *(const bf16x8*)(kbase + (size_t)((tn < ntiles ? tn : 0) * 32 + r32) * 64 + j * 16); }
            if (tile < ntiles) {
                f32x16 sc = {};
#pragma unroll
                for (int hd = 0; hd < 4; ++hd) { f32x16 pp = {};
#pragma unroll
                    for (int j = 0; j < 4; ++j) pp = MFMA32(kf[j], iqf[hd][j], pp);
#pragma unroll
                    for (int r = 0; r < 16; ++r) { const float pv = pp[r]; const int pb = __builtin_bit_cast(int, pv); const int pr = pb > 0 ? pb : 0;
                        sc[r] = __builtin_fmaf(wq[hd], __builtin_bit_cast(float, pr), sc[r]); } }
                const unsigned tq = tau[r32];
                typedef unsigned u32x16_t __attribute__((ext_vector_type(16))); u32x16_t comp; unsigned npass = 0u;
#pragma unroll
                for (int r = 0; r < 16; ++r) { const int key = tile * 32 + crow(r, hi);
                    unsigned u = __builtin_bit_cast(unsigned, sc[r] + 0.0f); u ^= (u >> 31) ? 0xffffffffu : 0x80000000u;
                    comp[r] = (u & 0xffffe000u) | (unsigned)(8191 - key); npass += (comp[r] > tq) ? 1u : 0u; }
                unsigned pos = 0u;
                if (npass) pos = __hip_atomic_fetch_add(cnt + r32, npass, __ATOMIC_RELAXED, __HIP_MEMORY_SCOPE_WORKGROUP);
                LAS unsigned* cq_ = cand + r32 * IX_STRIDE;
#pragma unroll
                for (int r = 0; r < 16; ++r) if (comp[r] > tq) { cq_[pos] = comp[r]; ++pos; }
                if (npass && pos > (unsigned)IX_TRIG) flg[rd % 3] = 1u;
            }
            WG_BAR_LDS();
            const bool need_any = flg[rd % 3] != 0u;
            if (tid == 0) flg[(rd + 2) % 3] = 0u;
            if (need_any) {
#pragma unroll 1
                for (int i = 0; i < 4; ++i) { const int qq = wave * 4 + i; const int n = __builtin_amdgcn_readfirstlane((int)cnt[qq]);
                    if (n > 256) { int kept; const unsigned th = wave_compact(cand + qq * IX_STRIDE, n, lane, kept); if (lane == 0) { cnt[qq] = (unsigned)kept; tau[qq] = th ? th - 1u : 0u; } } }
                WG_BAR_LDS();
            }
        }
#pragma unroll 1
        for (int i = 0; i < 4; ++i) { const int qq = wave * 4 + i; const int n = __builtin_amdgcn_readfirstlane((int)cnt[qq]);
            LAS unsigned* cq = cand + qq * IX_STRIDE; unsigned x[16];
#pragma unroll
            for (int k = 0; k < 16; ++k) { const int ii = lane + 64 * k; x[k] = (ii < n) ? cq[ii] : 0u; }
            unsigned th = 1u; if (n > 256) th = wave_search256<true>(x);
            asm volatile("" ::: "memory");
#pragma unroll
            for (int k = 0; k < 4; ++k) { unsigned z0 = 0u; asm volatile("" : "+v"(z0)); cq[lane + 64 * k] = z0; }
#pragma unroll
            for (int k = 0; k < 16; ++k) if (x[k] >= th) { const int key = 8191 - (int)(x[k] & 8191u);
                (void)__hip_atomic_fetch_or(cq + (key >> 5), 1u << (key & 31), __ATOMIC_RELAXED, __HIP_MEMORY_SCOPE_WORKGROUP); }
            LDS_WAIT(); asm volatile("" ::: "memory");
            const unsigned w0 = cq[4 * lane], w1 = cq[4 * lane + 1], w2 = cq[4 * lane + 2], w3 = cq[4 * lane + 3];
            *(u32x4*)(MW + (size_t)(qbase + qq) * 128 + 2 * lane) = (u32x4){w0, w1, w2, w3};
            asm volatile("" ::: "memory"); }
        WG_BAR();
    }
}

constexpr int AT_K = 0, AT_V = 2 * 8192, AT_WS = 4 * 8192, AT_OST = AT_WS + 4096, AT_MW = AT_OST + 8 * 4096, AT_KA = AT_MW + 2 * 8 * 512, AT_END = AT_KA + 2 * 2048;
static_assert(AT_END <= SCR_BYTES, "attention LDS");
#ifndef DBG_ATT_L
#define DBG_ATT_L 0
#endif

template <int MODE>
__device__ __forceinline__ void attn_unit(int b, int h, int qb, const bf16* Z, bf16* Ob, const float* cT, const u64* MW, const void* KA, const void* SBp, LAS char* shm, int wv) {
    int tid_l = lane_id() + wv * 64;
    const int tid = tid_l, lane = tid & 63, r32 = lane & 31, hi = lane >> 5; const int wid = __builtin_amdgcn_readfirstlane(tid >> 6);
    constexpr int QC = MODE == 0 ? Z_FQ : Z_AQ, KC = MODE == 0 ? Z_FK : Z_AK, VC = MODE == 0 ? Z_FV : Z_AV, OC = MODE == 0 ? 512 : 0;
    const long rowbase = (long)b * SEQ; const int q0 = qb * 512;
    const bf16* Qw = Z + (rowbase + q0 + wid * 64) * ZP + QC + h * 64;
    const bf16* Kh = Z + rowbase * ZP + KC + h * 64; const bf16* Vh = Z + rowbase * ZP + VC + h * 64;
    const unsigned lds0 = (unsigned)(uintptr_t)shm;
    LAS float* wsf = (LAS float*)(shm + AT_WS) + wid * 128;
    const int NT = 8 * (qb + 1); const int tlast = 8 * qb + wid;
    const bf16* ksrc = Kh + (long)lane * ZP + wid * 8;
    const bf16* vsrc = Vh + (long)(16 * (wid & 3) + (lane >> 2)) * ZP + (wid >> 2) * 32 + (lane & 3) * 8;
    const unsigned kdst = lds0 + AT_K + wid * 1024, vdst = lds0 + AT_V + wid * 1024, mdst = lds0 + AT_MW + wid * 512;
    const unsigned kadst = lds0 + AT_KA + (wid & 1) * 1024;
#define DMA_KA(t, sl) do { if (MODE == 0 && wid < 2) { const int ln_ = lane_id();     \
        glds16((const bf16*)KA + ((size_t)(b * 8 + h) * SEQ + (t) * 64 + 32 * wid + (ln_ >> 1)) * 16 + (ln_ & 1) * 8, (unsigned)__builtin_amdgcn_readfirstlane(kadst + (sl) * 2048)); } } while (0)
#define DMA_K(t, slotb) glds16(ksrc + (long)(t) * 64 * ZP, (unsigned)__builtin_amdgcn_readfirstlane(kdst + (slotb)))
#define DMA_V(t, slotb) glds16(vsrc + (long)(t) * 64 * ZP, (unsigned)__builtin_amdgcn_readfirstlane(vdst + (slotb)))
#define DMA_M(t, sl) do { const int ln_ = lane_id(); const unsigned* msrcA = (const unsigned*)(MW + (size_t)(rowbase + q0 + wid * 64 + (ln_ & 31)) * 128) + (ln_ >> 5);     \
        glds4(msrcA + 2 * (t), (unsigned)__builtin_amdgcn_readfirstlane(mdst + (sl) * 4096)); glds4(msrcA + 32 * 256 + 2 * (t), (unsigned)__builtin_amdgcn_readfirstlane(mdst + (sl) * 4096 + 256)); } while (0)
    int t_start = 0, t_first = 0;
    if (MODE == 0) { const float* cg = cT + (size_t)(b * 8 + h) * SEQ; const float th = 2.0f * (sqrtf(((const float*)SBp)[2 * (b * 8 + h)]) * sqrtf(((const float*)SBp)[2 * (b * 8 + h) + 1]) * 1.01f + 1.0f) + 40.0f; const int ln_ = lane_id();
        const float c0 = cg[q0], cw = cg[q0 + wid * 64];
        const float ca = (ln_ < NT) ? cg[64 * ln_ + 63] : -3e38f, cb = (ln_ + 64 < NT) ? cg[64 * (ln_ + 64) + 63] : -3e38f;
        { const u64 m0 = __ballot(ca <= c0 + th), m1 = __ballot(cb <= c0 + th); t_start = m0 ? (int)__builtin_ctzll(m0) : 64 + (int)__builtin_ctzll(m1 | (1ull << 63)); }
        { const u64 m0 = __ballot(ca <= cw + th), m1 = __ballot(cb <= cw + th); t_first = m0 ? (int)__builtin_ctzll(m0) : 64 + (int)__builtin_ctzll(m1 | (1ull << 63)); }
        if (t_start > 8 * qb) t_start = 8 * qb; if (t_first > tlast) t_first = tlast; }
    DMA_K(t_start, 0); DMA_V(t_start, 0); if (MODE == 1) DMA_M(0, 0); DMA_KA(t_start, 0);
    bf16x8 qA[4], qB[4];
#pragma unroll
    for (int d0 = 0; d0 < 4; ++d0) { qA[d0] = *(const bf16x8*)(Qw + (long)r32 * ZP + d0 * 16 + hi * 8); qB[d0] = *(const bf16x8*)(Qw + (long)(32 + r32) * ZP + d0 * 16 + hi * 8); }
    float mA = 0.f, mB = 0.f, lA = 0.f, lB = 0.f;
    const unsigned qa0 = (MODE == 0 && hi == 0) ? 0xbf80bf80u : 0u; const unsigned qa1c = (MODE == 0 && hi == 0) ? 0xbf80u : 0u;
    u32x4 qaA = {qa0, qa1c, 0u, 0u}, qaB = {qa0, qa1c, 0u, 0u};
    f32x16 oA[2], oB[2]; oA[0] = f32x16{}; oA[1] = f32x16{}; oB[0] = f32x16{}; oB[1] = f32x16{};
    const int qrelA = wid * 64 + r32;
    const LAS char* kp0 = shm + AT_K + hi * 1024 + r32 * 16;
    const LAS char* vp0 = shm + AT_V + ((lane >> 4) & 1) * 32 + (lane & 3) * 8 + (4 * hi + ((lane & 15) >> 2)) * 64;
    const LAS unsigned* mwp = (const LAS unsigned*)(shm + AT_MW + wid * 512);
    const LAS char* kap0 = shm + AT_KA + r32 * 32 + hi * 16;
    int slot = 0;
#define SOFTMAX(P0, P1, MH, LR, OO, QA, QREL, WSOFF, MWOFF, PW) do { \
        if (MODE == 0) { \
            if (t == tlast) { _Pragma("unroll") for (int r = 0; r < 16; ++r) { const int kv = crow(r, hi); if (kv > (QREL) - wid * 64) P0[r] = -INFINITY; if (kv + 32 > (QREL) - wid * 64) P1[r] = -INFINITY; } } \
        } else { const unsigned mlo = mwp[slot * 1024 + (MWOFF) + r32] >> (4 * hi), mhi = mwp[slot * 1024 + (MWOFF) + 32 + r32] >> (4 * hi);     \
            _Pragma("unroll") for (int r = 0; r < 16; ++r) { const int bitp = crow(r, 0); const float p0_ = P0[r], p1_ = P1[r];     \
                const unsigned s0_ = (unsigned)__builtin_amdgcn_sbfe((int)mlo, bitp, 1), s1_ = (unsigned)__builtin_amdgcn_sbfe((int)mhi, bitp, 1);                       \
                P0[r] = __builtin_bit_cast(float, (__builtin_bit_cast(unsigned, p0_) & s0_) | (0xff800000u & ~s0_)); P1[r] = __builtin_bit_cast(float, (__builtin_bit_cast(unsigned, p1_) & s1_) | (0xff800000u & ~s1_)); } } \
        float rm = __builtin_fmaxf(__builtin_fmaxf(P0[0], P0[1]), P1[0]), rm2 = __builtin_fmaxf(__builtin_fmaxf(P0[2], P0[3]), P1[1]); rm = __builtin_fmaxf(__builtin_fmaxf(rm, P1[2]), P1[3]); \
        _Pragma("unroll") for (int r = 4; r < 16; r += 4) { rm = __builtin_fmaxf(__builtin_fmaxf(rm, P0[r]), P0[r + 1]); rm2 = __builtin_fmaxf(__builtin_fmaxf(rm2, P0[r + 2]), P0[r + 3]); rm = __builtin_fmaxf(__builtin_fmaxf(rm, P1[r]), P1[r + 1]); rm2 = __builtin_fmaxf(__builtin_fmaxf(rm2, P1[r + 2]), P1[r + 3]); } \
        rm = __builtin_fmaxf(rm, rm2); \
        rm = swapmax(rm);                            \
        if (__any(rm > 8.0f)) { const bool big_ = __builtin_fabsf(MH) + __builtin_fabsf(rm > 0.f ? rm : 0.f) > 1800.0f;     \
            const float dl = rm > 0.f ? (big_ ? 64.0f * __builtin_ceilf((MH + rm) * (1.0f / 64.0f)) - MH : 8.0f * __builtin_ceilf(rm * 0.125f)) : 0.f; const float f = __builtin_amdgcn_exp2f(-dl); LR *= f; MH += dl; \
            QA[1] = (QA[1] & 0xffffu) | ((hi == 0) ? (f2bf(-MH) << 16) : 0u); \
            _Pragma("unroll") for (int r = 0; r < 16; ++r) { P0[r] -= dl; P1[r] -= dl; } \
            if (hi == 0) wsf[(WSOFF) + r32] = f; \
            LDS_WAIT(); \
            _Pragma("unroll") for (int j = 0; j < 4; ++j) { const f32x4 ff = *(const LAS f32x4*)(wsf + (WSOFF) + 8 * j + 4 * hi); \
                _Pragma("unroll") for (int i = 0; i < 4; ++i) { OO[0][4 * j + i] *= ff[i]; OO[1][4 * j + i] *= ff[i]; } } } \
        float sacc = 0.f; \
        _Pragma("unroll") for (int r = 0; r < 16; ++r) { P0[r] = __builtin_amdgcn_exp2f(P0[r]); P1[r] = __builtin_amdgcn_exp2f(P1[r]); sacc += P0[r] + P1[r]; } \
        LR += sacc; \
        _Pragma("unroll") for (int i = 0; i < 4; ++i) { PW[0][i] = cvtpk(P0[2 * i], P0[2 * i + 1]); PW[1][i] = cvtpk(P0[8 + 2 * i], P0[8 + 2 * i + 1]); PW[2][i] = cvtpk(P1[2 * i], P1[2 * i + 1]); PW[3][i] = cvtpk(P1[8 + 2 * i], P1[8 + 2 * i + 1]); } \
    } while (0)
#define PVMM(OO, PW) do { const LAS char* vp = vp0 + slot * 8192; \
        _Pragma("unroll") for (int d0 = 0; d0 < 2; ++d0) { s16x4 lo_[4], hh_[4]; \
            _Pragma("unroll") for (int ks = 0; ks < 4; ++ks) { lo_[ks] = vtr(vp + d0 * 4096 + ks * 1024); hh_[ks] = vtr(vp + d0 * 4096 + ks * 1024 + 512); } \
            _Pragma("unroll") for (int ks = 0; ks < 4; ++ks) { const bf16x8 vf = {lo_[ks][0], lo_[ks][1], lo_[ks][2], lo_[ks][3], hh_[ks][0], hh_[ks][1], hh_[ks][2], hh_[ks][3]}; \
                OO[d0] = MFMA32(__builtin_bit_cast(bf16x8, PW[ks]), vf, OO[d0]); } } } while (0)
    for (int t = t_start; t < NT; ++t) {
        asm volatile("s_waitcnt vmcnt(0) lgkmcnt(0)\n\ts_barrier" ::: "memory");
        if (t + 1 < NT) { DMA_K(t + 1, (slot ^ 1) * 8192); DMA_V(t + 1, (slot ^ 1) * 8192); if (MODE == 1) DMA_M(t + 1, slot ^ 1); DMA_KA(t + 1, slot ^ 1); }
        if (t <= tlast && t >= t_first) {
            f32x16 a0 = {}, a1 = {}, b0 = {}, b1 = {};
            { const LAS char* kb = kp0 + slot * 8192;
#pragma unroll
              for (int d0 = 0; d0 < 4; ++d0) { const bf16x8 k0 = *(const LAS bf16x8*)(kb + d0 * 2048), k1 = *(const LAS bf16x8*)(kb + d0 * 2048 + 512);
                  a0 = MFMA32(k0, qA[d0], a0); a1 = MFMA32(k1, qA[d0], a1); b0 = MFMA32(k0, qB[d0], b0); b1 = MFMA32(k1, qB[d0], b1); }
              bf16x8 x0, x1;
              if (MODE == 0) { x0 = *(const LAS bf16x8*)(kap0 + slot * 2048); x1 = *(const LAS bf16x8*)(kap0 + slot * 2048 + 1024); }
              else { const u32x4 cw = {0u, (hi == 0) ? 0x3f800000u : 0u, 0u, 0u}; x0 = __builtin_bit_cast(bf16x8, cw); x1 = x0; }
              a0 = MFMA32(x0, __builtin_bit_cast(bf16x8, qaA), a0); a1 = MFMA32(x1, __builtin_bit_cast(bf16x8, qaA), a1); b0 = MFMA32(x0, __builtin_bit_cast(bf16x8, qaB), b0); b1 = MFMA32(x1, __builtin_bit_cast(bf16x8, qaB), b1); }
            u32x4 pwA[4], pwB[4];
            SOFTMAX(a0, a1, mA, lA, oA, qaA, qrelA, 0, 0, pwA);
            PVMM(oA, pwA);
            SOFTMAX(b0, b1, mB, lB, oB, qaB, qrelA + 32, 32, 64, pwB);
            PVMM(oB, pwB);
        }
        slot ^= 1;
    }
#define EPILOG(OO, LR, WSOFF, ROWOFF) do { float l_ = swapsum(LR); if (hi == 0) wsf[64 + (WSOFF) + r32] = l_; LDS_WAIT(); float rli[16]; \
        _Pragma("unroll") for (int r = 0; r < 16; ++r) rli[r] = __builtin_amdgcn_rcpf(wsf[64 + (WSOFF) + crow(r, hi)]); \
        bf16* Ow = Ob + (rowbase + q0 + wid * 64 + (ROWOFF)) * OP + OC + h * 64; LAS bf16* stg = (LAS bf16*)(shm + AT_OST) + wid * 2048; \
        _Pragma("unroll") for (int r = 0; r < 16; ++r) { const int orow = crow(r, hi); _Pragma("unroll") for (int d0 = 0; d0 < 2; ++d0) stg[orow * 64 + d0 * 32 + r32] = (bf16)f2bf(OO[d0][r] * rli[r]); } \
        LDS_WAIT(); \
        _Pragma("unroll") for (int i = 0; i < 4; ++i) { const int row = i * 8 + (lane >> 3), ch = lane & 7; const u32x4 v = *(const LAS u32x4*)(stg + row * 64 + ch * 8); *(u32x4*)(Ow + (long)row * OP + ch * 8) = v; } \
        LDS_WAIT(); } while (0)
    EPILOG(oA, lA, 0, 0);
    EPILOG(oB, lB, 32, 32);
    asm volatile("s_waitcnt lgkmcnt(0)\n\ts_barrier" ::: "memory");
#undef DMA_K
#undef DMA_V
#undef DMA_M
#undef DMA_KA
#undef SOFTMAX
#undef PVMM
#undef EPILOG
}

__device__ __forceinline__ void attn_phase(KP p, int l, LAS unsigned char* lds, int vcu, int G, int wv) {
    unsigned char* ws = p->ws; const bf16* Z = (const bf16*)(ws + WS_Z); bf16* Ob = (bf16*)(ws + WS_OBUF); const float* cT = (const float*)(ws + WS_CT); const u64* MW = (const u64*)(ws + WS_MASKW);
    for (int U = vcu; U < 1024; U += G) {
        const int v = U & 255, i4 = U >> 8; const int mode = i4 & 1, k = i4 >> 1; const int bh = v >> 3, s = v & 7;
        const int qb = (k == 0) ? s : 15 - s;
        if (mode == 0) attn_unit<0>(bh >> 3, bh & 7, qb, Z, Ob, cT, MW, (const void*)(ws + WS_KA), (const void*)((const unsigned*)(ws + WS_CTL) + CW_SB + l * 64), (LAS char*)lds, wv);
        else attn_unit<1>(bh >> 3, bh & 7, qb, Z, Ob, cT, MW, (const void*)(ws + WS_KA), (const void*)((const unsigned*)(ws + WS_CTL) + CW_SB + l * 64), (LAS char*)lds, wv);
    }
}

constexpr int HG_LF = 0, HG_KK = 16640, HG_SEG = 33280, HG_P = 35328, HG_R = HG_P + 9216, HG_RT = HG_R + 9216, HG_VT = HG_RT + 9216, HG_ST = HG_VT + 9216, HG_CG = HG_ST + 9216, HG_END = HG_CG + 9216;
static_assert(HG_END <= SCR_BYTES, "hgrn LDS");
constexpr int HP = 72;

__device__ __forceinline__ void hgrn_front(KP p, int l, const unsigned short (&zf)[8], int h, int d, int seg, LAS float* SEG, float (&kk)[8], float (&bb)[8], float& bm, float& bl) {
    const int dd = h * 64 + d; const float lb = (l == 0) ? 0.f : sigmoidf_(p->lb_logits[512 + dd] - p->lb_logits[dd]);
    float run = 0.f;
#pragma unroll
    for (int i = 0; i < 8; ++i) { const float sg = sigmoidf_(bf2f(zf[i])); const float f = lb + (1.f - lb) * sg; kk[i] = (1.f - lb) * (1.f - sg); run += __logf(f); bb[i] = run; }
    SEG[seg * 64 + d] = run;
    WG_BAR_LDS();
    float pre = 0.f, m4 = 0.f, all = 0.f;
#pragma unroll
    for (int s2 = 0; s2 < 8; ++s2) { const float sv = SEG[s2 * 64 + d]; if (s2 < seg) pre += sv; if (s2 < 4) m4 += sv; all += sv; }
#pragma unroll
    for (int i = 0; i < 8; ++i) bb[i] += pre;
    bm = m4; bl = all;
}

#define H_ROWP(U_) (Z + (size_t)((((U_) >> 7) >> 3) * SEQ + ((U_) & 127) * 64 + 8 * seg) * ZP + (((U_) >> 7) & 7) * 64 + d)
__device__ __forceinline__ void h1_phase(KP p, int l, LAS unsigned char* lds, int vcu, int G, int tid, int wave, int lane) {
    unsigned char* ws = p->ws; const bf16* Z = (const bf16*)(ws + WS_Z); float* Ug = (float*)(ws + WS_UG); float* Dg = (float*)(ws + WS_DG); float* D2g = (float*)(ws + WS_D2G);
    LAS float* SEG = (LAS float*)(lds + HG_SEG); LAS bf16* RT = (LAS bf16*)(lds + HG_RT); LAS bf16* VT = (LAS bf16*)(lds + HG_VT);
    const int r32 = lane & 31, hi = lane >> 5; const int d = tid & 63, seg = tid >> 6;
    for (int U = vcu; U < 4096; U += G) {
        const int bh = U >> 7, h = bh & 7; const bf16* rp = H_ROWP(U);
        unsigned short zf[8], vv[8];
#pragma unroll
        for (int i = 0; i < 8; ++i) { zf[i] = rp[(size_t)i * ZP + Z_CF]; vv[i] = rp[(size_t)i * ZP + Z_CI]; }
        float kk[8], bb[8], bm, bl; hgrn_front(p, l, zf, h, d, seg, SEG, kk, bb, bm, bl);
        { unsigned rw[4], vw[4];
#pragma unroll
          for (int i = 0; i < 4; ++i) { rw[i] = pk2(kk[2 * i] * __expf(fminf(bm - bb[2 * i], 80.f)), kk[2 * i + 1] * __expf(fminf(bm - bb[2 * i + 1], 80.f))); vw[i] = (unsigned)vv[2 * i] | ((unsigned)vv[2 * i + 1] << 16); }
          *(LAS u32x4*)(RT + d * HP + 8 * seg) = (u32x4){rw[0], rw[1], rw[2], rw[3]}; *(LAS u32x4*)(VT + d * HP + 8 * seg) = (u32x4){vw[0], vw[1], vw[2], vw[3]}; }
        if (seg == 7) { Dg[(size_t)U * 64 + d] = __expf(bl); D2g[(size_t)U * 64 + d] = __expf(bl - bm); }
        WG_BAR_LDS();
        if (wave < 4) { const int ib = wave >> 1, jb = wave & 1; f32x16 acc = {};
#pragma unroll
            for (int ks = 0; ks < 4; ++ks) { const bf16x8 a = *(const LAS bf16x8*)(RT + (32 * ib + r32) * HP + 16 * ks + 8 * hi), bq = *(const LAS bf16x8*)(VT + (32 * jb + r32) * HP + 16 * ks + 8 * hi);
                acc = MFMA32(a, bq, acc); }
            float* up = Ug + ((size_t)U * 64 + 32 * jb + r32) * 64 + 32 * ib + 4 * hi;
#pragma unroll
            for (int rr = 0; rr < 4; ++rr) *(f32x4*)(up + 8 * rr) = (f32x4){acc[4 * rr], acc[4 * rr + 1], acc[4 * rr + 2], acc[4 * rr + 3]}; }
        WG_BAR_LDS();
    }
}

__device__ __forceinline__ void h2_phase(KP p, int G, int tid) {
    unsigned char* ws = p->ws; const float* Ug = (const float*)(ws + WS_UG); const float* Dg = (const float*)(ws + WS_DG); const float* D2g = (const float*)(ws + WS_D2G); bf16* Sst = (bf16*)(ws + WS_SST);
    for (int gid = blockIdx.x * NTHR + tid; gid < 32 * 4096; gid += G * NTHR) {
        const int bh = gid >> 12, ed = gid & 4095, d = ed & 63; float S = 0.f;
        const float* up = Ug + (size_t)bh * 128 * 4096 + ed; const float* dp = Dg + (size_t)bh * 128 * 64 + d; const float* d2p = D2g + (size_t)bh * 128 * 64 + d; bf16* sp = Sst + (size_t)bh * 128 * 4096 + ed;
        for (int c0 = 0; c0 < 128; c0 += 8) { float u[8], dd[8], d2[8];
#pragma unroll
            for (int i = 0; i < 8; ++i) { u[i] = up[(size_t)(c0 + i) * 4096]; dd[i] = dp[(c0 + i) * 64]; d2[i] = d2p[(c0 + i) * 64]; }
#pragma unroll
            for (int i = 0; i < 8; ++i) { sp[(size_t)(c0 + i) * 4096] = (bf16)f2bf(S); S = dd[i] * S + d2[i] * u[i]; } }
    }
}

__device__ __forceinline__ void h3_phase(KP p, int l, LAS unsigned char* lds, int vcu, int G, int tid, int wave, int lane) {
    unsigned char* ws = p->ws; const bf16* Z = (const bf16*)(ws + WS_Z); const bf16* Sst = (const bf16*)(ws + WS_SST); bf16* Ob = (bf16*)(ws + WS_OBUF);
    LAS float* SEG = (LAS float*)(lds + HG_SEG);
    LAS bf16* Pt = (LAS bf16*)(lds + HG_P); LAS bf16* Rt = (LAS bf16*)(lds + HG_R); LAS bf16* VT = (LAS bf16*)(lds + HG_VT); LAS bf16* ST = (LAS bf16*)(lds + HG_ST); LAS bf16* CG = (LAS bf16*)(lds + HG_CG);
    const int r32 = lane & 31, hi = lane >> 5; const int d = tid & 63, seg = tid >> 6;
    const float* gn = p->norm_g + l * 512;
    for (int U = vcu; U < 4096; U += G) {
        const int bh = U >> 7, c = U & 127, b = bh >> 3, h = bh & 7; const int t0 = b * SEQ + c * 64; const bf16* rp = H_ROWP(U);
        unsigned short zf[8], qv[8], vv[8], gg[8], sv[8];
#pragma unroll
        for (int i = 0; i < 8; ++i) { zf[i] = rp[(size_t)i * ZP + Z_CF]; qv[i] = rp[(size_t)i * ZP + Z_CQ]; vv[i] = rp[(size_t)i * ZP + Z_CI]; gg[i] = rp[(size_t)i * ZP + Z_CG]; sv[i] = Sst[(size_t)U * 4096 + (8 * seg + i) * 64 + d]; }
        float kk[8], bb[8], bm, bl; hgrn_front(p, l, zf, h, d, seg, SEG, kk, bb, bm, bl); (void)bl;
        { const float ebm = __expf(bm); unsigned vw[4];
#pragma unroll
          for (int i = 0; i < 8; ++i) { const int t = 8 * seg + i;
              Pt[t * HP + d] = (bf16)f2bf(bf2f(qv[i]) * __expf(fminf(bb[i] - bm, 80.f))); Rt[t * HP + d] = (bf16)f2bf(kk[i] * __expf(fminf(bm - bb[i], 80.f)));
              ST[t * HP + d] = (bf16)f2bf(bf2f(sv[i]) * ebm); CG[t * HP + d] = (bf16)gg[i]; }
#pragma unroll
          for (int i = 0; i < 4; ++i) vw[i] = (unsigned)vv[2 * i] | ((unsigned)vv[2 * i + 1] << 16);
          *(LAS u32x4*)(VT + d * HP + 8 * seg) = (u32x4){vw[0], vw[1], vw[2], vw[3]}; }
        WG_BAR_LDS();
        if (wave < 2) { const int ib = wave;
            u32x4 pw[2][2];
#pragma unroll
            for (int k = 0; k < 2; ++k) { f32x16 a = {};
                if (k <= ib) {
#pragma unroll
                    for (int js = 0; js < 4; ++js) { const bf16x8 ra = *(const LAS bf16x8*)(Rt + (32 * k + r32) * HP + 16 * js + 8 * hi), pb = *(const LAS bf16x8*)(Pt + (32 * ib + r32) * HP + 16 * js + 8 * hi);
                        a = MFMA32(ra, pb, a); }
                    if (k == ib) {
#pragma unroll
                        for (int r = 0; r < 16; ++r) if (crow(r, hi) > r32) a[r] = 0.f;
                    }
                }
#pragma unroll
                for (int i = 0; i < 4; ++i) { pw[k][0][i] = cvtpk(a[2 * i], a[2 * i + 1]); pw[k][1][i] = cvtpk(a[8 + 2 * i], a[8 + 2 * i + 1]); } }
            f32x16 oacc[2]; float ss = 0.f;
#pragma unroll
            for (int j = 0; j < 2; ++j) { f32x16 oa = {};
#pragma unroll
                for (int k = 0; k < 2; ++k) { if (k <= ib) {
#pragma unroll
                    for (int st = 0; st < 2; ++st) { const LAS bf16* vp = VT + (32 * j + r32) * HP + 32 * k + 16 * st + 4 * hi;
                        const s16x4 v0 = *(const LAS s16x4*)vp, v1 = *(const LAS s16x4*)(vp + 8);
                        const bf16x8 vf = {v0[0], v0[1], v0[2], v0[3], v1[0], v1[1], v1[2], v1[3]};
                        oa = MFMA32(vf, __builtin_bit_cast(bf16x8, pw[k][st]), oa); } } }
#pragma unroll
                for (int js = 0; js < 4; ++js) { const bf16x8 sa = *(const LAS bf16x8*)(ST + (32 * j + r32) * HP + 16 * js + 8 * hi), pb = *(const LAS bf16x8*)(Pt + (32 * ib + r32) * HP + 16 * js + 8 * hi);
                    oa = MFMA32(sa, pb, oa); }
#pragma unroll
                for (int r = 0; r < 16; ++r) ss += oa[r] * oa[r];
                oacc[j] = oa; }
            ss = swapsum(ss);
            const float rstd = 1.0f / sqrtf(ss * (1.0f / 64.0f) + RMS_EPS);
            bf16* orow = Ob + (size_t)(t0 + 32 * ib + r32) * OP + 1024 + h * 64;
#pragma unroll
            for (int j = 0; j < 2; ++j)
#pragma unroll
                for (int rr = 0; rr < 4; ++rr) { const int e0 = 32 * j + 8 * rr + 4 * hi; const f32x4 g4 = *(const f32x4*)(gn + h * 64 + e0);
                    const u32x2 cw = *(const LAS u32x2*)(CG + (32 * ib + r32) * HP + e0);
                    const float o0 = oacc[j][4 * rr] * rstd * g4[0] * sigmoidf_(bflo(cw.x)), o1 = oacc[j][4 * rr + 1] * rstd * g4[1] * sigmoidf_(bfhi(cw.x));
                    const float o2 = oacc[j][4 * rr + 2] * rstd * g4[2] * sigmoidf_(bflo(cw.y)), o3 = oacc[j][4 * rr + 3] * rstd * g4[3] * sigmoidf_(bfhi(cw.y));
                    *(u32x2*)(orow + e0) = (u32x2){cvtpk(o0, o1), cvtpk(o2, o3)}; }
        }
        WG_BAR_LDS();
    }
}

#undef H_ROWP
constexpr int RT_LG = 0, RT_HIST = 8 * 2048, RT_END = RT_HIST + 1024;
static_assert(RT_END <= SCR_BYTES, "router LDS");
typedef short bf16x8_t __attribute__((ext_vector_type(8)));
__device__ __forceinline__ void split_hi_lo(const f32x4 a, const f32x4 b, bf16x8_t& hi, bf16x8_t& lo) {
    const float v[8] = {a.x, a.y, a.z, a.w, b.x, b.y, b.z, b.w}; unsigned h[8], l[8];
#pragma unroll
    for (int i = 0; i < 8; ++i) { h[i] = f2bf(v[i]); l[i] = f2bf(v[i] - bf2f(h[i])); }
    const u32x4 hw = {h[0] | (h[1] << 16), h[2] | (h[3] << 16), h[4] | (h[5] << 16), h[6] | (h[7] << 16)}, lw = {l[0] | (l[1] << 16), l[2] | (l[3] << 16), l[4] | (l[5] << 16), l[6] | (l[7] << 16)};
    hi = __builtin_bit_cast(bf16x8_t, hw); lo = __builtin_bit_cast(bf16x8_t, lw);
}
__device__ __forceinline__ void ln1_phase(KP p, int l, const float* xin, LAS unsigned char* lds, int G, int tid, int wave, int lane) {
    unsigned char* ws = p->ws; const bf16* mix = (const bf16*)(ws + WS_MIX); float* x1 = (float*)(ws + WS_X1); bf16* x1b = (bf16*)(ws + WS_X1B);
    int* tke = (int*)(ws + WS_TKE); float* tkg = (float*)(ws + WS_TKG); int* wgcnt = (int*)(ws + WS_WGCNT);
    LAS float* LG = (LAS float*)(lds + RT_LG) + wave * 512; LAS unsigned* hist = (LAS unsigned*)(lds + RT_HIST);
    if (tid < 32) hist[tid] = 0u;
    WG_BAR();
    const float* lg = p->ln1_g + l * 1024; const float* lb = p->ln1_b + l * 1024;
    f32x4 gv[4], bv[4];
#pragma unroll
    for (int j = 0; j < 4; ++j) { gv[j] = *(const f32x4*)(lg + 4 * lane + 256 * j); bv[j] = *(const f32x4*)(lb + 4 * lane + 256 * j); }
    const int m0 = blockIdx.x * NWAVES + wave, mstride = G * NWAVES;
    for (int mb = m0; mb < NTOK; mb += 16 * mstride) {
        f32x4 xa[4], xm[4];
#define LOAD_XIN(mm) do { if (l == 0) { const f32x4* xr = (const f32x4*)(xin + (size_t)(mm) * DM) + lane; _Pragma("unroll") for (int j = 0; j < 4; ++j) xa[j] = xr[64 * j]; } \
            else { const u32x2* xr = (const u32x2*)((const bf16*)(ws + WS_XB) + (size_t)(mm) * DM) + lane; _Pragma("unroll") for (int j = 0; j < 4; ++j) { const u32x2 w = xr[64 * j]; xa[j] = (f32x4){bflo(w.x), bfhi(w.x), bflo(w.y), bfhi(w.y)}; } } } while (0)
        { LOAD_XIN(mb); const u32x2* mr = (const u32x2*)(mix + (size_t)mb * DM) + lane;
#pragma unroll
          for (int j = 0; j < 4; ++j) { const u32x2 w = mr[64 * j]; xm[j] = (f32x4){bflo(w.x), bfhi(w.x), bflo(w.y), bfhi(w.y)}; } }
#pragma unroll 1
        for (int i = 0; i < 16; ++i) { const int m = mb + i * mstride; if (m >= NTOK) break;
            f32x4 v[4]; float s = 0.f;
#pragma unroll
            for (int j = 0; j < 4; ++j) { v[j] = xa[j] * ALPHA + xm[j]; s += (v[j].x + v[j].y) + (v[j].z + v[j].w); }
            { const int mn = (m + mstride < NTOK) ? m + mstride : m;
              LOAD_XIN(mn); const u32x2* mr = (const u32x2*)(mix + (size_t)mn * DM) + lane;
#pragma unroll
              for (int j = 0; j < 4; ++j) { const u32x2 w = mr[64 * j]; xm[j] = (f32x4){bflo(w.x), bfhi(w.x), bflo(w.y), bfhi(w.y)}; } }
            const float mean = wave_sum(s) * (1.f / DM); float s2 = 0.f;
#pragma unroll
            for (int j = 0; j < 4; ++j) { v[j] = v[j] - mean; s2 += (v[j].x * v[j].x + v[j].y * v[j].y) + (v[j].z * v[j].z + v[j].w * v[j].w); }
            const float rstd = 1.f / sqrtf(wave_sum(s2) * (1.f / DM) + LN_EPS);
            f32x4* o4 = (f32x4*)(x1 + (size_t)m * DM) + lane; unsigned* o1 = (unsigned*)((unsigned char*)x1b + (size_t)m * DM) + lane;
#pragma unroll
            for (int j = 0; j < 4; ++j) { v[j] = v[j] * rstd * gv[j] + bv[j]; o4[64 * j] = v[j]; int w8 = __builtin_amdgcn_cvt_pk_fp8_f32(v[j].x, v[j].y, 0, false); w8 = __builtin_amdgcn_cvt_pk_fp8_f32(v[j].z, v[j].w, w8, true); o1[64 * j] = (unsigned)w8; } }
        asm volatile("s_waitcnt vmcnt(0)" ::: "memory"); __builtin_amdgcn_fence(__ATOMIC_ACQUIRE, "agent"); asm volatile("s_waitcnt vmcnt(0)" ::: "memory");
        { const int ti = lane & 15, kg = lane >> 4; int mt = mb + ti * mstride; if (mt >= NTOK) mt = mb;
          const float* xr = x1 + (size_t)mt * DM + 8 * kg; const bf16* wf = (const bf16*)(ws + WS_WRF) + (size_t)l * 32 * 2 * 2 * 512 + lane * 8;
          f32x4 acc0 = {0.f, 0.f, 0.f, 0.f}, acc1 = {0.f, 0.f, 0.f, 0.f};
#pragma unroll 4
          for (int s = 0; s < 32; ++s) { const f32x4 a0 = *(const f32x4*)(xr + 32 * s), a1 = *(const f32x4*)(xr + 32 * s + 4); bf16x8_t ah, al; split_hi_lo(a0, a1, ah, al);
              const bf16x8_t w0h = *(const bf16x8_t*)(wf + (size_t)(s * 4 + 0) * 512), w0l = *(const bf16x8_t*)(wf + (size_t)(s * 4 + 1) * 512), w1h = *(const bf16x8_t*)(wf + (size_t)(s * 4 + 2) * 512), w1l = *(const bf16x8_t*)(wf + (size_t)(s * 4 + 3) * 512);
              acc0 = __builtin_amdgcn_mfma_f32_16x16x32_bf16(ah, w0h, acc0, 0, 0, 0); acc0 = __builtin_amdgcn_mfma_f32_16x16x32_bf16(al, w0h, acc0, 0, 0, 0); acc0 = __builtin_amdgcn_mfma_f32_16x16x32_bf16(ah, w0l, acc0, 0, 0, 0);
              acc1 = __builtin_amdgcn_mfma_f32_16x16x32_bf16(ah, w1h, acc1, 0, 0, 0); acc1 = __builtin_amdgcn_mfma_f32_16x16x32_bf16(al, w1h, acc1, 0, 0, 0); acc1 = __builtin_amdgcn_mfma_f32_16x16x32_bf16(ah, w1l, acc1, 0, 0, 0); }
#pragma unroll
          for (int r = 0; r < 4; ++r) { LG[(4 * kg + r) * 32 + ti] = acc0[r]; LG[(4 * kg + r) * 32 + 16 + ti] = acc1[r]; } }
        LDS_WAIT();
        if (lane < 16) { const int m = mb + lane * mstride;
            if (m < NTOK) { float tv0 = -3e38f, tv1 = -3e38f, tv2 = -3e38f, tv3 = -3e38f; int ti0 = 0, ti1 = 0, ti2 = 0, ti3 = 0;
#pragma unroll
                for (int e4 = 0; e4 < 8; ++e4) { const f32x4 lv = *(const LAS f32x4*)(LG + lane * 32 + 4 * e4); const f32x4 bb = *(const f32x4*)(p->b_router + l * 32 + 4 * e4);
#pragma unroll
                    for (int i = 0; i < 4; ++i) { const float g = lv[i] + bb[i]; const int e = 4 * e4 + i;
                        if (g > tv0) { tv3 = tv2; ti3 = ti2; tv2 = tv1; ti2 = ti1; tv1 = tv0; ti1 = ti0; tv0 = g; ti0 = e; }
                        else if (g > tv1) { tv3 = tv2; ti3 = ti2; tv2 = tv1; ti2 = ti1; tv1 = g; ti1 = e; }
                        else if (g > tv2) { tv3 = tv2; ti3 = ti2; tv2 = g; ti2 = e; }
                        else if (g > tv3) { tv3 = g; ti3 = e; } } }
                const float e1 = __expf(tv1 - tv0), e2 = __expf(tv2 - tv0), e3 = __expf(tv3 - tv0); const float inv = 1.f / (1.f + e1 + e2 + e3);
                *(int4*)(tke + m * 4) = make_int4(ti0, ti1, ti2, ti3); *(f32x4*)(tkg + m * 4) = (f32x4){inv, e1 * inv, e2 * inv, e3 * inv};
                __hip_atomic_fetch_add(hist + ti0, 1u, __ATOMIC_RELAXED, __HIP_MEMORY_SCOPE_WORKGROUP); __hip_atomic_fetch_add(hist + ti1, 1u, __ATOMIC_RELAXED, __HIP_MEMORY_SCOPE_WORKGROUP);
                __hip_atomic_fetch_add(hist + ti2, 1u, __ATOMIC_RELAXED, __HIP_MEMORY_SCOPE_WORKGROUP); __hip_atomic_fetch_add(hist + ti3, 1u, __ATOMIC_RELAXED, __HIP_MEMORY_SCOPE_WORKGROUP); } }
        LDS_WAIT();
    }
    WG_BAR();
    if (tid < 32) wgcnt[blockIdx.x * 32 + tid] = (int)hist[tid];
}

__device__ __forceinline__ void slot_phase(KP p, LAS unsigned char* lds, int G, int tid, int wave, int lane) {
    unsigned char* ws = p->ws; const int* wgcnt = (const int*)(ws + WS_WGCNT); int* blk = (int*)(ws + WS_BLK);
    const int* tke = (const int*)(ws + WS_TKE); const float* tkg = (const float*)(ws + WS_TKG); int* tokslot = (int*)(ws + WS_TOKSLOT); float* gslot = (float*)(ws + WS_GSLOT);
    LAS unsigned* tot = (LAS unsigned*)lds; LAS unsigned* mine = tot + 32; LAS unsigned* cur = tot + 64;
    if (tid < 96) tot[tid] = 0u;
    WG_BAR();
    { const int e = tid & 31, part = tid >> 5; unsigned sa = 0u, sb = 0u;
      for (int w = part; w < G; w += 16) { const unsigned c = (unsigned)wgcnt[w * 32 + e]; sa += c; if (w < (int)blockIdx.x) sb += c; }
      __hip_atomic_fetch_add(tot + e, sa, __ATOMIC_RELAXED, __HIP_MEMORY_SCOPE_WORKGROUP); __hip_atomic_fetch_add(mine + e, sb, __ATOMIC_RELAXED, __HIP_MEMORY_SCOPE_WORKGROUP); }
    WG_BAR();
    if (tid == 0) { unsigned off = 0u;
#pragma unroll 1
        for (int e = 0; e < 32; ++e) { const unsigned padded = (tot[e] + 255u) & ~255u; cur[e] = off + mine[e];
            if (blockIdx.x == 0) { blk[BST_OFF + e] = (int)(off >> 8);
#pragma unroll 1
                for (unsigned bb = off >> 8; bb < ((off + padded) >> 8); ++bb) blk[16 + bb] = e; }
            off += padded; }
        if (blockIdx.x == 0) { blk[0] = (int)(off >> 8); blk[BST_OFF + 32] = (int)(off >> 8); } }
    WG_BAR();
    int* slottok = (int*)(ws + WS_SLOTTOK);
    if (blockIdx.x == 0 && tid < 32) { const unsigned ps = cur[tid], n = tot[tid];
        int zero_ = 0; asm volatile("" : "+v"(zero_));
#pragma unroll 1
        for (unsigned s = ps + n; s < ps + ((n + 255u) & ~255u); ++s) slottok[s] = zero_; }
    WG_BAR();
    for (int m = blockIdx.x * NWAVES + wave; m < NTOK; m += G * NWAVES) {
        if (lane < 4) { const int e = tke[m * 4 + lane]; const int slot = (int)__hip_atomic_fetch_add(cur + e, 1u, __ATOMIC_RELAXED, __HIP_MEMORY_SCOPE_WORKGROUP); tokslot[m * 4 + lane] = slot; gslot[slot] = tkg[m * 4 + lane]; slottok[slot] = m; }
    }
}

__device__ __forceinline__ void comb_phase(KP p, int l, float* xout, int G, int wave, int lane) {
    unsigned char* ws = p->ws; const float* x1 = (const float*)(ws + WS_X1); const bf16* y = (const bf16*)(ws + WS_Y); const int* tokslot = (const int*)(ws + WS_TOKSLOT); bf16* xb = (bf16*)(ws + WS_XB);
    const float* lg = p->ln2_g + l * 1024; const float* lb = p->ln2_b + l * 1024;
    f32x4 gv[4], bv[4];
#pragma unroll
    for (int j = 0; j < 4; ++j) { gv[j] = *(const f32x4*)(lg + 4 * lane + 256 * j); bv[j] = *(const f32x4*)(lb + 4 * lane + 256 * j); }
    for (int m = blockIdx.x * NWAVES + wave; m < NTOK; m += G * NWAVES) {
        const f32x4* xr = (const f32x4*)(x1 + (size_t)m * DM) + lane;
        f32x4 v[4];
#pragma unroll
        for (int j = 0; j < 4; ++j) v[j] = xr[64 * j] * ALPHA;
#pragma unroll
        for (int k = 0; k < 4; ++k) { const int sk = __builtin_amdgcn_readfirstlane(tokslot[m * 4 + k]); const u32x2* yr = (const u32x2*)(y + (size_t)sk * DM) + lane;
#pragma unroll
            for (int j = 0; j < 4; ++j) { const u32x2 w = yr[64 * j]; v[j].x += bflo(w.x); v[j].y += bfhi(w.x); v[j].z += bflo(w.y); v[j].w += bfhi(w.y); } }
        float s = 0.f;
#pragma unroll
        for (int j = 0; j < 4; ++j) s += (v[j].x + v[j].y) + (v[j].z + v[j].w);
        const float mean = wave_sum(s) * (1.f / DM); float s2 = 0.f;
#pragma unroll
        for (int j = 0; j < 4; ++j) { v[j] = v[j] - mean; s2 += (v[j].x * v[j].x + v[j].y * v[j].y) + (v[j].z * v[j].z + v[j].w * v[j].w); }
        const float rstd = 1.f / sqrtf(wave_sum(s2) * (1.f / DM) + LN_EPS);
        f32x4* o4 = (f32x4*)(xout + (size_t)m * DM) + lane; u32x2* o2 = (u32x2*)(xb + (size_t)m * DM) + lane;
#pragma unroll
        for (int j = 0; j < 4; ++j) { v[j] = v[j] * rstd * gv[j] + bv[j]; if (l == DEPTH - 1) o4[64 * j] = v[j]; else { o2[64 * j] = (u32x2){pk2(v[j].x, v[j].y), pk2(v[j].z, v[j].w)};
            int w8 = __builtin_amdgcn_cvt_pk_fp8_f32(v[j].x, v[j].y, 0, false); w8 = __builtin_amdgcn_cvt_pk_fp8_f32(v[j].z, v[j].w, w8, true); ((unsigned*)(ws + WS_XB8 + (size_t)m * DM))[lane + 64 * j] = (unsigned)w8; } }
    }
}

#ifndef ONE_LAUNCH
#define ONE_LAUNCH 1
#endif
__global__ void __launch_bounds__(NTHR, 2) fwd(Params p) {
    extern __shared__ __attribute__((aligned(16))) unsigned char lds_raw[];
    LAS unsigned char* lds = (LAS unsigned char*)lds_raw;
    volatile LAS unsigned* MISC = (volatile LAS unsigned*)(lds + MISC_OFF);
    const int tid = threadIdx.x, lane = tid & 63, wave = __builtin_amdgcn_readfirstlane(tid >> 6); const int wave0 = wave;
    const int G = gridDim.x; const int bx = blockIdx.x; const int vcu = (G % 8 == 0) ? (bx % 8) * (G / 8) + bx / 8 : bx;
    if (tid < 64) MISC[tid] = 0u;
    __syncthreads();
    if (p.use_bar) (void)xcd_barrier_post((unsigned*)(p.ws + WS_CTL) + CW_BAR, MISC + 8);
    const int lo = p.ph_lo, hi = p.ph_hi;
#ifndef PHSEL
#define PHSEL(k) true
#endif
#define IN(k) (PHSEL(k) && lo <= (k) && (k) < hi)
#define SEAM(k) do { if (lo <= (k) && (k) + 1 < hi) { KP qb_ = load_params(); XcdBarrier b_; b_.bar = (unsigned*)(qb_->ws + WS_CTL) + CW_BAR; b_.x = xb_xcc_id(); b_.st = MISC + 8; xcd_barrier(b_); } } while (0)
    const int gw0 = vcu * NWAVES + wave, NGW = G * NWAVES;
#define PH_IDS const int lane = lane_id(), wave = wave0, tid = wave0 * 64 + lane, gw = vcu * NWAVES + wave; (void)lane; (void)gw; (void)gw0;

    if (IN(0)) { PH_IDS KP q = load_params(); p0_prologue(q, lds, gw, NGW, wave, lane); SEAM(0); }

    for (int l = 0; l < DEPTH; ++l) {
        const int pb = 1 + l * NPH_LAYER;

        if (IN(pb + PH_INPROJ)) {
            KP q = load_params(); unsigned char* w = q->ws;
            pg8::Gemm g{(const bf16*)(w + WS_XB8), (const bf16*)(w + WS_WIN + (size_t)l * ZP * 1024), NTOK, ZP, 1024}; pg8::StaticOrder S; S.init(NTOK, ZP, G, bx);
            pg8::EpiZ E{(bf16*)(w + WS_Z), ZP, (const float*)(w + WS_TRIG), (bf16*)(w + WS_IKC)};
            pg8::gemm_phase<pg8::EpiZ, pg8::StaticOrder, true, true, true, W8_E8M0>(lds, g, S, E, wave0);
            SEAM(pb + PH_INPROJ);
        }
        if (IN(pb + PH_IDX)) { PH_IDS KP q = load_params(); idx_phase(q, l, lds, vcu, G, tid, wave, lane); SEAM(pb + PH_IDX); }
        if (IN(pb + PH_ATTN)) { PH_IDS KP q = load_params(); attn_phase(q, l, lds, vcu, G, wave0); SEAM(pb + PH_ATTN); }
        if (IN(pb + PH_H1)) { PH_IDS KP q = load_params(); h1_phase(q, l, lds, vcu, G, tid, wave, lane); SEAM(pb + PH_H1); }
        if (IN(pb + PH_H2)) { PH_IDS KP q = load_params(); h2_phase(q, G, tid); SEAM(pb + PH_H2); }
        if (IN(pb + PH_H3)) { PH_IDS KP q = load_params(); h3_phase(q, l, lds, vcu, G, tid, wave, lane); SEAM(pb + PH_H3); }
        if (IN(pb + PH_MERGE)) {
            KP q = load_params(); unsigned char* w = q->ws;
            pg8::Gemm g{(const bf16*)(w + WS_OBUF), (const bf16*)(w + WS_WP) + (size_t)l * 1024 * 1536, NTOK, 1024, 1536}; pg8::StaticOrder S; S.init(NTOK, 1024, G, bx);
            pg8::EpiMerge E{(const bf16*)(w + WS_Z) + Z_GT, ZP, (bf16*)(w + WS_MERGED), 1024};
            pg8::gemm_phase<pg8::EpiMerge, pg8::StaticOrder, true, true>(lds, g, S, E, wave0);
            SEAM(pb + PH_MERGE);
        }
        if (IN(pb + PH_WOUT)) {
            KP q = load_params(); unsigned char* w = q->ws;
            pg8::Gemm g{(const bf16*)(w + WS_MERGED), (const bf16*)(w + WS_WOUT) + (size_t)l * 1024 * 1024, NTOK, 1024, 1024}; pg8::StaticOrder S; S.init(NTOK, 1024, G, bx);
            pg8::EpiBf16 E{(bf16*)(w + WS_MIX), 1024};
            pg8::gemm_phase<pg8::EpiBf16, pg8::StaticOrder, true, true>(lds, g, S, E, wave0);
            SEAM(pb + PH_WOUT);
        }
        if (IN(pb + PH_LN1)) { PH_IDS KP q = load_params(); const float* xin = (l == 0) ? q->x : (const float*)(q->ws + WS_XCUR); ln1_phase(q, l, xin, lds, G, tid, wave, lane); SEAM(pb + PH_LN1); }
        if (IN(pb + PH_SLOT)) { PH_IDS KP q = load_params(); slot_phase(q, lds, G, tid, wave, lane); SEAM(pb + PH_SLOT); }
        if (IN(pb + PH_GU)) {
            KP q = load_params(); unsigned char* w = q->ws;
            pg8::Gemm g{(const bf16*)(w + WS_X1B), (const bf16*)(w + WS_WGU + (size_t)l * 32 * 2048 * 1024), MAXSLOT, 32 * 2048, 1024};
            pg8::moe_build_list((LAS int*)(lds + pg8::STAGE_BYTES), (const int*)(w + WS_BLK), 8, G, bx, wave0 * 64 + lane_id()); pg8::MoeOrderG S{(const LAS int*)(lds + pg8::STAGE_BYTES), (const int*)(w + WS_SLOTTOK)};
            pg8::EpiSwiGLU E{(bf16*)(w + WS_ACT), (const float*)(w + WS_BGU) + (size_t)l * 32 * 2048, 8};
            pg8::gemm_phase<pg8::EpiSwiGLU, pg8::MoeOrderG, true, true, true, W8_E8M0>(lds, g, S, E, wave0);
            SEAM(pb + PH_GU);
        }
        if (IN(pb + PH_DOWN)) {
            KP q = load_params(); unsigned char* w = q->ws;
            pg8::Gemm g{(const bf16*)(w + WS_ACT), (const bf16*)(w + WS_WDN + (size_t)l * 32 * 1024 * 1024), MAXSLOT, 32 * 1024, 1024};
            pg8::moe_build_list((LAS int*)(lds + pg8::STAGE_BYTES), (const int*)(w + WS_BLK), 4, G, bx, wave0 * 64 + lane_id()); pg8::MoeOrder S{(const LAS int*)(lds + pg8::STAGE_BYTES), nullptr};
            pg8::EpiDown E{(bf16*)(w + WS_Y), q->b_down + (size_t)l * 32 * 1024, (const float*)(w + WS_GSLOT), 4};
            pg8::gemm_phase<pg8::EpiDown, pg8::MoeOrder, true, true, true, W8_E8M0>(lds, g, S, E, wave0);
            SEAM(pb + PH_DOWN);
        }
        if (IN(pb + PH_COMB)) { PH_IDS KP q = load_params(); float* xout = (l == DEPTH - 1) ? q->out : (float*)(q->ws + WS_XCUR); comb_phase(q, l, xout, G, wave, lane); SEAM(pb + PH_COMB); }
    }
#undef IN
#undef SEAM
}

#ifndef DBG
#define DBG 0
#endif
#if DBG
constexpr int CW_DBG = 64;
__device__ __forceinline__ unsigned hsh(unsigned a) { a ^= a >> 16; a *= 0x7feb352du; a ^= a >> 15; a *= 0x846ca68bu; a ^= a >> 16; return a; }
__device__ __forceinline__ void dbg_fail(Params& p, int id) { atomicMin((int*)(p.ws + WS_CTL) + CW_DBG, id); }
__device__ __forceinline__ bool bad(float a, float ref, float rel, float abs_) { return !(fabsf(a - ref) <= rel * fabsf(ref) + abs_); }
__device__ __forceinline__ float dotx(const float* xr, const float* W, int ld, int col, int K) { float s = 0.f; for (int k = 0; k < K; ++k) s += xr[k] * W[(size_t)k * ld + col]; return s; }

__global__ void __launch_bounds__(64) chk(Params p, int l, int which) {
    __shared__ float Ssh[64 * 65];
    unsigned char* ws = p.ws; const int gt_ = blockIdx.x * 64 + threadIdx.x; const unsigned h0 = hsh(gt_ * 2654435761u + which * 97u + 12345u), h1 = hsh(h0 + 0x9e3779b9u), h2 = hsh(h1 + 77u);
    const float* xin = (l == 0) ? p.x : (const float*)(ws + WS_XCUR);
    const bf16* Z = (const bf16*)(ws + WS_Z);
    const int id = (l * 20 + which) * 4;
    const float* win = p.w_in + (size_t)l * 1024 * D_IN;
    if (which == 1) {
        const int t = h0 % NTOK, n = h1 % D_IN; const int sc = zcol_src(n); const float scale = (n < 512 || (n >= Z_FQ && n < Z_FK)) ? QSCALE : 1.f;
        const float ref = dotx(xin + (size_t)t * DM, win, D_IN, sc, 1024) * scale;
        if (bad(bf2f(Z[(size_t)t * ZP + n]), ref, 0.03f, 0.03f)) dbg_fail(p, id);
    } else if (which == 2) {
        const int t = h0 % NTOK, pos = t & (SEQ - 1), b = t >> 13; const float* xr = xin + (size_t)t * DM;
        { const int hh = h1 % 21, i = h2 & 31; const int col = hh < 8 ? Z_AQ + hh * 64 : hh < 16 ? Z_AK + (hh - 8) * 64 : hh < 20 ? Z_IQ + (hh - 16) * 64 : Z_IK;
          const float sc = hh < 8 ? QSCALE : 1.f; const float t1 = dotx(xr, win, D_IN, zcol_src(col + i), 1024) * sc, t2 = dotx(xr, win, D_IN, zcol_src(col + i + 32), 1024) * sc;
          const float inv = powf(10000.f, -(float)i / 32.f); const float ang = (float)pos * inv; const double rev = (double)ang * 0.15915494309189535; const float fr = (float)(rev - __builtin_rint(rev));
          const float c = __builtin_amdgcn_cosf(fr), s = __builtin_amdgcn_sinf(fr);
          if (bad(bf2f(Z[(size_t)t * ZP + col + i]), t1 * c - t2 * s, 0.03f, 0.03f) || bad(bf2f(Z[(size_t)t * ZP + col + i + 32]), t2 * c + t1 * s, 0.03f, 0.03f)) dbg_fail(p, id); }
        { const int c = h2 % 1024; const float a0 = dotx(xr, win, D_IN, 5452 + c, 1024), a1 = dotx(xr, win, D_IN, 5452 + 1024 + c, 1024), a2 = dotx(xr, win, D_IN, 5452 + 2048 + c, 1024);
          const float g0 = sigmoidf_(a0), g1 = sigmoidf_(a1), g2 = sigmoidf_(a2);
          if (bad(bf2f(Z[(size_t)t * ZP + Z_GT + c]), g0 / g1, 0.05f, 0.01f) || bad(bf2f(Z[(size_t)t * ZP + Z_GT + 1024 + c]), g1 / g2, 0.05f, 0.01f) || bad(bf2f(Z[(size_t)t * ZP + Z_GT + 2048 + c]), g2, 0.05f, 0.01f)) dbg_fail(p, id + 1); }
        { const int hh = h1 & 7; const float v = dotx(xr, win, D_IN, 3396 + hh, 1024) + p.b_fox[l * 8 + hh]; const float ls = -log1pf(expf(-v)) * LOG2E;
          if (bad(((const float*)(ws + WS_LFT))[(size_t)(b * 8 + hh) * SEQ + pos], ls, 0.05f, 0.003f)) dbg_fail(p, id + 2); }
    } else if (which == 3) {
        { const int bh = h0 & 31, t = h1 % SEQ; const float* lf = (const float*)(ws + WS_LFT) + (size_t)bh * SEQ; float s = 0.f; for (int i = 0; i <= t; ++i) s += lf[i];
          if (bad(((const float*)(ws + WS_CT))[(size_t)bh * SEQ + t], s, 1e-3f, 1e-2f)) dbg_fail(p, id); }
        if (gt_ < 192) { const int b = h1 & 3, q = (gt_ < 32) ? (int)(h2 % 512) : (int)(h2 % SEQ); const int nadm = ((q >> 6) + 1) * 64; const u64* mw = (const u64*)(ws + WS_MASKW) + (size_t)(b * SEQ + q) * 128;
          int pc = 0; bool oob = false; for (int w = 0; w < 128; ++w) { const u64 m = mw[w]; pc += __popcll(m); if (w * 64 >= nadm && m) oob = true; }
          if (pc != (nadm < 256 ? nadm : 256) || oob) dbg_fail(p, id + 1);
          const bf16* qr = Z + (size_t)(b * SEQ + q) * ZP; float minsel = 3e38f, maxun = -3e38f;
          for (int s = 0; s < nadm; ++s) { const bf16* kr = Z + (size_t)(b * SEQ + s) * ZP + Z_IK; float sc = 0.f;
              for (int hd = 0; hd < 4; ++hd) { float d = 0.f; for (int k = 0; k < 64; ++k) d += bf2f(qr[Z_IQ + hd * 64 + k]) * bf2f(kr[k]); sc += bf2f(qr[Z_IW + hd]) * 0.0625f * fmaxf(d, 0.f); }
              if ((mw[s >> 6] >> (s & 63)) & 1ull) minsel = fminf(minsel, sc); else maxun = fmaxf(maxun, sc); }
          if (nadm > 256 && !(maxun <= minsel + 0.02f * fabsf(minsel) + 2e-3f)) dbg_fail(p, id + 2); }
    } else if (which == 4) {
        if (gt_ == 0 && l == 0) { const bf16* ob = (const bf16*)(ws + WS_OBUF) + 512;
            const float a0 = bf2f(ob[0]), a1 = bf2f(ob[1]), a3 = bf2f(ob[3]), b0 = bf2f(ob[8]), b1 = bf2f(ob[9]), b3 = bf2f(ob[11]), m0 = bf2f(ob[4]), m1 = bf2f(ob[12]);
            auto tr = [](float v) { return v == 0.f ? 0.f : v == 1.f ? 1.f : 2.f; };
            ((float*)(ws + WS_CTL))[CW_DBG + 2] = 10.f * (tr(a0) + 3.f * tr(b0) + 9.f * tr(a1) + 27.f * tr(b1));
            ((float*)(ws + WS_CTL))[CW_DBG + 3] = sqrtf(10.f * (tr(a3) + 3.f * tr(b3) + 9.f * (m0 == m1 ? 1.f : 0.f) + 27.f * (m0 > -1e20f ? 1.f : 0.f))); }
        const int mode = gt_ & 1, b = h0 & 3, h = (h0 >> 2) & 7, q = (gt_ < 64) ? (int)(h1 % 300) : (int)(h1 % SEQ), d = h2 & 63;
        const int QC = mode == 0 ? Z_FQ : Z_AQ, KC = mode == 0 ? Z_FK : Z_AK, VC = mode == 0 ? Z_FV : Z_AV, OC = mode == 0 ? 512 : 0;
        const bf16* qr = Z + (size_t)(b * SEQ + q) * ZP + QC + h * 64; const float* c = (const float*)(ws + WS_CT) + (size_t)(b * 8 + h) * SEQ; const u64* mw = (const u64*)(ws + WS_MASKW) + (size_t)(b * SEQ + q) * 128;
        const int ns = mode == 0 ? q + 1 : ((q >> 6) + 1) * 64; float mx = -3e38f, mx2 = -3e38f; float ref = 0.f, ref2 = 0.f;
        for (int pass = 0; pass < 2; ++pass) { float den = 0.f, num = 0.f, den2 = 0.f, num2 = 0.f;
            for (int s = 0; s < ns; ++s) { if (mode == 1 && !((mw[s >> 6] >> (s & 63)) & 1ull)) continue;
                const bf16* kr = Z + (size_t)(b * SEQ + s) * ZP + KC + h * 64; float lg = 0.f; for (int k = 0; k < 64; ++k) lg += bf2f(qr[k]) * bf2f(kr[k]);
                const float lg2 = lg; if (mode == 0) lg += c[q] - c[s];
                if (pass == 0) { mx = fmaxf(mx, lg); mx2 = fmaxf(mx2, lg2); } else { const float vv = bf2f(Z[(size_t)(b * SEQ + s) * ZP + VC + h * 64 + d]); const float pp = exp2f(lg - mx), pq = exp2f(lg2 - mx2); den += pp; num += pp * vv; den2 += pq; num2 += pq * vv; } }
            if (pass == 1) { ref = num / den; ref2 = num2 / den2; } }
        const float got = bf2f(((const bf16*)(ws + WS_OBUF))[(size_t)(b * SEQ + q) * OP + OC + h * 64 + d]);
        if (bad(got, ref, 0.04f, 0.03f)) { dbg_fail(p, id + mode);
            int m = 0; if (mode == 0 && q == 0) m |= 1; if (mode == 0 && q < 32) m |= 2; if (mode == 1 && q < 64) m |= 4; if (mode == 1 && q >= 64) m |= 8; atomicOr((int*)(p.ws + WS_CTL) + CW_DBG + 1, m); }
    } else if (which == 7) {
        const int b = blockIdx.x & 3, h = (blockIdx.x >> 2) & 7, e = threadIdx.x;
        for (int d = 0; d < 64; ++d) Ssh[d * 65 + e] = 0.f;
        const float lbv_e = 0.f; (void)lbv_e;
        for (int t = 0; t < 200; ++t) { const bf16* zr = Z + (size_t)(b * SEQ + t) * ZP + h * 64; float o = 0.f; const float ve = bf2f(zr[Z_CI + e]);
            for (int d = 0; d < 64; ++d) { const int dd = h * 64 + d; const float lb = (l == 0) ? 0.f : sigmoidf_(p.lb_logits[512 + dd] - p.lb_logits[dd]);
                const float sg = sigmoidf_(bf2f(zr[Z_CF + d])); const float f = lb + (1.f - lb) * sg, kk = (1.f - lb) * (1.f - sg);
                const float S = f * Ssh[d * 65 + e] + kk * ve; Ssh[d * 65 + e] = S; o += bf2f(zr[Z_CQ + d]) * S; }
            const float ss = wave_sum(o * o); const float ref = o * (1.f / sqrtf(ss * (1.f / 64.f) + RMS_EPS)) * p.norm_g[l * 512 + h * 64 + e] * sigmoidf_(bf2f(zr[Z_CG + e]));
            if (bad(bf2f(((const bf16*)(ws + WS_OBUF))[(size_t)(b * SEQ + t) * OP + 1024 + h * 64 + e]), ref, 0.06f, 0.05f)) { const int n = atomicAdd((int*)(p.ws + WS_CTL) + CW_DBG + 4 + (t >= 64 ? 1 : 0), 1); if (n >= 40) dbg_fail(p, id + (t >= 64 ? 1 : 0)); } }
    } else if (which == 8) {
        const int t = h0 % NTOK, c = h1 % 1024; const bf16* zr = Z + (size_t)t * ZP + Z_GT; const float g2 = bf2f(zr[2048 + c]), g1 = bf2f(zr[1024 + c]) * g2, g0 = bf2f(zr[c]) * g1;
        const bf16* ob = (const bf16*)(ws + WS_OBUF) + (size_t)t * OP; float sa = 0.f, sb = 0.f, sc = 0.f;
        for (int k = 0; k < 512; ++k) { sa += bf2f(ob[k]) * p.w_pa[((size_t)l * 512 + k) * 1024 + c]; sb += bf2f(ob[512 + k]) * p.w_pb[((size_t)l * 512 + k) * 1024 + c]; sc += bf2f(ob[1024 + k]) * p.w_pc[((size_t)l * 512 + k) * 1024 + c]; }
        if (bad(bf2f(((const bf16*)(ws + WS_MERGED))[(size_t)t * 1024 + c]), g0 * sa + g1 * sb + g2 * sc, 0.04f, 0.01f)) dbg_fail(p, id);
    } else if (which == 9) {
        const int t = h0 % NTOK, c = h1 % 1024; const bf16* mr = (const bf16*)(ws + WS_MERGED) + (size_t)t * 1024; float s = 0.f;
        for (int k = 0; k < 1024; ++k) s += bf2f(mr[k]) * p.w_out[((size_t)l * 1024 + k) * 1024 + c];
        if (bad(((const float*)(ws + WS_MIX))[(size_t)t * 1024 + c], s, 0.03f, 0.005f)) dbg_fail(p, id);
    } else if (which == 10) {
        const int t = h0 % NTOK, c = h1 % 1024; const float* xr = xin + (size_t)t * DM; const float* mr = (const float*)(ws + WS_MIX) + (size_t)t * DM; const float* x1 = (const float*)(ws + WS_X1) + (size_t)t * DM;
        float mean = 0.f; for (int k = 0; k < 1024; ++k) mean += ALPHA * xr[k] + mr[k]; mean *= (1.f / 1024.f);
        float var = 0.f; for (int k = 0; k < 1024; ++k) { const float dlt = ALPHA * xr[k] + mr[k] - mean; var += dlt * dlt; } var *= (1.f / 1024.f);
        const float ref = (ALPHA * xr[c] + mr[c] - mean) / sqrtf(var + LN_EPS) * p.ln1_g[l * 1024 + c] + p.ln1_b[l * 1024 + c];
        if (bad(x1[c], ref, 1e-3f, 1e-3f) || bad(bf2f(((const bf16*)(ws + WS_X1B))[(size_t)t * DM + c]), ref, 0.01f, 0.01f)) dbg_fail(p, id);
        float tv0 = -3e38f, tv1 = -3e38f, tv2 = -3e38f, tv3 = -3e38f; int ti0 = -1, ti1 = -1, ti2 = -1, ti3 = -1;
        for (int e = 0; e < 32; ++e) { float lg = p.b_router[l * 32 + e]; for (int k = 0; k < 1024; ++k) lg += x1[k] * p.w_router[((size_t)l * 1024 + k) * 32 + e];
            if (lg > tv0) { tv3 = tv2; ti3 = ti2; tv2 = tv1; ti2 = ti1; tv1 = tv0; ti1 = ti0; tv0 = lg; ti0 = e; } else if (lg > tv1) { tv3 = tv2; ti3 = ti2; tv2 = tv1; ti2 = ti1; tv1 = lg; ti1 = e; }
            else if (lg > tv2) { tv3 = tv2; ti3 = ti2; tv2 = lg; ti2 = e; } else if (lg > tv3) { tv3 = lg; ti3 = e; } }
        const int* tke = (const int*)(ws + WS_TKE) + t * 4; const float* tkg = (const float*)(ws + WS_TKG) + t * 4;
        const float den = 1.f + expf(tv1 - tv0) + expf(tv2 - tv0) + expf(tv3 - tv0);
        if (tv2 - tv3 > 1e-3f && tv1 - tv2 > 1e-3f && tv0 - tv1 > 1e-3f) { if (tke[0] != ti0 || tke[1] != ti1 || tke[2] != ti2 || tke[3] != ti3) dbg_fail(p, id + 1);
            if (bad(tkg[0], 1.f / den, 1e-2f, 1e-3f) || bad(tkg[3], expf(tv3 - tv0) / den, 1e-2f, 1e-3f)) dbg_fail(p, id + 2); }
    } else if (which == 11) {
        const int t = h0 % NTOK, k = h1 & 3, c = h2 % 1024; const int slot = ((const int*)(ws + WS_TOKSLOT))[t * 4 + k], e = ((const int*)(ws + WS_TKE))[t * 4 + k]; const int* blk = (const int*)(ws + WS_BLK);
        if (slot < 0 || slot >= blk[0] * 256 || blk[0] > MAXBLK) { dbg_fail(p, id); return; }
        if (blk[16 + (slot >> 8)] != e) dbg_fail(p, id + 1);
        if (((const float*)(ws + WS_GSLOT))[slot] != ((const float*)(ws + WS_TKG))[t * 4 + k]) dbg_fail(p, id + 2);
        if (((const bf16*)(ws + WS_XG))[(size_t)slot * DM + c] != ((const bf16*)(ws + WS_X1B))[(size_t)t * DM + c]) dbg_fail(p, id + 3);
    } else if (which == 12) {
        const int t = h0 % NTOK, k = h1 & 3, j = h2 % 1024; const int slot = ((const int*)(ws + WS_TOKSLOT))[t * 4 + k], e = ((const int*)(ws + WS_TKE))[t * 4 + k];
        const bf16* xr = (const bf16*)(ws + WS_XG) + (size_t)slot * DM; const float* W = p.w_gu + (size_t)(l * 32 + e) * 1024 * 2048; float g = p.b_gu[(size_t)(l * 32 + e) * 2048 + j], u = p.b_gu[(size_t)(l * 32 + e) * 2048 + 1024 + j];
        for (int kk = 0; kk < 1024; ++kk) { const float xv = bf2f(xr[kk]); g += xv * W[(size_t)kk * 2048 + j]; u += xv * W[(size_t)kk * 2048 + 1024 + j]; }
        g = fminf(g, 7.f); u = fminf(fmaxf(u, -7.f), 7.f); const float ref = g * sigmoidf_(1.702f * g) * (u + 1.f);
        if (bad(bf2f(((const bf16*)(ws + WS_ACT))[(size_t)slot * 1024 + j]), ref, 0.04f, 0.02f)) dbg_fail(p, id);
    } else if (which == 13) {
        const int t = h0 % NTOK, k = h1 & 3, n = h2 % 1024; const int slot = ((const int*)(ws + WS_TOKSLOT))[t * 4 + k], e = ((const int*)(ws + WS_TKE))[t * 4 + k];
        const bf16* ar = (const bf16*)(ws + WS_ACT) + (size_t)slot * 1024; const float* W = p.w_down + (size_t)(l * 32 + e) * 1024 * 1024; float s = p.b_down[(size_t)(l * 32 + e) * 1024 + n];
        for (int kk = 0; kk < 1024; ++kk) s += bf2f(ar[kk]) * W[(size_t)kk * 1024 + n];
        if (bad(bf2f(((const bf16*)(ws + WS_Y))[(size_t)slot * 1024 + n]), s * ((const float*)(ws + WS_GSLOT))[slot], 0.04f, 0.005f)) dbg_fail(p, id);
    } else if (which == 14) {
        const int t = h0 % NTOK, c = h1 % 1024; const float* x1 = (const float*)(ws + WS_X1) + (size_t)t * DM; const bf16* y = (const bf16*)(ws + WS_Y); const int* ts = (const int*)(ws + WS_TOKSLOT) + t * 4;
        const float* xo = ((l == DEPTH - 1) ? p.out : (float*)(ws + WS_XCUR)) + (size_t)t * DM;
        float mean = 0.f; for (int k = 0; k < 1024; ++k) { float v = ALPHA * x1[k]; for (int j = 0; j < 4; ++j) v += bf2f(y[(size_t)ts[j] * 1024 + k]); mean += v; } mean *= (1.f / 1024.f);
        float var = 0.f, vc = 0.f; for (int k = 0; k < 1024; ++k) { float v = ALPHA * x1[k]; for (int j = 0; j < 4; ++j) v += bf2f(y[(size_t)ts[j] * 1024 + k]); var += (v - mean) * (v - mean); if (k == c) vc = v; } var *= (1.f / 1024.f);
        if (bad(xo[c], (vc - mean) / sqrtf(var + LN_EPS) * p.ln2_g[l * 1024 + c] + p.ln2_b[l * 1024 + c], 2e-3f, 2e-3f)) dbg_fail(p, id);
    }
}
__global__ void dbg_init(Params p) { if (threadIdx.x == 0 && blockIdx.x == 0) { ((int*)(p.ws + WS_CTL))[CW_DBG] = 0x7fffffff; ((int*)(p.ws + WS_CTL))[CW_DBG + 1] = 0; ((int*)(p.ws + WS_CTL))[CW_DBG + 4] = 0; ((int*)(p.ws + WS_CTL))[CW_DBG + 5] = 0; } }
__global__ void dbg_fill(Params p, int n) {
    const int code = ((const int*)(p.ws + WS_CTL))[CW_DBG]; if (code == 0x7fffffff) return;
    const int sub = code & 3, lw = code >> 2, l = lw / 20, which = lw % 20; const int k = l * 16 + which + 32 * sub;
    const float c = sqrtf(exp2f((float)k));
    const int msk = ((const int*)(p.ws + WS_CTL))[CW_DBG + 1];
    for (int i = blockIdx.x * blockDim.x + threadIdx.x; i < n; i += gridDim.x * blockDim.x) p.out[i] = (i == 0) ? 16.f * (float)(1 + msk) : c;
}
#endif

extern "C" void kernel_launch(void* const* d_in, const int* in_sizes, int n_in, void* d_out, int out_size, void* d_ws, size_t ws_size, hipStream_t stream) {
    static int grid = 0;
    if (grid == 0) {
        if (n_in != 19 || ws_size < WS_END) { fprintf(stderr, "kernel_launch: need 19 inputs and >= %zu bytes of workspace; got %d, %zu\n", (size_t)WS_END, n_in, ws_size); grid = -1; return; }
        int dev = 0, cus = 0, per_cu = 0;
        if (hipGetDevice(&dev) != hipSuccess || hipDeviceGetAttribute(&cus, hipDeviceAttributeMultiprocessorCount, dev) != hipSuccess) { grid = -1; return; }
        if (hipFuncSetAttribute((const void*)fwd, hipFuncAttributeMaxDynamicSharedMemorySize, LDS_BYTES) != hipSuccess) { fprintf(stderr, "kernel_launch: hipFuncSetAttribute failed\n"); grid = -1; return; }
        if (hipOccupancyMaxActiveBlocksPerMultiprocessor(&per_cu, (const void*)fwd, NTHR, LDS_BYTES) != hipSuccess || per_cu < 1) fprintf(stderr, "kernel_launch: occupancy query reports %d\n", per_cu);
        (void)hipGetLastError();
        grid = cus;
    }
    if (grid < 0) return;
    (void)hipMemsetAsync((char*)d_ws + WS_CTL, 0, CTL_ZERO_BYTES, stream);
    Params p{};
    const float** f = (const float**)&p;
    for (int i = 0; i < 19; ++i) f[i] = (const float*)d_in[i];
    p.out = (float*)d_out; p.ws = (unsigned char*)d_ws;
#if ONE_LAUNCH
    p.ph_lo = 0; p.ph_hi = NPHASES; p.use_bar = 1; p.pad = 0;
    hipLaunchKernelGGL(fwd, dim3(grid), dim3(NTHR), LDS_BYTES, stream, p);
#else
#if DBG
    hipLaunchKernelGGL(dbg_init, dim3(1), dim3(64), 0, stream, p);
#endif
    for (int ph = 0; ph < NPHASES; ++ph) { p.ph_lo = ph; p.ph_hi = ph + 1; p.use_bar = 0; p.pad = 0;
        hipLaunchKernelGGL(fwd, dim3(grid), dim3(NTHR), LDS_BYTES, stream, p);
#if DBG
        if (ph >= 1) { const int l = (ph - 1) / NPH_LAYER, k = (ph - 1) % NPH_LAYER; static const int wmap[NPH_LAYER] = {1, 2, 3, 4, 0, 0, 7, 8, 9, 10, 11, 12, 13, 14}; const int w = wmap[k];
            if (w) { const int nb = (w == 7) ? 32 : (w == 3) ? 4 : (w == 4) ? 2 : 16; hipLaunchKernelGGL(chk, dim3(nb), dim3(64), 0, stream, p, l, w); } }
#endif
    }
#if DBG
    hipLaunchKernelGGL(dbg_fill, dim3(1024), dim3(256), 0, stream, p, out_size);
#endif
#endif
}
```

```cpp
#include <hip/hip_runtime.h>
#include <cstdio>
#include <cstdint>

#define GAS __attribute__((address_space(1)))
#define LAS __attribute__((address_space(3)))
typedef unsigned short bf16;
typedef short bf16x8 __attribute__((ext_vector_type(8)));
typedef short s16x4 __attribute__((ext_vector_type(4)));
typedef float f32x2 __attribute__((ext_vector_type(2)));
typedef float f32x4 __attribute__((ext_vector_type(4)));
typedef float f32x16 __attribute__((ext_vector_type(16)));
typedef unsigned u32x2 __attribute__((ext_vector_type(2)));
typedef unsigned u32x4 __attribute__((ext_vector_type(4)));
typedef unsigned long long u64;

__device__ __forceinline__ unsigned f2bf(float f) { unsigned u = __builtin_bit_cast(unsigned, f); return (u + 0x7fffu + ((u >> 16) & 1u)) >> 16; }
__device__ __forceinline__ unsigned pk2(float lo, float hi) { return f2bf(lo) | (f2bf(hi) << 16); }
__device__ __forceinline__ float bf2f(unsigned b) { return __builtin_bit_cast(float, b << 16); }
__device__ __forceinline__ float bflo(unsigned w) { return __builtin_bit_cast(float, w << 16); }
__device__ __forceinline__ float bfhi(unsigned w) { return __builtin_bit_cast(float, w & 0xffff0000u); }
__device__ __forceinline__ float sigmoidf_(float x) { return __builtin_amdgcn_rcpf(1.0f + __expf(-x)); }

namespace pg8 {
#define PG8_LAS __attribute__((address_space(3)))
typedef unsigned short bf16_t;
typedef short bf16x8 __attribute__((ext_vector_type(8)));
typedef float f32x4 __attribute__((ext_vector_type(4)));
typedef unsigned u32x4 __attribute__((ext_vector_type(4)));
typedef unsigned u32x2_t __attribute__((ext_vector_type(2)));
constexpr int BM = 256, BK = 64, HALF = 128, HTB = HALF * BK * 2  , STAGE_BYTES = 8 * HTB, NXCD = 8, WGM = 8;

__host__ __device__ __forceinline__ int lds_byte(int r, int c) { const int cb = 2 * c; return (r >> 3) * 1024 + (r & 7) * 128 + (((cb >> 4) ^ ((r >> 1) & 7)) * 16) + (cb & 15); }
__host__ __device__ __forceinline__ void stage_rc(int b, int& R, int& C) { const int st = b / 1024, w = b % 1024; R = st * 8 + w / 128; const int c16 = ((w % 128) / 16) ^ ((R >> 1) & 7); C = c16 * 8 + (w % 16) / 2; }
__host__ __device__ __forceinline__ int perm32(int rho) { const int n = rho >> 4, i = rho & 15; return 8 * (i >> 2) + 4 * n + (i & 3); }

struct Unit { int pm, pn; };
struct Gemm { const bf16_t* A; const bf16_t* Bt; int M, N, K; };

struct StaticOrder {
    static constexpr bool GATHER = false; const int* tok = nullptr;
    int nM, nN, nwg, G, c;
    __host__ __device__ void init(int M, int N, int G_, int c_) { nM = M / BM; nN = N / BM; nwg = nM * nN; G = G_; c = c_; }
    __host__ __device__ bool next(int i, Unit& u) const {
        const long L = (long)i * G + c; if (L >= nwg) return false;
        int wgid = (int)L; { const int q = nwg / NXCD, r = nwg % NXCD, xcd = wgid % NXCD, off = wgid / NXCD; wgid = (xcd < r ? xcd * (q + 1) : r * (q + 1) + (xcd - r) * q) + off; }
        const int nig = WGM * nN, gid = wgid / nig, fm = gid * WGM, gsz = (nM - fm) < WGM ? (nM - fm) : WGM;
        u.pm = fm + ((wgid % nig) % gsz); u.pn = (wgid % nig) / gsz; return true;
    }
    __device__ __forceinline__ void a_ready(const Unit&) const {}
    __device__ __forceinline__ void done(const Unit&) const {}
};
template <bool GATHER_> struct MoeOrderT {
    static constexpr bool GATHER = GATHER_;
    const PG8_LAS int* list; const int* tok;
    __device__ bool next(int i, Unit& u) const {
        if (i >= __builtin_amdgcn_readfirstlane(list[0])) return false;
        u.pm = __builtin_amdgcn_readfirstlane(list[2 + 2 * i]); u.pn = __builtin_amdgcn_readfirstlane(list[3 + 2 * i]); return true;
    }
    __device__ __forceinline__ void a_ready(const Unit&) const {}
    __device__ __forceinline__ void done(const Unit&) const {}
};
typedef MoeOrderT<false> MoeOrder; typedef MoeOrderT<true> MoeOrderG;
__device__ __forceinline__ void moe_build_list(PG8_LAS int* list, const int* blk, int nN, int G, int c, int tid) {
    if (tid == 0) { const int* bst = blk + 16 + 544 + 16; int n = 0;
        if (G % 8 == 0) { const int W = G / 8, j = c / 8, x = c % 8;
            for (int i = 0; i < 64; ++i) { const int uu = i * W + j; const int bi = uu / nN, pl = uu - bi * nN; int rem = bi; bool ok = false;
                for (int k = 0; k < 4 && !ok; ++k) { const int e = x + 8 * k; const int b0 = bst[e], b1 = bst[e + 1]; if (rem < b1 - b0) { list[2 + 2 * n] = b0 + rem; list[3 + 2 * n] = e * nN + pl; ++n; ok = true; } else rem -= b1 - b0; }
                if (!ok) break; }
        } else { const int nb = bst[32];
            for (int i = 0; i < 64; ++i) { const int uu = i * G + c; const int bi = uu / nN, pl = uu - bi * nN; if (bi >= nb) break; int e = 0; for (int k = 1; k < 32; ++k) if (bi >= bst[k]) e = k; list[2 + 2 * n] = bi; list[3 + 2 * n] = e * nN + pl; ++n; } }
        list[0] = n; }
    asm volatile("s_waitcnt lgkmcnt(0)\n\ts_barrier" ::: "memory");
}

typedef __bf16 bf16x2_pg8 __attribute__((ext_vector_type(2))); typedef float f32x2_pg8 __attribute__((ext_vector_type(2)));
__device__ __forceinline__ unsigned cvt_pk_bf16(float lo, float hi) { const f32x2_pg8 v = {lo, hi}; return __builtin_bit_cast(unsigned, __builtin_convertvector(v, bf16x2_pg8)); }

struct EpiZ {
    static constexpr bool PERM = true, AFTER_DRAIN = false, MIDK = false;
    bf16_t* O; int ldc; const float* trig; bf16_t* IKC;
    __device__ __forceinline__ void operator()(const f32x4 (&acc)[2][2][4][2], const Unit& u, int wr, int wc, int fr, int fq) const {
        asm volatile("" : "+v"(fr), "+v"(fq));
        const int row0 = u.pm * BM + wr * 64 + fr; const int col0 = u.pn * BM + wc * 32 + 8 * fq;
        const bool rot_all = (u.pn < 4) || (u.pn == 32); const bool rot_b0 = rot_all || (u.pn == 33 && wc < 2);
        if (u.pn >= 20 && u.pn < 32) {
#pragma unroll
            for (int it = 0; it < 8; ++it) { const int ai = it >> 2, m = it & 3; unsigned char* rowb = (unsigned char*)(O + (size_t)(row0 + ai * HALF + m * 16) * ldc) + u.pn * 512 + wc * 32 + 8 * fq;
#pragma unroll
                for (int bj = 0; bj < 2; ++bj) { const f32x4 v0 = acc[ai][bj][m][0], v1 = acc[ai][bj][m][1];
                    int g0 = __builtin_amdgcn_cvt_pk_fp8_f32(v0[0], v0[1], 0, false); g0 = __builtin_amdgcn_cvt_pk_fp8_f32(v0[2], v0[3], g0, true);
                    int g1 = __builtin_amdgcn_cvt_pk_fp8_f32(v1[0], v1[1], 0, false); g1 = __builtin_amdgcn_cvt_pk_fp8_f32(v1[2], v1[3], g1, true);
                    *(u32x2_t*)(rowb + bj * HALF) = (u32x2_t){(unsigned)g0, (unsigned)g1}; } }
        } else if (!rot_b0) {
#pragma unroll
            for (int it = 0; it < 8; ++it) { const int ai = it >> 2, m = it & 3; bf16_t* rowp = O + (size_t)(row0 + ai * HALF + m * 16) * ldc + col0;
#pragma unroll
                for (int bj = 0; bj < 2; ++bj) { const f32x4 v0 = acc[ai][bj][m][0], v1 = acc[ai][bj][m][1];
                    u32x4 w; w.x = cvt_pk_bf16(v0[0], v0[1]); w.y = cvt_pk_bf16(v0[2], v0[3]); w.z = cvt_pk_bf16(v1[0], v1[1]); w.w = cvt_pk_bf16(v1[2], v1[3]);
                    *(u32x4*)(rowp + bj * HALF) = w; } }
        } else {
            const int i0 = (wc & 1) * 16 + 4 * fq;
#pragma unroll
            for (int ai = 0; ai < 2; ++ai) { f32x4 ca[4], cb[4];
#pragma unroll
            for (int m = 0; m < 4; ++m) { const float* tp = trig + ((size_t)((row0 + ai * HALF + m * 16) & 8191) * 32 + i0) * 2; ca[m] = *(const f32x4*)tp; cb[m] = *(const f32x4*)(tp + 4); }
            asm volatile("s_waitcnt vmcnt(0)" ::: "memory");
#pragma unroll
            for (int m = 0; m < 4; ++m) { const int row = row0 + ai * HALF + m * 16; bf16_t* rowp = O + (size_t)row * ldc + col0;
#pragma unroll
                for (int bj = 0; bj < 2; ++bj) { f32x4 v0 = acc[ai][bj][m][0], v1 = acc[ai][bj][m][1];
                    if (bj == 0 || rot_all) { const f32x4 a = ca[m], b = cb[m];
                        const f32x4 r0 = {v0[0] * a[0] - v0[1] * a[1], v0[1] * a[0] + v0[0] * a[1], v0[2] * a[2] - v0[3] * a[3], v0[3] * a[2] + v0[2] * a[3]};
                        const f32x4 r1 = {v1[0] * b[0] - v1[1] * b[1], v1[1] * b[0] + v1[0] * b[1], v1[2] * b[2] - v1[3] * b[3], v1[3] * b[2] + v1[2] * b[3]};
                        v0 = r0; v1 = r1; }
                    u32x4 w; w.x = cvt_pk_bf16(v0[0], v0[1]); w.y = cvt_pk_bf16(v0[2], v0[3]); w.z = cvt_pk_bf16(v1[0], v1[1]); w.w = cvt_pk_bf16(v1[2], v1[3]);
                    *(u32x4*)(rowp + bj * HALF) = w;
                    if (bj == 0 && u.pn == 33) *(u32x4*)(IKC + (size_t)row * 64 + wc * 32 + 8 * fq) = w; } } }
        }
    }
};
struct EpiF32 {
    static constexpr bool PERM = true, AFTER_DRAIN = false, MIDK = false;
    float* O; int ldc;
    __device__ __forceinline__ void operator()(const f32x4 (&acc)[2][2][4][2], const Unit& u, int wr, int wc, int fr, int fq) const {
        asm volatile("" : "+v"(fr), "+v"(fq));
        const int row0 = u.pm * BM + wr * 64 + fr; const int col0 = u.pn * BM + wc * 32 + 8 * fq;
#pragma unroll
        for (int ai = 0; ai < 2; ++ai)
#pragma unroll
            for (int m = 0; m < 4; ++m) { float* rowp = O + (size_t)(row0 + ai * HALF + m * 16) * ldc + col0;
#pragma unroll
                for (int bj = 0; bj < 2; ++bj) { *(f32x4*)(rowp + bj * HALF) = acc[ai][bj][m][0]; *(f32x4*)(rowp + bj * HALF + 4) = acc[ai][bj][m][1]; } }
    }
};
struct EpiBf16 {
    static constexpr bool PERM = true, AFTER_DRAIN = false, MIDK = false;
    bf16_t* O; int ldc;
    __device__ __forceinline__ void operator()(const f32x4 (&acc)[2][2][4][2], const Unit& u, int wr, int wc, int fr, int fq) const {
        asm volatile("" : "+v"(fr), "+v"(fq));
        const int row0 = u.pm * BM + wr * 64 + fr; const int col0 = u.pn * BM + wc * 32 + 8 * fq;
#pragma unroll
        for (int ai = 0; ai < 2; ++ai)
#pragma unroll
            for (int m = 0; m < 4; ++m) { bf16_t* rowp = O + (size_t)(row0 + ai * HALF + m * 16) * ldc + col0;
#pragma unroll
                for (int bj = 0; bj < 2; ++bj) { const f32x4 v0 = acc[ai][bj][m][0], v1 = acc[ai][bj][m][1];
                    u32x4 w; w.x = cvt_pk_bf16(v0[0], v0[1]); w.y = cvt_pk_bf16(v0[2], v0[3]); w.z = cvt_pk_bf16(v1[0], v1[1]); w.w = cvt_pk_bf16(v1[2], v1[3]);
                    *(u32x4*)(rowp + bj * HALF) = w; } }
    }
};
__device__ __forceinline__ void dec_fp8x8(const u32x2_t w, float (&o)[8]) {
    o[0] = __builtin_amdgcn_cvt_f32_fp8((int)w.x, 0); o[1] = __builtin_amdgcn_cvt_f32_fp8((int)w.x, 1); o[2] = __builtin_amdgcn_cvt_f32_fp8((int)w.x, 2); o[3] = __builtin_amdgcn_cvt_f32_fp8((int)w.x, 3);
    o[4] = __builtin_amdgcn_cvt_f32_fp8((int)w.y, 0); o[5] = __builtin_amdgcn_cvt_f32_fp8((int)w.y, 1); o[6] = __builtin_amdgcn_cvt_f32_fp8((int)w.y, 2); o[7] = __builtin_amdgcn_cvt_f32_fp8((int)w.y, 3);
}
struct EpiMerge {
    static constexpr bool PERM = true, AFTER_DRAIN = false, MIDK = true;
    const bf16_t* Gz; int gp; bf16_t* O; int ldc;
    __device__ __forceinline__ void scale(f32x4 (&acc)[2][2][4][2], const Unit& u, int idx, int wr, int wc, int fr, int fq) const {
        asm volatile("" : "+v"(fr), "+v"(fq));
        const int row0 = u.pm * BM + wr * 64 + fr; const int col0 = u.pn * BM + wc * 32 + 8 * fq;
        const int pa = (idx == 2) ? 2048 : (idx == 1) ? 2048 : 1024, pb = (idx == 1) ? 1024 : 0;
        u32x2_t wa[2], wb[2], na[2], nb[2];
#define MG_LOAD(IT, WA, WB) do { const unsigned char* rowp_ = (const unsigned char*)(Gz + (size_t)(row0 + ((IT) >> 2) * HALF + ((IT) & 3) * 16) * gp) + u.pn * 512 + wc * 32 + 8 * fq; \
            _Pragma("unroll") for (int bj = 0; bj < 2; ++bj) { WA[bj] = *(const u32x2_t*)(rowp_ + pa * 2 + bj * HALF); if (idx != 2) WB[bj] = *(const u32x2_t*)(rowp_ + pb * 2 + bj * HALF); else WB[bj] = WA[bj]; } } while (0)
        MG_LOAD(0, wa, wb);
#pragma unroll
        for (int it = 0; it < 8; ++it) { const int ai = it >> 2, m = it & 3;
            if (it + 1 < 8) MG_LOAD(it + 1, na, nb);
            asm volatile("" ::: "memory");
#pragma unroll
            for (int bj = 0; bj < 2; ++bj) { float s[8], ta[8], tb[8]; dec_fp8x8(wa[bj], ta); dec_fp8x8(wb[bj], tb);
#pragma unroll
                for (int i = 0; i < 4; ++i) { const float ea0 = __expf(-ta[2 * i]), ea1 = __expf(-ta[2 * i + 1]);
                    if (idx == 2) { s[2 * i] = __builtin_amdgcn_rcpf(1.f + ea0); s[2 * i + 1] = __builtin_amdgcn_rcpf(1.f + ea1); }
                    else { const float eb0 = __expf(-tb[2 * i]), eb1 = __expf(-tb[2 * i + 1]); s[2 * i] = (1.f + ea0) * __builtin_amdgcn_rcpf(1.f + eb0); s[2 * i + 1] = (1.f + ea1) * __builtin_amdgcn_rcpf(1.f + eb1); } }
                acc[ai][bj][m][0] = acc[ai][bj][m][0] * (f32x4){s[0], s[1], s[2], s[3]}; acc[ai][bj][m][1] = acc[ai][bj][m][1] * (f32x4){s[4], s[5], s[6], s[7]}; }
#pragma unroll
            for (int bj = 0; bj < 2; ++bj) { wa[bj] = na[bj]; wb[bj] = nb[bj]; } }
#undef MG_LOAD
    }
    __device__ __forceinline__ void mid(f32x4 (&acc)[2][2][4][2], const Unit& u, int idx, int wr, int wc, int fr, int fq) const { scale(acc, u, idx, wr, wc, fr, fq); }
    __device__ __forceinline__ void operator()(f32x4 (&acc)[2][2][4][2], const Unit& u, int wr, int wc, int fr, int fq) const {
        scale(acc, u, 2, wr, wc, fr, fq);
        asm volatile("" : "+v"(fr), "+v"(fq));
        const int row0 = u.pm * BM + wr * 64 + fr; const int col0 = u.pn * BM + wc * 32 + 8 * fq;
#pragma unroll
        for (int ai = 0; ai < 2; ++ai)
#pragma unroll
            for (int m = 0; m < 4; ++m) { bf16_t* rowp = O + (size_t)(row0 + ai * HALF + m * 16) * ldc + col0;
#pragma unroll
                for (int bj = 0; bj < 2; ++bj) { const f32x4 v0 = acc[ai][bj][m][0], v1 = acc[ai][bj][m][1];
                    u32x4 w; w.x = cvt_pk_bf16(v0[0], v0[1]); w.y = cvt_pk_bf16(v0[2], v0[3]); w.z = cvt_pk_bf16(v1[0], v1[1]); w.w = cvt_pk_bf16(v1[2], v1[3]);
                    *(u32x4*)(rowp + bj * HALF) = w; } }
    }
};
struct EpiSwiGLU {
    static constexpr bool PERM = true, AFTER_DRAIN = false, MIDK = false;
    bf16_t* O; const float* bias; int nN;
    __device__ __forceinline__ void operator()(const f32x4 (&acc)[2][2][4][2], const Unit& u, int wr, int wc, int fr, int fq) const {
        const int e = u.pn / nN, pl = u.pn - e * nN;
        asm volatile("" : "+v"(fr), "+v"(fq));
        const int row0 = u.pm * BM + wr * 64 + fr; const int colt = pl * BM + wc * 32 + 8 * fq;
        const float* bp = bias + (size_t)e * 2048 + colt;
        f32x4 bv[2][2];
#pragma unroll
        for (int bj = 0; bj < 2; ++bj) { bv[bj][0] = *(const f32x4*)(bp + bj * HALF); bv[bj][1] = *(const f32x4*)(bp + bj * HALF + 4); }
#pragma unroll
        for (int ai = 0; ai < 2; ++ai)
#pragma unroll
            for (int m = 0; m < 4; ++m) { unsigned char* rowp = (unsigned char*)O + (size_t)(row0 + ai * HALF + m * 16) * 1024 + (colt >> 1);
#pragma unroll
                for (int bj = 0; bj < 2; ++bj) { const f32x4 v0 = acc[ai][bj][m][0] + bv[bj][0], v1 = acc[ai][bj][m][1] + bv[bj][1];
                    float a[4];
                    const float gt[4] = {v0[0], v0[2], v1[0], v1[2]}, up[4] = {v0[1], v0[3], v1[1], v1[3]};
#pragma unroll
                    for (int i = 0; i < 4; ++i) { const float g = fminf(gt[i], 7.0f); const float uu = fminf(fmaxf(up[i], -7.0f), 7.0f);
                        a[i] = g * __builtin_amdgcn_rcpf(1.0f + __expf(-1.702f * g)) * (uu + 1.0f); }
                    int w8 = __builtin_amdgcn_cvt_pk_fp8_f32(a[0], a[1], 0, false); w8 = __builtin_amdgcn_cvt_pk_fp8_f32(a[2], a[3], w8, true);
                    *(unsigned*)(rowp + bj * (HALF / 2)) = (unsigned)w8; } }
    }
};
struct EpiDown {
    static constexpr bool PERM = true, AFTER_DRAIN = false, MIDK = false;
    bf16_t* O; const float* bias; const float* gate; int nN;
    __device__ __forceinline__ void operator()(const f32x4 (&acc)[2][2][4][2], const Unit& u, int wr, int wc, int fr, int fq) const {
        const int e = u.pn / nN, pl = u.pn - e * nN;
        asm volatile("" : "+v"(fr), "+v"(fq));
        const int row0 = u.pm * BM + wr * 64 + fr; const int colt = pl * BM + wc * 32 + 8 * fq;
        const float* bp = bias + (size_t)e * 1024 + colt;
        f32x4 bv[2][2];
#pragma unroll
        for (int bj = 0; bj < 2; ++bj) { bv[bj][0] = *(const f32x4*)(bp + bj * HALF); bv[bj][1] = *(const f32x4*)(bp + bj * HALF + 4); }
        float gs8[8];
#pragma unroll
        for (int it = 0; it < 8; ++it) gs8[it] = gate[row0 + (it >> 2) * HALF + (it & 3) * 16];
        asm volatile("s_waitcnt vmcnt(0)" ::: "memory");
#pragma unroll
        for (int ai = 0; ai < 2; ++ai)
#pragma unroll
            for (int m = 0; m < 4; ++m) { const int row = row0 + ai * HALF + m * 16; const float gs = gs8[ai * 4 + m]; bf16_t* rowp = O + (size_t)row * 1024 + colt;
#pragma unroll
                for (int bj = 0; bj < 2; ++bj) { const f32x4 v0 = (acc[ai][bj][m][0] + bv[bj][0]) * gs, v1 = (acc[ai][bj][m][1] + bv[bj][1]) * gs;
                    u32x4 w; w.x = cvt_pk_bf16(v0[0], v0[1]); w.y = cvt_pk_bf16(v0[2], v0[3]); w.z = cvt_pk_bf16(v1[0], v1[1]); w.w = cvt_pk_bf16(v1[2], v1[3]);
                    *(u32x4*)(rowp + bj * HALF) = w; } }
    }
};

template <class Epi, class Sched, bool ALIGN_EPI = false, bool SP2 = false, bool FP8 = false, int SCALE_B = 127>
__device__ __forceinline__ void gemm_phase(PG8_LAS unsigned char* lds, const Gemm g, const Sched& S, const Epi& E, int wv) {
    int tid_l = (int)__builtin_amdgcn_mbcnt_hi(~0u, __builtin_amdgcn_mbcnt_lo(~0u, 0u)); asm volatile("" : "+v"(tid_l)); tid_l += wv * 64;
    const int tid = tid_l, wid = __builtin_amdgcn_readfirstlane(tid >> 6), lane = tid & 63, wr = wid >> 2, wc = wid & 3, fr = lane & 15, fq = lane >> 4;
    const int K = g.K; const int KB = FP8 ? K : 2 * K;
    const int nt = KB / (2 * BK);
    unsigned voffA[2], voffB[2];
#pragma unroll
    for (int i = 0; i < 2; ++i) { int R, C; stage_rc(tid * 16 + i * 8192, R, C); const int Rb = Epi::PERM ? ((R & ~31) + perm32(R & 31)) : R;
        voffA[i] = (unsigned)(R * KB + 2 * C); voffB[i] = (unsigned)(Rb * KB + 2 * C); }
    unsigned voGc[2][2]; PG8_LAS unsigned* voGn_l = (PG8_LAS unsigned*)(lds + STAGE_BYTES + 1024) + tid;
#define PG8_GOFF(dst, pmv) do { if constexpr (Sched::GATHER) { _Pragma("unroll") for (int _h = 0; _h < 2; ++_h) _Pragma("unroll") for (int _i = 0; _i < 2; ++_i) { \
        const unsigned _R = voffA[_i] / (unsigned)KB, _cb = voffA[_i] % (unsigned)KB; dst[_h][_i] = (unsigned)S.tok[(pmv) * BM + _h * HALF + (int)_R] * (unsigned)KB + _cb; } } } while (0)
    const size_t kstep = (size_t)(BK * 2);
    const size_t hstep = (size_t)HALF * KB;
    const size_t tstep = 2 * hstep;
    const unsigned ldsw = (unsigned)wid * 1024u;
    const int aoff = lds_byte(wr * 64 + fr, FP8 ? fq * 16 : fq * 8), boff = lds_byte(wc * 32 + fr, FP8 ? fq * 16 : fq * 8);
    const int aoff1 = lds_byte(wr * 64 + fr, FP8 ? fq * 16 + 8 : fq * 8 + 32) - aoff, boff1 = lds_byte(wc * 32 + fr, FP8 ? fq * 16 + 8 : fq * 8 + 32) - boff;
#define PG8_SA(b, h) (((b) * 2 + (h)) * HTB)
#define PG8_SB(b, h) ((4 + (b) * 2 + (h)) * HTB)
#define PG8_STAGE(bufoff, gbase, voff) do { _Pragma("unroll") for (int _i = 0; _i < 2; ++_i) \
        __builtin_amdgcn_global_load_lds((const unsigned*)((const char*)(gbase) + (voff)[_i]), (PG8_LAS unsigned*)(lds + (bufoff) + ldsw + _i * 8192), 16, 0, 0); } while (0)
#define PG8_STAGE_A(bufoff, base, h, nx) do { if constexpr (Sched::GATHER) { unsigned _vo[2] = {voGc[h][0], voGc[h][1]}; if (nx) { _vo[0] = voGn_l[((h) * 2 + 0) * 512]; _vo[1] = voGn_l[((h) * 2 + 1) * 512]; } PG8_STAGE(bufoff, base, _vo); } else { PG8_STAGE(bufoff, (base) + (h) * hstep, voffA); } } while (0)
#define PG8_LD8(dst8, n_, base_, off_, off1_) do { _Pragma("unroll") for (int q_ = 0; q_ < n_; ++q_) { const v4i_ lo_ = *(const PG8_LAS v4i_*)(lds + (base_) + (off_) + q_ * 2048), hi_ = *(const PG8_LAS v4i_*)(lds + (base_) + (off_) + q_ * 2048 + (off1_)); \
        dst8[q_] = __builtin_shufflevector(lo_, hi_, 0, 1, 2, 3, 4, 5, 6, 7); } } while (0)
#define PG8_LDA(dst, b, h) do { if constexpr (FP8) { PG8_LD8(dst##8, 4, PG8_SA(b, h), aoff, aoff1); } else { _Pragma("unroll") for (int m = 0; m < 4; ++m) _Pragma("unroll") for (int k = 0; k < 2; ++k) dst[m][k] = *(const PG8_LAS bf16x8*)(lds + PG8_SA(b, h) + aoff + m * 2048 + k * aoff1); } } while (0)
#define PG8_LDB(dst, b, h) do { if constexpr (FP8) { PG8_LD8(dst##8, 2, PG8_SB(b, h), boff, boff1); } else { _Pragma("unroll") for (int n = 0; n < 2; ++n) _Pragma("unroll") for (int k = 0; k < 2; ++k) dst[n][k] = *(const PG8_LAS bf16x8*)(lds + PG8_SB(b, h) + boff + n * 2048 + k * boff1); } } while (0)
#define PG8_MMA(ai, bj, At, Bt) do { if constexpr (FP8) __builtin_amdgcn_sched_barrier(0); __builtin_amdgcn_s_setprio(1); _Pragma("unroll") for (int m = 0; m < 4; ++m) _Pragma("unroll") for (int n = 0; n < 2; ++n) { \
        if constexpr (FP8) { asm volatile("v_mfma_scale_f32_16x16x128_f8f6f4 %0, %1, %2, %0, %3, %4 op_sel_hi:[0,0,0]" : "+v"(acc[ai][bj][m][n]) : "v"(Bt##8[n]), "v"(At##8[m]), "v"(sclB), "v"(sclA)); } \
        else { _Pragma("unroll") for (int k = 0; k < 2; ++k) acc[ai][bj][m][n] = __builtin_amdgcn_mfma_f32_16x16x32_bf16(Bt[n][k], At[m][k], acc[ai][bj][m][n], 0, 0, 0); } } \
        __builtin_amdgcn_s_setprio(0); if constexpr (FP8) __builtin_amdgcn_sched_barrier(0); } while (0)
#define PG8_WAIT_V(n) asm volatile("s_waitcnt vmcnt(" #n ")" ::: "memory")
#define PG8_WAIT_L(n) asm volatile("s_waitcnt lgkmcnt(" #n ")" ::: "memory")
#define PG8_BAR __builtin_amdgcn_s_barrier()
#define PG8_SCHED __builtin_amdgcn_sched_barrier(0)
    Unit cur, nxt; int ui = 0;
    if (!S.next(0, cur)) return;
    f32x4 acc[2][2][4][2];
#pragma unroll
    for (int a = 0; a < 2; ++a)
#pragma unroll
        for (int b = 0; b < 2; ++b)
#pragma unroll
            for (int m = 0; m < 4; ++m)
#pragma unroll
                for (int n = 0; n < 2; ++n) acc[a][b][m][n] = (f32x4){0.f, 0.f, 0.f, 0.f};
    bf16x8 At[4][2], B0[2][2], B1[2][2];
    typedef int v8i_ __attribute__((ext_vector_type(8))); typedef int v4i_ __attribute__((ext_vector_type(4)));
    int sclB = SCALE_B * 0x01010101, sclA = 0x7f7f7f7f; asm volatile("" : "+v"(sclB), "+v"(sclA));
    v8i_ At8[4], B08[2], B18[2];
    const char* cA = (const char*)g.A + (Sched::GATHER ? (size_t)0 : (size_t)cur.pm * tstep); const char* cB = (const char*)g.Bt + (size_t)cur.pn * tstep;
    PG8_GOFF(voGc, cur.pm);
    S.a_ready(cur);
    if constexpr (SP2) {
        PG8_STAGE(PG8_SB(0, 0), cB, voffB); PG8_STAGE(PG8_SB(0, 1), cB + hstep, voffB); PG8_STAGE_A(PG8_SA(0, 0), cA, 0, false); PG8_STAGE_A(PG8_SA(0, 1), cA, 1, false);
        if (wr == 1) PG8_BAR;
        PG8_WAIT_V(2); PG8_BAR;
        PG8_STAGE(PG8_SB(1, 0), cB + kstep, voffB); PG8_STAGE_A(PG8_SA(1, 0), cA + kstep, 0, false); PG8_STAGE(PG8_SB(1, 1), cB + hstep + kstep, voffB);
        if constexpr (FP8 && !Sched::GATHER) PG8_WAIT_V(0); else PG8_WAIT_V(6);
        PG8_BAR;
    } else {
        PG8_STAGE(PG8_SB(0, 0), cB, voffB); PG8_STAGE_A(PG8_SA(0, 0), cA, 0, false); PG8_STAGE(PG8_SB(0, 1), cB + hstep, voffB); PG8_STAGE_A(PG8_SA(0, 1), cA, 1, false);
        if (wr == 1) PG8_BAR;
        PG8_WAIT_V(4); PG8_BAR;
        PG8_STAGE(PG8_SB(1, 0), cB + kstep, voffB); PG8_STAGE_A(PG8_SA(1, 0), cA + kstep, 0, false); PG8_STAGE(PG8_SB(1, 1), cB + hstep + kstep, voffB);
        PG8_WAIT_V(6); PG8_BAR;
    }
    for (;;) {
        const bool has_next = S.next(ui + 1, nxt);
        const char* nA = has_next ? (const char*)g.A + (Sched::GATHER ? (size_t)0 : (size_t)nxt.pm * tstep) : cA;
        if constexpr (Sched::GATHER) { unsigned _vn[2][2]; if (has_next) { PG8_GOFF(_vn, nxt.pm); } else { _Pragma("unroll") for (int _h = 0; _h < 2; ++_h) _Pragma("unroll") for (int _i = 0; _i < 2; ++_i) _vn[_h][_i] = voGc[_h][_i]; }
            _Pragma("unroll") for (int _h = 0; _h < 2; ++_h) _Pragma("unroll") for (int _i = 0; _i < 2; ++_i) voGn_l[(_h * 2 + _i) * 512] = _vn[_h][_i]; } const char* nB = has_next ? (const char*)g.Bt + (size_t)nxt.pn * tstep : cB;
        static_assert(SP2, "K-loop: super-phase form only");
#define PG8_KBODY(W1) do { \
            PG8_LDB(B0, 0, 0); PG8_LDB(B1, 0, 1); PG8_SCHED; PG8_LDA(At, 0, 0); PG8_STAGE_A(PG8_SA(1, 1), a1, 1, false); \
            PG8_WAIT_V(W1); PG8_WAIT_L(0); PG8_BAR; PG8_MMA(0, 0, At, B0); PG8_MMA(0, 1, At, B1); PG8_BAR; PG8_SCHED; \
            PG8_LDA(At, 0, 1); PG8_STAGE(PG8_SB(0, 0), b2, voffB); PG8_STAGE(PG8_SB(0, 1), b2 + hstep, voffB); PG8_STAGE_A(PG8_SA(0, 0), a2, 0, last); \
            PG8_WAIT_V(W1); PG8_WAIT_L(0); PG8_BAR; PG8_MMA(1, 0, At, B0); PG8_MMA(1, 1, At, B1); PG8_BAR; PG8_SCHED; \
            PG8_LDB(B0, 1, 0); PG8_LDB(B1, 1, 1); PG8_SCHED; PG8_LDA(At, 1, 0); PG8_STAGE_A(PG8_SA(0, 1), a2, 1, last); \
            PG8_WAIT_V(8); PG8_WAIT_L(0); PG8_BAR; PG8_MMA(0, 0, At, B0); PG8_MMA(0, 1, At, B1); PG8_BAR; PG8_SCHED; \
            PG8_LDA(At, 1, 1); PG8_STAGE(PG8_SB(1, 0), b3, voffB); PG8_STAGE(PG8_SB(1, 1), b3 + hstep, voffB); PG8_STAGE_A(PG8_SA(1, 0), a3, 0, last); \
            PG8_WAIT_V(8); PG8_WAIT_L(0); PG8_BAR; PG8_MMA(1, 0, At, B0); PG8_MMA(1, 1, At, B1); PG8_BAR; PG8_SCHED;; } while (0)
#define PG8_KPTRS(t) const bool last = ((t) == nt - 2); const char* a1 = cA + (size_t)((t) + 1) * kstep; \
            const char* a2 = last ? nA : cA + (size_t)((t) + 2) * kstep; const char* b2 = last ? nB : cB + (size_t)((t) + 2) * kstep; \
            const char* a3 = a2 + kstep; const char* b3 = b2 + kstep; \
            if (last && has_next) S.a_ready(nxt);
        constexpr bool PEEL = FP8 && !Sched::GATHER;
        if constexpr (PEEL) { PG8_KPTRS(0); PG8_KBODY(24); }
        for (int t = PEEL ? 2 : 0; t < nt; t += 2) {
            PG8_KPTRS(t);
            PG8_KBODY(8);
            if constexpr (Epi::MIDK) { if (((t + 2) & 7) == 0 && t + 2 < nt) E.mid(acc, cur, ((t + 2) >> 3) - 1, wr, wc, fr, fq); }
        }
#undef PG8_KBODY
#undef PG8_KPTRS
        if constexpr (FP8) asm volatile("s_nop 15\n\ts_nop 15" ::: "memory");
        if constexpr (ALIGN_EPI) { if (wr == 0) PG8_BAR; }
        if constexpr (!Epi::AFTER_DRAIN) { E(acc, cur, wr, wc, fr, fq); S.done(cur); }
        if (!has_next) break;
#pragma unroll
        for (int a = 0; a < 2; ++a)
#pragma unroll
            for (int b = 0; b < 2; ++b)
#pragma unroll
                for (int m = 0; m < 4; ++m)
#pragma unroll
                    for (int n = 0; n < 2; ++n) acc[a][b][m][n] = (f32x4){0.f, 0.f, 0.f, 0.f};
        cur = nxt; cA = nA; cB = nB; ++ui;
        if constexpr (Sched::GATHER) { _Pragma("unroll") for (int _h = 0; _h < 2; ++_h) _Pragma("unroll") for (int _i = 0; _i < 2; ++_i) voGc[_h][_i] = voGn_l[(_h * 2 + _i) * 512]; }
        if constexpr (ALIGN_EPI) { if (wr == 1) PG8_BAR; }
    }
    PG8_WAIT_V(0);
    if constexpr (!ALIGN_EPI) { if (wr == 0) PG8_BAR; }
    PG8_BAR;
#undef PG8_SA
#undef PG8_SB
#undef PG8_STAGE
#undef PG8_STAGE_A
#undef PG8_GOFF
#undef PG8_LDA
#undef PG8_LD8
#undef PG8_LDB
#undef PG8_MMA
#undef PG8_WAIT_V
#undef PG8_WAIT_L
#undef PG8_BAR
#undef PG8_SCHED
}
}
constexpr int BATCH = 4, SEQ = 8192, DM = 1024, NTOK = BATCH * SEQ, DEPTH = 2, NEXP = 32;
constexpr int D_IN = 8524, ZP = 8704;
constexpr int Z_AQ = 0, Z_AK = 512, Z_AV = 1024, Z_FQ = 1536, Z_FK = 2048, Z_FV = 2560, Z_CQ = 3072, Z_CF = 3584, Z_CI = 4096, Z_CG = 4608, Z_GT = 5120, Z_IQ = 8192, Z_IK = 8448, Z_IW = 8512, Z_FF = 8516;
constexpr int OP = 1536;
constexpr int MAXBLK = 544, MAXSLOT = MAXBLK * 256;
constexpr int BST_OFF = 16 + MAXBLK + 16;
constexpr float LOG2E = 1.4426950408889634f;
constexpr float QSCALE = 0.125f * LOG2E;
constexpr float ALPHA = 1.4142135623730951f;
constexpr float LN_EPS = 1e-5f, RMS_EPS = 1e-6f;
constexpr int NWAVES = 8, NTHR = 512;
constexpr float W8_SCALE = 64.0f; constexpr int W8_E8M0 = 127 - 6;
constexpr int NPH_LAYER = 14, NPHASES = 1 + DEPTH * NPH_LAYER;
enum { PH_INPROJ = 0, PH_PREP, PH_IDX, PH_ATTN, PH_H1, PH_H2, PH_H3, PH_MERGE, PH_WOUT, PH_LN1, PH_SLOT, PH_GU, PH_DOWN, PH_COMB };

__host__ __device__ __forceinline__ int zcol_src(int n) {
    if (n < 1024 || (n >= 8192 && n < 8512)) { const int p = n & 63; n = (n & ~63) + ((p & 1) ? 32 + (p >> 1) : (p >> 1)); }
    if (n < 1536) return n;
    if (n < 3072) return 1860 + (n - 1536);
    if (n < 5120) return 3404 + (n - 3072);
    if (n < 8192) return 5452 + (n - 5120);
    if (n < 8448) return 1536 + (n - 8192);
    if (n < 8512) return 1792 + (n - 8448);
    if (n < 8516) return 1856 + (n - 8512);
    if (n < 8524) return 3396 + (n - 8516);
    return -1;
}

constexpr size_t MiB = 1u << 20;
constexpr size_t WS_CTL = 0, CTL_ZERO_BYTES = 1 * MiB;
constexpr size_t WS_TRIG = 1 * MiB;
constexpr size_t WS_LFT = 3 * MiB;
constexpr size_t WS_CT = 4 * MiB;
constexpr size_t WS_DG = 5 * MiB, WS_D2G = 6 * MiB;
constexpr size_t WS_WGCNT = 7 * MiB;
constexpr size_t WS_BLK = 7 * MiB + 64 * 1024;
constexpr size_t WS_BGU = 7 * MiB + 128 * 1024;
constexpr size_t WS_TKE = 8 * MiB, WS_TKG = 8 * MiB + 512 * 1024, WS_TOKSLOT = 9 * MiB, WS_GSLOT = 9 * MiB + 512 * 1024;
constexpr size_t WS_SLOTTOK = 10 * MiB + 512 * 1024;
constexpr size_t WS_WRF = 11 * MiB;
constexpr size_t WS_WIN = 12 * MiB;
constexpr size_t WS_WP = 46 * MiB;
constexpr size_t WS_WOUT = 52 * MiB;
constexpr size_t WS_WGU = 56 * MiB;
constexpr size_t WS_WDN = 312 * MiB;
constexpr size_t WS_Z = 440 * MiB;
constexpr size_t WS_XG = WS_Z, WS_ACT = WS_Z + 272 * MiB;
constexpr size_t WS_OBUF = 984 * MiB;
constexpr size_t WS_MERGED = 1080 * MiB;
constexpr size_t WS_MIX = 1144 * MiB;
constexpr size_t WS_Y = WS_OBUF;
constexpr size_t WS_X1 = 1272 * MiB;
constexpr size_t WS_X1B = 1400 * MiB;
constexpr size_t WS_XCUR = 1464 * MiB;
constexpr size_t WS_XB = 1592 * MiB;
constexpr size_t WS_MASKW = 1656 * MiB;
constexpr size_t WS_UG = 1688 * MiB;
constexpr size_t WS_SST = 1752 * MiB;
constexpr size_t WS_SB = 7 * MiB + 768 * 1024;
constexpr size_t WS_KA = 1784 * MiB;
constexpr size_t WS_XB8 = 192 * MiB;
constexpr size_t WS_IKC = 184 * MiB;
constexpr size_t WS_END = 1792 * MiB;
static_assert(WS_Y + (size_t)MAXSLOT * 1024 * 2 <= WS_X1 && WS_ACT + (size_t)MAXSLOT * 1024 * 2 <= WS_OBUF, "ws map");
constexpr int CW_TMO = 0;
constexpr int CW_BAR = 4096;
constexpr int CW_HQ = 1024;
constexpr int CW_SB = 512;

constexpr int SCR_BYTES = 153600;
constexpr int MISC_OFF = SCR_BYTES;
constexpr int LDS_BYTES = SCR_BYTES + 256;

#define RLX_AGENT __ATOMIC_RELAXED, __HIP_MEMORY_SCOPE_AGENT
#define LDS_WAIT() asm volatile("s_waitcnt lgkmcnt(0)" ::: "memory")
#define VM_WAIT() asm volatile("s_waitcnt vmcnt(0)" ::: "memory")
#define WG_BAR() asm volatile("s_waitcnt vmcnt(0) lgkmcnt(0)\n\ts_barrier" ::: "memory")
#define WG_BAR_LDS() asm volatile("s_waitcnt lgkmcnt(0)\n\ts_barrier" ::: "memory")

#define XB_TMO      128
#define XB_XCNT(j)  (256  + 64 * (j))
#define XB_XSUB(j)  (1280 + 64 * (j))
#define XB_XGEN(j)  (2304 + 64 * (j))
#define XB_TOP      3328
#define XB_TOPGEN   3392
#define XCD_BAR_WORDS 3456
#define XB_SPIN_CAP (1u << 18)

__device__ __forceinline__ unsigned xb_ld(unsigned* p)              { return __hip_atomic_load(p, __ATOMIC_RELAXED, __HIP_MEMORY_SCOPE_AGENT); }
__device__ __forceinline__ unsigned xb_add(unsigned* p, unsigned v) { return __hip_atomic_fetch_add(p, v, __ATOMIC_RELAXED, __HIP_MEMORY_SCOPE_AGENT); }
__device__ __forceinline__ unsigned xb_xcc_id() { return (unsigned)__builtin_amdgcn_s_getreg((3 << 11) | 20) & 0xFu; }
#define XB_SPIN(cond, bar) do { unsigned _sp = 0; while (cond) { __builtin_amdgcn_s_sleep(1); \
    if ((++_sp & 255u) == 0u) { if (xb_ld(&(bar)[XB_TMO])) break; if (_sp > XB_SPIN_CAP) { atomicAdd(&(bar)[XB_TMO], 1u); break; } } } } while (0)

struct XcdBarrier {
    unsigned* bar; unsigned x;
    volatile LAS unsigned* st;
};

__device__ __forceinline__ XcdBarrier xcd_barrier_post(unsigned* bar, volatile LAS unsigned* st) {
    XcdBarrier b; b.bar = bar; b.x = xb_xcc_id(); b.st = st;
    if (threadIdx.x == 0) (void)xb_add(&bar[XB_XCNT(b.x)], 1u);
    return b;
}
__device__ __forceinline__ void xcd_barrier_complete(unsigned* bar, unsigned x, unsigned& nloc, unsigned& nx) {
    const unsigned G = gridDim.x * gridDim.y * gridDim.z;
    unsigned sum, cnt, mine, sp = 0u;
    for (;;) {
        sum = 0u; cnt = 0u; mine = 0u;
#pragma unroll
        for (unsigned j = 0; j < 16; ++j) { const unsigned c = xb_ld(&bar[XB_XCNT(j)]); sum += c; cnt += (c > 0u) ? 1u : 0u; mine = (j == x) ? c : mine; }
        if (sum == G) break;
        __builtin_amdgcn_s_sleep(1);
        if ((++sp & 255u) == 0u) { if (xb_ld(&bar[XB_TMO])) break; if (sp > XB_SPIN_CAP) { atomicAdd(&bar[XB_TMO], 1u); break; } }
    }
    nloc = mine > 0u ? mine : 1u; nx = cnt > 0u ? cnt : 1u;
}

__device__ __forceinline__ void xcd_barrier(const XcdBarrier& b) {
    asm volatile("s_waitcnt vmcnt(0)" ::: "memory");
    __syncthreads();
    if (threadIdx.x == 0) {
        unsigned* bar = b.bar;
        __builtin_amdgcn_s_waitcnt(0);
        unsigned nloc = b.st[0], nx = b.st[1];
        if (nloc == 0u) { xcd_barrier_complete(bar, b.x, nloc, nx); b.st[0] = nloc; b.st[1] = nx; }
        const unsigned old = xb_add(&bar[XB_XSUB(b.x)], 1u);
        const unsigned gen = old / nloc;
        if (old + 1u == (gen + 1u) * nloc) {
            __builtin_amdgcn_fence(__ATOMIC_RELEASE, "agent");
            asm volatile("s_waitcnt vmcnt(0)" ::: "memory");
            const unsigned og = xb_add(&bar[XB_TOP], 1u);
            const unsigned tg = og / nx;
            if (og + 1u == (tg + 1u) * nx) xb_add(&bar[XB_TOPGEN], 1u);
            else XB_SPIN(xb_ld(&bar[XB_TOPGEN]) == tg, bar);
            __builtin_amdgcn_fence(__ATOMIC_ACQUIRE, "agent");
            xb_add(&bar[XB_XGEN(b.x)], 1u);
            asm volatile("s_waitcnt vmcnt(0)" ::: "memory");
        } else {
            XB_SPIN(xb_ld(&bar[XB_XGEN(b.x)]) == gen, bar);
            __builtin_amdgcn_fence(__ATOMIC_ACQUIRE, "agent");
            asm volatile("s_waitcnt vmcnt(0)" ::: "memory");
        }
    }
    __syncthreads();
}
__device__ __forceinline__ int lane_id() { int l = (int)__builtin_amdgcn_mbcnt_hi(~0u, __builtin_amdgcn_mbcnt_lo(~0u, 0u)); asm volatile("" : "+v"(l)); return l; }
__device__ __forceinline__ float wave_sum(float v) {
#pragma unroll
    for (int o = 1; o < 64; o <<= 1) v += __shfl_xor(v, o);
    return v;
}
__device__ __forceinline__ int crow(int r, int hi) { return (r & 3) + 8 * (r >> 2) + 4 * hi; }
__device__ __forceinline__ void glds16(const void* gsrc, unsigned lds_dst) {
    __builtin_amdgcn_global_load_lds((const unsigned*)gsrc, (LAS unsigned*)(uintptr_t)lds_dst, 16, 0, 0); }
__device__ __forceinline__ void glds4(const void* gsrc, unsigned lds_dst) {
    __builtin_amdgcn_global_load_lds((const unsigned*)gsrc, (LAS unsigned*)(uintptr_t)lds_dst, 4, 0, 0); }
typedef __bf16 bf16x2_t __attribute__((ext_vector_type(2)));
__device__ __forceinline__ unsigned cvtpk(float lo, float hi) { const f32x2 v = {lo, hi}; const bf16x2_t b = __builtin_convertvector(v, bf16x2_t); return __builtin_bit_cast(unsigned, b); }
typedef short v4i16_t __attribute__((ext_vector_type(4)));
__device__ __forceinline__ s16x4 vtr(const LAS char* p) { return __builtin_bit_cast(s16x4, __builtin_amdgcn_ds_read_tr16_b64_v4i16((LAS v4i16_t*)p)); }
__device__ __forceinline__ void plswap(float& a, float& b) { asm volatile("s_nop 1\n\tv_permlane32_swap_b32 %0, %1\n\ts_nop 1" : "+v"(a), "+v"(b)); }
__device__ __forceinline__ float swapmax(float m) { float a = m, b = m; plswap(a, b); return fmaxf(a, b); }
__device__ __forceinline__ float swapsum(float m) { float a = m, b = m; plswap(a, b); return a + b; }
#define MFMA32(a, b, c) __builtin_amdgcn_mfma_f32_32x32x16_bf16((a), (b), (c), 0, 0, 0)

struct Params {
    const float* x; const float* w_in; const float* b_fox; const float* lb_logits; const float* norm_g; const float* w_pa; const float* w_pb; const float* w_pc; const float* w_out;
    const float* ln1_g; const float* ln1_b; const float* w_router; const float* b_router; const float* w_gu; const float* b_gu; const float* w_down; const float* b_down; const float* ln2_g; const float* ln2_b;
    float* out; unsigned char* ws; int ph_lo, ph_hi, use_bar, pad;
};

typedef const __attribute__((address_space(4))) Params* KP;
__device__ __forceinline__ KP load_params() { KP kp = (KP)__builtin_amdgcn_kernarg_segment_ptr(); asm volatile("" : "+s"(kp)); return kp; }

template <class F> __device__ __forceinline__ void cvt_tile(const float* W, size_t ldsrc, int k0, bf16* WT, size_t ldw, int kd0, int n0, const F& f, LAS float* scr, int lane) {
    const int c = lane & 31; int sc; float scale; f(n0 + c, sc, scale);
#pragma unroll 8
    for (int i = 0; i < 32; ++i) { const int kk = 2 * i + (lane >> 5); scr[kk * 33 + c] = sc >= 0 ? W[(size_t)(k0 + kk) * ldsrc + sc] * scale : 0.f; }
    LDS_WAIT(); asm volatile("" ::: "memory");
    const int ch = lane & 7;
#pragma unroll
    for (int j = 0; j < 4; ++j) { const int n = (lane >> 3) + 8 * j; const LAS float* s = scr + (8 * ch) * 33 + n;
        u32x4 o; o.x = pk2(s[0 * 33], s[1 * 33]); o.y = pk2(s[2 * 33], s[3 * 33]); o.z = pk2(s[4 * 33], s[5 * 33]); o.w = pk2(s[6 * 33], s[7 * 33]);
        *(u32x4*)(WT + (size_t)(n0 + n) * ldw + kd0 + 8 * ch) = o; }
    LDS_WAIT(); asm volatile("" ::: "memory");
}
template <class F> __device__ __forceinline__ void cvt_tile8(const float* W, size_t ldsrc, int k0, unsigned char* WT, size_t ldw, int n0, const F& f, float wscale, LAS float* scr, int lane) {
    const int c = lane & 31; int sc; float scale; f(n0 + c, sc, scale); scale *= wscale;
#pragma unroll 8
    for (int i = 0; i < 32; ++i) { const int kk = 2 * i + (lane >> 5); scr[kk * 33 + c] = sc >= 0 ? W[(size_t)(k0 + kk) * ldsrc + sc] * scale : 0.f; }
    LDS_WAIT(); asm volatile("" ::: "memory");
    const int ch = lane & 7;
#pragma unroll
    for (int j = 0; j < 4; ++j) { const int n = (lane >> 3) + 8 * j; const LAS float* s = scr + (8 * ch) * 33 + n;
        int w0 = __builtin_amdgcn_cvt_pk_fp8_f32(s[0 * 33], s[1 * 33], 0, false); w0 = __builtin_amdgcn_cvt_pk_fp8_f32(s[2 * 33], s[3 * 33], w0, true);
        int w1 = __builtin_amdgcn_cvt_pk_fp8_f32(s[4 * 33], s[5 * 33], 0, false); w1 = __builtin_amdgcn_cvt_pk_fp8_f32(s[6 * 33], s[7 * 33], w1, true);
        *(u32x2*)(WT + (size_t)(n0 + n) * ldw + k0 + 8 * ch) = (u32x2){(unsigned)w0, (unsigned)w1}; }
    LDS_WAIT(); asm volatile("" ::: "memory");
}
template <class F> __device__ __forceinline__ void cvt_tile8w(const float* W, size_t ldsrc, int k0, unsigned char* WT, size_t ldw, int n0, const F& f, float wscale, LAS float* scr, int lane) {
    const int c = lane & 31; int sc; float scale; f(n0 + c, sc, scale); scale *= wscale;
#pragma unroll 16
    for (int i = 0; i < 64; ++i) { const int kk = 2 * i + (lane >> 5); scr[kk * 33 + c] = sc >= 0 ? W[(size_t)(k0 + kk) * ldsrc + sc] * scale : 0.f; }
    LDS_WAIT(); asm volatile("" ::: "memory");
    const int ch = lane & 15;
#pragma unroll
    for (int j = 0; j < 8; ++j) { const int n = (lane >> 4) + 4 * j; const LAS float* s = scr + (8 * ch) * 33 + n;
        int w0 = __builtin_amdgcn_cvt_pk_fp8_f32(s[0 * 33], s[1 * 33], 0, false); w0 = __builtin_amdgcn_cvt_pk_fp8_f32(s[2 * 33], s[3 * 33], w0, true);
        int w1 = __builtin_amdgcn_cvt_pk_fp8_f32(s[4 * 33], s[5 * 33], 0, false); w1 = __builtin_amdgcn_cvt_pk_fp8_f32(s[6 * 33], s[7 * 33], w1, true);
        *(u32x2*)(WT + (size_t)(n0 + n) * ldw + k0 + 8 * ch) = (u32x2){(unsigned)w0, (unsigned)w1}; }
    LDS_WAIT(); asm volatile("" ::: "memory");
}
struct Tile8 { const float* W; size_t ldsrc; int k0; unsigned char* WT; int n0; int sc; float scale; };
__device__ __forceinline__ void tile8_load(const Tile8& t, float (&r)[64], int lane) {
#pragma unroll
    for (int i = 0; i < 64; ++i) r[i] = t.sc >= 0 ? t.W[(size_t)(t.k0 + 2 * i + (lane >> 5)) * t.ldsrc + t.sc] : 0.f;
}
__device__ __forceinline__ void tile8_finish(const Tile8& t, const float (&r)[64], LAS float* scr, int lane) {
    const int c = lane & 31;
#pragma unroll
    for (int i = 0; i < 64; ++i) scr[(2 * i + (lane >> 5)) * 33 + c] = r[i] * t.scale;
    LDS_WAIT(); asm volatile("" ::: "memory");
    const int ch = lane & 15;
#pragma unroll
    for (int j = 0; j < 8; ++j) { const int n = (lane >> 4) + 4 * j; const LAS float* s = scr + (8 * ch) * 33 + n;
        int w0 = __builtin_amdgcn_cvt_pk_fp8_f32(s[0 * 33], s[1 * 33], 0, false); w0 = __builtin_amdgcn_cvt_pk_fp8_f32(s[2 * 33], s[3 * 33], w0, true);
        int w1 = __builtin_amdgcn_cvt_pk_fp8_f32(s[4 * 33], s[5 * 33], 0, false); w1 = __builtin_amdgcn_cvt_pk_fp8_f32(s[6 * 33], s[7 * 33], w1, true);
        *(u32x2*)(t.WT + (size_t)(t.n0 + n) * 1024 + t.k0 + 8 * ch) = (u32x2){(unsigned)w0, (unsigned)w1}; }
    LDS_WAIT(); asm volatile("" ::: "memory");
}
struct MapIn { __device__ __forceinline__ void operator()(int n, int& sc, float& s) const { sc = zcol_src(n); s = (n < 512 || (n >= Z_FQ && n < Z_FK)) ? QSCALE : 1.0f; } };
struct MapGu { __device__ __forceinline__ void operator()(int n, int& sc, float& s) const { sc = (n & 1) ? 1024 + (n >> 1) : (n >> 1); s = 1.0f; } };
struct MapId { __device__ __forceinline__ void operator()(int n, int& sc, float& s) const { sc = n; s = 1.0f; } };

__device__ __forceinline__ void p0_prologue(KP p, LAS unsigned char* lds, int gw, int NGW, int wave, int lane) {
    LAS float* scr = (LAS float*)(lds + wave * 17408);
    unsigned char* ws = p->ws;
    constexpr int I_IN = 8 * 272, I_GU = 32 * 8 * 64, I_DN = 32 * 8 * 32, I_P = 3 * 8 * 32, I_OUT = 16 * 32, I_F8 = I_IN + I_GU + I_DN, I_B16 = I_P + I_OUT;
    { auto decode = [&](int it, Tile8& t) { const int l = it / I_F8; int r = it - l * I_F8; const int c = lane & 31; float scale = 1.0f; int sc;
          if (r < I_IN) { const int kb = r / 272, nb = r % 272; t.W = p->w_in + (size_t)l * 1024 * D_IN; t.ldsrc = D_IN; t.k0 = 128 * kb; t.WT = (unsigned char*)(ws + WS_WIN) + (size_t)l * ZP * 1024; t.n0 = 32 * nb; MapIn{}(t.n0 + c, sc, scale); }
          else if ((r -= I_IN) < I_GU) { const int e = r >> 9, r2 = r & 511, kb = r2 >> 6, nb = r2 & 63; t.W = p->w_gu + (size_t)(l * 32 + e) * 1024 * 2048; t.ldsrc = 2048; t.k0 = 128 * kb; t.WT = (unsigned char*)(ws + WS_WGU) + (size_t)(l * 32 + e) * 2048 * 1024; t.n0 = 32 * nb; MapGu{}(t.n0 + c, sc, scale); }
          else { r -= I_GU; const int e = r >> 8, r2 = r & 255, kb = r2 >> 5, nb = r2 & 31; t.W = p->w_down + (size_t)(l * 32 + e) * 1024 * 1024; t.ldsrc = 1024; t.k0 = 128 * kb; t.WT = (unsigned char*)(ws + WS_WDN) + (size_t)(l * 32 + e) * 1024 * 1024; t.n0 = 32 * nb; sc = t.n0 + c; }
          t.sc = sc; t.scale = scale * W8_SCALE; };
      Tile8 tc, tn; float rc[64], rn[64];
      if (gw < DEPTH * I_F8) { decode(gw, tc); tile8_load(tc, rc, lane); }
      for (int it = gw; it < DEPTH * I_F8; it += NGW) {
          const bool more = it + NGW < DEPTH * I_F8;
          if (more) { decode(it + NGW, tn); tile8_load(tn, rn, lane); }
          tile8_finish(tc, rc, scr, lane);
          if (more) { tc = tn;
#pragma unroll
              for (int i = 0; i < 64; ++i) rc[i] = rn[i]; } } }
    for (int it = gw; it < DEPTH * I_B16; it += NGW) {
        const int l = it / I_B16; int r = it - l * I_B16;
        if (r < I_P) { const int br = r >> 8, r2 = r & 255, kb = r2 >> 5, nb = r2 & 31; const float* W = (br == 0 ? p->w_pa : br == 1 ? p->w_pb : p->w_pc) + (size_t)l * 512 * 1024;
            cvt_tile(W, 1024, 64 * kb, (bf16*)(ws + WS_WP) + (size_t)l * 1024 * 1536, 1536, br * 512 + 64 * kb, 32 * nb, MapId{}, scr, lane); continue; } r -= I_P;
        { const int kb = r >> 5, nb = r & 31;
            cvt_tile(p->w_out + (size_t)l * 1024 * 1024, 1024, 64 * kb, (bf16*)(ws + WS_WOUT) + (size_t)l * 1024 * 1024, 1024, 64 * kb, 32 * nb, MapId{}, scr, lane); }
    }
    { float* bg = (float*)(ws + WS_BGU);
      for (int i = gw * 64 + lane; i < DEPTH * 32 * 2048; i += NGW * 64) { const int n = i & 2047, le = i >> 11; bg[i] = p->b_gu[(size_t)le * 2048 + ((n & 1) ? 1024 + (n >> 1) : (n >> 1))]; } }
    { bf16* wf = (bf16*)(ws + WS_WRF);
      for (int i = gw * 64 + lane; i < DEPTH * 32 * 2 * 64 * 8; i += NGW * 64) { const int ii = i & 7, ln = (i >> 3) & 63, nt = (i >> 9) & 1, s = (i >> 10) & 31, l = i >> 15;
          const int k = 32 * s + 8 * (ln >> 4) + ii, e = 16 * nt + (ln & 15); const float w = p->w_router[((size_t)l * 1024 + k) * 32 + e];
          const unsigned hb = f2bf(w); const float lo = w - bf2f(hb);
          const size_t base = ((((size_t)l * 32 + s) * 2 + nt) * 2) * 512 + ln * 8 + ii; wf[base] = (bf16)hb; wf[base + 512] = (bf16)f2bf(lo); } }
    { f32x2* tg = (f32x2*)(ws + WS_TRIG);
      for (int i = gw * 64 + lane; i < SEQ * 32; i += NGW * 64) { const int pos = i >> 5, k = i & 31;
          const float inv = exp2f(-(float)k * (13.287712379549449f / 32.0f)); const float ang = (float)pos * inv;
          const double rev = (double)ang * 0.15915494309189535; const float fr = (float)(rev - __builtin_rint(rev));
          tg[i] = (f32x2){__builtin_amdgcn_cosf(fr), __builtin_amdgcn_sinf(fr)}; } }
    { for (int m = gw; m < NTOK; m += NGW) { const f32x4* xr = (const f32x4*)(p->x + (size_t)m * DM) + lane;
#pragma unroll
          for (int j = 0; j < 4; ++j) { const f32x4 v = xr[64 * j];
              int w8 = __builtin_amdgcn_cvt_pk_fp8_f32(v.x, v.y, 0, false); w8 = __builtin_amdgcn_cvt_pk_fp8_f32(v.z, v.w, w8, true); ((unsigned*)(ws + WS_XB8 + (size_t)m * DM))[lane + 64 * j] = (unsigned)w8; } } }
}

__device__ __forceinline__ void prep_phase(KP p, int l, int gw, int NGW, int lane) {
    unsigned char* ws = p->ws; bf16* Z = (bf16*)(ws + WS_Z); const f32x2* tg = (const f32x2*)(ws + WS_TRIG); float* lfT = (float*)(ws + WS_LFT);
    const float bf_l = (lane < 8) ? p->b_fox[l * 8 + lane] : 0.f;
    for (int m = gw; m < NTOK; m += NGW) {
        bf16* zr = Z + (size_t)m * ZP; const int pos = m & (SEQ - 1), b = m >> 13;
        const f32x2 cs = tg[pos * 32 + (lane & 31)];
        unsigned short ta[11], tb[11];
#pragma unroll
        for (int it = 0; it < 11; ++it) { const int hh = 2 * it + (lane >> 5); const int hc = hh < 21 ? hh : 20;
            const int col = hc < 8 ? Z_AQ + hc * 64 : hc < 16 ? Z_AK + (hc - 8) * 64 : hc < 20 ? Z_IQ + (hc - 16) * 64 : Z_IK;
            const bf16* q = zr + col + (lane & 31); ta[it] = q[0]; tb[it] = q[32]; }
#pragma unroll
        for (int it = 0; it < 11; ++it) { const int hh = 2 * it + (lane >> 5);
            if (hh < 21) { const int col = hh < 8 ? Z_AQ + hh * 64 : hh < 16 ? Z_AK + (hh - 8) * 64 : hh < 20 ? Z_IQ + (hh - 16) * 64 : Z_IK;
                bf16* q = zr + col + (lane & 31); const float t1 = bf2f(ta[it]), t2 = bf2f(tb[it]);
                q[0] = (bf16)f2bf(t1 * cs.x - t2 * cs.y); q[32] = (bf16)f2bf(t2 * cs.x + t1 * cs.y); } }
#pragma unroll
        for (int j = 0; j < 2; ++j) { bf16* g0p = zr + Z_GT + lane * 8 + j * 512; const u32x4 a = *(const u32x4*)g0p, bb = *(const u32x4*)(g0p + 1024), cc = *(const u32x4*)(g0p + 2048);
            u32x4 o0, o1, o2;
#pragma unroll
            for (int i = 0; i < 4; ++i) {
                const float e0l = __expf(-bflo(a[i])), e0h = __expf(-bfhi(a[i])), e1l = __expf(-bflo(bb[i])), e1h = __expf(-bfhi(bb[i])), e2l = __expf(-bflo(cc[i])), e2h = __expf(-bfhi(cc[i]));
                o0[i] = pk2((1.f + e1l) / (1.f + e0l), (1.f + e1h) / (1.f + e0h));
                o1[i] = pk2((1.f + e2l) / (1.f + e1l), (1.f + e2h) / (1.f + e1h));
                o2[i] = pk2(1.f / (1.f + e2l), 1.f / (1.f + e2h)); }
            *(u32x4*)g0p = o0; *(u32x4*)(g0p + 1024) = o1; *(u32x4*)(g0p + 2048) = o2; }
        if (lane < 8) { const float v = bf2f(zr[Z_FF + lane]) + bf_l; const float ls = fminf(v, 0.f) - __logf(1.0f + __expf(-fabsf(v))); lfT[(size_t)(b * 8 + lane) * SEQ + pos] = ls * LOG2E; }
    }
}

constexpr int IX_CAP = 1024, IX_STRIDE = IX_CAP + 1  , IX_TRIG = 768, IX_CAND = 0, IX_BM = 0  , IX_HIST = 32 * IX_STRIDE * 4, IX_CNT = IX_HIST + 8 * 1024, IX_TAU = IX_CNT + 128, IX_FLAG = IX_TAU + 128, IX_END = IX_FLAG + 64;
static_assert(IX_END <= SCR_BYTES, "indexer LDS");

__device__ __forceinline__ int wave_incl_sum(int v) {
    v += __builtin_amdgcn_update_dpp(0, v, 0x111, 0xf, 0xf, false);
    v += __builtin_amdgcn_update_dpp(0, v, 0x112, 0xf, 0xf, false);
    v += __builtin_amdgcn_update_dpp(0, v, 0x114, 0xf, 0xf, false);
    v += __builtin_amdgcn_update_dpp(0, v, 0x118, 0xf, 0xf, false);
    v += __builtin_amdgcn_update_dpp(0, v, 0x142, 0xa, 0xf, false);
    v += __builtin_amdgcn_update_dpp(0, v, 0x143, 0xc, 0xf, false);
    return v;
}
__device__ __forceinline__ unsigned wave_or63(unsigned v) {
    v |= (unsigned)__builtin_amdgcn_update_dpp(0, (int)v, 0x111, 0xf, 0xf, false);
    v |= (unsigned)__builtin_amdgcn_update_dpp(0, (int)v, 0x112, 0xf, 0xf, false);
    v |= (unsigned)__builtin_amdgcn_update_dpp(0, (int)v, 0x114, 0xf, 0xf, false);
    v |= (unsigned)__builtin_amdgcn_update_dpp(0, (int)v, 0x118, 0xf, 0xf, false);
    v |= (unsigned)__builtin_amdgcn_update_dpp(0, (int)v, 0x142, 0xa, 0xf, false);
    v |= (unsigned)__builtin_amdgcn_update_dpp(0, (int)v, 0x143, 0xc, 0xf, false);
    return v;
}
__device__ __forceinline__ int count_ge8(const unsigned (&x)[16], int k0, unsigned t) {
    u64 m0, m1, m2, m3, m4, m5, m6, m7;
    asm("v_cmp_ge_u32_e64 %0, %8, %16\n\tv_cmp_ge_u32_e64 %1, %9, %16\n\tv_cmp_ge_u32_e64 %2, %10, %16\n\tv_cmp_ge_u32_e64 %3, %11, %16\n\t"
        "v_cmp_ge_u32_e64 %4, %12, %16\n\tv_cmp_ge_u32_e64 %5, %13, %16\n\tv_cmp_ge_u32_e64 %6, %14, %16\n\tv_cmp_ge_u32_e64 %7, %15, %16"
        : "=&s"(m0), "=&s"(m1), "=&s"(m2), "=&s"(m3), "=&s"(m4), "=&s"(m5), "=&s"(m6), "=&s"(m7)
        : "v"(x[k0]), "v"(x[k0 + 1]), "v"(x[k0 + 2]), "v"(x[k0 + 3]), "v"(x[k0 + 4]), "v"(x[k0 + 5]), "v"(x[k0 + 6]), "v"(x[k0 + 7]), "v"(t));
    return (int)(__popcll(m0) + __popcll(m1) + __popcll(m2) + __popcll(m3) + __popcll(m4) + __popcll(m5) + __popcll(m6) + __popcll(m7));
}
template <bool EXACT>
__device__ __forceinline__ unsigned wave_search256(const unsigned (&x)[16], int n) {
    const unsigned xr = (unsigned)__builtin_amdgcn_readfirstlane((int)x[0]); unsigned df = 0u;
#pragma unroll
    for (int k = 0; k < 16; ++k) df |= (x[k] != 0u) ? (x[k] ^ xr) : 0u;
    df = (unsigned)__builtin_amdgcn_readlane((int)wave_or63(df), 63);
    const int hb = 31 - (int)__builtin_clz(df | 1u);
    unsigned prefix = xr & ~((2u << hb) - 1u);
#pragma unroll 1
    for (int bit = hb; bit >= 0; --bit) { const unsigned trial = prefix | (1u << bit); int c = count_ge8(x, 0, trial); if (n > 512) c += count_ge8(x, 8, trial);
        if (c >= 256) { prefix = trial; if (EXACT ? (c == 256) : (c <= 384)) break; } }
    return prefix;
}
__device__ __forceinline__ unsigned wave_compact(LAS unsigned* cand, int n, int lane, int& kept) {
    unsigned x[16];
#pragma unroll
    for (int k = 0; k < 16; ++k) { const int i = lane + 64 * k; x[k] = (i < n) ? cand[i] : 0u; }
    const unsigned prefix = wave_search256<false>(x, n);
    int base = 0;
#pragma unroll
    for (int k = 0; k < 16; ++k) { const bool keep = x[k] >= prefix; const u64 mk = __ballot(keep);
        if (keep) cand[__builtin_amdgcn_mbcnt_hi((unsigned)(mk >> 32), __builtin_amdgcn_mbcnt_lo((unsigned)mk, (unsigned)base))] = x[k]; base += __popcll(mk); }
    kept = base;
    return prefix;
}

__device__ __forceinline__ void idx_phase(KP p, int l, LAS unsigned char* lds, int vcu, int G, int tid, int wave, int lane) {
    unsigned char* ws = p->ws; const bf16* Z = (const bf16*)(ws + WS_Z);
    { unsigned* sbr = (unsigned*)(ws + WS_CTL) + CW_SB + l * 64; LAS float* wt = (LAS float*)lds;
      for (int task = blockIdx.x; task < 256; task += G) { const int bh = task >> 3, part = task & 7; float qm = 0.f, km = 0.f;
          const bf16* zr = Z + (size_t)((bh >> 3) * SEQ + part * 1024 + tid * 2) * ZP + (bh & 7) * 64;
#pragma unroll
          for (int i = 0; i < 2; ++i) { float qs = 0.f, ks = 0.f;
#pragma unroll
              for (int c8 = 0; c8 < 8; ++c8) { const u32x4 a = *(const u32x4*)(zr + (size_t)i * ZP + Z_FQ + c8 * 8), kq = *(const u32x4*)(zr + (size_t)i * ZP + Z_FK + c8 * 8);
#pragma unroll
                  for (int w4 = 0; w4 < 4; ++w4) { qs += bflo(a[w4]) * bflo(a[w4]) + bfhi(a[w4]) * bfhi(a[w4]); ks += bflo(kq[w4]) * bflo(kq[w4]) + bfhi(kq[w4]) * bfhi(kq[w4]); } }
              qm = fmaxf(qm, qs); km = fmaxf(km, ks); }
#pragma unroll
          for (int o = 1; o < 64; o <<= 1) { qm = fmaxf(qm, __shfl_xor(qm, o)); km = fmaxf(km, __shfl_xor(km, o)); }
          if (lane == 0) { __hip_atomic_fetch_max(sbr + 2 * bh, __builtin_bit_cast(unsigned, qm), __ATOMIC_RELAXED, __HIP_MEMORY_SCOPE_AGENT); __hip_atomic_fetch_max(sbr + 2 * bh + 1, __builtin_bit_cast(unsigned, km), __ATOMIC_RELAXED, __HIP_MEMORY_SCOPE_AGENT); } }
      (void)wt; }
    for (int bh = blockIdx.x; bh < 32; bh += G) {
        float* dst = (float*)(ws + WS_CT) + (size_t)bh * SEQ;
        LAS float* wt = (LAS float*)lds;
        const float bfx = p->b_fox[l * 8 + (bh & 7)]; const bf16* zf = Z + (size_t)((bh >> 3) * SEQ + tid * 16) * ZP + Z_FF + (bh & 7);
        f32x4 v[4]; float run = 0.f;
#pragma unroll
        for (int j = 0; j < 4; ++j) {
#pragma unroll
            for (int i = 0; i < 4; ++i) { const float t = bf2f(zf[(size_t)(4 * j + i) * ZP]) + bfx; v[j][i] = (fminf(t, 0.f) - __logf(1.0f + __expf(-fabsf(t)))) * LOG2E; }
            v[j].x += run; v[j].y += v[j].x; v[j].z += v[j].y; v[j].w += v[j].z; run = v[j].w; }
        float inc = run;
#pragma unroll
        for (int o = 1; o < 64; o <<= 1) { const float t = __shfl_up(inc, o); if (lane >= o) inc += t; }
        if (lane == 63) wt[wave] = inc;
        WG_BAR();
        float off = inc - run;
        for (int w = 0; w < wave; ++w) off += wt[w];
        { u32x4* ka = (u32x4*)((bf16*)(ws + WS_KA) + ((size_t)bh * SEQ + tid * 16) * 16);
#pragma unroll
          for (int j = 0; j < 4; ++j) { const f32x4 c4 = v[j] + off; *(f32x4*)(dst + tid * 16 + 4 * j) = c4;
#pragma unroll
              for (int i = 0; i < 4; ++i) { const float c = c4[i]; const unsigned h1 = f2bf(c); const float r1 = c - bf2f(h1); const unsigned h2 = f2bf(r1); const unsigned h3 = f2bf(r1 - bf2f(h2));
                  unsigned z0 = 0u; asm volatile("" : "+v"(z0));
                  ka[(4 * j + i) * 2] = (u32x4){h1 | (h2 << 16), h3 | 0x3f800000u, z0, z0}; ka[(4 * j + i) * 2 + 1] = (u32x4){z0, z0, z0, z0}; } } }
        WG_BAR();
    }
    LAS unsigned* cand = (LAS unsigned*)(lds + IX_CAND); LAS unsigned* BM = (LAS unsigned*)(lds + IX_BM);
    LAS unsigned* cnt = (LAS unsigned*)(lds + IX_CNT); LAS unsigned* tau = (LAS unsigned*)(lds + IX_TAU); LAS unsigned* hist = (LAS unsigned*)(lds + IX_HIST); LAS unsigned* flg = (LAS unsigned*)(lds + IX_FLAG);
    u64* MW = (u64*)(ws + WS_MASKW);
    const int r32 = lane & 31, hi = lane >> 5;
    for (int U = vcu; U < 1024; U += G) {
        const int v = U & 255, i4 = U >> 8; const int b = v & 3, a = v >> 2;
        const int hc = (i4 == 0) ? a : (i4 == 1) ? 255 - a : (i4 == 2) ? 64 + a : 191 - a;
        const int qbase = b * SEQ + hc * 32; const int nadm = ((hc >> 1) + 1) * 64;
        if (nadm <= 256) {
            const int nw = nadm >> 6;
            for (int i = tid; i < 32 * 128; i += NTHR) { const int w = i >> 5, q = i & 31; unsigned on = (w < nw) ? 0xffffffffu : 0u; asm volatile("" : "+v"(on));
                MW[((size_t)(b * 128 + w)) * SEQ + hc * 32 + q] = (u64)on | ((u64)on << 32); }
            continue;
        }
        const bf16* qrow = Z + (size_t)(qbase + r32) * ZP;
        bf16x8 iqf[4][4];
#pragma unroll
        for (int hd = 0; hd < 4; ++hd)
#pragma unroll
            for (int j = 0; j < 4; ++j) iqf[hd][j] = *(const bf16x8*)(qrow + Z_IQ + hd * 64 + j * 16 + hi * 8);
        float wq[4];
#pragma unroll
        for (int hd = 0; hd < 4; ++hd) wq[hd] = bf2f(qrow[Z_IW + hd]) * (0.5f * 0.125f);
        if (tid < 32) { cnt[tid] = 0u; tau[tid] = 0u; } if (tid < 3) flg[tid] = 0u;
        const int ntiles = nadm >> 5, nrounds = (ntiles + 7) >> 3;
        const bf16* kbase = (const bf16*)(ws + WS_IKC) + (size_t)(b * SEQ) * 64 + hi * 8;
        bf16x8 kf[4], kn[4];
#pragma unroll
        for (int j = 0; j < 4; ++j) kn[j] = *(const bf16x8*)(kbase + (size_t)((wave < ntiles ? wave : 0) * 32 + r32) * 64 + j * 16);
        WG_BAR();
        for (int rd = 0; rd < nrounds; ++rd) {
            const int tile = rd * 8 + wave;
#pragma unroll
            for (int j = 0; j < 4; ++j) kf[j] = kn[j];
            { const int tn = (tile + 8 < ntiles) ? tile + 8 : tile;
#pragma unroll
              for (int j = 0; j < 4; ++j) kn[j] = *(const bf16x8*)(kbase + (size_t)((tn < ntiles ? tn : 0) * 32 + r32) * 64 + j * 16); }
            if (tile < ntiles) {
                f32x16 sc = {};
#pragma unroll
                for (int hd = 0; hd < 4; ++hd) { f32x16 pp = {};
#pragma unroll
                    for (int j = 0; j < 4; ++j) pp = MFMA32(kf[j], iqf[hd][j], pp);
#pragma unroll
                    for (int r = 0; r < 16; ++r) { const float pv = pp[r]; const int pb = __builtin_bit_cast(int, pv); const int pr = pb > 0 ? pb : 0;
                        sc[r] = __builtin_fmaf(wq[hd], __builtin_bit_cast(float, pr), sc[r]); } }
                const unsigned tq = tau[r32];
                typedef unsigned u32x16_t __attribute__((ext_vector_type(16))); u32x16_t comp; unsigned npass = 0u;
#pragma unroll
                for (int r = 0; r < 16; ++r) { const int key = tile * 32 + crow(r, hi);
                    unsigned u = __builtin_bit_cast(unsigned, sc[r] + 0.0f); u ^= (unsigned)((int)u >> 31) | 0x80000000u;
                    comp[r] = (u & 0xffffe000u) | (unsigned)(8191 - key); npass += (comp[r] > tq) ? 1u : 0u; }
                unsigned pos = 0u;
                if (npass) pos = __hip_atomic_fetch_add(cnt + r32, npass, __ATOMIC_RELAXED, __HIP_MEMORY_SCOPE_WORKGROUP);
                LAS unsigned* cq_ = cand + r32 * IX_STRIDE;
#pragma unroll
                for (int r = 0; r < 16; ++r) if (comp[r] > tq) { cq_[pos] = comp[r]; ++pos; }
                if (npass && pos > (unsigned)IX_TRIG) flg[rd % 3] = 1u;
            }
            WG_BAR_LDS();
            const bool need_any = flg[rd % 3] != 0u;
            if (tid == 0) flg[(rd + 2) % 3] = 0u;
            if (need_any) {
#pragma unroll 1
                for (int i = 0; i < 4; ++i) { const int qq = wave * 4 + i; const int n = __builtin_amdgcn_readfirstlane((int)cnt[qq]);
                    if (n > 256) { int kept; const unsigned th = wave_compact(cand + qq * IX_STRIDE, n, lane, kept); if (lane == 0) { cnt[qq] = (unsigned)kept; tau[qq] = th ? th - 1u : 0u; } } }
                WG_BAR_LDS();
            }
        }
#pragma unroll 1
        for (int i = 0; i < 4; ++i) { const int qq = wave * 4 + i; const int n = __builtin_amdgcn_readfirstlane((int)cnt[qq]);
            LAS unsigned* cq = cand + qq * IX_STRIDE; unsigned x[16];
#pragma unroll
            for (int k = 0; k < 16; ++k) { const int ii = lane + 64 * k; x[k] = (ii < n) ? cq[ii] : 0u; }
            unsigned th = 1u; if (n > 256) th = wave_search256<true>(x, n);
            asm volatile("" ::: "memory");
#pragma unroll
            for (int k = 0; k < 4; ++k) { unsigned z0 = 0u; asm volatile("" : "+v"(z0)); cq[lane + 64 * k] = z0; }
#pragma unroll
            for (int k = 0; k < 16; ++k) if (x[k] >= th) { const int key = 8191 - (int)(x[k] & 8191u);
                (void)__hip_atomic_fetch_or(cq + (key >> 5), 1u << (key & 31), __ATOMIC_RELAXED, __HIP_MEMORY_SCOPE_WORKGROUP); }
            LDS_WAIT(); asm volatile("" ::: "memory"); }
        WG_BAR();
        { const int w = tid >> 2, qg = tid & 3; u32x4 o[4];
#pragma unroll
          for (int j = 0; j < 4; ++j) { const LAS unsigned* c0 = cand + (qg * 8 + 2 * j) * IX_STRIDE + 2 * w; const LAS unsigned* c1 = c0 + IX_STRIDE; o[j] = (u32x4){c0[0], c0[1], c1[0], c1[1]}; }
          u32x4* dst = (u32x4*)(MW + ((size_t)(b * 128 + w)) * SEQ + hc * 32 + qg * 8);
#pragma unroll
          for (int j = 0; j < 4; ++j) dst[j] = o[j]; }
        WG_BAR();
    }
}

constexpr int AT_K = 0, AT_V = 2 * 8192, AT_WS = 4 * 8192, AT_OST = AT_WS + 4096, AT_MW = AT_OST + 8 * 4096, AT_KA = AT_MW + 2 * 8 * 512, AT_END = AT_KA + 2 * 2048;
static_assert(AT_END <= SCR_BYTES, "attention LDS");
#ifndef DBG_ATT_L
#define DBG_ATT_L 0
#endif

template <int MODE>
__device__ __forceinline__ void attn_unit(int b, int h, int qb, const bf16* Z, bf16* Ob, const float* cT, const u64* MW, const void* KA, const void* SBp, LAS char* shm, int wv) {
    int tid_l = lane_id() + wv * 64;
    const int tid = tid_l, lane = tid & 63, r32 = lane & 31, hi = lane >> 5; const int wid = __builtin_amdgcn_readfirstlane(tid >> 6);
    constexpr int QC = MODE == 0 ? Z_FQ : Z_AQ, KC = MODE == 0 ? Z_FK : Z_AK, VC = MODE == 0 ? Z_FV : Z_AV, OC = MODE == 0 ? 512 : 0;
    const long rowbase = (long)b * SEQ; const int q0 = qb * 512;
    const bf16* Qw = Z + (rowbase + q0 + wid * 64) * ZP + QC + h * 64;
    const bf16* Kh = Z + rowbase * ZP + KC + h * 64; const bf16* Vh = Z + rowbase * ZP + VC + h * 64;
    const unsigned lds0 = (unsigned)(uintptr_t)shm;
    LAS float* wsf = (LAS float*)(shm + AT_WS) + wid * 128;
    const int NT = 8 * (qb + 1); const int tlast = 8 * qb + wid;
    const bf16* ksrc = Kh + (long)(8 * wid + (lane >> 3)) * ZP + ((lane & 7) ^ (lane >> 3)) * 8;
    const bf16* vsrc = Vh + (long)(16 * (wid & 3) + (lane >> 2)) * ZP + (wid >> 2) * 32 + (lane & 3) * 8;
    const unsigned kdst = lds0 + AT_K + wid * 1024, vdst = lds0 + AT_V + wid * 1024, mdst = lds0 + AT_MW + wid * 512;
    const unsigned kadst = lds0 + AT_KA + (wid & 1) * 1024;
#define DMA_KA(t, sl) do { if (MODE == 0 && wid < 2) { const int ln_ = lane_id();     \
        glds16((const bf16*)KA + ((size_t)(b * 8 + h) * SEQ + (t) * 64 + 32 * wid + (ln_ >> 1)) * 16 + (ln_ & 1) * 8, (unsigned)__builtin_amdgcn_readfirstlane(kadst + (sl) * 2048)); } } while (0)
#define DMA_K(t, slotb) glds16(ksrc + (long)(t) * 64 * ZP, (unsigned)__builtin_amdgcn_readfirstlane(kdst + (slotb)))
#define DMA_V(t, slotb) glds16(vsrc + (long)(t) * 64 * ZP, (unsigned)__builtin_amdgcn_readfirstlane(vdst + (slotb)))
#define DMA_M(t, sl) do { const int ln_ = lane_id(); const unsigned* msrcA = (const unsigned*)(MW + ((size_t)(b * 128 + (t))) * SEQ + q0 + wid * 64) + 2 * (ln_ & 31) + (ln_ >> 5);     \
        glds4(msrcA, (unsigned)__builtin_amdgcn_readfirstlane(mdst + (sl) * 4096)); glds4(msrcA + 64, (unsigned)__builtin_amdgcn_readfirstlane(mdst + (sl) * 4096 + 256)); } while (0)
    int t_start = 0, t_first = 0;
    if (MODE == 0) { const float* cg = cT + (size_t)(b * 8 + h) * SEQ; const float th = 2.0f * (sqrtf(((const float*)SBp)[2 * (b * 8 + h)]) * sqrtf(((const float*)SBp)[2 * (b * 8 + h) + 1]) * 1.01f + 1.0f) + 40.0f; const int ln_ = lane_id();
        const float c0 = cg[q0], cw = cg[q0 + wid * 64];
        const float ca = (ln_ < NT) ? cg[64 * ln_ + 63] : -3e38f, cb = (ln_ + 64 < NT) ? cg[64 * (ln_ + 64) + 63] : -3e38f;
        { const u64 m0 = __ballot(ca <= c0 + th), m1 = __ballot(cb <= c0 + th); t_start = m0 ? (int)__builtin_ctzll(m0) : 64 + (int)__builtin_ctzll(m1 | (1ull << 63)); }
        { const u64 m0 = __ballot(ca <= cw + th), m1 = __ballot(cb <= cw + th); t_first = m0 ? (int)__builtin_ctzll(m0) : 64 + (int)__builtin_ctzll(m1 | (1ull << 63)); }
        if (t_start > 8 * qb) t_start = 8 * qb; if (t_first > tlast) t_first = tlast; }
    DMA_K(t_start, 0); DMA_V(t_start, 0); if (MODE == 1) DMA_M(0, 0); DMA_KA(t_start, 0);
    bf16x8 qA[4], qB[4];
#pragma unroll
    for (int d0 = 0; d0 < 4; ++d0) { qA[d0] = *(const bf16x8*)(Qw + (long)r32 * ZP + d0 * 16 + hi * 8); qB[d0] = *(const bf16x8*)(Qw + (long)(32 + r32) * ZP + d0 * 16 + hi * 8); }
    float mA = 0.f, mB = 0.f, lA = 0.f, lB = 0.f;
    const unsigned qa0 = (MODE == 0 && hi == 0) ? 0xbf80bf80u : 0u; const unsigned qa1c = (MODE == 0 && hi == 0) ? 0xbf80u : 0u;
    u32x4 qaA = {qa0, qa1c, 0u, 0u}, qaB = {qa0, qa1c, 0u, 0u};
    f32x16 oA[2], oB[2]; oA[0] = f32x16{}; oA[1] = f32x16{}; oB[0] = f32x16{}; oB[1] = f32x16{};
    const int qrelA = wid * 64 + r32;
    const LAS char* kp0 = shm + AT_K + r32 * 128; int koff[4];
#pragma unroll
    for (int d0 = 0; d0 < 4; ++d0) koff[d0] = ((2 * d0 + hi) ^ (r32 & 7)) * 16;
    const LAS char* vp0 = shm + AT_V + ((lane >> 4) & 1) * 32 + (lane & 3) * 8 + (4 * hi + ((lane & 15) >> 2)) * 64;
    const LAS unsigned* mwp = (const LAS unsigned*)(shm + AT_MW + wid * 512);
    const LAS char* kap0 = shm + AT_KA + r32 * 32 + hi * 16;
    int slot = 0;
#define SOFTMAX(P0, P1, MH, LR, OO, QA, QREL, WSOFF, MWOFF, PW) do { \
        if (MODE == 0) { \
            if (t == tlast) { _Pragma("unroll") for (int r = 0; r < 16; ++r) { const int kv = crow(r, hi); if (kv > (QREL) - wid * 64) P0[r] = -INFINITY; if (kv + 32 > (QREL) - wid * 64) P1[r] = -INFINITY; } } \
        } else { const unsigned mlo = mwp[slot * 1024 + (MWOFF) + r32] >> (4 * hi), mhi = mwp[slot * 1024 + (MWOFF) + 32 + r32] >> (4 * hi);     \
            _Pragma("unroll") for (int r = 0; r < 16; ++r) { const int bitp = crow(r, 0); const float p0_ = P0[r], p1_ = P1[r];     \
                const unsigned s0_ = (unsigned)__builtin_amdgcn_sbfe((int)mlo, bitp, 1), s1_ = (unsigned)__builtin_amdgcn_sbfe((int)mhi, bitp, 1);                       \
                P0[r] = __builtin_bit_cast(float, (__builtin_bit_cast(unsigned, p0_) & s0_) | (0xff800000u & ~s0_)); P1[r] = __builtin_bit_cast(float, (__builtin_bit_cast(unsigned, p1_) & s1_) | (0xff800000u & ~s1_)); } } \
        float rm = __builtin_fmaxf(__builtin_fmaxf(P0[0], P0[1]), P1[0]), rm2 = __builtin_fmaxf(__builtin_fmaxf(P0[2], P0[3]), P1[1]); rm = __builtin_fmaxf(__builtin_fmaxf(rm, P1[2]), P1[3]); \
        _Pragma("unroll") for (int r = 4; r < 16; r += 4) { rm = __builtin_fmaxf(__builtin_fmaxf(rm, P0[r]), P0[r + 1]); rm2 = __builtin_fmaxf(__builtin_fmaxf(rm2, P0[r + 2]), P0[r + 3]); rm = __builtin_fmaxf(__builtin_fmaxf(rm, P1[r]), P1[r + 1]); rm2 = __builtin_fmaxf(__builtin_fmaxf(rm2, P1[r + 2]), P1[r + 3]); } \
        rm = __builtin_fmaxf(rm, rm2); \
        rm = swapmax(rm);                            \
        if (__any(rm > 24.0f)) { const bool big_ = __builtin_fabsf(MH) + __builtin_fabsf(rm > 0.f ? rm : 0.f) > 1800.0f;     \
            const float dl = rm > 0.f ? (big_ ? 64.0f * __builtin_ceilf((MH + rm) * (1.0f / 64.0f)) - MH : 8.0f * __builtin_ceilf(rm * 0.125f)) : 0.f; const float f = __builtin_amdgcn_exp2f(-dl); LR *= f; MH += dl; \
            QA[1] = (QA[1] & 0xffffu) | ((hi == 0) ? (f2bf(-MH) << 16) : 0u); \
            _Pragma("unroll") for (int r = 0; r < 16; ++r) { P0[r] -= dl; P1[r] -= dl; } \
            if (hi == 0) wsf[(WSOFF) + r32] = f; \
            LDS_WAIT(); \
            _Pragma("unroll") for (int j = 0; j < 4; ++j) { const f32x4 ff = *(const LAS f32x4*)(wsf + (WSOFF) + 8 * j + 4 * hi); \
                _Pragma("unroll") for (int i = 0; i < 4; ++i) { OO[0][4 * j + i] *= ff[i]; OO[1][4 * j + i] *= ff[i]; } } } \
        f32x2 sa2_ = {0.f, 0.f}, sb2_ = {0.f, 0.f};                       \
        _Pragma("unroll") for (int r = 0; r < 16; r += 2) { P0[r] = __builtin_amdgcn_exp2f(P0[r]); P0[r + 1] = __builtin_amdgcn_exp2f(P0[r + 1]); P1[r] = __builtin_amdgcn_exp2f(P1[r]); P1[r + 1] = __builtin_amdgcn_exp2f(P1[r + 1]); \
            sa2_ += (f32x2){P0[r], P0[r + 1]}; sb2_ += (f32x2){P1[r], P1[r + 1]}; } \
        sa2_ += sb2_; LR += sa2_.x + sa2_.y; \
        _Pragma("unroll") for (int i = 0; i < 4; ++i) { PW[0][i] = cvtpk(P0[2 * i], P0[2 * i + 1]); PW[1][i] = cvtpk(P0[8 + 2 * i], P0[8 + 2 * i + 1]); PW[2][i] = cvtpk(P1[2 * i], P1[2 * i + 1]); PW[3][i] = cvtpk(P1[8 + 2 * i], P1[8 + 2 * i + 1]); } \
    } while (0)
      \
#define VLOAD() do { const LAS char* vp = vp0 + slot * 8192; \
        _Pragma("unroll") for (int d0 = 0; d0 < 2; ++d0) _Pragma("unroll") for (int ks = 0; ks < 4; ++ks) { const s16x4 lo_ = vtr(vp + d0 * 4096 + ks * 1024), hh_ = vtr(vp + d0 * 4096 + ks * 1024 + 512); \
            vfr[d0][ks] = (bf16x8){lo_[0], lo_[1], lo_[2], lo_[3], hh_[0], hh_[1], hh_[2], hh_[3]}; } } while (0)
#define PVMM(OO, PW) do { _Pragma("unroll") for (int d0 = 0; d0 < 2; ++d0) _Pragma("unroll") for (int ks = 0; ks < 4; ++ks) OO[d0] = MFMA32(__builtin_bit_cast(bf16x8, PW[ks]), vfr[d0][ks], OO[d0]); } while (0)
    for (int t = t_start; t < NT; ++t) {
        asm volatile("s_waitcnt vmcnt(0) lgkmcnt(0)\n\ts_barrier" ::: "memory");
        if (t + 1 < NT) { DMA_K(t + 1, (slot ^ 1) * 8192); DMA_V(t + 1, (slot ^ 1) * 8192); if (MODE == 1) DMA_M(t + 1, slot ^ 1); DMA_KA(t + 1, slot ^ 1); }
        if (t <= tlast && t >= t_first) {
            f32x16 a0 = {}, a1 = {}, b0 = {}, b1 = {};
            { const LAS char* kb = kp0 + slot * 8192;
#pragma unroll
              for (int d0 = 0; d0 < 4; ++d0) { const bf16x8 k0 = *(const LAS bf16x8*)(kb + koff[d0]), k1 = *(const LAS bf16x8*)(kb + koff[d0] + 4096);
                  a0 = MFMA32(k0, qA[d0], a0); a1 = MFMA32(k1, qA[d0], a1); b0 = MFMA32(k0, qB[d0], b0); b1 = MFMA32(k1, qB[d0], b1); }
              bf16x8 x0, x1;
              if (MODE == 0) { x0 = *(const LAS bf16x8*)(kap0 + slot * 2048); x1 = *(const LAS bf16x8*)(kap0 + slot * 2048 + 1024); }
              else { const u32x4 cw = {0u, (hi == 0) ? 0x3f800000u : 0u, 0u, 0u}; x0 = __builtin_bit_cast(bf16x8, cw); x1 = x0; }
              a0 = MFMA32(x0, __builtin_bit_cast(bf16x8, qaA), a0); a1 = MFMA32(x1, __builtin_bit_cast(bf16x8, qaA), a1); b0 = MFMA32(x0, __builtin_bit_cast(bf16x8, qaB), b0); b1 = MFMA32(x1, __builtin_bit_cast(bf16x8, qaB), b1); }
            u32x4 pwA[4], pwB[4]; bf16x8 vfr[2][4];
            SOFTMAX(a0, a1, mA, lA, oA, qaA, qrelA, 0, 0, pwA);
            VLOAD();
            PVMM(oA, pwA);
            SOFTMAX(b0, b1, mB, lB, oB, qaB, qrelA + 32, 32, 64, pwB);
            PVMM(oB, pwB);
        }
        slot ^= 1;
    }
#define EPILOG(OO, LR, WSOFF, ROWOFF) do { float l_ = swapsum(LR); if (hi == 0) wsf[64 + (WSOFF) + r32] = l_; LDS_WAIT(); float rli[16]; \
        _Pragma("unroll") for (int r = 0; r < 16; ++r) rli[r] = __builtin_amdgcn_rcpf(wsf[64 + (WSOFF) + crow(r, hi)]); \
        bf16* Ow = Ob + (rowbase + q0 + wid * 64 + (ROWOFF)) * OP + OC + h * 64; LAS bf16* stg = (LAS bf16*)(shm + AT_OST) + wid * 2048; \
        _Pragma("unroll") for (int r = 0; r < 16; ++r) { const int orow = crow(r, hi); _Pragma("unroll") for (int d0 = 0; d0 < 2; ++d0) stg[orow * 64 + d0 * 32 + r32] = (bf16)f2bf(OO[d0][r] * rli[r]); } \
        LDS_WAIT(); \
        _Pragma("unroll") for (int i = 0; i < 4; ++i) { const int row = i * 8 + (lane >> 3), ch = lane & 7; const u32x4 v = *(const LAS u32x4*)(stg + row * 64 + ch * 8); *(u32x4*)(Ow + (long)row * OP + ch * 8) = v; } \
        LDS_WAIT(); } while (0)
    EPILOG(oA, lA, 0, 0);
    EPILOG(oB, lB, 32, 32);
    asm volatile("s_waitcnt lgkmcnt(0)\n\ts_barrier" ::: "memory");
#undef DMA_K
#undef DMA_V
#undef DMA_M
#undef DMA_KA
#undef SOFTMAX
#undef PVMM
#undef VLOAD
#undef EPILOG
}

__device__ __forceinline__ void attn_phase(KP p, int l, LAS unsigned char* lds, int vcu, int G, int wv) {
    unsigned char* ws = p->ws; const bf16* Z = (const bf16*)(ws + WS_Z); bf16* Ob = (bf16*)(ws + WS_OBUF); const float* cT = (const float*)(ws + WS_CT); const u64* MW = (const u64*)(ws + WS_MASKW);
    for (int U = vcu; U < 1024; U += G) {
        const int v = U & 255, i4 = U >> 8; const int mode = i4 & 1, k = i4 >> 1; const int bh = v >> 3, s = v & 7;
        const int qb = (k == 0) ? s : 15 - s;
        if (mode == 0) attn_unit<0>(bh >> 3, bh & 7, qb, Z, Ob, cT, MW, (const void*)(ws + WS_KA), (const void*)((const unsigned*)(ws + WS_CTL) + CW_SB + l * 64), (LAS char*)lds, wv);
        else attn_unit<1>(bh >> 3, bh & 7, qb, Z, Ob, cT, MW, (const void*)(ws + WS_KA), (const void*)((const unsigned*)(ws + WS_CTL) + CW_SB + l * 64), (LAS char*)lds, wv);
    }
}

constexpr int HG_LF = 0, HG_KK = 16640, HG_SEG = 33280, HG_P = 35328, HG_R = HG_P + 9216, HG_RT = HG_R + 9216, HG_VT = HG_RT + 9216, HG_ST = HG_VT + 9216, HG_CG = HG_ST + 9216, HG_END = HG_CG + 9216;
static_assert(HG_END <= SCR_BYTES, "hgrn LDS");
constexpr int HP = 72;

__device__ __forceinline__ void hgrn_front(KP p, int l, const unsigned short (&zf)[8], int h, int d, int seg, LAS float* SEG, float (&kk)[8], float (&bb)[8], float& bm, float& bl) {
    const int dd = h * 64 + d; const float lb = (l == 0) ? 0.f : sigmoidf_(p->lb_logits[512 + dd] - p->lb_logits[dd]);
    float run = 0.f;
#pragma unroll
    for (int i = 0; i < 8; ++i) { const float sg = sigmoidf_(bf2f(zf[i])); const float f = lb + (1.f - lb) * sg; kk[i] = (1.f - lb) * (1.f - sg); run += __logf(f); bb[i] = run; }
    SEG[seg * 64 + d] = run;
    WG_BAR_LDS();
    float pre = 0.f, m4 = 0.f, all = 0.f;
#pragma unroll
    for (int s2 = 0; s2 < 8; ++s2) { const float sv = SEG[s2 * 64 + d]; if (s2 < seg) pre += sv; if (s2 < 4) m4 += sv; all += sv; }
#pragma unroll
    for (int i = 0; i < 8; ++i) bb[i] += pre;
    bm = m4; bl = all;
}

#define H_ROWP(U_) (Z + (size_t)((((U_) >> 7) >> 3) * SEQ + ((U_) & 127) * 64 + 8 * seg) * ZP + (((U_) >> 7) & 7) * 64 + d)
__device__ __forceinline__ void h1_phase(KP p, int l, LAS unsigned char* lds, int vcu, int G, int tid, int wave, int lane) {
    unsigned char* ws = p->ws; const bf16* Z = (const bf16*)(ws + WS_Z); float* Ug = (float*)(ws + WS_UG); float* Dg = (float*)(ws + WS_DG); float* D2g = (float*)(ws + WS_D2G);
    LAS float* SEG = (LAS float*)(lds + HG_SEG); LAS bf16* RT = (LAS bf16*)(lds + HG_RT); LAS bf16* VT = (LAS bf16*)(lds + HG_VT);
    const int r32 = lane & 31, hi = lane >> 5; const int d = tid & 63, seg = tid >> 6;
    unsigned* hq = (unsigned*)(ws + WS_CTL) + CW_HQ + l * 64; LAS int* qs = (LAS int*)(lds + MISC_OFF) + 12;
    for (int U = vcu; U < 4096; ) {
        unsigned nxt_ = 0u; if (tid == 0) nxt_ = __hip_atomic_fetch_add(hq, 1u, __ATOMIC_RELAXED, __HIP_MEMORY_SCOPE_AGENT);
        const int bh = U >> 7, h = bh & 7; const bf16* rp = H_ROWP(U);
        unsigned short zf[8], vv[8];
#pragma unroll
        for (int i = 0; i < 8; ++i) { zf[i] = rp[(size_t)i * ZP + Z_CF]; vv[i] = rp[(size_t)i * ZP + Z_CI]; }
        float kk[8], bb[8], bm, bl; hgrn_front(p, l, zf, h, d, seg, SEG, kk, bb, bm, bl);
        { unsigned rw[4], vw[4];
#pragma unroll
          for (int i = 0; i < 4; ++i) { rw[i] = pk2(kk[2 * i] * __expf(fminf(bm - bb[2 * i], 80.f)), kk[2 * i + 1] * __expf(fminf(bm - bb[2 * i + 1], 80.f))); vw[i] = (unsigned)vv[2 * i] | ((unsigned)vv[2 * i + 1] << 16); }
          *(LAS u32x4*)(RT + d * HP + 8 * seg) = (u32x4){rw[0], rw[1], rw[2], rw[3]}; *(LAS u32x4*)(VT + d * HP + 8 * seg) = (u32x4){vw[0], vw[1], vw[2], vw[3]}; }
        if (seg == 7) { Dg[(size_t)U * 64 + d] = __expf(bl); D2g[(size_t)U * 64 + d] = __expf(bl - bm); }
        WG_BAR_LDS();
        if (wave < 4) { const int ib = wave >> 1, jb = wave & 1; f32x16 acc = {};
#pragma unroll
            for (int ks = 0; ks < 4; ++ks) { const bf16x8 a = *(const LAS bf16x8*)(RT + (32 * ib + r32) * HP + 16 * ks + 8 * hi), bq = *(const LAS bf16x8*)(VT + (32 * jb + r32) * HP + 16 * ks + 8 * hi);
                acc = MFMA32(a, bq, acc); }
            float* up = Ug + ((size_t)U * 64 + 32 * jb + r32) * 64 + 32 * ib + 4 * hi;
#pragma unroll
            for (int rr = 0; rr < 4; ++rr) *(f32x4*)(up + 8 * rr) = (f32x4){acc[4 * rr], acc[4 * rr + 1], acc[4 * rr + 2], acc[4 * rr + 3]}; }
        if (tid == 0) qs[0] = G + (int)nxt_;
        WG_BAR_LDS();
        U = qs[0];
    }
}

__device__ __forceinline__ void h2_phase(KP p, int G, int tid) {
    unsigned char* ws = p->ws; const float* Ug = (const float*)(ws + WS_UG); const float* Dg = (const float*)(ws + WS_DG); const float* D2g = (const float*)(ws + WS_D2G); bf16* Sst = (bf16*)(ws + WS_SST);
    for (int gid = blockIdx.x * NTHR + tid; gid < 32 * 4096; gid += G * NTHR) {
        const int bh = gid >> 12, ed = gid & 4095, d = ed & 63; float S = 0.f;
        const float* up = Ug + (size_t)bh * 128 * 4096 + ed; const float* dp = Dg + (size_t)bh * 128 * 64 + d; const float* d2p = D2g + (size_t)bh * 128 * 64 + d; bf16* sp = Sst + (size_t)bh * 128 * 4096 + ed;
        for (int c0 = 0; c0 < 128; c0 += 8) { float u[8], dd[8], d2[8];
#pragma unroll
            for (int i = 0; i < 8; ++i) { u[i] = up[(size_t)(c0 + i) * 4096]; dd[i] = dp[(c0 + i) * 64]; d2[i] = d2p[(c0 + i) * 64]; }
#pragma unroll
            for (int i = 0; i < 8; ++i) { sp[(size_t)(c0 + i) * 4096] = (bf16)f2bf(S); S = dd[i] * S + d2[i] * u[i]; } }
    }
}

__device__ __forceinline__ void h3_phase(KP p, int l, LAS unsigned char* lds, int vcu, int G, int tid, int wave, int lane) {
    unsigned char* ws = p->ws; const bf16* Z = (const bf16*)(ws + WS_Z); const bf16* Sst = (const bf16*)(ws + WS_SST); bf16* Ob = (bf16*)(ws + WS_OBUF);
    LAS float* SEG = (LAS float*)(lds + HG_SEG);
    LAS bf16* Pt = (LAS bf16*)(lds + HG_P); LAS bf16* Rt = (LAS bf16*)(lds + HG_R); LAS bf16* VT = (LAS bf16*)(lds + HG_VT); LAS bf16* ST = (LAS bf16*)(lds + HG_ST); LAS bf16* CG = (LAS bf16*)(lds + HG_CG);
    const int r32 = lane & 31, hi = lane >> 5; const int d = tid & 63, seg = tid >> 6;
    const float* gn = p->norm_g + l * 512;
    for (int U = vcu; U < 4096; U += G) {
        const int bh = U >> 7, c = U & 127, b = bh >> 3, h = bh & 7; const int t0 = b * SEQ + c * 64; const bf16* rp = H_ROWP(U);
        unsigned short zf[8], qv[8], vv[8], gg[8], sv[8];
#pragma unroll
        for (int i = 0; i < 8; ++i) { zf[i] = rp[(size_t)i * ZP + Z_CF]; qv[i] = rp[(size_t)i * ZP + Z_CQ]; vv[i] = rp[(size_t)i * ZP + Z_CI]; gg[i] = rp[(size_t)i * ZP + Z_CG]; sv[i] = Sst[(size_t)U * 4096 + (8 * seg + i) * 64 + d]; }
        float kk[8], bb[8], bm, bl; hgrn_front(p, l, zf, h, d, seg, SEG, kk, bb, bm, bl); (void)bl;
        { const float ebm = __expf(bm); unsigned vw[4];
#pragma unroll
          for (int i = 0; i < 8; ++i) { const int t = 8 * seg + i;
              Pt[t * HP + d] = (bf16)f2bf(bf2f(qv[i]) * __expf(fminf(bb[i] - bm, 80.f))); Rt[t * HP + d] = (bf16)f2bf(kk[i] * __expf(fminf(bm - bb[i], 80.f)));
              ST[t * HP + d] = (bf16)f2bf(bf2f(sv[i]) * ebm); CG[t * HP + d] = (bf16)gg[i]; }
#pragma unroll
          for (int i = 0; i < 4; ++i) vw[i] = (unsigned)vv[2 * i] | ((unsigned)vv[2 * i + 1] << 16);
          *(LAS u32x4*)(VT + d * HP + 8 * seg) = (u32x4){vw[0], vw[1], vw[2], vw[3]}; }
        WG_BAR_LDS();
        if (wave < 2) { const int ib = wave;
            u32x4 pw[2][2];
#pragma unroll
            for (int k = 0; k < 2; ++k) { f32x16 a = {};
                if (k <= ib) {
#pragma unroll
                    for (int js = 0; js < 4; ++js) { const bf16x8 ra = *(const LAS bf16x8*)(Rt + (32 * k + r32) * HP + 16 * js + 8 * hi), pb = *(const LAS bf16x8*)(Pt + (32 * ib + r32) * HP + 16 * js + 8 * hi);
                        a = MFMA32(ra, pb, a); }
                    if (k == ib) {
#pragma unroll
                        for (int r = 0; r < 16; ++r) if (crow(r, hi) > r32) a[r] = 0.f;
                    }
                }
#pragma unroll
                for (int i = 0; i < 4; ++i) { pw[k][0][i] = cvtpk(a[2 * i], a[2 * i + 1]); pw[k][1][i] = cvtpk(a[8 + 2 * i], a[8 + 2 * i + 1]); } }
            f32x16 oacc[2]; float ss = 0.f;
#pragma unroll
            for (int j = 0; j < 2; ++j) { f32x16 oa = {};
#pragma unroll
                for (int k = 0; k < 2; ++k) { if (k <= ib) {
#pragma unroll
                    for (int st = 0; st < 2; ++st) { const LAS bf16* vp = VT + (32 * j + r32) * HP + 32 * k + 16 * st + 4 * hi;
                        const s16x4 v0 = *(const LAS s16x4*)vp, v1 = *(const LAS s16x4*)(vp + 8);
                        const bf16x8 vf = {v0[0], v0[1], v0[2], v0[3], v1[0], v1[1], v1[2], v1[3]};
                        oa = MFMA32(vf, __builtin_bit_cast(bf16x8, pw[k][st]), oa); } } }
#pragma unroll
                for (int js = 0; js < 4; ++js) { const bf16x8 sa = *(const LAS bf16x8*)(ST + (32 * j + r32) * HP + 16 * js + 8 * hi), pb = *(const LAS bf16x8*)(Pt + (32 * ib + r32) * HP + 16 * js + 8 * hi);
                    oa = MFMA32(sa, pb, oa); }
#pragma unroll
                for (int r = 0; r < 16; ++r) ss += oa[r] * oa[r];
                oacc[j] = oa; }
            f32x4 g8[8];
#pragma unroll
            for (int q = 0; q < 8; ++q) g8[q] = *(const f32x4*)(gn + h * 64 + 32 * (q >> 2) + 8 * (q & 3) + 4 * hi);
            ss = swapsum(ss);
            const float rstd = 1.0f / sqrtf(ss * (1.0f / 64.0f) + RMS_EPS);
            bf16* orow = Ob + (size_t)(t0 + 32 * ib + r32) * OP + 1024 + h * 64;
            asm volatile("s_waitcnt vmcnt(0)" ::: "memory");
#pragma unroll
            for (int j = 0; j < 2; ++j)
#pragma unroll
                for (int rr = 0; rr < 4; ++rr) { const int e0 = 32 * j + 8 * rr + 4 * hi; const f32x4 g4 = g8[4 * j + rr];
                    const u32x2 cw = *(const LAS u32x2*)(CG + (32 * ib + r32) * HP + e0);
                    const float o0 = oacc[j][4 * rr] * rstd * g4[0] * sigmoidf_(bflo(cw.x)), o1 = oacc[j][4 * rr + 1] * rstd * g4[1] * sigmoidf_(bfhi(cw.x));
                    const float o2 = oacc[j][4 * rr + 2] * rstd * g4[2] * sigmoidf_(bflo(cw.y)), o3 = oacc[j][4 * rr + 3] * rstd * g4[3] * sigmoidf_(bfhi(cw.y));
                    *(u32x2*)(orow + e0) = (u32x2){cvtpk(o0, o1), cvtpk(o2, o3)}; }
        }
        WG_BAR_LDS();
    }
}

#undef H_ROWP
constexpr int RT_LG = 0, RT_HIST = 8 * 2048, RT_END = RT_HIST + 1024;
static_assert(RT_END <= SCR_BYTES, "router LDS");
typedef short bf16x8_t __attribute__((ext_vector_type(8)));
__device__ __forceinline__ void split_hi_lo(const f32x4 a, const f32x4 b, bf16x8_t& hi, bf16x8_t& lo) {
    const float v[8] = {a.x, a.y, a.z, a.w, b.x, b.y, b.z, b.w}; unsigned h[8], l[8];
#pragma unroll
    for (int i = 0; i < 8; ++i) { h[i] = f2bf(v[i]); l[i] = f2bf(v[i] - bf2f(h[i])); }
    const u32x4 hw = {h[0] | (h[1] << 16), h[2] | (h[3] << 16), h[4] | (h[5] << 16), h[6] | (h[7] << 16)}, lw = {l[0] | (l[1] << 16), l[2] | (l[3] << 16), l[4] | (l[5] << 16), l[6] | (l[7] << 16)};
    hi = __builtin_bit_cast(bf16x8_t, hw); lo = __builtin_bit_cast(bf16x8_t, lw);
}
__device__ __forceinline__ void ln1_phase(KP p, int l, const float* xin, LAS unsigned char* lds, int G, int tid, int wave, int lane) {
    unsigned char* ws = p->ws; const bf16* mix = (const bf16*)(ws + WS_MIX); bf16* x1 = (bf16*)(ws + WS_X1); bf16* x1b = (bf16*)(ws + WS_X1B);
    int* tke = (int*)(ws + WS_TKE); float* tkg = (float*)(ws + WS_TKG); int* wgcnt = (int*)(ws + WS_WGCNT);
    LAS float* LG = (LAS float*)(lds + RT_LG) + wave * 512; LAS unsigned* hist = (LAS unsigned*)(lds + RT_HIST);
    if (tid < 32) hist[tid] = 0u;
    WG_BAR();
    const float* lg = p->ln1_g + l * 1024; const float* lb = p->ln1_b + l * 1024;
    f32x4 gv[4], bv[4];
#pragma unroll
    for (int j = 0; j < 4; ++j) { gv[j] = *(const f32x4*)(lg + 4 * lane + 256 * j); bv[j] = *(const f32x4*)(lb + 4 * lane + 256 * j); }
    const int m0 = blockIdx.x * NWAVES + wave, mstride = G * NWAVES;
    for (int mb = m0; mb < NTOK; mb += 16 * mstride) {
        f32x4 xa[4], xm[4];
#define LOAD_XIN(mm) do { if (l == 0) { const f32x4* xr = (const f32x4*)(xin + (size_t)(mm) * DM) + lane; _Pragma("unroll") for (int j = 0; j < 4; ++j) xa[j] = xr[64 * j]; } \
            else { const u32x2* xr = (const u32x2*)((const bf16*)(ws + WS_XB) + (size_t)(mm) * DM) + lane; _Pragma("unroll") for (int j = 0; j < 4; ++j) { const u32x2 w = xr[64 * j]; xa[j] = (f32x4){bflo(w.x), bfhi(w.x), bflo(w.y), bfhi(w.y)}; } } } while (0)
        { LOAD_XIN(mb); const u32x2* mr = (const u32x2*)(mix + (size_t)mb * DM) + lane;
#pragma unroll
          for (int j = 0; j < 4; ++j) { const u32x2 w = mr[64 * j]; xm[j] = (f32x4){bflo(w.x), bfhi(w.x), bflo(w.y), bfhi(w.y)}; } }
#pragma unroll 1
        for (int i = 0; i < 16; ++i) { const int m = mb + i * mstride; if (m >= NTOK) break;
            f32x4 v[4]; float s = 0.f;
#pragma unroll
            for (int j = 0; j < 4; ++j) { v[j] = xa[j] * ALPHA + xm[j]; s += (v[j].x + v[j].y) + (v[j].z + v[j].w); }
            { const int mn = (m + mstride < NTOK) ? m + mstride : m;
              LOAD_XIN(mn); const u32x2* mr = (const u32x2*)(mix + (size_t)mn * DM) + lane;
#pragma unroll
              for (int j = 0; j < 4; ++j) { const u32x2 w = mr[64 * j]; xm[j] = (f32x4){bflo(w.x), bfhi(w.x), bflo(w.y), bfhi(w.y)}; } }
            const float mean = wave_sum(s) * (1.f / DM); float s2 = 0.f;
#pragma unroll
            for (int j = 0; j < 4; ++j) { v[j] = v[j] - mean; s2 += (v[j].x * v[j].x + v[j].y * v[j].y) + (v[j].z * v[j].z + v[j].w * v[j].w); }
            const float rstd = 1.f / sqrtf(wave_sum(s2) * (1.f / DM) + LN_EPS);
            u32x2* o4 = (u32x2*)(x1 + (size_t)m * DM) + lane; unsigned* o1 = (unsigned*)((unsigned char*)x1b + (size_t)m * DM) + lane;
#pragma unroll
            for (int j = 0; j < 4; ++j) { v[j] = v[j] * rstd * gv[j] + bv[j]; o4[64 * j] = (u32x2){pk2(v[j].x, v[j].y), pk2(v[j].z, v[j].w)}; int w8 = __builtin_amdgcn_cvt_pk_fp8_f32(v[j].x, v[j].y, 0, false); w8 = __builtin_amdgcn_cvt_pk_fp8_f32(v[j].z, v[j].w, w8, true); o1[64 * j] = (unsigned)w8; } }
        asm volatile("s_waitcnt vmcnt(0)" ::: "memory"); __builtin_amdgcn_fence(__ATOMIC_ACQUIRE, "agent"); asm volatile("s_waitcnt vmcnt(0)" ::: "memory");
        { const int ti = lane & 15, kg = lane >> 4; int mt = mb + ti * mstride; if (mt >= NTOK) mt = mb;
          const bf16* xr = x1 + (size_t)mt * DM + 8 * kg; const bf16* wf = (const bf16*)(ws + WS_WRF) + (size_t)l * 32 * 2 * 2 * 512 + lane * 8;
          f32x4 acc0 = {0.f, 0.f, 0.f, 0.f}, acc1 = {0.f, 0.f, 0.f, 0.f};
#pragma unroll 4
          for (int s = 0; s < 32; ++s) { const bf16x8_t ah = *(const bf16x8_t*)(xr + 32 * s);
              const bf16x8_t w0h = *(const bf16x8_t*)(wf + (size_t)(s * 4 + 0) * 512), w0l = *(const bf16x8_t*)(wf + (size_t)(s * 4 + 1) * 512), w1h = *(const bf16x8_t*)(wf + (size_t)(s * 4 + 2) * 512), w1l = *(const bf16x8_t*)(wf + (size_t)(s * 4 + 3) * 512);
              acc0 = __builtin_amdgcn_mfma_f32_16x16x32_bf16(ah, w0h, acc0, 0, 0, 0); acc0 = __builtin_amdgcn_mfma_f32_16x16x32_bf16(ah, w0l, acc0, 0, 0, 0);
              acc1 = __builtin_amdgcn_mfma_f32_16x16x32_bf16(ah, w1h, acc1, 0, 0, 0); acc1 = __builtin_amdgcn_mfma_f32_16x16x32_bf16(ah, w1l, acc1, 0, 0, 0); }
#pragma unroll
          for (int r = 0; r < 4; ++r) { LG[(4 * kg + r) * 32 + ti] = acc0[r]; LG[(4 * kg + r) * 32 + 16 + ti] = acc1[r]; } }
        LDS_WAIT();
        if (lane < 16) { const int m = mb + lane * mstride;
            if (m < NTOK) { float tv0 = -3e38f, tv1 = -3e38f, tv2 = -3e38f, tv3 = -3e38f; int ti0 = 0, ti1 = 0, ti2 = 0, ti3 = 0;
#pragma unroll
                for (int e4 = 0; e4 < 8; ++e4) { const f32x4 lv = *(const LAS f32x4*)(LG + lane * 32 + 4 * e4); const f32x4 bb = *(const f32x4*)(p->b_router + l * 32 + 4 * e4);
#pragma unroll
                    for (int i = 0; i < 4; ++i) { const float g = lv[i] + bb[i]; const int e = 4 * e4 + i;
                        if (g > tv0) { tv3 = tv2; ti3 = ti2; tv2 = tv1; ti2 = ti1; tv1 = tv0; ti1 = ti0; tv0 = g; ti0 = e; }
                        else if (g > tv1) { tv3 = tv2; ti3 = ti2; tv2 = tv1; ti2 = ti1; tv1 = g; ti1 = e; }
                        else if (g > tv2) { tv3 = tv2; ti3 = ti2; tv2 = g; ti2 = e; }
                        else if (g > tv3) { tv3 = g; ti3 = e; } } }
                const float e1 = __expf(tv1 - tv0), e2 = __expf(tv2 - tv0), e3 = __expf(tv3 - tv0); const float inv = 1.f / (1.f + e1 + e2 + e3);
                *(int4*)(tke + m * 4) = make_int4(ti0, ti1, ti2, ti3); *(f32x4*)(tkg + m * 4) = (f32x4){inv, e1 * inv, e2 * inv, e3 * inv};
                __hip_atomic_fetch_add(hist + ti0, 1u, __ATOMIC_RELAXED, __HIP_MEMORY_SCOPE_WORKGROUP); __hip_atomic_fetch_add(hist + ti1, 1u, __ATOMIC_RELAXED, __HIP_MEMORY_SCOPE_WORKGROUP);
                __hip_atomic_fetch_add(hist + ti2, 1u, __ATOMIC_RELAXED, __HIP_MEMORY_SCOPE_WORKGROUP); __hip_atomic_fetch_add(hist + ti3, 1u, __ATOMIC_RELAXED, __HIP_MEMORY_SCOPE_WORKGROUP); } }
        LDS_WAIT();
    }
    WG_BAR();
    if (tid < 32) wgcnt[blockIdx.x * 32 + tid] = (int)hist[tid];
}

__device__ __forceinline__ void slot_phase(KP p, LAS unsigned char* lds, int G, int tid, int wave, int lane) {
    unsigned char* ws = p->ws; const int* wgcnt = (const int*)(ws + WS_WGCNT); int* blk = (int*)(ws + WS_BLK);
    const int* tke = (const int*)(ws + WS_TKE); const float* tkg = (const float*)(ws + WS_TKG); int* tokslot = (int*)(ws + WS_TOKSLOT); float* gslot = (float*)(ws + WS_GSLOT);
    LAS unsigned* tot = (LAS unsigned*)lds; LAS unsigned* mine = tot + 32; LAS unsigned* cur = tot + 64;
    if (tid < 96) tot[tid] = 0u;
    WG_BAR();
    { const int e = tid & 31, part = tid >> 5; unsigned sa = 0u, sb = 0u;
      for (int w = part; w < G; w += 16) { const unsigned c = (unsigned)wgcnt[w * 32 + e]; sa += c; if (w < (int)blockIdx.x) sb += c; }
      __hip_atomic_fetch_add(tot + e, sa, __ATOMIC_RELAXED, __HIP_MEMORY_SCOPE_WORKGROUP); __hip_atomic_fetch_add(mine + e, sb, __ATOMIC_RELAXED, __HIP_MEMORY_SCOPE_WORKGROUP); }
    WG_BAR();
    if (tid == 0) { unsigned off = 0u;
#pragma unroll 1
        for (int e = 0; e < 32; ++e) { const unsigned padded = (tot[e] + 255u) & ~255u; cur[e] = off + mine[e];
            if (blockIdx.x == 0) { blk[BST_OFF + e] = (int)(off >> 8);
#pragma unroll 1
                for (unsigned bb = off >> 8; bb < ((off + padded) >> 8); ++bb) blk[16 + bb] = e; }
            off += padded; }
        if (blockIdx.x == 0) { blk[0] = (int)(off >> 8); blk[BST_OFF + 32] = (int)(off >> 8); } }
    WG_BAR();
    int* slottok = (int*)(ws + WS_SLOTTOK);
    if (blockIdx.x == 0 && tid < 32) { const unsigned ps = cur[tid], n = tot[tid];
        int zero_ = 0; asm volatile("" : "+v"(zero_));
#pragma unroll 1
        for (unsigned s = ps + n; s < ps + ((n + 255u) & ~255u); ++s) slottok[s] = zero_; }
    WG_BAR();
    for (int mb = blockIdx.x * NWAVES + wave; mb < NTOK; mb += 16 * G * NWAVES) { const int m = mb + (lane >> 2) * (G * NWAVES), k = lane & 3;
        if (m < NTOK) { const int e = tke[m * 4 + k]; const int slot = (int)__hip_atomic_fetch_add(cur + e, 1u, __ATOMIC_RELAXED, __HIP_MEMORY_SCOPE_WORKGROUP); tokslot[m * 4 + k] = slot; gslot[slot] = tkg[m * 4 + k]; slottok[slot] = m; }
    }
}

__device__ __forceinline__ void comb_phase(KP p, int l, float* xout, int G, int wave, int lane) {
    unsigned char* ws = p->ws; const bf16* x1 = (const bf16*)(ws + WS_X1); const bf16* y = (const bf16*)(ws + WS_Y); const int* tokslot = (const int*)(ws + WS_TOKSLOT); bf16* xb = (bf16*)(ws + WS_XB);
    const float* lg = p->ln2_g + l * 1024; const float* lb = p->ln2_b + l * 1024;
    f32x4 gv[4], bv[4];
#pragma unroll
    for (int j = 0; j < 4; ++j) { gv[j] = *(const f32x4*)(lg + 4 * lane + 256 * j); bv[j] = *(const f32x4*)(lb + 4 * lane + 256 * j); }
    const int m0 = blockIdx.x * NWAVES + wave, mstep = G * NWAVES;
    u32x2 xw[4], yw[16], xn[4], yn[16];
    typedef int i32x4_t __attribute__((ext_vector_type(4)));
#define CB_LOAD(MM, TS, XW, YW) do { const u32x2* xr_ = (const u32x2*)(x1 + (size_t)(MM) * DM) + lane; _Pragma("unroll") for (int j = 0; j < 4; ++j) XW[j] = xr_[64 * j]; \
        _Pragma("unroll") for (int k = 0; k < 4; ++k) { const int sk_ = __builtin_amdgcn_readfirstlane(TS[k]); const u32x2* yr_ = (const u32x2*)(y + (size_t)sk_ * DM) + lane; _Pragma("unroll") for (int j = 0; j < 4; ++j) YW[4 * k + j] = yr_[64 * j]; } } while (0)
    i32x4_t ts = *(const i32x4_t*)(tokslot + (size_t)(m0 < NTOK ? m0 : 0) * 4);
    if (m0 < NTOK) CB_LOAD(m0, ts, xn, yn);
    ts = *(const i32x4_t*)(tokslot + (size_t)(m0 + mstep < NTOK ? m0 + mstep : 0) * 4);
    for (int m = m0; m < NTOK; m += mstep) {
#pragma unroll
        for (int j = 0; j < 4; ++j) xw[j] = xn[j];
#pragma unroll
        for (int j = 0; j < 16; ++j) yw[j] = yn[j];
        if (m + mstep < NTOK) CB_LOAD(m + mstep, ts, xn, yn);
        ts = *(const i32x4_t*)(tokslot + (size_t)(m + 2 * mstep < NTOK ? m + 2 * mstep : 0) * 4);
        f32x4 v[4];
#pragma unroll
        for (int j = 0; j < 4; ++j) { const u32x2 w = xw[j]; v[j] = (f32x4){bflo(w.x), bfhi(w.x), bflo(w.y), bfhi(w.y)} * ALPHA; }
#pragma unroll
        for (int k = 0; k < 4; ++k)
#pragma unroll
            for (int j = 0; j < 4; ++j) { const u32x2 w = yw[4 * k + j]; v[j].x += bflo(w.x); v[j].y += bfhi(w.x); v[j].z += bflo(w.y); v[j].w += bfhi(w.y); }
        float s = 0.f;
#pragma unroll
        for (int j = 0; j < 4; ++j) s += (v[j].x + v[j].y) + (v[j].z + v[j].w);
        const float mean = wave_sum(s) * (1.f / DM); float s2 = 0.f;
#pragma unroll
        for (int j = 0; j < 4; ++j) { v[j] = v[j] - mean; s2 += (v[j].x * v[j].x + v[j].y * v[j].y) + (v[j].z * v[j].z + v[j].w * v[j].w); }
        const float rstd = 1.f / sqrtf(wave_sum(s2) * (1.f / DM) + LN_EPS);
        f32x4* o4 = (f32x4*)(xout + (size_t)m * DM) + lane; u32x2* o2 = (u32x2*)(xb + (size_t)m * DM) + lane;
#pragma unroll
        for (int j = 0; j < 4; ++j) { v[j] = v[j] * rstd * gv[j] + bv[j]; if (l == DEPTH - 1) o4[64 * j] = v[j]; else { o2[64 * j] = (u32x2){pk2(v[j].x, v[j].y), pk2(v[j].z, v[j].w)};
            int w8 = __builtin_amdgcn_cvt_pk_fp8_f32(v[j].x, v[j].y, 0, false); w8 = __builtin_amdgcn_cvt_pk_fp8_f32(v[j].z, v[j].w, w8, true); ((unsigned*)(ws + WS_XB8 + (size_t)m * DM))[lane + 64 * j] = (unsigned)w8; } }
    }
}

#ifndef ONE_LAUNCH
#define ONE_LAUNCH 1
#endif
__global__ void __launch_bounds__(NTHR, 2) fwd(Params p) {
    extern __shared__ __attribute__((aligned(16))) unsigned char lds_raw[];
    LAS unsigned char* lds = (LAS unsigned char*)lds_raw;
    volatile LAS unsigned* MISC = (volatile LAS unsigned*)(lds + MISC_OFF);
    const int tid = threadIdx.x, lane = tid & 63, wave = __builtin_amdgcn_readfirstlane(tid >> 6); const int wave0 = wave;
    const int G = gridDim.x; const int bx = blockIdx.x; const int vcu = (G % 8 == 0) ? (bx % 8) * (G / 8) + bx / 8 : bx;
    if (tid < 64) MISC[tid] = 0u;
    __syncthreads();
    if (p.use_bar) (void)xcd_barrier_post((unsigned*)(p.ws + WS_CTL) + CW_BAR, MISC + 8);
    const int lo = p.ph_lo, hi = p.ph_hi;
#ifndef PHSEL
#define PHSEL(k) true
#endif
#define IN(k) (PHSEL(k) && lo <= (k) && (k) < hi)
#define SEAM(k) do { if (lo <= (k) && (k) + 1 < hi) { KP qb_ = load_params(); XcdBarrier b_; b_.bar = (unsigned*)(qb_->ws + WS_CTL) + CW_BAR; b_.x = xb_xcc_id(); b_.st = MISC + 8; xcd_barrier(b_); } } while (0)
    const int gw0 = vcu * NWAVES + wave, NGW = G * NWAVES;
#define PH_IDS const int lane = lane_id(), wave = wave0, tid = wave0 * 64 + lane, gw = vcu * NWAVES + wave; (void)lane; (void)gw; (void)gw0;

    if (IN(0)) { PH_IDS KP q = load_params(); p0_prologue(q, lds, gw, NGW, wave, lane); SEAM(0); }

    for (int l = 0; l < DEPTH; ++l) {
        const int pb = 1 + l * NPH_LAYER;

        if (IN(pb + PH_INPROJ)) {
            KP q = load_params(); unsigned char* w = q->ws;
            pg8::Gemm g{(const bf16*)(w + WS_XB8), (const bf16*)(w + WS_WIN + (size_t)l * ZP * 1024), NTOK, ZP, 1024}; pg8::StaticOrder S; S.init(NTOK, ZP, G, bx);
            pg8::EpiZ E{(bf16*)(w + WS_Z), ZP, (const float*)(w + WS_TRIG), (bf16*)(w + WS_IKC)};
            pg8::gemm_phase<pg8::EpiZ, pg8::StaticOrder, true, true, true, W8_E8M0>(lds, g, S, E, wave0);
            SEAM(pb + PH_INPROJ);
        }
        if (IN(pb + PH_IDX)) { PH_IDS KP q = load_params(); idx_phase(q, l, lds, vcu, G, tid, wave, lane); }
        if (IN(pb + PH_H1)) { PH_IDS KP q = load_params(); h1_phase(q, l, lds, vcu, G, tid, wave, lane); SEAM(pb + PH_H1); }
        if (IN(pb + PH_H2)) { PH_IDS KP q = load_params(); h2_phase(q, G, tid); SEAM(pb + PH_H2); }
        if (IN(pb + PH_H3)) { PH_IDS KP q = load_params(); h3_phase(q, l, lds, vcu, G, tid, wave, lane); }
        if (IN(pb + PH_ATTN)) { PH_IDS KP q = load_params(); attn_phase(q, l, lds, vcu, G, wave0); SEAM(pb + PH_H3); }
        if (IN(pb + PH_MERGE)) {
            KP q = load_params(); unsigned char* w = q->ws;
            pg8::Gemm g{(const bf16*)(w + WS_OBUF), (const bf16*)(w + WS_WP) + (size_t)l * 1024 * 1536, NTOK, 1024, 1536}; pg8::StaticOrder S; S.init(NTOK, 1024, G, bx);
            pg8::EpiMerge E{(const bf16*)(w + WS_Z) + Z_GT, ZP, (bf16*)(w + WS_MERGED), 1024};
            pg8::gemm_phase<pg8::EpiMerge, pg8::StaticOrder, true, true>(lds, g, S, E, wave0);
            SEAM(pb + PH_MERGE);
        }
        if (IN(pb + PH_WOUT)) {
            KP q = load_params(); unsigned char* w = q->ws;
            pg8::Gemm g{(const bf16*)(w + WS_MERGED), (const bf16*)(w + WS_WOUT) + (size_t)l * 1024 * 1024, NTOK, 1024, 1024}; pg8::StaticOrder S; S.init(NTOK, 1024, G, bx);
            pg8::EpiBf16 E{(bf16*)(w + WS_MIX), 1024};
            pg8::gemm_phase<pg8::EpiBf16, pg8::StaticOrder, true, true>(lds, g, S, E, wave0);
            SEAM(pb + PH_WOUT);
        }
        if (IN(pb + PH_LN1)) { PH_IDS KP q = load_params(); const float* xin = (l == 0) ? q->x : (const float*)(q->ws + WS_XCUR); ln1_phase(q, l, xin, lds, G, tid, wave, lane); SEAM(pb + PH_LN1); }
        if (IN(pb + PH_SLOT)) { PH_IDS KP q = load_params(); slot_phase(q, lds, G, tid, wave, lane); SEAM(pb + PH_SLOT); }
        if (IN(pb + PH_GU)) {
            KP q = load_params(); unsigned char* w = q->ws;
            pg8::Gemm g{(const bf16*)(w + WS_X1B), (const bf16*)(w + WS_WGU + (size_t)l * 32 * 2048 * 1024), MAXSLOT, 32 * 2048, 1024};
            pg8::moe_build_list((LAS int*)(lds + pg8::STAGE_BYTES), (const int*)(w + WS_BLK), 8, G, bx, wave0 * 64 + lane_id()); pg8::MoeOrderG S{(const LAS int*)(lds + pg8::STAGE_BYTES), (const int*)(w + WS_SLOTTOK)};
            pg8::EpiSwiGLU E{(bf16*)(w + WS_ACT), (const float*)(w + WS_BGU) + (size_t)l * 32 * 2048, 8};
            pg8::gemm_phase<pg8::EpiSwiGLU, pg8::MoeOrderG, true, true, true, W8_E8M0>(lds, g, S, E, wave0);
            SEAM(pb + PH_GU);
        }
        if (IN(pb + PH_DOWN)) {
            KP q = load_params(); unsigned char* w = q->ws;
            pg8::Gemm g{(const bf16*)(w + WS_ACT), (const bf16*)(w + WS_WDN + (size_t)l * 32 * 1024 * 1024), MAXSLOT, 32 * 1024, 1024};
            pg8::moe_build_list((LAS int*)(lds + pg8::STAGE_BYTES), (const int*)(w + WS_BLK), 4, G, bx, wave0 * 64 + lane_id()); pg8::MoeOrder S{(const LAS int*)(lds + pg8::STAGE_BYTES), nullptr};
            pg8::EpiDown E{(bf16*)(w + WS_Y), q->b_down + (size_t)l * 32 * 1024, (const float*)(w + WS_GSLOT), 4};
            pg8::gemm_phase<pg8::EpiDown, pg8::MoeOrder, true, true, true, W8_E8M0>(lds, g, S, E, wave0);
            SEAM(pb + PH_DOWN);
        }
        if (IN(pb + PH_COMB)) { PH_IDS KP q = load_params(); float* xout = (l == DEPTH - 1) ? q->out : (float*)(q->ws + WS_XCUR); comb_phase(q, l, xout, G, wave, lane); SEAM(pb + PH_COMB); }
    }
#undef IN
#undef SEAM
}

#ifndef DBG
#define DBG 0
#endif
#if DBG
constexpr int CW_DBG = 64;
__device__ __forceinline__ unsigned hsh(unsigned a) { a ^= a >> 16; a *= 0x7feb352du; a ^= a >> 15; a *= 0x846ca68bu; a ^= a >> 16; return a; }
__device__ __forceinline__ void dbg_fail(Params& p, int id) { atomicMin((int*)(p.ws + WS_CTL) + CW_DBG, id); }
__device__ __forceinline__ bool bad(float a, float ref, float rel, float abs_) { return !(fabsf(a - ref) <= rel * fabsf(ref) + abs_); }
__device__ __forceinline__ float dotx(const float* xr, const float* W, int ld, int col, int K) { float s = 0.f; for (int k = 0; k < K; ++k) s += xr[k] * W[(size_t)k * ld + col]; return s; }

__global__ void __launch_bounds__(64) chk(Params p, int l, int which) {
    __shared__ float Ssh[64 * 65];
    unsigned char* ws = p.ws; const int gt_ = blockIdx.x * 64 + threadIdx.x; const unsigned h0 = hsh(gt_ * 2654435761u + which * 97u + 12345u), h1 = hsh(h0 + 0x9e3779b9u), h2 = hsh(h1 + 77u);
    const float* xin = (l == 0) ? p.x : (const float*)(ws + WS_XCUR);
    const bf16* Z = (const bf16*)(ws + WS_Z);
    const int id = (l * 20 + which) * 4;
    const float* win = p.w_in + (size_t)l * 1024 * D_IN;
    if (which == 1) {
        const int t = h0 % NTOK, n = h1 % D_IN; const int sc = zcol_src(n); const float scale = (n < 512 || (n >= Z_FQ && n < Z_FK)) ? QSCALE : 1.f;
        const float ref = dotx(xin + (size_t)t * DM, win, D_IN, sc, 1024) * scale;
        if (bad(bf2f(Z[(size_t)t * ZP + n]), ref, 0.03f, 0.03f)) dbg_fail(p, id);
    } else if (which == 2) {
        const int t = h0 % NTOK, pos = t & (SEQ - 1), b = t >> 13; const float* xr = xin + (size_t)t * DM;
        { const int hh = h1 % 21, i = h2 & 31; const int col = hh < 8 ? Z_AQ + hh * 64 : hh < 16 ? Z_AK + (hh - 8) * 64 : hh < 20 ? Z_IQ + (hh - 16) * 64 : Z_IK;
          const float sc = hh < 8 ? QSCALE : 1.f; const float t1 = dotx(xr, win, D_IN, zcol_src(col + i), 1024) * sc, t2 = dotx(xr, win, D_IN, zcol_src(col + i + 32), 1024) * sc;
          const float inv = powf(10000.f, -(float)i / 32.f); const float ang = (float)pos * inv; const double rev = (double)ang * 0.15915494309189535; const float fr = (float)(rev - __builtin_rint(rev));
          const float c = __builtin_amdgcn_cosf(fr), s = __builtin_amdgcn_sinf(fr);
          if (bad(bf2f(Z[(size_t)t * ZP + col + i]), t1 * c - t2 * s, 0.03f, 0.03f) || bad(bf2f(Z[(size_t)t * ZP + col + i + 32]), t2 * c + t1 * s, 0.03f, 0.03f)) dbg_fail(p, id); }
        { const int c = h2 % 1024; const float a0 = dotx(xr, win, D_IN, 5452 + c, 1024), a1 = dotx(xr, win, D_IN, 5452 + 1024 + c, 1024), a2 = dotx(xr, win, D_IN, 5452 + 2048 + c, 1024);
          const float g0 = sigmoidf_(a0), g1 = sigmoidf_(a1), g2 = sigmoidf_(a2);
          if (bad(bf2f(Z[(size_t)t * ZP + Z_GT + c]), g0 / g1, 0.05f, 0.01f) || bad(bf2f(Z[(size_t)t * ZP + Z_GT + 1024 + c]), g1 / g2, 0.05f, 0.01f) || bad(bf2f(Z[(size_t)t * ZP + Z_GT + 2048 + c]), g2, 0.05f, 0.01f)) dbg_fail(p, id + 1); }
        { const int hh = h1 & 7; const float v = dotx(xr, win, D_IN, 3396 + hh, 1024) + p.b_fox[l * 8 + hh]; const float ls = -log1pf(expf(-v)) * LOG2E;
          if (bad(((const float*)(ws + WS_LFT))[(size_t)(b * 8 + hh) * SEQ + pos], ls, 0.05f, 0.003f)) dbg_fail(p, id + 2); }
    } else if (which == 3) {
        { const int bh = h0 & 31, t = h1 % SEQ; const float* lf = (const float*)(ws + WS_LFT) + (size_t)bh * SEQ; float s = 0.f; for (int i = 0; i <= t; ++i) s += lf[i];
          if (bad(((const float*)(ws + WS_CT))[(size_t)bh * SEQ + t], s, 1e-3f, 1e-2f)) dbg_fail(p, id); }
        if (gt_ < 192) { const int b = h1 & 3, q = (gt_ < 32) ? (int)(h2 % 512) : (int)(h2 % SEQ); const int nadm = ((q >> 6) + 1) * 64; const u64* mw = (const u64*)(ws + WS_MASKW) + (size_t)(b * SEQ + q) * 128;
          int pc = 0; bool oob = false; for (int w = 0; w < 128; ++w) { const u64 m = mw[w]; pc += __popcll(m); if (w * 64 >= nadm && m) oob = true; }
          if (pc != (nadm < 256 ? nadm : 256) || oob) dbg_fail(p, id + 1);
          const bf16* qr = Z + (size_t)(b * SEQ + q) * ZP; float minsel = 3e38f, maxun = -3e38f;
          for (int s = 0; s < nadm; ++s) { const bf16* kr = Z + (size_t)(b * SEQ + s) * ZP + Z_IK; float sc = 0.f;
              for (int hd = 0; hd < 4; ++hd) { float d = 0.f; for (int k = 0; k < 64; ++k) d += bf2f(qr[Z_IQ + hd * 64 + k]) * bf2f(kr[k]); sc += bf2f(qr[Z_IW + hd]) * 0.0625f * fmaxf(d, 0.f); }
              if ((mw[s >> 6] >> (s & 63)) & 1ull) minsel = fminf(minsel, sc); else maxun = fmaxf(maxun, sc); }
          if (nadm > 256 && !(maxun <= minsel + 0.02f * fabsf(minsel) + 2e-3f)) dbg_fail(p, id + 2); }
    } else if (which == 4) {
        if (gt_ == 0 && l == 0) { const bf16* ob = (const bf16*)(ws + WS_OBUF) + 512;
            const float a0 = bf2f(ob[0]), a1 = bf2f(ob[1]), a3 = bf2f(ob[3]), b0 = bf2f(ob[8]), b1 = bf2f(ob[9]), b3 = bf2f(ob[11]), m0 = bf2f(ob[4]), m1 = bf2f(ob[12]);
            auto tr = [](float v) { return v == 0.f ? 0.f : v == 1.f ? 1.f : 2.f; };
            ((float*)(ws + WS_CTL))[CW_DBG + 2] = 10.f * (tr(a0) + 3.f * tr(b0) + 9.f * tr(a1) + 27.f * tr(b1));
            ((float*)(ws + WS_CTL))[CW_DBG + 3] = sqrtf(10.f * (tr(a3) + 3.f * tr(b3) + 9.f * (m0 == m1 ? 1.f : 0.f) + 27.f * (m0 > -1e20f ? 1.f : 0.f))); }
        const int mode = gt_ & 1, b = h0 & 3, h = (h0 >> 2) & 7, q = (gt_ < 64) ? (int)(h1 % 300) : (int)(h1 % SEQ), d = h2 & 63;
        const int QC = mode == 0 ? Z_FQ : Z_AQ, KC = mode == 0 ? Z_FK : Z_AK, VC = mode == 0 ? Z_FV : Z_AV, OC = mode == 0 ? 512 : 0;
        const bf16* qr = Z + (size_t)(b * SEQ + q) * ZP + QC + h * 64; const float* c = (const float*)(ws + WS_CT) + (size_t)(b * 8 + h) * SEQ; const u64* mw = (const u64*)(ws + WS_MASKW) + (size_t)(b * SEQ + q) * 128;
        const int ns = mode == 0 ? q + 1 : ((q >> 6) + 1) * 64; float mx = -3e38f, mx2 = -3e38f; float ref = 0.f, ref2 = 0.f;
        for (int pass = 0; pass < 2; ++pass) { float den = 0.f, num = 0.f, den2 = 0.f, num2 = 0.f;
            for (int s = 0; s < ns; ++s) { if (mode == 1 && !((mw[s >> 6] >> (s & 63)) & 1ull)) continue;
                const bf16* kr = Z + (size_t)(b * SEQ + s) * ZP + KC + h * 64; float lg = 0.f; for (int k = 0; k < 64; ++k) lg += bf2f(qr[k]) * bf2f(kr[k]);
                const float lg2 = lg; if (mode == 0) lg += c[q] - c[s];
                if (pass == 0) { mx = fmaxf(mx, lg); mx2 = fmaxf(mx2, lg2); } else { const float vv = bf2f(Z[(size_t)(b * SEQ + s) * ZP + VC + h * 64 + d]); const float pp = exp2f(lg - mx), pq = exp2f(lg2 - mx2); den += pp; num += pp * vv; den2 += pq; num2 += pq * vv; } }
            if (pass == 1) { ref = num / den; ref2 = num2 / den2; } }
        const float got = bf2f(((const bf16*)(ws + WS_OBUF))[(size_t)(b * SEQ + q) * OP + OC + h * 64 + d]);
        if (bad(got, ref, 0.04f, 0.03f)) { dbg_fail(p, id + mode);
            int m = 0; if (mode == 0 && q == 0) m |= 1; if (mode == 0 && q < 32) m |= 2; if (mode == 1 && q < 64) m |= 4; if (mode == 1 && q >= 64) m |= 8; atomicOr((int*)(p.ws + WS_CTL) + CW_DBG + 1, m); }
    } else if (which == 7) {
        const int b = blockIdx.x & 3, h = (blockIdx.x >> 2) & 7, e = threadIdx.x;
        for (int d = 0; d < 64; ++d) Ssh[d * 65 + e] = 0.f;
        const float lbv_e = 0.f; (void)lbv_e;
        for (int t = 0; t < 200; ++t) { const bf16* zr = Z + (size_t)(b * SEQ + t) * ZP + h * 64; float o = 0.f; const float ve = bf2f(zr[Z_CI + e]);
            for (int d = 0; d < 64; ++d) { const int dd = h * 64 + d; const float lb = (l == 0) ? 0.f : sigmoidf_(p.lb_logits[512 + dd] - p.lb_logits[dd]);
                const float sg = sigmoidf_(bf2f(zr[Z_CF + d])); const float f = lb + (1.f - lb) * sg, kk = (1.f - lb) * (1.f - sg);
                const float S = f * Ssh[d * 65 + e] + kk * ve; Ssh[d * 65 + e] = S; o += bf2f(zr[Z_CQ + d]) * S; }
            const float ss = wave_sum(o * o); const float ref = o * (1.f / sqrtf(ss * (1.f / 64.f) + RMS_EPS)) * p.norm_g[l * 512 + h * 64 + e] * sigmoidf_(bf2f(zr[Z_CG + e]));
            if (bad(bf2f(((const bf16*)(ws + WS_OBUF))[(size_t)(b * SEQ + t) * OP + 1024 + h * 64 + e]), ref, 0.06f, 0.05f)) { const int n = atomicAdd((int*)(p.ws + WS_CTL) + CW_DBG + 4 + (t >= 64 ? 1 : 0), 1); if (n >= 40) dbg_fail(p, id + (t >= 64 ? 1 : 0)); } }
    } else if (which == 8) {
        const int t = h0 % NTOK, c = h1 % 1024; const bf16* zr = Z + (size_t)t * ZP + Z_GT; const float g2 = bf2f(zr[2048 + c]), g1 = bf2f(zr[1024 + c]) * g2, g0 = bf2f(zr[c]) * g1;
        const bf16* ob = (const bf16*)(ws + WS_OBUF) + (size_t)t * OP; float sa = 0.f, sb = 0.f, sc = 0.f;
        for (int k = 0; k < 512; ++k) { sa += bf2f(ob[k]) * p.w_pa[((size_t)l * 512 + k) * 1024 + c]; sb += bf2f(ob[512 + k]) * p.w_pb[((size_t)l * 512 + k) * 1024 + c]; sc += bf2f(ob[1024 + k]) * p.w_pc[((size_t)l * 512 + k) * 1024 + c]; }
        if (bad(bf2f(((const bf16*)(ws + WS_MERGED))[(size_t)t * 1024 + c]), g0 * sa + g1 * sb + g2 * sc, 0.04f, 0.01f)) dbg_fail(p, id);
    } else if (which == 9) {
        const int t = h0 % NTOK, c = h1 % 1024; const bf16* mr = (const bf16*)(ws + WS_MERGED) + (size_t)t * 1024; float s = 0.f;
        for (int k = 0; k < 1024; ++k) s += bf2f(mr[k]) * p.w_out[((size_t)l * 1024 + k) * 1024 + c];
        if (bad(((const float*)(ws + WS_MIX))[(size_t)t * 1024 + c], s, 0.03f, 0.005f)) dbg_fail(p, id);
    } else if (which == 10) {
        const int t = h0 % NTOK, c = h1 % 1024; const float* xr = xin + (size_t)t * DM; const float* mr = (const float*)(ws + WS_MIX) + (size_t)t * DM; const float* x1 = (const float*)(ws + WS_X1) + (size_t)t * DM;
        float mean = 0.f; for (int k = 0; k < 1024; ++k) mean += ALPHA * xr[k] + mr[k]; mean *= (1.f / 1024.f);
        float var = 0.f; for (int k = 0; k < 1024; ++k) { const float dlt = ALPHA * xr[k] + mr[k] - mean; var += dlt * dlt; } var *= (1.f / 1024.f);
        const float ref = (ALPHA * xr[c] + mr[c] - mean) / sqrtf(var + LN_EPS) * p.ln1_g[l * 1024 + c] + p.ln1_b[l * 1024 + c];
        if (bad(x1[c], ref, 1e-3f, 1e-3f) || bad(bf2f(((const bf16*)(ws + WS_X1B))[(size_t)t * DM + c]), ref, 0.01f, 0.01f)) dbg_fail(p, id);
        float tv0 = -3e38f, tv1 = -3e38f, tv2 = -3e38f, tv3 = -3e38f; int ti0 = -1, ti1 = -1, ti2 = -1, ti3 = -1;
        for (int e = 0; e < 32; ++e) { float lg = p.b_router[l * 32 + e]; for (int k = 0; k < 1024; ++k) lg += x1[k] * p.w_router[((size_t)l * 1024 + k) * 32 + e];
            if (lg > tv0) { tv3 = tv2; ti3 = ti2; tv2 = tv1; ti2 = ti1; tv1 = tv0; ti1 = ti0; tv0 = lg; ti0 = e; } else if (lg > tv1) { tv3 = tv2; ti3 = ti2; tv2 = tv1; ti2 = ti1; tv1 = lg; ti1 = e; }
            else if (lg > tv2) { tv3 = tv2; ti3 = ti2; tv2 = lg; ti2 = e; } else if (lg > tv3) { tv3 = lg; ti3 = e; } }
        const int* tke = (const int*)(ws + WS_TKE) + t * 4; const float* tkg = (const float*)(ws + WS_TKG) + t * 4;
        const float den = 1.f + expf(tv1 - tv0) + expf(tv2 - tv0) + expf(tv3 - tv0);
        if (tv2 - tv3 > 1e-3f && tv1 - tv2 > 1e-3f && tv0 - tv1 > 1e-3f) { if (tke[0] != ti0 || tke[1] != ti1 || tke[2] != ti2 || tke[3] != ti3) dbg_fail(p, id + 1);
            if (bad(tkg[0], 1.f / den, 1e-2f, 1e-3f) || bad(tkg[3], expf(tv3 - tv0) / den, 1e-2f, 1e-3f)) dbg_fail(p, id + 2); }
    } else if (which == 11) {
        const int t = h0 % NTOK, k = h1 & 3, c = h2 % 1024; const int slot = ((const int*)(ws + WS_TOKSLOT))[t * 4 + k], e = ((const int*)(ws + WS_TKE))[t * 4 + k]; const int* blk = (const int*)(ws + WS_BLK);
        if (slot < 0 || slot >= blk[0] * 256 || blk[0] > MAXBLK) { dbg_fail(p, id); return; }
        if (blk[16 + (slot >> 8)] != e) dbg_fail(p, id + 1);
        if (((const float*)(ws + WS_GSLOT))[slot] != ((const float*)(ws + WS_TKG))[t * 4 + k]) dbg_fail(p, id + 2);
        if (((const bf16*)(ws + WS_XG))[(size_t)slot * DM + c] != ((const bf16*)(ws + WS_X1B))[(size_t)t * DM + c]) dbg_fail(p, id + 3);
    } else if (which == 12) {
        const int t = h0 % NTOK, k = h1 & 3, j = h2 % 1024; const int slot = ((const int*)(ws + WS_TOKSLOT))[t * 4 + k], e = ((const int*)(ws + WS_TKE))[t * 4 + k];
        const bf16* xr = (const bf16*)(ws + WS_XG) + (size_t)slot * DM; const float* W = p.w_gu + (size_t)(l * 32 + e) * 1024 * 2048; float g = p.b_gu[(size_t)(l * 32 + e) * 2048 + j], u = p.b_gu[(size_t)(l * 32 + e) * 2048 + 1024 + j];
        for (int kk = 0; kk < 1024; ++kk) { const float xv = bf2f(xr[kk]); g += xv * W[(size_t)kk * 2048 + j]; u += xv * W[(size_t)kk * 2048 + 1024 + j]; }
        g = fminf(g, 7.f); u = fminf(fmaxf(u, -7.f), 7.f); const float ref = g * sigmoidf_(1.702f * g) * (u + 1.f);
        if (bad(bf2f(((const bf16*)(ws + WS_ACT))[(size_t)slot * 1024 + j]), ref, 0.04f, 0.02f)) dbg_fail(p, id);
    } else if (which == 13) {
        const int t = h0 % NTOK, k = h1 & 3, n = h2 % 1024; const int slot = ((const int*)(ws + WS_TOKSLOT))[t * 4 + k], e = ((const int*)(ws + WS_TKE))[t * 4 + k];
        const bf16* ar = (const bf16*)(ws + WS_ACT) + (size_t)slot * 1024; const float* W = p.w_down + (size_t)(l * 32 + e) * 1024 * 1024; float s = p.b_down[(size_t)(l * 32 + e) * 1024 + n];
        for (int kk = 0; kk < 1024; ++kk) s += bf2f(ar[kk]) * W[(size_t)kk * 1024 + n];
        if (bad(bf2f(((const bf16*)(ws + WS_Y))[(size_t)slot * 1024 + n]), s * ((const float*)(ws + WS_GSLOT))[slot], 0.04f, 0.005f)) dbg_fail(p, id);
    } else if (which == 14) {
        const int t = h0 % NTOK, c = h1 % 1024; const float* x1 = (const float*)(ws + WS_X1) + (size_t)t * DM; const bf16* y = (const bf16*)(ws + WS_Y); const int* ts = (const int*)(ws + WS_TOKSLOT) + t * 4;
        const float* xo = ((l == DEPTH - 1) ? p.out : (float*)(ws + WS_XCUR)) + (size_t)t * DM;
        float mean = 0.f; for (int k = 0; k < 1024; ++k) { float v = ALPHA * x1[k]; for (int j = 0; j < 4; ++j) v += bf2f(y[(size_t)ts[j] * 1024 + k]); mean += v; } mean *= (1.f / 1024.f);
        float var = 0.f, vc = 0.f; for (int k = 0; k < 1024; ++k) { float v = ALPHA * x1[k]; for (int j = 0; j < 4; ++j) v += bf2f(y[(size_t)ts[j] * 1024 + k]); var += (v - mean) * (v - mean); if (k == c) vc = v; } var *= (1.f / 1024.f);
        if (bad(xo[c], (vc - mean) / sqrtf(var + LN_EPS) * p.ln2_g[l * 1024 + c] + p.ln2_b[l * 1024 + c], 2e-3f, 2e-3f)) dbg_fail(p, id);
    }
}
__global__ void dbg_init(Params p) { if (threadIdx.x == 0 && blockIdx.x == 0) { ((int*)(p.ws + WS_CTL))[CW_DBG] = 0x7fffffff; ((int*)(p.ws + WS_CTL))[CW_DBG + 1] = 0; ((int*)(p.ws + WS_CTL))[CW_DBG + 4] = 0; ((int*)(p.ws + WS_CTL))[CW_DBG + 5] = 0; } }
__global__ void dbg_fill(Params p, int n) {
    const int code = ((const int*)(p.ws + WS_CTL))[CW_DBG]; if (code == 0x7fffffff) return;
    const int sub = code & 3, lw = code >> 2, l = lw / 20, which = lw % 20; const int k = l * 16 + which + 32 * sub;
    const float c = sqrtf(exp2f((float)k));
    const int msk = ((const int*)(p.ws + WS_CTL))[CW_DBG + 1];
    for (int i = blockIdx.x * blockDim.x + threadIdx.x; i < n; i += gridDim.x * blockDim.x) p.out[i] = (i == 0) ? 16.f * (float)(1 + msk) : c;
}
#endif

extern "C" void kernel_launch(void* const* d_in, const int* in_sizes, int n_in, void* d_out, int out_size, void* d_ws, size_t ws_size, hipStream_t stream) {
    static int grid = 0;
    if (grid == 0) {
        if (n_in != 19 || ws_size < WS_END) { fprintf(stderr, "kernel_launch: need 19 inputs and >= %zu bytes of workspace; got %d, %zu\n", (size_t)WS_END, n_in, ws_size); grid = -1; return; }
        int dev = 0, cus = 0, per_cu = 0;
        if (hipGetDevice(&dev) != hipSuccess || hipDeviceGetAttribute(&cus, hipDeviceAttributeMultiprocessorCount, dev) != hipSuccess) { grid = -1; return; }
        if (hipFuncSetAttribute((const void*)fwd, hipFuncAttributeMaxDynamicSharedMemorySize, LDS_BYTES) != hipSuccess) { fprintf(stderr, "kernel_launch: hipFuncSetAttribute failed\n"); grid = -1; return; }
        if (hipOccupancyMaxActiveBlocksPerMultiprocessor(&per_cu, (const void*)fwd, NTHR, LDS_BYTES) != hipSuccess || per_cu < 1) fprintf(stderr, "kernel_launch: occupancy query reports %d\n", per_cu);
        (void)hipGetLastError();
        grid = cus;
    }
    if (grid < 0) return;
    (void)hipMemsetAsync((char*)d_ws + WS_CTL, 0, CTL_ZERO_BYTES, stream);
    Params p{};
    const float** f = (const float**)&p;
    for (int i = 0; i < 19; ++i) f[i] = (const float*)d_in[i];
    p.out = (float*)d_out; p.ws = (unsigned char*)d_ws;
#if ONE_LAUNCH
    p.ph_lo = 0; p.ph_hi = NPHASES; p.use_bar = 1; p.pad = 0;
    hipLaunchKernelGGL(fwd, dim3(grid), dim3(NTHR), LDS_BYTES, stream, p);
#else
#if DBG
    hipLaunchKernelGGL(dbg_init, dim3(1), dim3(64), 0, stream, p);
#endif
    for (int ph = 0; ph < NPHASES; ++ph) { p.ph_lo = ph; p.ph_hi = ph + 1; p.use_bar = 0; p.pad = 0;
        hipLaunchKernelGGL(fwd, dim3(grid), dim3(NTHR), LDS_BYTES, stream, p);
#if DBG
        if (ph >= 1) { const int l = (ph - 1) / NPH_LAYER, k = (ph - 1) % NPH_LAYER; static const int wmap[NPH_LAYER] = {1, 2, 3, 4, 0, 0, 7, 8, 9, 10, 11, 12, 13, 14}; const int w = wmap[k];
            if (w) { const int nb = (w == 7) ? 32 : (w == 3) ? 4 : (w == 4) ? 2 : 16; hipLaunchKernelGGL(chk, dim3(nb), dim3(64), 0, stream, p, l, w); } }
#endif
    }
#if DBG
    hipLaunchKernelGGL(dbg_fill, dim3(1024), dim3(256), 0, stream, p, out_size);
#endif
#endif
}
```
